# Optimizing an MI355X kernel written in HIP

```python
import jax, jax.numpy as jnp
from jax import lax
import numpy as np


D_MODEL = 1024
BATCH = 8
SEQ = 4096
DEPTH = 2

HEAD_DIM = 64
N_HEADS_A = D_MODEL // (2 * HEAD_DIM)
N_HEADS_B = D_MODEL // (2 * HEAD_DIM)
WIDTH_A = N_HEADS_A * HEAD_DIM
WIDTH_B = N_HEADS_B * HEAD_DIM
MIX_WIDTH = WIDTH_A + WIDTH_B
IN_COLS_A = 4 * WIDTH_A
IN_COLS = IN_COLS_A + 3 * WIDTH_B
D_DECAY_LORA = 64
D_AAA_LORA = 64
D_GATE_LORA = 128
DILATED_PAIRS = ((128, 1), (512, 4), (2048, 16))
ROPE_THETA = 10000.0
N_FOURIER_GROUPS = 8
FOURIER_GROUP = D_MODEL // N_FOURIER_GROUPS
D_FF = ((8 * D_MODEL // 3 + 127) // 128) * 128
N_EVEN = (DEPTH + 1) // 2
N_ODD = DEPTH // 2
RMS_EPS = 1e-6
LNX_EPS = 64e-5
L2_EPS = 1e-12
NEG_BIG = -1e30
F32 = jnp.float32

kernel_name = 'hybrid_rwkv7_dilated_fnet_block'


def rmsnorm(x, g):
    xf = x.astype(F32)
    y = xf * lax.rsqrt(jnp.mean(xf * xf, -1, keepdims=True) + RMS_EPS)
    return (y * g.astype(F32)).astype(x.dtype)


def dwconv3(x, w):
    xp = jnp.pad(x, ((0, 0), (1, 1), (0, 0)))
    return xp[:, :-2] * w[0] + xp[:, 1:-1] * w[1] + xp[:, 2:] * w[2]


def rope(x, pos):
    half = x.shape[-1] // 2
    inv = ROPE_THETA ** (-jnp.arange(half, dtype=F32) / half)
    ang = pos.astype(F32)[:, None] * inv[None, :]
    cos = jnp.cos(ang)[None, :, None, :]
    sin = jnp.sin(ang)[None, :, None, :]
    x1 = x[..., :half].astype(F32)
    x2 = x[..., half:].astype(F32)
    return jnp.concatenate([x1 * cos - x2 * sin, x2 * cos + x1 * sin], -1).astype(x.dtype)


def wkv7_scan(r, w, k, v, kk, a, reverse):
    B_, S_, H_, N_ = r.shape
    xs = tuple(jnp.moveaxis(t, 1, 0) for t in (r, w, k, v, kk, a))

    def step(state, inp):
        r_t, w_t, k_t, v_t, kk_t, a_t = inp
        sk = jnp.einsum('bhij,bhj->bhi', state, kk_t)
        state = (state * w_t[:, :, None, :]
                 - sk[..., :, None] * (kk_t * a_t)[:, :, None, :]
                 + v_t[..., :, None] * k_t[:, :, None, :])
        y = jnp.einsum('bhij,bhj->bhi', state, r_t)
        return state, y

    s0 = jnp.zeros((B_, H_, N_, N_), F32)
    _, ys = lax.scan(step, s0, xs, reverse=reverse)
    return jnp.moveaxis(ys, 0, 1)


def rwkv7_mixer(r, k, v, u, w0, w1, w2, a0, a1, a2, g1, g2, k_k, k_a, r_k, lnx_w, lnx_b):
    B_, S_, _ = r.shape
    rf, kf, vf, uf = (t.astype(F32) for t in (r, k, v, u))
    hs = lambda t: t.reshape(B_, S_, N_HEADS_A, HEAD_DIM)
    g = jax.nn.sigmoid(uf @ g1) @ g2
    kk = hs(kf * k_k)
    kk = kk * lax.rsqrt(jnp.sum(kk * kk, -1, keepdims=True) + L2_EPS)
    rh, vh = hs(rf), hs(vf)
    y = 0.0
    bonus = 0.0
    for d in range(2):
        w_log = -jax.nn.softplus(-(w0[d] + jnp.tanh(uf @ w1[d]) @ w2[d])) - 0.5
        decay = jnp.exp(-jnp.exp(w_log))
        a = jax.nn.sigmoid(a0[d] + (uf @ a1[d]) @ a2[d])
        kd = hs(kf * (1.0 + (a - 1.0) * k_a))
        ah = hs(a)
        y = y + wkv7_scan(rh, hs(decay), kd, vh, kk, ah, reverse=(d == 1))
        bonus = bonus + jnp.sum(rh * kd * r_k, -1, keepdims=True) * vh
    mu = jnp.mean(y, -1, keepdims=True)
    var = jnp.mean(jnp.square(y - mu), -1, keepdims=True)
    y = ((y - mu) * lax.rsqrt(var + LNX_EPS)).reshape(B_, S_, WIDTH_A) * lnx_w + lnx_b
    y = (y + bonus.reshape(B_, S_, WIDTH_A)) * g
    return y.astype(r.dtype)


def dilated_branch(q, k, v, window, dilation):
    B_, S_, H_, E_ = q.shape
    hk = window // (2 * dilation)
    M = S_ // dilation
    nb = -(-M // hk)
    Mp = nb * hk

    def blocks(t):
        t = t.reshape(B_, M, dilation, H_, E_)
        t = jnp.pad(t, ((0, 0), (0, Mp - M), (0, 0), (0, 0), (0, 0)))
        return t.reshape(B_, nb, hk, dilation, H_, E_)

    def band(t):
        tp = jnp.pad(t, ((0, 0), (1, 1), (0, 0), (0, 0), (0, 0), (0, 0)))
        return jnp.concatenate([tp[:, :-2], tp[:, 1:-1], tp[:, 2:]], axis=2)

    qb = blocks(q)
    kw = band(blocks(k))
    vw = band(blocks(v))
    s = jnp.einsum('bnqrhe,bnkrhe->bnrhqk', qb, kw).astype(F32) * (E_ ** -0.5)
    blk = jnp.arange(nb)[:, None, None]
    qi = blk * hk + jnp.arange(hk)[None, :, None]
    ki = (blk - 1) * hk + jnp.arange(3 * hk)[None, None, :]
    valid = (jnp.abs(ki - qi) <= hk) & (ki >= 0) & (ki < M)
    s = jnp.where(valid[None, :, None, None], s, NEG_BIG)
    m = jnp.max(s, -1)
    p = jnp.exp(s - m[..., None])
    den = jnp.sum(p, -1)
    num = jnp.einsum('bnrhqk,bnkrhe->bnqrhe', p.astype(v.dtype), vw).astype(F32)

    def unblock(t):
        t = t.reshape((B_, Mp, dilation) + t.shape[4:])[:, :M]
        return t.reshape((B_, S_) + t.shape[3:])

    m = unblock(jnp.moveaxis(m, -1, 2))
    den = unblock(jnp.moveaxis(den, -1, 2))
    num = unblock(num)
    return m, den, num


def dilated_attention(q, k, v):
    outs = [dilated_branch(q, k, v, w, d) for (w, d) in DILATED_PAIRS]
    m_all = jnp.max(jnp.stack([o[0] for o in outs], 0), 0)
    den = 0.0
    num = 0.0
    for m, dn, nm in outs:
        e = jnp.exp(m - m_all)
        den = den + e * dn
        num = num + e[..., None] * nm
    return num / den[..., None]


def parallel_mixer(h, mix_in, mix_conv, w0, w1, w2, a0, a1, a2, g1, g2,
                   k_k, k_a, r_k, lnx_w, lnx_b, mix_out):
    B_, S_, _ = h.shape
    z = h @ mix_in
    za = dwconv3(z[..., :IN_COLS_A], mix_conv)
    r, k, v, u = jnp.split(za, 4, -1)
    ya = rwkv7_mixer(r, k, v, u, w0, w1, w2, a0, a1, a2, g1, g2, k_k, k_a, r_k, lnx_w, lnx_b)
    qb, kb, vb = (t.reshape(B_, S_, N_HEADS_B, HEAD_DIM) for t in jnp.split(z[..., IN_COLS_A:], 3, -1))
    pos = jnp.arange(S_)
    qb = rope(qb, pos)
    kb = rope(kb, pos)
    yb = dilated_attention(qb, kb, vb).astype(h.dtype).reshape(B_, S_, WIDTH_B)
    return jnp.concatenate([ya, yb], -1) @ mix_out


def fourier_mixer(h, fnet_w):
    B_, S_, D_ = h.shape
    hg = h.astype(F32).reshape(B_, S_, N_FOURIER_GROUPS, FOURIER_GROUP)
    f = jnp.fft.fft2(hg, axes=(1, 3), norm='ortho').real
    return f.reshape(B_, S_, D_).astype(h.dtype) @ fnet_w


def conv_glu(h, up, conv, down):
    z = dwconv3(h @ up, conv)
    gate, val = jnp.split(z, 2, -1)
    return (jax.nn.gelu(gate, approximate=True) * val) @ down


def setup_inputs(seed: int = 0) -> dict:
    key = jax.random.key(seed)
    ks = jax.random.split(key, 26)
    nrm = lambda k, shape, s: jax.random.normal(k, shape, F32) * s
    ident3 = lambda k, C, n: jnp.broadcast_to(jnp.array([0.0, 1.0, 0.0], F32)[None, :, None], (n, 3, C)) + nrm(k, (n, 3, C), 0.2)
    return {
        'x': nrm(ks[0], (BATCH, SEQ, D_MODEL), 1.0),
        'c': nrm(ks[1], (BATCH, D_MODEL), 1.0),
        'ada_w': nrm(ks[2], (DEPTH, D_MODEL, 6 * D_MODEL), D_MODEL ** -0.5),
        'ada_b': nrm(ks[3], (DEPTH, 6 * D_MODEL), 0.02),
        'norm_g': 1.0 + nrm(ks[4], (DEPTH, 4, D_MODEL), 0.05),
        'mix_in': nrm(ks[5], (N_EVEN, D_MODEL, IN_COLS), D_MODEL ** -0.5),
        'mix_conv': ident3(ks[6], IN_COLS_A, N_EVEN),
        'rwkv_w0': jax.random.uniform(ks[7], (N_EVEN, 2, WIDTH_A), F32, -6.0, -1.0),
        'rwkv_w1': nrm(ks[8], (N_EVEN, 2, WIDTH_A, D_DECAY_LORA), WIDTH_A ** -0.5),
        'rwkv_w2': nrm(ks[9], (N_EVEN, 2, D_DECAY_LORA, WIDTH_A), 0.1 * D_DECAY_LORA ** -0.5),
        'rwkv_a0': nrm(ks[10], (N_EVEN, 2, WIDTH_A), 0.5),
        'rwkv_a1': nrm(ks[11], (N_EVEN, 2, WIDTH_A, D_AAA_LORA), WIDTH_A ** -0.5),
        'rwkv_a2': nrm(ks[12], (N_EVEN, 2, D_AAA_LORA, WIDTH_A), 0.5 * D_AAA_LORA ** -0.5),
        'rwkv_g1': nrm(ks[13], (N_EVEN, WIDTH_A, D_GATE_LORA), WIDTH_A ** -0.5),
        'rwkv_g2': nrm(ks[14], (N_EVEN, D_GATE_LORA, WIDTH_A), D_GATE_LORA ** -0.5),
        'rwkv_k_k': 0.85 + nrm(ks[15], (N_EVEN, WIDTH_A), 0.1),
        'rwkv_k_a': 1.0 + nrm(ks[16], (N_EVEN, WIDTH_A), 0.1),
        'rwkv_r_k': nrm(ks[17], (N_EVEN, N_HEADS_A, HEAD_DIM), 0.1),
        'rwkv_lnx_w': 1.0 + nrm(ks[18], (N_EVEN, WIDTH_A), 0.05),
        'rwkv_lnx_b': nrm(ks[19], (N_EVEN, WIDTH_A), 0.02),
        'mix_out': nrm(ks[20], (N_EVEN, MIX_WIDTH, D_MODEL), MIX_WIDTH ** -0.5),
        'fnet_w': nrm(ks[21], (N_ODD, D_MODEL, D_MODEL), D_MODEL ** -0.5),
        'ffn_up': nrm(ks[22], (DEPTH, D_MODEL, 2 * D_FF), D_MODEL ** -0.5),
        'ffn_conv': ident3(ks[23], 2 * D_FF, DEPTH),
        'ffn_down': nrm(ks[24], (DEPTH, D_FF, D_MODEL), D_FF ** -0.5),
    }


def reference(x, c, ada_w, ada_b, norm_g, mix_in, mix_conv, rwkv_w0, rwkv_w1, rwkv_w2,
              rwkv_a0, rwkv_a1, rwkv_a2, rwkv_g1, rwkv_g2, rwkv_k_k, rwkv_k_a, rwkv_r_k,
              rwkv_lnx_w, rwkv_lnx_b, mix_out, fnet_w, ffn_up, ffn_conv, ffn_down):
    cs = jax.nn.silu(c)
    for l in range(DEPTH):
        mod = cs @ ada_w[l] + ada_b[l]
        sh1, sc1, gt1, sh2, sc2, gt2 = [m[:, None, :] for m in jnp.split(mod, 6, -1)]
        h = rmsnorm(x, norm_g[l, 0]) * (1.0 + sc1) + sh1
        if l % 2 == 0:
            e = l // 2
            y = parallel_mixer(h, mix_in[e], mix_conv[e], rwkv_w0[e], rwkv_w1[e], rwkv_w2[e],
                               rwkv_a0[e], rwkv_a1[e], rwkv_a2[e], rwkv_g1[e], rwkv_g2[e],
                               rwkv_k_k[e], rwkv_k_a[e], rwkv_r_k[e], rwkv_lnx_w[e], rwkv_lnx_b[e],
                               mix_out[e])
        else:
            y = fourier_mixer(h, fnet_w[l // 2])
        x = x + gt1 * rmsnorm(y, norm_g[l, 1])
        h = rmsnorm(x, norm_g[l, 2]) * (1.0 + sc2) + sh2
        y = conv_glu(h, ffn_up[l], ffn_conv[l], ffn_down[l])
        x = x + gt2 * rmsnorm(y, norm_g[l, 3])
    return x
```

```cpp
#include <hip/hip_runtime.h>
#include <hip/hip_cooperative_groups.h>
#include <stdint.h>
#include <cstdio>
namespace cg = cooperative_groups;

typedef unsigned short bf16_t;
typedef short bf16x8 __attribute__((ext_vector_type(8)));
typedef short s16x4 __attribute__((ext_vector_type(4)));
typedef float f32x4 __attribute__((ext_vector_type(4)));
typedef float f32x2 __attribute__((ext_vector_type(2)));
typedef unsigned u32x4 __attribute__((ext_vector_type(4)));
typedef unsigned u32x2 __attribute__((ext_vector_type(2)));

#define DEV __device__ __forceinline__

constexpr int NB = 8, SEQ = 4096, DM = 1024, MT = NB * SEQ, DFF = 2816, INC = 3584;
constexpr size_t MiB = 1024 * 1024;
constexpr int NTHR = 512;
constexpr int LDS_BYTES = 106496;

constexpr size_t W_MIXIN = 0;
constexpr size_t W_UP = 7 * MiB;
constexpr size_t W_DOWN = 29 * MiB;
constexpr size_t W_MIXOUT = 40 * MiB;
constexpr size_t W_FNET = 42 * MiB;
constexpr size_t W_L1 = 44 * MiB;
constexpr size_t W_W2 = W_L1 + 512 * 1024;
constexpr size_t W_A2 = W_W2 + 128 * 1024;
constexpr size_t W_G2 = W_A2 + 128 * 1024;
constexpr size_t W_DFTC = W_G2 + 128 * 1024;
constexpr size_t W_MOD = 45 * MiB;
constexpr size_t W_ROPE = 46 * MiB;
constexpr size_t R0 = 48 * MiB;
constexpr size_t O_H0 = R0;
constexpr size_t O_Z = 112 * MiB;
constexpr size_t O_QR = 336 * MiB, O_KR = 368 * MiB, O_VT = 400 * MiB;
constexpr size_t O_NUM = R0;
constexpr size_t O_MD = 240 * MiB;
constexpr size_t O_YCAT = 448 * MiB;
constexpr size_t O_OMW = 48 * MiB, O_KD = 112 * MiB, O_KKA = 176 * MiB, O_KK = 240 * MiB, O_G = 272 * MiB, O_L1 = 304 * MiB, O_Y = 304 * MiB;
constexpr size_t O_YF = 48 * MiB;
constexpr size_t O_H = 176 * MiB;
constexpr size_t O_ZF = 240 * MiB;
constexpr size_t O_ACT = 416 * MiB;
constexpr size_t O_COSSIN = 240 * MiB;
constexpr size_t O_CST = 304 * MiB;
constexpr size_t O_F = 432 * MiB;

struct P {
  const float *x, *c, *ada_w, *ada_b, *norm_g, *mix_in, *mix_conv, *w0, *w1, *w2, *a0, *a1, *a2, *g1, *g2, *k_k, *k_a, *r_k, *lnx_w,
      *lnx_b, *mix_out, *fnet_w, *ffn_up, *ffn_conv, *ffn_down;
  float* out;
  char* ws;
};

DEV float bf2f(bf16_t h) { return __uint_as_float(((unsigned)h) << 16); }
DEV bf16_t f2bf(float f) {
  unsigned u = __float_as_uint(f);
  u += 0x7fffu + ((u >> 16) & 1u);
  return (bf16_t)(u >> 16);
}
DEV unsigned pk2(float a, float b) { return (unsigned)f2bf(a) | ((unsigned)f2bf(b) << 16); }
DEV float lo16(unsigned u) { return __uint_as_float(u << 16); }
DEV float hi16(unsigned u) { return __uint_as_float(u & 0xffff0000u); }
DEV float wave_sum(float v) {
#pragma unroll
  for (int o = 32; o; o >>= 1) v += __shfl_xor(v, o);
  return v;
}
DEV float sigmoidf_(float x) { return 1.f / (1.f + __expf(-x)); }

template <class Epi>
DEV void gemm_tile(char* lds, const bf16_t* __restrict__ A, int lda, const bf16_t* __restrict__ Bt, int ldb, int K, int trow, int tcol,
                   const Epi& epi) {
  const int tid = threadIdx.x, w = tid >> 6, l = tid & 63, wm = w >> 1, wn = w & 1, lr = l & 15, lq = l >> 4;
  const bf16_t* ga[4];
  const bf16_t* gb[2];
#pragma unroll
  for (int j = 0; j < 4; ++j) {
    const int c = w * 4 + j, mt = c >> 1, sl = c & 1;
    ga[j] = A + (size_t)(mt * 16 + lr) * lda + sl * 32 + lq * 8;
  }
#pragma unroll
  for (int j = 0; j < 2; ++j) {
    const int nt = w, sl = j;
    const int rowb = (nt >> 2) * 64 + (lr >> 2) * 16 + (nt & 3) * 4 + (lr & 3);
    gb[j] = Bt + (size_t)rowb * ldb + sl * 32 + lq * 8;
  }
  f32x4 acc[4][4];
#pragma unroll
  for (int i = 0; i < 4; ++i)
#pragma unroll
    for (int j = 0; j < 4; ++j) acc[i][j] = (f32x4){0.f, 0.f, 0.f, 0.f};
  u32x4 ra[4], rb[2];
  const int nk = K >> 6;
#pragma unroll
  for (int j = 0; j < 4; ++j) ra[j] = *(const u32x4*)(ga[j]);
#pragma unroll
  for (int j = 0; j < 2; ++j) rb[j] = *(const u32x4*)(gb[j]);
#pragma unroll
  for (int j = 0; j < 4; ++j) *(u32x4*)(lds + (w * 4 + j) * 1024 + l * 16) = ra[j];
#pragma unroll
  for (int j = 0; j < 2; ++j) *(u32x4*)(lds + 32768 + (w * 2 + j) * 1024 + l * 16) = rb[j];
  __syncthreads();
  for (int kt = 0; kt < nk; ++kt) {
    char* cur = lds + (kt & 1) * 49152;
    const bool more = (kt + 1 < nk);
    if (more) {
#pragma unroll
      for (int j = 0; j < 4; ++j) ra[j] = *(const u32x4*)(ga[j] + (kt + 1) * 64);
#pragma unroll
      for (int j = 0; j < 2; ++j) rb[j] = *(const u32x4*)(gb[j] + (kt + 1) * 64);
    }
#pragma unroll
    for (int s = 0; s < 2; ++s) {
      bf16x8 af[4], bfr[4];
#pragma unroll
      for (int i = 0; i < 4; ++i) af[i] = *(const bf16x8*)(cur + ((wm * 4 + i) * 2 + s) * 1024 + l * 16);
#pragma unroll
      for (int j = 0; j < 4; ++j) bfr[j] = *(const bf16x8*)(cur + 32768 + ((wn * 4 + j) * 2 + s) * 1024 + l * 16);
#pragma unroll
      for (int i = 0; i < 4; ++i)
#pragma unroll
        for (int j = 0; j < 4; ++j) acc[i][j] = __builtin_amdgcn_mfma_f32_16x16x32_bf16(bfr[j], af[i], acc[i][j], 0, 0, 0);
    }
    if (more) {
      char* nxt = lds + ((kt + 1) & 1) * 49152;
#pragma unroll
      for (int j = 0; j < 4; ++j) *(u32x4*)(nxt + (w * 4 + j) * 1024 + l * 16) = ra[j];
#pragma unroll
      for (int j = 0; j < 2; ++j) *(u32x4*)(nxt + 32768 + (w * 2 + j) * 1024 + l * 16) = rb[j];
    }
    __syncthreads();
  }
#pragma unroll
  for (int i = 0; i < 4; ++i) epi(trow + wm * 64 + i * 16 + lr, tcol + wn * 64 + lq * 16, acc[i]);
}

DEV void store16_bf16(bf16_t* dst, const f32x4 (&v)[4], float sc) {
  u32x4 a, b;
  a.x = pk2(v[0][0] * sc, v[0][1] * sc); a.y = pk2(v[0][2] * sc, v[0][3] * sc);
  a.z = pk2(v[1][0] * sc, v[1][1] * sc); a.w = pk2(v[1][2] * sc, v[1][3] * sc);
  b.x = pk2(v[2][0] * sc, v[2][1] * sc); b.y = pk2(v[2][2] * sc, v[2][3] * sc);
  b.z = pk2(v[3][0] * sc, v[3][1] * sc); b.w = pk2(v[3][2] * sc, v[3][3] * sc);
  *(u32x4*)dst = a;
  *(u32x4*)(dst + 8) = b;
}

struct EpiBf16 {
  bf16_t* O; int ldo;
  DEV void operator()(int row, int col, const f32x4 (&v)[4]) const { store16_bf16(O + (size_t)row * ldo + col, v, 1.f); }
};
struct EpiF32 {
  float* O; int ldo;
  DEV void operator()(int row, int col, const f32x4 (&v)[4]) const {
    float* d = O + (size_t)row * ldo + col;
#pragma unroll
    for (int j = 0; j < 4; ++j) *(f32x4*)(d + 4 * j) = v[j];
  }
};
struct EpiLora1 {
  bf16_t* O;
  DEV void operator()(int row, int col, const f32x4 (&v)[4]) const {
    f32x4 o[4];
#pragma unroll
    for (int j = 0; j < 4; ++j)
#pragma unroll
      for (int r = 0; r < 4; ++r) {
        const float t = v[j][r];
        o[j][r] = (col < 128) ? tanhf(t) : ((col < 256) ? t : sigmoidf_(t));
      }
    store16_bf16(O + (size_t)row * 384 + col, o, 1.f);
  }
};
struct EpiDecay {
  bf16_t* O; const float* w0;
  DEV void operator()(int row, int col, const f32x4 (&v)[4]) const {
    f32x4 o[4];
#pragma unroll
    for (int j = 0; j < 4; ++j)
#pragma unroll
      for (int r = 0; r < 4; ++r) {
        const float xx = w0[col + 4 * j + r] + v[j][r];
        const float nx = -xx;
        const float sp = (nx > 20.f) ? nx : log1pf(expf(nx));
        const float e = expf(-sp - 0.5f);
        o[j][r] = -expm1f(-e);
      }
    store16_bf16(O + (size_t)row * 512 + col, o, 1.f);
  }
};
struct EpiA {
  bf16_t *KD, *KKA, *KK; const float *a0, *k_k, *k_a; const bf16_t* za; int writekk;
  DEV void operator()(int row, int col, const f32x4 (&v)[4]) const {
    const bf16_t* kp = za + (size_t)row * 2048 + 512 + col;
    const u32x4 k0 = *(const u32x4*)kp, k1 = *(const u32x4*)(kp + 8);
    float kf[16];
    kf[0] = lo16(k0.x); kf[1] = hi16(k0.x); kf[2] = lo16(k0.y); kf[3] = hi16(k0.y); kf[4] = lo16(k0.z); kf[5] = hi16(k0.z); kf[6] = lo16(k0.w); kf[7] = hi16(k0.w);
    kf[8] = lo16(k1.x); kf[9] = hi16(k1.x); kf[10] = lo16(k1.y); kf[11] = hi16(k1.y); kf[12] = lo16(k1.z); kf[13] = hi16(k1.z); kf[14] = lo16(k1.w); kf[15] = hi16(k1.w);
    float kr[16], ss = 0.f;
#pragma unroll
    for (int i = 0; i < 16; ++i) { kr[i] = kf[i] * k_k[col + i]; ss += kr[i] * kr[i]; }
    ss += __shfl_xor(ss, 16);
    ss += __shfl_xor(ss, 32);
    const float rn = rsqrtf(ss + 1e-12f);
    f32x4 okd[4], okka[4], okk[4];
#pragma unroll
    for (int j = 0; j < 4; ++j)
#pragma unroll
      for (int r = 0; r < 4; ++r) {
        const int i = 4 * j + r;
        const float a = sigmoidf_(a0[col + i] + v[j][r]);
        const float kk = kr[i] * rn;
        okd[j][r] = kf[i] * (1.f + (a - 1.f) * k_a[col + i]);
        okka[j][r] = kk * a;
        okk[j][r] = kk;
      }
    store16_bf16(KD + (size_t)row * 512 + col, okd, 1.f);
    store16_bf16(KKA + (size_t)row * 512 + col, okka, 1.f);
    if (writekk) store16_bf16(KK + (size_t)row * 512 + col, okk, 1.f);
  }
};
struct EpiDftc {
  bf16_t* CST; int g;
  DEV void operator()(int row, int col, const f32x4 (&v)[4]) const {
    const int b = col >> 12, s = col & 4095;
    store16_bf16(CST + ((size_t)(b * 1024 + g * 128 + (row & 127)) * 8192 + (row >> 7) * 4096 + s), v, 1.f);
  }
};

DEV void transpose_convert(char* lds, const float* __restrict__ W, int K, int N, bf16_t* __restrict__ Wt, int ldt, int rot) {
  float* tile = (float*)lds;
  const int tn_n = N >> 6, nt = (K >> 6) * tn_n, tid = threadIdx.x;
  for (int t = (blockIdx.x + rot) % gridDim.x; t < nt; t += gridDim.x) {
    const int tk = t / tn_n, tn = t % tn_n;
    for (int i = tid; i < 4096; i += NTHR) {
      const int r = i >> 6, cc = i & 63;
      tile[r * 65 + cc] = W[(size_t)(tk * 64 + r) * N + tn * 64 + cc];
    }
    __syncthreads();
    for (int i = tid; i < 4096; i += NTHR) {
      const int n = i >> 6, k = i & 63;
      Wt[(size_t)(tn * 64 + n) * ldt + tk * 64 + k] = f2bf(tile[k * 65 + n]);
    }
    __syncthreads();
  }
}

DEV void compute_mod(char* lds, const P& p) {
  float* cs = (float*)lds;
  float* red = (float*)(lds + 32768);
  const int tid = threadIdx.x;
  float* mod = (float*)(p.ws + W_MOD);
  bool have = false;
  for (int item = blockIdx.x; item < 192; item += gridDim.x) {
    if (!have) {
      for (int i = tid; i < 8192; i += NTHR) { const float cv = p.c[i]; cs[i] = cv / (1.f + expf(-cv)); }
      __syncthreads();
      have = true;
    }
    const int l = item / 96, cb = item % 96, col = cb * 64 + (tid & 63), kg = tid >> 6;
    float a0 = 0, a1 = 0, a2 = 0, a3 = 0, a4 = 0, a5 = 0, a6 = 0, a7 = 0;
    const float* wp = p.ada_w + ((size_t)l * 1024 + kg * 128) * 6144 + col;
    for (int k = 0; k < 128; ++k) {
      const float wv = wp[(size_t)k * 6144];
      const int kk = kg * 128 + k;
      a0 += cs[kk] * wv; a1 += cs[1024 + kk] * wv; a2 += cs[2048 + kk] * wv; a3 += cs[3072 + kk] * wv;
      a4 += cs[4096 + kk] * wv; a5 += cs[5120 + kk] * wv; a6 += cs[6144 + kk] * wv; a7 += cs[7168 + kk] * wv;
    }
    float* rp = red + kg * 512 + (tid & 63);
    rp[0] = a0; rp[64] = a1; rp[128] = a2; rp[192] = a3; rp[256] = a4; rp[320] = a5; rp[384] = a6; rp[448] = a7;
    __syncthreads();
    {
      const int b = tid >> 6, cc = tid & 63;
      float s = 0.f;
#pragma unroll
      for (int g = 0; g < 8; ++g) s += red[g * 512 + b * 64 + cc];
      mod[(size_t)(l * 8 + b) * 6144 + cb * 64 + cc] = s + p.ada_b[l * 6144 + cb * 64 + cc];
    }
    __syncthreads();
  }
}

template <bool HAS_Y, bool HAS_H>
DEV void rowpass(const float* __restrict__ xin, const float* __restrict__ yf, const float* __restrict__ gy, const float* __restrict__ gate,
                 float* __restrict__ xout, const float* __restrict__ gh, const float* __restrict__ sc, const float* __restrict__ sh,
                 bf16_t* __restrict__ h) {
  const int lane = threadIdx.x & 63, gw = blockIdx.x * 8 + (threadIdx.x >> 6), nw = gridDim.x * 8;
  for (int row = gw; row < MT; row += nw) {
    const int b = row >> 12;
    f32x4 xv[4];
#pragma unroll
    for (int i = 0; i < 4; ++i) xv[i] = *(const f32x4*)(xin + (size_t)row * 1024 + i * 256 + lane * 4);
    if (HAS_Y) {
      f32x4 yv[4];
      float ss = 0.f;
#pragma unroll
      for (int i = 0; i < 4; ++i) {
        yv[i] = *(const f32x4*)(yf + (size_t)row * 1024 + i * 256 + lane * 4);
        ss += yv[i][0] * yv[i][0] + yv[i][1] * yv[i][1] + yv[i][2] * yv[i][2] + yv[i][3] * yv[i][3];
      }
      ss = wave_sum(ss);
      const float rs = rsqrtf(ss * (1.f / 1024.f) + 1e-6f);
#pragma unroll
      for (int i = 0; i < 4; ++i) {
        const int col = i * 256 + lane * 4;
        const f32x4 g4 = *(const f32x4*)(gy + col), gt = *(const f32x4*)(gate + (size_t)b * 6144 + col);
        xv[i] = xv[i] + gt * (yv[i] * rs * g4);
        *(f32x4*)(xout + (size_t)row * 1024 + col) = xv[i];
      }
    }
    if (HAS_H) {
      float ss = 0.f;
#pragma unroll
      for (int i = 0; i < 4; ++i) ss += xv[i][0] * xv[i][0] + xv[i][1] * xv[i][1] + xv[i][2] * xv[i][2] + xv[i][3] * xv[i][3];
      ss = wave_sum(ss);
      const float rs = rsqrtf(ss * (1.f / 1024.f) + 1e-6f);
#pragma unroll
      for (int i = 0; i < 4; ++i) {
        const int col = i * 256 + lane * 4;
        const f32x4 g4 = *(const f32x4*)(gh + col), s4 = *(const f32x4*)(sc + (size_t)b * 6144 + col), h4 = *(const f32x4*)(sh + (size_t)b * 6144 + col);
        const f32x4 o = (xv[i] * rs * g4) * (s4 + 1.f) + h4;
        u32x2 pk;
        pk.x = pk2(o[0], o[1]); pk.y = pk2(o[2], o[3]);
        *(u32x2*)(h + (size_t)row * 1024 + col) = pk;
      }
    }
  }
}

DEV void unpack8(const u32x4 u, float (&f)[8]) {
  f[0] = lo16(u.x); f[1] = hi16(u.x); f[2] = lo16(u.y); f[3] = hi16(u.y); f[4] = lo16(u.z); f[5] = hi16(u.z); f[6] = lo16(u.w); f[7] = hi16(u.w);
}
DEV u32x4 pack8(const float (&f)[8]) {
  u32x4 u;
  u.x = pk2(f[0], f[1]); u.y = pk2(f[2], f[3]); u.z = pk2(f[4], f[5]); u.w = pk2(f[6], f[7]);
  return u;
}

DEV void prep1(const P& p) {
  const bf16_t* z = (const bf16_t*)(p.ws + O_Z);
  bf16_t* za = (bf16_t*)p.out;
  bf16_t* qr = (bf16_t*)(p.ws + O_QR);
  bf16_t* kr = (bf16_t*)(p.ws + O_KR);
  bf16_t* vt = (bf16_t*)(p.ws + O_VT);
  const float* rope = (const float*)(p.ws + W_ROPE);
  const int gt = blockIdx.x * NTHR + threadIdx.x, ngt = gridDim.x * NTHR;
  for (int idx = gt; idx < MT * 256; idx += ngt) {
    const int tok = idx >> 8, c8 = (idx & 255) * 8, s = tok & 4095;
    const bf16_t* zp = z + (size_t)tok * INC + c8;
    float zc[8], zm[8], zn[8], o[8];
    unpack8(*(const u32x4*)zp, zc);
    if (s > 0) unpack8(*(const u32x4*)(zp - INC), zm); else { for (int i = 0; i < 8; ++i) zm[i] = 0.f; }
    if (s < 4095) unpack8(*(const u32x4*)(zp + INC), zn); else { for (int i = 0; i < 8; ++i) zn[i] = 0.f; }
#pragma unroll
    for (int i = 0; i < 8; ++i) o[i] = zm[i] * p.mix_conv[c8 + i] + zc[i] * p.mix_conv[2048 + c8 + i] + zn[i] * p.mix_conv[4096 + c8 + i];
    *(u32x4*)(za + (size_t)tok * 2048 + c8) = pack8(o);
  }
  for (int idx = gt; idx < MT * 64; idx += ngt) {
    const int e8 = idx & 3, which = (idx >> 2) & 1, h = (idx >> 3) & 7, tok = idx >> 6, s = tok & 4095;
    const bf16_t* src = z + (size_t)tok * INC + 2048 + which * 512 + h * 64 + e8 * 8;
    float x1[8], x2[8], o1[8], o2[8];
    unpack8(*(const u32x4*)src, x1);
    unpack8(*(const u32x4*)(src + 32), x2);
    const float* rp = rope + ((size_t)s * 32 + e8 * 8) * 2;
    const float scl = which ? 1.f : 0.125f;
#pragma unroll
    for (int i = 0; i < 8; ++i) {
      const float cv = rp[2 * i], sv = rp[2 * i + 1];
      o1[i] = (x1[i] * cv - x2[i] * sv) * scl;
      o2[i] = (x2[i] * cv + x1[i] * sv) * scl;
    }
    bf16_t* dst = (which ? kr : qr) + (size_t)tok * 512 + h * 64 + e8 * 8;
    *(u32x4*)dst = pack8(o1);
    *(u32x4*)(dst + 32) = pack8(o2);
  }
  {
    const int lane = threadIdx.x & 63, gw = blockIdx.x * 8 + (threadIdx.x >> 6), nw = gridDim.x * 8;
    for (int item = gw; item < 3 * 4096; item += nw) {
      const int br = item >> 12, rem = item & 4095, b = rem >> 9, h = (rem >> 6) & 7, nb = rem & 63;
      const int dsh = 2 * br;
      const int Mr = 4096 >> dsh;
      const int pp = nb * 64 + lane, rsd = pp / Mr, m = pp % Mr, s = (m << dsh) + rsd;
      const bf16_t* src = z + (size_t)(b * 4096 + s) * INC + 3072 + h * 64;
      bf16_t* dst = vt + ((size_t)((br * 8 + b) * 8 + h) * 64) * 4096 + pp;
#pragma unroll
      for (int c = 0; c < 8; ++c) {
        const u32x4 u = *(const u32x4*)(src + c * 8);
        dst[(size_t)(c * 8 + 0) * 4096] = (bf16_t)(u.x & 0xffff); dst[(size_t)(c * 8 + 1) * 4096] = (bf16_t)(u.x >> 16);
        dst[(size_t)(c * 8 + 2) * 4096] = (bf16_t)(u.y & 0xffff); dst[(size_t)(c * 8 + 3) * 4096] = (bf16_t)(u.y >> 16);
        dst[(size_t)(c * 8 + 4) * 4096] = (bf16_t)(u.z & 0xffff); dst[(size_t)(c * 8 + 5) * 4096] = (bf16_t)(u.z >> 16);
        dst[(size_t)(c * 8 + 6) * 4096] = (bf16_t)(u.w & 0xffff); dst[(size_t)(c * 8 + 7) * 4096] = (bf16_t)(u.w >> 16);
      }
    }
  }
}

DEV void attention(const P& p) {
  const bf16_t* qr = (const bf16_t*)(p.ws + O_QR);
  const bf16_t* kr = (const bf16_t*)(p.ws + O_KR);
  const bf16_t* vt = (const bf16_t*)(p.ws + O_VT);
  float* num = (float*)(p.ws + O_NUM);
  float* md = (float*)(p.ws + O_MD);
  const int lane = threadIdx.x & 63, lr = lane & 15, lq = lane >> 4;
  const int gw = blockIdx.x * 8 + (threadIdx.x >> 6), nw = gridDim.x * 8;
  for (int item = gw; item < 3 * 4096 * 4; item += nw) {
    const int mt = item & 3, nb = (item >> 2) & 63, h = (item >> 8) & 7, b = (item >> 11) & 7, br = item >> 14;
    const int dsh = 2 * br, Mr = 4096 >> dsh;
    const int seg = (nb * 64) / Mr, segstart = seg * Mr, segend = segstart + Mr;
    const bool pv_ok = (nb * 64 - 64 >= segstart), nx_ok = (nb * 64 + 128 <= segend);
    const int qp = nb * 64 + mt * 16 + lr;
    const int qtok = b * 4096 + (((qp - segstart) << dsh) + seg);
    bf16x8 qf[2];
    qf[0] = *(const bf16x8*)(qr + (size_t)qtok * 512 + h * 64 + lq * 8);
    qf[1] = *(const bf16x8*)(qr + (size_t)qtok * 512 + h * 64 + 32 + lq * 8);
    f32x4 sacc[12];
#pragma unroll
    for (int kt = 0; kt < 12; ++kt) {
      const int kb = kt >> 2;
      int blk = nb + kb - 1;
      if ((kb == 0 && !pv_ok) || (kb == 2 && !nx_ok)) blk = nb;
      const int kp = blk * 64 + (kt & 3) * 16 + lr;
      const int ktok = b * 4096 + (((kp - segstart) << dsh) + seg);
      const bf16x8 k0 = *(const bf16x8*)(kr + (size_t)ktok * 512 + h * 64 + lq * 8);
      const bf16x8 k1 = *(const bf16x8*)(kr + (size_t)ktok * 512 + h * 64 + 32 + lq * 8);
      f32x4 a = (f32x4){0.f, 0.f, 0.f, 0.f};
      a = __builtin_amdgcn_mfma_f32_16x16x32_bf16(k0, qf[0], a, 0, 0, 0);
      a = __builtin_amdgcn_mfma_f32_16x16x32_bf16(k1, qf[1], a, 0, 0, 0);
      sacc[kt] = a;
    }
    const int qi = mt * 16 + lr;
    float mx = -1e30f;
#pragma unroll
    for (int kt = 0; kt < 12; ++kt) {
      const int kb = kt >> 2;
#pragma unroll
      for (int r = 0; r < 4; ++r) {
        const int kj = (kt & 3) * 16 + lq * 4 + r;
        bool ok = true;
        if (kb == 0) ok = pv_ok && (kj >= qi);
        if (kb == 2) ok = nx_ok && (kj <= qi);
        const float sv = ok ? sacc[kt][r] : -1e30f;
        sacc[kt][r] = sv;
        mx = fmaxf(mx, sv);
      }
    }
    mx = fmaxf(mx, __shfl_xor(mx, 16));
    mx = fmaxf(mx, __shfl_xor(mx, 32));
    float den = 0.f;
#pragma unroll
    for (int kt = 0; kt < 12; ++kt)
#pragma unroll
      for (int r = 0; r < 4; ++r) {
        const float pe = __expf(sacc[kt][r] - mx);
        sacc[kt][r] = pe;
        den += pe;
      }
    den += __shfl_xor(den, 16);
    den += __shfl_xor(den, 32);
    f32x4 oacc[4];
#pragma unroll
    for (int et = 0; et < 4; ++et) oacc[et] = (f32x4){0.f, 0.f, 0.f, 0.f};
    const bf16_t* vbase = vt + ((size_t)((br * 8 + b) * 8 + h) * 64) * 4096;
#pragma unroll
    for (int t = 0; t < 6; ++t) {
      const int kb = t >> 1;
      int blk = nb + kb - 1;
      if ((kb == 0 && !pv_ok) || (kb == 2 && !nx_ok)) blk = nb;
      const int kp0 = blk * 64 + ((2 * t) & 3) * 16 + lq * 4;
      const int kp1 = blk * 64 + ((2 * t + 1) & 3) * 16 + lq * 4;
      u32x4 pu;
      pu.x = pk2(sacc[2 * t][0], sacc[2 * t][1]); pu.y = pk2(sacc[2 * t][2], sacc[2 * t][3]);
      pu.z = pk2(sacc[2 * t + 1][0], sacc[2 * t + 1][1]); pu.w = pk2(sacc[2 * t + 1][2], sacc[2 * t + 1][3]);
      const bf16x8 pf = __builtin_bit_cast(bf16x8, pu);
#pragma unroll
      for (int et = 0; et < 4; ++et) {
        const bf16_t* vrow = vbase + (size_t)(et * 16 + lr) * 4096;
        const u32x2 v0 = *(const u32x2*)(vrow + kp0), v1 = *(const u32x2*)(vrow + kp1);
        u32x4 vu;
        vu.x = v0.x; vu.y = v0.y; vu.z = v1.x; vu.w = v1.y;
        oacc[et] = __builtin_amdgcn_mfma_f32_16x16x32_bf16(__builtin_bit_cast(bf16x8, vu), pf, oacc[et], 0, 0, 0);
      }
    }
    float* np = num + ((size_t)br * MT + qtok) * 512 + h * 64 + lq * 4;
#pragma unroll
    for (int et = 0; et < 4; ++et) *(f32x4*)(np + et * 16) = oacc[et];
    if (lq == 0) {
      f32x2 o;
      o.x = mx; o.y = den;
      *(f32x2*)(md + (((size_t)br * MT + qtok) * 8 + h) * 2) = o;
    }
  }
}

DEV void combineA(const P& p) {
  const float* num = (const float*)(p.ws + O_NUM);
  const float* md = (const float*)(p.ws + O_MD);
  bf16_t* ycat = (bf16_t*)(p.ws + O_YCAT);
  const int gt = blockIdx.x * NTHR + threadIdx.x, ngt = gridDim.x * NTHR;
  for (int idx = gt; idx < MT * 128; idx += ngt) {
    const int e4 = idx & 15, h = (idx >> 4) & 7, tok = idx >> 7;
    f32x2 m0 = *(const f32x2*)(md + (((size_t)0 * MT + tok) * 8 + h) * 2);
    f32x2 m1 = *(const f32x2*)(md + (((size_t)1 * MT + tok) * 8 + h) * 2);
    f32x2 m2 = *(const f32x2*)(md + (((size_t)2 * MT + tok) * 8 + h) * 2);
    const float ma = fmaxf(m0.x, fmaxf(m1.x, m2.x));
    const float e0 = __expf(m0.x - ma), e1 = __expf(m1.x - ma), e2 = __expf(m2.x - ma);
    const float dn = e0 * m0.y + e1 * m1.y + e2 * m2.y;
    const f32x4 n0 = *(const f32x4*)(num + ((size_t)0 * MT + tok) * 512 + h * 64 + e4 * 4);
    const f32x4 n1 = *(const f32x4*)(num + ((size_t)1 * MT + tok) * 512 + h * 64 + e4 * 4);
    const f32x4 n2 = *(const f32x4*)(num + ((size_t)2 * MT + tok) * 512 + h * 64 + e4 * 4);
    const f32x4 o = (n0 * e0 + n1 * e1 + n2 * e2) * (1.f / dn);
    u32x2 pk;
    pk.x = pk2(o[0], o[1]); pk.y = pk2(o[2], o[3]);
    *(u32x2*)(ycat + (size_t)tok * 1024 + 512 + h * 64 + e4 * 4) = pk;
  }
}

DEV float dpp_allreduce16(float x) {
  x += __int_as_float(__builtin_amdgcn_update_dpp(0, __float_as_int(x), 0xB1, 0xF, 0xF, true));
  x += __int_as_float(__builtin_amdgcn_update_dpp(0, __float_as_int(x), 0x4E, 0xF, 0xF, true));
  x += __int_as_float(__builtin_amdgcn_update_dpp(0, __float_as_int(x), 0x141, 0xF, 0xF, true));
  x += __int_as_float(__builtin_amdgcn_update_dpp(0, __float_as_int(x), 0x140, 0xF, 0xF, true));
  return x;
}

DEV void scan_phase(char* lds, const P& p) {
  const bf16_t* omw = (const bf16_t*)(p.ws + O_OMW);
  const bf16_t* kd = (const bf16_t*)(p.ws + O_KD);
  const bf16_t* kka = (const bf16_t*)(p.ws + O_KKA);
  const bf16_t* kk = (const bf16_t*)(p.ws + O_KK);
  const bf16_t* za = (const bf16_t*)p.out;
  float* Y = (float*)(p.ws + O_Y);
  float* inb = (float*)lds;
  float* ybuf = (float*)(lds + 98304);
  const int tid = threadIdx.x, w = tid >> 6, lane = tid & 63, rg = lane >> 4, jl = lane & 15, j0 = jl * 4;
  for (int it = blockIdx.x; it < 256; it += gridDim.x) {
    const int sc = it >> 1, half = it & 1, d = sc >> 6, b = (sc >> 3) & 7, h = sc & 7;
    const int rowl = w * 4 + rg, row = half * 32 + rowl;
    const bf16_t* src[3];
    int dsto[3], stepi[3], isw[3];
#pragma unroll
    for (int q = 0; q < 3; ++q) {
      const int pid = tid + q * NTHR, i = pid / 48, rem = pid % 48, arr = rem >> 3, pc = rem & 7;
      const bf16_t* base;
      size_t ld;
      if (arr == 0) { base = omw + (size_t)d * MT * 512 + h * 64; ld = 512; }
      else if (arr == 1) { base = kd + (size_t)d * MT * 512 + h * 64; ld = 512; }
      else if (arr == 2) { base = kka + (size_t)d * MT * 512 + h * 64; ld = 512; }
      else if (arr == 3) { base = kk + h * 64; ld = 512; }
      else if (arr == 4) { base = za + h * 64; ld = 2048; }
      else { base = za + 1024 + h * 64; ld = 2048; }
      const int t0 = d ? (4095 - i) : i;
      src[q] = base + ((size_t)(b * 4096 + t0)) * ld + pc * 8;
      stepi[q] = (int)ld * 32 * (d ? -1 : 1);
      dsto[q] = i * 384 + arr * 64 + pc * 8;
      isw[q] = (arr == 0);
    }
    float s0 = 0.f, s1 = 0.f, s2 = 0.f, s3 = 0.f;
    u32x4 rg_[3];
#pragma unroll
    for (int q = 0; q < 3; ++q) rg_[q] = *(const u32x4*)(src[q]);
#pragma unroll
    for (int q = 0; q < 3; ++q) {
      float f[8];
      unpack8(rg_[q], f);
      if (isw[q]) { for (int i = 0; i < 8; ++i) f[i] = 1.f - f[i]; }
      *(f32x4*)(inb + dsto[q]) = (f32x4){f[0], f[1], f[2], f[3]};
      *(f32x4*)(inb + dsto[q] + 4) = (f32x4){f[4], f[5], f[6], f[7]};
    }
    __syncthreads();
    for (int c = 0; c < 128; ++c) {
      const float* cur = inb + (c & 1) * 12288;
      float* yb = ybuf + (c & 1) * 1024;
      if (c + 1 < 128) {
#pragma unroll
        for (int q = 0; q < 3; ++q) rg_[q] = *(const u32x4*)(src[q] + (ptrdiff_t)stepi[q] * (c + 1));
      }
#pragma unroll 4
      for (int i = 0; i < 32; ++i) {
        const float* st = cur + i * 384;
        const f32x4 w4 = *(const f32x4*)(st + j0), kd4 = *(const f32x4*)(st + 64 + j0), ka4 = *(const f32x4*)(st + 128 + j0),
                    kk4 = *(const f32x4*)(st + 192 + j0), r4 = *(const f32x4*)(st + 256 + j0);
        const float v = st[320 + row];
        float sk = (s0 * kk4[0] + s1 * kk4[1]) + (s2 * kk4[2] + s3 * kk4[3]);
        sk = dpp_allreduce16(sk);
        s0 = s0 * w4[0] + (v * kd4[0] - sk * ka4[0]);
        s1 = s1 * w4[1] + (v * kd4[1] - sk * ka4[1]);
        s2 = s2 * w4[2] + (v * kd4[2] - sk * ka4[2]);
        s3 = s3 * w4[3] + (v * kd4[3] - sk * ka4[3]);
        float y = (s0 * r4[0] + s1 * r4[1]) + (s2 * r4[2] + s3 * r4[3]);
        y = dpp_allreduce16(y);
        if (jl == 0) yb[i * 32 + rowl] = y;
      }
      if (c + 1 < 128) {
        float* nb_ = inb + ((c + 1) & 1) * 12288;
#pragma unroll
        for (int q = 0; q < 3; ++q) {
          float f[8];
          unpack8(rg_[q], f);
          if (isw[q]) { for (int i = 0; i < 8; ++i) f[i] = 1.f - f[i]; }
          *(f32x4*)(nb_ + dsto[q]) = (f32x4){f[0], f[1], f[2], f[3]};
          *(f32x4*)(nb_ + dsto[q] + 4) = (f32x4){f[4], f[5], f[6], f[7]};
        }
      }
      __syncthreads();
      {
        const int idx = tid * 2, i = idx >> 5, rl = idx & 31;
        const int t = d ? (4095 - (c * 32 + i)) : (c * 32 + i);
        const f32x2 o = *(const f32x2*)(yb + idx);
        *(f32x2*)(Y + ((size_t)d * MT + b * 4096 + t) * 512 + h * 64 + half * 32 + rl) = o;
      }
    }
    __syncthreads();
  }
}

DEV void postB(const P& p) {
  const float* Y = (const float*)(p.ws + O_Y);
  const bf16_t* kd = (const bf16_t*)(p.ws + O_KD);
  const bf16_t* gg = (const bf16_t*)(p.ws + O_G);
  const bf16_t* za = (const bf16_t*)p.out;
  bf16_t* ycat = (bf16_t*)(p.ws + O_YCAT);
  const int lane = threadIdx.x & 63, gw = blockIdx.x * 8 + (threadIdx.x >> 6), nw = gridDim.x * 8;
  for (int item = gw; item < MT * 8; item += nw) {
    const int tok = item >> 3, h = item & 7, c = h * 64 + lane;
    const float y = Y[(size_t)tok * 512 + c] + Y[((size_t)MT + tok) * 512 + c];
    const float mu = wave_sum(y) * (1.f / 64.f);
    const float dv = y - mu;
    const float var = wave_sum(dv * dv) * (1.f / 64.f);
    const float yn = dv * rsqrtf(var + 64e-5f) * p.lnx_w[c] + p.lnx_b[c];
    const float r = bf2f(za[(size_t)tok * 2048 + c]), v = bf2f(za[(size_t)tok * 2048 + 1024 + c]);
    const float kds = bf2f(kd[(size_t)tok * 512 + c]) + bf2f(kd[((size_t)MT + tok) * 512 + c]);
    const float bon = wave_sum(r * kds * p.r_k[c]) * v;
    const float o = (yn + bon) * bf2f(gg[(size_t)tok * 512 + c]);
    ycat[(size_t)tok * 1024 + c] = f2bf(o);
  }
}

DEV void glu_pass(const P& p, int l) {
  const bf16_t* zf = (const bf16_t*)(p.ws + O_ZF);
  bf16_t* act = (bf16_t*)(p.ws + O_ACT);
  const float* cw = p.ffn_conv + (size_t)l * 3 * 5632;
  const int gt = blockIdx.x * NTHR + threadIdx.x, ngt = gridDim.x * NTHR;
  for (int idx = gt; idx < 16384 * 352; idx += ngt) {
    const int row = idx / 352, c8 = (idx % 352) * 8, s = row & 4095;
    const bf16_t* zp = zf + (size_t)row * 5632 + c8;
    float gc[8], gm[8], gn[8], vc[8], vm[8], vn[8], o[8];
    unpack8(*(const u32x4*)zp, gc);
    unpack8(*(const u32x4*)(zp + 2816), vc);
    if (s > 0) { unpack8(*(const u32x4*)(zp - 5632), gm); unpack8(*(const u32x4*)(zp - 5632 + 2816), vm); }
    else { for (int i = 0; i < 8; ++i) { gm[i] = 0.f; vm[i] = 0.f; } }
    if (s < 4095) { unpack8(*(const u32x4*)(zp + 5632), gn); unpack8(*(const u32x4*)(zp + 5632 + 2816), vn); }
    else { for (int i = 0; i < 8; ++i) { gn[i] = 0.f; vn[i] = 0.f; } }
#pragma unroll
    for (int i = 0; i < 8; ++i) {
      const float g = gm[i] * cw[c8 + i] + gc[i] * cw[5632 + c8 + i] + gn[i] * cw[11264 + c8 + i];
      const float vv = vm[i] * cw[2816 + c8 + i] + vc[i] * cw[5632 + 2816 + c8 + i] + vn[i] * cw[11264 + 2816 + c8 + i];
      const float u = 0.7978845608028654f * (g + 0.044715f * g * g * g);
      const float ge = 0.5f * g * (1.f + tanhf(u));
      o[i] = ge * vv;
    }
    *(u32x4*)(act + (size_t)row * 2816 + c8) = pack8(o);
  }
}

template <class Epi>
DEV void gemm_grid(char* lds, const bf16_t* A, int lda, const bf16_t* Bt, int ldb, int K, int tilesM, int tilesN, const Epi& epi) {
  const int nt = tilesM * tilesN;
  for (int t = blockIdx.x; t < nt; t += gridDim.x) {
    const int tm = t / tilesN, tn = t % tilesN;
    gemm_tile(lds, A + (size_t)tm * 256 * lda, lda, Bt + (size_t)tn * 128 * ldb, ldb, K, tm * 256, tn * 128, epi);
  }
}

DEV void ffn(char* lds, cg::grid_group& grid, const P& p, int l) {
  const bf16_t* h = (const bf16_t*)(p.ws + O_H);
  bf16_t* zf = (bf16_t*)(p.ws + O_ZF);
  bf16_t* act = (bf16_t*)(p.ws + O_ACT);
  float* yf = (float*)(p.ws + O_YF);
  const bf16_t* upt = (const bf16_t*)(p.ws + W_UP) + (size_t)l * 5632 * 1024;
  const bf16_t* dnt = (const bf16_t*)(p.ws + W_DOWN) + (size_t)l * 1024 * 2816;
  for (int half = 0; half < 2; ++half) {
    gemm_grid(lds, h + (size_t)half * 16384 * 1024, 1024, upt, 1024, 1024, 64, 44, EpiBf16{zf, 5632});
    grid.sync();
    glu_pass(p, l);
    grid.sync();
    gemm_grid(lds, act, 2816, dnt, 2816, 2816, 64, 8, EpiF32{yf + (size_t)half * 16384 * 1024, 1024});
  }
  grid.sync();
}

__global__ void __launch_bounds__(NTHR) mega(P p) {
  extern __shared__ __attribute__((aligned(16))) char lds[];
  cg::grid_group grid = cg::this_grid();
  char* ws = p.ws;
  float* mod = (float*)(ws + W_MOD);
  const int gt = blockIdx.x * NTHR + threadIdx.x, ngt = gridDim.x * NTHR;

  compute_mod(lds, p);
  transpose_convert(lds, p.mix_in, 1024, 3584, (bf16_t*)(ws + W_MIXIN), 1024, 0);
  for (int l = 0; l < 2; ++l) {
    transpose_convert(lds, p.ffn_up + (size_t)l * 1024 * 5632, 1024, 5632, (bf16_t*)(ws + W_UP) + (size_t)l * 5632 * 1024, 1024, 64 * l);
    transpose_convert(lds, p.ffn_down + (size_t)l * 2816 * 1024, 2816, 1024, (bf16_t*)(ws + W_DOWN) + (size_t)l * 1024 * 2816, 2816, 128 + 64 * l);
  }
  transpose_convert(lds, p.mix_out, 1024, 1024, (bf16_t*)(ws + W_MIXOUT), 1024, 32);
  transpose_convert(lds, p.fnet_w, 1024, 1024, (bf16_t*)(ws + W_FNET), 1024, 96);
  for (int d = 0; d < 2; ++d) {
    transpose_convert(lds, p.w1 + (size_t)d * 512 * 64, 512, 64, (bf16_t*)(ws + W_L1) + (size_t)(d * 64) * 512, 512, 8 * d);
    transpose_convert(lds, p.a1 + (size_t)d * 512 * 64, 512, 64, (bf16_t*)(ws + W_L1) + (size_t)(128 + d * 64) * 512, 512, 16 + 8 * d);
    transpose_convert(lds, p.w2 + (size_t)d * 64 * 512, 64, 512, (bf16_t*)(ws + W_W2) + (size_t)d * 512 * 64, 64, 48 + 8 * d);
    transpose_convert(lds, p.a2 + (size_t)d * 64 * 512, 64, 512, (bf16_t*)(ws + W_A2) + (size_t)d * 512 * 64, 64, 64 + 8 * d);
  }
  transpose_convert(lds, p.g1, 512, 128, (bf16_t*)(ws + W_L1) + (size_t)256 * 512, 512, 32);
  transpose_convert(lds, p.g2, 128, 512, (bf16_t*)(ws + W_G2), 128, 80);
  {
    float* rope = (float*)(ws + W_ROPE);
    for (int idx = gt; idx < 4096 * 32; idx += ngt) {
      const int s = idx >> 5, e = idx & 31;
      const float inv = powf(10000.f, -(float)e / 32.f);
      const float ang = (float)s * inv;
      float sv, cv;
      sincosf(ang, &sv, &cv);
      rope[2 * idx] = cv;
      rope[2 * idx + 1] = sv;
    }
    bf16_t* dftc = (bf16_t*)(ws + W_DFTC);
    for (int idx = gt; idx < 256 * 128; idx += ngt) {
      const int n = idx >> 7, c = idx & 127, k2 = n & 127;
      const float ph = (float)((k2 * c) & 127) * (1.f / 64.f);
      const float v = (n < 128) ? cospif(ph) : sinpif(ph);
      dftc[idx] = f2bf(v * 0.08838834764831845f);
    }
  }
  grid.sync();
  rowpass<false, true>(p.x, nullptr, nullptr, nullptr, nullptr, p.norm_g, mod + 1024, mod, (bf16_t*)(ws + O_H0));
  grid.sync();
  gemm_grid(lds, (const bf16_t*)(ws + O_H0), 1024, (const bf16_t*)(ws + W_MIXIN), 1024, 1024, 128, 28, EpiBf16{(bf16_t*)(ws + O_Z), INC});
  grid.sync();
  prep1(p);
  grid.sync();
  attention(p);
  grid.sync();
  combineA(p);
  gemm_grid(lds, (const bf16_t*)p.out + 1536, 2048, (const bf16_t*)(ws + W_L1), 512, 512, 128, 3, EpiLora1{(bf16_t*)(ws + O_L1)});
  grid.sync();
  for (int d = 0; d < 2; ++d) {
    gemm_grid(lds, (const bf16_t*)(ws + O_L1) + d * 64, 384, (const bf16_t*)(ws + W_W2) + (size_t)d * 512 * 64, 64, 64, 128, 4,
              EpiDecay{(bf16_t*)(ws + O_OMW) + (size_t)d * MT * 512, p.w0 + d * 512});
    gemm_grid(lds, (const bf16_t*)(ws + O_L1) + 128 + d * 64, 384, (const bf16_t*)(ws + W_A2) + (size_t)d * 512 * 64, 64, 64, 128, 4,
              EpiA{(bf16_t*)(ws + O_KD) + (size_t)d * MT * 512, (bf16_t*)(ws + O_KKA) + (size_t)d * MT * 512, (bf16_t*)(ws + O_KK), p.a0 + d * 512,
                   p.k_k, p.k_a, (const bf16_t*)p.out, d == 0});
  }
  gemm_grid(lds, (const bf16_t*)(ws + O_L1) + 256, 384, (const bf16_t*)(ws + W_G2), 128, 128, 128, 4, EpiBf16{(bf16_t*)(ws + O_G), 512});
  grid.sync();
  scan_phase(lds, p);
  grid.sync();
  postB(p);
  grid.sync();
  gemm_grid(lds, (const bf16_t*)(ws + O_YCAT), 1024, (const bf16_t*)(ws + W_MIXOUT), 1024, 1024, 128, 8, EpiF32{(float*)(ws + O_YF), 1024});
  grid.sync();
  rowpass<true, true>(p.x, (const float*)(ws + O_YF), p.norm_g + 1024, mod + 2048, p.out, p.norm_g + 2048, mod + 4096, mod + 3072, (bf16_t*)(ws + O_H));
  grid.sync();
  ffn(lds, grid, p, 0);
  {
    const float* mod1 = mod + 8 * 6144;
    rowpass<true, true>(p.out, (const float*)(ws + O_YF), p.norm_g + 3072, mod + 5120, p.out, p.norm_g + 4096, mod1 + 1024, mod1, (bf16_t*)(ws + O_H));
    bf16_t* cs = (bf16_t*)(ws + O_COSSIN);
    for (int idx = gt; idx < 4096 * 1024; idx += ngt) {
      const int k1 = idx >> 10, k8 = (idx & 1023) * 8;
      float o[8];
#pragma unroll
      for (int i = 0; i < 8; ++i) {
        const int kk = k8 + i, s = kk & 4095;
        const float ph = (float)((k1 * s) & 4095) * (1.f / 2048.f);
        o[i] = ((kk < 4096) ? cospif(ph) : -sinpif(ph)) * (1.f / 64.f);
      }
      *(u32x4*)(cs + (size_t)k1 * 8192 + k8) = pack8(o);
    }
    grid.sync();
    for (int t = blockIdx.x; t < 8 * 256; t += gridDim.x) {
      const int g = t >> 8, tn = t & 255;
      gemm_tile(lds, (const bf16_t*)(ws + W_DFTC), 128, (const bf16_t*)(ws + O_H) + (size_t)tn * 128 * 1024 + g * 128, 1024, 128, 0, tn * 128,
                EpiDftc{(bf16_t*)(ws + O_CST), g});
    }
    grid.sync();
    for (int t = blockIdx.x; t < 8 * 128; t += gridDim.x) {
      const int b = t >> 7, r = t & 127, tm = r >> 3, tn = r & 7;
      gemm_tile(lds, (const bf16_t*)(ws + O_COSSIN) + (size_t)tm * 256 * 8192, 8192, (const bf16_t*)(ws + O_CST) + ((size_t)b * 1024 + tn * 128) * 8192, 8192,
                8192, b * 4096 + tm * 256, tn * 128, EpiBf16{(bf16_t*)(ws + O_F), 1024});
    }
    grid.sync();
    gemm_grid(lds, (const bf16_t*)(ws + O_F), 1024, (const bf16_t*)(ws + W_FNET), 1024, 1024, 128, 8, EpiF32{(float*)(ws + O_YF), 1024});
    grid.sync();
    rowpass<true, true>(p.out, (const float*)(ws + O_YF), p.norm_g + 4096 + 1024, mod1 + 2048, p.out, p.norm_g + 4096 + 2048, mod1 + 4096, mod1 + 3072,
                        (bf16_t*)(ws + O_H));
    grid.sync();
    ffn(lds, grid, p, 1);
    rowpass<true, false>(p.out, (const float*)(ws + O_YF), p.norm_g + 4096 + 3072, mod1 + 5120, p.out, nullptr, nullptr, nullptr, nullptr);
  }
}

extern "C" void kernel_launch(void* const* d_in, const int* in_sizes, int n_in, void* d_out, int out_size, void* d_ws, size_t ws_size,
                              hipStream_t stream) {
  static int grid_blocks = 0;
  if (!grid_blocks) {
    int dev = 0, cus = 0, per_cu = 0;
    hipGetDevice(&dev);
    hipDeviceGetAttribute(&cus, hipDeviceAttributeMultiprocessorCount, dev);
    hipFuncSetAttribute((const void*)mega, hipFuncAttributeMaxDynamicSharedMemorySize, LDS_BYTES);
    hipOccupancyMaxActiveBlocksPerMultiprocessor(&per_cu, (const void*)mega, NTHR, LDS_BYTES);
    if (per_cu < 1) { fprintf(stderr, "occupancy query returned %d\n", per_cu); per_cu = 1; }
    if (per_cu > 1) per_cu = 1;
    grid_blocks = cus * per_cu;
  }
  P p{};
  const float** pp = (const float**)&p;
  for (int i = 0; i < 25; ++i) pp[i] = (const float*)d_in[i];
  p.out = (float*)d_out;
  p.ws = (char*)d_ws;
  void* args[] = {&p};
  hipError_t e = hipLaunchCooperativeKernel((const void*)mega, dim3(grid_blocks), dim3(NTHR), args, LDS_BYTES, stream);
  if (e != hipSuccess) fprintf(stderr, "cooperative launch failed: %s (grid %d)\n", hipGetErrorString(e), grid_blocks);
}
```

```cpp
#include <hip/hip_runtime.h>
#include <hip/hip_cooperative_groups.h>
#include <stdint.h>
#include <cstdio>
namespace cg = cooperative_groups;

typedef unsigned short bf16_t;
typedef short bf16x8 __attribute__((ext_vector_type(8)));
typedef short s16x4 __attribute__((ext_vector_type(4)));
typedef float f32x4 __attribute__((ext_vector_type(4)));
typedef float f32x2 __attribute__((ext_vector_type(2)));
typedef unsigned u32x4 __attribute__((ext_vector_type(4)));
typedef unsigned u32x2 __attribute__((ext_vector_type(2)));

#define DEV __device__ __forceinline__

constexpr int NB = 8, SEQ = 4096, DM = 1024, MT = NB * SEQ, DFF = 2816, INC = 3584;
constexpr size_t MiB = 1024 * 1024;
constexpr int NTHR = 512;
constexpr int LDS_BYTES = 131072;

constexpr size_t W_MIXIN = 0;
constexpr size_t W_UP = 7 * MiB;
constexpr size_t W_DOWN = 29 * MiB;
constexpr size_t W_MIXOUT = 40 * MiB;
constexpr size_t W_FNET = 42 * MiB;
constexpr size_t W_L1 = 44 * MiB;
constexpr size_t W_W2 = W_L1 + 512 * 1024;
constexpr size_t W_A2 = W_W2 + 128 * 1024;
constexpr size_t W_G2 = W_A2 + 128 * 1024;
constexpr size_t W_DFTC = W_G2 + 128 * 1024;
constexpr size_t W_MOD = 45 * MiB;
constexpr size_t W_ROPE = 46 * MiB;
constexpr size_t R0 = 48 * MiB;
constexpr size_t O_H0 = R0;
constexpr size_t O_Z = 112 * MiB;
constexpr size_t O_QR = 336 * MiB, O_KR = 368 * MiB, O_VT = 400 * MiB;
constexpr size_t O_NUM = R0;
constexpr size_t O_MD = 240 * MiB;
constexpr size_t O_YCAT = 448 * MiB;
constexpr size_t O_OMW = 48 * MiB, O_KD = 112 * MiB, O_KKA = 176 * MiB, O_KK = 240 * MiB, O_G = 272 * MiB, O_L1 = 304 * MiB, O_Y = 304 * MiB;
constexpr size_t O_YF = 48 * MiB;
constexpr size_t O_H = 176 * MiB;
constexpr size_t O_ZF = 240 * MiB;
constexpr size_t O_ACT = 416 * MiB;
constexpr size_t O_COSSIN = 240 * MiB;
constexpr size_t O_CST = 304 * MiB;
constexpr size_t O_F = 432 * MiB;

struct P {
  const float *x, *c, *ada_w, *ada_b, *norm_g, *mix_in, *mix_conv, *w0, *w1, *w2, *a0, *a1, *a2, *g1, *g2, *k_k, *k_a, *r_k, *lnx_w,
      *lnx_b, *mix_out, *fnet_w, *ffn_up, *ffn_conv, *ffn_down;
  float* out;
  char* ws;
};

DEV float bf2f(bf16_t h) { return __uint_as_float(((unsigned)h) << 16); }
DEV bf16_t f2bf(float f) {
  unsigned u = __float_as_uint(f);
  u += 0x7fffu + ((u >> 16) & 1u);
  return (bf16_t)(u >> 16);
}
DEV unsigned pk2(float a, float b) { return (unsigned)f2bf(a) | ((unsigned)f2bf(b) << 16); }
DEV float lo16(unsigned u) { return __uint_as_float(u << 16); }
DEV float hi16(unsigned u) { return __uint_as_float(u & 0xffff0000u); }
DEV float wave_sum(float v) {
#pragma unroll
  for (int o = 32; o; o >>= 1) v += __shfl_xor(v, o);
  return v;
}
DEV float sigmoidf_(float x) { return 1.f / (1.f + __expf(-x)); }

namespace pg8 {
#define PG8_LAS __attribute__((address_space(3)))
typedef unsigned short bf16_t;
typedef short bf16x8 __attribute__((ext_vector_type(8)));
typedef float f32x4 __attribute__((ext_vector_type(4)));
typedef unsigned u32x4 __attribute__((ext_vector_type(4)));
constexpr int BM = 256, BK = 64, HALF = 128, HTB = HALF * BK * 2  , STAGE_BYTES = 8 * HTB, NXCD = 8, WGM = 8;

__host__ __device__ __forceinline__ int lds_byte(int r, int c) { const int st = (r >> 4) * 2 + (c >> 5), rr = r & 15, cc = c & 31, ob = rr * 64 + cc * 2; return st * 1024 + (ob ^ (((ob >> 9) & 1) << 5)); }
__host__ __device__ __forceinline__ void stage_rc(int b, int& R, int& C) { const int st = b / 1024, sb = b % 1024, swz = sb ^ (((sb >> 9) & 1) << 5); R = (st >> 1) * 16 + swz / 64; C = (st & 1) * 32 + (swz % 64) / 2; }
__host__ __device__ __forceinline__ int perm32(int rho) { const int n = rho >> 4, i = rho & 15; return 8 * (i >> 2) + 4 * n + (i & 3); }

struct Unit { int pm, pn; };
struct Gemm { const bf16_t* A; const bf16_t* Bt; int M, N, K; };

struct StaticOrder {
    int nM, nN, nwg, G, c;
    __host__ __device__ void init(int M, int N, int G_, int c_) { nM = M / BM; nN = N / BM; nwg = nM * nN; G = G_; c = c_; }
    __host__ __device__ bool next(int i, Unit& u) const {
        const long L = (long)i * G + c; if (L >= nwg) return false;
        int wgid = (int)L; { const int q = nwg / NXCD, r = nwg % NXCD, xcd = wgid % NXCD, off = wgid / NXCD; wgid = (xcd < r ? xcd * (q + 1) : r * (q + 1) + (xcd - r) * q) + off; }
        const int nig = WGM * nN, gid = wgid / nig, fm = gid * WGM, gsz = (nM - fm) < WGM ? (nM - fm) : WGM;
        u.pm = fm + ((wgid % nig) % gsz); u.pn = (wgid % nig) / gsz; return true;
    }
    __device__ __forceinline__ void a_ready(const Unit&) const {}
    __device__ __forceinline__ void done(const Unit&) const {}
};

__device__ __forceinline__ unsigned cvt_pk_bf16(float lo, float hi) { unsigned r; asm volatile("v_cvt_pk_bf16_f32 %0, %1, %2" : "=v"(r) : "v"(lo), "v"(hi)); return r; }

template <bool BATCHED> struct PEpiBf16 {
    static constexpr bool PERM = true, AFTER_DRAIN = false;
    bf16_t* O; int ldc;
    __device__ __forceinline__ void operator()(const f32x4 (&acc)[2][2][4][2], const Unit& u, int wr, int wc, int fr, int fq) const {
        const int rb = BATCHED ? ((u.pn >> 2) * 4096 + u.pm * 256) : u.pm * 256, cb = BATCHED ? (u.pn & 3) * 256 : u.pn * 256;
        const int row0 = rb + wr * 64 + fr, col0 = cb + wc * 32 + 8 * fq;
#pragma unroll
        for (int ai = 0; ai < 2; ++ai)
#pragma unroll
            for (int m = 0; m < 4; ++m) { bf16_t* rowp = O + (size_t)(row0 + ai * HALF + m * 16) * ldc + col0;
#pragma unroll
                for (int bj = 0; bj < 2; ++bj) { const f32x4 v0 = acc[ai][bj][m][0], v1 = acc[ai][bj][m][1];
                    u32x4 w; w.x = cvt_pk_bf16(v0[0], v0[1]); w.y = cvt_pk_bf16(v0[2], v0[3]); w.z = cvt_pk_bf16(v1[0], v1[1]); w.w = cvt_pk_bf16(v1[2], v1[3]);
                    *(u32x4*)(rowp + bj * HALF) = w; } }
    }
};
struct PEpiF32 {
    static constexpr bool PERM = true, AFTER_DRAIN = false;
    float* O; int ldc;
    __device__ __forceinline__ void operator()(const f32x4 (&acc)[2][2][4][2], const Unit& u, int wr, int wc, int fr, int fq) const {
        const int row0 = u.pm * 256 + wr * 64 + fr, col0 = u.pn * 256 + wc * 32 + 8 * fq;
#pragma unroll
        for (int ai = 0; ai < 2; ++ai)
#pragma unroll
            for (int m = 0; m < 4; ++m) { float* rowp = O + (size_t)(row0 + ai * HALF + m * 16) * ldc + col0;
#pragma unroll
                for (int bj = 0; bj < 2; ++bj) { *(f32x4*)(rowp + bj * HALF) = acc[ai][bj][m][0]; *(f32x4*)(rowp + bj * HALF + 4) = acc[ai][bj][m][1]; } }
    }
};
struct BatchOrder {
    int G, c;
    __device__ __forceinline__ bool next(int i, Unit& u) const { const int L = i * G + c; if (L >= 512) return false; const int b = L >> 6, r = L & 63; u.pm = r >> 2; u.pn = b * 4 + (r & 3); return true; }
    __device__ __forceinline__ void a_ready(const Unit&) const {}
    __device__ __forceinline__ void done(const Unit&) const {}
};
template <class Epi, class Sched, bool ALIGN_EPI = false, bool SP2 = false>
__device__ __forceinline__ void gemm_phase(PG8_LAS unsigned char* lds, const Gemm g, const Sched& S, const Epi& E) {
    int tid_ = threadIdx.x; asm volatile("" : "+v"(tid_));
    const int tid = tid_, wid = __builtin_amdgcn_readfirstlane(tid >> 6), lane = tid & 63, wr = wid >> 2, wc = wid & 3, fr = lane & 15, fq = lane >> 4;
    const int K = g.K, nt = K / BK;
    unsigned voffA[2], voffB[2];
#pragma unroll
    for (int i = 0; i < 2; ++i) { int R, C; stage_rc(tid * 16 + i * 8192, R, C); const int Rb = Epi::PERM ? ((R & ~31) + perm32(R & 31)) : R;
        voffA[i] = (unsigned)(R * K + C) * 2u; voffB[i] = (unsigned)(Rb * K + C) * 2u; }
    const size_t kstep = (size_t)(BK * 2);
    const size_t hstep = (size_t)HALF * K * 2;
    const size_t tstep = 2 * hstep;
    const unsigned ldsw = (unsigned)wid * 1024u;
    const int aoff = lds_byte(wr * 64 + fr, fq * 8), boff = lds_byte(wc * 32 + fr, fq * 8);
#define PG8_SA(b, h) (((b) * 2 + (h)) * HTB)
#define PG8_SB(b, h) ((4 + (b) * 2 + (h)) * HTB)
#define PG8_STAGE(bufoff, gbase, voff) do { _Pragma("unroll") for (int _i = 0; _i < 2; ++_i) \
        __builtin_amdgcn_global_load_lds((const unsigned*)((const char*)(gbase) + (voff)[_i]), (PG8_LAS unsigned*)(lds + (bufoff) + ldsw + _i * 8192), 16, 0, 0); } while (0)
#define PG8_LDA(dst, b, h) do { _Pragma("unroll") for (int m = 0; m < 4; ++m) _Pragma("unroll") for (int k = 0; k < 2; ++k) dst[m][k] = *(const PG8_LAS bf16x8*)(lds + PG8_SA(b, h) + aoff + m * 2048 + k * 1024); } while (0)
#define PG8_LDB(dst, b, h) do { _Pragma("unroll") for (int n = 0; n < 2; ++n) _Pragma("unroll") for (int k = 0; k < 2; ++k) dst[n][k] = *(const PG8_LAS bf16x8*)(lds + PG8_SB(b, h) + boff + n * 2048 + k * 1024); } while (0)
#define PG8_MMA(ai, bj, At, Bt) do { __builtin_amdgcn_s_setprio(1); _Pragma("unroll") for (int m = 0; m < 4; ++m) _Pragma("unroll") for (int n = 0; n < 2; ++n) _Pragma("unroll") for (int k = 0; k < 2; ++k) \
        acc[ai][bj][m][n] = __builtin_amdgcn_mfma_f32_16x16x32_bf16(Bt[n][k], At[m][k], acc[ai][bj][m][n], 0, 0, 0); __builtin_amdgcn_s_setprio(0); } while (0)
#define PG8_WAIT_V(n) asm volatile("s_waitcnt vmcnt(" #n ")" ::: "memory")
#define PG8_WAIT_L(n) asm volatile("s_waitcnt lgkmcnt(" #n ")" ::: "memory")
#define PG8_BAR __builtin_amdgcn_s_barrier()
#define PG8_SCHED __builtin_amdgcn_sched_barrier(0)
    Unit cur, nxt; int ui = 0;
    if (!S.next(0, cur)) return;
    f32x4 acc[2][2][4][2];
#pragma unroll
    for (int a = 0; a < 2; ++a)
#pragma unroll
        for (int b = 0; b < 2; ++b)
#pragma unroll
            for (int m = 0; m < 4; ++m)
#pragma unroll
                for (int n = 0; n < 2; ++n) acc[a][b][m][n] = (f32x4){0.f, 0.f, 0.f, 0.f};
    bf16x8 At[4][2], B0[2][2], B1[2][2];
    const char* cA = (const char*)g.A + (size_t)cur.pm * tstep; const char* cB = (const char*)g.Bt + (size_t)cur.pn * tstep;
    S.a_ready(cur);
    if constexpr (SP2) {
        PG8_STAGE(PG8_SB(0, 0), cB, voffB); PG8_STAGE(PG8_SB(0, 1), cB + hstep, voffB); PG8_STAGE(PG8_SA(0, 0), cA, voffA); PG8_STAGE(PG8_SA(0, 1), cA + hstep, voffA);
        if (wr == 1) PG8_BAR;
        PG8_WAIT_V(2); PG8_BAR;
        PG8_STAGE(PG8_SB(1, 0), cB + kstep, voffB); PG8_STAGE(PG8_SA(1, 0), cA + kstep, voffA); PG8_STAGE(PG8_SB(1, 1), cB + hstep + kstep, voffB);
        PG8_WAIT_V(6); PG8_BAR;
    } else {
        PG8_STAGE(PG8_SB(0, 0), cB, voffB); PG8_STAGE(PG8_SA(0, 0), cA, voffA); PG8_STAGE(PG8_SB(0, 1), cB + hstep, voffB); PG8_STAGE(PG8_SA(0, 1), cA + hstep, voffA);
        if (wr == 1) PG8_BAR;
        PG8_WAIT_V(4); PG8_BAR;
        PG8_STAGE(PG8_SB(1, 0), cB + kstep, voffB); PG8_STAGE(PG8_SA(1, 0), cA + kstep, voffA); PG8_STAGE(PG8_SB(1, 1), cB + hstep + kstep, voffB);
        PG8_WAIT_V(6); PG8_BAR;
    }
    for (;;) {
        const bool has_next = S.next(ui + 1, nxt);
        const char* nA = has_next ? (const char*)g.A + (size_t)nxt.pm * tstep : cA; const char* nB = has_next ? (const char*)g.Bt + (size_t)nxt.pn * tstep : cB;
        for (int t = 0; t < nt; t += 2) {
            const bool last = (t == nt - 2);
            const char* a1 = cA + (size_t)(t + 1) * kstep;
            const char* a2 = last ? nA : cA + (size_t)(t + 2) * kstep; const char* b2 = last ? nB : cB + (size_t)(t + 2) * kstep;
            const char* a3 = a2 + kstep; const char* b3 = b2 + kstep;
            if (last && has_next) S.a_ready(nxt);
            if constexpr (SP2) {
            PG8_LDB(B0, 0, 0); PG8_LDB(B1, 0, 1); PG8_SCHED; PG8_LDA(At, 0, 0); PG8_STAGE(PG8_SA(1, 1), a1 + hstep, voffA);
            PG8_WAIT_V(8); PG8_WAIT_L(0); PG8_BAR; PG8_MMA(0, 0, At, B0); PG8_MMA(0, 1, At, B1); PG8_BAR; PG8_SCHED;
            PG8_LDA(At, 0, 1); PG8_STAGE(PG8_SB(0, 0), b2, voffB); PG8_STAGE(PG8_SB(0, 1), b2 + hstep, voffB); PG8_STAGE(PG8_SA(0, 0), a2, voffA);
            PG8_WAIT_V(8); PG8_WAIT_L(0); PG8_BAR; PG8_MMA(1, 0, At, B0); PG8_MMA(1, 1, At, B1); PG8_BAR; PG8_SCHED;
            PG8_LDB(B0, 1, 0); PG8_LDB(B1, 1, 1); PG8_SCHED; PG8_LDA(At, 1, 0); PG8_STAGE(PG8_SA(0, 1), a2 + hstep, voffA);
            PG8_WAIT_V(8); PG8_WAIT_L(0); PG8_BAR; PG8_MMA(0, 0, At, B0); PG8_MMA(0, 1, At, B1); PG8_BAR; PG8_SCHED;
            PG8_LDA(At, 1, 1); PG8_STAGE(PG8_SB(1, 0), b3, voffB); PG8_STAGE(PG8_SB(1, 1), b3 + hstep, voffB); PG8_STAGE(PG8_SA(1, 0), a3, voffA);
            PG8_WAIT_V(8); PG8_WAIT_L(0); PG8_BAR; PG8_MMA(1, 0, At, B0); PG8_MMA(1, 1, At, B1); PG8_BAR; PG8_SCHED;
            } else {
            PG8_LDB(B0, 0, 0); PG8_SCHED; PG8_LDA(At, 0, 0); PG8_STAGE(PG8_SA(1, 1), a1 + hstep, voffA);
            PG8_WAIT_L(8); PG8_BAR; PG8_WAIT_L(0); PG8_MMA(0, 0, At, B0); PG8_BAR; PG8_SCHED;
            PG8_LDB(B1, 0, 1); PG8_STAGE(PG8_SB(0, 0), b2, voffB);
            PG8_BAR; PG8_WAIT_L(0); PG8_MMA(0, 1, At, B1); PG8_BAR;
            PG8_LDA(At, 0, 1); PG8_STAGE(PG8_SA(0, 0), a2, voffA);
            PG8_BAR; PG8_WAIT_L(0); PG8_MMA(1, 0, At, B0); PG8_BAR; PG8_SCHED;
            PG8_STAGE(PG8_SB(0, 1), b2 + hstep, voffB);
            PG8_WAIT_V(6); PG8_BAR; PG8_MMA(1, 1, At, B1); PG8_BAR;
            PG8_LDB(B0, 1, 0); PG8_SCHED; PG8_LDA(At, 1, 0); PG8_STAGE(PG8_SA(0, 1), a2 + hstep, voffA);
            PG8_WAIT_L(8); PG8_BAR; PG8_WAIT_L(0); PG8_MMA(0, 0, At, B0); PG8_BAR; PG8_SCHED;
            PG8_LDB(B1, 1, 1); PG8_STAGE(PG8_SB(1, 0), b3, voffB);
            PG8_BAR; PG8_WAIT_L(0); PG8_MMA(0, 1, At, B1); PG8_BAR;
            PG8_LDA(At, 1, 1); PG8_STAGE(PG8_SA(1, 0), a3, voffA);
            PG8_BAR; PG8_WAIT_L(0); PG8_MMA(1, 0, At, B0); PG8_BAR; PG8_SCHED;
            PG8_STAGE(PG8_SB(1, 1), b3 + hstep, voffB);
            PG8_WAIT_V(6); PG8_BAR; PG8_MMA(1, 1, At, B1); PG8_BAR;
            }
        }
        if constexpr (ALIGN_EPI) { if (wr == 0) PG8_BAR; }
        if constexpr (!Epi::AFTER_DRAIN) { E(acc, cur, wr, wc, fr, fq); S.done(cur); }
        if (!has_next) break;
#pragma unroll
        for (int a = 0; a < 2; ++a)
#pragma unroll
            for (int b = 0; b < 2; ++b)
#pragma unroll
                for (int m = 0; m < 4; ++m)
#pragma unroll
                    for (int n = 0; n < 2; ++n) acc[a][b][m][n] = (f32x4){0.f, 0.f, 0.f, 0.f};
        cur = nxt; cA = nA; cB = nB; ++ui;
        if constexpr (ALIGN_EPI) { if (wr == 1) PG8_BAR; }
    }
    PG8_WAIT_V(0);
    if constexpr (!ALIGN_EPI) { if (wr == 0) PG8_BAR; }
    PG8_BAR;
    if constexpr (Epi::AFTER_DRAIN) { E.fused(acc, cur, wr, wc, fr, fq, lds, wid, lane); S.done(cur); }
#undef PG8_SA
#undef PG8_SB
#undef PG8_STAGE
#undef PG8_LDA
#undef PG8_LDB
#undef PG8_MMA
#undef PG8_WAIT_V
#undef PG8_WAIT_L
#undef PG8_BAR
#undef PG8_SCHED
}
}

template <class Epi>
DEV void gemm_tile(char* lds, const bf16_t* __restrict__ A, int lda, const bf16_t* __restrict__ Bt, int ldb, int K, int trow, int tcol,
                   const Epi& epi) {
  const int tid = threadIdx.x, w = tid >> 6, l = tid & 63, wm = w >> 1, wn = w & 1, lr = l & 15, lq = l >> 4;
  const bf16_t* ga[4];
  const bf16_t* gb[2];
#pragma unroll
  for (int j = 0; j < 4; ++j) {
    const int c = w * 4 + j, mt = c >> 1, sl = c & 1;
    ga[j] = A + (size_t)(mt * 16 + lr) * lda + sl * 32 + lq * 8;
  }
#pragma unroll
  for (int j = 0; j < 2; ++j) {
    const int nt = w, sl = j;
    const int rowb = (nt >> 2) * 64 + (lr >> 2) * 16 + (nt & 3) * 4 + (lr & 3);
    gb[j] = Bt + (size_t)rowb * ldb + sl * 32 + lq * 8;
  }
  f32x4 acc[4][4];
#pragma unroll
  for (int i = 0; i < 4; ++i)
#pragma unroll
    for (int j = 0; j < 4; ++j) acc[i][j] = (f32x4){0.f, 0.f, 0.f, 0.f};
  u32x4 ra[4], rb[2];
  const int nk = K >> 6;
#pragma unroll
  for (int j = 0; j < 4; ++j) ra[j] = *(const u32x4*)(ga[j]);
#pragma unroll
  for (int j = 0; j < 2; ++j) rb[j] = *(const u32x4*)(gb[j]);
#pragma unroll
  for (int j = 0; j < 4; ++j) *(u32x4*)(lds + (w * 4 + j) * 1024 + l * 16) = ra[j];
#pragma unroll
  for (int j = 0; j < 2; ++j) *(u32x4*)(lds + 32768 + (w * 2 + j) * 1024 + l * 16) = rb[j];
  __syncthreads();
  for (int kt = 0; kt < nk; ++kt) {
    char* cur = lds + (kt & 1) * 49152;
    const bool more = (kt + 1 < nk);
    if (more) {
#pragma unroll
      for (int j = 0; j < 4; ++j) ra[j] = *(const u32x4*)(ga[j] + (kt + 1) * 64);
#pragma unroll
      for (int j = 0; j < 2; ++j) rb[j] = *(const u32x4*)(gb[j] + (kt + 1) * 64);
    }
#pragma unroll
    for (int s = 0; s < 2; ++s) {
      bf16x8 af[4], bfr[4];
#pragma unroll
      for (int i = 0; i < 4; ++i) af[i] = *(const bf16x8*)(cur + ((wm * 4 + i) * 2 + s) * 1024 + l * 16);
#pragma unroll
      for (int j = 0; j < 4; ++j) bfr[j] = *(const bf16x8*)(cur + 32768 + ((wn * 4 + j) * 2 + s) * 1024 + l * 16);
#pragma unroll
      for (int i = 0; i < 4; ++i)
#pragma unroll
        for (int j = 0; j < 4; ++j) acc[i][j] = __builtin_amdgcn_mfma_f32_16x16x32_bf16(bfr[j], af[i], acc[i][j], 0, 0, 0);
    }
    if (more) {
      char* nxt = lds + ((kt + 1) & 1) * 49152;
#pragma unroll
      for (int j = 0; j < 4; ++j) *(u32x4*)(nxt + (w * 4 + j) * 1024 + l * 16) = ra[j];
#pragma unroll
      for (int j = 0; j < 2; ++j) *(u32x4*)(nxt + 32768 + (w * 2 + j) * 1024 + l * 16) = rb[j];
    }
    __syncthreads();
  }
#pragma unroll
  for (int i = 0; i < 4; ++i) epi(trow + wm * 64 + i * 16 + lr, tcol + wn * 64 + lq * 16, acc[i]);
}

DEV void store16_bf16(bf16_t* dst, const f32x4 (&v)[4], float sc) {
  u32x4 a, b;
  a.x = pk2(v[0][0] * sc, v[0][1] * sc); a.y = pk2(v[0][2] * sc, v[0][3] * sc);
  a.z = pk2(v[1][0] * sc, v[1][1] * sc); a.w = pk2(v[1][2] * sc, v[1][3] * sc);
  b.x = pk2(v[2][0] * sc, v[2][1] * sc); b.y = pk2(v[2][2] * sc, v[2][3] * sc);
  b.z = pk2(v[3][0] * sc, v[3][1] * sc); b.w = pk2(v[3][2] * sc, v[3][3] * sc);
  *(u32x4*)dst = a;
  *(u32x4*)(dst + 8) = b;
}

struct EpiBf16 {
  bf16_t* O; int ldo;
  DEV void operator()(int row, int col, const f32x4 (&v)[4]) const { store16_bf16(O + (size_t)row * ldo + col, v, 1.f); }
};
struct EpiF32 {
  float* O; int ldo;
  DEV void operator()(int row, int col, const f32x4 (&v)[4]) const {
    float* d = O + (size_t)row * ldo + col;
#pragma unroll
    for (int j = 0; j < 4; ++j) *(f32x4*)(d + 4 * j) = v[j];
  }
};
struct EpiLora1 {
  bf16_t* O;
  DEV void operator()(int row, int col, const f32x4 (&v)[4]) const {
    f32x4 o[4];
#pragma unroll
    for (int j = 0; j < 4; ++j)
#pragma unroll
      for (int r = 0; r < 4; ++r) {
        const float t = v[j][r];
        o[j][r] = (col < 128) ? tanhf(t) : ((col < 256) ? t : sigmoidf_(t));
      }
    store16_bf16(O + (size_t)row * 384 + col, o, 1.f);
  }
};
struct EpiDecay {
  bf16_t* O; const float* w0;
  DEV void operator()(int row, int col, const f32x4 (&v)[4]) const {
    f32x4 o[4];
#pragma unroll
    for (int j = 0; j < 4; ++j)
#pragma unroll
      for (int r = 0; r < 4; ++r) {
        const float xx = w0[col + 4 * j + r] + v[j][r];
        const float nx = -xx;
        const float sp = (nx > 20.f) ? nx : log1pf(expf(nx));
        const float e = expf(-sp - 0.5f);
        o[j][r] = -expm1f(-e);
      }
    store16_bf16(O + (size_t)row * 512 + col, o, 1.f);
  }
};
struct EpiA {
  bf16_t *KD, *KKA, *KK; const float *a0, *k_k, *k_a; const bf16_t* za; int writekk;
  DEV void operator()(int row, int col, const f32x4 (&v)[4]) const {
    const bf16_t* kp = za + (size_t)row * 2048 + 512 + col;
    const u32x4 k0 = *(const u32x4*)kp, k1 = *(const u32x4*)(kp + 8);
    float kf[16];
    kf[0] = lo16(k0.x); kf[1] = hi16(k0.x); kf[2] = lo16(k0.y); kf[3] = hi16(k0.y); kf[4] = lo16(k0.z); kf[5] = hi16(k0.z); kf[6] = lo16(k0.w); kf[7] = hi16(k0.w);
    kf[8] = lo16(k1.x); kf[9] = hi16(k1.x); kf[10] = lo16(k1.y); kf[11] = hi16(k1.y); kf[12] = lo16(k1.z); kf[13] = hi16(k1.z); kf[14] = lo16(k1.w); kf[15] = hi16(k1.w);
    float kr[16], ss = 0.f;
#pragma unroll
    for (int i = 0; i < 16; ++i) { kr[i] = kf[i] * k_k[col + i]; ss += kr[i] * kr[i]; }
    ss += __shfl_xor(ss, 16);
    ss += __shfl_xor(ss, 32);
    const float rn = rsqrtf(ss + 1e-12f);
    f32x4 okd[4], okka[4], okk[4];
#pragma unroll
    for (int j = 0; j < 4; ++j)
#pragma unroll
      for (int r = 0; r < 4; ++r) {
        const int i = 4 * j + r;
        const float a = sigmoidf_(a0[col + i] + v[j][r]);
        const float kk = kr[i] * rn;
        okd[j][r] = kf[i] * (1.f + (a - 1.f) * k_a[col + i]);
        okka[j][r] = kk * a;
        okk[j][r] = kk;
      }
    store16_bf16(KD + (size_t)row * 512 + col, okd, 1.f);
    store16_bf16(KKA + (size_t)row * 512 + col, okka, 1.f);
    if (writekk) store16_bf16(KK + (size_t)row * 512 + col, okk, 1.f);
  }
};
struct EpiDftc {
  bf16_t* CST; int g;
  DEV void operator()(int row, int col, const f32x4 (&v)[4]) const {
    const int b = col >> 12, s = col & 4095;
    store16_bf16(CST + ((size_t)(b * 1024 + g * 128 + (row & 127)) * 8192 + (row >> 7) * 4096 + s), v, 1.f);
  }
};

DEV void transpose_convert(char* lds, const float* __restrict__ W, int K, int N, bf16_t* __restrict__ Wt, int ldt, int rot) {
  float* tile = (float*)lds;
  const int tn_n = N >> 6, nt = (K >> 6) * tn_n, tid = threadIdx.x;
  for (int t = (blockIdx.x + rot) % gridDim.x; t < nt; t += gridDim.x) {
    const int tk = t / tn_n, tn = t % tn_n;
    for (int i = tid; i < 4096; i += NTHR) {
      const int r = i >> 6, cc = i & 63;
      tile[r * 65 + cc] = W[(size_t)(tk * 64 + r) * N + tn * 64 + cc];
    }
    __syncthreads();
    for (int i = tid; i < 4096; i += NTHR) {
      const int n = i >> 6, k = i & 63;
      Wt[(size_t)(tn * 64 + n) * ldt + tk * 64 + k] = f2bf(tile[k * 65 + n]);
    }
    __syncthreads();
  }
}

DEV void compute_mod(char* lds, const P& p) {
  float* cs = (float*)lds;
  float* red = (float*)(lds + 32768);
  const int tid = threadIdx.x;
  float* mod = (float*)(p.ws + W_MOD);
  bool have = false;
  for (int item = blockIdx.x; item < 192; item += gridDim.x) {
    if (!have) {
      for (int i = tid; i < 8192; i += NTHR) { const float cv = p.c[i]; cs[i] = cv / (1.f + expf(-cv)); }
      __syncthreads();
      have = true;
    }
    const int l = item / 96, cb = item % 96, col = cb * 64 + (tid & 63), kg = tid >> 6;
    float a0 = 0, a1 = 0, a2 = 0, a3 = 0, a4 = 0, a5 = 0, a6 = 0, a7 = 0;
    const float* wp = p.ada_w + ((size_t)l * 1024 + kg * 128) * 6144 + col;
    for (int k = 0; k < 128; ++k) {
      const float wv = wp[(size_t)k * 6144];
      const int kk = kg * 128 + k;
      a0 += cs[kk] * wv; a1 += cs[1024 + kk] * wv; a2 += cs[2048 + kk] * wv; a3 += cs[3072 + kk] * wv;
      a4 += cs[4096 + kk] * wv; a5 += cs[5120 + kk] * wv; a6 += cs[6144 + kk] * wv; a7 += cs[7168 + kk] * wv;
    }
    float* rp = red + kg * 512 + (tid & 63);
    rp[0] = a0; rp[64] = a1; rp[128] = a2; rp[192] = a3; rp[256] = a4; rp[320] = a5; rp[384] = a6; rp[448] = a7;
    __syncthreads();
    {
      const int b = tid >> 6, cc = tid & 63;
      float s = 0.f;
#pragma unroll
      for (int g = 0; g < 8; ++g) s += red[g * 512 + b * 64 + cc];
      mod[(size_t)(l * 8 + b) * 6144 + cb * 64 + cc] = s + p.ada_b[l * 6144 + cb * 64 + cc];
    }
    __syncthreads();
  }
}

template <bool HAS_Y, bool HAS_H>
DEV void rowpass(const float* __restrict__ xin, const float* __restrict__ yf, const float* __restrict__ gy, const float* __restrict__ gate,
                 float* __restrict__ xout, const float* __restrict__ gh, const float* __restrict__ sc, const float* __restrict__ sh,
                 bf16_t* __restrict__ h) {
  const int lane = threadIdx.x & 63, gw = blockIdx.x * 8 + (threadIdx.x >> 6), nw = gridDim.x * 8;
  for (int row = gw; row < MT; row += nw) {
    const int b = row >> 12;
    f32x4 xv[4];
#pragma unroll
    for (int i = 0; i < 4; ++i) xv[i] = *(const f32x4*)(xin + (size_t)row * 1024 + i * 256 + lane * 4);
    if (HAS_Y) {
      f32x4 yv[4];
      float ss = 0.f;
#pragma unroll
      for (int i = 0; i < 4; ++i) {
        yv[i] = *(const f32x4*)(yf + (size_t)row * 1024 + i * 256 + lane * 4);
        ss += yv[i][0] * yv[i][0] + yv[i][1] * yv[i][1] + yv[i][2] * yv[i][2] + yv[i][3] * yv[i][3];
      }
      ss = wave_sum(ss);
      const float rs = rsqrtf(ss * (1.f / 1024.f) + 1e-6f);
#pragma unroll
      for (int i = 0; i < 4; ++i) {
        const int col = i * 256 + lane * 4;
        const f32x4 g4 = *(const f32x4*)(gy + col), gt = *(const f32x4*)(gate + (size_t)b * 6144 + col);
        xv[i] = xv[i] + gt * (yv[i] * rs * g4);
        *(f32x4*)(xout + (size_t)row * 1024 + col) = xv[i];
      }
    }
    if (HAS_H) {
      float ss = 0.f;
#pragma unroll
      for (int i = 0; i < 4; ++i) ss += xv[i][0] * xv[i][0] + xv[i][1] * xv[i][1] + xv[i][2] * xv[i][2] + xv[i][3] * xv[i][3];
      ss = wave_sum(ss);
      const float rs = rsqrtf(ss * (1.f / 1024.f) + 1e-6f);
#pragma unroll
      for (int i = 0; i < 4; ++i) {
        const int col = i * 256 + lane * 4;
        const f32x4 g4 = *(const f32x4*)(gh + col), s4 = *(const f32x4*)(sc + (size_t)b * 6144 + col), h4 = *(const f32x4*)(sh + (size_t)b * 6144 + col);
        const f32x4 o = (xv[i] * rs * g4) * (s4 + 1.f) + h4;
        u32x2 pk;
        pk.x = pk2(o[0], o[1]); pk.y = pk2(o[2], o[3]);
        *(u32x2*)(h + (size_t)row * 1024 + col) = pk;
      }
    }
  }
}

DEV void unpack8(const u32x4 u, float (&f)[8]) {
  f[0] = lo16(u.x); f[1] = hi16(u.x); f[2] = lo16(u.y); f[3] = hi16(u.y); f[4] = lo16(u.z); f[5] = hi16(u.z); f[6] = lo16(u.w); f[7] = hi16(u.w);
}
DEV u32x4 pack8(const float (&f)[8]) {
  u32x4 u;
  u.x = pk2(f[0], f[1]); u.y = pk2(f[2], f[3]); u.z = pk2(f[4], f[5]); u.w = pk2(f[6], f[7]);
  return u;
}

DEV void prep1(const P& p) {
  const bf16_t* z = (const bf16_t*)(p.ws + O_Z);
  bf16_t* za = (bf16_t*)p.out;
  bf16_t* qr = (bf16_t*)(p.ws + O_QR);
  bf16_t* kr = (bf16_t*)(p.ws + O_KR);
  bf16_t* vt = (bf16_t*)(p.ws + O_VT);
  const float* rope = (const float*)(p.ws + W_ROPE);
  const int gt = blockIdx.x * NTHR + threadIdx.x, ngt = gridDim.x * NTHR;
  for (int idx = gt; idx < MT * 256; idx += ngt) {
    const int tok = idx >> 8, c8 = (idx & 255) * 8, s = tok & 4095;
    const bf16_t* zp = z + (size_t)tok * INC + c8;
    float zc[8], zm[8], zn[8], o[8];
    unpack8(*(const u32x4*)zp, zc);
    if (s > 0) unpack8(*(const u32x4*)(zp - INC), zm); else { for (int i = 0; i < 8; ++i) zm[i] = 0.f; }
    if (s < 4095) unpack8(*(const u32x4*)(zp + INC), zn); else { for (int i = 0; i < 8; ++i) zn[i] = 0.f; }
#pragma unroll
    for (int i = 0; i < 8; ++i) o[i] = zm[i] * p.mix_conv[c8 + i] + zc[i] * p.mix_conv[2048 + c8 + i] + zn[i] * p.mix_conv[4096 + c8 + i];
    *(u32x4*)(za + (size_t)tok * 2048 + c8) = pack8(o);
  }
  for (int idx = gt; idx < MT * 64; idx += ngt) {
    const int e8 = idx & 3, which = (idx >> 2) & 1, h = (idx >> 3) & 7, tok = idx >> 6, s = tok & 4095;
    const bf16_t* src = z + (size_t)tok * INC + 2048 + which * 512 + h * 64 + e8 * 8;
    float x1[8], x2[8], o1[8], o2[8];
    unpack8(*(const u32x4*)src, x1);
    unpack8(*(const u32x4*)(src + 32), x2);
    const float* rp = rope + ((size_t)s * 32 + e8 * 8) * 2;
    const float scl = which ? 1.f : 0.125f;
#pragma unroll
    for (int i = 0; i < 8; ++i) {
      const float cv = rp[2 * i], sv = rp[2 * i + 1];
      o1[i] = (x1[i] * cv - x2[i] * sv) * scl;
      o2[i] = (x2[i] * cv + x1[i] * sv) * scl;
    }
    bf16_t* dst = (which ? kr : qr) + (size_t)tok * 512 + h * 64 + e8 * 8;
    *(u32x4*)dst = pack8(o1);
    *(u32x4*)(dst + 32) = pack8(o2);
  }
  {
    const int lane = threadIdx.x & 63, gw = blockIdx.x * 8 + (threadIdx.x >> 6), nw = gridDim.x * 8;
    for (int item = gw; item < 3 * 4096; item += nw) {
      const int br = item >> 12, rem = item & 4095, b = rem >> 9, h = (rem >> 6) & 7, nb = rem & 63;
      const int dsh = 2 * br;
      const int Mr = 4096 >> dsh;
      const int pp = nb * 64 + lane, rsd = pp / Mr, m = pp % Mr, s = (m << dsh) + rsd;
      const bf16_t* src = z + (size_t)(b * 4096 + s) * INC + 3072 + h * 64;
      bf16_t* dst = vt + ((size_t)((br * 8 + b) * 8 + h) * 64) * 4096 + pp;
#pragma unroll
      for (int c = 0; c < 8; ++c) {
        const u32x4 u = *(const u32x4*)(src + c * 8);
        dst[(size_t)(c * 8 + 0) * 4096] = (bf16_t)(u.x & 0xffff); dst[(size_t)(c * 8 + 1) * 4096] = (bf16_t)(u.x >> 16);
        dst[(size_t)(c * 8 + 2) * 4096] = (bf16_t)(u.y & 0xffff); dst[(size_t)(c * 8 + 3) * 4096] = (bf16_t)(u.y >> 16);
        dst[(size_t)(c * 8 + 4) * 4096] = (bf16_t)(u.z & 0xffff); dst[(size_t)(c * 8 + 5) * 4096] = (bf16_t)(u.z >> 16);
        dst[(size_t)(c * 8 + 6) * 4096] = (bf16_t)(u.w & 0xffff); dst[(size_t)(c * 8 + 7) * 4096] = (bf16_t)(u.w >> 16);
      }
    }
  }
}

DEV void attention(const P& p) {
  const bf16_t* qr = (const bf16_t*)(p.ws + O_QR);
  const bf16_t* kr = (const bf16_t*)(p.ws + O_KR);
  const bf16_t* vt = (const bf16_t*)(p.ws + O_VT);
  float* num = (float*)(p.ws + O_NUM);
  float* md = (float*)(p.ws + O_MD);
  const int lane = threadIdx.x & 63, lr = lane & 15, lq = lane >> 4;
  const int gw = blockIdx.x * 8 + (threadIdx.x >> 6), nw = gridDim.x * 8;
  for (int item = gw; item < 3 * 4096 * 4; item += nw) {
    const int mt = item & 3, nb = (item >> 2) & 63, h = (item >> 8) & 7, b = (item >> 11) & 7, br = item >> 14;
    const int dsh = 2 * br, Mr = 4096 >> dsh;
    const int seg = (nb * 64) / Mr, segstart = seg * Mr, segend = segstart + Mr;
    const bool pv_ok = (nb * 64 - 64 >= segstart), nx_ok = (nb * 64 + 128 <= segend);
    const int qp = nb * 64 + mt * 16 + lr;
    const int qtok = b * 4096 + (((qp - segstart) << dsh) + seg);
    bf16x8 qf[2];
    qf[0] = *(const bf16x8*)(qr + (size_t)qtok * 512 + h * 64 + lq * 8);
    qf[1] = *(const bf16x8*)(qr + (size_t)qtok * 512 + h * 64 + 32 + lq * 8);
    f32x4 sacc[12];
#pragma unroll
    for (int kt = 0; kt < 12; ++kt) {
      const int kb = kt >> 2;
      int blk = nb + kb - 1;
      if ((kb == 0 && !pv_ok) || (kb == 2 && !nx_ok)) blk = nb;
      const int kp = blk * 64 + (kt & 3) * 16 + lr;
      const int ktok = b * 4096 + (((kp - segstart) << dsh) + seg);
      const bf16x8 k0 = *(const bf16x8*)(kr + (size_t)ktok * 512 + h * 64 + lq * 8);
      const bf16x8 k1 = *(const bf16x8*)(kr + (size_t)ktok * 512 + h * 64 + 32 + lq * 8);
      f32x4 a = (f32x4){0.f, 0.f, 0.f, 0.f};
      a = __builtin_amdgcn_mfma_f32_16x16x32_bf16(k0, qf[0], a, 0, 0, 0);
      a = __builtin_amdgcn_mfma_f32_16x16x32_bf16(k1, qf[1], a, 0, 0, 0);
      sacc[kt] = a;
    }
    const int qi = mt * 16 + lr;
    float mx = -1e30f;
#pragma unroll
    for (int kt = 0; kt < 12; ++kt) {
      const int kb = kt >> 2;
#pragma unroll
      for (int r = 0; r < 4; ++r) {
        const int kj = (kt & 3) * 16 + lq * 4 + r;
        bool ok = true;
        if (kb == 0) ok = pv_ok && (kj >= qi);
        if (kb == 2) ok = nx_ok && (kj <= qi);
        const float sv = ok ? sacc[kt][r] : -1e30f;
        sacc[kt][r] = sv;
        mx = fmaxf(mx, sv);
      }
    }
    mx = fmaxf(mx, __shfl_xor(mx, 16));
    mx = fmaxf(mx, __shfl_xor(mx, 32));
    float den = 0.f;
#pragma unroll
    for (int kt = 0; kt < 12; ++kt)
#pragma unroll
      for (int r = 0; r < 4; ++r) {
        const float pe = __expf(sacc[kt][r] - mx);
        sacc[kt][r] = pe;
        den += pe;
      }
    den += __shfl_xor(den, 16);
    den += __shfl_xor(den, 32);
    f32x4 oacc[4];
#pragma unroll
    for (int et = 0; et < 4; ++et) oacc[et] = (f32x4){0.f, 0.f, 0.f, 0.f};
    const bf16_t* vbase = vt + ((size_t)((br * 8 + b) * 8 + h) * 64) * 4096;
#pragma unroll
    for (int t = 0; t < 6; ++t) {
      const int kb = t >> 1;
      int blk = nb + kb - 1;
      if ((kb == 0 && !pv_ok) || (kb == 2 && !nx_ok)) blk = nb;
      const int kp0 = blk * 64 + ((2 * t) & 3) * 16 + lq * 4;
      const int kp1 = blk * 64 + ((2 * t + 1) & 3) * 16 + lq * 4;
      u32x4 pu;
      pu.x = pk2(sacc[2 * t][0], sacc[2 * t][1]); pu.y = pk2(sacc[2 * t][2], sacc[2 * t][3]);
      pu.z = pk2(sacc[2 * t + 1][0], sacc[2 * t + 1][1]); pu.w = pk2(sacc[2 * t + 1][2], sacc[2 * t + 1][3]);
      const bf16x8 pf = __builtin_bit_cast(bf16x8, pu);
#pragma unroll
      for (int et = 0; et < 4; ++et) {
        const bf16_t* vrow = vbase + (size_t)(et * 16 + lr) * 4096;
        const u32x2 v0 = *(const u32x2*)(vrow + kp0), v1 = *(const u32x2*)(vrow + kp1);
        u32x4 vu;
        vu.x = v0.x; vu.y = v0.y; vu.z = v1.x; vu.w = v1.y;
        oacc[et] = __builtin_amdgcn_mfma_f32_16x16x32_bf16(__builtin_bit_cast(bf16x8, vu), pf, oacc[et], 0, 0, 0);
      }
    }
    float* np = num + ((size_t)br * MT + qtok) * 512 + h * 64 + lq * 4;
#pragma unroll
    for (int et = 0; et < 4; ++et) *(f32x4*)(np + et * 16) = oacc[et];
    if (lq == 0) {
      f32x2 o;
      o.x = mx; o.y = den;
      *(f32x2*)(md + (((size_t)br * MT + qtok) * 8 + h) * 2) = o;
    }
  }
}

DEV void combineA(const P& p) {
  const float* num = (const float*)(p.ws + O_NUM);
  const float* md = (const float*)(p.ws + O_MD);
  bf16_t* ycat = (bf16_t*)(p.ws + O_YCAT);
  const int gt = blockIdx.x * NTHR + threadIdx.x, ngt = gridDim.x * NTHR;
  for (int idx = gt; idx < MT * 128; idx += ngt) {
    const int e4 = idx & 15, h = (idx >> 4) & 7, tok = idx >> 7;
    f32x2 m0 = *(const f32x2*)(md + (((size_t)0 * MT + tok) * 8 + h) * 2);
    f32x2 m1 = *(const f32x2*)(md + (((size_t)1 * MT + tok) * 8 + h) * 2);
    f32x2 m2 = *(const f32x2*)(md + (((size_t)2 * MT + tok) * 8 + h) * 2);
    const float ma = fmaxf(m0.x, fmaxf(m1.x, m2.x));
    const float e0 = __expf(m0.x - ma), e1 = __expf(m1.x - ma), e2 = __expf(m2.x - ma);
    const float dn = e0 * m0.y + e1 * m1.y + e2 * m2.y;
    const f32x4 n0 = *(const f32x4*)(num + ((size_t)0 * MT + tok) * 512 + h * 64 + e4 * 4);
    const f32x4 n1 = *(const f32x4*)(num + ((size_t)1 * MT + tok) * 512 + h * 64 + e4 * 4);
    const f32x4 n2 = *(const f32x4*)(num + ((size_t)2 * MT + tok) * 512 + h * 64 + e4 * 4);
    const f32x4 o = (n0 * e0 + n1 * e1 + n2 * e2) * (1.f / dn);
    u32x2 pk;
    pk.x = pk2(o[0], o[1]); pk.y = pk2(o[2], o[3]);
    *(u32x2*)(ycat + (size_t)tok * 1024 + 512 + h * 64 + e4 * 4) = pk;
  }
}

DEV float dpp_allreduce16(float x) {
  x += __int_as_float(__builtin_amdgcn_update_dpp(0, __float_as_int(x), 0xB1, 0xF, 0xF, true));
  x += __int_as_float(__builtin_amdgcn_update_dpp(0, __float_as_int(x), 0x4E, 0xF, 0xF, true));
  x += __int_as_float(__builtin_amdgcn_update_dpp(0, __float_as_int(x), 0x141, 0xF, 0xF, true));
  x += __int_as_float(__builtin_amdgcn_update_dpp(0, __float_as_int(x), 0x140, 0xF, 0xF, true));
  return x;
}

DEV void scan_phase(char* lds, const P& p) {
  const bf16_t* omw = (const bf16_t*)(p.ws + O_OMW);
  const bf16_t* kd = (const bf16_t*)(p.ws + O_KD);
  const bf16_t* kka = (const bf16_t*)(p.ws + O_KKA);
  const bf16_t* kk = (const bf16_t*)(p.ws + O_KK);
  const bf16_t* za = (const bf16_t*)p.out;
  float* Y = (float*)(p.ws + O_Y);
  float* inb = (float*)lds;
  float* ybuf = (float*)(lds + 98304);
  const int tid = threadIdx.x, w = tid >> 6, lane = tid & 63, rg = lane >> 4, jl = lane & 15, j0 = jl * 4;
  for (int it = blockIdx.x; it < 256; it += gridDim.x) {
    const int sc = it >> 1, half = it & 1, d = sc >> 6, b = (sc >> 3) & 7, h = sc & 7;
    const int rowl = w * 4 + rg, row = half * 32 + rowl;
    const bf16_t* src[3];
    int dsto[3], stepi[3], isw[3];
#pragma unroll
    for (int q = 0; q < 3; ++q) {
      const int pid = tid + q * NTHR, i = pid / 48, rem = pid % 48, arr = rem >> 3, pc = rem & 7;
      const bf16_t* base;
      size_t ld;
      if (arr == 0) { base = omw + (size_t)d * MT * 512 + h * 64; ld = 512; }
      else if (arr == 1) { base = kd + (size_t)d * MT * 512 + h * 64; ld = 512; }
      else if (arr == 2) { base = kka + (size_t)d * MT * 512 + h * 64; ld = 512; }
      else if (arr == 3) { base = kk + h * 64; ld = 512; }
      else if (arr == 4) { base = za + h * 64; ld = 2048; }
      else { base = za + 1024 + h * 64; ld = 2048; }
      const int t0 = d ? (4095 - i) : i;
      src[q] = base + ((size_t)(b * 4096 + t0)) * ld + pc * 8;
      stepi[q] = (int)ld * 32 * (d ? -1 : 1);
      dsto[q] = i * 384 + arr * 64 + pc * 8;
      isw[q] = (arr == 0);
    }
    float s0 = 0.f, s1 = 0.f, s2 = 0.f, s3 = 0.f;
    u32x4 rg_[3];
#pragma unroll
    for (int q = 0; q < 3; ++q) rg_[q] = *(const u32x4*)(src[q]);
#pragma unroll
    for (int q = 0; q < 3; ++q) {
      float f[8];
      unpack8(rg_[q], f);
      if (isw[q]) { for (int i = 0; i < 8; ++i) f[i] = 1.f - f[i]; }
      *(f32x4*)(inb + dsto[q]) = (f32x4){f[0], f[1], f[2], f[3]};
      *(f32x4*)(inb + dsto[q] + 4) = (f32x4){f[4], f[5], f[6], f[7]};
    }
    __syncthreads();
    for (int c = 0; c < 128; ++c) {
      const float* cur = inb + (c & 1) * 12288;
      float* yb = ybuf + (c & 1) * 1024;
      if (c + 1 < 128) {
#pragma unroll
        for (int q = 0; q < 3; ++q) rg_[q] = *(const u32x4*)(src[q] + (ptrdiff_t)stepi[q] * (c + 1));
      }
#pragma unroll 4
      for (int i = 0; i < 32; ++i) {
        const float* st = cur + i * 384;
        const f32x4 w4 = *(const f32x4*)(st + j0), kd4 = *(const f32x4*)(st + 64 + j0), ka4 = *(const f32x4*)(st + 128 + j0),
                    kk4 = *(const f32x4*)(st + 192 + j0), r4 = *(const f32x4*)(st + 256 + j0);
        const float v = st[320 + row];
        float sk = (s0 * kk4[0] + s1 * kk4[1]) + (s2 * kk4[2] + s3 * kk4[3]);
        sk = dpp_allreduce16(sk);
        s0 = s0 * w4[0] + (v * kd4[0] - sk * ka4[0]);
        s1 = s1 * w4[1] + (v * kd4[1] - sk * ka4[1]);
        s2 = s2 * w4[2] + (v * kd4[2] - sk * ka4[2]);
        s3 = s3 * w4[3] + (v * kd4[3] - sk * ka4[3]);
        float y = (s0 * r4[0] + s1 * r4[1]) + (s2 * r4[2] + s3 * r4[3]);
        y = dpp_allreduce16(y);
        if (jl == 0) yb[i * 32 + rowl] = y;
      }
      if (c + 1 < 128) {
        float* nb_ = inb + ((c + 1) & 1) * 12288;
#pragma unroll
        for (int q = 0; q < 3; ++q) {
          float f[8];
          unpack8(rg_[q], f);
          if (isw[q]) { for (int i = 0; i < 8; ++i) f[i] = 1.f - f[i]; }
          *(f32x4*)(nb_ + dsto[q]) = (f32x4){f[0], f[1], f[2], f[3]};
          *(f32x4*)(nb_ + dsto[q] + 4) = (f32x4){f[4], f[5], f[6], f[7]};
        }
      }
      __syncthreads();
      {
        const int idx = tid * 2, i = idx >> 5, rl = idx & 31;
        const int t = d ? (4095 - (c * 32 + i)) : (c * 32 + i);
        const f32x2 o = *(const f32x2*)(yb + idx);
        *(f32x2*)(Y + ((size_t)d * MT + b * 4096 + t) * 512 + h * 64 + half * 32 + rl) = o;
      }
    }
    __syncthreads();
  }
}

DEV void postB(const P& p) {
  const float* Y = (const float*)(p.ws + O_Y);
  const bf16_t* kd = (const bf16_t*)(p.ws + O_KD);
  const bf16_t* gg = (const bf16_t*)(p.ws + O_G);
  const bf16_t* za = (const bf16_t*)p.out;
  bf16_t* ycat = (bf16_t*)(p.ws + O_YCAT);
  const int lane = threadIdx.x & 63, gw = blockIdx.x * 8 + (threadIdx.x >> 6), nw = gridDim.x * 8;
  for (int item = gw; item < MT * 8; item += nw) {
    const int tok = item >> 3, h = item & 7, c = h * 64 + lane;
    const float y = Y[(size_t)tok * 512 + c] + Y[((size_t)MT + tok) * 512 + c];
    const float mu = wave_sum(y) * (1.f / 64.f);
    const float dv = y - mu;
    const float var = wave_sum(dv * dv) * (1.f / 64.f);
    const float yn = dv * rsqrtf(var + 64e-5f) * p.lnx_w[c] + p.lnx_b[c];
    const float r = bf2f(za[(size_t)tok * 2048 + c]), v = bf2f(za[(size_t)tok * 2048 + 1024 + c]);
    const float kds = bf2f(kd[(size_t)tok * 512 + c]) + bf2f(kd[((size_t)MT + tok) * 512 + c]);
    const float bon = wave_sum(r * kds * p.r_k[c]) * v;
    const float o = (yn + bon) * bf2f(gg[(size_t)tok * 512 + c]);
    ycat[(size_t)tok * 1024 + c] = f2bf(o);
  }
}

DEV void glu_pass(const P& p, int l) {
  const bf16_t* zf = (const bf16_t*)(p.ws + O_ZF);
  bf16_t* act = (bf16_t*)(p.ws + O_ACT);
  const float* cw = p.ffn_conv + (size_t)l * 3 * 5632;
  const int gt = blockIdx.x * NTHR + threadIdx.x, ngt = gridDim.x * NTHR;
  for (int idx = gt; idx < 16384 * 352; idx += ngt) {
    const int row = idx / 352, c8 = (idx % 352) * 8, s = row & 4095;
    const bf16_t* zp = zf + (size_t)row * 5632 + c8;
    float gc[8], gm[8], gn[8], vc[8], vm[8], vn[8], o[8];
    unpack8(*(const u32x4*)zp, gc);
    unpack8(*(const u32x4*)(zp + 2816), vc);
    if (s > 0) { unpack8(*(const u32x4*)(zp - 5632), gm); unpack8(*(const u32x4*)(zp - 5632 + 2816), vm); }
    else { for (int i = 0; i < 8; ++i) { gm[i] = 0.f; vm[i] = 0.f; } }
    if (s < 4095) { unpack8(*(const u32x4*)(zp + 5632), gn); unpack8(*(const u32x4*)(zp + 5632 + 2816), vn); }
    else { for (int i = 0; i < 8; ++i) { gn[i] = 0.f; vn[i] = 0.f; } }
#pragma unroll
    for (int i = 0; i < 8; ++i) {
      const float g = gm[i] * cw[c8 + i] + gc[i] * cw[5632 + c8 + i] + gn[i] * cw[11264 + c8 + i];
      const float vv = vm[i] * cw[2816 + c8 + i] + vc[i] * cw[5632 + 2816 + c8 + i] + vn[i] * cw[11264 + 2816 + c8 + i];
      const float u = 0.7978845608028654f * (g + 0.044715f * g * g * g);
      const float ge = 0.5f * g * (1.f + tanhf(u));
      o[i] = ge * vv;
    }
    *(u32x4*)(act + (size_t)row * 2816 + c8) = pack8(o);
  }
}

template <class Epi>
DEV void gemm_grid(char* lds, const bf16_t* A, int lda, const bf16_t* Bt, int ldb, int K, int tilesM, int tilesN, const Epi& epi) {
  const int nt = tilesM * tilesN;
  for (int t = blockIdx.x; t < nt; t += gridDim.x) {
    const int tm = t / tilesN, tn = t % tilesN;
    gemm_tile(lds, A + (size_t)tm * 256 * lda, lda, Bt + (size_t)tn * 128 * ldb, ldb, K, tm * 256, tn * 128, epi);
  }
}


#define LDSP ((PG8_LAS unsigned char*)lds)
template <class Epi>
DEV void pgemm(char* lds, const bf16_t* A, const bf16_t* Bt, int M_, int N_, int K_, const Epi& E) {
  pg8::Gemm g{A, Bt, M_, N_, K_};
  pg8::StaticOrder S;
  S.init(M_, N_, (int)gridDim.x, (int)blockIdx.x);
  pg8::gemm_phase<Epi, pg8::StaticOrder, true, true>(LDSP, g, S, E);
}

DEV void ffn(char* lds, cg::grid_group& grid, const P& p, int l) {
  const bf16_t* h = (const bf16_t*)(p.ws + O_H);
  bf16_t* zf = (bf16_t*)(p.ws + O_ZF);
  bf16_t* act = (bf16_t*)(p.ws + O_ACT);
  float* yf = (float*)(p.ws + O_YF);
  const bf16_t* upt = (const bf16_t*)(p.ws + W_UP) + (size_t)l * 5632 * 1024;
  const bf16_t* dnt = (const bf16_t*)(p.ws + W_DOWN) + (size_t)l * 1024 * 2816;
  for (int half = 0; half < 2; ++half) {
    pgemm(lds, h + (size_t)half * 16384 * 1024, upt, 16384, 5632, 1024, pg8::PEpiBf16<false>{zf, 5632});
    grid.sync();
    glu_pass(p, l);
    grid.sync();
    pgemm(lds, act, dnt, 16384, 1024, 2816, pg8::PEpiF32{yf + (size_t)half * 16384 * 1024, 1024});
  }
  grid.sync();
}

__global__ void __launch_bounds__(NTHR) mega(P p) {
  extern __shared__ __attribute__((aligned(16))) char lds[];
  cg::grid_group grid = cg::this_grid();
  char* ws = p.ws;
  float* mod = (float*)(ws + W_MOD);
  const int gt = blockIdx.x * NTHR + threadIdx.x, ngt = gridDim.x * NTHR;

  compute_mod(lds, p);
  transpose_convert(lds, p.mix_in, 1024, 3584, (bf16_t*)(ws + W_MIXIN), 1024, 0);
  for (int l = 0; l < 2; ++l) {
    transpose_convert(lds, p.ffn_up + (size_t)l * 1024 * 5632, 1024, 5632, (bf16_t*)(ws + W_UP) + (size_t)l * 5632 * 1024, 1024, 64 * l);
    transpose_convert(lds, p.ffn_down + (size_t)l * 2816 * 1024, 2816, 1024, (bf16_t*)(ws + W_DOWN) + (size_t)l * 1024 * 2816, 2816, 128 + 64 * l);
  }
  transpose_convert(lds, p.mix_out, 1024, 1024, (bf16_t*)(ws + W_MIXOUT), 1024, 32);
  transpose_convert(lds, p.fnet_w, 1024, 1024, (bf16_t*)(ws + W_FNET), 1024, 96);
  for (int d = 0; d < 2; ++d) {
    transpose_convert(lds, p.w1 + (size_t)d * 512 * 64, 512, 64, (bf16_t*)(ws + W_L1) + (size_t)(d * 64) * 512, 512, 8 * d);
    transpose_convert(lds, p.a1 + (size_t)d * 512 * 64, 512, 64, (bf16_t*)(ws + W_L1) + (size_t)(128 + d * 64) * 512, 512, 16 + 8 * d);
    transpose_convert(lds, p.w2 + (size_t)d * 64 * 512, 64, 512, (bf16_t*)(ws + W_W2) + (size_t)d * 512 * 64, 64, 48 + 8 * d);
    transpose_convert(lds, p.a2 + (size_t)d * 64 * 512, 64, 512, (bf16_t*)(ws + W_A2) + (size_t)d * 512 * 64, 64, 64 + 8 * d);
  }
  transpose_convert(lds, p.g1, 512, 128, (bf16_t*)(ws + W_L1) + (size_t)256 * 512, 512, 32);
  transpose_convert(lds, p.g2, 128, 512, (bf16_t*)(ws + W_G2), 128, 80);
  {
    float* rope = (float*)(ws + W_ROPE);
    for (int idx = gt; idx < 4096 * 32; idx += ngt) {
      const int s = idx >> 5, e = idx & 31;
      const float inv = powf(10000.f, -(float)e / 32.f);
      const float ang = (float)s * inv;
      float sv, cv;
      sincosf(ang, &sv, &cv);
      rope[2 * idx] = cv;
      rope[2 * idx + 1] = sv;
    }
    bf16_t* dftc = (bf16_t*)(ws + W_DFTC);
    for (int idx = gt; idx < 256 * 128; idx += ngt) {
      const int n = idx >> 7, c = idx & 127, k2 = n & 127;
      const float ph = (float)((k2 * c) & 127) * (1.f / 64.f);
      const float v = (n < 128) ? cospif(ph) : sinpif(ph);
      dftc[idx] = f2bf(v * 0.08838834764831845f);
    }
  }
  grid.sync();
  rowpass<false, true>(p.x, nullptr, nullptr, nullptr, nullptr, p.norm_g, mod + 1024, mod, (bf16_t*)(ws + O_H0));
  grid.sync();
  pgemm(lds, (const bf16_t*)(ws + O_H0), (const bf16_t*)(ws + W_MIXIN), MT, INC, 1024, pg8::PEpiBf16<false>{(bf16_t*)(ws + O_Z), INC});
  grid.sync();
  prep1(p);
  grid.sync();
  attention(p);
  grid.sync();
  combineA(p);
  gemm_grid(lds, (const bf16_t*)p.out + 1536, 2048, (const bf16_t*)(ws + W_L1), 512, 512, 128, 3, EpiLora1{(bf16_t*)(ws + O_L1)});
  grid.sync();
  for (int d = 0; d < 2; ++d) {
    gemm_grid(lds, (const bf16_t*)(ws + O_L1) + d * 64, 384, (const bf16_t*)(ws + W_W2) + (size_t)d * 512 * 64, 64, 64, 128, 4,
              EpiDecay{(bf16_t*)(ws + O_OMW) + (size_t)d * MT * 512, p.w0 + d * 512});
    gemm_grid(lds, (const bf16_t*)(ws + O_L1) + 128 + d * 64, 384, (const bf16_t*)(ws + W_A2) + (size_t)d * 512 * 64, 64, 64, 128, 4,
              EpiA{(bf16_t*)(ws + O_KD) + (size_t)d * MT * 512, (bf16_t*)(ws + O_KKA) + (size_t)d * MT * 512, (bf16_t*)(ws + O_KK), p.a0 + d * 512,
                   p.k_k, p.k_a, (const bf16_t*)p.out, d == 0});
  }
  gemm_grid(lds, (const bf16_t*)(ws + O_L1) + 256, 384, (const bf16_t*)(ws + W_G2), 128, 128, 128, 4, EpiBf16{(bf16_t*)(ws + O_G), 512});
  grid.sync();
  scan_phase(lds, p);
  grid.sync();
  postB(p);
  grid.sync();
  pgemm(lds, (const bf16_t*)(ws + O_YCAT), (const bf16_t*)(ws + W_MIXOUT), MT, 1024, 1024, pg8::PEpiF32{(float*)(ws + O_YF), 1024});
  grid.sync();
  rowpass<true, true>(p.x, (const float*)(ws + O_YF), p.norm_g + 1024, mod + 2048, p.out, p.norm_g + 2048, mod + 4096, mod + 3072, (bf16_t*)(ws + O_H));
  grid.sync();
  ffn(lds, grid, p, 0);
  {
    const float* mod1 = mod + 8 * 6144;
    rowpass<true, true>(p.out, (const float*)(ws + O_YF), p.norm_g + 3072, mod + 5120, p.out, p.norm_g + 4096, mod1 + 1024, mod1, (bf16_t*)(ws + O_H));
    bf16_t* cs = (bf16_t*)(ws + O_COSSIN);
    for (int idx = gt; idx < 4096 * 1024; idx += ngt) {
      const int k1 = idx >> 10, k8 = (idx & 1023) * 8;
      float o[8];
#pragma unroll
      for (int i = 0; i < 8; ++i) {
        const int kk = k8 + i, s = kk & 4095;
        const float ph = (float)((k1 * s) & 4095) * (1.f / 2048.f);
        o[i] = ((kk < 4096) ? cospif(ph) : -sinpif(ph)) * (1.f / 64.f);
      }
      *(u32x4*)(cs + (size_t)k1 * 8192 + k8) = pack8(o);
    }
    grid.sync();
    for (int t = blockIdx.x; t < 8 * 256; t += gridDim.x) {
      const int g = t >> 8, tn = t & 255;
      gemm_tile(lds, (const bf16_t*)(ws + W_DFTC), 128, (const bf16_t*)(ws + O_H) + (size_t)tn * 128 * 1024 + g * 128, 1024, 128, 0, tn * 128,
                EpiDftc{(bf16_t*)(ws + O_CST), g});
    }
    grid.sync();
    {
      pg8::Gemm g{(const bf16_t*)(ws + O_COSSIN), (const bf16_t*)(ws + O_CST), 4096, 8192, 8192};
      pg8::BatchOrder S{(int)gridDim.x, (int)blockIdx.x};
      pg8::gemm_phase<pg8::PEpiBf16<true>, pg8::BatchOrder, true, true>(LDSP, g, S, pg8::PEpiBf16<true>{(bf16_t*)(ws + O_F), 1024});
    }
    grid.sync();
    pgemm(lds, (const bf16_t*)(ws + O_F), (const bf16_t*)(ws + W_FNET), MT, 1024, 1024, pg8::PEpiF32{(float*)(ws + O_YF), 1024});
    grid.sync();
    rowpass<true, true>(p.out, (const float*)(ws + O_YF), p.norm_g + 4096 + 1024, mod1 + 2048, p.out, p.norm_g + 4096 + 2048, mod1 + 4096, mod1 + 3072,
                        (bf16_t*)(ws + O_H));
    grid.sync();
    ffn(lds, grid, p, 1);
    rowpass<true, false>(p.out, (const float*)(ws + O_YF), p.norm_g + 4096 + 3072, mod1 + 5120, p.out, nullptr, nullptr, nullptr, nullptr);
  }
}

extern "C" void kernel_launch(void* const* d_in, const int* in_sizes, int n_in, void* d_out, int out_size, void* d_ws, size_t ws_size,
                              hipStream_t stream) {
  static int grid_blocks = 0;
  if (!grid_blocks) {
    int dev = 0, cus = 0, per_cu = 0;
    hipGetDevice(&dev);
    hipDeviceGetAttribute(&cus, hipDeviceAttributeMultiprocessorCount, dev);
    hipFuncSetAttribute((const void*)mega, hipFuncAttributeMaxDynamicSharedMemorySize, LDS_BYTES);
    hipOccupancyMaxActiveBlocksPerMultiprocessor(&per_cu, (const void*)mega, NTHR, LDS_BYTES);
    if (per_cu < 1) { fprintf(stderr, "occupancy query returned %d\n", per_cu); per_cu = 1; }
    if (per_cu > 1) per_cu = 1;
    grid_blocks = cus * per_cu;
  }
  P p{};
  const float** pp = (const float**)&p;
  for (int i = 0; i < 25; ++i) pp[i] = (const float*)d_in[i];
  p.out = (float*)d_out;
  p.ws = (char*)d_ws;
  void* args[] = {&p};
  hipError_t e = hipLaunchCooperativeKernel((const void*)mega, dim3(grid_blocks), dim3(NTHR), args, LDS_BYTES, stream);
  if (e != hipSuccess) fprintf(stderr, "cooperative launch failed: %s (grid %d)\n", hipGetErrorString(e), grid_blocks);
}
```

```cpp
#include <hip/hip_runtime.h>
#include <hip/hip_cooperative_groups.h>
#include <stdint.h>
#include <cstdio>
namespace cg = cooperative_groups;

typedef unsigned short bf16_t;
typedef short bf16x8 __attribute__((ext_vector_type(8)));
typedef short s16x4 __attribute__((ext_vector_type(4)));
typedef float f32x4 __attribute__((ext_vector_type(4)));
typedef float f32x2 __attribute__((ext_vector_type(2)));
typedef unsigned u32x4 __attribute__((ext_vector_type(4)));
typedef unsigned u32x2 __attribute__((ext_vector_type(2)));

#define DEV __device__ __forceinline__

constexpr int NB = 8, SEQ = 4096, DM = 1024, MT = NB * SEQ, DFF = 2816, INC = 3584;
constexpr size_t MiB = 1024 * 1024;
constexpr int NTHR = 512;
constexpr int LDS_BYTES = 131072 + 16;
constexpr size_t W_BAR = 47 * 1024 * 1024;
#ifndef REP_SCAN
#define REP_SCAN 1
#endif
#ifndef REP_ATT
#define REP_ATT 1
#endif
#ifndef REP_SYNC
#define REP_SYNC 0
#endif
#ifndef REP_PREP
#define REP_PREP 1
#endif
#ifndef REP_LORA
#define REP_LORA 1
#endif
#ifndef REP_GLU
#define REP_GLU 1
#endif
#ifndef REP_PRO
#define REP_PRO 1
#endif
#ifndef REP_ROW
#define REP_ROW 1
#endif

constexpr size_t W_MIXIN = 0;
constexpr size_t W_UP = 7 * MiB;
constexpr size_t W_DOWN = 29 * MiB;
constexpr size_t W_MIXOUT = 40 * MiB;
constexpr size_t W_FNET = 42 * MiB;
constexpr size_t W_L1 = 44 * MiB;
constexpr size_t W_W2 = W_L1 + 512 * 1024;
constexpr size_t W_A2 = W_W2 + 128 * 1024;
constexpr size_t W_G2 = W_A2 + 128 * 1024;
constexpr size_t W_DFTC = W_G2 + 128 * 1024;
constexpr size_t W_MOD = 45 * MiB;
constexpr size_t W_ROPE = 46 * MiB;
constexpr size_t R0 = 48 * MiB;
constexpr size_t O_H0 = R0;
constexpr size_t O_Z = 112 * MiB;
constexpr size_t O_QR = 336 * MiB, O_KR = 368 * MiB, O_VT = 400 * MiB;
constexpr size_t O_NUM = R0;
constexpr size_t O_MD = 240 * MiB;
constexpr size_t O_YCAT = 448 * MiB;
constexpr size_t O_OMW = 48 * MiB, O_KD = 112 * MiB, O_KKA = 176 * MiB, O_KK = 240 * MiB, O_G = 272 * MiB, O_L1 = 304 * MiB, O_Y = 304 * MiB;
constexpr size_t O_YF = 48 * MiB;
constexpr size_t O_H = 176 * MiB;
constexpr size_t O_ZF = 240 * MiB;
constexpr size_t O_ACT = 416 * MiB;
constexpr size_t O_COSSIN = 240 * MiB;
constexpr size_t O_CST = 304 * MiB;
constexpr size_t O_F = 432 * MiB;

struct P {
  const float *x, *c, *ada_w, *ada_b, *norm_g, *mix_in, *mix_conv, *w0, *w1, *w2, *a0, *a1, *a2, *g1, *g2, *k_k, *k_a, *r_k, *lnx_w,
      *lnx_b, *mix_out, *fnet_w, *ffn_up, *ffn_conv, *ffn_down;
  float* out;
  char* ws;
};

DEV float bf2f(bf16_t h) { return __uint_as_float(((unsigned)h) << 16); }
DEV bf16_t f2bf(float f) {
  unsigned u = __float_as_uint(f);
  u += 0x7fffu + ((u >> 16) & 1u);
  return (bf16_t)(u >> 16);
}
DEV unsigned pk2(float a, float b) { return (unsigned)f2bf(a) | ((unsigned)f2bf(b) << 16); }
DEV float lo16(unsigned u) { return __uint_as_float(u << 16); }
DEV float hi16(unsigned u) { return __uint_as_float(u & 0xffff0000u); }
DEV float wave_sum(float v) {
#pragma unroll
  for (int o = 32; o; o >>= 1) v += __shfl_xor(v, o);
  return v;
}
DEV float sigmoidf_(float x) { return 1.f / (1.f + __expf(-x)); }

#include <cstdint>
#include <cstdlib>
#include <vector>

#define XB_TMO      128
#define XB_XCNT(j)  (256  + 64 * (j))
#define XB_XSUB(j)  (1280 + 64 * (j))
#define XB_XGEN(j)  (2304 + 64 * (j))
#define XB_TOP      3328
#define XB_TOPGEN   3392
#define XCD_BAR_WORDS 3456
#define XB_SPIN_CAP (1u << 18)
#define XLAS __attribute__((address_space(3)))

__device__ __forceinline__ unsigned xb_ld(unsigned* p)              { return __hip_atomic_load(p, __ATOMIC_RELAXED, __HIP_MEMORY_SCOPE_AGENT); }
__device__ __forceinline__ unsigned xb_add(unsigned* p, unsigned v) { return __hip_atomic_fetch_add(p, v, __ATOMIC_RELAXED, __HIP_MEMORY_SCOPE_AGENT); }
__device__ __forceinline__ unsigned xb_xcc_id() { return (unsigned)__builtin_amdgcn_s_getreg((3 << 11) | 20) & 0xFu; }
#define XB_SPIN(cond, bar) do { unsigned _sp = 0; while (cond) { __builtin_amdgcn_s_sleep(1); \
    if ((++_sp & 255u) == 0u) { if (xb_ld(&(bar)[XB_TMO])) break; if (_sp > XB_SPIN_CAP) { atomicAdd(&(bar)[XB_TMO], 1u); break; } } } } while (0)

struct XcdBarrier {
    unsigned* bar; unsigned x;
    volatile XLAS unsigned* st;
};

__device__ __forceinline__ XcdBarrier xcd_barrier_post(unsigned* bar, volatile XLAS unsigned* st) {
    XcdBarrier b; b.bar = bar; b.x = xb_xcc_id(); b.st = st;
    if (threadIdx.x == 0) (void)xb_add(&bar[XB_XCNT(b.x)], 1u);
    return b;
}
__device__ __forceinline__ void xcd_barrier_complete(unsigned* bar, unsigned x, unsigned& nloc, unsigned& nx) {
    const unsigned G = gridDim.x * gridDim.y * gridDim.z;
    unsigned sum, cnt, mine, sp = 0u;
    for (;;) {
        sum = 0u; cnt = 0u; mine = 0u;
#pragma unroll
        for (unsigned j = 0; j < 16; ++j) { const unsigned c = xb_ld(&bar[XB_XCNT(j)]); sum += c; cnt += (c > 0u) ? 1u : 0u; mine = (j == x) ? c : mine; }
        if (sum == G) break;
        __builtin_amdgcn_s_sleep(1);
        if ((++sp & 255u) == 0u) { if (xb_ld(&bar[XB_TMO])) break; if (sp > XB_SPIN_CAP) { atomicAdd(&bar[XB_TMO], 1u); break; } }
    }
    nloc = mine > 0u ? mine : 1u; nx = cnt > 0u ? cnt : 1u;
}

__device__ __forceinline__ void xcd_barrier(const XcdBarrier& b) {
    asm volatile("s_waitcnt vmcnt(0)" ::: "memory");
    __syncthreads();
    if (threadIdx.x == 0) {
        unsigned* bar = b.bar;
        __builtin_amdgcn_s_waitcnt(0);
        unsigned nloc = b.st[0], nx = b.st[1];
        if (nloc == 0u) { xcd_barrier_complete(bar, b.x, nloc, nx); b.st[0] = nloc; b.st[1] = nx; }
        const unsigned old = xb_add(&bar[XB_XSUB(b.x)], 1u);
        const unsigned gen = old / nloc;
        if (old + 1u == (gen + 1u) * nloc) {
            __builtin_amdgcn_fence(__ATOMIC_RELEASE, "agent");
            asm volatile("s_waitcnt vmcnt(0)" ::: "memory");
            const unsigned og = xb_add(&bar[XB_TOP], 1u);
            const unsigned tg = og / nx;
            if (og + 1u == (tg + 1u) * nx) xb_add(&bar[XB_TOPGEN], 1u);
            else XB_SPIN(xb_ld(&bar[XB_TOPGEN]) == tg, bar);
            __builtin_amdgcn_fence(__ATOMIC_ACQUIRE, "agent");
            xb_add(&bar[XB_XGEN(b.x)], 1u);
            asm volatile("s_waitcnt vmcnt(0)" ::: "memory");
        } else {
            XB_SPIN(xb_ld(&bar[XB_XGEN(b.x)]) == gen, bar);
            __builtin_amdgcn_fence(__ATOMIC_ACQUIRE, "agent");
            asm volatile("s_waitcnt vmcnt(0)" ::: "memory");
        }
    }
    __syncthreads();
}

namespace pg8 {
#define PG8_LAS __attribute__((address_space(3)))
typedef unsigned short bf16_t;
typedef short bf16x8 __attribute__((ext_vector_type(8)));
typedef float f32x4 __attribute__((ext_vector_type(4)));
typedef unsigned u32x4 __attribute__((ext_vector_type(4)));
constexpr int BM = 256, BK = 64, HALF = 128, HTB = HALF * BK * 2  , STAGE_BYTES = 8 * HTB, NXCD = 8, WGM = 8;

__host__ __device__ __forceinline__ int lds_byte(int r, int c) { const int st = (r >> 4) * 2 + (c >> 5), rr = r & 15, cc = c & 31, ob = rr * 64 + cc * 2; return st * 1024 + (ob ^ (((ob >> 9) & 1) << 5)); }
__host__ __device__ __forceinline__ void stage_rc(int b, int& R, int& C) { const int st = b / 1024, sb = b % 1024, swz = sb ^ (((sb >> 9) & 1) << 5); R = (st >> 1) * 16 + swz / 64; C = (st & 1) * 32 + (swz % 64) / 2; }
__host__ __device__ __forceinline__ int perm32(int rho) { const int n = rho >> 4, i = rho & 15; return 8 * (i >> 2) + 4 * n + (i & 3); }

struct Unit { int pm, pn; };
struct Gemm { const bf16_t* A; const bf16_t* Bt; int M, N, K; };

struct StaticOrder {
    int nM, nN, nwg, G, c;
    __host__ __device__ void init(int M, int N, int G_, int c_) { nM = M / BM; nN = N / BM; nwg = nM * nN; G = G_; c = c_; }
    __host__ __device__ bool next(int i, Unit& u) const {
        const long L = (long)i * G + c; if (L >= nwg) return false;
        int wgid = (int)L; { const int q = nwg / NXCD, r = nwg % NXCD, xcd = wgid % NXCD, off = wgid / NXCD; wgid = (xcd < r ? xcd * (q + 1) : r * (q + 1) + (xcd - r) * q) + off; }
        const int nig = WGM * nN, gid = wgid / nig, fm = gid * WGM, gsz = (nM - fm) < WGM ? (nM - fm) : WGM;
        u.pm = fm + ((wgid % nig) % gsz); u.pn = (wgid % nig) / gsz; return true;
    }
    __device__ __forceinline__ void a_ready(const Unit&) const {}
    __device__ __forceinline__ void done(const Unit&) const {}
};

__device__ __forceinline__ unsigned cvt_pk_bf16(float lo, float hi) { unsigned r; asm volatile("v_cvt_pk_bf16_f32 %0, %1, %2" : "=v"(r) : "v"(lo), "v"(hi)); return r; }

template <bool BATCHED> struct PEpiBf16 {
    static constexpr bool PERM = true, AFTER_DRAIN = false;
    bf16_t* O; int ldc;
    __device__ __forceinline__ void operator()(const f32x4 (&acc)[2][2][4][2], const Unit& u, int wr, int wc, int fr, int fq) const {
        const int rb = BATCHED ? ((u.pn >> 2) * 4096 + u.pm * 256) : u.pm * 256, cb = BATCHED ? (u.pn & 3) * 256 : u.pn * 256;
        const int row0 = rb + wr * 64 + fr, col0 = cb + wc * 32 + 8 * fq;
#pragma unroll
        for (int ai = 0; ai < 2; ++ai)
#pragma unroll
            for (int m = 0; m < 4; ++m) { bf16_t* rowp = O + (size_t)(row0 + ai * HALF + m * 16) * ldc + col0;
#pragma unroll
                for (int bj = 0; bj < 2; ++bj) { const f32x4 v0 = acc[ai][bj][m][0], v1 = acc[ai][bj][m][1];
                    u32x4 w; w.x = cvt_pk_bf16(v0[0], v0[1]); w.y = cvt_pk_bf16(v0[2], v0[3]); w.z = cvt_pk_bf16(v1[0], v1[1]); w.w = cvt_pk_bf16(v1[2], v1[3]);
                    *(u32x4*)(rowp + bj * HALF) = w; } }
    }
};
struct PEpiF32 {
    static constexpr bool PERM = true, AFTER_DRAIN = false;
    float* O; int ldc;
    __device__ __forceinline__ void operator()(const f32x4 (&acc)[2][2][4][2], const Unit& u, int wr, int wc, int fr, int fq) const {
        const int row0 = u.pm * 256 + wr * 64 + fr, col0 = u.pn * 256 + wc * 32 + 8 * fq;
#pragma unroll
        for (int ai = 0; ai < 2; ++ai)
#pragma unroll
            for (int m = 0; m < 4; ++m) { float* rowp = O + (size_t)(row0 + ai * HALF + m * 16) * ldc + col0;
#pragma unroll
                for (int bj = 0; bj < 2; ++bj) { *(f32x4*)(rowp + bj * HALF) = acc[ai][bj][m][0]; *(f32x4*)(rowp + bj * HALF + 4) = acc[ai][bj][m][1]; } }
    }
};
struct BatchOrder {
    int G, c;
    __device__ __forceinline__ bool next(int i, Unit& u) const { const int L = i * G + c; if (L >= 512) return false; const int b = L >> 6, r = L & 63; u.pm = r >> 2; u.pn = b * 4 + (r & 3); return true; }
    __device__ __forceinline__ void a_ready(const Unit&) const {}
    __device__ __forceinline__ void done(const Unit&) const {}
};
template <class Epi, class Sched, bool ALIGN_EPI = false, bool SP2 = false>
__device__ __forceinline__ void gemm_phase(PG8_LAS unsigned char* lds, const Gemm g, const Sched& S, const Epi& E) {
    int tid_ = threadIdx.x; asm volatile("" : "+v"(tid_));
    const int tid = tid_, wid = __builtin_amdgcn_readfirstlane(tid >> 6), lane = tid & 63, wr = wid >> 2, wc = wid & 3, fr = lane & 15, fq = lane >> 4;
    const int K = g.K, nt = K / BK;
    unsigned voffA[2], voffB[2];
#pragma unroll
    for (int i = 0; i < 2; ++i) { int R, C; stage_rc(tid * 16 + i * 8192, R, C); const int Rb = Epi::PERM ? ((R & ~31) + perm32(R & 31)) : R;
        voffA[i] = (unsigned)(R * K + C) * 2u; voffB[i] = (unsigned)(Rb * K + C) * 2u; }
    const size_t kstep = (size_t)(BK * 2);
    const size_t hstep = (size_t)HALF * K * 2;
    const size_t tstep = 2 * hstep;
    const unsigned ldsw = (unsigned)wid * 1024u;
    const int aoff = lds_byte(wr * 64 + fr, fq * 8), boff = lds_byte(wc * 32 + fr, fq * 8);
#define PG8_SA(b, h) (((b) * 2 + (h)) * HTB)
#define PG8_SB(b, h) ((4 + (b) * 2 + (h)) * HTB)
#define PG8_STAGE(bufoff, gbase, voff) do { _Pragma("unroll") for (int _i = 0; _i < 2; ++_i) \
        __builtin_amdgcn_global_load_lds((const unsigned*)((const char*)(gbase) + (voff)[_i]), (PG8_LAS unsigned*)(lds + (bufoff) + ldsw + _i * 8192), 16, 0, 0); } while (0)
#define PG8_LDA(dst, b, h) do { _Pragma("unroll") for (int m = 0; m < 4; ++m) _Pragma("unroll") for (int k = 0; k < 2; ++k) dst[m][k] = *(const PG8_LAS bf16x8*)(lds + PG8_SA(b, h) + aoff + m * 2048 + k * 1024); } while (0)
#define PG8_LDB(dst, b, h) do { _Pragma("unroll") for (int n = 0; n < 2; ++n) _Pragma("unroll") for (int k = 0; k < 2; ++k) dst[n][k] = *(const PG8_LAS bf16x8*)(lds + PG8_SB(b, h) + boff + n * 2048 + k * 1024); } while (0)
#define PG8_MMA(ai, bj, At, Bt) do { __builtin_amdgcn_s_setprio(1); _Pragma("unroll") for (int m = 0; m < 4; ++m) _Pragma("unroll") for (int n = 0; n < 2; ++n) _Pragma("unroll") for (int k = 0; k < 2; ++k) \
        acc[ai][bj][m][n] = __builtin_amdgcn_mfma_f32_16x16x32_bf16(Bt[n][k], At[m][k], acc[ai][bj][m][n], 0, 0, 0); __builtin_amdgcn_s_setprio(0); } while (0)
#define PG8_WAIT_V(n) asm volatile("s_waitcnt vmcnt(" #n ")" ::: "memory")
#define PG8_WAIT_L(n) asm volatile("s_waitcnt lgkmcnt(" #n ")" ::: "memory")
#define PG8_BAR __builtin_amdgcn_s_barrier()
#define PG8_SCHED __builtin_amdgcn_sched_barrier(0)
    Unit cur, nxt; int ui = 0;
    if (!S.next(0, cur)) return;
    f32x4 acc[2][2][4][2];
#pragma unroll
    for (int a = 0; a < 2; ++a)
#pragma unroll
        for (int b = 0; b < 2; ++b)
#pragma unroll
            for (int m = 0; m < 4; ++m)
#pragma unroll
                for (int n = 0; n < 2; ++n) acc[a][b][m][n] = (f32x4){0.f, 0.f, 0.f, 0.f};
    bf16x8 At[4][2], B0[2][2], B1[2][2];
    const char* cA = (const char*)g.A + (size_t)cur.pm * tstep; const char* cB = (const char*)g.Bt + (size_t)cur.pn * tstep;
    S.a_ready(cur);
    if constexpr (SP2) {
        PG8_STAGE(PG8_SB(0, 0), cB, voffB); PG8_STAGE(PG8_SB(0, 1), cB + hstep, voffB); PG8_STAGE(PG8_SA(0, 0), cA, voffA); PG8_STAGE(PG8_SA(0, 1), cA + hstep, voffA);
        if (wr == 1) PG8_BAR;
        PG8_WAIT_V(2); PG8_BAR;
        PG8_STAGE(PG8_SB(1, 0), cB + kstep, voffB); PG8_STAGE(PG8_SA(1, 0), cA + kstep, voffA); PG8_STAGE(PG8_SB(1, 1), cB + hstep + kstep, voffB);
        PG8_WAIT_V(6); PG8_BAR;
    } else {
        PG8_STAGE(PG8_SB(0, 0), cB, voffB); PG8_STAGE(PG8_SA(0, 0), cA, voffA); PG8_STAGE(PG8_SB(0, 1), cB + hstep, voffB); PG8_STAGE(PG8_SA(0, 1), cA + hstep, voffA);
        if (wr == 1) PG8_BAR;
        PG8_WAIT_V(4); PG8_BAR;
        PG8_STAGE(PG8_SB(1, 0), cB + kstep, voffB); PG8_STAGE(PG8_SA(1, 0), cA + kstep, voffA); PG8_STAGE(PG8_SB(1, 1), cB + hstep + kstep, voffB);
        PG8_WAIT_V(6); PG8_BAR;
    }
    for (;;) {
        const bool has_next = S.next(ui + 1, nxt);
        const char* nA = has_next ? (const char*)g.A + (size_t)nxt.pm * tstep : cA; const char* nB = has_next ? (const char*)g.Bt + (size_t)nxt.pn * tstep : cB;
        for (int t = 0; t < nt; t += 2) {
            const bool last = (t == nt - 2);
            const char* a1 = cA + (size_t)(t + 1) * kstep;
            const char* a2 = last ? nA : cA + (size_t)(t + 2) * kstep; const char* b2 = last ? nB : cB + (size_t)(t + 2) * kstep;
            const char* a3 = a2 + kstep; const char* b3 = b2 + kstep;
            if (last && has_next) S.a_ready(nxt);
            if constexpr (SP2) {
            PG8_LDB(B0, 0, 0); PG8_LDB(B1, 0, 1); PG8_SCHED; PG8_LDA(At, 0, 0); PG8_STAGE(PG8_SA(1, 1), a1 + hstep, voffA);
            PG8_WAIT_V(8); PG8_WAIT_L(0); PG8_BAR; PG8_MMA(0, 0, At, B0); PG8_MMA(0, 1, At, B1); PG8_BAR; PG8_SCHED;
            PG8_LDA(At, 0, 1); PG8_STAGE(PG8_SB(0, 0), b2, voffB); PG8_STAGE(PG8_SB(0, 1), b2 + hstep, voffB); PG8_STAGE(PG8_SA(0, 0), a2, voffA);
            PG8_WAIT_V(8); PG8_WAIT_L(0); PG8_BAR; PG8_MMA(1, 0, At, B0); PG8_MMA(1, 1, At, B1); PG8_BAR; PG8_SCHED;
            PG8_LDB(B0, 1, 0); PG8_LDB(B1, 1, 1); PG8_SCHED; PG8_LDA(At, 1, 0); PG8_STAGE(PG8_SA(0, 1), a2 + hstep, voffA);
            PG8_WAIT_V(8); PG8_WAIT_L(0); PG8_BAR; PG8_MMA(0, 0, At, B0); PG8_MMA(0, 1, At, B1); PG8_BAR; PG8_SCHED;
            PG8_LDA(At, 1, 1); PG8_STAGE(PG8_SB(1, 0), b3, voffB); PG8_STAGE(PG8_SB(1, 1), b3 + hstep, voffB); PG8_STAGE(PG8_SA(1, 0), a3, voffA);
            PG8_WAIT_V(8); PG8_WAIT_L(0); PG8_BAR; PG8_MMA(1, 0, At, B0); PG8_MMA(1, 1, At, B1); PG8_BAR; PG8_SCHED;
            } else {
            PG8_LDB(B0, 0, 0); PG8_SCHED; PG8_LDA(At, 0, 0); PG8_STAGE(PG8_SA(1, 1), a1 + hstep, voffA);
            PG8_WAIT_L(8); PG8_BAR; PG8_WAIT_L(0); PG8_MMA(0, 0, At, B0); PG8_BAR; PG8_SCHED;
            PG8_LDB(B1, 0, 1); PG8_STAGE(PG8_SB(0, 0), b2, voffB);
            PG8_BAR; PG8_WAIT_L(0); PG8_MMA(0, 1, At, B1); PG8_BAR;
            PG8_LDA(At, 0, 1); PG8_STAGE(PG8_SA(0, 0), a2, voffA);
            PG8_BAR; PG8_WAIT_L(0); PG8_MMA(1, 0, At, B0); PG8_BAR; PG8_SCHED;
            PG8_STAGE(PG8_SB(0, 1), b2 + hstep, voffB);
            PG8_WAIT_V(6); PG8_BAR; PG8_MMA(1, 1, At, B1); PG8_BAR;
            PG8_LDB(B0, 1, 0); PG8_SCHED; PG8_LDA(At, 1, 0); PG8_STAGE(PG8_SA(0, 1), a2 + hstep, voffA);
            PG8_WAIT_L(8); PG8_BAR; PG8_WAIT_L(0); PG8_MMA(0, 0, At, B0); PG8_BAR; PG8_SCHED;
            PG8_LDB(B1, 1, 1); PG8_STAGE(PG8_SB(1, 0), b3, voffB);
            PG8_BAR; PG8_WAIT_L(0); PG8_MMA(0, 1, At, B1); PG8_BAR;
            PG8_LDA(At, 1, 1); PG8_STAGE(PG8_SA(1, 0), a3, voffA);
            PG8_BAR; PG8_WAIT_L(0); PG8_MMA(1, 0, At, B0); PG8_BAR; PG8_SCHED;
            PG8_STAGE(PG8_SB(1, 1), b3 + hstep, voffB);
            PG8_WAIT_V(6); PG8_BAR; PG8_MMA(1, 1, At, B1); PG8_BAR;
            }
        }
        if constexpr (ALIGN_EPI) { if (wr == 0) PG8_BAR; }
        if constexpr (!Epi::AFTER_DRAIN) { E(acc, cur, wr, wc, fr, fq); S.done(cur); }
        if (!has_next) break;
#pragma unroll
        for (int a = 0; a < 2; ++a)
#pragma unroll
            for (int b = 0; b < 2; ++b)
#pragma unroll
                for (int m = 0; m < 4; ++m)
#pragma unroll
                    for (int n = 0; n < 2; ++n) acc[a][b][m][n] = (f32x4){0.f, 0.f, 0.f, 0.f};
        cur = nxt; cA = nA; cB = nB; ++ui;
        if constexpr (ALIGN_EPI) { if (wr == 1) PG8_BAR; }
    }
    PG8_WAIT_V(0);
    if constexpr (!ALIGN_EPI) { if (wr == 0) PG8_BAR; }
    PG8_BAR;
    if constexpr (Epi::AFTER_DRAIN) { E.fused(acc, cur, wr, wc, fr, fq, lds, wid, lane); S.done(cur); }
#undef PG8_SA
#undef PG8_SB
#undef PG8_STAGE
#undef PG8_LDA
#undef PG8_LDB
#undef PG8_MMA
#undef PG8_WAIT_V
#undef PG8_WAIT_L
#undef PG8_BAR
#undef PG8_SCHED
}
}

template <class Epi>
DEV void gemm_tile(char* lds, const bf16_t* __restrict__ A, int lda, const bf16_t* __restrict__ Bt, int ldb, int K, int trow, int tcol,
                   const Epi& epi) {
  const int tid = threadIdx.x, w = tid >> 6, l = tid & 63, wm = w >> 1, wn = w & 1, lr = l & 15, lq = l >> 4;
  const bf16_t* ga[4];
  const bf16_t* gb[2];
#pragma unroll
  for (int j = 0; j < 4; ++j) {
    const int c = w * 4 + j, mt = c >> 1, sl = c & 1;
    ga[j] = A + (size_t)(mt * 16 + lr) * lda + sl * 32 + lq * 8;
  }
#pragma unroll
  for (int j = 0; j < 2; ++j) {
    const int nt = w, sl = j;
    const int rowb = (nt >> 2) * 64 + (lr >> 2) * 16 + (nt & 3) * 4 + (lr & 3);
    gb[j] = Bt + (size_t)rowb * ldb + sl * 32 + lq * 8;
  }
  f32x4 acc[4][4];
#pragma unroll
  for (int i = 0; i < 4; ++i)
#pragma unroll
    for (int j = 0; j < 4; ++j) acc[i][j] = (f32x4){0.f, 0.f, 0.f, 0.f};
  u32x4 ra[4], rb[2];
  const int nk = K >> 6;
#pragma unroll
  for (int j = 0; j < 4; ++j) ra[j] = *(const u32x4*)(ga[j]);
#pragma unroll
  for (int j = 0; j < 2; ++j) rb[j] = *(const u32x4*)(gb[j]);
#pragma unroll
  for (int j = 0; j < 4; ++j) *(u32x4*)(lds + (w * 4 + j) * 1024 + l * 16) = ra[j];
#pragma unroll
  for (int j = 0; j < 2; ++j) *(u32x4*)(lds + 32768 + (w * 2 + j) * 1024 + l * 16) = rb[j];
  __syncthreads();
  for (int kt = 0; kt < nk; ++kt) {
    char* cur = lds + (kt & 1) * 49152;
    const bool more = (kt + 1 < nk);
    if (more) {
#pragma unroll
      for (int j = 0; j < 4; ++j) ra[j] = *(const u32x4*)(ga[j] + (kt + 1) * 64);
#pragma unroll
      for (int j = 0; j < 2; ++j) rb[j] = *(const u32x4*)(gb[j] + (kt + 1) * 64);
    }
#pragma unroll
    for (int s = 0; s < 2; ++s) {
      bf16x8 af[4], bfr[4];
#pragma unroll
      for (int i = 0; i < 4; ++i) af[i] = *(const bf16x8*)(cur + ((wm * 4 + i) * 2 + s) * 1024 + l * 16);
#pragma unroll
      for (int j = 0; j < 4; ++j) bfr[j] = *(const bf16x8*)(cur + 32768 + ((wn * 4 + j) * 2 + s) * 1024 + l * 16);
#pragma unroll
      for (int i = 0; i < 4; ++i)
#pragma unroll
        for (int j = 0; j < 4; ++j) acc[i][j] = __builtin_amdgcn_mfma_f32_16x16x32_bf16(bfr[j], af[i], acc[i][j], 0, 0, 0);
    }
    if (more) {
      char* nxt = lds + ((kt + 1) & 1) * 49152;
#pragma unroll
      for (int j = 0; j < 4; ++j) *(u32x4*)(nxt + (w * 4 + j) * 1024 + l * 16) = ra[j];
#pragma unroll
      for (int j = 0; j < 2; ++j) *(u32x4*)(nxt + 32768 + (w * 2 + j) * 1024 + l * 16) = rb[j];
    }
    __syncthreads();
  }
#pragma unroll
  for (int i = 0; i < 4; ++i) epi(trow + wm * 64 + i * 16 + lr, tcol + wn * 64 + lq * 16, acc[i]);
}

DEV void store16_bf16(bf16_t* dst, const f32x4 (&v)[4], float sc) {
  u32x4 a, b;
  a.x = pk2(v[0][0] * sc, v[0][1] * sc); a.y = pk2(v[0][2] * sc, v[0][3] * sc);
  a.z = pk2(v[1][0] * sc, v[1][1] * sc); a.w = pk2(v[1][2] * sc, v[1][3] * sc);
  b.x = pk2(v[2][0] * sc, v[2][1] * sc); b.y = pk2(v[2][2] * sc, v[2][3] * sc);
  b.z = pk2(v[3][0] * sc, v[3][1] * sc); b.w = pk2(v[3][2] * sc, v[3][3] * sc);
  *(u32x4*)dst = a;
  *(u32x4*)(dst + 8) = b;
}

struct EpiBf16 {
  bf16_t* O; int ldo;
  DEV void operator()(int row, int col, const f32x4 (&v)[4]) const { store16_bf16(O + (size_t)row * ldo + col, v, 1.f); }
};
struct EpiF32 {
  float* O; int ldo;
  DEV void operator()(int row, int col, const f32x4 (&v)[4]) const {
    float* d = O + (size_t)row * ldo + col;
#pragma unroll
    for (int j = 0; j < 4; ++j) *(f32x4*)(d + 4 * j) = v[j];
  }
};
struct EpiLora1 {
  bf16_t* O;
  DEV void operator()(int row, int col, const f32x4 (&v)[4]) const {
    f32x4 o[4];
#pragma unroll
    for (int j = 0; j < 4; ++j)
#pragma unroll
      for (int r = 0; r < 4; ++r) {
        const float t = v[j][r];
        o[j][r] = (col < 128) ? tanhf(t) : ((col < 256) ? t : sigmoidf_(t));
      }
    store16_bf16(O + (size_t)row * 384 + col, o, 1.f);
  }
};
struct EpiDecay {
  bf16_t* O; const float* w0;
  DEV void operator()(int row, int col, const f32x4 (&v)[4]) const {
    f32x4 o[4];
#pragma unroll
    for (int j = 0; j < 4; ++j)
#pragma unroll
      for (int r = 0; r < 4; ++r) {
        const float xx = w0[col + 4 * j + r] + v[j][r];
        const float nx = -xx;
        const float sp = (nx > 20.f) ? nx : log1pf(expf(nx));
        const float e = expf(-sp - 0.5f);
        o[j][r] = -expm1f(-e);
      }
    store16_bf16(O + (size_t)row * 512 + col, o, 1.f);
  }
};
struct EpiA {
  bf16_t *KD, *KKA, *KK; const float *a0, *k_k, *k_a; const bf16_t* za; int writekk;
  DEV void operator()(int row, int col, const f32x4 (&v)[4]) const {
    const bf16_t* kp = za + (size_t)row * 2048 + 512 + col;
    const u32x4 k0 = *(const u32x4*)kp, k1 = *(const u32x4*)(kp + 8);
    float kf[16];
    kf[0] = lo16(k0.x); kf[1] = hi16(k0.x); kf[2] = lo16(k0.y); kf[3] = hi16(k0.y); kf[4] = lo16(k0.z); kf[5] = hi16(k0.z); kf[6] = lo16(k0.w); kf[7] = hi16(k0.w);
    kf[8] = lo16(k1.x); kf[9] = hi16(k1.x); kf[10] = lo16(k1.y); kf[11] = hi16(k1.y); kf[12] = lo16(k1.z); kf[13] = hi16(k1.z); kf[14] = lo16(k1.w); kf[15] = hi16(k1.w);
    float kr[16], ss = 0.f;
#pragma unroll
    for (int i = 0; i < 16; ++i) { kr[i] = kf[i] * k_k[col + i]; ss += kr[i] * kr[i]; }
    ss += __shfl_xor(ss, 16);
    ss += __shfl_xor(ss, 32);
    const float rn = rsqrtf(ss + 1e-12f);
    f32x4 okd[4], okka[4], okk[4];
#pragma unroll
    for (int j = 0; j < 4; ++j)
#pragma unroll
      for (int r = 0; r < 4; ++r) {
        const int i = 4 * j + r;
        const float a = sigmoidf_(a0[col + i] + v[j][r]);
        const float kk = kr[i] * rn;
        okd[j][r] = kf[i] * (1.f + (a - 1.f) * k_a[col + i]);
        okka[j][r] = kk * a;
        okk[j][r] = kk;
      }
    store16_bf16(KD + (size_t)row * 512 + col, okd, 1.f);
    store16_bf16(KKA + (size_t)row * 512 + col, okka, 1.f);
    if (writekk) store16_bf16(KK + (size_t)row * 512 + col, okk, 1.f);
  }
};
struct EpiDftc {
  bf16_t* CST; int g;
  DEV void operator()(int row, int col, const f32x4 (&v)[4]) const {
    const int b = col >> 12, s = col & 4095;
    store16_bf16(CST + ((size_t)(b * 1024 + g * 128 + (row & 127)) * 8192 + (row >> 7) * 4096 + s), v, 1.f);
  }
};

DEV void transpose_convert(char* lds, const float* __restrict__ W, int K, int N, bf16_t* __restrict__ Wt, int ldt, int rot) {
  float* tile = (float*)lds;
  const int tn_n = N >> 6, nt = (K >> 6) * tn_n, tid = threadIdx.x;
  for (int t = (blockIdx.x + rot) % gridDim.x; t < nt; t += gridDim.x) {
    const int tk = t / tn_n, tn = t % tn_n;
    for (int i = tid; i < 4096; i += NTHR) {
      const int r = i >> 6, cc = i & 63;
      tile[r * 65 + cc] = W[(size_t)(tk * 64 + r) * N + tn * 64 + cc];
    }
    __syncthreads();
    for (int i = tid; i < 4096; i += NTHR) {
      const int n = i >> 6, k = i & 63;
      Wt[(size_t)(tn * 64 + n) * ldt + tk * 64 + k] = f2bf(tile[k * 65 + n]);
    }
    __syncthreads();
  }
}

DEV void compute_mod(char* lds, const P& p) {
  float* cs = (float*)lds;
  float* red = (float*)(lds + 32768);
  const int tid = threadIdx.x;
  float* mod = (float*)(p.ws + W_MOD);
  bool have = false;
  for (int item = blockIdx.x; item < 192; item += gridDim.x) {
    if (!have) {
      for (int i = tid; i < 8192; i += NTHR) { const float cv = p.c[i]; cs[i] = cv / (1.f + expf(-cv)); }
      __syncthreads();
      have = true;
    }
    const int l = item / 96, cb = item % 96, col = cb * 64 + (tid & 63), kg = tid >> 6;
    float a0 = 0, a1 = 0, a2 = 0, a3 = 0, a4 = 0, a5 = 0, a6 = 0, a7 = 0;
    const float* wp = p.ada_w + ((size_t)l * 1024 + kg * 128) * 6144 + col;
    for (int k = 0; k < 128; ++k) {
      const float wv = wp[(size_t)k * 6144];
      const int kk = kg * 128 + k;
      a0 += cs[kk] * wv; a1 += cs[1024 + kk] * wv; a2 += cs[2048 + kk] * wv; a3 += cs[3072 + kk] * wv;
      a4 += cs[4096 + kk] * wv; a5 += cs[5120 + kk] * wv; a6 += cs[6144 + kk] * wv; a7 += cs[7168 + kk] * wv;
    }
    float* rp = red + kg * 512 + (tid & 63);
    rp[0] = a0; rp[64] = a1; rp[128] = a2; rp[192] = a3; rp[256] = a4; rp[320] = a5; rp[384] = a6; rp[448] = a7;
    __syncthreads();
    {
      const int b = tid >> 6, cc = tid & 63;
      float s = 0.f;
#pragma unroll
      for (int g = 0; g < 8; ++g) s += red[g * 512 + b * 64 + cc];
      mod[(size_t)(l * 8 + b) * 6144 + cb * 64 + cc] = s + p.ada_b[l * 6144 + cb * 64 + cc];
    }
    __syncthreads();
  }
}

template <bool HAS_Y, bool HAS_H>
DEV void rowpass(const float* __restrict__ xin, const float* __restrict__ yf, const float* __restrict__ gy, const float* __restrict__ gate,
                 float* __restrict__ xout, const float* __restrict__ gh, const float* __restrict__ sc, const float* __restrict__ sh,
                 bf16_t* __restrict__ h) {
  const int lane = threadIdx.x & 63, gw = blockIdx.x * 8 + (threadIdx.x >> 6), nw = gridDim.x * 8;
  for (int row = gw; row < MT; row += nw) {
    const int b = row >> 12;
    f32x4 xv[4];
#pragma unroll
    for (int i = 0; i < 4; ++i) xv[i] = *(const f32x4*)(xin + (size_t)row * 1024 + i * 256 + lane * 4);
    if (HAS_Y) {
      f32x4 yv[4];
      float ss = 0.f;
#pragma unroll
      for (int i = 0; i < 4; ++i) {
        yv[i] = *(const f32x4*)(yf + (size_t)row * 1024 + i * 256 + lane * 4);
        ss += yv[i][0] * yv[i][0] + yv[i][1] * yv[i][1] + yv[i][2] * yv[i][2] + yv[i][3] * yv[i][3];
      }
      ss = wave_sum(ss);
      const float rs = rsqrtf(ss * (1.f / 1024.f) + 1e-6f);
#pragma unroll
      for (int i = 0; i < 4; ++i) {
        const int col = i * 256 + lane * 4;
        const f32x4 g4 = *(const f32x4*)(gy + col), gt = *(const f32x4*)(gate + (size_t)b * 6144 + col);
        xv[i] = xv[i] + gt * (yv[i] * rs * g4);
        *(f32x4*)(xout + (size_t)row * 1024 + col) = xv[i];
      }
    }
    if (HAS_H) {
      float ss = 0.f;
#pragma unroll
      for (int i = 0; i < 4; ++i) ss += xv[i][0] * xv[i][0] + xv[i][1] * xv[i][1] + xv[i][2] * xv[i][2] + xv[i][3] * xv[i][3];
      ss = wave_sum(ss);
      const float rs = rsqrtf(ss * (1.f / 1024.f) + 1e-6f);
#pragma unroll
      for (int i = 0; i < 4; ++i) {
        const int col = i * 256 + lane * 4;
        const f32x4 g4 = *(const f32x4*)(gh + col), s4 = *(const f32x4*)(sc + (size_t)b * 6144 + col), h4 = *(const f32x4*)(sh + (size_t)b * 6144 + col);
        const f32x4 o = (xv[i] * rs * g4) * (s4 + 1.f) + h4;
        u32x2 pk;
        pk.x = pk2(o[0], o[1]); pk.y = pk2(o[2], o[3]);
        *(u32x2*)(h + (size_t)row * 1024 + col) = pk;
      }
    }
  }
}

DEV void unpack8(const u32x4 u, float (&f)[8]) {
  f[0] = lo16(u.x); f[1] = hi16(u.x); f[2] = lo16(u.y); f[3] = hi16(u.y); f[4] = lo16(u.z); f[5] = hi16(u.z); f[6] = lo16(u.w); f[7] = hi16(u.w);
}
DEV u32x4 pack8(const float (&f)[8]) {
  u32x4 u;
  u.x = pk2(f[0], f[1]); u.y = pk2(f[2], f[3]); u.z = pk2(f[4], f[5]); u.w = pk2(f[6], f[7]);
  return u;
}

DEV void prep1(const P& p) {
  const bf16_t* z = (const bf16_t*)(p.ws + O_Z);
  bf16_t* za = (bf16_t*)p.out;
  bf16_t* qr = (bf16_t*)(p.ws + O_QR);
  bf16_t* kr = (bf16_t*)(p.ws + O_KR);
  bf16_t* vt = (bf16_t*)(p.ws + O_VT);
  const float* rope = (const float*)(p.ws + W_ROPE);
  const int gt = blockIdx.x * NTHR + threadIdx.x, ngt = gridDim.x * NTHR;
  for (int idx = gt; idx < MT * 256; idx += ngt) {
    const int tok = idx >> 8, c8 = (idx & 255) * 8, s = tok & 4095;
    const bf16_t* zp = z + (size_t)tok * INC + c8;
    float zc[8], zm[8], zn[8], o[8];
    unpack8(*(const u32x4*)zp, zc);
    if (s > 0) unpack8(*(const u32x4*)(zp - INC), zm); else { for (int i = 0; i < 8; ++i) zm[i] = 0.f; }
    if (s < 4095) unpack8(*(const u32x4*)(zp + INC), zn); else { for (int i = 0; i < 8; ++i) zn[i] = 0.f; }
#pragma unroll
    for (int i = 0; i < 8; ++i) o[i] = zm[i] * p.mix_conv[c8 + i] + zc[i] * p.mix_conv[2048 + c8 + i] + zn[i] * p.mix_conv[4096 + c8 + i];
    *(u32x4*)(za + (size_t)tok * 2048 + c8) = pack8(o);
  }
  for (int idx = gt; idx < MT * 64; idx += ngt) {
    const int e8 = idx & 3, which = (idx >> 2) & 1, h = (idx >> 3) & 7, tok = idx >> 6, s = tok & 4095;
    const bf16_t* src = z + (size_t)tok * INC + 2048 + which * 512 + h * 64 + e8 * 8;
    float x1[8], x2[8], o1[8], o2[8];
    unpack8(*(const u32x4*)src, x1);
    unpack8(*(const u32x4*)(src + 32), x2);
    const float* rp = rope + ((size_t)s * 32 + e8 * 8) * 2;
    const float scl = which ? 1.f : 0.125f;
#pragma unroll
    for (int i = 0; i < 8; ++i) {
      const float cv = rp[2 * i], sv = rp[2 * i + 1];
      o1[i] = (x1[i] * cv - x2[i] * sv) * scl;
      o2[i] = (x2[i] * cv + x1[i] * sv) * scl;
    }
    bf16_t* dst = (which ? kr : qr) + (size_t)tok * 512 + h * 64 + e8 * 8;
    *(u32x4*)dst = pack8(o1);
    *(u32x4*)(dst + 32) = pack8(o2);
  }
  {
    const int lane = threadIdx.x & 63, gw = blockIdx.x * 8 + (threadIdx.x >> 6), nw = gridDim.x * 8;
    for (int item = gw; item < 3 * 4096; item += nw) {
      const int br = item >> 12, rem = item & 4095, b = rem >> 9, h = (rem >> 6) & 7, nb = rem & 63;
      const int dsh = 2 * br;
      const int Mr = 4096 >> dsh;
      const int pp = nb * 64 + lane, rsd = pp / Mr, m = pp % Mr, s = (m << dsh) + rsd;
      const bf16_t* src = z + (size_t)(b * 4096 + s) * INC + 3072 + h * 64;
      bf16_t* dst = vt + ((size_t)((br * 8 + b) * 8 + h) * 64) * 4096 + pp;
#pragma unroll
      for (int c = 0; c < 8; ++c) {
        const u32x4 u = *(const u32x4*)(src + c * 8);
        dst[(size_t)(c * 8 + 0) * 4096] = (bf16_t)(u.x & 0xffff); dst[(size_t)(c * 8 + 1) * 4096] = (bf16_t)(u.x >> 16);
        dst[(size_t)(c * 8 + 2) * 4096] = (bf16_t)(u.y & 0xffff); dst[(size_t)(c * 8 + 3) * 4096] = (bf16_t)(u.y >> 16);
        dst[(size_t)(c * 8 + 4) * 4096] = (bf16_t)(u.z & 0xffff); dst[(size_t)(c * 8 + 5) * 4096] = (bf16_t)(u.z >> 16);
        dst[(size_t)(c * 8 + 6) * 4096] = (bf16_t)(u.w & 0xffff); dst[(size_t)(c * 8 + 7) * 4096] = (bf16_t)(u.w >> 16);
      }
    }
  }
}

DEV void attention(const P& p) {
  const bf16_t* qr = (const bf16_t*)(p.ws + O_QR);
  const bf16_t* kr = (const bf16_t*)(p.ws + O_KR);
  const bf16_t* vt = (const bf16_t*)(p.ws + O_VT);
  float* num = (float*)(p.ws + O_NUM);
  float* md = (float*)(p.ws + O_MD);
  const int lane = threadIdx.x & 63, lr = lane & 15, lq = lane >> 4;
  const int gw = blockIdx.x * 8 + (threadIdx.x >> 6), nw = gridDim.x * 8;
  for (int item = gw; item < 3 * 4096 * 4; item += nw) {
    const int mt = item & 3, nb = (item >> 2) & 63, h = (item >> 8) & 7, b = (item >> 11) & 7, br = item >> 14;
    const int dsh = 2 * br, Mr = 4096 >> dsh;
    const int seg = (nb * 64) / Mr, segstart = seg * Mr, segend = segstart + Mr;
    const bool pv_ok = (nb * 64 - 64 >= segstart), nx_ok = (nb * 64 + 128 <= segend);
    const int qp = nb * 64 + mt * 16 + lr;
    const int qtok = b * 4096 + (((qp - segstart) << dsh) + seg);
    bf16x8 qf[2];
    qf[0] = *(const bf16x8*)(qr + (size_t)qtok * 512 + h * 64 + lq * 8);
    qf[1] = *(const bf16x8*)(qr + (size_t)qtok * 512 + h * 64 + 32 + lq * 8);
    f32x4 sacc[12];
#pragma unroll
    for (int kt = 0; kt < 12; ++kt) {
      const int kb = kt >> 2;
      int blk = nb + kb - 1;
      if ((kb == 0 && !pv_ok) || (kb == 2 && !nx_ok)) blk = nb;
      const int kp = blk * 64 + (kt & 3) * 16 + lr;
      const int ktok = b * 4096 + (((kp - segstart) << dsh) + seg);
      const bf16x8 k0 = *(const bf16x8*)(kr + (size_t)ktok * 512 + h * 64 + lq * 8);
      const bf16x8 k1 = *(const bf16x8*)(kr + (size_t)ktok * 512 + h * 64 + 32 + lq * 8);
      f32x4 a = (f32x4){0.f, 0.f, 0.f, 0.f};
      a = __builtin_amdgcn_mfma_f32_16x16x32_bf16(k0, qf[0], a, 0, 0, 0);
      a = __builtin_amdgcn_mfma_f32_16x16x32_bf16(k1, qf[1], a, 0, 0, 0);
      sacc[kt] = a;
    }
    const int qi = mt * 16 + lr;
    float mx = -1e30f;
#pragma unroll
    for (int kt = 0; kt < 12; ++kt) {
      const int kb = kt >> 2;
#pragma unroll
      for (int r = 0; r < 4; ++r) {
        const int kj = (kt & 3) * 16 + lq * 4 + r;
        bool ok = true;
        if (kb == 0) ok = pv_ok && (kj >= qi);
        if (kb == 2) ok = nx_ok && (kj <= qi);
        const float sv = ok ? sacc[kt][r] : -1e30f;
        sacc[kt][r] = sv;
        mx = fmaxf(mx, sv);
      }
    }
    mx = fmaxf(mx, __shfl_xor(mx, 16));
    mx = fmaxf(mx, __shfl_xor(mx, 32));
    float den = 0.f;
#pragma unroll
    for (int kt = 0; kt < 12; ++kt)
#pragma unroll
      for (int r = 0; r < 4; ++r) {
        const float pe = __expf(sacc[kt][r] - mx);
        sacc[kt][r] = pe;
        den += pe;
      }
    den += __shfl_xor(den, 16);
    den += __shfl_xor(den, 32);
    f32x4 oacc[4];
#pragma unroll
    for (int et = 0; et < 4; ++et) oacc[et] = (f32x4){0.f, 0.f, 0.f, 0.f};
    const bf16_t* vbase = vt + ((size_t)((br * 8 + b) * 8 + h) * 64) * 4096;
#pragma unroll
    for (int t = 0; t < 6; ++t) {
      const int kb = t >> 1;
      int blk = nb + kb - 1;
      if ((kb == 0 && !pv_ok) || (kb == 2 && !nx_ok)) blk = nb;
      const int kp0 = blk * 64 + ((2 * t) & 3) * 16 + lq * 4;
      const int kp1 = blk * 64 + ((2 * t + 1) & 3) * 16 + lq * 4;
      u32x4 pu;
      pu.x = pk2(sacc[2 * t][0], sacc[2 * t][1]); pu.y = pk2(sacc[2 * t][2], sacc[2 * t][3]);
      pu.z = pk2(sacc[2 * t + 1][0], sacc[2 * t + 1][1]); pu.w = pk2(sacc[2 * t + 1][2], sacc[2 * t + 1][3]);
      const bf16x8 pf = __builtin_bit_cast(bf16x8, pu);
#pragma unroll
      for (int et = 0; et < 4; ++et) {
        const bf16_t* vrow = vbase + (size_t)(et * 16 + lr) * 4096;
        const u32x2 v0 = *(const u32x2*)(vrow + kp0), v1 = *(const u32x2*)(vrow + kp1);
        u32x4 vu;
        vu.x = v0.x; vu.y = v0.y; vu.z = v1.x; vu.w = v1.y;
        oacc[et] = __builtin_amdgcn_mfma_f32_16x16x32_bf16(__builtin_bit_cast(bf16x8, vu), pf, oacc[et], 0, 0, 0);
      }
    }
    float* np = num + ((size_t)br * MT + qtok) * 512 + h * 64 + lq * 4;
#pragma unroll
    for (int et = 0; et < 4; ++et) *(f32x4*)(np + et * 16) = oacc[et];
    if (lq == 0) {
      f32x2 o;
      o.x = mx; o.y = den;
      *(f32x2*)(md + (((size_t)br * MT + qtok) * 8 + h) * 2) = o;
    }
  }
}

DEV void combineA(const P& p) {
  const float* num = (const float*)(p.ws + O_NUM);
  const float* md = (const float*)(p.ws + O_MD);
  bf16_t* ycat = (bf16_t*)(p.ws + O_YCAT);
  const int gt = blockIdx.x * NTHR + threadIdx.x, ngt = gridDim.x * NTHR;
  for (int idx = gt; idx < MT * 128; idx += ngt) {
    const int e4 = idx & 15, h = (idx >> 4) & 7, tok = idx >> 7;
    f32x2 m0 = *(const f32x2*)(md + (((size_t)0 * MT + tok) * 8 + h) * 2);
    f32x2 m1 = *(const f32x2*)(md + (((size_t)1 * MT + tok) * 8 + h) * 2);
    f32x2 m2 = *(const f32x2*)(md + (((size_t)2 * MT + tok) * 8 + h) * 2);
    const float ma = fmaxf(m0.x, fmaxf(m1.x, m2.x));
    const float e0 = __expf(m0.x - ma), e1 = __expf(m1.x - ma), e2 = __expf(m2.x - ma);
    const float dn = e0 * m0.y + e1 * m1.y + e2 * m2.y;
    const f32x4 n0 = *(const f32x4*)(num + ((size_t)0 * MT + tok) * 512 + h * 64 + e4 * 4);
    const f32x4 n1 = *(const f32x4*)(num + ((size_t)1 * MT + tok) * 512 + h * 64 + e4 * 4);
    const f32x4 n2 = *(const f32x4*)(num + ((size_t)2 * MT + tok) * 512 + h * 64 + e4 * 4);
    const f32x4 o = (n0 * e0 + n1 * e1 + n2 * e2) * (1.f / dn);
    u32x2 pk;
    pk.x = pk2(o[0], o[1]); pk.y = pk2(o[2], o[3]);
    *(u32x2*)(ycat + (size_t)tok * 1024 + 512 + h * 64 + e4 * 4) = pk;
  }
}

DEV float dpp_allreduce16(float x) {
  x += __int_as_float(__builtin_amdgcn_update_dpp(0, __float_as_int(x), 0xB1, 0xF, 0xF, true));
  x += __int_as_float(__builtin_amdgcn_update_dpp(0, __float_as_int(x), 0x4E, 0xF, 0xF, true));
  x += __int_as_float(__builtin_amdgcn_update_dpp(0, __float_as_int(x), 0x141, 0xF, 0xF, true));
  x += __int_as_float(__builtin_amdgcn_update_dpp(0, __float_as_int(x), 0x140, 0xF, 0xF, true));
  return x;
}

DEV void scan_phase(char* lds, const P& p) {
  const bf16_t* omw = (const bf16_t*)(p.ws + O_OMW);
  const bf16_t* kd = (const bf16_t*)(p.ws + O_KD);
  const bf16_t* kka = (const bf16_t*)(p.ws + O_KKA);
  const bf16_t* kk = (const bf16_t*)(p.ws + O_KK);
  const bf16_t* za = (const bf16_t*)p.out;
  float* Y = (float*)(p.ws + O_Y);
  float* inb = (float*)lds;
  float* ybuf = (float*)(lds + 98304);
  const int tid = threadIdx.x, w = tid >> 6, lane = tid & 63, rg = lane >> 4, jl = lane & 15, j0 = jl * 4;
  for (int it = blockIdx.x; it < 256; it += gridDim.x) {
    const int sc = it >> 1, half = it & 1, d = sc >> 6, b = (sc >> 3) & 7, h = sc & 7;
    const int rowl = w * 4 + rg, row = half * 32 + rowl;
    const bf16_t* src[3];
    int dsto[3], stepi[3], isw[3];
#pragma unroll
    for (int q = 0; q < 3; ++q) {
      const int pid = tid + q * NTHR, i = pid / 48, rem = pid % 48, arr = rem >> 3, pc = rem & 7;
      const bf16_t* base;
      size_t ld;
      if (arr == 0) { base = omw + (size_t)d * MT * 512 + h * 64; ld = 512; }
      else if (arr == 1) { base = kd + (size_t)d * MT * 512 + h * 64; ld = 512; }
      else if (arr == 2) { base = kka + (size_t)d * MT * 512 + h * 64; ld = 512; }
      else if (arr == 3) { base = kk + h * 64; ld = 512; }
      else if (arr == 4) { base = za + h * 64; ld = 2048; }
      else { base = za + 1024 + h * 64; ld = 2048; }
      const int t0 = d ? (4095 - i) : i;
      src[q] = base + ((size_t)(b * 4096 + t0)) * ld + pc * 8;
      stepi[q] = (int)ld * 32 * (d ? -1 : 1);
      dsto[q] = i * 384 + arr * 64 + pc * 8;
      isw[q] = (arr == 0);
    }
    float s0 = 0.f, s1 = 0.f, s2 = 0.f, s3 = 0.f;
    u32x4 rg_[3];
#pragma unroll
    for (int q = 0; q < 3; ++q) rg_[q] = *(const u32x4*)(src[q]);
#pragma unroll
    for (int q = 0; q < 3; ++q) {
      float f[8];
      unpack8(rg_[q], f);
      if (isw[q]) { for (int i = 0; i < 8; ++i) f[i] = 1.f - f[i]; }
      *(f32x4*)(inb + dsto[q]) = (f32x4){f[0], f[1], f[2], f[3]};
      *(f32x4*)(inb + dsto[q] + 4) = (f32x4){f[4], f[5], f[6], f[7]};
    }
    __syncthreads();
    for (int c = 0; c < 128; ++c) {
      const float* cur = inb + (c & 1) * 12288;
      float* yb = ybuf + (c & 1) * 1024;
      if (c + 1 < 128) {
#pragma unroll
        for (int q = 0; q < 3; ++q) rg_[q] = *(const u32x4*)(src[q] + (ptrdiff_t)stepi[q] * (c + 1));
      }
#pragma unroll 4
      for (int i = 0; i < 32; ++i) {
        const float* st = cur + i * 384;
        const f32x4 w4 = *(const f32x4*)(st + j0), kd4 = *(const f32x4*)(st + 64 + j0), ka4 = *(const f32x4*)(st + 128 + j0),
                    kk4 = *(const f32x4*)(st + 192 + j0), r4 = *(const f32x4*)(st + 256 + j0);
        const float v = st[320 + row];
        float sk = (s0 * kk4[0] + s1 * kk4[1]) + (s2 * kk4[2] + s3 * kk4[3]);
        sk = dpp_allreduce16(sk);
        s0 = s0 * w4[0] + (v * kd4[0] - sk * ka4[0]);
        s1 = s1 * w4[1] + (v * kd4[1] - sk * ka4[1]);
        s2 = s2 * w4[2] + (v * kd4[2] - sk * ka4[2]);
        s3 = s3 * w4[3] + (v * kd4[3] - sk * ka4[3]);
        float y = (s0 * r4[0] + s1 * r4[1]) + (s2 * r4[2] + s3 * r4[3]);
        y = dpp_allreduce16(y);
        if (jl == 0) yb[i * 32 + rowl] = y;
      }
      if (c + 1 < 128) {
        float* nb_ = inb + ((c + 1) & 1) * 12288;
#pragma unroll
        for (int q = 0; q < 3; ++q) {
          float f[8];
          unpack8(rg_[q], f);
          if (isw[q]) { for (int i = 0; i < 8; ++i) f[i] = 1.f - f[i]; }
          *(f32x4*)(nb_ + dsto[q]) = (f32x4){f[0], f[1], f[2], f[3]};
          *(f32x4*)(nb_ + dsto[q] + 4) = (f32x4){f[4], f[5], f[6], f[7]};
        }
      }
      __syncthreads();
      {
        const int idx = tid * 2, i = idx >> 5, rl = idx & 31;
        const int t = d ? (4095 - (c * 32 + i)) : (c * 32 + i);
        const f32x2 o = *(const f32x2*)(yb + idx);
        *(f32x2*)(Y + ((size_t)d * MT + b * 4096 + t) * 512 + h * 64 + half * 32 + rl) = o;
      }
    }
    __syncthreads();
  }
}

DEV void postB(const P& p) {
  const float* Y = (const float*)(p.ws + O_Y);
  const bf16_t* kd = (const bf16_t*)(p.ws + O_KD);
  const bf16_t* gg = (const bf16_t*)(p.ws + O_G);
  const bf16_t* za = (const bf16_t*)p.out;
  bf16_t* ycat = (bf16_t*)(p.ws + O_YCAT);
  const int lane = threadIdx.x & 63, gw = blockIdx.x * 8 + (threadIdx.x >> 6), nw = gridDim.x * 8;
  for (int item = gw; item < MT * 8; item += nw) {
    const int tok = item >> 3, h = item & 7, c = h * 64 + lane;
    const float y = Y[(size_t)tok * 512 + c] + Y[((size_t)MT + tok) * 512 + c];
    const float mu = wave_sum(y) * (1.f / 64.f);
    const float dv = y - mu;
    const float var = wave_sum(dv * dv) * (1.f / 64.f);
    const float yn = dv * rsqrtf(var + 64e-5f) * p.lnx_w[c] + p.lnx_b[c];
    const float r = bf2f(za[(size_t)tok * 2048 + c]), v = bf2f(za[(size_t)tok * 2048 + 1024 + c]);
    const float kds = bf2f(kd[(size_t)tok * 512 + c]) + bf2f(kd[((size_t)MT + tok) * 512 + c]);
    const float bon = wave_sum(r * kds * p.r_k[c]) * v;
    const float o = (yn + bon) * bf2f(gg[(size_t)tok * 512 + c]);
    ycat[(size_t)tok * 1024 + c] = f2bf(o);
  }
}

DEV void glu_pass(const P& p, int l) {
  const bf16_t* zf = (const bf16_t*)(p.ws + O_ZF);
  bf16_t* act = (bf16_t*)(p.ws + O_ACT);
  const float* cw = p.ffn_conv + (size_t)l * 3 * 5632;
  const int gt = blockIdx.x * NTHR + threadIdx.x, ngt = gridDim.x * NTHR;
  constexpr int RL = 16;
  for (int item = gt; item < (16384 / RL) * 352; item += ngt) {
    const int run = item / 352, c8 = (item - run * 352) * 8, row0 = run * RL, s0 = row0 & 4095;
    float wg0[8], wg1[8], wg2[8], wv0[8], wv1[8], wv2[8];
#pragma unroll
    for (int i = 0; i < 8; i += 4) {
      *(f32x4*)(wg0 + i) = *(const f32x4*)(cw + c8 + i); *(f32x4*)(wg1 + i) = *(const f32x4*)(cw + 5632 + c8 + i); *(f32x4*)(wg2 + i) = *(const f32x4*)(cw + 11264 + c8 + i);
      *(f32x4*)(wv0 + i) = *(const f32x4*)(cw + 2816 + c8 + i); *(f32x4*)(wv1 + i) = *(const f32x4*)(cw + 5632 + 2816 + c8 + i); *(f32x4*)(wv2 + i) = *(const f32x4*)(cw + 11264 + 2816 + c8 + i);
    }
    const bf16_t* zp = zf + (size_t)row0 * 5632 + c8;
    u32x4 pg = (u32x4){0u, 0u, 0u, 0u}, pv = pg;
    if (s0 > 0) { pg = *(const u32x4*)(zp - 5632); pv = *(const u32x4*)(zp - 5632 + 2816); }
    u32x4 cg_ = *(const u32x4*)zp, cv = *(const u32x4*)(zp + 2816);
#pragma unroll 4
    for (int r = 0; r < RL; ++r) {
      u32x4 ng = (u32x4){0u, 0u, 0u, 0u}, nv = ng;
      if (s0 + r < 4095) { ng = *(const u32x4*)(zp + (size_t)(r + 1) * 5632); nv = *(const u32x4*)(zp + (size_t)(r + 1) * 5632 + 2816); }
      float gm[8], gc[8], gn[8], vm[8], vc[8], vn[8], o[8];
      unpack8(pg, gm); unpack8(cg_, gc); unpack8(ng, gn); unpack8(pv, vm); unpack8(cv, vc); unpack8(nv, vn);
#pragma unroll
      for (int i = 0; i < 8; ++i) {
        const float g = gm[i] * wg0[i] + gc[i] * wg1[i] + gn[i] * wg2[i];
        const float vv = vm[i] * wv0[i] + vc[i] * wv1[i] + vn[i] * wv2[i];
        const float u2 = -1.5957691216057308f * (g + 0.044715f * g * g * g);
        const float ge = g * __builtin_amdgcn_rcpf(1.f + __expf(u2));
        o[i] = ge * vv;
      }
      *(u32x4*)(act + (size_t)(row0 + r) * 2816 + c8) = pack8(o);
      pg = cg_; pv = cv; cg_ = ng; cv = nv;
    }
  }
}

template <class Epi>
DEV void gemm_grid(char* lds, const bf16_t* A, int lda, const bf16_t* Bt, int ldb, int K, int tilesM, int tilesN, const Epi& epi) {
  const int nt = tilesM * tilesN;
  for (int t = blockIdx.x; t < nt; t += gridDim.x) {
    const int tm = t / tilesN, tn = t % tilesN;
    gemm_tile(lds, A + (size_t)tm * 256 * lda, lda, Bt + (size_t)tn * 128 * ldb, ldb, K, tm * 256, tn * 128, epi);
  }
}


#define LDSP ((PG8_LAS unsigned char*)lds)
template <class Epi>
DEV void pgemm(char* lds, const bf16_t* A, const bf16_t* Bt, int M_, int N_, int K_, const Epi& E) {
  pg8::Gemm g{A, Bt, M_, N_, K_};
  pg8::StaticOrder S;
  S.init(M_, N_, (int)gridDim.x, (int)blockIdx.x);
  pg8::gemm_phase<Epi, pg8::StaticOrder, true, true>(LDSP, g, S, E);
}

DEV void ffn(char* lds, const XcdBarrier& xbar, const P& p, int l) {
  const bf16_t* h = (const bf16_t*)(p.ws + O_H);
  bf16_t* zf = (bf16_t*)(p.ws + O_ZF);
  bf16_t* act = (bf16_t*)(p.ws + O_ACT);
  float* yf = (float*)(p.ws + O_YF);
  const bf16_t* upt = (const bf16_t*)(p.ws + W_UP) + (size_t)l * 5632 * 1024;
  const bf16_t* dnt = (const bf16_t*)(p.ws + W_DOWN) + (size_t)l * 1024 * 2816;
  for (int half = 0; half < 2; ++half) {
    pgemm(lds, h + (size_t)half * 16384 * 1024, upt, 16384, 5632, 1024, pg8::PEpiBf16<false>{zf, 5632});
    xcd_barrier(xbar);
    for (int rep_ = 0; rep_ < REP_GLU; ++rep_) { glu_pass(p, l); xcd_barrier(xbar); }
    pgemm(lds, act, dnt, 16384, 1024, 2816, pg8::PEpiF32{yf + (size_t)half * 16384 * 1024, 1024});
  }
  xcd_barrier(xbar);
}

__global__ void __launch_bounds__(NTHR) mega(P p) {
  extern __shared__ __attribute__((aligned(16))) char lds[];
  cg::grid_group grid = cg::this_grid();
  char* ws = p.ws;
  if (threadIdx.x < 4) ((unsigned*)(lds + 131072))[threadIdx.x] = 0u;
  __syncthreads();
  const XcdBarrier xbar = xcd_barrier_post((unsigned*)(ws + W_BAR), (volatile XLAS unsigned*)(lds + 131072));
  float* mod = (float*)(ws + W_MOD);
  const int gt = blockIdx.x * NTHR + threadIdx.x, ngt = gridDim.x * NTHR;

  compute_mod(lds, p);
  transpose_convert(lds, p.mix_in, 1024, 3584, (bf16_t*)(ws + W_MIXIN), 1024, 0);
  for (int l = 0; l < 2; ++l) {
    transpose_convert(lds, p.ffn_up + (size_t)l * 1024 * 5632, 1024, 5632, (bf16_t*)(ws + W_UP) + (size_t)l * 5632 * 1024, 1024, 64 * l);
    transpose_convert(lds, p.ffn_down + (size_t)l * 2816 * 1024, 2816, 1024, (bf16_t*)(ws + W_DOWN) + (size_t)l * 1024 * 2816, 2816, 128 + 64 * l);
  }
  transpose_convert(lds, p.mix_out, 1024, 1024, (bf16_t*)(ws + W_MIXOUT), 1024, 32);
  transpose_convert(lds, p.fnet_w, 1024, 1024, (bf16_t*)(ws + W_FNET), 1024, 96);
  for (int d = 0; d < 2; ++d) {
    transpose_convert(lds, p.w1 + (size_t)d * 512 * 64, 512, 64, (bf16_t*)(ws + W_L1) + (size_t)(d * 64) * 512, 512, 8 * d);
    transpose_convert(lds, p.a1 + (size_t)d * 512 * 64, 512, 64, (bf16_t*)(ws + W_L1) + (size_t)(128 + d * 64) * 512, 512, 16 + 8 * d);
    transpose_convert(lds, p.w2 + (size_t)d * 64 * 512, 64, 512, (bf16_t*)(ws + W_W2) + (size_t)d * 512 * 64, 64, 48 + 8 * d);
    transpose_convert(lds, p.a2 + (size_t)d * 64 * 512, 64, 512, (bf16_t*)(ws + W_A2) + (size_t)d * 512 * 64, 64, 64 + 8 * d);
  }
  transpose_convert(lds, p.g1, 512, 128, (bf16_t*)(ws + W_L1) + (size_t)256 * 512, 512, 32);
  transpose_convert(lds, p.g2, 128, 512, (bf16_t*)(ws + W_G2), 128, 80);
  {
    float* rope = (float*)(ws + W_ROPE);
    for (int idx = gt; idx < 4096 * 32; idx += ngt) {
      const int s = idx >> 5, e = idx & 31;
      const float inv = powf(10000.f, -(float)e / 32.f);
      const float ang = (float)s * inv;
      float sv, cv;
      sincosf(ang, &sv, &cv);
      rope[2 * idx] = cv;
      rope[2 * idx + 1] = sv;
    }
    bf16_t* dftc = (bf16_t*)(ws + W_DFTC);
    for (int idx = gt; idx < 256 * 128; idx += ngt) {
      const int n = idx >> 7, c = idx & 127, k2 = n & 127;
      const float ph = (float)((k2 * c) & 127) * (1.f / 64.f);
      const float v = (n < 128) ? cospif(ph) : sinpif(ph);
      dftc[idx] = f2bf(v * 0.08838834764831845f);
    }
  }
  grid.sync();
  for (int rep_ = 0; rep_ < REP_ROW; ++rep_) { rowpass<false, true>(p.x, nullptr, nullptr, nullptr, nullptr, p.norm_g, mod + 1024, mod, (bf16_t*)(ws + O_H0)); xcd_barrier(xbar); }
  pgemm(lds, (const bf16_t*)(ws + O_H0), (const bf16_t*)(ws + W_MIXIN), MT, INC, 1024, pg8::PEpiBf16<false>{(bf16_t*)(ws + O_Z), INC});
  xcd_barrier(xbar);
  for (int rep_ = 0; rep_ < REP_PREP; ++rep_) { prep1(p); xcd_barrier(xbar); }
  for (int rep_ = 0; rep_ < REP_ATT; ++rep_) { attention(p); xcd_barrier(xbar); }
  combineA(p);
  gemm_grid(lds, (const bf16_t*)p.out + 1536, 2048, (const bf16_t*)(ws + W_L1), 512, 512, 128, 3, EpiLora1{(bf16_t*)(ws + O_L1)});
  xcd_barrier(xbar);
  for (int d = 0; d < 2; ++d) {
    gemm_grid(lds, (const bf16_t*)(ws + O_L1) + d * 64, 384, (const bf16_t*)(ws + W_W2) + (size_t)d * 512 * 64, 64, 64, 128, 4,
              EpiDecay{(bf16_t*)(ws + O_OMW) + (size_t)d * MT * 512, p.w0 + d * 512});
    gemm_grid(lds, (const bf16_t*)(ws + O_L1) + 128 + d * 64, 384, (const bf16_t*)(ws + W_A2) + (size_t)d * 512 * 64, 64, 64, 128, 4,
              EpiA{(bf16_t*)(ws + O_KD) + (size_t)d * MT * 512, (bf16_t*)(ws + O_KKA) + (size_t)d * MT * 512, (bf16_t*)(ws + O_KK), p.a0 + d * 512,
                   p.k_k, p.k_a, (const bf16_t*)p.out, d == 0});
  }
  gemm_grid(lds, (const bf16_t*)(ws + O_L1) + 256, 384, (const bf16_t*)(ws + W_G2), 128, 128, 128, 4, EpiBf16{(bf16_t*)(ws + O_G), 512});
  xcd_barrier(xbar);
  for (int rep_ = 0; rep_ < REP_SCAN; ++rep_) { scan_phase(lds, p); xcd_barrier(xbar); }
  for (int rep_ = 0; rep_ < REP_SYNC; ++rep_) xcd_barrier(xbar);
  postB(p);
  xcd_barrier(xbar);
  pgemm(lds, (const bf16_t*)(ws + O_YCAT), (const bf16_t*)(ws + W_MIXOUT), MT, 1024, 1024, pg8::PEpiF32{(float*)(ws + O_YF), 1024});
  xcd_barrier(xbar);
  rowpass<true, true>(p.x, (const float*)(ws + O_YF), p.norm_g + 1024, mod + 2048, p.out, p.norm_g + 2048, mod + 4096, mod + 3072, (bf16_t*)(ws + O_H));
  xcd_barrier(xbar);
  ffn(lds, xbar, p, 0);
  {
    const float* mod1 = mod + 8 * 6144;
    rowpass<true, true>(p.out, (const float*)(ws + O_YF), p.norm_g + 3072, mod + 5120, p.out, p.norm_g + 4096, mod1 + 1024, mod1, (bf16_t*)(ws + O_H));
    bf16_t* cs = (bf16_t*)(ws + O_COSSIN);
    for (int idx = gt; idx < 4096 * 1024; idx += ngt) {
      const int k1 = idx >> 10, k8 = (idx & 1023) * 8;
      float o[8];
#pragma unroll
      for (int i = 0; i < 8; ++i) {
        const int kk = k8 + i, s = kk & 4095;
        const float ph = (float)((k1 * s) & 4095) * (1.f / 2048.f);
        o[i] = ((kk < 4096) ? cospif(ph) : -sinpif(ph)) * (1.f / 64.f);
      }
      *(u32x4*)(cs + (size_t)k1 * 8192 + k8) = pack8(o);
    }
    xcd_barrier(xbar);
    for (int t = blockIdx.x; t < 8 * 256; t += gridDim.x) {
      const int g = t >> 8, tn = t & 255;
      gemm_tile(lds, (const bf16_t*)(ws + W_DFTC), 128, (const bf16_t*)(ws + O_H) + (size_t)tn * 128 * 1024 + g * 128, 1024, 128, 0, tn * 128,
                EpiDftc{(bf16_t*)(ws + O_CST), g});
    }
    xcd_barrier(xbar);
    {
      pg8::Gemm g{(const bf16_t*)(ws + O_COSSIN), (const bf16_t*)(ws + O_CST), 4096, 8192, 8192};
      pg8::BatchOrder S{(int)gridDim.x, (int)blockIdx.x};
      pg8::gemm_phase<pg8::PEpiBf16<true>, pg8::BatchOrder, true, true>(LDSP, g, S, pg8::PEpiBf16<true>{(bf16_t*)(ws + O_F), 1024});
    }
    xcd_barrier(xbar);
    pgemm(lds, (const bf16_t*)(ws + O_F), (const bf16_t*)(ws + W_FNET), MT, 1024, 1024, pg8::PEpiF32{(float*)(ws + O_YF), 1024});
    xcd_barrier(xbar);
    rowpass<true, true>(p.out, (const float*)(ws + O_YF), p.norm_g + 4096 + 1024, mod1 + 2048, p.out, p.norm_g + 4096 + 2048, mod1 + 4096, mod1 + 3072,
                        (bf16_t*)(ws + O_H));
    xcd_barrier(xbar);
    ffn(lds, xbar, p, 1);
    rowpass<true, false>(p.out, (const float*)(ws + O_YF), p.norm_g + 4096 + 3072, mod1 + 5120, p.out, nullptr, nullptr, nullptr, nullptr);
  }
}

extern "C" void kernel_launch(void* const* d_in, const int* in_sizes, int n_in, void* d_out, int out_size, void* d_ws, size_t ws_size,
                              hipStream_t stream) {
  static int grid_blocks = 0;
  if (!grid_blocks) {
    int dev = 0, cus = 0, per_cu = 0;
    hipGetDevice(&dev);
    hipDeviceGetAttribute(&cus, hipDeviceAttributeMultiprocessorCount, dev);
    hipFuncSetAttribute((const void*)mega, hipFuncAttributeMaxDynamicSharedMemorySize, LDS_BYTES);
    hipOccupancyMaxActiveBlocksPerMultiprocessor(&per_cu, (const void*)mega, NTHR, LDS_BYTES);
    if (per_cu < 1) { fprintf(stderr, "occupancy query returned %d\n", per_cu); per_cu = 1; }
    if (per_cu > 1) per_cu = 1;
    grid_blocks = cus * per_cu;
  }
  P p{};
  const float** pp = (const float**)&p;
  for (int i = 0; i < 25; ++i) pp[i] = (const float*)d_in[i];
  p.out = (float*)d_out;
  p.ws = (char*)d_ws;
  (void)hipMemsetAsync((char*)d_ws + W_BAR, 0, XCD_BAR_WORDS * sizeof(unsigned), stream);
  void* args[] = {&p};
  hipError_t e = hipLaunchCooperativeKernel((const void*)mega, dim3(grid_blocks), dim3(NTHR), args, LDS_BYTES, stream);
  if (e != hipSuccess) fprintf(stderr, "cooperative launch failed: %s (grid %d)\n", hipGetErrorString(e), grid_blocks);
}
```

```cpp
#include <hip/hip_runtime.h>
#include <hip/hip_cooperative_groups.h>
#include <stdint.h>
#include <cstdio>
namespace cg = cooperative_groups;

typedef unsigned short bf16_t;
typedef short bf16x8 __attribute__((ext_vector_type(8)));
typedef short s16x4 __attribute__((ext_vector_type(4)));
typedef float f32x4 __attribute__((ext_vector_type(4)));
typedef float f32x2 __attribute__((ext_vector_type(2)));
typedef unsigned u32x4 __attribute__((ext_vector_type(4)));
typedef unsigned u32x2 __attribute__((ext_vector_type(2)));

#define DEV __device__ __forceinline__

constexpr int NB = 8, SEQ = 4096, DM = 1024, MT = NB * SEQ, DFF = 2816, INC = 3584;
constexpr size_t MiB = 1024 * 1024;
constexpr int NTHR = 512;
constexpr int LDS_BYTES = 131072 + 16;
constexpr size_t W_BAR = 47 * 1024 * 1024;
#ifndef REP_SCAN
#define REP_SCAN 1
#endif
#ifndef REP_ATT
#define REP_ATT 1
#endif
#ifndef REP_SYNC
#define REP_SYNC 0
#endif
#ifndef REP_PREP
#define REP_PREP 1
#endif
#ifndef REP_LORA
#define REP_LORA 1
#endif
#ifndef REP_GLU
#define REP_GLU 1
#endif
#ifndef REP_PRO
#define REP_PRO 1
#endif
#ifndef REP_ROW
#define REP_ROW 1
#endif

constexpr size_t W_MIXIN = 0;
constexpr size_t W_UP = 7 * MiB;
constexpr size_t W_DOWN = 29 * MiB;
constexpr size_t W_MIXOUT = 40 * MiB;
constexpr size_t W_FNET = 42 * MiB;
constexpr size_t W_L1 = 44 * MiB;
constexpr size_t W_W2 = W_L1 + 512 * 1024;
constexpr size_t W_A2 = W_W2 + 128 * 1024;
constexpr size_t W_G2 = W_A2 + 128 * 1024;
constexpr size_t W_DFTC = W_G2 + 128 * 1024;
constexpr size_t W_MOD = 45 * MiB;
constexpr size_t W_ROPE = 46 * MiB;
constexpr size_t R0 = 48 * MiB;
constexpr size_t O_H0 = R0;
constexpr size_t O_Z = 112 * MiB;
constexpr size_t O_QR = 336 * MiB, O_KR = 368 * MiB, O_VT = 400 * MiB;
constexpr size_t O_NUM = R0;
constexpr size_t O_MD = 240 * MiB;
constexpr size_t O_YCAT = 448 * MiB;
constexpr size_t O_OMW = 48 * MiB, O_KD = 112 * MiB, O_KKA = 176 * MiB, O_KK = 240 * MiB, O_G = 272 * MiB, O_L1 = 304 * MiB, O_Y = 304 * MiB;
constexpr size_t O_YF = 48 * MiB;
constexpr size_t O_H = 176 * MiB;
constexpr size_t O_ZF = 240 * MiB;
constexpr size_t O_ACT = 416 * MiB;
constexpr size_t O_COSSIN = 240 * MiB;
constexpr size_t O_CST = 304 * MiB;
constexpr size_t O_F = 432 * MiB;

struct P {
  const float *x, *c, *ada_w, *ada_b, *norm_g, *mix_in, *mix_conv, *w0, *w1, *w2, *a0, *a1, *a2, *g1, *g2, *k_k, *k_a, *r_k, *lnx_w,
      *lnx_b, *mix_out, *fnet_w, *ffn_up, *ffn_conv, *ffn_down;
  float* out;
  char* ws;
};

DEV float bf2f(bf16_t h) { return __uint_as_float(((unsigned)h) << 16); }
DEV bf16_t f2bf(float f) {
  unsigned u = __float_as_uint(f);
  u += 0x7fffu + ((u >> 16) & 1u);
  return (bf16_t)(u >> 16);
}
DEV unsigned pk2(float a, float b) { return (unsigned)f2bf(a) | ((unsigned)f2bf(b) << 16); }
DEV float lo16(unsigned u) { return __uint_as_float(u << 16); }
DEV float hi16(unsigned u) { return __uint_as_float(u & 0xffff0000u); }
DEV float wave_sum(float v) {
#pragma unroll
  for (int o = 32; o; o >>= 1) v += __shfl_xor(v, o);
  return v;
}
DEV float sigmoidf_(float x) { return __builtin_amdgcn_rcpf(1.f + __expf(-x)); }

#include <cstdint>
#include <cstdlib>
#include <vector>

#define XB_TMO      128
#define XB_XCNT(j)  (256  + 64 * (j))
#define XB_XSUB(j)  (1280 + 64 * (j))
#define XB_XGEN(j)  (2304 + 64 * (j))
#define XB_TOP      3328
#define XB_TOPGEN   3392
#define XCD_BAR_WORDS 3456
#define XB_SPIN_CAP (1u << 18)
#define XLAS __attribute__((address_space(3)))

__device__ __forceinline__ unsigned xb_ld(unsigned* p)              { return __hip_atomic_load(p, __ATOMIC_RELAXED, __HIP_MEMORY_SCOPE_AGENT); }
__device__ __forceinline__ unsigned xb_add(unsigned* p, unsigned v) { return __hip_atomic_fetch_add(p, v, __ATOMIC_RELAXED, __HIP_MEMORY_SCOPE_AGENT); }
__device__ __forceinline__ unsigned xb_xcc_id() { return (unsigned)__builtin_amdgcn_s_getreg((3 << 11) | 20) & 0xFu; }
#define XB_SPIN(cond, bar) do { unsigned _sp = 0; while (cond) { __builtin_amdgcn_s_sleep(1); \
    if ((++_sp & 255u) == 0u) { if (xb_ld(&(bar)[XB_TMO])) break; if (_sp > XB_SPIN_CAP) { atomicAdd(&(bar)[XB_TMO], 1u); break; } } } } while (0)

struct XcdBarrier {
    unsigned* bar; unsigned x;
    volatile XLAS unsigned* st;
};

__device__ __forceinline__ XcdBarrier xcd_barrier_post(unsigned* bar, volatile XLAS unsigned* st) {
    XcdBarrier b; b.bar = bar; b.x = xb_xcc_id(); b.st = st;
    if (threadIdx.x == 0) (void)xb_add(&bar[XB_XCNT(b.x)], 1u);
    return b;
}
__device__ __forceinline__ void xcd_barrier_complete(unsigned* bar, unsigned x, unsigned& nloc, unsigned& nx) {
    const unsigned G = gridDim.x * gridDim.y * gridDim.z;
    unsigned sum, cnt, mine, sp = 0u;
    for (;;) {
        sum = 0u; cnt = 0u; mine = 0u;
#pragma unroll
        for (unsigned j = 0; j < 16; ++j) { const unsigned c = xb_ld(&bar[XB_XCNT(j)]); sum += c; cnt += (c > 0u) ? 1u : 0u; mine = (j == x) ? c : mine; }
        if (sum == G) break;
        __builtin_amdgcn_s_sleep(1);
        if ((++sp & 255u) == 0u) { if (xb_ld(&bar[XB_TMO])) break; if (sp > XB_SPIN_CAP) { atomicAdd(&bar[XB_TMO], 1u); break; } }
    }
    nloc = mine > 0u ? mine : 1u; nx = cnt > 0u ? cnt : 1u;
}

__device__ __forceinline__ void xcd_barrier(const XcdBarrier& b) {
    asm volatile("s_waitcnt vmcnt(0)" ::: "memory");
    __syncthreads();
    if (threadIdx.x == 0) {
        unsigned* bar = b.bar;
        __builtin_amdgcn_s_waitcnt(0);
        unsigned nloc = b.st[0], nx = b.st[1];
        if (nloc == 0u) { xcd_barrier_complete(bar, b.x, nloc, nx); b.st[0] = nloc; b.st[1] = nx; }
        const unsigned old = xb_add(&bar[XB_XSUB(b.x)], 1u);
        const unsigned gen = old / nloc;
        if (old + 1u == (gen + 1u) * nloc) {
            __builtin_amdgcn_fence(__ATOMIC_RELEASE, "agent");
            asm volatile("s_waitcnt vmcnt(0)" ::: "memory");
            const unsigned og = xb_add(&bar[XB_TOP], 1u);
            const unsigned tg = og / nx;
            if (og + 1u == (tg + 1u) * nx) xb_add(&bar[XB_TOPGEN], 1u);
            else XB_SPIN(xb_ld(&bar[XB_TOPGEN]) == tg, bar);
            __builtin_amdgcn_fence(__ATOMIC_ACQUIRE, "agent");
            xb_add(&bar[XB_XGEN(b.x)], 1u);
            asm volatile("s_waitcnt vmcnt(0)" ::: "memory");
        } else {
            XB_SPIN(xb_ld(&bar[XB_XGEN(b.x)]) == gen, bar);
            __builtin_amdgcn_fence(__ATOMIC_ACQUIRE, "agent");
            asm volatile("s_waitcnt vmcnt(0)" ::: "memory");
        }
    }
    __syncthreads();
}

namespace pg8 {
#define PG8_LAS __attribute__((address_space(3)))
typedef unsigned short bf16_t;
typedef short bf16x8 __attribute__((ext_vector_type(8)));
typedef float f32x4 __attribute__((ext_vector_type(4)));
typedef unsigned u32x4 __attribute__((ext_vector_type(4)));
constexpr int BM = 256, BK = 64, HALF = 128, HTB = HALF * BK * 2  , STAGE_BYTES = 8 * HTB, NXCD = 8, WGM = 8;

__host__ __device__ __forceinline__ int lds_byte(int r, int c) { const int st = (r >> 4) * 2 + (c >> 5), rr = r & 15, cc = c & 31, ob = rr * 64 + cc * 2; return st * 1024 + (ob ^ (((ob >> 9) & 1) << 5)); }
__host__ __device__ __forceinline__ void stage_rc(int b, int& R, int& C) { const int st = b / 1024, sb = b % 1024, swz = sb ^ (((sb >> 9) & 1) << 5); R = (st >> 1) * 16 + swz / 64; C = (st & 1) * 32 + (swz % 64) / 2; }
__host__ __device__ __forceinline__ int perm32(int rho) { const int n = rho >> 4, i = rho & 15; return 8 * (i >> 2) + 4 * n + (i & 3); }

struct Unit { int pm, pn; };
struct Gemm { const bf16_t* A; const bf16_t* Bt; int M, N, K; };

struct StaticOrder {
    int nM, nN, nwg, G, c;
    __host__ __device__ void init(int M, int N, int G_, int c_) { nM = M / BM; nN = N / BM; nwg = nM * nN; G = G_; c = c_; }
    __host__ __device__ bool next(int i, Unit& u) const {
        const long L = (long)i * G + c; if (L >= nwg) return false;
        int wgid = (int)L; { const int q = nwg / NXCD, r = nwg % NXCD, xcd = wgid % NXCD, off = wgid / NXCD; wgid = (xcd < r ? xcd * (q + 1) : r * (q + 1) + (xcd - r) * q) + off; }
        const int nig = WGM * nN, gid = wgid / nig, fm = gid * WGM, gsz = (nM - fm) < WGM ? (nM - fm) : WGM;
        u.pm = fm + ((wgid % nig) % gsz); u.pn = (wgid % nig) / gsz; return true;
    }
    __device__ __forceinline__ void a_ready(const Unit&) const {}
    __device__ __forceinline__ void done(const Unit&) const {}
};

__device__ __forceinline__ unsigned cvt_pk_bf16(float lo, float hi) { unsigned r; asm volatile("v_cvt_pk_bf16_f32 %0, %1, %2" : "=v"(r) : "v"(lo), "v"(hi)); return r; }

template <bool BATCHED> struct PEpiBf16 {
    static constexpr bool PERM = true, AFTER_DRAIN = false;
    bf16_t* O; int ldc;
    __device__ __forceinline__ void operator()(const f32x4 (&acc)[2][2][4][2], const Unit& u, int wr, int wc, int fr, int fq) const {
        const int rb = BATCHED ? ((u.pn >> 2) * 4096 + u.pm * 256) : u.pm * 256, cb = BATCHED ? (u.pn & 3) * 256 : u.pn * 256;
        const int row0 = rb + wr * 64 + fr, col0 = cb + wc * 32 + 8 * fq;
#pragma unroll
        for (int ai = 0; ai < 2; ++ai)
#pragma unroll
            for (int m = 0; m < 4; ++m) { bf16_t* rowp = O + (size_t)(row0 + ai * HALF + m * 16) * ldc + col0;
#pragma unroll
                for (int bj = 0; bj < 2; ++bj) { const f32x4 v0 = acc[ai][bj][m][0], v1 = acc[ai][bj][m][1];
                    u32x4 w; w.x = cvt_pk_bf16(v0[0], v0[1]); w.y = cvt_pk_bf16(v0[2], v0[3]); w.z = cvt_pk_bf16(v1[0], v1[1]); w.w = cvt_pk_bf16(v1[2], v1[3]);
                    *(u32x4*)(rowp + bj * HALF) = w; } }
    }
};
struct PEpiF32 {
    static constexpr bool PERM = true, AFTER_DRAIN = false;
    float* O; int ldc;
    __device__ __forceinline__ void operator()(const f32x4 (&acc)[2][2][4][2], const Unit& u, int wr, int wc, int fr, int fq) const {
        const int row0 = u.pm * 256 + wr * 64 + fr, col0 = u.pn * 256 + wc * 32 + 8 * fq;
#pragma unroll
        for (int ai = 0; ai < 2; ++ai)
#pragma unroll
            for (int m = 0; m < 4; ++m) { float* rowp = O + (size_t)(row0 + ai * HALF + m * 16) * ldc + col0;
#pragma unroll
                for (int bj = 0; bj < 2; ++bj) { *(f32x4*)(rowp + bj * HALF) = acc[ai][bj][m][0]; *(f32x4*)(rowp + bj * HALF + 4) = acc[ai][bj][m][1]; } }
    }
};
struct BatchOrder {
    int G, c;
    __device__ __forceinline__ bool next(int i, Unit& u) const { const int L = i * G + c; if (L >= 512) return false; const int b = L >> 6, r = L & 63; u.pm = r >> 2; u.pn = b * 4 + (r & 3); return true; }
    __device__ __forceinline__ void a_ready(const Unit&) const {}
    __device__ __forceinline__ void done(const Unit&) const {}
};
template <class Epi, class Sched, bool ALIGN_EPI = false, bool SP2 = false>
__device__ __forceinline__ void gemm_phase(PG8_LAS unsigned char* lds, const Gemm g, const Sched& S, const Epi& E) {
    int tid_ = threadIdx.x; asm volatile("" : "+v"(tid_));
    const int tid = tid_, wid = __builtin_amdgcn_readfirstlane(tid >> 6), lane = tid & 63, wr = wid >> 2, wc = wid & 3, fr = lane & 15, fq = lane >> 4;
    const int K = g.K, nt = K / BK;
    unsigned voffA[2], voffB[2];
#pragma unroll
    for (int i = 0; i < 2; ++i) { int R, C; stage_rc(tid * 16 + i * 8192, R, C); const int Rb = Epi::PERM ? ((R & ~31) + perm32(R & 31)) : R;
        voffA[i] = (unsigned)(R * K + C) * 2u; voffB[i] = (unsigned)(Rb * K + C) * 2u; }
    const size_t kstep = (size_t)(BK * 2);
    const size_t hstep = (size_t)HALF * K * 2;
    const size_t tstep = 2 * hstep;
    const unsigned ldsw = (unsigned)wid * 1024u;
    const int aoff = lds_byte(wr * 64 + fr, fq * 8), boff = lds_byte(wc * 32 + fr, fq * 8);
#define PG8_SA(b, h) (((b) * 2 + (h)) * HTB)
#define PG8_SB(b, h) ((4 + (b) * 2 + (h)) * HTB)
#define PG8_STAGE(bufoff, gbase, voff) do { _Pragma("unroll") for (int _i = 0; _i < 2; ++_i) \
        __builtin_amdgcn_global_load_lds((const unsigned*)((const char*)(gbase) + (voff)[_i]), (PG8_LAS unsigned*)(lds + (bufoff) + ldsw + _i * 8192), 16, 0, 0); } while (0)
#define PG8_LDA(dst, b, h) do { _Pragma("unroll") for (int m = 0; m < 4; ++m) _Pragma("unroll") for (int k = 0; k < 2; ++k) dst[m][k] = *(const PG8_LAS bf16x8*)(lds + PG8_SA(b, h) + aoff + m * 2048 + k * 1024); } while (0)
#define PG8_LDB(dst, b, h) do { _Pragma("unroll") for (int n = 0; n < 2; ++n) _Pragma("unroll") for (int k = 0; k < 2; ++k) dst[n][k] = *(const PG8_LAS bf16x8*)(lds + PG8_SB(b, h) + boff + n * 2048 + k * 1024); } while (0)
#define PG8_MMA(ai, bj, At, Bt) do { __builtin_amdgcn_s_setprio(1); _Pragma("unroll") for (int m = 0; m < 4; ++m) _Pragma("unroll") for (int n = 0; n < 2; ++n) _Pragma("unroll") for (int k = 0; k < 2; ++k) \
        acc[ai][bj][m][n] = __builtin_amdgcn_mfma_f32_16x16x32_bf16(Bt[n][k], At[m][k], acc[ai][bj][m][n], 0, 0, 0); __builtin_amdgcn_s_setprio(0); } while (0)
#define PG8_WAIT_V(n) asm volatile("s_waitcnt vmcnt(" #n ")" ::: "memory")
#define PG8_WAIT_L(n) asm volatile("s_waitcnt lgkmcnt(" #n ")" ::: "memory")
#define PG8_BAR __builtin_amdgcn_s_barrier()
#define PG8_SCHED __builtin_amdgcn_sched_barrier(0)
    Unit cur, nxt; int ui = 0;
    if (!S.next(0, cur)) return;
    f32x4 acc[2][2][4][2];
#pragma unroll
    for (int a = 0; a < 2; ++a)
#pragma unroll
        for (int b = 0; b < 2; ++b)
#pragma unroll
            for (int m = 0; m < 4; ++m)
#pragma unroll
                for (int n = 0; n < 2; ++n) acc[a][b][m][n] = (f32x4){0.f, 0.f, 0.f, 0.f};
    bf16x8 At[4][2], B0[2][2], B1[2][2];
    const char* cA = (const char*)g.A + (size_t)cur.pm * tstep; const char* cB = (const char*)g.Bt + (size_t)cur.pn * tstep;
    S.a_ready(cur);
    if constexpr (SP2) {
        PG8_STAGE(PG8_SB(0, 0), cB, voffB); PG8_STAGE(PG8_SB(0, 1), cB + hstep, voffB); PG8_STAGE(PG8_SA(0, 0), cA, voffA); PG8_STAGE(PG8_SA(0, 1), cA + hstep, voffA);
        if (wr == 1) PG8_BAR;
        PG8_WAIT_V(2); PG8_BAR;
        PG8_STAGE(PG8_SB(1, 0), cB + kstep, voffB); PG8_STAGE(PG8_SA(1, 0), cA + kstep, voffA); PG8_STAGE(PG8_SB(1, 1), cB + hstep + kstep, voffB);
        PG8_WAIT_V(6); PG8_BAR;
    } else {
        PG8_STAGE(PG8_SB(0, 0), cB, voffB); PG8_STAGE(PG8_SA(0, 0), cA, voffA); PG8_STAGE(PG8_SB(0, 1), cB + hstep, voffB); PG8_STAGE(PG8_SA(0, 1), cA + hstep, voffA);
        if (wr == 1) PG8_BAR;
        PG8_WAIT_V(4); PG8_BAR;
        PG8_STAGE(PG8_SB(1, 0), cB + kstep, voffB); PG8_STAGE(PG8_SA(1, 0), cA + kstep, voffA); PG8_STAGE(PG8_SB(1, 1), cB + hstep + kstep, voffB);
        PG8_WAIT_V(6); PG8_BAR;
    }
    for (;;) {
        const bool has_next = S.next(ui + 1, nxt);
        const char* nA = has_next ? (const char*)g.A + (size_t)nxt.pm * tstep : cA; const char* nB = has_next ? (const char*)g.Bt + (size_t)nxt.pn * tstep : cB;
        for (int t = 0; t < nt; t += 2) {
            const bool last = (t == nt - 2);
            const char* a1 = cA + (size_t)(t + 1) * kstep;
            const char* a2 = last ? nA : cA + (size_t)(t + 2) * kstep; const char* b2 = last ? nB : cB + (size_t)(t + 2) * kstep;
            const char* a3 = a2 + kstep; const char* b3 = b2 + kstep;
            if (last && has_next) S.a_ready(nxt);
            if constexpr (SP2) {
            PG8_LDB(B0, 0, 0); PG8_LDB(B1, 0, 1); PG8_SCHED; PG8_LDA(At, 0, 0); PG8_STAGE(PG8_SA(1, 1), a1 + hstep, voffA);
            PG8_WAIT_V(8); PG8_WAIT_L(0); PG8_BAR; PG8_MMA(0, 0, At, B0); PG8_MMA(0, 1, At, B1); PG8_BAR; PG8_SCHED;
            PG8_LDA(At, 0, 1); PG8_STAGE(PG8_SB(0, 0), b2, voffB); PG8_STAGE(PG8_SB(0, 1), b2 + hstep, voffB); PG8_STAGE(PG8_SA(0, 0), a2, voffA);
            PG8_WAIT_V(8); PG8_WAIT_L(0); PG8_BAR; PG8_MMA(1, 0, At, B0); PG8_MMA(1, 1, At, B1); PG8_BAR; PG8_SCHED;
            PG8_LDB(B0, 1, 0); PG8_LDB(B1, 1, 1); PG8_SCHED; PG8_LDA(At, 1, 0); PG8_STAGE(PG8_SA(0, 1), a2 + hstep, voffA);
            PG8_WAIT_V(8); PG8_WAIT_L(0); PG8_BAR; PG8_MMA(0, 0, At, B0); PG8_MMA(0, 1, At, B1); PG8_BAR; PG8_SCHED;
            PG8_LDA(At, 1, 1); PG8_STAGE(PG8_SB(1, 0), b3, voffB); PG8_STAGE(PG8_SB(1, 1), b3 + hstep, voffB); PG8_STAGE(PG8_SA(1, 0), a3, voffA);
            PG8_WAIT_V(8); PG8_WAIT_L(0); PG8_BAR; PG8_MMA(1, 0, At, B0); PG8_MMA(1, 1, At, B1); PG8_BAR; PG8_SCHED;
            } else {
            PG8_LDB(B0, 0, 0); PG8_SCHED; PG8_LDA(At, 0, 0); PG8_STAGE(PG8_SA(1, 1), a1 + hstep, voffA);
            PG8_WAIT_L(8); PG8_BAR; PG8_WAIT_L(0); PG8_MMA(0, 0, At, B0); PG8_BAR; PG8_SCHED;
            PG8_LDB(B1, 0, 1); PG8_STAGE(PG8_SB(0, 0), b2, voffB);
            PG8_BAR; PG8_WAIT_L(0); PG8_MMA(0, 1, At, B1); PG8_BAR;
            PG8_LDA(At, 0, 1); PG8_STAGE(PG8_SA(0, 0), a2, voffA);
            PG8_BAR; PG8_WAIT_L(0); PG8_MMA(1, 0, At, B0); PG8_BAR; PG8_SCHED;
            PG8_STAGE(PG8_SB(0, 1), b2 + hstep, voffB);
            PG8_WAIT_V(6); PG8_BAR; PG8_MMA(1, 1, At, B1); PG8_BAR;
            PG8_LDB(B0, 1, 0); PG8_SCHED; PG8_LDA(At, 1, 0); PG8_STAGE(PG8_SA(0, 1), a2 + hstep, voffA);
            PG8_WAIT_L(8); PG8_BAR; PG8_WAIT_L(0); PG8_MMA(0, 0, At, B0); PG8_BAR; PG8_SCHED;
            PG8_LDB(B1, 1, 1); PG8_STAGE(PG8_SB(1, 0), b3, voffB);
            PG8_BAR; PG8_WAIT_L(0); PG8_MMA(0, 1, At, B1); PG8_BAR;
            PG8_LDA(At, 1, 1); PG8_STAGE(PG8_SA(1, 0), a3, voffA);
            PG8_BAR; PG8_WAIT_L(0); PG8_MMA(1, 0, At, B0); PG8_BAR; PG8_SCHED;
            PG8_STAGE(PG8_SB(1, 1), b3 + hstep, voffB);
            PG8_WAIT_V(6); PG8_BAR; PG8_MMA(1, 1, At, B1); PG8_BAR;
            }
        }
        if constexpr (ALIGN_EPI) { if (wr == 0) PG8_BAR; }
        if constexpr (!Epi::AFTER_DRAIN) { E(acc, cur, wr, wc, fr, fq); S.done(cur); }
        if (!has_next) break;
#pragma unroll
        for (int a = 0; a < 2; ++a)
#pragma unroll
            for (int b = 0; b < 2; ++b)
#pragma unroll
                for (int m = 0; m < 4; ++m)
#pragma unroll
                    for (int n = 0; n < 2; ++n) acc[a][b][m][n] = (f32x4){0.f, 0.f, 0.f, 0.f};
        cur = nxt; cA = nA; cB = nB; ++ui;
        if constexpr (ALIGN_EPI) { if (wr == 1) PG8_BAR; }
    }
    PG8_WAIT_V(0);
    if constexpr (!ALIGN_EPI) { if (wr == 0) PG8_BAR; }
    PG8_BAR;
    if constexpr (Epi::AFTER_DRAIN) { E.fused(acc, cur, wr, wc, fr, fq, lds, wid, lane); S.done(cur); }
#undef PG8_SA
#undef PG8_SB
#undef PG8_STAGE
#undef PG8_LDA
#undef PG8_LDB
#undef PG8_MMA
#undef PG8_WAIT_V
#undef PG8_WAIT_L
#undef PG8_BAR
#undef PG8_SCHED
}
}

template <class Epi>
DEV void gemm_tile(char* lds, const bf16_t* __restrict__ A, int lda, const bf16_t* __restrict__ Bt, int ldb, int K, int trow, int tcol,
                   const Epi& epi) {
  const int tid = threadIdx.x, w = tid >> 6, l = tid & 63, wm = w >> 1, wn = w & 1, lr = l & 15, lq = l >> 4;
  const bf16_t* ga[4];
  const bf16_t* gb[2];
#pragma unroll
  for (int j = 0; j < 4; ++j) {
    const int c = w * 4 + j, mt = c >> 1, sl = c & 1;
    ga[j] = A + (size_t)(mt * 16 + lr) * lda + sl * 32 + lq * 8;
  }
#pragma unroll
  for (int j = 0; j < 2; ++j) {
    const int nt = w, sl = j;
    const int rowb = (nt >> 2) * 64 + (lr >> 2) * 16 + (nt & 3) * 4 + (lr & 3);
    gb[j] = Bt + (size_t)rowb * ldb + sl * 32 + lq * 8;
  }
  f32x4 acc[4][4];
#pragma unroll
  for (int i = 0; i < 4; ++i)
#pragma unroll
    for (int j = 0; j < 4; ++j) acc[i][j] = (f32x4){0.f, 0.f, 0.f, 0.f};
  u32x4 ra[4], rb[2];
  const int nk = K >> 6;
#pragma unroll
  for (int j = 0; j < 4; ++j) ra[j] = *(const u32x4*)(ga[j]);
#pragma unroll
  for (int j = 0; j < 2; ++j) rb[j] = *(const u32x4*)(gb[j]);
#pragma unroll
  for (int j = 0; j < 4; ++j) *(u32x4*)(lds + (w * 4 + j) * 1024 + l * 16) = ra[j];
#pragma unroll
  for (int j = 0; j < 2; ++j) *(u32x4*)(lds + 32768 + (w * 2 + j) * 1024 + l * 16) = rb[j];
  __syncthreads();
  for (int kt = 0; kt < nk; ++kt) {
    char* cur = lds + (kt & 1) * 49152;
    const bool more = (kt + 1 < nk);
    if (more) {
#pragma unroll
      for (int j = 0; j < 4; ++j) ra[j] = *(const u32x4*)(ga[j] + (kt + 1) * 64);
#pragma unroll
      for (int j = 0; j < 2; ++j) rb[j] = *(const u32x4*)(gb[j] + (kt + 1) * 64);
    }
#pragma unroll
    for (int s = 0; s < 2; ++s) {
      bf16x8 af[4], bfr[4];
#pragma unroll
      for (int i = 0; i < 4; ++i) af[i] = *(const bf16x8*)(cur + ((wm * 4 + i) * 2 + s) * 1024 + l * 16);
#pragma unroll
      for (int j = 0; j < 4; ++j) bfr[j] = *(const bf16x8*)(cur + 32768 + ((wn * 4 + j) * 2 + s) * 1024 + l * 16);
#pragma unroll
      for (int i = 0; i < 4; ++i)
#pragma unroll
        for (int j = 0; j < 4; ++j) acc[i][j] = __builtin_amdgcn_mfma_f32_16x16x32_bf16(bfr[j], af[i], acc[i][j], 0, 0, 0);
    }
    if (more) {
      char* nxt = lds + ((kt + 1) & 1) * 49152;
#pragma unroll
      for (int j = 0; j < 4; ++j) *(u32x4*)(nxt + (w * 4 + j) * 1024 + l * 16) = ra[j];
#pragma unroll
      for (int j = 0; j < 2; ++j) *(u32x4*)(nxt + 32768 + (w * 2 + j) * 1024 + l * 16) = rb[j];
    }
    __syncthreads();
  }
#pragma unroll
  for (int i = 0; i < 4; ++i) epi(trow + wm * 64 + i * 16 + lr, tcol + wn * 64 + lq * 16, acc[i]);
}

DEV void store16_bf16(bf16_t* dst, const f32x4 (&v)[4], float sc) {
  u32x4 a, b;
  a.x = pk2(v[0][0] * sc, v[0][1] * sc); a.y = pk2(v[0][2] * sc, v[0][3] * sc);
  a.z = pk2(v[1][0] * sc, v[1][1] * sc); a.w = pk2(v[1][2] * sc, v[1][3] * sc);
  b.x = pk2(v[2][0] * sc, v[2][1] * sc); b.y = pk2(v[2][2] * sc, v[2][3] * sc);
  b.z = pk2(v[3][0] * sc, v[3][1] * sc); b.w = pk2(v[3][2] * sc, v[3][3] * sc);
  *(u32x4*)dst = a;
  *(u32x4*)(dst + 8) = b;
}

struct EpiBf16 {
  bf16_t* O; int ldo;
  DEV void operator()(int row, int col, const f32x4 (&v)[4]) const { store16_bf16(O + (size_t)row * ldo + col, v, 1.f); }
};
struct EpiF32 {
  float* O; int ldo;
  DEV void operator()(int row, int col, const f32x4 (&v)[4]) const {
    float* d = O + (size_t)row * ldo + col;
#pragma unroll
    for (int j = 0; j < 4; ++j) *(f32x4*)(d + 4 * j) = v[j];
  }
};
struct EpiLora1 {
  bf16_t* O;
  DEV void operator()(int row, int col, const f32x4 (&v)[4]) const {
    f32x4 o[4];
#pragma unroll
    for (int j = 0; j < 4; ++j)
#pragma unroll
      for (int r = 0; r < 4; ++r) {
        const float t = v[j][r];
        o[j][r] = (col < 128) ? (1.f - 2.f * __builtin_amdgcn_rcpf(1.f + __expf(2.f * t))) : ((col < 256) ? t : sigmoidf_(t));
      }
    store16_bf16(O + (size_t)row * 384 + col, o, 1.f);
  }
};
struct EpiDecay {
  bf16_t* O; const float* w0;
  DEV void operator()(int row, int col, const f32x4 (&v)[4]) const {
    f32x4 o[4];
#pragma unroll
    for (int j = 0; j < 4; ++j)
#pragma unroll
      for (int r = 0; r < 4; ++r) {
        const float xx = w0[col + 4 * j + r] + v[j][r];
        const float nx = -xx;
        const float sp = (nx > 20.f) ? nx : __logf(1.f + __expf(nx));
        const float e = __expf(-sp - 0.5f);
        o[j][r] = 1.f - __expf(-e);
      }
    store16_bf16(O + (size_t)row * 512 + col, o, 1.f);
  }
};
struct EpiA {
  bf16_t *KD, *KKA, *KK; const float *a0, *k_k, *k_a; const bf16_t* za; int writekk;
  DEV void operator()(int row, int col, const f32x4 (&v)[4]) const {
    const bf16_t* kp = za + (size_t)row * 2048 + 512 + col;
    const u32x4 k0 = *(const u32x4*)kp, k1 = *(const u32x4*)(kp + 8);
    float kf[16];
    kf[0] = lo16(k0.x); kf[1] = hi16(k0.x); kf[2] = lo16(k0.y); kf[3] = hi16(k0.y); kf[4] = lo16(k0.z); kf[5] = hi16(k0.z); kf[6] = lo16(k0.w); kf[7] = hi16(k0.w);
    kf[8] = lo16(k1.x); kf[9] = hi16(k1.x); kf[10] = lo16(k1.y); kf[11] = hi16(k1.y); kf[12] = lo16(k1.z); kf[13] = hi16(k1.z); kf[14] = lo16(k1.w); kf[15] = hi16(k1.w);
    float kr[16], ss = 0.f;
#pragma unroll
    for (int i = 0; i < 16; ++i) { kr[i] = kf[i] * k_k[col + i]; ss += kr[i] * kr[i]; }
    ss += __shfl_xor(ss, 16);
    ss += __shfl_xor(ss, 32);
    const float rn = rsqrtf(ss + 1e-12f);
    f32x4 okd[4], okka[4], okk[4];
#pragma unroll
    for (int j = 0; j < 4; ++j)
#pragma unroll
      for (int r = 0; r < 4; ++r) {
        const int i = 4 * j + r;
        const float a = sigmoidf_(a0[col + i] + v[j][r]);
        const float kk = kr[i] * rn;
        okd[j][r] = kf[i] * (1.f + (a - 1.f) * k_a[col + i]);
        okka[j][r] = kk * a;
        okk[j][r] = kk;
      }
    store16_bf16(KD + (size_t)row * 512 + col, okd, 1.f);
    store16_bf16(KKA + (size_t)row * 512 + col, okka, 1.f);
    if (writekk) store16_bf16(KK + (size_t)row * 512 + col, okk, 1.f);
  }
};
struct EpiDftc {
  bf16_t* CST; int g;
  DEV void operator()(int row, int col, const f32x4 (&v)[4]) const {
    const int b = col >> 12, s = col & 4095;
    store16_bf16(CST + ((size_t)(b * 1024 + g * 128 + (row & 127)) * 8192 + (row >> 7) * 4096 + s), v, 1.f);
  }
};

DEV void transpose_convert(char* lds, const float* __restrict__ W, int K, int N, bf16_t* __restrict__ Wt, int ldt, int rot) {
  float* tile = (float*)lds;
  const int tn_n = N >> 6, nt = (K >> 6) * tn_n, tid = threadIdx.x;
  for (int t = (blockIdx.x + rot) % gridDim.x; t < nt; t += gridDim.x) {
    const int tk = t / tn_n, tn = t % tn_n;
    for (int i = tid; i < 4096; i += NTHR) {
      const int r = i >> 6, cc = i & 63;
      tile[r * 65 + cc] = W[(size_t)(tk * 64 + r) * N + tn * 64 + cc];
    }
    __syncthreads();
    for (int i = tid; i < 4096; i += NTHR) {
      const int n = i >> 6, k = i & 63;
      Wt[(size_t)(tn * 64 + n) * ldt + tk * 64 + k] = f2bf(tile[k * 65 + n]);
    }
    __syncthreads();
  }
}

DEV void compute_mod(char* lds, const P& p) {
  float* cs = (float*)lds;
  float* red = (float*)(lds + 32768);
  const int tid = threadIdx.x;
  float* mod = (float*)(p.ws + W_MOD);
  bool have = false;
  for (int item = blockIdx.x; item < 192; item += gridDim.x) {
    if (!have) {
      for (int i = tid; i < 8192; i += NTHR) { const float cv = p.c[i]; cs[i] = cv / (1.f + expf(-cv)); }
      __syncthreads();
      have = true;
    }
    const int l = item / 96, cb = item % 96, col = cb * 64 + (tid & 63), kg = tid >> 6;
    float a0 = 0, a1 = 0, a2 = 0, a3 = 0, a4 = 0, a5 = 0, a6 = 0, a7 = 0;
    const float* wp = p.ada_w + ((size_t)l * 1024 + kg * 128) * 6144 + col;
    for (int k = 0; k < 128; ++k) {
      const float wv = wp[(size_t)k * 6144];
      const int kk = kg * 128 + k;
      a0 += cs[kk] * wv; a1 += cs[1024 + kk] * wv; a2 += cs[2048 + kk] * wv; a3 += cs[3072 + kk] * wv;
      a4 += cs[4096 + kk] * wv; a5 += cs[5120 + kk] * wv; a6 += cs[6144 + kk] * wv; a7 += cs[7168 + kk] * wv;
    }
    float* rp = red + kg * 512 + (tid & 63);
    rp[0] = a0; rp[64] = a1; rp[128] = a2; rp[192] = a3; rp[256] = a4; rp[320] = a5; rp[384] = a6; rp[448] = a7;
    __syncthreads();
    {
      const int b = tid >> 6, cc = tid & 63;
      float s = 0.f;
#pragma unroll
      for (int g = 0; g < 8; ++g) s += red[g * 512 + b * 64 + cc];
      mod[(size_t)(l * 8 + b) * 6144 + cb * 64 + cc] = s + p.ada_b[l * 6144 + cb * 64 + cc];
    }
    __syncthreads();
  }
}

template <bool HAS_Y, bool HAS_H>
DEV void rowpass(const float* __restrict__ xin, const float* __restrict__ yf, const float* __restrict__ gy, const float* __restrict__ gate,
                 float* __restrict__ xout, const float* __restrict__ gh, const float* __restrict__ sc, const float* __restrict__ sh,
                 bf16_t* __restrict__ h) {
  const int lane = threadIdx.x & 63, gw = blockIdx.x * 8 + (threadIdx.x >> 6), nw = gridDim.x * 8;
  for (int row = gw; row < MT; row += nw) {
    const int b = row >> 12;
    f32x4 xv[4];
#pragma unroll
    for (int i = 0; i < 4; ++i) xv[i] = *(const f32x4*)(xin + (size_t)row * 1024 + i * 256 + lane * 4);
    if (HAS_Y) {
      f32x4 yv[4];
      float ss = 0.f;
#pragma unroll
      for (int i = 0; i < 4; ++i) {
        yv[i] = *(const f32x4*)(yf + (size_t)row * 1024 + i * 256 + lane * 4);
        ss += yv[i][0] * yv[i][0] + yv[i][1] * yv[i][1] + yv[i][2] * yv[i][2] + yv[i][3] * yv[i][3];
      }
      ss = wave_sum(ss);
      const float rs = rsqrtf(ss * (1.f / 1024.f) + 1e-6f);
#pragma unroll
      for (int i = 0; i < 4; ++i) {
        const int col = i * 256 + lane * 4;
        const f32x4 g4 = *(const f32x4*)(gy + col), gt = *(const f32x4*)(gate + (size_t)b * 6144 + col);
        xv[i] = xv[i] + gt * (yv[i] * rs * g4);
        *(f32x4*)(xout + (size_t)row * 1024 + col) = xv[i];
      }
    }
    if (HAS_H) {
      float ss = 0.f;
#pragma unroll
      for (int i = 0; i < 4; ++i) ss += xv[i][0] * xv[i][0] + xv[i][1] * xv[i][1] + xv[i][2] * xv[i][2] + xv[i][3] * xv[i][3];
      ss = wave_sum(ss);
      const float rs = rsqrtf(ss * (1.f / 1024.f) + 1e-6f);
#pragma unroll
      for (int i = 0; i < 4; ++i) {
        const int col = i * 256 + lane * 4;
        const f32x4 g4 = *(const f32x4*)(gh + col), s4 = *(const f32x4*)(sc + (size_t)b * 6144 + col), h4 = *(const f32x4*)(sh + (size_t)b * 6144 + col);
        const f32x4 o = (xv[i] * rs * g4) * (s4 + 1.f) + h4;
        u32x2 pk;
        pk.x = pk2(o[0], o[1]); pk.y = pk2(o[2], o[3]);
        *(u32x2*)(h + (size_t)row * 1024 + col) = pk;
      }
    }
  }
}

DEV void unpack8(const u32x4 u, float (&f)[8]) {
  f[0] = lo16(u.x); f[1] = hi16(u.x); f[2] = lo16(u.y); f[3] = hi16(u.y); f[4] = lo16(u.z); f[5] = hi16(u.z); f[6] = lo16(u.w); f[7] = hi16(u.w);
}
DEV u32x4 pack8(const float (&f)[8]) {
  u32x4 u;
  u.x = pk2(f[0], f[1]); u.y = pk2(f[2], f[3]); u.z = pk2(f[4], f[5]); u.w = pk2(f[6], f[7]);
  return u;
}

DEV void prep1(const P& p) {
  const bf16_t* z = (const bf16_t*)(p.ws + O_Z);
  bf16_t* za = (bf16_t*)p.out;
  bf16_t* qr = (bf16_t*)(p.ws + O_QR);
  bf16_t* kr = (bf16_t*)(p.ws + O_KR);
  bf16_t* vt = (bf16_t*)(p.ws + O_VT);
  const float* rope = (const float*)(p.ws + W_ROPE);
  const int gt = blockIdx.x * NTHR + threadIdx.x, ngt = gridDim.x * NTHR;
  for (int idx = gt; idx < MT * 256; idx += ngt) {
    const int tok = idx >> 8, c8 = (idx & 255) * 8, s = tok & 4095;
    const bf16_t* zp = z + (size_t)tok * INC + c8;
    float zc[8], zm[8], zn[8], o[8];
    unpack8(*(const u32x4*)zp, zc);
    if (s > 0) unpack8(*(const u32x4*)(zp - INC), zm); else { for (int i = 0; i < 8; ++i) zm[i] = 0.f; }
    if (s < 4095) unpack8(*(const u32x4*)(zp + INC), zn); else { for (int i = 0; i < 8; ++i) zn[i] = 0.f; }
#pragma unroll
    for (int i = 0; i < 8; ++i) o[i] = zm[i] * p.mix_conv[c8 + i] + zc[i] * p.mix_conv[2048 + c8 + i] + zn[i] * p.mix_conv[4096 + c8 + i];
    *(u32x4*)(za + (size_t)tok * 2048 + c8) = pack8(o);
  }
  for (int idx = gt; idx < MT * 64; idx += ngt) {
    const int e8 = idx & 3, which = (idx >> 2) & 1, h = (idx >> 3) & 7, tok = idx >> 6, s = tok & 4095;
    const bf16_t* src = z + (size_t)tok * INC + 2048 + which * 512 + h * 64 + e8 * 8;
    float x1[8], x2[8], o1[8], o2[8];
    unpack8(*(const u32x4*)src, x1);
    unpack8(*(const u32x4*)(src + 32), x2);
    const float* rp = rope + ((size_t)s * 32 + e8 * 8) * 2;
    const float scl = which ? 1.f : 0.125f;
#pragma unroll
    for (int i = 0; i < 8; ++i) {
      const float cv = rp[2 * i], sv = rp[2 * i + 1];
      o1[i] = (x1[i] * cv - x2[i] * sv) * scl;
      o2[i] = (x2[i] * cv + x1[i] * sv) * scl;
    }
    bf16_t* dst = (which ? kr : qr) + (size_t)tok * 512 + h * 64 + e8 * 8;
    *(u32x4*)dst = pack8(o1);
    *(u32x4*)(dst + 32) = pack8(o2);
  }
  {
    const int lane = threadIdx.x & 63, gw = blockIdx.x * 8 + (threadIdx.x >> 6), nw = gridDim.x * 8;
    for (int item = gw; item < 3 * 4096; item += nw) {
      const int br = item >> 12, rem = item & 4095, b = rem >> 9, h = (rem >> 6) & 7, nb = rem & 63;
      const int dsh = 2 * br;
      const int Mr = 4096 >> dsh;
      const int pp = nb * 64 + lane, rsd = pp / Mr, m = pp % Mr, s = (m << dsh) + rsd;
      const bf16_t* src = z + (size_t)(b * 4096 + s) * INC + 3072 + h * 64;
      bf16_t* dst = vt + ((size_t)((br * 8 + b) * 8 + h) * 64) * 4096 + pp;
#pragma unroll
      for (int c = 0; c < 8; ++c) {
        const u32x4 u = *(const u32x4*)(src + c * 8);
        dst[(size_t)(c * 8 + 0) * 4096] = (bf16_t)(u.x & 0xffff); dst[(size_t)(c * 8 + 1) * 4096] = (bf16_t)(u.x >> 16);
        dst[(size_t)(c * 8 + 2) * 4096] = (bf16_t)(u.y & 0xffff); dst[(size_t)(c * 8 + 3) * 4096] = (bf16_t)(u.y >> 16);
        dst[(size_t)(c * 8 + 4) * 4096] = (bf16_t)(u.z & 0xffff); dst[(size_t)(c * 8 + 5) * 4096] = (bf16_t)(u.z >> 16);
        dst[(size_t)(c * 8 + 6) * 4096] = (bf16_t)(u.w & 0xffff); dst[(size_t)(c * 8 + 7) * 4096] = (bf16_t)(u.w >> 16);
      }
    }
  }
}

DEV void attention(const P& p) {
  const bf16_t* qr = (const bf16_t*)(p.ws + O_QR);
  const bf16_t* kr = (const bf16_t*)(p.ws + O_KR);
  const bf16_t* vt = (const bf16_t*)(p.ws + O_VT);
  float* num = (float*)(p.ws + O_NUM);
  float* md = (float*)(p.ws + O_MD);
  const int lane = threadIdx.x & 63, lr = lane & 15, lq = lane >> 4;
  const int gw = blockIdx.x * 8 + (threadIdx.x >> 6), nw = gridDim.x * 8;
  for (int item = gw; item < 3 * 4096 * 4; item += nw) {
    const int mt = item & 3, nb = (item >> 2) & 63, h = (item >> 8) & 7, b = (item >> 11) & 7, br = item >> 14;
    const int dsh = 2 * br, Mr = 4096 >> dsh;
    const int seg = (nb * 64) / Mr, segstart = seg * Mr, segend = segstart + Mr;
    const bool pv_ok = (nb * 64 - 64 >= segstart), nx_ok = (nb * 64 + 128 <= segend);
    const int qp = nb * 64 + mt * 16 + lr;
    const int qtok = b * 4096 + (((qp - segstart) << dsh) + seg);
    bf16x8 qf[2];
    qf[0] = *(const bf16x8*)(qr + (size_t)qtok * 512 + h * 64 + lq * 8);
    qf[1] = *(const bf16x8*)(qr + (size_t)qtok * 512 + h * 64 + 32 + lq * 8);
    f32x4 sacc[12];
#pragma unroll
    for (int kt = 0; kt < 12; ++kt) {
      const int kb = kt >> 2;
      int blk = nb + kb - 1;
      if ((kb == 0 && !pv_ok) || (kb == 2 && !nx_ok)) blk = nb;
      const int kp = blk * 64 + (kt & 3) * 16 + lr;
      const int ktok = b * 4096 + (((kp - segstart) << dsh) + seg);
      const bf16x8 k0 = *(const bf16x8*)(kr + (size_t)ktok * 512 + h * 64 + lq * 8);
      const bf16x8 k1 = *(const bf16x8*)(kr + (size_t)ktok * 512 + h * 64 + 32 + lq * 8);
      f32x4 a = (f32x4){0.f, 0.f, 0.f, 0.f};
      a = __builtin_amdgcn_mfma_f32_16x16x32_bf16(k0, qf[0], a, 0, 0, 0);
      a = __builtin_amdgcn_mfma_f32_16x16x32_bf16(k1, qf[1], a, 0, 0, 0);
      sacc[kt] = a;
    }
    const int qi = mt * 16 + lr;
    float mx = -1e30f;
#pragma unroll
    for (int kt = 0; kt < 12; ++kt) {
      const int kb = kt >> 2;
#pragma unroll
      for (int r = 0; r < 4; ++r) {
        const int kj = (kt & 3) * 16 + lq * 4 + r;
        bool ok = true;
        if (kb == 0) ok = pv_ok && (kj >= qi);
        if (kb == 2) ok = nx_ok && (kj <= qi);
        const float sv = ok ? sacc[kt][r] : -1e30f;
        sacc[kt][r] = sv;
        mx = fmaxf(mx, sv);
      }
    }
    mx = fmaxf(mx, __shfl_xor(mx, 16));
    mx = fmaxf(mx, __shfl_xor(mx, 32));
    float den = 0.f;
#pragma unroll
    for (int kt = 0; kt < 12; ++kt)
#pragma unroll
      for (int r = 0; r < 4; ++r) {
        const float pe = __expf(sacc[kt][r] - mx);
        sacc[kt][r] = pe;
        den += pe;
      }
    den += __shfl_xor(den, 16);
    den += __shfl_xor(den, 32);
    f32x4 oacc[4];
#pragma unroll
    for (int et = 0; et < 4; ++et) oacc[et] = (f32x4){0.f, 0.f, 0.f, 0.f};
    const bf16_t* vbase = vt + ((size_t)((br * 8 + b) * 8 + h) * 64) * 4096;
#pragma unroll
    for (int t = 0; t < 6; ++t) {
      const int kb = t >> 1;
      int blk = nb + kb - 1;
      if ((kb == 0 && !pv_ok) || (kb == 2 && !nx_ok)) blk = nb;
      const int kp0 = blk * 64 + ((2 * t) & 3) * 16 + lq * 4;
      const int kp1 = blk * 64 + ((2 * t + 1) & 3) * 16 + lq * 4;
      u32x4 pu;
      pu.x = pk2(sacc[2 * t][0], sacc[2 * t][1]); pu.y = pk2(sacc[2 * t][2], sacc[2 * t][3]);
      pu.z = pk2(sacc[2 * t + 1][0], sacc[2 * t + 1][1]); pu.w = pk2(sacc[2 * t + 1][2], sacc[2 * t + 1][3]);
      const bf16x8 pf = __builtin_bit_cast(bf16x8, pu);
#pragma unroll
      for (int et = 0; et < 4; ++et) {
        const bf16_t* vrow = vbase + (size_t)(et * 16 + lr) * 4096;
        const u32x2 v0 = *(const u32x2*)(vrow + kp0), v1 = *(const u32x2*)(vrow + kp1);
        u32x4 vu;
        vu.x = v0.x; vu.y = v0.y; vu.z = v1.x; vu.w = v1.y;
        oacc[et] = __builtin_amdgcn_mfma_f32_16x16x32_bf16(__builtin_bit_cast(bf16x8, vu), pf, oacc[et], 0, 0, 0);
      }
    }
    float* np = num + ((size_t)br * MT + qtok) * 512 + h * 64 + lq * 4;
#pragma unroll
    for (int et = 0; et < 4; ++et) *(f32x4*)(np + et * 16) = oacc[et];
    if (lq == 0) {
      f32x2 o;
      o.x = mx; o.y = den;
      *(f32x2*)(md + (((size_t)br * MT + qtok) * 8 + h) * 2) = o;
    }
  }
}

DEV void combineA(const P& p) {
  const float* num = (const float*)(p.ws + O_NUM);
  const float* md = (const float*)(p.ws + O_MD);
  bf16_t* ycat = (bf16_t*)(p.ws + O_YCAT);
  const int gt = blockIdx.x * NTHR + threadIdx.x, ngt = gridDim.x * NTHR;
  for (int idx = gt; idx < MT * 128; idx += ngt) {
    const int e4 = idx & 15, h = (idx >> 4) & 7, tok = idx >> 7;
    f32x2 m0 = *(const f32x2*)(md + (((size_t)0 * MT + tok) * 8 + h) * 2);
    f32x2 m1 = *(const f32x2*)(md + (((size_t)1 * MT + tok) * 8 + h) * 2);
    f32x2 m2 = *(const f32x2*)(md + (((size_t)2 * MT + tok) * 8 + h) * 2);
    const float ma = fmaxf(m0.x, fmaxf(m1.x, m2.x));
    const float e0 = __expf(m0.x - ma), e1 = __expf(m1.x - ma), e2 = __expf(m2.x - ma);
    const float dn = e0 * m0.y + e1 * m1.y + e2 * m2.y;
    const f32x4 n0 = *(const f32x4*)(num + ((size_t)0 * MT + tok) * 512 + h * 64 + e4 * 4);
    const f32x4 n1 = *(const f32x4*)(num + ((size_t)1 * MT + tok) * 512 + h * 64 + e4 * 4);
    const f32x4 n2 = *(const f32x4*)(num + ((size_t)2 * MT + tok) * 512 + h * 64 + e4 * 4);
    const f32x4 o = (n0 * e0 + n1 * e1 + n2 * e2) * (1.f / dn);
    u32x2 pk;
    pk.x = pk2(o[0], o[1]); pk.y = pk2(o[2], o[3]);
    *(u32x2*)(ycat + (size_t)tok * 1024 + 512 + h * 64 + e4 * 4) = pk;
  }
}

DEV float dpp_allreduce16(float x) {
  x += __int_as_float(__builtin_amdgcn_update_dpp(0, __float_as_int(x), 0xB1, 0xF, 0xF, true));
  x += __int_as_float(__builtin_amdgcn_update_dpp(0, __float_as_int(x), 0x4E, 0xF, 0xF, true));
  x += __int_as_float(__builtin_amdgcn_update_dpp(0, __float_as_int(x), 0x141, 0xF, 0xF, true));
  x += __int_as_float(__builtin_amdgcn_update_dpp(0, __float_as_int(x), 0x140, 0xF, 0xF, true));
  return x;
}

DEV void scan_phase(char* lds, const P& p) {
  const bf16_t* omw = (const bf16_t*)(p.ws + O_OMW);
  const bf16_t* kd = (const bf16_t*)(p.ws + O_KD);
  const bf16_t* kka = (const bf16_t*)(p.ws + O_KKA);
  const bf16_t* kk = (const bf16_t*)(p.ws + O_KK);
  const bf16_t* za = (const bf16_t*)p.out;
  float* Y = (float*)(p.ws + O_Y);
  float* inb = (float*)lds;
  float* ybuf = (float*)(lds + 98304);
  const int tid = threadIdx.x, w = tid >> 6, lane = tid & 63, rg = lane >> 4, jl = lane & 15, j0 = jl * 4;
  for (int it = blockIdx.x; it < 256; it += gridDim.x) {
    const int sc = it >> 1, half = it & 1, d = sc >> 6, b = (sc >> 3) & 7, h = sc & 7;
    const int rowl = w * 4 + rg, row = half * 32 + rowl;
    const bf16_t* src[3];
    int dsto[3], stepi[3], isw[3];
#pragma unroll
    for (int q = 0; q < 3; ++q) {
      const int pid = tid + q * NTHR, i = pid / 48, rem = pid % 48, arr = rem >> 3, pc = rem & 7;
      const bf16_t* base;
      size_t ld;
      if (arr == 0) { base = omw + (size_t)d * MT * 512 + h * 64; ld = 512; }
      else if (arr == 1) { base = kd + (size_t)d * MT * 512 + h * 64; ld = 512; }
      else if (arr == 2) { base = kka + (size_t)d * MT * 512 + h * 64; ld = 512; }
      else if (arr == 3) { base = kk + h * 64; ld = 512; }
      else if (arr == 4) { base = za + h * 64; ld = 2048; }
      else { base = za + 1024 + h * 64; ld = 2048; }
      const int t0 = d ? (4095 - i) : i;
      src[q] = base + ((size_t)(b * 4096 + t0)) * ld + pc * 8;
      stepi[q] = (int)ld * 32 * (d ? -1 : 1);
      dsto[q] = i * 384 + arr * 64 + pc * 8;
      isw[q] = (arr == 0);
    }
    float s0 = 0.f, s1 = 0.f, s2 = 0.f, s3 = 0.f;
    u32x4 rg_[3];
#pragma unroll
    for (int q = 0; q < 3; ++q) rg_[q] = *(const u32x4*)(src[q]);
#pragma unroll
    for (int q = 0; q < 3; ++q) {
      float f[8];
      unpack8(rg_[q], f);
      if (isw[q]) { for (int i = 0; i < 8; ++i) f[i] = 1.f - f[i]; }
      *(f32x4*)(inb + dsto[q]) = (f32x4){f[0], f[1], f[2], f[3]};
      *(f32x4*)(inb + dsto[q] + 4) = (f32x4){f[4], f[5], f[6], f[7]};
    }
    __syncthreads();
    for (int c = 0; c < 128; ++c) {
      const float* cur = inb + (c & 1) * 12288;
      float* yb = ybuf + (c & 1) * 1024;
      if (c + 1 < 128) {
#pragma unroll
        for (int q = 0; q < 3; ++q) rg_[q] = *(const u32x4*)(src[q] + (ptrdiff_t)stepi[q] * (c + 1));
      }
#pragma unroll 4
      for (int i = 0; i < 32; ++i) {
        const float* st = cur + i * 384;
        const f32x4 w4 = *(const f32x4*)(st + j0), kd4 = *(const f32x4*)(st + 64 + j0), ka4 = *(const f32x4*)(st + 128 + j0),
                    kk4 = *(const f32x4*)(st + 192 + j0), r4 = *(const f32x4*)(st + 256 + j0);
        const float v = st[320 + row];
        float sk = (s0 * kk4[0] + s1 * kk4[1]) + (s2 * kk4[2] + s3 * kk4[3]);
        sk = dpp_allreduce16(sk);
        s0 = s0 * w4[0] + (v * kd4[0] - sk * ka4[0]);
        s1 = s1 * w4[1] + (v * kd4[1] - sk * ka4[1]);
        s2 = s2 * w4[2] + (v * kd4[2] - sk * ka4[2]);
        s3 = s3 * w4[3] + (v * kd4[3] - sk * ka4[3]);
        float y = (s0 * r4[0] + s1 * r4[1]) + (s2 * r4[2] + s3 * r4[3]);
        y = dpp_allreduce16(y);
        if (jl == 0) yb[i * 32 + rowl] = y;
      }
      if (c + 1 < 128) {
        float* nb_ = inb + ((c + 1) & 1) * 12288;
#pragma unroll
        for (int q = 0; q < 3; ++q) {
          float f[8];
          unpack8(rg_[q], f);
          if (isw[q]) { for (int i = 0; i < 8; ++i) f[i] = 1.f - f[i]; }
          *(f32x4*)(nb_ + dsto[q]) = (f32x4){f[0], f[1], f[2], f[3]};
          *(f32x4*)(nb_ + dsto[q] + 4) = (f32x4){f[4], f[5], f[6], f[7]};
        }
      }
      __syncthreads();
      {
        const int idx = tid * 2, i = idx >> 5, rl = idx & 31;
        const int t = d ? (4095 - (c * 32 + i)) : (c * 32 + i);
        const f32x2 o = *(const f32x2*)(yb + idx);
        *(f32x2*)(Y + ((size_t)d * MT + b * 4096 + t) * 512 + h * 64 + half * 32 + rl) = o;
      }
    }
    __syncthreads();
  }
}

DEV void postB(const P& p) {
  const float* Y = (const float*)(p.ws + O_Y);
  const bf16_t* kd = (const bf16_t*)(p.ws + O_KD);
  const bf16_t* gg = (const bf16_t*)(p.ws + O_G);
  const bf16_t* za = (const bf16_t*)p.out;
  bf16_t* ycat = (bf16_t*)(p.ws + O_YCAT);
  const int lane = threadIdx.x & 63, sub = lane >> 4, jl = lane & 15, gw = blockIdx.x * 8 + (threadIdx.x >> 6), nw = gridDim.x * 8;
  for (int it = gw; it < MT * 2; it += nw) {
    const int item = it * 4 + sub, tok = item >> 3, h = item & 7, c = h * 64 + jl * 4;
    const f32x4 y0 = *(const f32x4*)(Y + (size_t)tok * 512 + c), y1 = *(const f32x4*)(Y + ((size_t)MT + tok) * 512 + c);
    const u32x2 k0 = *(const u32x2*)(kd + (size_t)tok * 512 + c), k1 = *(const u32x2*)(kd + ((size_t)MT + tok) * 512 + c);
    const u32x2 ru = *(const u32x2*)(za + (size_t)tok * 2048 + c), vu = *(const u32x2*)(za + (size_t)tok * 2048 + 1024 + c), gu = *(const u32x2*)(gg + (size_t)tok * 512 + c);
    const f32x4 lw = *(const f32x4*)(p.lnx_w + c), lb = *(const f32x4*)(p.lnx_b + c), rk = *(const f32x4*)(p.r_k + c);
    const f32x4 y = y0 + y1;
    const float mu = dpp_allreduce16((y[0] + y[1]) + (y[2] + y[3])) * (1.f / 64.f);
    const f32x4 dv = y - mu;
    const float var = dpp_allreduce16((dv[0] * dv[0] + dv[1] * dv[1]) + (dv[2] * dv[2] + dv[3] * dv[3])) * (1.f / 64.f);
    const float rs = rsqrtf(var + 64e-5f);
    const f32x4 r = (f32x4){lo16(ru.x), hi16(ru.x), lo16(ru.y), hi16(ru.y)}, v = (f32x4){lo16(vu.x), hi16(vu.x), lo16(vu.y), hi16(vu.y)};
    const f32x4 g = (f32x4){lo16(gu.x), hi16(gu.x), lo16(gu.y), hi16(gu.y)};
    const f32x4 kds = (f32x4){lo16(k0.x) + lo16(k1.x), hi16(k0.x) + hi16(k1.x), lo16(k0.y) + lo16(k1.y), hi16(k0.y) + hi16(k1.y)};
    const f32x4 t = r * kds * rk;
    const float bs = dpp_allreduce16((t[0] + t[1]) + (t[2] + t[3]));
    const f32x4 o = (dv * rs * lw + lb + v * bs) * g;
    u32x2 pk;
    pk.x = pk2(o[0], o[1]); pk.y = pk2(o[2], o[3]);
    *(u32x2*)(ycat + (size_t)tok * 1024 + c) = pk;
  }
}

DEV void glu_pass(const P& p, int l) {
  const bf16_t* zf = (const bf16_t*)(p.ws + O_ZF);
  bf16_t* act = (bf16_t*)(p.ws + O_ACT);
  const float* cw = p.ffn_conv + (size_t)l * 3 * 5632;
  const int gt = blockIdx.x * NTHR + threadIdx.x, ngt = gridDim.x * NTHR;
  constexpr int RL = 16;
  for (int item = gt; item < (16384 / RL) * 352; item += ngt) {
    const int run = item / 352, c8 = (item - run * 352) * 8, row0 = run * RL, s0 = row0 & 4095;
    float wg0[8], wg1[8], wg2[8], wv0[8], wv1[8], wv2[8];
#pragma unroll
    for (int i = 0; i < 8; i += 4) {
      *(f32x4*)(wg0 + i) = *(const f32x4*)(cw + c8 + i); *(f32x4*)(wg1 + i) = *(const f32x4*)(cw + 5632 + c8 + i); *(f32x4*)(wg2 + i) = *(const f32x4*)(cw + 11264 + c8 + i);
      *(f32x4*)(wv0 + i) = *(const f32x4*)(cw + 2816 + c8 + i); *(f32x4*)(wv1 + i) = *(const f32x4*)(cw + 5632 + 2816 + c8 + i); *(f32x4*)(wv2 + i) = *(const f32x4*)(cw + 11264 + 2816 + c8 + i);
    }
    const bf16_t* zp = zf + (size_t)row0 * 5632 + c8;
    u32x4 pg = (u32x4){0u, 0u, 0u, 0u}, pv = pg;
    if (s0 > 0) { pg = *(const u32x4*)(zp - 5632); pv = *(const u32x4*)(zp - 5632 + 2816); }
    u32x4 cg_ = *(const u32x4*)zp, cv = *(const u32x4*)(zp + 2816);
#pragma unroll 4
    for (int r = 0; r < RL; ++r) {
      u32x4 ng = (u32x4){0u, 0u, 0u, 0u}, nv = ng;
      if (s0 + r < 4095) { ng = *(const u32x4*)(zp + (size_t)(r + 1) * 5632); nv = *(const u32x4*)(zp + (size_t)(r + 1) * 5632 + 2816); }
      float gm[8], gc[8], gn[8], vm[8], vc[8], vn[8], o[8];
      unpack8(pg, gm); unpack8(cg_, gc); unpack8(ng, gn); unpack8(pv, vm); unpack8(cv, vc); unpack8(nv, vn);
#pragma unroll
      for (int i = 0; i < 8; ++i) {
        const float g = gm[i] * wg0[i] + gc[i] * wg1[i] + gn[i] * wg2[i];
        const float vv = vm[i] * wv0[i] + vc[i] * wv1[i] + vn[i] * wv2[i];
        const float u2 = -1.5957691216057308f * (g + 0.044715f * g * g * g);
        const float ge = g * __builtin_amdgcn_rcpf(1.f + __expf(u2));
        o[i] = ge * vv;
      }
      *(u32x4*)(act + (size_t)(row0 + r) * 2816 + c8) = pack8(o);
      pg = cg_; pv = cv; cg_ = ng; cv = nv;
    }
  }
}

template <class Epi>
DEV void gemm_grid(char* lds, const bf16_t* A, int lda, const bf16_t* Bt, int ldb, int K, int tilesM, int tilesN, const Epi& epi) {
  const int nt = tilesM * tilesN;
  for (int t = blockIdx.x; t < nt; t += gridDim.x) {
    const int tm = t / tilesN, tn = t % tilesN;
    gemm_tile(lds, A + (size_t)tm * 256 * lda, lda, Bt + (size_t)tn * 128 * ldb, ldb, K, tm * 256, tn * 128, epi);
  }
}


#define LDSP ((PG8_LAS unsigned char*)lds)
template <class Epi>
DEV void pgemm(char* lds, const bf16_t* A, const bf16_t* Bt, int M_, int N_, int K_, const Epi& E) {
  pg8::Gemm g{A, Bt, M_, N_, K_};
  pg8::StaticOrder S;
  S.init(M_, N_, (int)gridDim.x, (int)blockIdx.x);
  pg8::gemm_phase<Epi, pg8::StaticOrder, true, true>(LDSP, g, S, E);
}

DEV void ffn(char* lds, const XcdBarrier& xbar, const P& p, int l) {
  const bf16_t* h = (const bf16_t*)(p.ws + O_H);
  bf16_t* zf = (bf16_t*)(p.ws + O_ZF);
  bf16_t* act = (bf16_t*)(p.ws + O_ACT);
  float* yf = (float*)(p.ws + O_YF);
  const bf16_t* upt = (const bf16_t*)(p.ws + W_UP) + (size_t)l * 5632 * 1024;
  const bf16_t* dnt = (const bf16_t*)(p.ws + W_DOWN) + (size_t)l * 1024 * 2816;
  for (int half = 0; half < 2; ++half) {
    pgemm(lds, h + (size_t)half * 16384 * 1024, upt, 16384, 5632, 1024, pg8::PEpiBf16<false>{zf, 5632});
    xcd_barrier(xbar);
    for (int rep_ = 0; rep_ < REP_GLU; ++rep_) { glu_pass(p, l); xcd_barrier(xbar); }
    pgemm(lds, act, dnt, 16384, 1024, 2816, pg8::PEpiF32{yf + (size_t)half * 16384 * 1024, 1024});
  }
  xcd_barrier(xbar);
}

__global__ void __launch_bounds__(NTHR) mega(P p) {
  extern __shared__ __attribute__((aligned(16))) char lds[];
  cg::grid_group grid = cg::this_grid();
  char* ws = p.ws;
  if (threadIdx.x < 4) ((unsigned*)(lds + 131072))[threadIdx.x] = 0u;
  __syncthreads();
  const XcdBarrier xbar = xcd_barrier_post((unsigned*)(ws + W_BAR), (volatile XLAS unsigned*)(lds + 131072));
  float* mod = (float*)(ws + W_MOD);
  const int gt = blockIdx.x * NTHR + threadIdx.x, ngt = gridDim.x * NTHR;

  compute_mod(lds, p);
  transpose_convert(lds, p.mix_in, 1024, 3584, (bf16_t*)(ws + W_MIXIN), 1024, 0);
  for (int l = 0; l < 2; ++l) {
    transpose_convert(lds, p.ffn_up + (size_t)l * 1024 * 5632, 1024, 5632, (bf16_t*)(ws + W_UP) + (size_t)l * 5632 * 1024, 1024, 64 * l);
    transpose_convert(lds, p.ffn_down + (size_t)l * 2816 * 1024, 2816, 1024, (bf16_t*)(ws + W_DOWN) + (size_t)l * 1024 * 2816, 2816, 128 + 64 * l);
  }
  transpose_convert(lds, p.mix_out, 1024, 1024, (bf16_t*)(ws + W_MIXOUT), 1024, 32);
  transpose_convert(lds, p.fnet_w, 1024, 1024, (bf16_t*)(ws + W_FNET), 1024, 96);
  for (int d = 0; d < 2; ++d) {
    transpose_convert(lds, p.w1 + (size_t)d * 512 * 64, 512, 64, (bf16_t*)(ws + W_L1) + (size_t)(d * 64) * 512, 512, 8 * d);
    transpose_convert(lds, p.a1 + (size_t)d * 512 * 64, 512, 64, (bf16_t*)(ws + W_L1) + (size_t)(128 + d * 64) * 512, 512, 16 + 8 * d);
    transpose_convert(lds, p.w2 + (size_t)d * 64 * 512, 64, 512, (bf16_t*)(ws + W_W2) + (size_t)d * 512 * 64, 64, 48 + 8 * d);
    transpose_convert(lds, p.a2 + (size_t)d * 64 * 512, 64, 512, (bf16_t*)(ws + W_A2) + (size_t)d * 512 * 64, 64, 64 + 8 * d);
  }
  transpose_convert(lds, p.g1, 512, 128, (bf16_t*)(ws + W_L1) + (size_t)256 * 512, 512, 32);
  transpose_convert(lds, p.g2, 128, 512, (bf16_t*)(ws + W_G2), 128, 80);
  {
    float* rope = (float*)(ws + W_ROPE);
    for (int idx = gt; idx < 4096 * 32; idx += ngt) {
      const int s = idx >> 5, e = idx & 31;
      const float inv = powf(10000.f, -(float)e / 32.f);
      const float ang = (float)s * inv;
      float sv, cv;
      sincosf(ang, &sv, &cv);
      rope[2 * idx] = cv;
      rope[2 * idx + 1] = sv;
    }
    bf16_t* dftc = (bf16_t*)(ws + W_DFTC);
    for (int idx = gt; idx < 256 * 128; idx += ngt) {
      const int n = idx >> 7, c = idx & 127, k2 = n & 127;
      const float ph = (float)((k2 * c) & 127) * (1.f / 64.f);
      const float v = (n < 128) ? cospif(ph) : sinpif(ph);
      dftc[idx] = f2bf(v * 0.08838834764831845f);
    }
  }
  grid.sync();
  for (int rep_ = 0; rep_ < REP_ROW; ++rep_) { rowpass<false, true>(p.x, nullptr, nullptr, nullptr, nullptr, p.norm_g, mod + 1024, mod, (bf16_t*)(ws + O_H0)); xcd_barrier(xbar); }
  pgemm(lds, (const bf16_t*)(ws + O_H0), (const bf16_t*)(ws + W_MIXIN), MT, INC, 1024, pg8::PEpiBf16<false>{(bf16_t*)(ws + O_Z), INC});
  xcd_barrier(xbar);
  for (int rep_ = 0; rep_ < REP_PREP; ++rep_) { prep1(p); xcd_barrier(xbar); }
  for (int rep_ = 0; rep_ < REP_ATT; ++rep_) { attention(p); xcd_barrier(xbar); }
  combineA(p);
  gemm_grid(lds, (const bf16_t*)p.out + 1536, 2048, (const bf16_t*)(ws + W_L1), 512, 512, 128, 3, EpiLora1{(bf16_t*)(ws + O_L1)});
  xcd_barrier(xbar);
  for (int d = 0; d < 2; ++d) {
    gemm_grid(lds, (const bf16_t*)(ws + O_L1) + d * 64, 384, (const bf16_t*)(ws + W_W2) + (size_t)d * 512 * 64, 64, 64, 128, 4,
              EpiDecay{(bf16_t*)(ws + O_OMW) + (size_t)d * MT * 512, p.w0 + d * 512});
    gemm_grid(lds, (const bf16_t*)(ws + O_L1) + 128 + d * 64, 384, (const bf16_t*)(ws + W_A2) + (size_t)d * 512 * 64, 64, 64, 128, 4,
              EpiA{(bf16_t*)(ws + O_KD) + (size_t)d * MT * 512, (bf16_t*)(ws + O_KKA) + (size_t)d * MT * 512, (bf16_t*)(ws + O_KK), p.a0 + d * 512,
                   p.k_k, p.k_a, (const bf16_t*)p.out, d == 0});
  }
  gemm_grid(lds, (const bf16_t*)(ws + O_L1) + 256, 384, (const bf16_t*)(ws + W_G2), 128, 128, 128, 4, EpiBf16{(bf16_t*)(ws + O_G), 512});
  xcd_barrier(xbar);
  for (int rep_ = 0; rep_ < REP_SCAN; ++rep_) { scan_phase(lds, p); xcd_barrier(xbar); }
  for (int rep_ = 0; rep_ < REP_SYNC; ++rep_) xcd_barrier(xbar);
  postB(p);
  xcd_barrier(xbar);
  pgemm(lds, (const bf16_t*)(ws + O_YCAT), (const bf16_t*)(ws + W_MIXOUT), MT, 1024, 1024, pg8::PEpiF32{(float*)(ws + O_YF), 1024});
  xcd_barrier(xbar);
  rowpass<true, true>(p.x, (const float*)(ws + O_YF), p.norm_g + 1024, mod + 2048, p.out, p.norm_g + 2048, mod + 4096, mod + 3072, (bf16_t*)(ws + O_H));
  xcd_barrier(xbar);
  ffn(lds, xbar, p, 0);
  {
    const float* mod1 = mod + 8 * 6144;
    rowpass<true, true>(p.out, (const float*)(ws + O_YF), p.norm_g + 3072, mod + 5120, p.out, p.norm_g + 4096, mod1 + 1024, mod1, (bf16_t*)(ws + O_H));
    bf16_t* cs = (bf16_t*)(ws + O_COSSIN);
    for (int idx = gt; idx < 4096 * 1024; idx += ngt) {
      const int k1 = idx >> 10, k8 = (idx & 1023) * 8;
      float o[8];
#pragma unroll
      for (int i = 0; i < 8; ++i) {
        const int kk = k8 + i, s = kk & 4095;
        const float ph = (float)((k1 * s) & 4095) * (1.f / 2048.f);
        o[i] = ((kk < 4096) ? cospif(ph) : -sinpif(ph)) * (1.f / 64.f);
      }
      *(u32x4*)(cs + (size_t)k1 * 8192 + k8) = pack8(o);
    }
    xcd_barrier(xbar);
    for (int t = blockIdx.x; t < 8 * 256; t += gridDim.x) {
      const int g = t >> 8, tn = t & 255;
      gemm_tile(lds, (const bf16_t*)(ws + W_DFTC), 128, (const bf16_t*)(ws + O_H) + (size_t)tn * 128 * 1024 + g * 128, 1024, 128, 0, tn * 128,
                EpiDftc{(bf16_t*)(ws + O_CST), g});
    }
    xcd_barrier(xbar);
    {
      pg8::Gemm g{(const bf16_t*)(ws + O_COSSIN), (const bf16_t*)(ws + O_CST), 4096, 8192, 8192};
      pg8::BatchOrder S{(int)gridDim.x, (int)blockIdx.x};
      pg8::gemm_phase<pg8::PEpiBf16<true>, pg8::BatchOrder, true, true>(LDSP, g, S, pg8::PEpiBf16<true>{(bf16_t*)(ws + O_F), 1024});
    }
    xcd_barrier(xbar);
    pgemm(lds, (const bf16_t*)(ws + O_F), (const bf16_t*)(ws + W_FNET), MT, 1024, 1024, pg8::PEpiF32{(float*)(ws + O_YF), 1024});
    xcd_barrier(xbar);
    rowpass<true, true>(p.out, (const float*)(ws + O_YF), p.norm_g + 4096 + 1024, mod1 + 2048, p.out, p.norm_g + 4096 + 2048, mod1 + 4096, mod1 + 3072,
                        (bf16_t*)(ws + O_H));
    xcd_barrier(xbar);
    ffn(lds, xbar, p, 1);
    rowpass<true, false>(p.out, (const float*)(ws + O_YF), p.norm_g + 4096 + 3072, mod1 + 5120, p.out, nullptr, nullptr, nullptr, nullptr);
  }
}

extern "C" void kernel_launch(void* const* d_in, const int* in_sizes, int n_in, void* d_out, int out_size, void* d_ws, size_t ws_size,
                              hipStream_t stream) {
  static int grid_blocks = 0;
  if (!grid_blocks) {
    int dev = 0, cus = 0, per_cu = 0;
    hipGetDevice(&dev);
    hipDeviceGetAttribute(&cus, hipDeviceAttributeMultiprocessorCount, dev);
    hipFuncSetAttribute((const void*)mega, hipFuncAttributeMaxDynamicSharedMemorySize, LDS_BYTES);
    hipOccupancyMaxActiveBlocksPerMultiprocessor(&per_cu, (const void*)mega, NTHR, LDS_BYTES);
    if (per_cu < 1) { fprintf(stderr, "occupancy query returned %d\n", per_cu); per_cu = 1; }
    if (per_cu > 1) per_cu = 1;
    grid_blocks = cus * per_cu;
  }
  P p{};
  const float** pp = (const float**)&p;
  for (int i = 0; i < 25; ++i) pp[i] = (const float*)d_in[i];
  p.out = (float*)d_out;
  p.ws = (char*)d_ws;
  (void)hipMemsetAsync((char*)d_ws + W_BAR, 0, XCD_BAR_WORDS * sizeof(unsigned), stream);
  void* args[] = {&p};
  hipError_t e = hipLaunchCooperativeKernel((const void*)mega, dim3(grid_blocks), dim3(NTHR), args, LDS_BYTES, stream);
  if (e != hipSuccess) fprintf(stderr, "cooperative launch failed: %s (grid %d)\n", hipGetErrorString(e), grid_blocks);
}
```

```cpp
#include <hip/hip_runtime.h>
#include <hip/hip_cooperative_groups.h>
#include <stdint.h>
#include <cstdio>
namespace cg = cooperative_groups;

typedef unsigned short bf16_t;
typedef short bf16x8 __attribute__((ext_vector_type(8)));
typedef short s16x4 __attribute__((ext_vector_type(4)));
typedef float f32x4 __attribute__((ext_vector_type(4)));
typedef float f32x2 __attribute__((ext_vector_type(2)));
typedef unsigned u32x4 __attribute__((ext_vector_type(4)));
typedef unsigned u32x2 __attribute__((ext_vector_type(2)));

#define DEV __device__ __forceinline__

constexpr int NB = 8, SEQ = 4096, DM = 1024, MT = NB * SEQ, DFF = 2816, INC = 3584;
constexpr size_t MiB = 1024 * 1024;
constexpr int NTHR = 512;
constexpr int LDS_BYTES = 131072 + 16;
constexpr size_t W_BAR = 47 * 1024 * 1024;
#ifndef REP_SCAN
#define REP_SCAN 1
#endif
#ifndef REP_ATT
#define REP_ATT 1
#endif
#ifndef REP_SYNC
#define REP_SYNC 0
#endif
#ifndef REP_PREP
#define REP_PREP 1
#endif
#ifndef REP_LORA
#define REP_LORA 1
#endif
#ifndef REP_GLU
#define REP_GLU 1
#endif
#ifndef REP_PRO
#define REP_PRO 1
#endif
#ifndef REP_ROW
#define REP_ROW 1
#endif

constexpr size_t W_MIXIN = 0;
constexpr size_t W_UP = 7 * MiB;
constexpr size_t W_DOWN = 29 * MiB;
constexpr size_t W_MIXOUT = 40 * MiB;
constexpr size_t W_FNET = 42 * MiB;
constexpr size_t W_L1 = 44 * MiB;
constexpr size_t W_W2 = W_L1 + 512 * 1024;
constexpr size_t W_A2 = W_W2 + 128 * 1024;
constexpr size_t W_G2 = W_A2 + 128 * 1024;
constexpr size_t W_DFTC = W_G2 + 128 * 1024;
constexpr size_t W_MOD = 45 * MiB;
constexpr size_t W_ROPE = 46 * MiB;
constexpr size_t R0 = 48 * MiB;
constexpr size_t O_H0 = R0;
constexpr size_t O_Z = 112 * MiB;
constexpr size_t O_QR = 336 * MiB, O_KR = 368 * MiB, O_VT = 400 * MiB;
constexpr size_t O_NUM = R0;
constexpr size_t O_MD = 240 * MiB;
constexpr size_t O_YCAT = 448 * MiB;
constexpr size_t O_OMW = 48 * MiB, O_KD = 112 * MiB, O_KKA = 176 * MiB, O_KK = 240 * MiB, O_G = 272 * MiB, O_L1 = 304 * MiB, O_Y = 304 * MiB;
constexpr size_t O_YF = 48 * MiB;
constexpr size_t O_H = 176 * MiB;
constexpr size_t O_ZF = 240 * MiB;
constexpr size_t O_ACT = 416 * MiB;
constexpr size_t O_COSSIN = 240 * MiB;
constexpr size_t O_CST = 304 * MiB;
constexpr size_t O_F = 432 * MiB;
constexpr size_t O_EO = 48 * MiB;

struct P {
  const float *x, *c, *ada_w, *ada_b, *norm_g, *mix_in, *mix_conv, *w0, *w1, *w2, *a0, *a1, *a2, *g1, *g2, *k_k, *k_a, *r_k, *lnx_w,
      *lnx_b, *mix_out, *fnet_w, *ffn_up, *ffn_conv, *ffn_down;
  float* out;
  char* ws;
};

DEV float bf2f(bf16_t h) { return __uint_as_float(((unsigned)h) << 16); }
DEV bf16_t f2bf(float f) {
  unsigned u = __float_as_uint(f);
  u += 0x7fffu + ((u >> 16) & 1u);
  return (bf16_t)(u >> 16);
}
DEV unsigned pk2(float a, float b) { return (unsigned)f2bf(a) | ((unsigned)f2bf(b) << 16); }
DEV float lo16(unsigned u) { return __uint_as_float(u << 16); }
DEV float hi16(unsigned u) { return __uint_as_float(u & 0xffff0000u); }
DEV float wave_sum(float v) {
#pragma unroll
  for (int o = 32; o; o >>= 1) v += __shfl_xor(v, o);
  return v;
}
DEV float sigmoidf_(float x) { return __builtin_amdgcn_rcpf(1.f + __expf(-x)); }

#include <cstdint>
#include <cstdlib>
#include <vector>

#define XB_TMO      128
#define XB_XCNT(j)  (256  + 64 * (j))
#define XB_XSUB(j)  (1280 + 64 * (j))
#define XB_XGEN(j)  (2304 + 64 * (j))
#define XB_TOP      3328
#define XB_TOPGEN   3392
#define XCD_BAR_WORDS 3456
#define XB_SPIN_CAP (1u << 18)
#define XLAS __attribute__((address_space(3)))

__device__ __forceinline__ unsigned xb_ld(unsigned* p)              { return __hip_atomic_load(p, __ATOMIC_RELAXED, __HIP_MEMORY_SCOPE_AGENT); }
__device__ __forceinline__ unsigned xb_add(unsigned* p, unsigned v) { return __hip_atomic_fetch_add(p, v, __ATOMIC_RELAXED, __HIP_MEMORY_SCOPE_AGENT); }
__device__ __forceinline__ unsigned xb_xcc_id() { return (unsigned)__builtin_amdgcn_s_getreg((3 << 11) | 20) & 0xFu; }
#define XB_SPIN(cond, bar) do { unsigned _sp = 0; while (cond) { __builtin_amdgcn_s_sleep(1); \
    if ((++_sp & 255u) == 0u) { if (xb_ld(&(bar)[XB_TMO])) break; if (_sp > XB_SPIN_CAP) { atomicAdd(&(bar)[XB_TMO], 1u); break; } } } } while (0)

struct XcdBarrier {
    unsigned* bar; unsigned x;
    volatile XLAS unsigned* st;
};

__device__ __forceinline__ XcdBarrier xcd_barrier_post(unsigned* bar, volatile XLAS unsigned* st) {
    XcdBarrier b; b.bar = bar; b.x = xb_xcc_id(); b.st = st;
    if (threadIdx.x == 0) (void)xb_add(&bar[XB_XCNT(b.x)], 1u);
    return b;
}
__device__ __forceinline__ void xcd_barrier_complete(unsigned* bar, unsigned x, unsigned& nloc, unsigned& nx) {
    const unsigned G = gridDim.x * gridDim.y * gridDim.z;
    unsigned sum, cnt, mine, sp = 0u;
    for (;;) {
        sum = 0u; cnt = 0u; mine = 0u;
#pragma unroll
        for (unsigned j = 0; j < 16; ++j) { const unsigned c = xb_ld(&bar[XB_XCNT(j)]); sum += c; cnt += (c > 0u) ? 1u : 0u; mine = (j == x) ? c : mine; }
        if (sum == G) break;
        __builtin_amdgcn_s_sleep(1);
        if ((++sp & 255u) == 0u) { if (xb_ld(&bar[XB_TMO])) break; if (sp > XB_SPIN_CAP) { atomicAdd(&bar[XB_TMO], 1u); break; } }
    }
    nloc = mine > 0u ? mine : 1u; nx = cnt > 0u ? cnt : 1u;
}

__device__ __forceinline__ void xcd_barrier(const XcdBarrier& b) {
    asm volatile("s_waitcnt vmcnt(0)" ::: "memory");
    __syncthreads();
    if (threadIdx.x == 0) {
        unsigned* bar = b.bar;
        __builtin_amdgcn_s_waitcnt(0);
        unsigned nloc = b.st[0], nx = b.st[1];
        if (nloc == 0u) { xcd_barrier_complete(bar, b.x, nloc, nx); b.st[0] = nloc; b.st[1] = nx; }
        const unsigned old = xb_add(&bar[XB_XSUB(b.x)], 1u);
        const unsigned gen = old / nloc;
        if (old + 1u == (gen + 1u) * nloc) {
            __builtin_amdgcn_fence(__ATOMIC_RELEASE, "agent");
            asm volatile("s_waitcnt vmcnt(0)" ::: "memory");
            const unsigned og = xb_add(&bar[XB_TOP], 1u);
            const unsigned tg = og / nx;
            if (og + 1u == (tg + 1u) * nx) xb_add(&bar[XB_TOPGEN], 1u);
            else XB_SPIN(xb_ld(&bar[XB_TOPGEN]) == tg, bar);
            __builtin_amdgcn_fence(__ATOMIC_ACQUIRE, "agent");
            xb_add(&bar[XB_XGEN(b.x)], 1u);
            asm volatile("s_waitcnt vmcnt(0)" ::: "memory");
        } else {
            XB_SPIN(xb_ld(&bar[XB_XGEN(b.x)]) == gen, bar);
            __builtin_amdgcn_fence(__ATOMIC_ACQUIRE, "agent");
            asm volatile("s_waitcnt vmcnt(0)" ::: "memory");
        }
    }
    __syncthreads();
}

namespace pg8 {
#define PG8_LAS __attribute__((address_space(3)))
typedef unsigned short bf16_t;
typedef short bf16x8 __attribute__((ext_vector_type(8)));
typedef float f32x4 __attribute__((ext_vector_type(4)));
typedef unsigned u32x4 __attribute__((ext_vector_type(4)));
constexpr int BM = 256, BK = 64, HALF = 128, HTB = HALF * BK * 2  , STAGE_BYTES = 8 * HTB, NXCD = 8, WGM = 8;

__host__ __device__ __forceinline__ int lds_byte(int r, int c) { const int st = (r >> 4) * 2 + (c >> 5), rr = r & 15, cc = c & 31, ob = rr * 64 + cc * 2; return st * 1024 + (ob ^ (((ob >> 9) & 1) << 5)); }
__host__ __device__ __forceinline__ void stage_rc(int b, int& R, int& C) { const int st = b / 1024, sb = b % 1024, swz = sb ^ (((sb >> 9) & 1) << 5); R = (st >> 1) * 16 + swz / 64; C = (st & 1) * 32 + (swz % 64) / 2; }
__host__ __device__ __forceinline__ int perm32(int rho) { const int n = rho >> 4, i = rho & 15; return 8 * (i >> 2) + 4 * n + (i & 3); }

struct Unit { int pm, pn; };
struct Gemm { const bf16_t* A; const bf16_t* Bt; int M, N, K; };

struct StaticOrder {
    int nM, nN, nwg, G, c;
    __host__ __device__ void init(int M, int N, int G_, int c_) { nM = M / BM; nN = N / BM; nwg = nM * nN; G = G_; c = c_; }
    __host__ __device__ bool next(int i, Unit& u) const {
        const long L = (long)i * G + c; if (L >= nwg) return false;
        int wgid = (int)L; { const int q = nwg / NXCD, r = nwg % NXCD, xcd = wgid % NXCD, off = wgid / NXCD; wgid = (xcd < r ? xcd * (q + 1) : r * (q + 1) + (xcd - r) * q) + off; }
        const int nig = WGM * nN, gid = wgid / nig, fm = gid * WGM, gsz = (nM - fm) < WGM ? (nM - fm) : WGM;
        u.pm = fm + ((wgid % nig) % gsz); u.pn = (wgid % nig) / gsz; return true;
    }
    __device__ __forceinline__ void a_ready(const Unit&) const {}
    __device__ __forceinline__ void done(const Unit&) const {}
};

__device__ __forceinline__ unsigned cvt_pk_bf16(float lo, float hi) { unsigned r; asm volatile("v_cvt_pk_bf16_f32 %0, %1, %2" : "=v"(r) : "v"(lo), "v"(hi)); return r; }

template <bool BATCHED> struct PEpiBf16 {
    static constexpr bool PERM = true, AFTER_DRAIN = false;
    bf16_t* O; int ldc;
    __device__ __forceinline__ void operator()(const f32x4 (&acc)[2][2][4][2], const Unit& u, int wr, int wc, int fr, int fq) const {
        const int rb = BATCHED ? ((u.pn >> 2) * 4096 + u.pm * 256) : u.pm * 256, cb = BATCHED ? (u.pn & 3) * 256 : u.pn * 256;
        const int row0 = rb + wr * 64 + fr, col0 = cb + wc * 32 + 8 * fq;
#pragma unroll
        for (int ai = 0; ai < 2; ++ai)
#pragma unroll
            for (int m = 0; m < 4; ++m) { bf16_t* rowp = O + (size_t)(row0 + ai * HALF + m * 16) * ldc + col0;
#pragma unroll
                for (int bj = 0; bj < 2; ++bj) { const f32x4 v0 = acc[ai][bj][m][0], v1 = acc[ai][bj][m][1];
                    u32x4 w; w.x = cvt_pk_bf16(v0[0], v0[1]); w.y = cvt_pk_bf16(v0[2], v0[3]); w.z = cvt_pk_bf16(v1[0], v1[1]); w.w = cvt_pk_bf16(v1[2], v1[3]);
                    *(u32x4*)(rowp + bj * HALF) = w; } }
    }
};
struct PEpiF32 {
    static constexpr bool PERM = true, AFTER_DRAIN = false;
    float* O; int ldc;
    __device__ __forceinline__ void operator()(const f32x4 (&acc)[2][2][4][2], const Unit& u, int wr, int wc, int fr, int fq) const {
        const int row0 = u.pm * 256 + wr * 64 + fr, col0 = u.pn * 256 + wc * 32 + 8 * fq;
#pragma unroll
        for (int ai = 0; ai < 2; ++ai)
#pragma unroll
            for (int m = 0; m < 4; ++m) { float* rowp = O + (size_t)(row0 + ai * HALF + m * 16) * ldc + col0;
#pragma unroll
                for (int bj = 0; bj < 2; ++bj) { *(f32x4*)(rowp + bj * HALF) = acc[ai][bj][m][0]; *(f32x4*)(rowp + bj * HALF + 4) = acc[ai][bj][m][1]; } }
    }
};
struct PEpiF32B {
    static constexpr bool PERM = true, AFTER_DRAIN = false;
    float* O;
    __device__ __forceinline__ void operator()(const f32x4 (&acc)[2][2][4][2], const Unit& u, int wr, int wc, int fr, int fq) const {
        const int row0 = (u.pn >> 2) * 2048 + (u.pm & 7) * 256 + wr * 64 + fr, col0 = (u.pn & 3) * 256 + wc * 32 + 8 * fq;
#pragma unroll
        for (int ai = 0; ai < 2; ++ai)
#pragma unroll
            for (int m = 0; m < 4; ++m) { float* rowp = O + (size_t)(row0 + ai * HALF + m * 16) * 1024 + col0;
#pragma unroll
                for (int bj = 0; bj < 2; ++bj) { *(f32x4*)(rowp + bj * HALF) = acc[ai][bj][m][0]; *(f32x4*)(rowp + bj * HALF + 4) = acc[ai][bj][m][1]; } }
    }
};
struct BatchOrder {
    int G, c;
    __device__ __forceinline__ bool next(int i, Unit& u) const { const int L = i * G + c; if (L >= 512) return false; const int be = L >> 5, r = L & 31; u.pm = (be & 1) * 8 + (r >> 2); u.pn = be * 4 + (r & 3); return true; }
    __device__ __forceinline__ void a_ready(const Unit&) const {}
    __device__ __forceinline__ void done(const Unit&) const {}
};
template <class Epi, class Sched, bool ALIGN_EPI = false, bool SP2 = false>
__device__ __forceinline__ void gemm_phase(PG8_LAS unsigned char* lds, const Gemm g, const Sched& S, const Epi& E) {
    int tid_ = threadIdx.x; asm volatile("" : "+v"(tid_));
    const int tid = tid_, wid = __builtin_amdgcn_readfirstlane(tid >> 6), lane = tid & 63, wr = wid >> 2, wc = wid & 3, fr = lane & 15, fq = lane >> 4;
    const int K = g.K, nt = K / BK;
    unsigned voffA[2], voffB[2];
#pragma unroll
    for (int i = 0; i < 2; ++i) { int R, C; stage_rc(tid * 16 + i * 8192, R, C); const int Rb = Epi::PERM ? ((R & ~31) + perm32(R & 31)) : R;
        voffA[i] = (unsigned)(R * K + C) * 2u; voffB[i] = (unsigned)(Rb * K + C) * 2u; }
    const size_t kstep = (size_t)(BK * 2);
    const size_t hstep = (size_t)HALF * K * 2;
    const size_t tstep = 2 * hstep;
    const unsigned ldsw = (unsigned)wid * 1024u;
    const int aoff = lds_byte(wr * 64 + fr, fq * 8), boff = lds_byte(wc * 32 + fr, fq * 8);
#define PG8_SA(b, h) (((b) * 2 + (h)) * HTB)
#define PG8_SB(b, h) ((4 + (b) * 2 + (h)) * HTB)
#define PG8_STAGE(bufoff, gbase, voff) do { _Pragma("unroll") for (int _i = 0; _i < 2; ++_i) \
        __builtin_amdgcn_global_load_lds((const unsigned*)((const char*)(gbase) + (voff)[_i]), (PG8_LAS unsigned*)(lds + (bufoff) + ldsw + _i * 8192), 16, 0, 0); } while (0)
#define PG8_LDA(dst, b, h) do { _Pragma("unroll") for (int m = 0; m < 4; ++m) _Pragma("unroll") for (int k = 0; k < 2; ++k) dst[m][k] = *(const PG8_LAS bf16x8*)(lds + PG8_SA(b, h) + aoff + m * 2048 + k * 1024); } while (0)
#define PG8_LDB(dst, b, h) do { _Pragma("unroll") for (int n = 0; n < 2; ++n) _Pragma("unroll") for (int k = 0; k < 2; ++k) dst[n][k] = *(const PG8_LAS bf16x8*)(lds + PG8_SB(b, h) + boff + n * 2048 + k * 1024); } while (0)
#define PG8_MMA(ai, bj, At, Bt) do { __builtin_amdgcn_s_setprio(1); _Pragma("unroll") for (int m = 0; m < 4; ++m) _Pragma("unroll") for (int n = 0; n < 2; ++n) _Pragma("unroll") for (int k = 0; k < 2; ++k) \
        acc[ai][bj][m][n] = __builtin_amdgcn_mfma_f32_16x16x32_bf16(Bt[n][k], At[m][k], acc[ai][bj][m][n], 0, 0, 0); __builtin_amdgcn_s_setprio(0); } while (0)
#define PG8_WAIT_V(n) asm volatile("s_waitcnt vmcnt(" #n ")" ::: "memory")
#define PG8_WAIT_L(n) asm volatile("s_waitcnt lgkmcnt(" #n ")" ::: "memory")
#define PG8_BAR __builtin_amdgcn_s_barrier()
#define PG8_SCHED __builtin_amdgcn_sched_barrier(0)
    Unit cur, nxt; int ui = 0;
    if (!S.next(0, cur)) return;
    f32x4 acc[2][2][4][2];
#pragma unroll
    for (int a = 0; a < 2; ++a)
#pragma unroll
        for (int b = 0; b < 2; ++b)
#pragma unroll
            for (int m = 0; m < 4; ++m)
#pragma unroll
                for (int n = 0; n < 2; ++n) acc[a][b][m][n] = (f32x4){0.f, 0.f, 0.f, 0.f};
    bf16x8 At[4][2], B0[2][2], B1[2][2];
    const char* cA = (const char*)g.A + (size_t)cur.pm * tstep; const char* cB = (const char*)g.Bt + (size_t)cur.pn * tstep;
    S.a_ready(cur);
    if constexpr (SP2) {
        PG8_STAGE(PG8_SB(0, 0), cB, voffB); PG8_STAGE(PG8_SB(0, 1), cB + hstep, voffB); PG8_STAGE(PG8_SA(0, 0), cA, voffA); PG8_STAGE(PG8_SA(0, 1), cA + hstep, voffA);
        if (wr == 1) PG8_BAR;
        PG8_WAIT_V(2); PG8_BAR;
        PG8_STAGE(PG8_SB(1, 0), cB + kstep, voffB); PG8_STAGE(PG8_SA(1, 0), cA + kstep, voffA); PG8_STAGE(PG8_SB(1, 1), cB + hstep + kstep, voffB);
        PG8_WAIT_V(6); PG8_BAR;
    } else {
        PG8_STAGE(PG8_SB(0, 0), cB, voffB); PG8_STAGE(PG8_SA(0, 0), cA, voffA); PG8_STAGE(PG8_SB(0, 1), cB + hstep, voffB); PG8_STAGE(PG8_SA(0, 1), cA + hstep, voffA);
        if (wr == 1) PG8_BAR;
        PG8_WAIT_V(4); PG8_BAR;
        PG8_STAGE(PG8_SB(1, 0), cB + kstep, voffB); PG8_STAGE(PG8_SA(1, 0), cA + kstep, voffA); PG8_STAGE(PG8_SB(1, 1), cB + hstep + kstep, voffB);
        PG8_WAIT_V(6); PG8_BAR;
    }
    for (;;) {
        const bool has_next = S.next(ui + 1, nxt);
        const char* nA = has_next ? (const char*)g.A + (size_t)nxt.pm * tstep : cA; const char* nB = has_next ? (const char*)g.Bt + (size_t)nxt.pn * tstep : cB;
        for (int t = 0; t < nt; t += 2) {
            const bool last = (t == nt - 2);
            const char* a1 = cA + (size_t)(t + 1) * kstep;
            const char* a2 = last ? nA : cA + (size_t)(t + 2) * kstep; const char* b2 = last ? nB : cB + (size_t)(t + 2) * kstep;
            const char* a3 = a2 + kstep; const char* b3 = b2 + kstep;
            if (last && has_next) S.a_ready(nxt);
            if constexpr (SP2) {
            PG8_LDB(B0, 0, 0); PG8_LDB(B1, 0, 1); PG8_SCHED; PG8_LDA(At, 0, 0); PG8_STAGE(PG8_SA(1, 1), a1 + hstep, voffA);
            PG8_WAIT_V(8); PG8_WAIT_L(0); PG8_BAR; PG8_MMA(0, 0, At, B0); PG8_MMA(0, 1, At, B1); PG8_BAR; PG8_SCHED;
            PG8_LDA(At, 0, 1); PG8_STAGE(PG8_SB(0, 0), b2, voffB); PG8_STAGE(PG8_SB(0, 1), b2 + hstep, voffB); PG8_STAGE(PG8_SA(0, 0), a2, voffA);
            PG8_WAIT_V(8); PG8_WAIT_L(0); PG8_BAR; PG8_MMA(1, 0, At, B0); PG8_MMA(1, 1, At, B1); PG8_BAR; PG8_SCHED;
            PG8_LDB(B0, 1, 0); PG8_LDB(B1, 1, 1); PG8_SCHED; PG8_LDA(At, 1, 0); PG8_STAGE(PG8_SA(0, 1), a2 + hstep, voffA);
            PG8_WAIT_V(8); PG8_WAIT_L(0); PG8_BAR; PG8_MMA(0, 0, At, B0); PG8_MMA(0, 1, At, B1); PG8_BAR; PG8_SCHED;
            PG8_LDA(At, 1, 1); PG8_STAGE(PG8_SB(1, 0), b3, voffB); PG8_STAGE(PG8_SB(1, 1), b3 + hstep, voffB); PG8_STAGE(PG8_SA(1, 0), a3, voffA);
            PG8_WAIT_V(8); PG8_WAIT_L(0); PG8_BAR; PG8_MMA(1, 0, At, B0); PG8_MMA(1, 1, At, B1); PG8_BAR; PG8_SCHED;
            } else {
            PG8_LDB(B0, 0, 0); PG8_SCHED; PG8_LDA(At, 0, 0); PG8_STAGE(PG8_SA(1, 1), a1 + hstep, voffA);
            PG8_WAIT_L(8); PG8_BAR; PG8_WAIT_L(0); PG8_MMA(0, 0, At, B0); PG8_BAR; PG8_SCHED;
            PG8_LDB(B1, 0, 1); PG8_STAGE(PG8_SB(0, 0), b2, voffB);
            PG8_BAR; PG8_WAIT_L(0); PG8_MMA(0, 1, At, B1); PG8_BAR;
            PG8_LDA(At, 0, 1); PG8_STAGE(PG8_SA(0, 0), a2, voffA);
            PG8_BAR; PG8_WAIT_L(0); PG8_MMA(1, 0, At, B0); PG8_BAR; PG8_SCHED;
            PG8_STAGE(PG8_SB(0, 1), b2 + hstep, voffB);
            PG8_WAIT_V(6); PG8_BAR; PG8_MMA(1, 1, At, B1); PG8_BAR;
            PG8_LDB(B0, 1, 0); PG8_SCHED; PG8_LDA(At, 1, 0); PG8_STAGE(PG8_SA(0, 1), a2 + hstep, voffA);
            PG8_WAIT_L(8); PG8_BAR; PG8_WAIT_L(0); PG8_MMA(0, 0, At, B0); PG8_BAR; PG8_SCHED;
            PG8_LDB(B1, 1, 1); PG8_STAGE(PG8_SB(1, 0), b3, voffB);
            PG8_BAR; PG8_WAIT_L(0); PG8_MMA(0, 1, At, B1); PG8_BAR;
            PG8_LDA(At, 1, 1); PG8_STAGE(PG8_SA(1, 0), a3, voffA);
            PG8_BAR; PG8_WAIT_L(0); PG8_MMA(1, 0, At, B0); PG8_BAR; PG8_SCHED;
            PG8_STAGE(PG8_SB(1, 1), b3 + hstep, voffB);
            PG8_WAIT_V(6); PG8_BAR; PG8_MMA(1, 1, At, B1); PG8_BAR;
            }
        }
        if constexpr (ALIGN_EPI) { if (wr == 0) PG8_BAR; }
        if constexpr (!Epi::AFTER_DRAIN) { E(acc, cur, wr, wc, fr, fq); S.done(cur); }
        if (!has_next) break;
#pragma unroll
        for (int a = 0; a < 2; ++a)
#pragma unroll
            for (int b = 0; b < 2; ++b)
#pragma unroll
                for (int m = 0; m < 4; ++m)
#pragma unroll
                    for (int n = 0; n < 2; ++n) acc[a][b][m][n] = (f32x4){0.f, 0.f, 0.f, 0.f};
        cur = nxt; cA = nA; cB = nB; ++ui;
        if constexpr (ALIGN_EPI) { if (wr == 1) PG8_BAR; }
    }
    PG8_WAIT_V(0);
    if constexpr (!ALIGN_EPI) { if (wr == 0) PG8_BAR; }
    PG8_BAR;
    if constexpr (Epi::AFTER_DRAIN) { E.fused(acc, cur, wr, wc, fr, fq, lds, wid, lane); S.done(cur); }
#undef PG8_SA
#undef PG8_SB
#undef PG8_STAGE
#undef PG8_LDA
#undef PG8_LDB
#undef PG8_MMA
#undef PG8_WAIT_V
#undef PG8_WAIT_L
#undef PG8_BAR
#undef PG8_SCHED
}
}

template <class Epi>
DEV void gemm_tile(char* lds, const bf16_t* __restrict__ A, int lda, const bf16_t* __restrict__ Bt, int ldb, int K, int trow, int tcol,
                   const Epi& epi) {
  const int tid = threadIdx.x, w = tid >> 6, l = tid & 63, wm = w >> 1, wn = w & 1, lr = l & 15, lq = l >> 4;
  const bf16_t* ga[4];
  const bf16_t* gb[2];
#pragma unroll
  for (int j = 0; j < 4; ++j) {
    const int c = w * 4 + j, mt = c >> 1, sl = c & 1;
    ga[j] = A + (size_t)(mt * 16 + lr) * lda + sl * 32 + lq * 8;
  }
#pragma unroll
  for (int j = 0; j < 2; ++j) {
    const int nt = w, sl = j;
    const int rowb = (nt >> 2) * 64 + (lr >> 2) * 16 + (nt & 3) * 4 + (lr & 3);
    gb[j] = Bt + (size_t)rowb * ldb + sl * 32 + lq * 8;
  }
  f32x4 acc[4][4];
#pragma unroll
  for (int i = 0; i < 4; ++i)
#pragma unroll
    for (int j = 0; j < 4; ++j) acc[i][j] = (f32x4){0.f, 0.f, 0.f, 0.f};
  u32x4 ra[4], rb[2];
  const int nk = K >> 6;
#pragma unroll
  for (int j = 0; j < 4; ++j) ra[j] = *(const u32x4*)(ga[j]);
#pragma unroll
  for (int j = 0; j < 2; ++j) rb[j] = *(const u32x4*)(gb[j]);
#pragma unroll
  for (int j = 0; j < 4; ++j) *(u32x4*)(lds + (w * 4 + j) * 1024 + l * 16) = ra[j];
#pragma unroll
  for (int j = 0; j < 2; ++j) *(u32x4*)(lds + 32768 + (w * 2 + j) * 1024 + l * 16) = rb[j];
  __syncthreads();
  for (int kt = 0; kt < nk; ++kt) {
    char* cur = lds + (kt & 1) * 49152;
    const bool more = (kt + 1 < nk);
    if (more) {
#pragma unroll
      for (int j = 0; j < 4; ++j) ra[j] = *(const u32x4*)(ga[j] + (kt + 1) * 64);
#pragma unroll
      for (int j = 0; j < 2; ++j) rb[j] = *(const u32x4*)(gb[j] + (kt + 1) * 64);
    }
#pragma unroll
    for (int s = 0; s < 2; ++s) {
      bf16x8 af[4], bfr[4];
#pragma unroll
      for (int i = 0; i < 4; ++i) af[i] = *(const bf16x8*)(cur + ((wm * 4 + i) * 2 + s) * 1024 + l * 16);
#pragma unroll
      for (int j = 0; j < 4; ++j) bfr[j] = *(const bf16x8*)(cur + 32768 + ((wn * 4 + j) * 2 + s) * 1024 + l * 16);
#pragma unroll
      for (int i = 0; i < 4; ++i)
#pragma unroll
        for (int j = 0; j < 4; ++j) acc[i][j] = __builtin_amdgcn_mfma_f32_16x16x32_bf16(bfr[j], af[i], acc[i][j], 0, 0, 0);
    }
    if (more) {
      char* nxt = lds + ((kt + 1) & 1) * 49152;
#pragma unroll
      for (int j = 0; j < 4; ++j) *(u32x4*)(nxt + (w * 4 + j) * 1024 + l * 16) = ra[j];
#pragma unroll
      for (int j = 0; j < 2; ++j) *(u32x4*)(nxt + 32768 + (w * 2 + j) * 1024 + l * 16) = rb[j];
    }
    __syncthreads();
  }
#pragma unroll
  for (int i = 0; i < 4; ++i) epi(trow + wm * 64 + i * 16 + lr, tcol + wn * 64 + lq * 16, acc[i]);
}

DEV void store16_bf16(bf16_t* dst, const f32x4 (&v)[4], float sc) {
  u32x4 a, b;
  a.x = pk2(v[0][0] * sc, v[0][1] * sc); a.y = pk2(v[0][2] * sc, v[0][3] * sc);
  a.z = pk2(v[1][0] * sc, v[1][1] * sc); a.w = pk2(v[1][2] * sc, v[1][3] * sc);
  b.x = pk2(v[2][0] * sc, v[2][1] * sc); b.y = pk2(v[2][2] * sc, v[2][3] * sc);
  b.z = pk2(v[3][0] * sc, v[3][1] * sc); b.w = pk2(v[3][2] * sc, v[3][3] * sc);
  *(u32x4*)dst = a;
  *(u32x4*)(dst + 8) = b;
}

struct EpiBf16 {
  bf16_t* O; int ldo;
  DEV void operator()(int row, int col, const f32x4 (&v)[4]) const { store16_bf16(O + (size_t)row * ldo + col, v, 1.f); }
};
struct EpiF32 {
  float* O; int ldo;
  DEV void operator()(int row, int col, const f32x4 (&v)[4]) const {
    float* d = O + (size_t)row * ldo + col;
#pragma unroll
    for (int j = 0; j < 4; ++j) *(f32x4*)(d + 4 * j) = v[j];
  }
};
struct EpiLora1 {
  bf16_t* O;
  DEV void operator()(int row, int col, const f32x4 (&v)[4]) const {
    f32x4 o[4];
#pragma unroll
    for (int j = 0; j < 4; ++j)
#pragma unroll
      for (int r = 0; r < 4; ++r) {
        const float t = v[j][r];
        o[j][r] = (col < 128) ? (1.f - 2.f * __builtin_amdgcn_rcpf(1.f + __expf(2.f * t))) : ((col < 256) ? t : sigmoidf_(t));
      }
    store16_bf16(O + (size_t)row * 384 + col, o, 1.f);
  }
};
struct EpiDecay {
  bf16_t* O; const float* w0;
  DEV void operator()(int row, int col, const f32x4 (&v)[4]) const {
    f32x4 o[4];
#pragma unroll
    for (int j = 0; j < 4; ++j)
#pragma unroll
      for (int r = 0; r < 4; ++r) {
        const float xx = w0[col + 4 * j + r] + v[j][r];
        const float nx = -xx;
        const float sp = (nx > 20.f) ? nx : __logf(1.f + __expf(nx));
        const float e = __expf(-sp - 0.5f);
        o[j][r] = 1.f - __expf(-e);
      }
    store16_bf16(O + (size_t)row * 512 + col, o, 1.f);
  }
};
struct EpiA {
  bf16_t *KD, *KKA, *KK; const float *a0, *k_k, *k_a; const bf16_t* za; int writekk;
  DEV void operator()(int row, int col, const f32x4 (&v)[4]) const {
    const bf16_t* kp = za + (size_t)row * 2048 + 512 + col;
    const u32x4 k0 = *(const u32x4*)kp, k1 = *(const u32x4*)(kp + 8);
    float kf[16];
    kf[0] = lo16(k0.x); kf[1] = hi16(k0.x); kf[2] = lo16(k0.y); kf[3] = hi16(k0.y); kf[4] = lo16(k0.z); kf[5] = hi16(k0.z); kf[6] = lo16(k0.w); kf[7] = hi16(k0.w);
    kf[8] = lo16(k1.x); kf[9] = hi16(k1.x); kf[10] = lo16(k1.y); kf[11] = hi16(k1.y); kf[12] = lo16(k1.z); kf[13] = hi16(k1.z); kf[14] = lo16(k1.w); kf[15] = hi16(k1.w);
    float kr[16], ss = 0.f;
#pragma unroll
    for (int i = 0; i < 16; ++i) { kr[i] = kf[i] * k_k[col + i]; ss += kr[i] * kr[i]; }
    ss += __shfl_xor(ss, 16);
    ss += __shfl_xor(ss, 32);
    const float rn = rsqrtf(ss + 1e-12f);
    f32x4 okd[4], okka[4], okk[4];
#pragma unroll
    for (int j = 0; j < 4; ++j)
#pragma unroll
      for (int r = 0; r < 4; ++r) {
        const int i = 4 * j + r;
        const float a = sigmoidf_(a0[col + i] + v[j][r]);
        const float kk = kr[i] * rn;
        okd[j][r] = kf[i] * (1.f + (a - 1.f) * k_a[col + i]);
        okka[j][r] = kk * a;
        okk[j][r] = kk;
      }
    store16_bf16(KD + (size_t)row * 512 + col, okd, 1.f);
    store16_bf16(KKA + (size_t)row * 512 + col, okka, 1.f);
    if (writekk) store16_bf16(KK + (size_t)row * 512 + col, okk, 1.f);
  }
};
struct EpiDftc {
  bf16_t* CST; int g;
  DEV void operator()(int row, int col, const f32x4 (&v)[4]) const {
    const int b = col >> 12, s = col & 4095;
    store16_bf16(CST + ((size_t)((b * 2 + (row >> 7)) * 1024 + g * 128 + (row & 127)) * 4096 + s), v, 1.f);
  }
};

DEV void transpose_convert(char* lds, const float* __restrict__ W, int K, int N, bf16_t* __restrict__ Wt, int ldt, int rot) {
  float* tile = (float*)lds;
  const int tn_n = N >> 6, nt = (K >> 6) * tn_n, tid = threadIdx.x;
  for (int t = (blockIdx.x + rot) % gridDim.x; t < nt; t += gridDim.x) {
    const int tk = t / tn_n, tn = t % tn_n;
    for (int i = tid; i < 4096; i += NTHR) {
      const int r = i >> 6, cc = i & 63;
      tile[r * 65 + cc] = W[(size_t)(tk * 64 + r) * N + tn * 64 + cc];
    }
    __syncthreads();
    for (int i = tid; i < 4096; i += NTHR) {
      const int n = i >> 6, k = i & 63;
      Wt[(size_t)(tn * 64 + n) * ldt + tk * 64 + k] = f2bf(tile[k * 65 + n]);
    }
    __syncthreads();
  }
}

DEV void compute_mod(char* lds, const P& p) {
  float* cs = (float*)lds;
  float* red = (float*)(lds + 32768);
  const int tid = threadIdx.x;
  float* mod = (float*)(p.ws + W_MOD);
  bool have = false;
  for (int item = blockIdx.x; item < 192; item += gridDim.x) {
    if (!have) {
      for (int i = tid; i < 8192; i += NTHR) { const float cv = p.c[i]; cs[i] = cv / (1.f + expf(-cv)); }
      __syncthreads();
      have = true;
    }
    const int l = item / 96, cb = item % 96, col = cb * 64 + (tid & 63), kg = tid >> 6;
    float a0 = 0, a1 = 0, a2 = 0, a3 = 0, a4 = 0, a5 = 0, a6 = 0, a7 = 0;
    const float* wp = p.ada_w + ((size_t)l * 1024 + kg * 128) * 6144 + col;
    for (int k = 0; k < 128; ++k) {
      const float wv = wp[(size_t)k * 6144];
      const int kk = kg * 128 + k;
      a0 += cs[kk] * wv; a1 += cs[1024 + kk] * wv; a2 += cs[2048 + kk] * wv; a3 += cs[3072 + kk] * wv;
      a4 += cs[4096 + kk] * wv; a5 += cs[5120 + kk] * wv; a6 += cs[6144 + kk] * wv; a7 += cs[7168 + kk] * wv;
    }
    float* rp = red + kg * 512 + (tid & 63);
    rp[0] = a0; rp[64] = a1; rp[128] = a2; rp[192] = a3; rp[256] = a4; rp[320] = a5; rp[384] = a6; rp[448] = a7;
    __syncthreads();
    {
      const int b = tid >> 6, cc = tid & 63;
      float s = 0.f;
#pragma unroll
      for (int g = 0; g < 8; ++g) s += red[g * 512 + b * 64 + cc];
      mod[(size_t)(l * 8 + b) * 6144 + cb * 64 + cc] = s + p.ada_b[l * 6144 + cb * 64 + cc];
    }
    __syncthreads();
  }
}

template <bool HAS_Y, bool HAS_H>
DEV void rowpass(const float* __restrict__ xin, const bf16_t* __restrict__ yf, const float* __restrict__ gy, const float* __restrict__ gate,
                 float* __restrict__ xout, const float* __restrict__ gh, const float* __restrict__ sc, const float* __restrict__ sh,
                 bf16_t* __restrict__ h) {
  const int lane = threadIdx.x & 63, gw = blockIdx.x * 8 + (threadIdx.x >> 6), nw = gridDim.x * 8;
  for (int row = gw; row < MT; row += nw) {
    const int b = row >> 12;
    f32x4 xv[4];
#pragma unroll
    for (int i = 0; i < 4; ++i) xv[i] = *(const f32x4*)(xin + (size_t)row * 1024 + i * 256 + lane * 4);
    if (HAS_Y) {
      f32x4 yv[4];
      float ss = 0.f;
#pragma unroll
      for (int i = 0; i < 4; ++i) {
        const u32x2 yu = *(const u32x2*)(yf + (size_t)row * 1024 + i * 256 + lane * 4);
        yv[i] = (f32x4){lo16(yu.x), hi16(yu.x), lo16(yu.y), hi16(yu.y)};
        ss += yv[i][0] * yv[i][0] + yv[i][1] * yv[i][1] + yv[i][2] * yv[i][2] + yv[i][3] * yv[i][3];
      }
      ss = wave_sum(ss);
      const float rs = rsqrtf(ss * (1.f / 1024.f) + 1e-6f);
#pragma unroll
      for (int i = 0; i < 4; ++i) {
        const int col = i * 256 + lane * 4;
        const f32x4 g4 = *(const f32x4*)(gy + col), gt = *(const f32x4*)(gate + (size_t)b * 6144 + col);
        xv[i] = xv[i] + gt * (yv[i] * rs * g4);
        *(f32x4*)(xout + (size_t)row * 1024 + col) = xv[i];
      }
    }
    if (HAS_H) {
      float ss = 0.f;
#pragma unroll
      for (int i = 0; i < 4; ++i) ss += xv[i][0] * xv[i][0] + xv[i][1] * xv[i][1] + xv[i][2] * xv[i][2] + xv[i][3] * xv[i][3];
      ss = wave_sum(ss);
      const float rs = rsqrtf(ss * (1.f / 1024.f) + 1e-6f);
#pragma unroll
      for (int i = 0; i < 4; ++i) {
        const int col = i * 256 + lane * 4;
        const f32x4 g4 = *(const f32x4*)(gh + col), s4 = *(const f32x4*)(sc + (size_t)b * 6144 + col), h4 = *(const f32x4*)(sh + (size_t)b * 6144 + col);
        const f32x4 o = (xv[i] * rs * g4) * (s4 + 1.f) + h4;
        u32x2 pk;
        pk.x = pk2(o[0], o[1]); pk.y = pk2(o[2], o[3]);
        *(u32x2*)(h + (size_t)row * 1024 + col) = pk;
      }
    }
  }
}

DEV void unpack8(const u32x4 u, float (&f)[8]) {
  f[0] = lo16(u.x); f[1] = hi16(u.x); f[2] = lo16(u.y); f[3] = hi16(u.y); f[4] = lo16(u.z); f[5] = hi16(u.z); f[6] = lo16(u.w); f[7] = hi16(u.w);
}
DEV u32x4 pack8(const float (&f)[8]) {
  u32x4 u;
  u.x = pk2(f[0], f[1]); u.y = pk2(f[2], f[3]); u.z = pk2(f[4], f[5]); u.w = pk2(f[6], f[7]);
  return u;
}

DEV void prep1(const P& p) {
  const bf16_t* z = (const bf16_t*)(p.ws + O_Z);
  bf16_t* za = (bf16_t*)p.out;
  bf16_t* qr = (bf16_t*)(p.ws + O_QR);
  bf16_t* kr = (bf16_t*)(p.ws + O_KR);
  bf16_t* vt = (bf16_t*)(p.ws + O_VT);
  const float* rope = (const float*)(p.ws + W_ROPE);
  const int gt = blockIdx.x * NTHR + threadIdx.x, ngt = gridDim.x * NTHR;
  for (int idx = gt; idx < MT * 256; idx += ngt) {
    const int tok = idx >> 8, c8 = (idx & 255) * 8, s = tok & 4095;
    const bf16_t* zp = z + (size_t)tok * INC + c8;
    float zc[8], zm[8], zn[8], o[8];
    unpack8(*(const u32x4*)zp, zc);
    if (s > 0) unpack8(*(const u32x4*)(zp - INC), zm); else { for (int i = 0; i < 8; ++i) zm[i] = 0.f; }
    if (s < 4095) unpack8(*(const u32x4*)(zp + INC), zn); else { for (int i = 0; i < 8; ++i) zn[i] = 0.f; }
#pragma unroll
    for (int i = 0; i < 8; ++i) o[i] = zm[i] * p.mix_conv[c8 + i] + zc[i] * p.mix_conv[2048 + c8 + i] + zn[i] * p.mix_conv[4096 + c8 + i];
    *(u32x4*)(za + (size_t)tok * 2048 + c8) = pack8(o);
  }
  for (int idx = gt; idx < MT * 64; idx += ngt) {
    const int e8 = idx & 3, which = (idx >> 2) & 1, h = (idx >> 3) & 7, tok = idx >> 6, s = tok & 4095;
    const bf16_t* src = z + (size_t)tok * INC + 2048 + which * 512 + h * 64 + e8 * 8;
    float x1[8], x2[8], o1[8], o2[8];
    unpack8(*(const u32x4*)src, x1);
    unpack8(*(const u32x4*)(src + 32), x2);
    const float* rp = rope + ((size_t)s * 32 + e8 * 8) * 2;
    const float scl = which ? 1.f : 0.125f;
#pragma unroll
    for (int i = 0; i < 8; ++i) {
      const float cv = rp[2 * i], sv = rp[2 * i + 1];
      o1[i] = (x1[i] * cv - x2[i] * sv) * scl;
      o2[i] = (x2[i] * cv + x1[i] * sv) * scl;
    }
    bf16_t* dst = (which ? kr : qr) + (size_t)tok * 512 + h * 64 + e8 * 8;
    *(u32x4*)dst = pack8(o1);
    *(u32x4*)(dst + 32) = pack8(o2);
  }
  {
    const int lane = threadIdx.x & 63, gw = blockIdx.x * 8 + (threadIdx.x >> 6), nw = gridDim.x * 8;
    for (int item = gw; item < 3 * 4096; item += nw) {
      const int br = item >> 12, rem = item & 4095, b = rem >> 9, h = (rem >> 6) & 7, nb = rem & 63;
      const int dsh = 2 * br;
      const int Mr = 4096 >> dsh;
      const int pp = nb * 64 + lane, rsd = pp / Mr, m = pp % Mr, s = (m << dsh) + rsd;
      const bf16_t* src = z + (size_t)(b * 4096 + s) * INC + 3072 + h * 64;
      bf16_t* dst = vt + ((size_t)((br * 8 + b) * 8 + h) * 64) * 4096 + pp;
#pragma unroll
      for (int c = 0; c < 8; ++c) {
        const u32x4 u = *(const u32x4*)(src + c * 8);
        dst[(size_t)(c * 8 + 0) * 4096] = (bf16_t)(u.x & 0xffff); dst[(size_t)(c * 8 + 1) * 4096] = (bf16_t)(u.x >> 16);
        dst[(size_t)(c * 8 + 2) * 4096] = (bf16_t)(u.y & 0xffff); dst[(size_t)(c * 8 + 3) * 4096] = (bf16_t)(u.y >> 16);
        dst[(size_t)(c * 8 + 4) * 4096] = (bf16_t)(u.z & 0xffff); dst[(size_t)(c * 8 + 5) * 4096] = (bf16_t)(u.z >> 16);
        dst[(size_t)(c * 8 + 6) * 4096] = (bf16_t)(u.w & 0xffff); dst[(size_t)(c * 8 + 7) * 4096] = (bf16_t)(u.w >> 16);
      }
    }
  }
}

DEV void attention(const P& p) {
  const bf16_t* qr = (const bf16_t*)(p.ws + O_QR);
  const bf16_t* kr = (const bf16_t*)(p.ws + O_KR);
  const bf16_t* vt = (const bf16_t*)(p.ws + O_VT);
  float* num = (float*)(p.ws + O_NUM);
  float* md = (float*)(p.ws + O_MD);
  const int lane = threadIdx.x & 63, lr = lane & 15, lq = lane >> 4;
  const int gw = blockIdx.x * 8 + (threadIdx.x >> 6), nw = gridDim.x * 8;
  for (int item = gw; item < 3 * 4096 * 4; item += nw) {
    const int mt = item & 3, nb = (item >> 2) & 63, h = (item >> 8) & 7, b = (item >> 11) & 7, br = item >> 14;
    const int dsh = 2 * br, Mr = 4096 >> dsh;
    const int seg = (nb * 64) / Mr, segstart = seg * Mr, segend = segstart + Mr;
    const bool pv_ok = (nb * 64 - 64 >= segstart), nx_ok = (nb * 64 + 128 <= segend);
    const int qp = nb * 64 + mt * 16 + lr;
    const int qtok = b * 4096 + (((qp - segstart) << dsh) + seg);
    bf16x8 qf[2];
    qf[0] = *(const bf16x8*)(qr + (size_t)qtok * 512 + h * 64 + lq * 8);
    qf[1] = *(const bf16x8*)(qr + (size_t)qtok * 512 + h * 64 + 32 + lq * 8);
    f32x4 sacc[12];
#pragma unroll
    for (int kt = 0; kt < 12; ++kt) {
      const int kb = kt >> 2;
      int blk = nb + kb - 1;
      if ((kb == 0 && !pv_ok) || (kb == 2 && !nx_ok)) blk = nb;
      const int kp = blk * 64 + (kt & 3) * 16 + lr;
      const int ktok = b * 4096 + (((kp - segstart) << dsh) + seg);
      const bf16x8 k0 = *(const bf16x8*)(kr + (size_t)ktok * 512 + h * 64 + lq * 8);
      const bf16x8 k1 = *(const bf16x8*)(kr + (size_t)ktok * 512 + h * 64 + 32 + lq * 8);
      f32x4 a = (f32x4){0.f, 0.f, 0.f, 0.f};
      a = __builtin_amdgcn_mfma_f32_16x16x32_bf16(k0, qf[0], a, 0, 0, 0);
      a = __builtin_amdgcn_mfma_f32_16x16x32_bf16(k1, qf[1], a, 0, 0, 0);
      sacc[kt] = a;
    }
    const int qi = mt * 16 + lr;
    float mx = -1e30f;
#pragma unroll
    for (int kt = 0; kt < 12; ++kt) {
      const int kb = kt >> 2;
#pragma unroll
      for (int r = 0; r < 4; ++r) {
        const int kj = (kt & 3) * 16 + lq * 4 + r;
        bool ok = true;
        if (kb == 0) ok = pv_ok && (kj >= qi);
        if (kb == 2) ok = nx_ok && (kj <= qi);
        const float sv = ok ? sacc[kt][r] : -1e30f;
        sacc[kt][r] = sv;
        mx = fmaxf(mx, sv);
      }
    }
    mx = fmaxf(mx, __shfl_xor(mx, 16));
    mx = fmaxf(mx, __shfl_xor(mx, 32));
    float den = 0.f;
#pragma unroll
    for (int kt = 0; kt < 12; ++kt)
#pragma unroll
      for (int r = 0; r < 4; ++r) {
        const float pe = __expf(sacc[kt][r] - mx);
        sacc[kt][r] = pe;
        den += pe;
      }
    den += __shfl_xor(den, 16);
    den += __shfl_xor(den, 32);
    f32x4 oacc[4];
#pragma unroll
    for (int et = 0; et < 4; ++et) oacc[et] = (f32x4){0.f, 0.f, 0.f, 0.f};
    const bf16_t* vbase = vt + ((size_t)((br * 8 + b) * 8 + h) * 64) * 4096;
#pragma unroll
    for (int t = 0; t < 6; ++t) {
      const int kb = t >> 1;
      int blk = nb + kb - 1;
      if ((kb == 0 && !pv_ok) || (kb == 2 && !nx_ok)) blk = nb;
      const int kp0 = blk * 64 + ((2 * t) & 3) * 16 + lq * 4;
      const int kp1 = blk * 64 + ((2 * t + 1) & 3) * 16 + lq * 4;
      u32x4 pu;
      pu.x = pk2(sacc[2 * t][0], sacc[2 * t][1]); pu.y = pk2(sacc[2 * t][2], sacc[2 * t][3]);
      pu.z = pk2(sacc[2 * t + 1][0], sacc[2 * t + 1][1]); pu.w = pk2(sacc[2 * t + 1][2], sacc[2 * t + 1][3]);
      const bf16x8 pf = __builtin_bit_cast(bf16x8, pu);
#pragma unroll
      for (int et = 0; et < 4; ++et) {
        const bf16_t* vrow = vbase + (size_t)(et * 16 + lr) * 4096;
        const u32x2 v0 = *(const u32x2*)(vrow + kp0), v1 = *(const u32x2*)(vrow + kp1);
        u32x4 vu;
        vu.x = v0.x; vu.y = v0.y; vu.z = v1.x; vu.w = v1.y;
        oacc[et] = __builtin_amdgcn_mfma_f32_16x16x32_bf16(__builtin_bit_cast(bf16x8, vu), pf, oacc[et], 0, 0, 0);
      }
    }
    float* np = num + ((size_t)br * MT + qtok) * 512 + h * 64 + lq * 4;
#pragma unroll
    for (int et = 0; et < 4; ++et) *(f32x4*)(np + et * 16) = oacc[et];
    if (lq == 0) {
      f32x2 o;
      o.x = mx; o.y = den;
      *(f32x2*)(md + (((size_t)br * MT + qtok) * 8 + h) * 2) = o;
    }
  }
}

DEV void combineA(const P& p) {
  const float* num = (const float*)(p.ws + O_NUM);
  const float* md = (const float*)(p.ws + O_MD);
  bf16_t* ycat = (bf16_t*)(p.ws + O_YCAT);
  const int gt = blockIdx.x * NTHR + threadIdx.x, ngt = gridDim.x * NTHR;
  for (int idx = gt; idx < MT * 128; idx += ngt) {
    const int e4 = idx & 15, h = (idx >> 4) & 7, tok = idx >> 7;
    f32x2 m0 = *(const f32x2*)(md + (((size_t)0 * MT + tok) * 8 + h) * 2);
    f32x2 m1 = *(const f32x2*)(md + (((size_t)1 * MT + tok) * 8 + h) * 2);
    f32x2 m2 = *(const f32x2*)(md + (((size_t)2 * MT + tok) * 8 + h) * 2);
    const float ma = fmaxf(m0.x, fmaxf(m1.x, m2.x));
    const float e0 = __expf(m0.x - ma), e1 = __expf(m1.x - ma), e2 = __expf(m2.x - ma);
    const float dn = e0 * m0.y + e1 * m1.y + e2 * m2.y;
    const f32x4 n0 = *(const f32x4*)(num + ((size_t)0 * MT + tok) * 512 + h * 64 + e4 * 4);
    const f32x4 n1 = *(const f32x4*)(num + ((size_t)1 * MT + tok) * 512 + h * 64 + e4 * 4);
    const f32x4 n2 = *(const f32x4*)(num + ((size_t)2 * MT + tok) * 512 + h * 64 + e4 * 4);
    const f32x4 o = (n0 * e0 + n1 * e1 + n2 * e2) * (1.f / dn);
    u32x2 pk;
    pk.x = pk2(o[0], o[1]); pk.y = pk2(o[2], o[3]);
    *(u32x2*)(ycat + (size_t)tok * 1024 + 512 + h * 64 + e4 * 4) = pk;
  }
}

DEV float dpp_allreduce16(float x) {
  x += __int_as_float(__builtin_amdgcn_update_dpp(0, __float_as_int(x), 0xB1, 0xF, 0xF, true));
  x += __int_as_float(__builtin_amdgcn_update_dpp(0, __float_as_int(x), 0x4E, 0xF, 0xF, true));
  x += __int_as_float(__builtin_amdgcn_update_dpp(0, __float_as_int(x), 0x141, 0xF, 0xF, true));
  x += __int_as_float(__builtin_amdgcn_update_dpp(0, __float_as_int(x), 0x140, 0xF, 0xF, true));
  return x;
}

DEV void scan_phase(char* lds, const P& p) {
  const bf16_t* omw = (const bf16_t*)(p.ws + O_OMW);
  const bf16_t* kd = (const bf16_t*)(p.ws + O_KD);
  const bf16_t* kka = (const bf16_t*)(p.ws + O_KKA);
  const bf16_t* kk = (const bf16_t*)(p.ws + O_KK);
  const bf16_t* za = (const bf16_t*)p.out;
  float* Y = (float*)(p.ws + O_Y);
  float* inb = (float*)lds;
  float* ypart = (float*)(lds + 98304);
  const int tid = threadIdx.x, w = tid >> 6, lane = tid & 63, rg = lane >> 4, jl = lane & 15, j0 = jl * 4;
  for (int it = blockIdx.x; it < 256; it += gridDim.x) {
    const int sc = it >> 1, half = it & 1, d = sc >> 6, b = (sc >> 3) & 7, h = sc & 7;
    const int rowl = w * 4 + rg, row = half * 32 + rowl;
    const bf16_t* src[3];
    int dsto[3], stepi[3], isw[3];
#pragma unroll
    for (int q = 0; q < 3; ++q) {
      const int pid = tid + q * NTHR, i = pid / 48, rem = pid % 48, arr = rem >> 3, pc = rem & 7;
      const bf16_t* base;
      size_t ld;
      if (arr == 0) { base = omw + (size_t)d * MT * 512 + h * 64; ld = 512; }
      else if (arr == 1) { base = kd + (size_t)d * MT * 512 + h * 64; ld = 512; }
      else if (arr == 2) { base = kka + (size_t)d * MT * 512 + h * 64; ld = 512; }
      else if (arr == 3) { base = kk + h * 64; ld = 512; }
      else if (arr == 4) { base = za + h * 64; ld = 2048; }
      else { base = za + 1024 + h * 64; ld = 2048; }
      const int t0 = d ? (4095 - i) : i;
      src[q] = base + ((size_t)(b * 4096 + t0)) * ld + pc * 8;
      stepi[q] = (int)ld * 32 * (d ? -1 : 1);
      dsto[q] = i * 384 + arr * 64 + pc * 8;
      isw[q] = (arr == 0);
    }
    f32x2 s01 = (f32x2){0.f, 0.f}, s23 = (f32x2){0.f, 0.f};
    u32x4 rg_[3];
#pragma unroll
    for (int q = 0; q < 3; ++q) rg_[q] = *(const u32x4*)(src[q]);
#pragma unroll
    for (int q = 0; q < 3; ++q) {
      float f[8];
      unpack8(rg_[q], f);
      if (isw[q]) { for (int i = 0; i < 8; ++i) f[i] = 1.f - f[i]; }
      *(f32x4*)(inb + dsto[q]) = (f32x4){f[0], f[1], f[2], f[3]};
      *(f32x4*)(inb + dsto[q] + 4) = (f32x4){f[4], f[5], f[6], f[7]};
    }
    __syncthreads();
    for (int c = 0; c < 128; ++c) {
      const float* cur = inb + (c & 1) * 12288;
      float* yp = ypart + (c & 1) * 4096 + rowl * 4 + (jl >> 2);
      if (c + 1 < 128) {
#pragma unroll
        for (int q = 0; q < 3; ++q) rg_[q] = *(const u32x4*)(src[q] + (ptrdiff_t)stepi[q] * (c + 1));
      }
      f32x4 w4 = *(const f32x4*)(cur + j0), kd4 = *(const f32x4*)(cur + 64 + j0), ka4 = *(const f32x4*)(cur + 128 + j0),
            kk4 = *(const f32x4*)(cur + 192 + j0), r4 = *(const f32x4*)(cur + 256 + j0);
      float v = cur[320 + row];
#pragma unroll 8
      for (int i = 0; i < 32; ++i) {
        const float* sn = cur + ((i + 1) & 31) * 384;
        const f32x4 nw4 = *(const f32x4*)(sn + j0), nkd4 = *(const f32x4*)(sn + 64 + j0), nka4 = *(const f32x4*)(sn + 128 + j0),
                    nkk4 = *(const f32x4*)(sn + 192 + j0), nr4 = *(const f32x4*)(sn + 256 + j0);
        const float nv = sn[320 + row];
        const f32x2 t = s01 * kk4.xy + s23 * kk4.zw;
        const float sk = dpp_allreduce16(t.x + t.y);
        const f32x2 a01 = kd4.xy * v - ka4.xy * sk, a23 = kd4.zw * v - ka4.zw * sk;
        s01 = s01 * w4.xy + a01;
        s23 = s23 * w4.zw + a23;
        const f32x2 u = s01 * r4.xy + s23 * r4.zw;
        float y = u.x + u.y;
        y += __int_as_float(__builtin_amdgcn_update_dpp(0, __float_as_int(y), 0xB1, 0xF, 0xF, true));
        y += __int_as_float(__builtin_amdgcn_update_dpp(0, __float_as_int(y), 0x4E, 0xF, 0xF, true));
        yp[i * 128] = y;
        w4 = nw4; kd4 = nkd4; ka4 = nka4; kk4 = nkk4; r4 = nr4; v = nv;
      }
      if (c + 1 < 128) {
        float* nb_ = inb + ((c + 1) & 1) * 12288;
#pragma unroll
        for (int q = 0; q < 3; ++q) {
          float f[8];
          unpack8(rg_[q], f);
          if (isw[q]) { for (int i = 0; i < 8; ++i) f[i] = 1.f - f[i]; }
          *(f32x4*)(nb_ + dsto[q]) = (f32x4){f[0], f[1], f[2], f[3]};
          *(f32x4*)(nb_ + dsto[q] + 4) = (f32x4){f[4], f[5], f[6], f[7]};
        }
      }
      __syncthreads();
      {
        const int idx = tid * 2, i = idx >> 5, rl = idx & 31;
        const int t = d ? (4095 - (c * 32 + i)) : (c * 32 + i);
        const float* q = ypart + (c & 1) * 4096 + idx * 4;
        const f32x4 q0 = *(const f32x4*)q, q1 = *(const f32x4*)(q + 4);
        f32x2 o;
        o.x = (q0[0] + q0[1]) + (q0[2] + q0[3]);
        o.y = (q1[0] + q1[1]) + (q1[2] + q1[3]);
        *(f32x2*)(Y + ((size_t)d * MT + b * 4096 + t) * 512 + h * 64 + half * 32 + rl) = o;
      }
    }
    __syncthreads();
  }
}

DEV void postB(const P& p) {
  const float* Y = (const float*)(p.ws + O_Y);
  const bf16_t* kd = (const bf16_t*)(p.ws + O_KD);
  const bf16_t* gg = (const bf16_t*)(p.ws + O_G);
  const bf16_t* za = (const bf16_t*)p.out;
  bf16_t* ycat = (bf16_t*)(p.ws + O_YCAT);
  const int lane = threadIdx.x & 63, sub = lane >> 4, jl = lane & 15, gw = blockIdx.x * 8 + (threadIdx.x >> 6), nw = gridDim.x * 8;
  for (int it = gw; it < MT * 2; it += nw) {
    const int item = it * 4 + sub, tok = item >> 3, h = item & 7, c = h * 64 + jl * 4;
    const f32x4 y0 = *(const f32x4*)(Y + (size_t)tok * 512 + c), y1 = *(const f32x4*)(Y + ((size_t)MT + tok) * 512 + c);
    const u32x2 k0 = *(const u32x2*)(kd + (size_t)tok * 512 + c), k1 = *(const u32x2*)(kd + ((size_t)MT + tok) * 512 + c);
    const u32x2 ru = *(const u32x2*)(za + (size_t)tok * 2048 + c), vu = *(const u32x2*)(za + (size_t)tok * 2048 + 1024 + c), gu = *(const u32x2*)(gg + (size_t)tok * 512 + c);
    const f32x4 lw = *(const f32x4*)(p.lnx_w + c), lb = *(const f32x4*)(p.lnx_b + c), rk = *(const f32x4*)(p.r_k + c);
    const f32x4 y = y0 + y1;
    const float mu = dpp_allreduce16((y[0] + y[1]) + (y[2] + y[3])) * (1.f / 64.f);
    const f32x4 dv = y - mu;
    const float var = dpp_allreduce16((dv[0] * dv[0] + dv[1] * dv[1]) + (dv[2] * dv[2] + dv[3] * dv[3])) * (1.f / 64.f);
    const float rs = rsqrtf(var + 64e-5f);
    const f32x4 r = (f32x4){lo16(ru.x), hi16(ru.x), lo16(ru.y), hi16(ru.y)}, v = (f32x4){lo16(vu.x), hi16(vu.x), lo16(vu.y), hi16(vu.y)};
    const f32x4 g = (f32x4){lo16(gu.x), hi16(gu.x), lo16(gu.y), hi16(gu.y)};
    const f32x4 kds = (f32x4){lo16(k0.x) + lo16(k1.x), hi16(k0.x) + hi16(k1.x), lo16(k0.y) + lo16(k1.y), hi16(k0.y) + hi16(k1.y)};
    const f32x4 t = r * kds * rk;
    const float bs = dpp_allreduce16((t[0] + t[1]) + (t[2] + t[3]));
    const f32x4 o = (dv * rs * lw + lb + v * bs) * g;
    u32x2 pk;
    pk.x = pk2(o[0], o[1]); pk.y = pk2(o[2], o[3]);
    *(u32x2*)(ycat + (size_t)tok * 1024 + c) = pk;
  }
}

DEV void glu_pass(const P& p, int l) {
  const bf16_t* zf = (const bf16_t*)(p.ws + O_ZF);
  bf16_t* act = (bf16_t*)(p.ws + O_ACT);
  const float* cw = p.ffn_conv + (size_t)l * 3 * 5632;
  const int gt = blockIdx.x * NTHR + threadIdx.x, ngt = gridDim.x * NTHR;
  constexpr int RL = 16;
  for (int item = gt; item < (16384 / RL) * 352; item += ngt) {
    const int run = item / 352, c8 = (item - run * 352) * 8, row0 = run * RL, s0 = row0 & 4095;
    float wg0[8], wg1[8], wg2[8], wv0[8], wv1[8], wv2[8];
#pragma unroll
    for (int i = 0; i < 8; i += 4) {
      *(f32x4*)(wg0 + i) = *(const f32x4*)(cw + c8 + i); *(f32x4*)(wg1 + i) = *(const f32x4*)(cw + 5632 + c8 + i); *(f32x4*)(wg2 + i) = *(const f32x4*)(cw + 11264 + c8 + i);
      *(f32x4*)(wv0 + i) = *(const f32x4*)(cw + 2816 + c8 + i); *(f32x4*)(wv1 + i) = *(const f32x4*)(cw + 5632 + 2816 + c8 + i); *(f32x4*)(wv2 + i) = *(const f32x4*)(cw + 11264 + 2816 + c8 + i);
    }
    const bf16_t* zp = zf + (size_t)row0 * 5632 + c8;
    u32x4 pg = (u32x4){0u, 0u, 0u, 0u}, pv = pg;
    if (s0 > 0) { pg = *(const u32x4*)(zp - 5632); pv = *(const u32x4*)(zp - 5632 + 2816); }
    u32x4 cg_ = *(const u32x4*)zp, cv = *(const u32x4*)(zp + 2816);
#pragma unroll 4
    for (int r = 0; r < RL; ++r) {
      u32x4 ng = (u32x4){0u, 0u, 0u, 0u}, nv = ng;
      if (s0 + r < 4095) { ng = *(const u32x4*)(zp + (size_t)(r + 1) * 5632); nv = *(const u32x4*)(zp + (size_t)(r + 1) * 5632 + 2816); }
      float gm[8], gc[8], gn[8], vm[8], vc[8], vn[8], o[8];
      unpack8(pg, gm); unpack8(cg_, gc); unpack8(ng, gn); unpack8(pv, vm); unpack8(cv, vc); unpack8(nv, vn);
#pragma unroll
      for (int i = 0; i < 8; ++i) {
        const float g = gm[i] * wg0[i] + gc[i] * wg1[i] + gn[i] * wg2[i];
        const float vv = vm[i] * wv0[i] + vc[i] * wv1[i] + vn[i] * wv2[i];
        const float u2 = -1.5957691216057308f * (g + 0.044715f * g * g * g);
        const float ge = g * __builtin_amdgcn_rcpf(1.f + __expf(u2));
        o[i] = ge * vv;
      }
      *(u32x4*)(act + (size_t)(row0 + r) * 2816 + c8) = pack8(o);
      pg = cg_; pv = cv; cg_ = ng; cv = nv;
    }
  }
}

template <class Epi>
DEV void gemm_grid(char* lds, const bf16_t* A, int lda, const bf16_t* Bt, int ldb, int K, int tilesM, int tilesN, const Epi& epi) {
  const int nt = tilesM * tilesN;
  for (int t = blockIdx.x; t < nt; t += gridDim.x) {
    const int tm = t / tilesN, tn = t % tilesN;
    gemm_tile(lds, A + (size_t)tm * 256 * lda, lda, Bt + (size_t)tn * 128 * ldb, ldb, K, tm * 256, tn * 128, epi);
  }
}


DEV void dft_combine(const P& p) {
  const float* EO = (const float*)(p.ws + O_EO);
  const bf16_t* CST = (const bf16_t*)(p.ws + O_CST);
  bf16_t* f = (bf16_t*)(p.ws + O_F);
  for (int idx = blockIdx.x * NTHR + threadIdx.x; idx < 8 * 2048 * 256; idx += gridDim.x * NTHR) {
    const int c4 = (idx & 255) * 4, k1 = (idx >> 8) & 2047, b = idx >> 19;
    const f32x4 e = *(const f32x4*)(EO + ((size_t)(b * 2) * 2048 + k1) * 1024 + c4), o = *(const f32x4*)(EO + ((size_t)(b * 2 + 1) * 2048 + k1) * 1024 + c4);
    const f32x4 d = e - o, s = e + o;
    u32x2 pk;
    pk.x = pk2(d[0], d[1]); pk.y = pk2(d[2], d[3]);
    *(u32x2*)(f + ((size_t)b * 4096 + k1) * 1024 + c4) = pk;
    if (k1 > 0) {
      pk.x = pk2(s[0], s[1]); pk.y = pk2(s[2], s[3]);
      *(u32x2*)(f + ((size_t)b * 4096 + 4096 - k1) * 1024 + c4) = pk;
    }
  }
  {
    const int lane = threadIdx.x & 63, gw = blockIdx.x * 8 + (threadIdx.x >> 6), nw = gridDim.x * 8;
    for (int r = gw; r < 8 * 1024; r += nw) {
      const int b = r >> 10, n = r & 1023;
      const bf16_t* cp = CST + ((size_t)(b * 2) * 1024 + n) * 4096;
      float acc = 0.f;
#pragma unroll
      for (int j = 0; j < 8; ++j) {
        const u32x4 u = *(const u32x4*)(cp + j * 512 + lane * 8);
        acc += (lo16(u.x) - hi16(u.x)) + (lo16(u.y) - hi16(u.y)) + (lo16(u.z) - hi16(u.z)) + (lo16(u.w) - hi16(u.w));
      }
      acc = wave_sum(acc);
      if (lane == 0) f[((size_t)b * 4096 + 2048) * 1024 + n] = f2bf(acc * (1.f / 64.f));
    }
  }
}

#define LDSP ((PG8_LAS unsigned char*)lds)
template <class Epi>
DEV void pgemm(char* lds, const bf16_t* A, const bf16_t* Bt, int M_, int N_, int K_, const Epi& E) {
  pg8::Gemm g{A, Bt, M_, N_, K_};
  pg8::StaticOrder S;
  S.init(M_, N_, (int)gridDim.x, (int)blockIdx.x);
  pg8::gemm_phase<Epi, pg8::StaticOrder, true, true>(LDSP, g, S, E);
}

DEV void ffn(char* lds, const XcdBarrier& xbar, const P& p, int l) {
  const bf16_t* h = (const bf16_t*)(p.ws + O_H);
  bf16_t* zf = (bf16_t*)(p.ws + O_ZF);
  bf16_t* act = (bf16_t*)(p.ws + O_ACT);
  bf16_t* yf = (bf16_t*)(p.ws + O_YF);
  const bf16_t* upt = (const bf16_t*)(p.ws + W_UP) + (size_t)l * 5632 * 1024;
  const bf16_t* dnt = (const bf16_t*)(p.ws + W_DOWN) + (size_t)l * 1024 * 2816;
  for (int half = 0; half < 2; ++half) {
    pgemm(lds, h + (size_t)half * 16384 * 1024, upt, 16384, 5632, 1024, pg8::PEpiBf16<false>{zf, 5632});
    xcd_barrier(xbar);
    for (int rep_ = 0; rep_ < REP_GLU; ++rep_) { glu_pass(p, l); xcd_barrier(xbar); }
    pgemm(lds, act, dnt, 16384, 1024, 2816, pg8::PEpiBf16<false>{yf + (size_t)half * 16384 * 1024, 1024});
  }
  xcd_barrier(xbar);
}

__global__ void __launch_bounds__(NTHR) mega(P p) {
  extern __shared__ __attribute__((aligned(16))) char lds[];
  cg::grid_group grid = cg::this_grid();
  char* ws = p.ws;
  if (threadIdx.x < 4) ((unsigned*)(lds + 131072))[threadIdx.x] = 0u;
  __syncthreads();
  const XcdBarrier xbar = xcd_barrier_post((unsigned*)(ws + W_BAR), (volatile XLAS unsigned*)(lds + 131072));
  float* mod = (float*)(ws + W_MOD);
  const int gt = blockIdx.x * NTHR + threadIdx.x, ngt = gridDim.x * NTHR;

  compute_mod(lds, p);
  transpose_convert(lds, p.mix_in, 1024, 3584, (bf16_t*)(ws + W_MIXIN), 1024, 0);
  for (int l = 0; l < 2; ++l) {
    transpose_convert(lds, p.ffn_up + (size_t)l * 1024 * 5632, 1024, 5632, (bf16_t*)(ws + W_UP) + (size_t)l * 5632 * 1024, 1024, 64 * l);
    transpose_convert(lds, p.ffn_down + (size_t)l * 2816 * 1024, 2816, 1024, (bf16_t*)(ws + W_DOWN) + (size_t)l * 1024 * 2816, 2816, 128 + 64 * l);
  }
  transpose_convert(lds, p.mix_out, 1024, 1024, (bf16_t*)(ws + W_MIXOUT), 1024, 32);
  transpose_convert(lds, p.fnet_w, 1024, 1024, (bf16_t*)(ws + W_FNET), 1024, 96);
  for (int d = 0; d < 2; ++d) {
    transpose_convert(lds, p.w1 + (size_t)d * 512 * 64, 512, 64, (bf16_t*)(ws + W_L1) + (size_t)(d * 64) * 512, 512, 8 * d);
    transpose_convert(lds, p.a1 + (size_t)d * 512 * 64, 512, 64, (bf16_t*)(ws + W_L1) + (size_t)(128 + d * 64) * 512, 512, 16 + 8 * d);
    transpose_convert(lds, p.w2 + (size_t)d * 64 * 512, 64, 512, (bf16_t*)(ws + W_W2) + (size_t)d * 512 * 64, 64, 48 + 8 * d);
    transpose_convert(lds, p.a2 + (size_t)d * 64 * 512, 64, 512, (bf16_t*)(ws + W_A2) + (size_t)d * 512 * 64, 64, 64 + 8 * d);
  }
  transpose_convert(lds, p.g1, 512, 128, (bf16_t*)(ws + W_L1) + (size_t)256 * 512, 512, 32);
  transpose_convert(lds, p.g2, 128, 512, (bf16_t*)(ws + W_G2), 128, 80);
  {
    float* rope = (float*)(ws + W_ROPE);
    for (int idx = gt; idx < 4096 * 32; idx += ngt) {
      const int s = idx >> 5, e = idx & 31;
      const float inv = powf(10000.f, -(float)e / 32.f);
      const float ang = (float)s * inv;
      float sv, cv;
      sincosf(ang, &sv, &cv);
      rope[2 * idx] = cv;
      rope[2 * idx + 1] = sv;
    }
    bf16_t* dftc = (bf16_t*)(ws + W_DFTC);
    for (int idx = gt; idx < 256 * 128; idx += ngt) {
      const int n = idx >> 7, c = idx & 127, k2 = n & 127;
      const float ph = (float)((k2 * c) & 127) * (1.f / 64.f);
      const float v = (n < 128) ? cospif(ph) : sinpif(ph);
      dftc[idx] = f2bf(v * 0.08838834764831845f);
    }
  }
  grid.sync();
  for (int rep_ = 0; rep_ < REP_ROW; ++rep_) { rowpass<false, true>(p.x, nullptr, nullptr, nullptr, nullptr, p.norm_g, mod + 1024, mod, (bf16_t*)(ws + O_H0)); xcd_barrier(xbar); }
  pgemm(lds, (const bf16_t*)(ws + O_H0), (const bf16_t*)(ws + W_MIXIN), MT, INC, 1024, pg8::PEpiBf16<false>{(bf16_t*)(ws + O_Z), INC});
  xcd_barrier(xbar);
  for (int rep_ = 0; rep_ < REP_PREP; ++rep_) { prep1(p); xcd_barrier(xbar); }
  for (int rep_ = 0; rep_ < REP_ATT; ++rep_) { attention(p); xcd_barrier(xbar); }
  combineA(p);
  gemm_grid(lds, (const bf16_t*)p.out + 1536, 2048, (const bf16_t*)(ws + W_L1), 512, 512, 128, 3, EpiLora1{(bf16_t*)(ws + O_L1)});
  xcd_barrier(xbar);
  for (int d = 0; d < 2; ++d) {
    gemm_grid(lds, (const bf16_t*)(ws + O_L1) + d * 64, 384, (const bf16_t*)(ws + W_W2) + (size_t)d * 512 * 64, 64, 64, 128, 4,
              EpiDecay{(bf16_t*)(ws + O_OMW) + (size_t)d * MT * 512, p.w0 + d * 512});
    gemm_grid(lds, (const bf16_t*)(ws + O_L1) + 128 + d * 64, 384, (const bf16_t*)(ws + W_A2) + (size_t)d * 512 * 64, 64, 64, 128, 4,
              EpiA{(bf16_t*)(ws + O_KD) + (size_t)d * MT * 512, (bf16_t*)(ws + O_KKA) + (size_t)d * MT * 512, (bf16_t*)(ws + O_KK), p.a0 + d * 512,
                   p.k_k, p.k_a, (const bf16_t*)p.out, d == 0});
  }
  gemm_grid(lds, (const bf16_t*)(ws + O_L1) + 256, 384, (const bf16_t*)(ws + W_G2), 128, 128, 128, 4, EpiBf16{(bf16_t*)(ws + O_G), 512});
  xcd_barrier(xbar);
  for (int rep_ = 0; rep_ < REP_SCAN; ++rep_) { scan_phase(lds, p); xcd_barrier(xbar); }
  for (int rep_ = 0; rep_ < REP_SYNC; ++rep_) xcd_barrier(xbar);
  postB(p);
  xcd_barrier(xbar);
  pgemm(lds, (const bf16_t*)(ws + O_YCAT), (const bf16_t*)(ws + W_MIXOUT), MT, 1024, 1024, pg8::PEpiBf16<false>{(bf16_t*)(ws + O_YF), 1024});
  xcd_barrier(xbar);
  rowpass<true, true>(p.x, (const bf16_t*)(ws + O_YF), p.norm_g + 1024, mod + 2048, p.out, p.norm_g + 2048, mod + 4096, mod + 3072, (bf16_t*)(ws + O_H));
  xcd_barrier(xbar);
  ffn(lds, xbar, p, 0);
  {
    const float* mod1 = mod + 8 * 6144;
    rowpass<true, true>(p.out, (const bf16_t*)(ws + O_YF), p.norm_g + 3072, mod + 5120, p.out, p.norm_g + 4096, mod1 + 1024, mod1, (bf16_t*)(ws + O_H));
    bf16_t* cs = (bf16_t*)(ws + O_COSSIN);
    for (int idx = blockIdx.x * NTHR + threadIdx.x; idx < 4096 * 512; idx += gridDim.x * NTHR) {
      const int rr = idx >> 9, s8 = (idx & 511) * 8, k1 = rr & 2047;
      float o[8];
#pragma unroll
      for (int i = 0; i < 8; ++i) {
        const float ph = (float)((k1 * (s8 + i)) & 4095) * (1.f / 2048.f);
        o[i] = ((rr < 2048) ? cospif(ph) : sinpif(ph)) * (1.f / 64.f);
      }
      *(u32x4*)(cs + (size_t)rr * 4096 + s8) = pack8(o);
    }
    xcd_barrier(xbar);
    for (int t = blockIdx.x; t < 8 * 256; t += gridDim.x) {
      const int g = t >> 8, tn = t & 255;
      gemm_tile(lds, (const bf16_t*)(ws + W_DFTC), 128, (const bf16_t*)(ws + O_H) + (size_t)tn * 128 * 1024 + g * 128, 1024, 128, 0, tn * 128,
                EpiDftc{(bf16_t*)(ws + O_CST), g});
    }
    xcd_barrier(xbar);
    {
      pg8::Gemm g{(const bf16_t*)(ws + O_COSSIN), (const bf16_t*)(ws + O_CST), 4096, 16384, 4096};
      pg8::BatchOrder S{(int)gridDim.x, (int)blockIdx.x};
      pg8::gemm_phase<pg8::PEpiF32B, pg8::BatchOrder, true, true>(LDSP, g, S, pg8::PEpiF32B{(float*)(ws + O_EO)});
    }
    xcd_barrier(xbar);
    dft_combine(p);
    xcd_barrier(xbar);
    pgemm(lds, (const bf16_t*)(ws + O_F), (const bf16_t*)(ws + W_FNET), MT, 1024, 1024, pg8::PEpiBf16<false>{(bf16_t*)(ws + O_YF), 1024});
    xcd_barrier(xbar);
    rowpass<true, true>(p.out, (const bf16_t*)(ws + O_YF), p.norm_g + 4096 + 1024, mod1 + 2048, p.out, p.norm_g + 4096 + 2048, mod1 + 4096, mod1 + 3072,
                        (bf16_t*)(ws + O_H));
    xcd_barrier(xbar);
    ffn(lds, xbar, p, 1);
    rowpass<true, false>(p.out, (const bf16_t*)(ws + O_YF), p.norm_g + 4096 + 3072, mod1 + 5120, p.out, nullptr, nullptr, nullptr, nullptr);
  }
}

extern "C" void kernel_launch(void* const* d_in, const int* in_sizes, int n_in, void* d_out, int out_size, void* d_ws, size_t ws_size,
                              hipStream_t stream) {
  static int grid_blocks = 0;
  if (!grid_blocks) {
    int dev = 0, cus = 0, per_cu = 0;
    hipGetDevice(&dev);
    hipDeviceGetAttribute(&cus, hipDeviceAttributeMultiprocessorCount, dev);
    hipFuncSetAttribute((const void*)mega, hipFuncAttributeMaxDynamicSharedMemorySize, LDS_BYTES);
    hipOccupancyMaxActiveBlocksPerMultiprocessor(&per_cu, (const void*)mega, NTHR, LDS_BYTES);
    if (per_cu < 1) { fprintf(stderr, "occupancy query returned %d\n", per_cu); per_cu = 1; }
    if (per_cu > 1) per_cu = 1;
    grid_blocks = cus * per_cu;
  }
  P p{};
  const float** pp = (const float**)&p;
  for (int i = 0; i < 25; ++i) pp[i] = (const float*)d_in[i];
  p.out = (float*)d_out;
  p.ws = (char*)d_ws;
  (void)hipMemsetAsync((char*)d_ws + W_BAR, 0, XCD_BAR_WORDS * sizeof(unsigned), stream);
  void* args[] = {&p};
  hipError_t e = hipLaunchCooperativeKernel((const void*)mega, dim3(grid_blocks), dim3(NTHR), args, LDS_BYTES, stream);
  if (e != hipSuccess) fprintf(stderr, "cooperative launch failed: %s (grid %d)\n", hipGetErrorString(e), grid_blocks);
}
```

```cpp
#include <hip/hip_runtime.h>
#include <hip/hip_cooperative_groups.h>
#include <stdint.h>
#include <cstdio>
namespace cg = cooperative_groups;

typedef unsigned short bf16_t;
typedef short bf16x8 __attribute__((ext_vector_type(8)));
typedef short s16x4 __attribute__((ext_vector_type(4)));
typedef float f32x4 __attribute__((ext_vector_type(4)));
typedef float f32x2 __attribute__((ext_vector_type(2)));
typedef unsigned u32x4 __attribute__((ext_vector_type(4)));
typedef unsigned u32x2 __attribute__((ext_vector_type(2)));

#define DEV __device__ __forceinline__

constexpr int NB = 8, SEQ = 4096, DM = 1024, MT = NB * SEQ, DFF = 2816, INC = 3584;
constexpr size_t MiB = 1024 * 1024;
constexpr int NTHR = 512;
constexpr int LDS_BYTES = 131072 + 16;
constexpr size_t W_BAR = 47 * 1024 * 1024;
#ifndef REP_SCAN
#define REP_SCAN 1
#endif
#ifndef REP_ATT
#define REP_ATT 1
#endif
#ifndef REP_SYNC
#define REP_SYNC 0
#endif
#ifndef REP_PREP
#define REP_PREP 1
#endif
#ifndef REP_LORA
#define REP_LORA 1
#endif
#ifndef REP_GLU
#define REP_GLU 1
#endif
#ifndef REP_PRO
#define REP_PRO 1
#endif
#ifndef REP_ROW
#define REP_ROW 1
#endif

constexpr size_t W_MIXIN = 0;
constexpr size_t W_UP = 7 * MiB;
constexpr size_t W_DOWN = 29 * MiB;
constexpr size_t W_MIXOUT = 40 * MiB;
constexpr size_t W_FNET = 42 * MiB;
constexpr size_t W_L1 = 44 * MiB;
constexpr size_t W_W2 = W_L1 + 512 * 1024;
constexpr size_t W_A2 = W_W2 + 128 * 1024;
constexpr size_t W_G2 = W_A2 + 128 * 1024;
constexpr size_t W_DFTC = W_G2 + 128 * 1024;
constexpr size_t W_MOD = 45 * MiB;
constexpr size_t W_ROPE = 46 * MiB;
constexpr size_t R0 = 48 * MiB;
constexpr size_t O_H0 = R0;
constexpr size_t O_Z = 112 * MiB;
constexpr size_t O_QR = 336 * MiB, O_KR = 368 * MiB, O_VT = 400 * MiB;
constexpr size_t O_NUM = R0;
constexpr size_t O_MD = 240 * MiB;
constexpr size_t O_YCAT = 448 * MiB;
constexpr size_t O_OMW = 48 * MiB, O_KD = 112 * MiB, O_KKA = 176 * MiB, O_KK = 240 * MiB, O_G = 272 * MiB, O_L1 = 304 * MiB, O_Y = 304 * MiB;
constexpr size_t O_YF = 48 * MiB;
constexpr size_t O_H = 176 * MiB;
constexpr size_t O_ZF = 240 * MiB;
constexpr size_t O_ACT = 416 * MiB;
constexpr size_t O_COSSIN = 240 * MiB;
constexpr size_t O_CST = 304 * MiB;
constexpr size_t O_F = 432 * MiB;
constexpr size_t O_EO = 48 * MiB;

struct P {
  const float *x, *c, *ada_w, *ada_b, *norm_g, *mix_in, *mix_conv, *w0, *w1, *w2, *a0, *a1, *a2, *g1, *g2, *k_k, *k_a, *r_k, *lnx_w,
      *lnx_b, *mix_out, *fnet_w, *ffn_up, *ffn_conv, *ffn_down;
  float* out;
  char* ws;
};

DEV float bf2f(bf16_t h) { return __uint_as_float(((unsigned)h) << 16); }
DEV bf16_t f2bf(float f) {
  unsigned u = __float_as_uint(f);
  u += 0x7fffu + ((u >> 16) & 1u);
  return (bf16_t)(u >> 16);
}
DEV unsigned pk2(float a, float b) { return (unsigned)f2bf(a) | ((unsigned)f2bf(b) << 16); }
DEV float lo16(unsigned u) { return __uint_as_float(u << 16); }
DEV float hi16(unsigned u) { return __uint_as_float(u & 0xffff0000u); }
DEV float wave_sum(float v) {
#pragma unroll
  for (int o = 32; o; o >>= 1) v += __shfl_xor(v, o);
  return v;
}
DEV float sigmoidf_(float x) { return __builtin_amdgcn_rcpf(1.f + __expf(-x)); }

#include <cstdint>
#include <cstdlib>
#include <vector>

#define XB_TMO      128
#define XB_XCNT(j)  (256  + 64 * (j))
#define XB_XSUB(j)  (1280 + 64 * (j))
#define XB_XGEN(j)  (2304 + 64 * (j))
#define XB_TOP      3328
#define XB_TOPGEN   3392
#define XCD_BAR_WORDS 3456
#define XB_SPIN_CAP (1u << 18)
#define XLAS __attribute__((address_space(3)))

__device__ __forceinline__ unsigned xb_ld(unsigned* p)              { return __hip_atomic_load(p, __ATOMIC_RELAXED, __HIP_MEMORY_SCOPE_AGENT); }
__device__ __forceinline__ unsigned xb_add(unsigned* p, unsigned v) { return __hip_atomic_fetch_add(p, v, __ATOMIC_RELAXED, __HIP_MEMORY_SCOPE_AGENT); }
__device__ __forceinline__ unsigned xb_xcc_id() { return (unsigned)__builtin_amdgcn_s_getreg((3 << 11) | 20) & 0xFu; }
#define XB_SPIN(cond, bar) do { unsigned _sp = 0; while (cond) { __builtin_amdgcn_s_sleep(1); \
    if ((++_sp & 255u) == 0u) { if (xb_ld(&(bar)[XB_TMO])) break; if (_sp > XB_SPIN_CAP) { atomicAdd(&(bar)[XB_TMO], 1u); break; } } } } while (0)

struct XcdBarrier {
    unsigned* bar; unsigned x;
    volatile XLAS unsigned* st;
};

__device__ __forceinline__ XcdBarrier xcd_barrier_post(unsigned* bar, volatile XLAS unsigned* st) {
    XcdBarrier b; b.bar = bar; b.x = xb_xcc_id(); b.st = st;
    if (threadIdx.x == 0) (void)xb_add(&bar[XB_XCNT(b.x)], 1u);
    return b;
}
__device__ __forceinline__ void xcd_barrier_complete(unsigned* bar, unsigned x, unsigned& nloc, unsigned& nx) {
    const unsigned G = gridDim.x * gridDim.y * gridDim.z;
    unsigned sum, cnt, mine, sp = 0u;
    for (;;) {
        sum = 0u; cnt = 0u; mine = 0u;
#pragma unroll
        for (unsigned j = 0; j < 16; ++j) { const unsigned c = xb_ld(&bar[XB_XCNT(j)]); sum += c; cnt += (c > 0u) ? 1u : 0u; mine = (j == x) ? c : mine; }
        if (sum == G) break;
        __builtin_amdgcn_s_sleep(1);
        if ((++sp & 255u) == 0u) { if (xb_ld(&bar[XB_TMO])) break; if (sp > XB_SPIN_CAP) { atomicAdd(&bar[XB_TMO], 1u); break; } }
    }
    nloc = mine > 0u ? mine : 1u; nx = cnt > 0u ? cnt : 1u;
}

__device__ __forceinline__ void xcd_barrier(const XcdBarrier& b) {
    asm volatile("s_waitcnt vmcnt(0)" ::: "memory");
    __syncthreads();
    if (threadIdx.x == 0) {
        unsigned* bar = b.bar;
        __builtin_amdgcn_s_waitcnt(0);
        unsigned nloc = b.st[0], nx = b.st[1];
        if (nloc == 0u) { xcd_barrier_complete(bar, b.x, nloc, nx); b.st[0] = nloc; b.st[1] = nx; }
        const unsigned old = xb_add(&bar[XB_XSUB(b.x)], 1u);
        const unsigned gen = old / nloc;
        if (old + 1u == (gen + 1u) * nloc) {
            __builtin_amdgcn_fence(__ATOMIC_RELEASE, "agent");
            asm volatile("s_waitcnt vmcnt(0)" ::: "memory");
            const unsigned og = xb_add(&bar[XB_TOP], 1u);
            const unsigned tg = og / nx;
            if (og + 1u == (tg + 1u) * nx) xb_add(&bar[XB_TOPGEN], 1u);
            else XB_SPIN(xb_ld(&bar[XB_TOPGEN]) == tg, bar);
            __builtin_amdgcn_fence(__ATOMIC_ACQUIRE, "agent");
            xb_add(&bar[XB_XGEN(b.x)], 1u);
            asm volatile("s_waitcnt vmcnt(0)" ::: "memory");
        } else {
            XB_SPIN(xb_ld(&bar[XB_XGEN(b.x)]) == gen, bar);
            __builtin_amdgcn_fence(__ATOMIC_ACQUIRE, "agent");
            asm volatile("s_waitcnt vmcnt(0)" ::: "memory");
        }
    }
    __syncthreads();
}

namespace pg8 {
#define PG8_LAS __attribute__((address_space(3)))
typedef unsigned short bf16_t;
typedef short bf16x8 __attribute__((ext_vector_type(8)));
typedef float f32x4 __attribute__((ext_vector_type(4)));
typedef unsigned u32x4 __attribute__((ext_vector_type(4)));
constexpr int BM = 256, BK = 64, HALF = 128, HTB = HALF * BK * 2  , STAGE_BYTES = 8 * HTB, NXCD = 8, WGM = 8;

__host__ __device__ __forceinline__ int lds_byte(int r, int c) { const int st = (r >> 4) * 2 + (c >> 5), rr = r & 15, cc = c & 31, ob = rr * 64 + cc * 2; return st * 1024 + (ob ^ (((ob >> 9) & 1) << 5)); }
__host__ __device__ __forceinline__ void stage_rc(int b, int& R, int& C) { const int st = b / 1024, sb = b % 1024, swz = sb ^ (((sb >> 9) & 1) << 5); R = (st >> 1) * 16 + swz / 64; C = (st & 1) * 32 + (swz % 64) / 2; }
__host__ __device__ __forceinline__ int perm32(int rho) { const int n = rho >> 4, i = rho & 15; return 8 * (i >> 2) + 4 * n + (i & 3); }

struct Unit { int pm, pn; };
struct Gemm { const bf16_t* A; const bf16_t* Bt; int M, N, K; };

struct StaticOrder {
    int nM, nN, nwg, G, c;
    __host__ __device__ void init(int M, int N, int G_, int c_) { nM = M / BM; nN = N / BM; nwg = nM * nN; G = G_; c = c_; }
    __host__ __device__ bool next(int i, Unit& u) const {
        const long L = (long)i * G + c; if (L >= nwg) return false;
        int wgid = (int)L; { const int q = nwg / NXCD, r = nwg % NXCD, xcd = wgid % NXCD, off = wgid / NXCD; wgid = (xcd < r ? xcd * (q + 1) : r * (q + 1) + (xcd - r) * q) + off; }
        const int nig = WGM * nN, gid = wgid / nig, fm = gid * WGM, gsz = (nM - fm) < WGM ? (nM - fm) : WGM;
        u.pm = fm + ((wgid % nig) % gsz); u.pn = (wgid % nig) / gsz; return true;
    }
    __device__ __forceinline__ void a_ready(const Unit&) const {}
    __device__ __forceinline__ void done(const Unit&) const {}
};

__device__ __forceinline__ unsigned cvt_pk_bf16(float lo, float hi) { unsigned r; asm volatile("v_cvt_pk_bf16_f32 %0, %1, %2" : "=v"(r) : "v"(lo), "v"(hi)); return r; }

template <bool BATCHED> struct PEpiBf16 {
    static constexpr bool PERM = true, AFTER_DRAIN = false;
    bf16_t* O; int ldc;
    __device__ __forceinline__ void operator()(const f32x4 (&acc)[2][2][4][2], const Unit& u, int wr, int wc, int fr, int fq) const {
        const int rb = BATCHED ? ((u.pn >> 2) * 4096 + u.pm * 256) : u.pm * 256, cb = BATCHED ? (u.pn & 3) * 256 : u.pn * 256;
        const int row0 = rb + wr * 64 + fr, col0 = cb + wc * 32 + 8 * fq;
#pragma unroll
        for (int ai = 0; ai < 2; ++ai)
#pragma unroll
            for (int m = 0; m < 4; ++m) { bf16_t* rowp = O + (size_t)(row0 + ai * HALF + m * 16) * ldc + col0;
#pragma unroll
                for (int bj = 0; bj < 2; ++bj) { const f32x4 v0 = acc[ai][bj][m][0], v1 = acc[ai][bj][m][1];
                    u32x4 w; w.x = cvt_pk_bf16(v0[0], v0[1]); w.y = cvt_pk_bf16(v0[2], v0[3]); w.z = cvt_pk_bf16(v1[0], v1[1]); w.w = cvt_pk_bf16(v1[2], v1[3]);
                    *(u32x4*)(rowp + bj * HALF) = w; } }
    }
};
struct PEpiF32 {
    static constexpr bool PERM = true, AFTER_DRAIN = false;
    float* O; int ldc;
    __device__ __forceinline__ void operator()(const f32x4 (&acc)[2][2][4][2], const Unit& u, int wr, int wc, int fr, int fq) const {
        const int row0 = u.pm * 256 + wr * 64 + fr, col0 = u.pn * 256 + wc * 32 + 8 * fq;
#pragma unroll
        for (int ai = 0; ai < 2; ++ai)
#pragma unroll
            for (int m = 0; m < 4; ++m) { float* rowp = O + (size_t)(row0 + ai * HALF + m * 16) * ldc + col0;
#pragma unroll
                for (int bj = 0; bj < 2; ++bj) { *(f32x4*)(rowp + bj * HALF) = acc[ai][bj][m][0]; *(f32x4*)(rowp + bj * HALF + 4) = acc[ai][bj][m][1]; } }
    }
};
struct PEpiF32B {
    static constexpr bool PERM = true, AFTER_DRAIN = false;
    float* O;
    __device__ __forceinline__ void operator()(const f32x4 (&acc)[2][2][4][2], const Unit& u, int wr, int wc, int fr, int fq) const {
        const int row0 = (u.pn >> 2) * 2048 + (u.pm & 7) * 256 + wr * 64 + fr, col0 = (u.pn & 3) * 256 + wc * 32 + 8 * fq;
#pragma unroll
        for (int ai = 0; ai < 2; ++ai)
#pragma unroll
            for (int m = 0; m < 4; ++m) { float* rowp = O + (size_t)(row0 + ai * HALF + m * 16) * 1024 + col0;
#pragma unroll
                for (int bj = 0; bj < 2; ++bj) { *(f32x4*)(rowp + bj * HALF) = acc[ai][bj][m][0]; *(f32x4*)(rowp + bj * HALF + 4) = acc[ai][bj][m][1]; } }
    }
};
struct BatchOrder {
    int G, c;
    __device__ __forceinline__ bool next(int i, Unit& u) const { const int L = i * G + c; if (L >= 512) return false; const int be = L >> 5, r = L & 31; u.pm = (be & 1) * 8 + (r >> 2); u.pn = be * 4 + (r & 3); return true; }
    __device__ __forceinline__ void a_ready(const Unit&) const {}
    __device__ __forceinline__ void done(const Unit&) const {}
};
template <class Epi, class Sched, bool ALIGN_EPI = false, bool SP2 = false>
__device__ __forceinline__ void gemm_phase(PG8_LAS unsigned char* lds, const Gemm g, const Sched& S, const Epi& E) {
    int tid_ = threadIdx.x; asm volatile("" : "+v"(tid_));
    const int tid = tid_, wid = __builtin_amdgcn_readfirstlane(tid >> 6), lane = tid & 63, wr = wid >> 2, wc = wid & 3, fr = lane & 15, fq = lane >> 4;
    const int K = g.K, nt = K / BK;
    unsigned voffA[2], voffB[2];
#pragma unroll
    for (int i = 0; i < 2; ++i) { int R, C; stage_rc(tid * 16 + i * 8192, R, C); const int Rb = Epi::PERM ? ((R & ~31) + perm32(R & 31)) : R;
        voffA[i] = (unsigned)(R * K + C) * 2u; voffB[i] = (unsigned)(Rb * K + C) * 2u; }
    const size_t kstep = (size_t)(BK * 2);
    const size_t hstep = (size_t)HALF * K * 2;
    const size_t tstep = 2 * hstep;
    const unsigned ldsw = (unsigned)wid * 1024u;
    const int aoff = lds_byte(wr * 64 + fr, fq * 8), boff = lds_byte(wc * 32 + fr, fq * 8);
#define PG8_SA(b, h) (((b) * 2 + (h)) * HTB)
#define PG8_SB(b, h) ((4 + (b) * 2 + (h)) * HTB)
#define PG8_STAGE(bufoff, gbase, voff) do { _Pragma("unroll") for (int _i = 0; _i < 2; ++_i) \
        __builtin_amdgcn_global_load_lds((const unsigned*)((const char*)(gbase) + (voff)[_i]), (PG8_LAS unsigned*)(lds + (bufoff) + ldsw + _i * 8192), 16, 0, 0); } while (0)
#define PG8_LDA(dst, b, h) do { _Pragma("unroll") for (int m = 0; m < 4; ++m) _Pragma("unroll") for (int k = 0; k < 2; ++k) dst[m][k] = *(const PG8_LAS bf16x8*)(lds + PG8_SA(b, h) + aoff + m * 2048 + k * 1024); } while (0)
#define PG8_LDB(dst, b, h) do { _Pragma("unroll") for (int n = 0; n < 2; ++n) _Pragma("unroll") for (int k = 0; k < 2; ++k) dst[n][k] = *(const PG8_LAS bf16x8*)(lds + PG8_SB(b, h) + boff + n * 2048 + k * 1024); } while (0)
#define PG8_MMA(ai, bj, At, Bt) do { __builtin_amdgcn_s_setprio(1); _Pragma("unroll") for (int m = 0; m < 4; ++m) _Pragma("unroll") for (int n = 0; n < 2; ++n) _Pragma("unroll") for (int k = 0; k < 2; ++k) \
        acc[ai][bj][m][n] = __builtin_amdgcn_mfma_f32_16x16x32_bf16(Bt[n][k], At[m][k], acc[ai][bj][m][n], 0, 0, 0); __builtin_amdgcn_s_setprio(0); } while (0)
#define PG8_WAIT_V(n) asm volatile("s_waitcnt vmcnt(" #n ")" ::: "memory")
#define PG8_WAIT_L(n) asm volatile("s_waitcnt lgkmcnt(" #n ")" ::: "memory")
#define PG8_BAR __builtin_amdgcn_s_barrier()
#define PG8_SCHED __builtin_amdgcn_sched_barrier(0)
    Unit cur, nxt; int ui = 0;
    if (!S.next(0, cur)) return;
    f32x4 acc[2][2][4][2];
#pragma unroll
    for (int a = 0; a < 2; ++a)
#pragma unroll
        for (int b = 0; b < 2; ++b)
#pragma unroll
            for (int m = 0; m < 4; ++m)
#pragma unroll
                for (int n = 0; n < 2; ++n) acc[a][b][m][n] = (f32x4){0.f, 0.f, 0.f, 0.f};
    bf16x8 At[4][2], B0[2][2], B1[2][2];
    const char* cA = (const char*)g.A + (size_t)cur.pm * tstep; const char* cB = (const char*)g.Bt + (size_t)cur.pn * tstep;
    S.a_ready(cur);
    if constexpr (SP2) {
        PG8_STAGE(PG8_SB(0, 0), cB, voffB); PG8_STAGE(PG8_SB(0, 1), cB + hstep, voffB); PG8_STAGE(PG8_SA(0, 0), cA, voffA); PG8_STAGE(PG8_SA(0, 1), cA + hstep, voffA);
        if (wr == 1) PG8_BAR;
        PG8_WAIT_V(2); PG8_BAR;
        PG8_STAGE(PG8_SB(1, 0), cB + kstep, voffB); PG8_STAGE(PG8_SA(1, 0), cA + kstep, voffA); PG8_STAGE(PG8_SB(1, 1), cB + hstep + kstep, voffB);
        PG8_WAIT_V(6); PG8_BAR;
    } else {
        PG8_STAGE(PG8_SB(0, 0), cB, voffB); PG8_STAGE(PG8_SA(0, 0), cA, voffA); PG8_STAGE(PG8_SB(0, 1), cB + hstep, voffB); PG8_STAGE(PG8_SA(0, 1), cA + hstep, voffA);
        if (wr == 1) PG8_BAR;
        PG8_WAIT_V(4); PG8_BAR;
        PG8_STAGE(PG8_SB(1, 0), cB + kstep, voffB); PG8_STAGE(PG8_SA(1, 0), cA + kstep, voffA); PG8_STAGE(PG8_SB(1, 1), cB + hstep + kstep, voffB);
        PG8_WAIT_V(6); PG8_BAR;
    }
    for (;;) {
        const bool has_next = S.next(ui + 1, nxt);
        const char* nA = has_next ? (const char*)g.A + (size_t)nxt.pm * tstep : cA; const char* nB = has_next ? (const char*)g.Bt + (size_t)nxt.pn * tstep : cB;
        for (int t = 0; t < nt; t += 2) {
            const bool last = (t == nt - 2);
            const char* a1 = cA + (size_t)(t + 1) * kstep;
            const char* a2 = last ? nA : cA + (size_t)(t + 2) * kstep; const char* b2 = last ? nB : cB + (size_t)(t + 2) * kstep;
            const char* a3 = a2 + kstep; const char* b3 = b2 + kstep;
            if (last && has_next) S.a_ready(nxt);
            if constexpr (SP2) {
            PG8_LDB(B0, 0, 0); PG8_LDB(B1, 0, 1); PG8_SCHED; PG8_LDA(At, 0, 0); PG8_STAGE(PG8_SA(1, 1), a1 + hstep, voffA);
            PG8_WAIT_V(8); PG8_WAIT_L(0); PG8_BAR; PG8_MMA(0, 0, At, B0); PG8_MMA(0, 1, At, B1); PG8_BAR; PG8_SCHED;
            PG8_LDA(At, 0, 1); PG8_STAGE(PG8_SB(0, 0), b2, voffB); PG8_STAGE(PG8_SB(0, 1), b2 + hstep, voffB); PG8_STAGE(PG8_SA(0, 0), a2, voffA);
            PG8_WAIT_V(8); PG8_WAIT_L(0); PG8_BAR; PG8_MMA(1, 0, At, B0); PG8_MMA(1, 1, At, B1); PG8_BAR; PG8_SCHED;
            PG8_LDB(B0, 1, 0); PG8_LDB(B1, 1, 1); PG8_SCHED; PG8_LDA(At, 1, 0); PG8_STAGE(PG8_SA(0, 1), a2 + hstep, voffA);
            PG8_WAIT_V(8); PG8_WAIT_L(0); PG8_BAR; PG8_MMA(0, 0, At, B0); PG8_MMA(0, 1, At, B1); PG8_BAR; PG8_SCHED;
            PG8_LDA(At, 1, 1); PG8_STAGE(PG8_SB(1, 0), b3, voffB); PG8_STAGE(PG8_SB(1, 1), b3 + hstep, voffB); PG8_STAGE(PG8_SA(1, 0), a3, voffA);
            PG8_WAIT_V(8); PG8_WAIT_L(0); PG8_BAR; PG8_MMA(1, 0, At, B0); PG8_MMA(1, 1, At, B1); PG8_BAR; PG8_SCHED;
            } else {
            PG8_LDB(B0, 0, 0); PG8_SCHED; PG8_LDA(At, 0, 0); PG8_STAGE(PG8_SA(1, 1), a1 + hstep, voffA);
            PG8_WAIT_L(8); PG8_BAR; PG8_WAIT_L(0); PG8_MMA(0, 0, At, B0); PG8_BAR; PG8_SCHED;
            PG8_LDB(B1, 0, 1); PG8_STAGE(PG8_SB(0, 0), b2, voffB);
            PG8_BAR; PG8_WAIT_L(0); PG8_MMA(0, 1, At, B1); PG8_BAR;
            PG8_LDA(At, 0, 1); PG8_STAGE(PG8_SA(0, 0), a2, voffA);
            PG8_BAR; PG8_WAIT_L(0); PG8_MMA(1, 0, At, B0); PG8_BAR; PG8_SCHED;
            PG8_STAGE(PG8_SB(0, 1), b2 + hstep, voffB);
            PG8_WAIT_V(6); PG8_BAR; PG8_MMA(1, 1, At, B1); PG8_BAR;
            PG8_LDB(B0, 1, 0); PG8_SCHED; PG8_LDA(At, 1, 0); PG8_STAGE(PG8_SA(0, 1), a2 + hstep, voffA);
            PG8_WAIT_L(8); PG8_BAR; PG8_WAIT_L(0); PG8_MMA(0, 0, At, B0); PG8_BAR; PG8_SCHED;
            PG8_LDB(B1, 1, 1); PG8_STAGE(PG8_SB(1, 0), b3, voffB);
            PG8_BAR; PG8_WAIT_L(0); PG8_MMA(0, 1, At, B1); PG8_BAR;
            PG8_LDA(At, 1, 1); PG8_STAGE(PG8_SA(1, 0), a3, voffA);
            PG8_BAR; PG8_WAIT_L(0); PG8_MMA(1, 0, At, B0); PG8_BAR; PG8_SCHED;
            PG8_STAGE(PG8_SB(1, 1), b3 + hstep, voffB);
            PG8_WAIT_V(6); PG8_BAR; PG8_MMA(1, 1, At, B1); PG8_BAR;
            }
        }
        if constexpr (ALIGN_EPI) { if (wr == 0) PG8_BAR; }
        if constexpr (!Epi::AFTER_DRAIN) { E(acc, cur, wr, wc, fr, fq); S.done(cur); }
        if (!has_next) break;
#pragma unroll
        for (int a = 0; a < 2; ++a)
#pragma unroll
            for (int b = 0; b < 2; ++b)
#pragma unroll
                for (int m = 0; m < 4; ++m)
#pragma unroll
                    for (int n = 0; n < 2; ++n) acc[a][b][m][n] = (f32x4){0.f, 0.f, 0.f, 0.f};
        cur = nxt; cA = nA; cB = nB; ++ui;
        if constexpr (ALIGN_EPI) { if (wr == 1) PG8_BAR; }
    }
    PG8_WAIT_V(0);
    if constexpr (!ALIGN_EPI) { if (wr == 0) PG8_BAR; }
    PG8_BAR;
    if constexpr (Epi::AFTER_DRAIN) { E.fused(acc, cur, wr, wc, fr, fq, lds, wid, lane); S.done(cur); }
#undef PG8_SA
#undef PG8_SB
#undef PG8_STAGE
#undef PG8_LDA
#undef PG8_LDB
#undef PG8_MMA
#undef PG8_WAIT_V
#undef PG8_WAIT_L
#undef PG8_BAR
#undef PG8_SCHED
}
}

template <class Epi>
DEV void gemm_tile(char* lds, const bf16_t* __restrict__ A, int lda, const bf16_t* __restrict__ Bt, int ldb, int K, int trow, int tcol,
                   const Epi& epi) {
  const int tid = threadIdx.x, w = tid >> 6, l = tid & 63, wm = w >> 1, wn = w & 1, lr = l & 15, lq = l >> 4;
  const bf16_t* ga[4];
  const bf16_t* gb[2];
#pragma unroll
  for (int j = 0; j < 4; ++j) {
    const int c = w * 4 + j, mt = c >> 1, sl = c & 1;
    ga[j] = A + (size_t)(mt * 16 + lr) * lda + sl * 32 + lq * 8;
  }
#pragma unroll
  for (int j = 0; j < 2; ++j) {
    const int nt = w, sl = j;
    const int rowb = (nt >> 2) * 64 + (lr >> 2) * 16 + (nt & 3) * 4 + (lr & 3);
    gb[j] = Bt + (size_t)rowb * ldb + sl * 32 + lq * 8;
  }
  f32x4 acc[4][4];
#pragma unroll
  for (int i = 0; i < 4; ++i)
#pragma unroll
    for (int j = 0; j < 4; ++j) acc[i][j] = (f32x4){0.f, 0.f, 0.f, 0.f};
  u32x4 ra[4], rb[2];
  const int nk = K >> 6;
#pragma unroll
  for (int j = 0; j < 4; ++j) ra[j] = *(const u32x4*)(ga[j]);
#pragma unroll
  for (int j = 0; j < 2; ++j) rb[j] = *(const u32x4*)(gb[j]);
#pragma unroll
  for (int j = 0; j < 4; ++j) *(u32x4*)(lds + (w * 4 + j) * 1024 + l * 16) = ra[j];
#pragma unroll
  for (int j = 0; j < 2; ++j) *(u32x4*)(lds + 32768 + (w * 2 + j) * 1024 + l * 16) = rb[j];
  __syncthreads();
  for (int kt = 0; kt < nk; ++kt) {
    char* cur = lds + (kt & 1) * 49152;
    const bool more = (kt + 1 < nk);
    if (more) {
#pragma unroll
      for (int j = 0; j < 4; ++j) ra[j] = *(const u32x4*)(ga[j] + (kt + 1) * 64);
#pragma unroll
      for (int j = 0; j < 2; ++j) rb[j] = *(const u32x4*)(gb[j] + (kt + 1) * 64);
    }
#pragma unroll
    for (int s = 0; s < 2; ++s) {
      bf16x8 af[4], bfr[4];
#pragma unroll
      for (int i = 0; i < 4; ++i) af[i] = *(const bf16x8*)(cur + ((wm * 4 + i) * 2 + s) * 1024 + l * 16);
#pragma unroll
      for (int j = 0; j < 4; ++j) bfr[j] = *(const bf16x8*)(cur + 32768 + ((wn * 4 + j) * 2 + s) * 1024 + l * 16);
#pragma unroll
      for (int i = 0; i < 4; ++i)
#pragma unroll
        for (int j = 0; j < 4; ++j) acc[i][j] = __builtin_amdgcn_mfma_f32_16x16x32_bf16(bfr[j], af[i], acc[i][j], 0, 0, 0);
    }
    if (more) {
      char* nxt = lds + ((kt + 1) & 1) * 49152;
#pragma unroll
      for (int j = 0; j < 4; ++j) *(u32x4*)(nxt + (w * 4 + j) * 1024 + l * 16) = ra[j];
#pragma unroll
      for (int j = 0; j < 2; ++j) *(u32x4*)(nxt + 32768 + (w * 2 + j) * 1024 + l * 16) = rb[j];
    }
    __syncthreads();
  }
#pragma unroll
  for (int i = 0; i < 4; ++i) epi(trow + wm * 64 + i * 16 + lr, tcol + wn * 64 + lq * 16, acc[i]);
}

DEV void store16_bf16(bf16_t* dst, const f32x4 (&v)[4], float sc) {
  u32x4 a, b;
  a.x = pk2(v[0][0] * sc, v[0][1] * sc); a.y = pk2(v[0][2] * sc, v[0][3] * sc);
  a.z = pk2(v[1][0] * sc, v[1][1] * sc); a.w = pk2(v[1][2] * sc, v[1][3] * sc);
  b.x = pk2(v[2][0] * sc, v[2][1] * sc); b.y = pk2(v[2][2] * sc, v[2][3] * sc);
  b.z = pk2(v[3][0] * sc, v[3][1] * sc); b.w = pk2(v[3][2] * sc, v[3][3] * sc);
  *(u32x4*)dst = a;
  *(u32x4*)(dst + 8) = b;
}

struct EpiBf16 {
  bf16_t* O; int ldo;
  DEV void operator()(int row, int col, const f32x4 (&v)[4]) const { store16_bf16(O + (size_t)row * ldo + col, v, 1.f); }
};
struct EpiF32 {
  float* O; int ldo;
  DEV void operator()(int row, int col, const f32x4 (&v)[4]) const {
    float* d = O + (size_t)row * ldo + col;
#pragma unroll
    for (int j = 0; j < 4; ++j) *(f32x4*)(d + 4 * j) = v[j];
  }
};
struct EpiLora1 {
  bf16_t* O;
  DEV void operator()(int row, int col, const f32x4 (&v)[4]) const {
    f32x4 o[4];
#pragma unroll
    for (int j = 0; j < 4; ++j)
#pragma unroll
      for (int r = 0; r < 4; ++r) {
        const float t = v[j][r];
        o[j][r] = (col < 128) ? (1.f - 2.f * __builtin_amdgcn_rcpf(1.f + __expf(2.f * t))) : ((col < 256) ? t : sigmoidf_(t));
      }
    store16_bf16(O + (size_t)row * 384 + col, o, 1.f);
  }
};
struct EpiDecay {
  bf16_t* O; const float* w0;
  DEV void operator()(int row, int col, const f32x4 (&v)[4]) const {
    f32x4 o[4];
#pragma unroll
    for (int j = 0; j < 4; ++j)
#pragma unroll
      for (int r = 0; r < 4; ++r) {
        const float xx = w0[col + 4 * j + r] + v[j][r];
        const float nx = -xx;
        const float sp = (nx > 20.f) ? nx : __logf(1.f + __expf(nx));
        const float e = __expf(-sp - 0.5f);
        o[j][r] = 1.f - __expf(-e);
      }
    store16_bf16(O + (size_t)row * 512 + col, o, 1.f);
  }
};
struct EpiA {
  bf16_t *KD, *KKA, *KK; const float *a0, *k_k, *k_a; const bf16_t* za; int writekk;
  DEV void operator()(int row, int col, const f32x4 (&v)[4]) const {
    const bf16_t* kp = za + (size_t)row * 2048 + 512 + col;
    const u32x4 k0 = *(const u32x4*)kp, k1 = *(const u32x4*)(kp + 8);
    float kf[16];
    kf[0] = lo16(k0.x); kf[1] = hi16(k0.x); kf[2] = lo16(k0.y); kf[3] = hi16(k0.y); kf[4] = lo16(k0.z); kf[5] = hi16(k0.z); kf[6] = lo16(k0.w); kf[7] = hi16(k0.w);
    kf[8] = lo16(k1.x); kf[9] = hi16(k1.x); kf[10] = lo16(k1.y); kf[11] = hi16(k1.y); kf[12] = lo16(k1.z); kf[13] = hi16(k1.z); kf[14] = lo16(k1.w); kf[15] = hi16(k1.w);
    float kr[16], ss = 0.f;
#pragma unroll
    for (int i = 0; i < 16; ++i) { kr[i] = kf[i] * k_k[col + i]; ss += kr[i] * kr[i]; }
    ss += __shfl_xor(ss, 16);
    ss += __shfl_xor(ss, 32);
    const float rn = rsqrtf(ss + 1e-12f);
    f32x4 okd[4], okka[4], okk[4];
#pragma unroll
    for (int j = 0; j < 4; ++j)
#pragma unroll
      for (int r = 0; r < 4; ++r) {
        const int i = 4 * j + r;
        const float a = sigmoidf_(a0[col + i] + v[j][r]);
        const float kk = kr[i] * rn;
        okd[j][r] = kf[i] * (1.f + (a - 1.f) * k_a[col + i]);
        okka[j][r] = kk * a;
        okk[j][r] = kk;
      }
    store16_bf16(KD + (size_t)row * 512 + col, okd, 1.f);
    store16_bf16(KKA + (size_t)row * 512 + col, okka, 1.f);
    if (writekk) store16_bf16(KK + (size_t)row * 512 + col, okk, 1.f);
  }
};
struct EpiDftc {
  bf16_t* CST; int g;
  DEV void operator()(int row, int col, const f32x4 (&v)[4]) const {
    const int b = col >> 12, s = col & 4095;
    store16_bf16(CST + ((size_t)((b * 2 + (row >> 7)) * 1024 + g * 128 + (row & 127)) * 4096 + s), v, 1.f);
  }
};

DEV void transpose_convert(char* lds, const float* __restrict__ W, int K, int N, bf16_t* __restrict__ Wt, int ldt, int rot) {
  float* tile = (float*)lds;
  const int tn_n = N >> 6, nt = (K >> 6) * tn_n, tid = threadIdx.x;
  for (int t = (blockIdx.x + rot) % gridDim.x; t < nt; t += gridDim.x) {
    const int tk = t / tn_n, tn = t % tn_n;
    for (int i = tid; i < 4096; i += NTHR) {
      const int r = i >> 6, cc = i & 63;
      tile[r * 65 + cc] = W[(size_t)(tk * 64 + r) * N + tn * 64 + cc];
    }
    __syncthreads();
    for (int i = tid; i < 4096; i += NTHR) {
      const int n = i >> 6, k = i & 63;
      Wt[(size_t)(tn * 64 + n) * ldt + tk * 64 + k] = f2bf(tile[k * 65 + n]);
    }
    __syncthreads();
  }
}

DEV void compute_mod(char* lds, const P& p) {
  float* cs = (float*)lds;
  float* red = (float*)(lds + 32768);
  const int tid = threadIdx.x;
  float* mod = (float*)(p.ws + W_MOD);
  bool have = false;
  for (int item = blockIdx.x; item < 192; item += gridDim.x) {
    if (!have) {
      for (int i = tid; i < 8192; i += NTHR) { const float cv = p.c[i]; cs[i] = cv / (1.f + expf(-cv)); }
      __syncthreads();
      have = true;
    }
    const int l = item / 96, cb = item % 96, col = cb * 64 + (tid & 63), kg = tid >> 6;
    float a0 = 0, a1 = 0, a2 = 0, a3 = 0, a4 = 0, a5 = 0, a6 = 0, a7 = 0;
    const float* wp = p.ada_w + ((size_t)l * 1024 + kg * 128) * 6144 + col;
    for (int k = 0; k < 128; ++k) {
      const float wv = wp[(size_t)k * 6144];
      const int kk = kg * 128 + k;
      a0 += cs[kk] * wv; a1 += cs[1024 + kk] * wv; a2 += cs[2048 + kk] * wv; a3 += cs[3072 + kk] * wv;
      a4 += cs[4096 + kk] * wv; a5 += cs[5120 + kk] * wv; a6 += cs[6144 + kk] * wv; a7 += cs[7168 + kk] * wv;
    }
    float* rp = red + kg * 512 + (tid & 63);
    rp[0] = a0; rp[64] = a1; rp[128] = a2; rp[192] = a3; rp[256] = a4; rp[320] = a5; rp[384] = a6; rp[448] = a7;
    __syncthreads();
    {
      const int b = tid >> 6, cc = tid & 63;
      float s = 0.f;
#pragma unroll
      for (int g = 0; g < 8; ++g) s += red[g * 512 + b * 64 + cc];
      mod[(size_t)(l * 8 + b) * 6144 + cb * 64 + cc] = s + p.ada_b[l * 6144 + cb * 64 + cc];
    }
    __syncthreads();
  }
}

template <bool HAS_Y, bool HAS_H>
DEV void rowpass(const float* __restrict__ xin, const bf16_t* __restrict__ yf, const float* __restrict__ gy, const float* __restrict__ gate,
                 float* __restrict__ xout, const float* __restrict__ gh, const float* __restrict__ sc, const float* __restrict__ sh,
                 bf16_t* __restrict__ h) {
  const int lane = threadIdx.x & 63, gw = blockIdx.x * 8 + (threadIdx.x >> 6), nw = gridDim.x * 8;
  for (int row = gw; row < MT; row += nw) {
    const int b = row >> 12;
    f32x4 xv[4];
#pragma unroll
    for (int i = 0; i < 4; ++i) xv[i] = *(const f32x4*)(xin + (size_t)row * 1024 + i * 256 + lane * 4);
    if (HAS_Y) {
      f32x4 yv[4];
      float ss = 0.f;
#pragma unroll
      for (int i = 0; i < 4; ++i) {
        const u32x2 yu = *(const u32x2*)(yf + (size_t)row * 1024 + i * 256 + lane * 4);
        yv[i] = (f32x4){lo16(yu.x), hi16(yu.x), lo16(yu.y), hi16(yu.y)};
        ss += yv[i][0] * yv[i][0] + yv[i][1] * yv[i][1] + yv[i][2] * yv[i][2] + yv[i][3] * yv[i][3];
      }
      ss = wave_sum(ss);
      const float rs = rsqrtf(ss * (1.f / 1024.f) + 1e-6f);
#pragma unroll
      for (int i = 0; i < 4; ++i) {
        const int col = i * 256 + lane * 4;
        const f32x4 g4 = *(const f32x4*)(gy + col), gt = *(const f32x4*)(gate + (size_t)b * 6144 + col);
        xv[i] = xv[i] + gt * (yv[i] * rs * g4);
        *(f32x4*)(xout + (size_t)row * 1024 + col) = xv[i];
      }
    }
    if (HAS_H) {
      float ss = 0.f;
#pragma unroll
      for (int i = 0; i < 4; ++i) ss += xv[i][0] * xv[i][0] + xv[i][1] * xv[i][1] + xv[i][2] * xv[i][2] + xv[i][3] * xv[i][3];
      ss = wave_sum(ss);
      const float rs = rsqrtf(ss * (1.f / 1024.f) + 1e-6f);
#pragma unroll
      for (int i = 0; i < 4; ++i) {
        const int col = i * 256 + lane * 4;
        const f32x4 g4 = *(const f32x4*)(gh + col), s4 = *(const f32x4*)(sc + (size_t)b * 6144 + col), h4 = *(const f32x4*)(sh + (size_t)b * 6144 + col);
        const f32x4 o = (xv[i] * rs * g4) * (s4 + 1.f) + h4;
        u32x2 pk;
        pk.x = pk2(o[0], o[1]); pk.y = pk2(o[2], o[3]);
        *(u32x2*)(h + (size_t)row * 1024 + col) = pk;
      }
    }
  }
}

DEV void unpack8(const u32x4 u, float (&f)[8]) {
  f[0] = lo16(u.x); f[1] = hi16(u.x); f[2] = lo16(u.y); f[3] = hi16(u.y); f[4] = lo16(u.z); f[5] = hi16(u.z); f[6] = lo16(u.w); f[7] = hi16(u.w);
}
DEV u32x4 pack8(const float (&f)[8]) {
  u32x4 u;
  u.x = pk2(f[0], f[1]); u.y = pk2(f[2], f[3]); u.z = pk2(f[4], f[5]); u.w = pk2(f[6], f[7]);
  return u;
}

DEV void prep1(const P& p) {
  const bf16_t* z = (const bf16_t*)(p.ws + O_Z);
  bf16_t* za = (bf16_t*)p.out;
  bf16_t* qr = (bf16_t*)(p.ws + O_QR);
  bf16_t* kr = (bf16_t*)(p.ws + O_KR);
  bf16_t* vt = (bf16_t*)(p.ws + O_VT);
  const float* rope = (const float*)(p.ws + W_ROPE);
  const int gt = blockIdx.x * NTHR + threadIdx.x, ngt = gridDim.x * NTHR;
  for (int idx = gt; idx < MT * 256; idx += ngt) {
    const int tok = idx >> 8, c8 = (idx & 255) * 8, s = tok & 4095;
    const bf16_t* zp = z + (size_t)tok * INC + c8;
    float zc[8], zm[8], zn[8], o[8];
    unpack8(*(const u32x4*)zp, zc);
    if (s > 0) unpack8(*(const u32x4*)(zp - INC), zm); else { for (int i = 0; i < 8; ++i) zm[i] = 0.f; }
    if (s < 4095) unpack8(*(const u32x4*)(zp + INC), zn); else { for (int i = 0; i < 8; ++i) zn[i] = 0.f; }
#pragma unroll
    for (int i = 0; i < 8; ++i) o[i] = zm[i] * p.mix_conv[c8 + i] + zc[i] * p.mix_conv[2048 + c8 + i] + zn[i] * p.mix_conv[4096 + c8 + i];
    *(u32x4*)(za + (size_t)tok * 2048 + c8) = pack8(o);
  }
  for (int idx = gt; idx < MT * 64; idx += ngt) {
    const int e8 = idx & 3, which = (idx >> 2) & 1, h = (idx >> 3) & 7, tok = idx >> 6, s = tok & 4095;
    const bf16_t* src = z + (size_t)tok * INC + 2048 + which * 512 + h * 64 + e8 * 8;
    float x1[8], x2[8], o1[8], o2[8];
    unpack8(*(const u32x4*)src, x1);
    unpack8(*(const u32x4*)(src + 32), x2);
    const float* rp = rope + ((size_t)s * 32 + e8 * 8) * 2;
    const float scl = which ? 1.f : 0.125f;
#pragma unroll
    for (int i = 0; i < 8; ++i) {
      const float cv = rp[2 * i], sv = rp[2 * i + 1];
      o1[i] = (x1[i] * cv - x2[i] * sv) * scl;
      o2[i] = (x2[i] * cv + x1[i] * sv) * scl;
    }
    bf16_t* dst = (which ? kr : qr) + (size_t)tok * 512 + h * 64 + e8 * 8;
    *(u32x4*)dst = pack8(o1);
    *(u32x4*)(dst + 32) = pack8(o2);
  }
  {
    const int lane = threadIdx.x & 63, gw = blockIdx.x * 8 + (threadIdx.x >> 6), nw = gridDim.x * 8;
    for (int item = gw; item < 3 * 4096; item += nw) {
      const int br = item >> 12, rem = item & 4095, b = rem >> 9, h = (rem >> 6) & 7, nb = rem & 63;
      const int dsh = 2 * br;
      const int Mr = 4096 >> dsh;
      const int pp = nb * 64 + lane, rsd = pp / Mr, m = pp % Mr, s = (m << dsh) + rsd;
      const bf16_t* src = z + (size_t)(b * 4096 + s) * INC + 3072 + h * 64;
      bf16_t* dst = vt + ((size_t)((br * 8 + b) * 8 + h) * 64) * 4096 + pp;
#pragma unroll
      for (int c = 0; c < 8; ++c) {
        const u32x4 u = *(const u32x4*)(src + c * 8);
        dst[(size_t)(c * 8 + 0) * 4096] = (bf16_t)(u.x & 0xffff); dst[(size_t)(c * 8 + 1) * 4096] = (bf16_t)(u.x >> 16);
        dst[(size_t)(c * 8 + 2) * 4096] = (bf16_t)(u.y & 0xffff); dst[(size_t)(c * 8 + 3) * 4096] = (bf16_t)(u.y >> 16);
        dst[(size_t)(c * 8 + 4) * 4096] = (bf16_t)(u.z & 0xffff); dst[(size_t)(c * 8 + 5) * 4096] = (bf16_t)(u.z >> 16);
        dst[(size_t)(c * 8 + 6) * 4096] = (bf16_t)(u.w & 0xffff); dst[(size_t)(c * 8 + 7) * 4096] = (bf16_t)(u.w >> 16);
      }
    }
  }
}

DEV void attention(char* lds, const P& p) {
  const bf16_t* qr = (const bf16_t*)(p.ws + O_QR);
  const bf16_t* kr = (const bf16_t*)(p.ws + O_KR);
  const bf16_t* vt = (const bf16_t*)(p.ws + O_VT);
  float* num = (float*)(p.ws + O_NUM);
  float* md = (float*)(p.ws + O_MD);
  constexpr int UNIT_LDS = 24576 + 64 * 400;
  const int tid = threadIdx.x, w = tid >> 6, lane = tid & 63, lr = lane & 15, lq = lane >> 4;
  const int uh = tid >> 8, lt = tid & 255, mt = w & 3;
  char* ul = lds + uh * UNIT_LDS;
  u32x4 pre[12];
  auto load_pair = [&](int pi) {
    const int unit = pi * 2 + uh;
    const int nb = unit & 63, h = (unit >> 6) & 7, b = (unit >> 9) & 7, br = unit >> 12;
    const int dsh = 2 * br, Mr = 4096 >> dsh;
    const int seg = (nb * 64) / Mr, segstart = seg * Mr, segend = segstart + Mr;
    const bool pv_ok = (nb * 64 - 64 >= segstart), nx_ok = (nb * 64 + 128 <= segend);
    const bf16_t* vbase = vt + ((size_t)((br * 8 + b) * 8 + h) * 64) * 4096;
#pragma unroll
    for (int j = 0; j < 6; ++j) {
      const int pc = lt + 256 * j, key = pc >> 3, ch = pc & 7, kb = key >> 6;
      int blk = nb + kb - 1;
      if ((kb == 0 && !pv_ok) || (kb == 2 && !nx_ok)) blk = nb;
      const int kp = blk * 64 + (key & 63);
      const int ktok = b * 4096 + (((kp - segstart) << dsh) + seg);
      pre[j] = *(const u32x4*)(kr + (size_t)ktok * 512 + h * 64 + ch * 8);
    }
#pragma unroll
    for (int j = 0; j < 6; ++j) {
      const int pc = lt + 256 * j, e = pc / 24, ch = pc - e * 24, kb = ch >> 3;
      int blk = nb + kb - 1;
      if ((kb == 0 && !pv_ok) || (kb == 2 && !nx_ok)) blk = nb;
      pre[6 + j] = *(const u32x4*)(vbase + (size_t)e * 4096 + blk * 64 + (ch & 7) * 8);
    }
  };
  const int npairs = 3 * 4096 / 2;
  int pi = blockIdx.x;
  if (pi < npairs) load_pair(pi);
  for (; pi < npairs; pi += gridDim.x) {
#pragma unroll
    for (int j = 0; j < 6; ++j) {
      const int pc = lt + 256 * j, key = pc >> 3, ch = pc & 7;
      *(u32x4*)(ul + key * 128 + ((ch ^ (key & 7)) * 16)) = pre[j];
    }
#pragma unroll
    for (int j = 0; j < 6; ++j) {
      const int pc = lt + 256 * j, e = pc / 24, ch = pc - e * 24;
      *(u32x4*)(ul + 24576 + e * 400 + ch * 16) = pre[6 + j];
    }
    __syncthreads();
    const int unit = pi * 2 + uh;
    const int nb = unit & 63, h = (unit >> 6) & 7, b = (unit >> 9) & 7, br = unit >> 12;
    const int dsh = 2 * br, Mr = 4096 >> dsh;
    const int seg = (nb * 64) / Mr, segstart = seg * Mr, segend = segstart + Mr;
    const bool pv_ok = (nb * 64 - 64 >= segstart), nx_ok = (nb * 64 + 128 <= segend);
    const int qp = nb * 64 + mt * 16 + lr;
    const int qtok = b * 4096 + (((qp - segstart) << dsh) + seg);
    bf16x8 qf[2];
    qf[0] = *(const bf16x8*)(qr + (size_t)qtok * 512 + h * 64 + lq * 8);
    qf[1] = *(const bf16x8*)(qr + (size_t)qtok * 512 + h * 64 + 32 + lq * 8);
    if (pi + (int)gridDim.x < npairs) load_pair(pi + gridDim.x);
    f32x4 sacc[12];
#pragma unroll
    for (int kt = 0; kt < 12; ++kt) {
      const int key = kt * 16 + lr;
      const bf16x8 k0 = *(const bf16x8*)(ul + key * 128 + ((lq ^ (key & 7)) * 16));
      const bf16x8 k1 = *(const bf16x8*)(ul + key * 128 + (((4 + lq) ^ (key & 7)) * 16));
      f32x4 a = (f32x4){0.f, 0.f, 0.f, 0.f};
      a = __builtin_amdgcn_mfma_f32_16x16x32_bf16(k0, qf[0], a, 0, 0, 0);
      a = __builtin_amdgcn_mfma_f32_16x16x32_bf16(k1, qf[1], a, 0, 0, 0);
      sacc[kt] = a;
    }
    const int qi = mt * 16 + lr;
    float mx = -1e30f;
#pragma unroll
    for (int kt = 0; kt < 12; ++kt) {
      const int kb = kt >> 2;
#pragma unroll
      for (int r = 0; r < 4; ++r) {
        const int kj = (kt & 3) * 16 + lq * 4 + r;
        bool ok = true;
        if (kb == 0) ok = pv_ok && (kj >= qi);
        if (kb == 2) ok = nx_ok && (kj <= qi);
        const float sv = ok ? sacc[kt][r] : -1e30f;
        sacc[kt][r] = sv;
        mx = fmaxf(mx, sv);
      }
    }
    mx = fmaxf(mx, __shfl_xor(mx, 16));
    mx = fmaxf(mx, __shfl_xor(mx, 32));
    float den = 0.f;
#pragma unroll
    for (int kt = 0; kt < 12; ++kt)
#pragma unroll
      for (int r = 0; r < 4; ++r) {
        const float pe = __expf(sacc[kt][r] - mx);
        sacc[kt][r] = pe;
        den += pe;
      }
    den += __shfl_xor(den, 16);
    den += __shfl_xor(den, 32);
    f32x4 oacc[4];
#pragma unroll
    for (int et = 0; et < 4; ++et) oacc[et] = (f32x4){0.f, 0.f, 0.f, 0.f};
#pragma unroll
    for (int t = 0; t < 6; ++t) {
      u32x4 pu;
      pu.x = pk2(sacc[2 * t][0], sacc[2 * t][1]); pu.y = pk2(sacc[2 * t][2], sacc[2 * t][3]);
      pu.z = pk2(sacc[2 * t + 1][0], sacc[2 * t + 1][1]); pu.w = pk2(sacc[2 * t + 1][2], sacc[2 * t + 1][3]);
      const bf16x8 pf = __builtin_bit_cast(bf16x8, pu);
#pragma unroll
      for (int et = 0; et < 4; ++et) {
        const char* vrow = ul + 24576 + (et * 16 + lr) * 400 + t * 64 + lq * 8;
        const u32x2 v0 = *(const u32x2*)vrow, v1 = *(const u32x2*)(vrow + 32);
        u32x4 vu;
        vu.x = v0.x; vu.y = v0.y; vu.z = v1.x; vu.w = v1.y;
        oacc[et] = __builtin_amdgcn_mfma_f32_16x16x32_bf16(__builtin_bit_cast(bf16x8, vu), pf, oacc[et], 0, 0, 0);
      }
    }
    float* np = num + ((size_t)br * MT + qtok) * 512 + h * 64 + lq * 4;
#pragma unroll
    for (int et = 0; et < 4; ++et) *(f32x4*)(np + et * 16) = oacc[et];
    if (lq == 0) {
      f32x2 o;
      o.x = mx; o.y = den;
      *(f32x2*)(md + (((size_t)br * MT + qtok) * 8 + h) * 2) = o;
    }
    __syncthreads();
  }
}

DEV void combineA(const P& p) {
  const float* num = (const float*)(p.ws + O_NUM);
  const float* md = (const float*)(p.ws + O_MD);
  bf16_t* ycat = (bf16_t*)(p.ws + O_YCAT);
  const int gt = blockIdx.x * NTHR + threadIdx.x, ngt = gridDim.x * NTHR;
  for (int idx = gt; idx < MT * 128; idx += ngt) {
    const int e4 = idx & 15, h = (idx >> 4) & 7, tok = idx >> 7;
    f32x2 m0 = *(const f32x2*)(md + (((size_t)0 * MT + tok) * 8 + h) * 2);
    f32x2 m1 = *(const f32x2*)(md + (((size_t)1 * MT + tok) * 8 + h) * 2);
    f32x2 m2 = *(const f32x2*)(md + (((size_t)2 * MT + tok) * 8 + h) * 2);
    const float ma = fmaxf(m0.x, fmaxf(m1.x, m2.x));
    const float e0 = __expf(m0.x - ma), e1 = __expf(m1.x - ma), e2 = __expf(m2.x - ma);
    const float dn = e0 * m0.y + e1 * m1.y + e2 * m2.y;
    const f32x4 n0 = *(const f32x4*)(num + ((size_t)0 * MT + tok) * 512 + h * 64 + e4 * 4);
    const f32x4 n1 = *(const f32x4*)(num + ((size_t)1 * MT + tok) * 512 + h * 64 + e4 * 4);
    const f32x4 n2 = *(const f32x4*)(num + ((size_t)2 * MT + tok) * 512 + h * 64 + e4 * 4);
    const f32x4 o = (n0 * e0 + n1 * e1 + n2 * e2) * (1.f / dn);
    u32x2 pk;
    pk.x = pk2(o[0], o[1]); pk.y = pk2(o[2], o[3]);
    *(u32x2*)(ycat + (size_t)tok * 1024 + 512 + h * 64 + e4 * 4) = pk;
  }
}

DEV float dpp_allreduce16(float x) {
  x += __int_as_float(__builtin_amdgcn_update_dpp(0, __float_as_int(x), 0xB1, 0xF, 0xF, true));
  x += __int_as_float(__builtin_amdgcn_update_dpp(0, __float_as_int(x), 0x4E, 0xF, 0xF, true));
  x += __int_as_float(__builtin_amdgcn_update_dpp(0, __float_as_int(x), 0x141, 0xF, 0xF, true));
  x += __int_as_float(__builtin_amdgcn_update_dpp(0, __float_as_int(x), 0x140, 0xF, 0xF, true));
  return x;
}

DEV void scan_phase(char* lds, const P& p) {
  const bf16_t* omw = (const bf16_t*)(p.ws + O_OMW);
  const bf16_t* kd = (const bf16_t*)(p.ws + O_KD);
  const bf16_t* kka = (const bf16_t*)(p.ws + O_KKA);
  const bf16_t* kk = (const bf16_t*)(p.ws + O_KK);
  const bf16_t* za = (const bf16_t*)p.out;
  float* Y = (float*)(p.ws + O_Y);
  float* inb = (float*)lds;
  float* ypart = (float*)(lds + 98304);
  const int tid = threadIdx.x, w = tid >> 6, lane = tid & 63, rg = lane >> 4, jl = lane & 15, j0 = jl * 4;
  for (int it = blockIdx.x; it < 256; it += gridDim.x) {
    const int sc = it >> 1, half = it & 1, d = sc >> 6, b = (sc >> 3) & 7, h = sc & 7;
    if (w >= 4) {
      const int lt = tid - 256;
      const bf16_t* src[6];
      int dsto[6], stepi[6], isw[6];
#pragma unroll
      for (int q = 0; q < 6; ++q) {
        const int pid = lt + q * 256, i = pid / 48, rem = pid % 48, arr = rem >> 3, pc = rem & 7;
        const bf16_t* base;
        size_t ld;
        if (arr == 0) { base = omw + (size_t)d * MT * 512 + h * 64; ld = 512; }
        else if (arr == 1) { base = kd + (size_t)d * MT * 512 + h * 64; ld = 512; }
        else if (arr == 2) { base = kka + (size_t)d * MT * 512 + h * 64; ld = 512; }
        else if (arr == 3) { base = kk + h * 64; ld = 512; }
        else if (arr == 4) { base = za + h * 64; ld = 2048; }
        else { base = za + 1024 + h * 64; ld = 2048; }
        const int t0 = d ? (4095 - i) : i;
        src[q] = base + ((size_t)(b * 4096 + t0)) * ld + pc * 8;
        stepi[q] = (int)ld * 32 * (d ? -1 : 1);
        dsto[q] = i * 384 + arr * 64 + pc * 8;
        isw[q] = (arr == 0);
      }
      u32x4 rr[6];
#pragma unroll
      for (int q = 0; q < 6; ++q) rr[q] = *(const u32x4*)(src[q]);
#pragma unroll
      for (int q = 0; q < 6; ++q) {
        float f[8];
        unpack8(rr[q], f);
        if (isw[q]) { for (int i = 0; i < 8; ++i) f[i] = 1.f - f[i]; }
        *(f32x4*)(inb + dsto[q]) = (f32x4){f[0], f[1], f[2], f[3]};
        *(f32x4*)(inb + dsto[q] + 4) = (f32x4){f[4], f[5], f[6], f[7]};
      }
#pragma unroll
      for (int q = 0; q < 6; ++q) rr[q] = *(const u32x4*)(src[q] + (ptrdiff_t)stepi[q]);
      __syncthreads();
      for (int c = 0; c < 128; ++c) {
        if (c + 1 < 128) {
          float* nb_ = inb + ((c + 1) & 1) * 12288;
#pragma unroll
          for (int q = 0; q < 6; ++q) {
            float f[8];
            unpack8(rr[q], f);
            if (isw[q]) { for (int i = 0; i < 8; ++i) f[i] = 1.f - f[i]; }
            *(f32x4*)(nb_ + dsto[q]) = (f32x4){f[0], f[1], f[2], f[3]};
            *(f32x4*)(nb_ + dsto[q] + 4) = (f32x4){f[4], f[5], f[6], f[7]};
          }
        }
        if (c + 2 < 128) {
#pragma unroll
          for (int q = 0; q < 6; ++q) rr[q] = *(const u32x4*)(src[q] + (ptrdiff_t)stepi[q] * (c + 2));
        }
        if (c > 0) {
          const int cc = c - 1, idx = lt * 4, i = idx >> 5, rl = idx & 31;
          const int t = d ? (4095 - (cc * 32 + i)) : (cc * 32 + i);
          const float* q = ypart + (cc & 1) * 4096 + i * 128 + rl;
          const f32x4 o = (*(const f32x4*)q + *(const f32x4*)(q + 32)) + (*(const f32x4*)(q + 64) + *(const f32x4*)(q + 96));
          *(f32x4*)(Y + ((size_t)d * MT + b * 4096 + t) * 512 + h * 64 + half * 32 + rl) = o;
        }
        __syncthreads();
      }
      {
        const int cc = 127, idx = lt * 4, i = idx >> 5, rl = idx & 31;
        const int t = d ? (4095 - (cc * 32 + i)) : (cc * 32 + i);
        const float* q = ypart + (cc & 1) * 4096 + i * 128 + rl;
        const f32x4 o = (*(const f32x4*)q + *(const f32x4*)(q + 32)) + (*(const f32x4*)(q + 64) + *(const f32x4*)(q + 96));
        *(f32x4*)(Y + ((size_t)d * MT + b * 4096 + t) * 512 + h * 64 + half * 32 + rl) = o;
      }
    } else {
      const int rowl = w * 8 + rg * 2, row = half * 32 + rowl;
      f32x2 a01 = (f32x2){0.f, 0.f}, a23 = a01, b01 = a01, b23 = a01;
      __syncthreads();
      for (int c = 0; c < 128; ++c) {
        const float* cur = inb + (c & 1) * 12288;
        float* yp = ypart + (c & 1) * 4096 + (jl >> 2) * 32 + rowl;
        f32x4 w4 = *(const f32x4*)(cur + j0), kd4 = *(const f32x4*)(cur + 64 + j0), ka4 = *(const f32x4*)(cur + 128 + j0),
              kk4 = *(const f32x4*)(cur + 192 + j0), r4 = *(const f32x4*)(cur + 256 + j0);
        f32x2 v2 = *(const f32x2*)(cur + 320 + row);
#pragma unroll 8
        for (int i = 0; i < 32; ++i) {
          const float* sn = cur + ((i + 1) & 31) * 384;
          const f32x4 nw4 = *(const f32x4*)(sn + j0), nkd4 = *(const f32x4*)(sn + 64 + j0), nka4 = *(const f32x4*)(sn + 128 + j0),
                      nkk4 = *(const f32x4*)(sn + 192 + j0), nr4 = *(const f32x4*)(sn + 256 + j0);
          const f32x2 nv2 = *(const f32x2*)(sn + 320 + row);
          const f32x2 ta = a01 * kk4.xy + a23 * kk4.zw, tb = b01 * kk4.xy + b23 * kk4.zw;
          const float ska = dpp_allreduce16(ta.x + ta.y), skb = dpp_allreduce16(tb.x + tb.y);
          a01 = a01 * w4.xy + (kd4.xy * v2.x - ka4.xy * ska);
          a23 = a23 * w4.zw + (kd4.zw * v2.x - ka4.zw * ska);
          b01 = b01 * w4.xy + (kd4.xy * v2.y - ka4.xy * skb);
          b23 = b23 * w4.zw + (kd4.zw * v2.y - ka4.zw * skb);
          const f32x2 ua = a01 * r4.xy + a23 * r4.zw, ub = b01 * r4.xy + b23 * r4.zw;
          f32x2 y;
          y.x = ua.x + ua.y; y.y = ub.x + ub.y;
          y.x += __int_as_float(__builtin_amdgcn_update_dpp(0, __float_as_int(y.x), 0xB1, 0xF, 0xF, true));
          y.y += __int_as_float(__builtin_amdgcn_update_dpp(0, __float_as_int(y.y), 0xB1, 0xF, 0xF, true));
          y.x += __int_as_float(__builtin_amdgcn_update_dpp(0, __float_as_int(y.x), 0x4E, 0xF, 0xF, true));
          y.y += __int_as_float(__builtin_amdgcn_update_dpp(0, __float_as_int(y.y), 0x4E, 0xF, 0xF, true));
          *(f32x2*)(yp + i * 128) = y;
          w4 = nw4; kd4 = nkd4; ka4 = nka4; kk4 = nkk4; r4 = nr4; v2 = nv2;
        }
        __syncthreads();
      }
    }
    __syncthreads();
  }
}

DEV void postB(const P& p) {
  const float* Y = (const float*)(p.ws + O_Y);
  const bf16_t* kd = (const bf16_t*)(p.ws + O_KD);
  const bf16_t* gg = (const bf16_t*)(p.ws + O_G);
  const bf16_t* za = (const bf16_t*)p.out;
  bf16_t* ycat = (bf16_t*)(p.ws + O_YCAT);
  const int lane = threadIdx.x & 63, sub = lane >> 4, jl = lane & 15, gw = blockIdx.x * 8 + (threadIdx.x >> 6), nw = gridDim.x * 8;
  for (int it = gw; it < MT * 2; it += nw) {
    const int item = it * 4 + sub, tok = item >> 3, h = item & 7, c = h * 64 + jl * 4;
    const f32x4 y0 = *(const f32x4*)(Y + (size_t)tok * 512 + c), y1 = *(const f32x4*)(Y + ((size_t)MT + tok) * 512 + c);
    const u32x2 k0 = *(const u32x2*)(kd + (size_t)tok * 512 + c), k1 = *(const u32x2*)(kd + ((size_t)MT + tok) * 512 + c);
    const u32x2 ru = *(const u32x2*)(za + (size_t)tok * 2048 + c), vu = *(const u32x2*)(za + (size_t)tok * 2048 + 1024 + c), gu = *(const u32x2*)(gg + (size_t)tok * 512 + c);
    const f32x4 lw = *(const f32x4*)(p.lnx_w + c), lb = *(const f32x4*)(p.lnx_b + c), rk = *(const f32x4*)(p.r_k + c);
    const f32x4 y = y0 + y1;
    const float mu = dpp_allreduce16((y[0] + y[1]) + (y[2] + y[3])) * (1.f / 64.f);
    const f32x4 dv = y - mu;
    const float var = dpp_allreduce16((dv[0] * dv[0] + dv[1] * dv[1]) + (dv[2] * dv[2] + dv[3] * dv[3])) * (1.f / 64.f);
    const float rs = rsqrtf(var + 64e-5f);
    const f32x4 r = (f32x4){lo16(ru.x), hi16(ru.x), lo16(ru.y), hi16(ru.y)}, v = (f32x4){lo16(vu.x), hi16(vu.x), lo16(vu.y), hi16(vu.y)};
    const f32x4 g = (f32x4){lo16(gu.x), hi16(gu.x), lo16(gu.y), hi16(gu.y)};
    const f32x4 kds = (f32x4){lo16(k0.x) + lo16(k1.x), hi16(k0.x) + hi16(k1.x), lo16(k0.y) + lo16(k1.y), hi16(k0.y) + hi16(k1.y)};
    const f32x4 t = r * kds * rk;
    const float bs = dpp_allreduce16((t[0] + t[1]) + (t[2] + t[3]));
    const f32x4 o = (dv * rs * lw + lb + v * bs) * g;
    u32x2 pk;
    pk.x = pk2(o[0], o[1]); pk.y = pk2(o[2], o[3]);
    *(u32x2*)(ycat + (size_t)tok * 1024 + c) = pk;
  }
}

DEV void glu_pass(const P& p, int l) {
  const bf16_t* zf = (const bf16_t*)(p.ws + O_ZF);
  bf16_t* act = (bf16_t*)(p.ws + O_ACT);
  const float* cw = p.ffn_conv + (size_t)l * 3 * 5632;
  const int gt = blockIdx.x * NTHR + threadIdx.x, ngt = gridDim.x * NTHR;
  constexpr int RL = 16;
  for (int item = gt; item < (16384 / RL) * 352; item += ngt) {
    const int run = item / 352, c8 = (item - run * 352) * 8, row0 = run * RL, s0 = row0 & 4095;
    float wg0[8], wg1[8], wg2[8], wv0[8], wv1[8], wv2[8];
#pragma unroll
    for (int i = 0; i < 8; i += 4) {
      *(f32x4*)(wg0 + i) = *(const f32x4*)(cw + c8 + i); *(f32x4*)(wg1 + i) = *(const f32x4*)(cw + 5632 + c8 + i); *(f32x4*)(wg2 + i) = *(const f32x4*)(cw + 11264 + c8 + i);
      *(f32x4*)(wv0 + i) = *(const f32x4*)(cw + 2816 + c8 + i); *(f32x4*)(wv1 + i) = *(const f32x4*)(cw + 5632 + 2816 + c8 + i); *(f32x4*)(wv2 + i) = *(const f32x4*)(cw + 11264 + 2816 + c8 + i);
    }
    const bf16_t* zp = zf + (size_t)row0 * 5632 + c8;
    u32x4 pg = (u32x4){0u, 0u, 0u, 0u}, pv = pg;
    if (s0 > 0) { pg = *(const u32x4*)(zp - 5632); pv = *(const u32x4*)(zp - 5632 + 2816); }
    u32x4 cg_ = *(const u32x4*)zp, cv = *(const u32x4*)(zp + 2816);
#pragma unroll 4
    for (int r = 0; r < RL; ++r) {
      u32x4 ng = (u32x4){0u, 0u, 0u, 0u}, nv = ng;
      if (s0 + r < 4095) { ng = *(const u32x4*)(zp + (size_t)(r + 1) * 5632); nv = *(const u32x4*)(zp + (size_t)(r + 1) * 5632 + 2816); }
      float gm[8], gc[8], gn[8], vm[8], vc[8], vn[8], o[8];
      unpack8(pg, gm); unpack8(cg_, gc); unpack8(ng, gn); unpack8(pv, vm); unpack8(cv, vc); unpack8(nv, vn);
#pragma unroll
      for (int i = 0; i < 8; ++i) {
        const float g = gm[i] * wg0[i] + gc[i] * wg1[i] + gn[i] * wg2[i];
        const float vv = vm[i] * wv0[i] + vc[i] * wv1[i] + vn[i] * wv2[i];
        const float u2 = -1.5957691216057308f * (g + 0.044715f * g * g * g);
        const float ge = g * __builtin_amdgcn_rcpf(1.f + __expf(u2));
        o[i] = ge * vv;
      }
      *(u32x4*)(act + (size_t)(row0 + r) * 2816 + c8) = pack8(o);
      pg = cg_; pv = cv; cg_ = ng; cv = nv;
    }
  }
}

template <class Epi>
DEV void gemm_grid(char* lds, const bf16_t* A, int lda, const bf16_t* Bt, int ldb, int K, int tilesM, int tilesN, const Epi& epi) {
  const int nt = tilesM * tilesN;
  for (int t = blockIdx.x; t < nt; t += gridDim.x) {
    const int tm = t / tilesN, tn = t % tilesN;
    gemm_tile(lds, A + (size_t)tm * 256 * lda, lda, Bt + (size_t)tn * 128 * ldb, ldb, K, tm * 256, tn * 128, epi);
  }
}


DEV void dft_combine(const P& p) {
  const float* EO = (const float*)(p.ws + O_EO);
  const bf16_t* CST = (const bf16_t*)(p.ws + O_CST);
  bf16_t* f = (bf16_t*)(p.ws + O_F);
  for (int idx = blockIdx.x * NTHR + threadIdx.x; idx < 8 * 2048 * 256; idx += gridDim.x * NTHR) {
    const int c4 = (idx & 255) * 4, k1 = (idx >> 8) & 2047, b = idx >> 19;
    const f32x4 e = *(const f32x4*)(EO + ((size_t)(b * 2) * 2048 + k1) * 1024 + c4), o = *(const f32x4*)(EO + ((size_t)(b * 2 + 1) * 2048 + k1) * 1024 + c4);
    const f32x4 d = e - o, s = e + o;
    u32x2 pk;
    pk.x = pk2(d[0], d[1]); pk.y = pk2(d[2], d[3]);
    *(u32x2*)(f + ((size_t)b * 4096 + k1) * 1024 + c4) = pk;
    if (k1 > 0) {
      pk.x = pk2(s[0], s[1]); pk.y = pk2(s[2], s[3]);
      *(u32x2*)(f + ((size_t)b * 4096 + 4096 - k1) * 1024 + c4) = pk;
    }
  }
  {
    const int lane = threadIdx.x & 63, gw = blockIdx.x * 8 + (threadIdx.x >> 6), nw = gridDim.x * 8;
    for (int r = gw; r < 8 * 1024; r += nw) {
      const int b = r >> 10, n = r & 1023;
      const bf16_t* cp = CST + ((size_t)(b * 2) * 1024 + n) * 4096;
      float acc = 0.f;
#pragma unroll
      for (int j = 0; j < 8; ++j) {
        const u32x4 u = *(const u32x4*)(cp + j * 512 + lane * 8);
        acc += (lo16(u.x) - hi16(u.x)) + (lo16(u.y) - hi16(u.y)) + (lo16(u.z) - hi16(u.z)) + (lo16(u.w) - hi16(u.w));
      }
      acc = wave_sum(acc);
      if (lane == 0) f[((size_t)b * 4096 + 2048) * 1024 + n] = f2bf(acc * (1.f / 64.f));
    }
  }
}

#define LDSP ((PG8_LAS unsigned char*)lds)
template <class Epi>
DEV void pgemm(char* lds, const bf16_t* A, const bf16_t* Bt, int M_, int N_, int K_, const Epi& E) {
  pg8::Gemm g{A, Bt, M_, N_, K_};
  pg8::StaticOrder S;
  S.init(M_, N_, (int)gridDim.x, (int)blockIdx.x);
  pg8::gemm_phase<Epi, pg8::StaticOrder, true, true>(LDSP, g, S, E);
}

DEV void ffn(char* lds, const XcdBarrier& xbar, const P& p, int l) {
  const bf16_t* h = (const bf16_t*)(p.ws + O_H);
  bf16_t* zf = (bf16_t*)(p.ws + O_ZF);
  bf16_t* act = (bf16_t*)(p.ws + O_ACT);
  bf16_t* yf = (bf16_t*)(p.ws + O_YF);
  const bf16_t* upt = (const bf16_t*)(p.ws + W_UP) + (size_t)l * 5632 * 1024;
  const bf16_t* dnt = (const bf16_t*)(p.ws + W_DOWN) + (size_t)l * 1024 * 2816;
  for (int half = 0; half < 2; ++half) {
    pgemm(lds, h + (size_t)half * 16384 * 1024, upt, 16384, 5632, 1024, pg8::PEpiBf16<false>{zf, 5632});
    xcd_barrier(xbar);
    for (int rep_ = 0; rep_ < REP_GLU; ++rep_) { glu_pass(p, l); xcd_barrier(xbar); }
    pgemm(lds, act, dnt, 16384, 1024, 2816, pg8::PEpiBf16<false>{yf + (size_t)half * 16384 * 1024, 1024});
  }
  xcd_barrier(xbar);
}

__global__ void __launch_bounds__(NTHR) mega(P p) {
  extern __shared__ __attribute__((aligned(16))) char lds[];
  cg::grid_group grid = cg::this_grid();
  char* ws = p.ws;
  if (threadIdx.x < 4) ((unsigned*)(lds + 131072))[threadIdx.x] = 0u;
  __syncthreads();
  const XcdBarrier xbar = xcd_barrier_post((unsigned*)(ws + W_BAR), (volatile XLAS unsigned*)(lds + 131072));
  float* mod = (float*)(ws + W_MOD);
  const int gt = blockIdx.x * NTHR + threadIdx.x, ngt = gridDim.x * NTHR;

  compute_mod(lds, p);
  transpose_convert(lds, p.mix_in, 1024, 3584, (bf16_t*)(ws + W_MIXIN), 1024, 0);
  for (int l = 0; l < 2; ++l) {
    transpose_convert(lds, p.ffn_up + (size_t)l * 1024 * 5632, 1024, 5632, (bf16_t*)(ws + W_UP) + (size_t)l * 5632 * 1024, 1024, 64 * l);
    transpose_convert(lds, p.ffn_down + (size_t)l * 2816 * 1024, 2816, 1024, (bf16_t*)(ws + W_DOWN) + (size_t)l * 1024 * 2816, 2816, 128 + 64 * l);
  }
  transpose_convert(lds, p.mix_out, 1024, 1024, (bf16_t*)(ws + W_MIXOUT), 1024, 32);
  transpose_convert(lds, p.fnet_w, 1024, 1024, (bf16_t*)(ws + W_FNET), 1024, 96);
  for (int d = 0; d < 2; ++d) {
    transpose_convert(lds, p.w1 + (size_t)d * 512 * 64, 512, 64, (bf16_t*)(ws + W_L1) + (size_t)(d * 64) * 512, 512, 8 * d);
    transpose_convert(lds, p.a1 + (size_t)d * 512 * 64, 512, 64, (bf16_t*)(ws + W_L1) + (size_t)(128 + d * 64) * 512, 512, 16 + 8 * d);
    transpose_convert(lds, p.w2 + (size_t)d * 64 * 512, 64, 512, (bf16_t*)(ws + W_W2) + (size_t)d * 512 * 64, 64, 48 + 8 * d);
    transpose_convert(lds, p.a2 + (size_t)d * 64 * 512, 64, 512, (bf16_t*)(ws + W_A2) + (size_t)d * 512 * 64, 64, 64 + 8 * d);
  }
  transpose_convert(lds, p.g1, 512, 128, (bf16_t*)(ws + W_L1) + (size_t)256 * 512, 512, 32);
  transpose_convert(lds, p.g2, 128, 512, (bf16_t*)(ws + W_G2), 128, 80);
  {
    float* rope = (float*)(ws + W_ROPE);
    for (int idx = gt; idx < 4096 * 32; idx += ngt) {
      const int s = idx >> 5, e = idx & 31;
      const float inv = powf(10000.f, -(float)e / 32.f);
      const float ang = (float)s * inv;
      float sv, cv;
      sincosf(ang, &sv, &cv);
      rope[2 * idx] = cv;
      rope[2 * idx + 1] = sv;
    }
    bf16_t* dftc = (bf16_t*)(ws + W_DFTC);
    for (int idx = gt; idx < 256 * 128; idx += ngt) {
      const int n = idx >> 7, c = idx & 127, k2 = n & 127;
      const float ph = (float)((k2 * c) & 127) * (1.f / 64.f);
      const float v = (n < 128) ? cospif(ph) : sinpif(ph);
      dftc[idx] = f2bf(v * 0.08838834764831845f);
    }
  }
  grid.sync();
  for (int rep_ = 0; rep_ < REP_ROW; ++rep_) { rowpass<false, true>(p.x, nullptr, nullptr, nullptr, nullptr, p.norm_g, mod + 1024, mod, (bf16_t*)(ws + O_H0)); xcd_barrier(xbar); }
  pgemm(lds, (const bf16_t*)(ws + O_H0), (const bf16_t*)(ws + W_MIXIN), MT, INC, 1024, pg8::PEpiBf16<false>{(bf16_t*)(ws + O_Z), INC});
  xcd_barrier(xbar);
  for (int rep_ = 0; rep_ < REP_PREP; ++rep_) { prep1(p); xcd_barrier(xbar); }
  for (int rep_ = 0; rep_ < REP_ATT; ++rep_) { attention(lds, p); xcd_barrier(xbar); }
  combineA(p);
  gemm_grid(lds, (const bf16_t*)p.out + 1536, 2048, (const bf16_t*)(ws + W_L1), 512, 512, 128, 3, EpiLora1{(bf16_t*)(ws + O_L1)});
  xcd_barrier(xbar);
  for (int d = 0; d < 2; ++d) {
    gemm_grid(lds, (const bf16_t*)(ws + O_L1) + d * 64, 384, (const bf16_t*)(ws + W_W2) + (size_t)d * 512 * 64, 64, 64, 128, 4,
              EpiDecay{(bf16_t*)(ws + O_OMW) + (size_t)d * MT * 512, p.w0 + d * 512});
    gemm_grid(lds, (const bf16_t*)(ws + O_L1) + 128 + d * 64, 384, (const bf16_t*)(ws + W_A2) + (size_t)d * 512 * 64, 64, 64, 128, 4,
              EpiA{(bf16_t*)(ws + O_KD) + (size_t)d * MT * 512, (bf16_t*)(ws + O_KKA) + (size_t)d * MT * 512, (bf16_t*)(ws + O_KK), p.a0 + d * 512,
                   p.k_k, p.k_a, (const bf16_t*)p.out, d == 0});
  }
  gemm_grid(lds, (const bf16_t*)(ws + O_L1) + 256, 384, (const bf16_t*)(ws + W_G2), 128, 128, 128, 4, EpiBf16{(bf16_t*)(ws + O_G), 512});
  xcd_barrier(xbar);
  for (int rep_ = 0; rep_ < REP_SCAN; ++rep_) { scan_phase(lds, p); xcd_barrier(xbar); }
  for (int rep_ = 0; rep_ < REP_SYNC; ++rep_) xcd_barrier(xbar);
  postB(p);
  xcd_barrier(xbar);
  pgemm(lds, (const bf16_t*)(ws + O_YCAT), (const bf16_t*)(ws + W_MIXOUT), MT, 1024, 1024, pg8::PEpiBf16<false>{(bf16_t*)(ws + O_YF), 1024});
  xcd_barrier(xbar);
  rowpass<true, true>(p.x, (const bf16_t*)(ws + O_YF), p.norm_g + 1024, mod + 2048, p.out, p.norm_g + 2048, mod + 4096, mod + 3072, (bf16_t*)(ws + O_H));
  xcd_barrier(xbar);
  ffn(lds, xbar, p, 0);
  {
    const float* mod1 = mod + 8 * 6144;
    rowpass<true, true>(p.out, (const bf16_t*)(ws + O_YF), p.norm_g + 3072, mod + 5120, p.out, p.norm_g + 4096, mod1 + 1024, mod1, (bf16_t*)(ws + O_H));
    bf16_t* cs = (bf16_t*)(ws + O_COSSIN);
    for (int idx = blockIdx.x * NTHR + threadIdx.x; idx < 4096 * 512; idx += gridDim.x * NTHR) {
      const int rr = idx >> 9, s8 = (idx & 511) * 8, k1 = rr & 2047;
      float o[8];
#pragma unroll
      for (int i = 0; i < 8; ++i) {
        const float ph = (float)((k1 * (s8 + i)) & 4095) * (1.f / 2048.f);
        o[i] = ((rr < 2048) ? cospif(ph) : sinpif(ph)) * (1.f / 64.f);
      }
      *(u32x4*)(cs + (size_t)rr * 4096 + s8) = pack8(o);
    }
    xcd_barrier(xbar);
    for (int t = blockIdx.x; t < 8 * 256; t += gridDim.x) {
      const int g = t >> 8, tn = t & 255;
      gemm_tile(lds, (const bf16_t*)(ws + W_DFTC), 128, (const bf16_t*)(ws + O_H) + (size_t)tn * 128 * 1024 + g * 128, 1024, 128, 0, tn * 128,
                EpiDftc{(bf16_t*)(ws + O_CST), g});
    }
    xcd_barrier(xbar);
    {
      pg8::Gemm g{(const bf16_t*)(ws + O_COSSIN), (const bf16_t*)(ws + O_CST), 4096, 16384, 4096};
      pg8::BatchOrder S{(int)gridDim.x, (int)blockIdx.x};
      pg8::gemm_phase<pg8::PEpiF32B, pg8::BatchOrder, true, true>(LDSP, g, S, pg8::PEpiF32B{(float*)(ws + O_EO)});
    }
    xcd_barrier(xbar);
    dft_combine(p);
    xcd_barrier(xbar);
    pgemm(lds, (const bf16_t*)(ws + O_F), (const bf16_t*)(ws + W_FNET), MT, 1024, 1024, pg8::PEpiBf16<false>{(bf16_t*)(ws + O_YF), 1024});
    xcd_barrier(xbar);
    rowpass<true, true>(p.out, (const bf16_t*)(ws + O_YF), p.norm_g + 4096 + 1024, mod1 + 2048, p.out, p.norm_g + 4096 + 2048, mod1 + 4096, mod1 + 3072,
                        (bf16_t*)(ws + O_H));
    xcd_barrier(xbar);
    ffn(lds, xbar, p, 1);
    rowpass<true, false>(p.out, (const bf16_t*)(ws + O_YF), p.norm_g + 4096 + 3072, mod1 + 5120, p.out, nullptr, nullptr, nullptr, nullptr);
  }
}

extern "C" void kernel_launch(void* const* d_in, const int* in_sizes, int n_in, void* d_out, int out_size, void* d_ws, size_t ws_size,
                              hipStream_t stream) {
  static int grid_blocks = 0;
  if (!grid_blocks) {
    int dev = 0, cus = 0, per_cu = 0;
    hipGetDevice(&dev);
    hipDeviceGetAttribute(&cus, hipDeviceAttributeMultiprocessorCount, dev);
    hipFuncSetAttribute((const void*)mega, hipFuncAttributeMaxDynamicSharedMemorySize, LDS_BYTES);
    hipOccupancyMaxActiveBlocksPerMultiprocessor(&per_cu, (const void*)mega, NTHR, LDS_BYTES);
    if (per_cu < 1) { fprintf(stderr, "occupancy query returned %d\n", per_cu); per_cu = 1; }
    if (per_cu > 1) per_cu = 1;
    grid_blocks = cus * per_cu;
  }
  P p{};
  const float** pp = (const float**)&p;
  for (int i = 0; i < 25; ++i) pp[i] = (const float*)d_in[i];
  p.out = (float*)d_out;
  p.ws = (char*)d_ws;
  (void)hipMemsetAsync((char*)d_ws + W_BAR, 0, XCD_BAR_WORDS * sizeof(unsigned), stream);
  void* args[] = {&p};
  hipError_t e = hipLaunchCooperativeKernel((const void*)mega, dim3(grid_blocks), dim3(NTHR), args, LDS_BYTES, stream);
  if (e != hipSuccess) fprintf(stderr, "cooperative launch failed: %s (grid %d)\n", hipGetErrorString(e), grid_blocks);
}
```

```cpp
#include <hip/hip_runtime.h>
#include <hip/hip_cooperative_groups.h>
#include <stdint.h>
#include <cstdio>
namespace cg = cooperative_groups;

typedef unsigned short bf16_t;
typedef short bf16x8 __attribute__((ext_vector_type(8)));
typedef short s16x4 __attribute__((ext_vector_type(4)));
typedef float f32x4 __attribute__((ext_vector_type(4)));
typedef float f32x2 __attribute__((ext_vector_type(2)));
typedef unsigned u32x4 __attribute__((ext_vector_type(4)));
typedef unsigned u32x2 __attribute__((ext_vector_type(2)));

#define DEV __device__ __forceinline__

constexpr int NB = 8, SEQ = 4096, DM = 1024, MT = NB * SEQ, DFF = 2816, INC = 3584;
constexpr size_t MiB = 1024 * 1024;
constexpr int NTHR = 512;
constexpr int LDS_BYTES = 131072 + 16;
constexpr size_t W_BAR = 47 * 1024 * 1024;
#ifndef REP_SCAN
#define REP_SCAN 1
#endif
#ifndef REP_ATT
#define REP_ATT 1
#endif
#ifndef REP_SYNC
#define REP_SYNC 0
#endif
#ifndef REP_PREP
#define REP_PREP 1
#endif
#ifndef REP_LORA
#define REP_LORA 1
#endif
#ifndef REP_GLU
#define REP_GLU 1
#endif
#ifndef REP_PRO
#define REP_PRO 1
#endif
#ifndef REP_ROW
#define REP_ROW 1
#endif

constexpr size_t W_MIXIN = 0;
constexpr size_t W_UP = 7 * MiB;
constexpr size_t W_DOWN = 29 * MiB;
constexpr size_t W_MIXOUT = 40 * MiB;
constexpr size_t W_FNET = 42 * MiB;
constexpr size_t W_L1 = 44 * MiB;
constexpr size_t W_W2 = W_L1 + 512 * 1024;
constexpr size_t W_A2 = W_W2 + 128 * 1024;
constexpr size_t W_G2 = W_A2 + 128 * 1024;
constexpr size_t W_DFTC = W_G2 + 128 * 1024;
constexpr size_t W_MOD = 45 * MiB;
constexpr size_t W_ROPE = 46 * MiB;
constexpr size_t R0 = 48 * MiB;
constexpr size_t O_H0 = R0;
constexpr size_t O_Z = 112 * MiB;
constexpr size_t O_QR = 336 * MiB, O_KR = 368 * MiB, O_VT = 400 * MiB;
constexpr size_t O_NUM = R0;
constexpr size_t O_MD = 240 * MiB;
constexpr size_t O_YCAT = 448 * MiB;
constexpr size_t O_OMW = 48 * MiB, O_KD = 112 * MiB, O_KKA = 176 * MiB, O_KK = 240 * MiB, O_G = 272 * MiB, O_L1 = 304 * MiB, O_Y = 304 * MiB;
constexpr size_t O_YF = 48 * MiB;
constexpr size_t O_H = 176 * MiB;
constexpr size_t O_ZF = 240 * MiB;
constexpr size_t O_ACT = 240 * MiB;
constexpr size_t O_SB = 416 * MiB;
constexpr size_t O_COSSIN = 240 * MiB;
constexpr size_t O_CST = 304 * MiB;
constexpr size_t O_F = 432 * MiB;
constexpr size_t O_EO = 48 * MiB;

struct P {
  const float *x, *c, *ada_w, *ada_b, *norm_g, *mix_in, *mix_conv, *w0, *w1, *w2, *a0, *a1, *a2, *g1, *g2, *k_k, *k_a, *r_k, *lnx_w,
      *lnx_b, *mix_out, *fnet_w, *ffn_up, *ffn_conv, *ffn_down;
  float* out;
  char* ws;
};

DEV float bf2f(bf16_t h) { return __uint_as_float(((unsigned)h) << 16); }
DEV bf16_t f2bf(float f) {
  unsigned u = __float_as_uint(f);
  u += 0x7fffu + ((u >> 16) & 1u);
  return (bf16_t)(u >> 16);
}
DEV unsigned pk2(float a, float b) { return (unsigned)f2bf(a) | ((unsigned)f2bf(b) << 16); }
DEV float lo16(unsigned u) { return __uint_as_float(u << 16); }
DEV float hi16(unsigned u) { return __uint_as_float(u & 0xffff0000u); }
DEV float wave_sum(float v) {
#pragma unroll
  for (int o = 32; o; o >>= 1) v += __shfl_xor(v, o);
  return v;
}
DEV float sigmoidf_(float x) { return __builtin_amdgcn_rcpf(1.f + __expf(-x)); }

#include <cstdint>
#include <cstdlib>
#include <vector>

#define XB_TMO      128
#define XB_XCNT(j)  (256  + 64 * (j))
#define XB_XSUB(j)  (1280 + 64 * (j))
#define XB_XGEN(j)  (2304 + 64 * (j))
#define XB_TOP      3328
#define XB_TOPGEN   3392
#define XCD_BAR_WORDS 3456
#define XB_SPIN_CAP (1u << 18)
#define XLAS __attribute__((address_space(3)))

__device__ __forceinline__ unsigned xb_ld(unsigned* p)              { return __hip_atomic_load(p, __ATOMIC_RELAXED, __HIP_MEMORY_SCOPE_AGENT); }
__device__ __forceinline__ unsigned xb_add(unsigned* p, unsigned v) { return __hip_atomic_fetch_add(p, v, __ATOMIC_RELAXED, __HIP_MEMORY_SCOPE_AGENT); }
__device__ __forceinline__ unsigned xb_xcc_id() { return (unsigned)__builtin_amdgcn_s_getreg((3 << 11) | 20) & 0xFu; }
#define XB_SPIN(cond, bar) do { unsigned _sp = 0; while (cond) { __builtin_amdgcn_s_sleep(1); \
    if ((++_sp & 255u) == 0u) { if (xb_ld(&(bar)[XB_TMO])) break; if (_sp > XB_SPIN_CAP) { atomicAdd(&(bar)[XB_TMO], 1u); break; } } } } while (0)

struct XcdBarrier {
    unsigned* bar; unsigned x;
    volatile XLAS unsigned* st;
};

__device__ __forceinline__ XcdBarrier xcd_barrier_post(unsigned* bar, volatile XLAS unsigned* st) {
    XcdBarrier b; b.bar = bar; b.x = xb_xcc_id(); b.st = st;
    if (threadIdx.x == 0) (void)xb_add(&bar[XB_XCNT(b.x)], 1u);
    return b;
}
__device__ __forceinline__ void xcd_barrier_complete(unsigned* bar, unsigned x, unsigned& nloc, unsigned& nx) {
    const unsigned G = gridDim.x * gridDim.y * gridDim.z;
    unsigned sum, cnt, mine, sp = 0u;
    for (;;) {
        sum = 0u; cnt = 0u; mine = 0u;
#pragma unroll
        for (unsigned j = 0; j < 16; ++j) { const unsigned c = xb_ld(&bar[XB_XCNT(j)]); sum += c; cnt += (c > 0u) ? 1u : 0u; mine = (j == x) ? c : mine; }
        if (sum == G) break;
        __builtin_amdgcn_s_sleep(1);
        if ((++sp & 255u) == 0u) { if (xb_ld(&bar[XB_TMO])) break; if (sp > XB_SPIN_CAP) { atomicAdd(&bar[XB_TMO], 1u); break; } }
    }
    nloc = mine > 0u ? mine : 1u; nx = cnt > 0u ? cnt : 1u;
}

__device__ __forceinline__ void xcd_barrier(const XcdBarrier& b) {
    asm volatile("s_waitcnt vmcnt(0)" ::: "memory");
    __syncthreads();
    if (threadIdx.x == 0) {
        unsigned* bar = b.bar;
        __builtin_amdgcn_s_waitcnt(0);
        unsigned nloc = b.st[0], nx = b.st[1];
        if (nloc == 0u) { xcd_barrier_complete(bar, b.x, nloc, nx); b.st[0] = nloc; b.st[1] = nx; }
        const unsigned old = xb_add(&bar[XB_XSUB(b.x)], 1u);
        const unsigned gen = old / nloc;
        if (old + 1u == (gen + 1u) * nloc) {
            __builtin_amdgcn_fence(__ATOMIC_RELEASE, "agent");
            asm volatile("s_waitcnt vmcnt(0)" ::: "memory");
            const unsigned og = xb_add(&bar[XB_TOP], 1u);
            const unsigned tg = og / nx;
            if (og + 1u == (tg + 1u) * nx) xb_add(&bar[XB_TOPGEN], 1u);
            else XB_SPIN(xb_ld(&bar[XB_TOPGEN]) == tg, bar);
            __builtin_amdgcn_fence(__ATOMIC_ACQUIRE, "agent");
            xb_add(&bar[XB_XGEN(b.x)], 1u);
            asm volatile("s_waitcnt vmcnt(0)" ::: "memory");
        } else {
            XB_SPIN(xb_ld(&bar[XB_XGEN(b.x)]) == gen, bar);
            __builtin_amdgcn_fence(__ATOMIC_ACQUIRE, "agent");
            asm volatile("s_waitcnt vmcnt(0)" ::: "memory");
        }
    }
    __syncthreads();
}

namespace pg8 {
#define PG8_LAS __attribute__((address_space(3)))
typedef unsigned short bf16_t;
typedef short bf16x8 __attribute__((ext_vector_type(8)));
typedef float f32x4 __attribute__((ext_vector_type(4)));
typedef unsigned u32x4 __attribute__((ext_vector_type(4)));
constexpr int BM = 256, BK = 64, HALF = 128, HTB = HALF * BK * 2  , STAGE_BYTES = 8 * HTB, NXCD = 8, WGM = 8;

__host__ __device__ __forceinline__ int lds_byte(int r, int c) { const int st = (r >> 4) * 2 + (c >> 5), rr = r & 15, cc = c & 31, ob = rr * 64 + cc * 2; return st * 1024 + (ob ^ (((ob >> 9) & 1) << 5)); }
__host__ __device__ __forceinline__ void stage_rc(int b, int& R, int& C) { const int st = b / 1024, sb = b % 1024, swz = sb ^ (((sb >> 9) & 1) << 5); R = (st >> 1) * 16 + swz / 64; C = (st & 1) * 32 + (swz % 64) / 2; }
__host__ __device__ __forceinline__ int perm32(int rho) { const int n = rho >> 4, i = rho & 15; return 8 * (i >> 2) + 4 * n + (i & 3); }

struct Unit { int pm, pn; };
struct Gemm { const bf16_t* A; const bf16_t* Bt; int M, N, K; };

struct StaticOrder {
    int nM, nN, nwg, G, c;
    __host__ __device__ void init(int M, int N, int G_, int c_) { nM = M / BM; nN = N / BM; nwg = nM * nN; G = G_; c = c_; }
    __host__ __device__ bool next(int i, Unit& u) const {
        const long L = (long)i * G + c; if (L >= nwg) return false;
        int wgid = (int)L; { const int q = nwg / NXCD, r = nwg % NXCD, xcd = wgid % NXCD, off = wgid / NXCD; wgid = (xcd < r ? xcd * (q + 1) : r * (q + 1) + (xcd - r) * q) + off; }
        const int nig = WGM * nN, gid = wgid / nig, fm = gid * WGM, gsz = (nM - fm) < WGM ? (nM - fm) : WGM;
        u.pm = fm + ((wgid % nig) % gsz); u.pn = (wgid % nig) / gsz; return true;
    }
    __device__ __forceinline__ void a_ready(const Unit&) const {}
    __device__ __forceinline__ void done(const Unit&) const {}
};

__device__ __forceinline__ unsigned cvt_pk_bf16(float lo, float hi) { unsigned r; asm volatile("v_cvt_pk_bf16_f32 %0, %1, %2" : "=v"(r) : "v"(lo), "v"(hi)); return r; }

template <bool BATCHED> struct PEpiBf16 {
    static constexpr bool PERM = true, AFTER_DRAIN = false;
    bf16_t* O; int ldc;
    __device__ __forceinline__ void operator()(const f32x4 (&acc)[2][2][4][2], const Unit& u, int wr, int wc, int fr, int fq) const {
        const int rb = BATCHED ? ((u.pn >> 2) * 4096 + u.pm * 256) : u.pm * 256, cb = BATCHED ? (u.pn & 3) * 256 : u.pn * 256;
        const int row0 = rb + wr * 64 + fr, col0 = cb + wc * 32 + 8 * fq;
#pragma unroll
        for (int ai = 0; ai < 2; ++ai)
#pragma unroll
            for (int m = 0; m < 4; ++m) { bf16_t* rowp = O + (size_t)(row0 + ai * HALF + m * 16) * ldc + col0;
#pragma unroll
                for (int bj = 0; bj < 2; ++bj) { const f32x4 v0 = acc[ai][bj][m][0], v1 = acc[ai][bj][m][1];
                    u32x4 w; w.x = cvt_pk_bf16(v0[0], v0[1]); w.y = cvt_pk_bf16(v0[2], v0[3]); w.z = cvt_pk_bf16(v1[0], v1[1]); w.w = cvt_pk_bf16(v1[2], v1[3]);
                    *(u32x4*)(rowp + bj * HALF) = w; } }
    }
};
struct PEpiF32 {
    static constexpr bool PERM = true, AFTER_DRAIN = false;
    float* O; int ldc;
    __device__ __forceinline__ void operator()(const f32x4 (&acc)[2][2][4][2], const Unit& u, int wr, int wc, int fr, int fq) const {
        const int row0 = u.pm * 256 + wr * 64 + fr, col0 = u.pn * 256 + wc * 32 + 8 * fq;
#pragma unroll
        for (int ai = 0; ai < 2; ++ai)
#pragma unroll
            for (int m = 0; m < 4; ++m) { float* rowp = O + (size_t)(row0 + ai * HALF + m * 16) * ldc + col0;
#pragma unroll
                for (int bj = 0; bj < 2; ++bj) { *(f32x4*)(rowp + bj * HALF) = acc[ai][bj][m][0]; *(f32x4*)(rowp + bj * HALF + 4) = acc[ai][bj][m][1]; } }
    }
};
template <int CTRL> __device__ __forceinline__ float dppz(float x) { return __int_as_float(__builtin_amdgcn_update_dpp(0, __float_as_int(x), CTRL, 0xF, 0xF, true)); }
template <int CTRL> __device__ __forceinline__ float dppo(float old, float x) { return __int_as_float(__builtin_amdgcn_update_dpp(__float_as_int(old), __float_as_int(x), CTRL, 0xF, 0xF, false)); }
struct PEpiGlu {
    static constexpr bool PERM = true, AFTER_DRAIN = false;
    bf16_t* act; bf16_t* sb; const float* cw;
    __device__ __forceinline__ void operator()(const f32x4 (&acc)[2][2][4][2], const Unit& u, int wr, int wc, int fr, int fq) const {
        const int chb = u.pn * 128 + wc * 32 + 8 * fq, colp = u.pn * 256 + wc * 32 + 8 * fq;
#pragma unroll
        for (int n = 0; n < 2; ++n) {
            const int ch = chb + 4 * n;
            const f32x4 g0 = *(const f32x4*)(cw + ch), g1 = *(const f32x4*)(cw + 5632 + ch), g2 = *(const f32x4*)(cw + 11264 + ch);
            const f32x4 v0 = *(const f32x4*)(cw + 2816 + ch), v1 = *(const f32x4*)(cw + 5632 + 2816 + ch), v2 = *(const f32x4*)(cw + 11264 + 2816 + ch);
#pragma unroll
            for (int ai = 0; ai < 2; ++ai) {
                const int strip = u.pm * 4 + ai * 2 + wr, rowbase = u.pm * 256 + ai * HALF + wr * 64;
#pragma unroll
                for (int m = 0; m < 4; ++m) {
                    float o[4];
#pragma unroll
                    for (int r = 0; r < 4; ++r) {
                        const float gc = acc[ai][0][m][n][r], vc = acc[ai][1][m][n][r];
                        float gx = 0.f, vx = 0.f, gy = 0.f, vy = 0.f;
                        if (m > 0) { gx = dppz<0x121>(acc[ai][0][m - 1][n][r]); vx = dppz<0x121>(acc[ai][1][m - 1][n][r]); }
                        const float gp = dppo<0x111>(gx, gc), vp = dppo<0x111>(vx, vc);
                        if (m < 3) { gy = dppz<0x12F>(acc[ai][0][m + 1][n][r]); vy = dppz<0x12F>(acc[ai][1][m + 1][n][r]); }
                        const float gn = dppo<0x101>(gy, gc), vn = dppo<0x101>(vy, vc);
                        const float g = gp * g0[r] + gc * g1[r] + gn * g2[r];
                        const float v = vp * v0[r] + vc * v1[r] + vn * v2[r];
                        const float u2 = -1.5957691216057308f * (g + 0.044715f * g * g * g);
                        o[r] = g * __builtin_amdgcn_rcpf(1.f + __expf(u2)) * v;
                    }
                    u32x2 w; w.x = cvt_pk_bf16(o[0], o[1]); w.y = cvt_pk_bf16(o[2], o[3]);
                    *(u32x2*)(act + (size_t)(rowbase + m * 16 + fr) * 2816 + ch) = w;
                }
                if (fr < 2) {
                    bf16_t* sp = sb + ((size_t)strip * 4 + fr) * 5632 + colp + 4 * n;
                    u32x2 w; w.x = cvt_pk_bf16(acc[ai][0][0][n][0], acc[ai][0][0][n][1]); w.y = cvt_pk_bf16(acc[ai][0][0][n][2], acc[ai][0][0][n][3]);
                    *(u32x2*)sp = w;
                    w.x = cvt_pk_bf16(acc[ai][1][0][n][0], acc[ai][1][0][n][1]); w.y = cvt_pk_bf16(acc[ai][1][0][n][2], acc[ai][1][0][n][3]);
                    *(u32x2*)(sp + 128) = w;
                }
                if (fr >= 14) {
                    bf16_t* sp = sb + ((size_t)strip * 4 + (fr - 12)) * 5632 + colp + 4 * n;
                    u32x2 w; w.x = cvt_pk_bf16(acc[ai][0][3][n][0], acc[ai][0][3][n][1]); w.y = cvt_pk_bf16(acc[ai][0][3][n][2], acc[ai][0][3][n][3]);
                    *(u32x2*)sp = w;
                    w.x = cvt_pk_bf16(acc[ai][1][3][n][0], acc[ai][1][3][n][1]); w.y = cvt_pk_bf16(acc[ai][1][3][n][2], acc[ai][1][3][n][3]);
                    *(u32x2*)(sp + 128) = w;
                }
            }
        }
    }
};
struct PEpiF32B {
    static constexpr bool PERM = true, AFTER_DRAIN = false;
    float* O;
    __device__ __forceinline__ void operator()(const f32x4 (&acc)[2][2][4][2], const Unit& u, int wr, int wc, int fr, int fq) const {
        const int row0 = (u.pn >> 2) * 2048 + (u.pm & 7) * 256 + wr * 64 + fr, col0 = (u.pn & 3) * 256 + wc * 32 + 8 * fq;
#pragma unroll
        for (int ai = 0; ai < 2; ++ai)
#pragma unroll
            for (int m = 0; m < 4; ++m) { float* rowp = O + (size_t)(row0 + ai * HALF + m * 16) * 1024 + col0;
#pragma unroll
                for (int bj = 0; bj < 2; ++bj) { *(f32x4*)(rowp + bj * HALF) = acc[ai][bj][m][0]; *(f32x4*)(rowp + bj * HALF + 4) = acc[ai][bj][m][1]; } }
    }
};
struct BatchOrder {
    int G, c;
    __device__ __forceinline__ bool next(int i, Unit& u) const { const int L = i * G + c; if (L >= 512) return false; const int be = L >> 5, r = L & 31; u.pm = (be & 1) * 8 + (r >> 2); u.pn = be * 4 + (r & 3); return true; }
    __device__ __forceinline__ void a_ready(const Unit&) const {}
    __device__ __forceinline__ void done(const Unit&) const {}
};
template <class Epi, class Sched, bool ALIGN_EPI = false, bool SP2 = false>
__device__ __forceinline__ void gemm_phase(PG8_LAS unsigned char* lds, const Gemm g, const Sched& S, const Epi& E) {
    int tid_ = threadIdx.x; asm volatile("" : "+v"(tid_));
    const int tid = tid_, wid = __builtin_amdgcn_readfirstlane(tid >> 6), lane = tid & 63, wr = wid >> 2, wc = wid & 3, fr = lane & 15, fq = lane >> 4;
    const int K = g.K, nt = K / BK;
    unsigned voffA[2], voffB[2];
#pragma unroll
    for (int i = 0; i < 2; ++i) { int R, C; stage_rc(tid * 16 + i * 8192, R, C); const int Rb = Epi::PERM ? ((R & ~31) + perm32(R & 31)) : R;
        voffA[i] = (unsigned)(R * K + C) * 2u; voffB[i] = (unsigned)(Rb * K + C) * 2u; }
    const size_t kstep = (size_t)(BK * 2);
    const size_t hstep = (size_t)HALF * K * 2;
    const size_t tstep = 2 * hstep;
    const unsigned ldsw = (unsigned)wid * 1024u;
    const int aoff = lds_byte(wr * 64 + fr, fq * 8), boff = lds_byte(wc * 32 + fr, fq * 8);
#define PG8_SA(b, h) (((b) * 2 + (h)) * HTB)
#define PG8_SB(b, h) ((4 + (b) * 2 + (h)) * HTB)
#define PG8_STAGE(bufoff, gbase, voff) do { _Pragma("unroll") for (int _i = 0; _i < 2; ++_i) \
        __builtin_amdgcn_global_load_lds((const unsigned*)((const char*)(gbase) + (voff)[_i]), (PG8_LAS unsigned*)(lds + (bufoff) + ldsw + _i * 8192), 16, 0, 0); } while (0)
#define PG8_LDA(dst, b, h) do { _Pragma("unroll") for (int m = 0; m < 4; ++m) _Pragma("unroll") for (int k = 0; k < 2; ++k) dst[m][k] = *(const PG8_LAS bf16x8*)(lds + PG8_SA(b, h) + aoff + m * 2048 + k * 1024); } while (0)
#define PG8_LDB(dst, b, h) do { _Pragma("unroll") for (int n = 0; n < 2; ++n) _Pragma("unroll") for (int k = 0; k < 2; ++k) dst[n][k] = *(const PG8_LAS bf16x8*)(lds + PG8_SB(b, h) + boff + n * 2048 + k * 1024); } while (0)
#define PG8_MMA(ai, bj, At, Bt) do { __builtin_amdgcn_s_setprio(1); _Pragma("unroll") for (int m = 0; m < 4; ++m) _Pragma("unroll") for (int n = 0; n < 2; ++n) _Pragma("unroll") for (int k = 0; k < 2; ++k) \
        acc[ai][bj][m][n] = __builtin_amdgcn_mfma_f32_16x16x32_bf16(Bt[n][k], At[m][k], acc[ai][bj][m][n], 0, 0, 0); __builtin_amdgcn_s_setprio(0); } while (0)
#define PG8_WAIT_V(n) asm volatile("s_waitcnt vmcnt(" #n ")" ::: "memory")
#define PG8_WAIT_L(n) asm volatile("s_waitcnt lgkmcnt(" #n ")" ::: "memory")
#define PG8_BAR __builtin_amdgcn_s_barrier()
#define PG8_SCHED __builtin_amdgcn_sched_barrier(0)
    Unit cur, nxt; int ui = 0;
    if (!S.next(0, cur)) return;
    f32x4 acc[2][2][4][2];
#pragma unroll
    for (int a = 0; a < 2; ++a)
#pragma unroll
        for (int b = 0; b < 2; ++b)
#pragma unroll
            for (int m = 0; m < 4; ++m)
#pragma unroll
                for (int n = 0; n < 2; ++n) acc[a][b][m][n] = (f32x4){0.f, 0.f, 0.f, 0.f};
    bf16x8 At[4][2], B0[2][2], B1[2][2];
    const char* cA = (const char*)g.A + (size_t)cur.pm * tstep; const char* cB = (const char*)g.Bt + (size_t)cur.pn * tstep;
    S.a_ready(cur);
    if constexpr (SP2) {
        PG8_STAGE(PG8_SB(0, 0), cB, voffB); PG8_STAGE(PG8_SB(0, 1), cB + hstep, voffB); PG8_STAGE(PG8_SA(0, 0), cA, voffA); PG8_STAGE(PG8_SA(0, 1), cA + hstep, voffA);
        if (wr == 1) PG8_BAR;
        PG8_WAIT_V(2); PG8_BAR;
        PG8_STAGE(PG8_SB(1, 0), cB + kstep, voffB); PG8_STAGE(PG8_SA(1, 0), cA + kstep, voffA); PG8_STAGE(PG8_SB(1, 1), cB + hstep + kstep, voffB);
        PG8_WAIT_V(6); PG8_BAR;
    } else {
        PG8_STAGE(PG8_SB(0, 0), cB, voffB); PG8_STAGE(PG8_SA(0, 0), cA, voffA); PG8_STAGE(PG8_SB(0, 1), cB + hstep, voffB); PG8_STAGE(PG8_SA(0, 1), cA + hstep, voffA);
        if (wr == 1) PG8_BAR;
        PG8_WAIT_V(4); PG8_BAR;
        PG8_STAGE(PG8_SB(1, 0), cB + kstep, voffB); PG8_STAGE(PG8_SA(1, 0), cA + kstep, voffA); PG8_STAGE(PG8_SB(1, 1), cB + hstep + kstep, voffB);
        PG8_WAIT_V(6); PG8_BAR;
    }
    for (;;) {
        const bool has_next = S.next(ui + 1, nxt);
        const char* nA = has_next ? (const char*)g.A + (size_t)nxt.pm * tstep : cA; const char* nB = has_next ? (const char*)g.Bt + (size_t)nxt.pn * tstep : cB;
        for (int t = 0; t < nt; t += 2) {
            const bool last = (t == nt - 2);
            const char* a1 = cA + (size_t)(t + 1) * kstep;
            const char* a2 = last ? nA : cA + (size_t)(t + 2) * kstep; const char* b2 = last ? nB : cB + (size_t)(t + 2) * kstep;
            const char* a3 = a2 + kstep; const char* b3 = b2 + kstep;
            if (last && has_next) S.a_ready(nxt);
            if constexpr (SP2) {
            PG8_LDB(B0, 0, 0); PG8_LDB(B1, 0, 1); PG8_SCHED; PG8_LDA(At, 0, 0); PG8_STAGE(PG8_SA(1, 1), a1 + hstep, voffA);
            PG8_WAIT_V(8); PG8_WAIT_L(0); PG8_BAR; PG8_MMA(0, 0, At, B0); PG8_MMA(0, 1, At, B1); PG8_BAR; PG8_SCHED;
            PG8_LDA(At, 0, 1); PG8_STAGE(PG8_SB(0, 0), b2, voffB); PG8_STAGE(PG8_SB(0, 1), b2 + hstep, voffB); PG8_STAGE(PG8_SA(0, 0), a2, voffA);
            PG8_WAIT_V(8); PG8_WAIT_L(0); PG8_BAR; PG8_MMA(1, 0, At, B0); PG8_MMA(1, 1, At, B1); PG8_BAR; PG8_SCHED;
            PG8_LDB(B0, 1, 0); PG8_LDB(B1, 1, 1); PG8_SCHED; PG8_LDA(At, 1, 0); PG8_STAGE(PG8_SA(0, 1), a2 + hstep, voffA);
            PG8_WAIT_V(8); PG8_WAIT_L(0); PG8_BAR; PG8_MMA(0, 0, At, B0); PG8_MMA(0, 1, At, B1); PG8_BAR; PG8_SCHED;
            PG8_LDA(At, 1, 1); PG8_STAGE(PG8_SB(1, 0), b3, voffB); PG8_STAGE(PG8_SB(1, 1), b3 + hstep, voffB); PG8_STAGE(PG8_SA(1, 0), a3, voffA);
            PG8_WAIT_V(8); PG8_WAIT_L(0); PG8_BAR; PG8_MMA(1, 0, At, B0); PG8_MMA(1, 1, At, B1); PG8_BAR; PG8_SCHED;
            } else {
            PG8_LDB(B0, 0, 0); PG8_SCHED; PG8_LDA(At, 0, 0); PG8_STAGE(PG8_SA(1, 1), a1 + hstep, voffA);
            PG8_WAIT_L(8); PG8_BAR; PG8_WAIT_L(0); PG8_MMA(0, 0, At, B0); PG8_BAR; PG8_SCHED;
            PG8_LDB(B1, 0, 1); PG8_STAGE(PG8_SB(0, 0), b2, voffB);
            PG8_BAR; PG8_WAIT_L(0); PG8_MMA(0, 1, At, B1); PG8_BAR;
            PG8_LDA(At, 0, 1); PG8_STAGE(PG8_SA(0, 0), a2, voffA);
            PG8_BAR; PG8_WAIT_L(0); PG8_MMA(1, 0, At, B0); PG8_BAR; PG8_SCHED;
            PG8_STAGE(PG8_SB(0, 1), b2 + hstep, voffB);
            PG8_WAIT_V(6); PG8_BAR; PG8_MMA(1, 1, At, B1); PG8_BAR;
            PG8_LDB(B0, 1, 0); PG8_SCHED; PG8_LDA(At, 1, 0); PG8_STAGE(PG8_SA(0, 1), a2 + hstep, voffA);
            PG8_WAIT_L(8); PG8_BAR; PG8_WAIT_L(0); PG8_MMA(0, 0, At, B0); PG8_BAR; PG8_SCHED;
            PG8_LDB(B1, 1, 1); PG8_STAGE(PG8_SB(1, 0), b3, voffB);
            PG8_BAR; PG8_WAIT_L(0); PG8_MMA(0, 1, At, B1); PG8_BAR;
            PG8_LDA(At, 1, 1); PG8_STAGE(PG8_SA(1, 0), a3, voffA);
            PG8_BAR; PG8_WAIT_L(0); PG8_MMA(1, 0, At, B0); PG8_BAR; PG8_SCHED;
            PG8_STAGE(PG8_SB(1, 1), b3 + hstep, voffB);
            PG8_WAIT_V(6); PG8_BAR; PG8_MMA(1, 1, At, B1); PG8_BAR;
            }
        }
        if constexpr (ALIGN_EPI) { if (wr == 0) PG8_BAR; }
        if constexpr (!Epi::AFTER_DRAIN) { E(acc, cur, wr, wc, fr, fq); S.done(cur); }
        if (!has_next) break;
#pragma unroll
        for (int a = 0; a < 2; ++a)
#pragma unroll
            for (int b = 0; b < 2; ++b)
#pragma unroll
                for (int m = 0; m < 4; ++m)
#pragma unroll
                    for (int n = 0; n < 2; ++n) acc[a][b][m][n] = (f32x4){0.f, 0.f, 0.f, 0.f};
        cur = nxt; cA = nA; cB = nB; ++ui;
        if constexpr (ALIGN_EPI) { if (wr == 1) PG8_BAR; }
    }
    PG8_WAIT_V(0);
    if constexpr (!ALIGN_EPI) { if (wr == 0) PG8_BAR; }
    PG8_BAR;
    if constexpr (Epi::AFTER_DRAIN) { E.fused(acc, cur, wr, wc, fr, fq, lds, wid, lane); S.done(cur); }
#undef PG8_SA
#undef PG8_SB
#undef PG8_STAGE
#undef PG8_LDA
#undef PG8_LDB
#undef PG8_MMA
#undef PG8_WAIT_V
#undef PG8_WAIT_L
#undef PG8_BAR
#undef PG8_SCHED
}
}

template <class Epi>
DEV void gemm_tile(char* lds, const bf16_t* __restrict__ A, int lda, const bf16_t* __restrict__ Bt, int ldb, int K, int trow, int tcol,
                   const Epi& epi) {
  const int tid = threadIdx.x, w = tid >> 6, l = tid & 63, wm = w >> 1, wn = w & 1, lr = l & 15, lq = l >> 4;
  const bf16_t* ga[4];
  const bf16_t* gb[2];
#pragma unroll
  for (int j = 0; j < 4; ++j) {
    const int c = w * 4 + j, mt = c >> 1, sl = c & 1;
    ga[j] = A + (size_t)(mt * 16 + lr) * lda + sl * 32 + lq * 8;
  }
#pragma unroll
  for (int j = 0; j < 2; ++j) {
    const int nt = w, sl = j;
    const int rowb = (nt >> 2) * 64 + (lr >> 2) * 16 + (nt & 3) * 4 + (lr & 3);
    gb[j] = Bt + (size_t)rowb * ldb + sl * 32 + lq * 8;
  }
  f32x4 acc[4][4];
#pragma unroll
  for (int i = 0; i < 4; ++i)
#pragma unroll
    for (int j = 0; j < 4; ++j) acc[i][j] = (f32x4){0.f, 0.f, 0.f, 0.f};
  u32x4 ra[4], rb[2];
  const int nk = K >> 6;
#pragma unroll
  for (int j = 0; j < 4; ++j) ra[j] = *(const u32x4*)(ga[j]);
#pragma unroll
  for (int j = 0; j < 2; ++j) rb[j] = *(const u32x4*)(gb[j]);
#pragma unroll
  for (int j = 0; j < 4; ++j) *(u32x4*)(lds + (w * 4 + j) * 1024 + l * 16) = ra[j];
#pragma unroll
  for (int j = 0; j < 2; ++j) *(u32x4*)(lds + 32768 + (w * 2 + j) * 1024 + l * 16) = rb[j];
  __syncthreads();
  for (int kt = 0; kt < nk; ++kt) {
    char* cur = lds + (kt & 1) * 49152;
    const bool more = (kt + 1 < nk);
    if (more) {
#pragma unroll
      for (int j = 0; j < 4; ++j) ra[j] = *(const u32x4*)(ga[j] + (kt + 1) * 64);
#pragma unroll
      for (int j = 0; j < 2; ++j) rb[j] = *(const u32x4*)(gb[j] + (kt + 1) * 64);
    }
#pragma unroll
    for (int s = 0; s < 2; ++s) {
      bf16x8 af[4], bfr[4];
#pragma unroll
      for (int i = 0; i < 4; ++i) af[i] = *(const bf16x8*)(cur + ((wm * 4 + i) * 2 + s) * 1024 + l * 16);
#pragma unroll
      for (int j = 0; j < 4; ++j) bfr[j] = *(const bf16x8*)(cur + 32768 + ((wn * 4 + j) * 2 + s) * 1024 + l * 16);
#pragma unroll
      for (int i = 0; i < 4; ++i)
#pragma unroll
        for (int j = 0; j < 4; ++j) acc[i][j] = __builtin_amdgcn_mfma_f32_16x16x32_bf16(bfr[j], af[i], acc[i][j], 0, 0, 0);
    }
    if (more) {
      char* nxt = lds + ((kt + 1) & 1) * 49152;
#pragma unroll
      for (int j = 0; j < 4; ++j) *(u32x4*)(nxt + (w * 4 + j) * 1024 + l * 16) = ra[j];
#pragma unroll
      for (int j = 0; j < 2; ++j) *(u32x4*)(nxt + 32768 + (w * 2 + j) * 1024 + l * 16) = rb[j];
    }
    __syncthreads();
  }
#pragma unroll
  for (int i = 0; i < 4; ++i) epi(trow + wm * 64 + i * 16 + lr, tcol + wn * 64 + lq * 16, acc[i]);
}

DEV void store16_bf16(bf16_t* dst, const f32x4 (&v)[4], float sc) {
  u32x4 a, b;
  a.x = pk2(v[0][0] * sc, v[0][1] * sc); a.y = pk2(v[0][2] * sc, v[0][3] * sc);
  a.z = pk2(v[1][0] * sc, v[1][1] * sc); a.w = pk2(v[1][2] * sc, v[1][3] * sc);
  b.x = pk2(v[2][0] * sc, v[2][1] * sc); b.y = pk2(v[2][2] * sc, v[2][3] * sc);
  b.z = pk2(v[3][0] * sc, v[3][1] * sc); b.w = pk2(v[3][2] * sc, v[3][3] * sc);
  *(u32x4*)dst = a;
  *(u32x4*)(dst + 8) = b;
}

struct EpiBf16 {
  bf16_t* O; int ldo;
  DEV void operator()(int row, int col, const f32x4 (&v)[4]) const { store16_bf16(O + (size_t)row * ldo + col, v, 1.f); }
};
struct EpiF32 {
  float* O; int ldo;
  DEV void operator()(int row, int col, const f32x4 (&v)[4]) const {
    float* d = O + (size_t)row * ldo + col;
#pragma unroll
    for (int j = 0; j < 4; ++j) *(f32x4*)(d + 4 * j) = v[j];
  }
};
struct EpiLora1 {
  bf16_t* O;
  DEV void operator()(int row, int col, const f32x4 (&v)[4]) const {
    f32x4 o[4];
#pragma unroll
    for (int j = 0; j < 4; ++j)
#pragma unroll
      for (int r = 0; r < 4; ++r) {
        const float t = v[j][r];
        o[j][r] = (col < 128) ? (1.f - 2.f * __builtin_amdgcn_rcpf(1.f + __expf(2.f * t))) : ((col < 256) ? t : sigmoidf_(t));
      }
    store16_bf16(O + (size_t)row * 384 + col, o, 1.f);
  }
};
struct EpiDecay {
  bf16_t* O; const float* w0;
  DEV void operator()(int row, int col, const f32x4 (&v)[4]) const {
    f32x4 o[4];
#pragma unroll
    for (int j = 0; j < 4; ++j)
#pragma unroll
      for (int r = 0; r < 4; ++r) {
        const float xx = w0[col + 4 * j + r] + v[j][r];
        const float nx = -xx;
        const float sp = (nx > 20.f) ? nx : __logf(1.f + __expf(nx));
        const float e = __expf(-sp - 0.5f);
        o[j][r] = 1.f - __expf(-e);
      }
    store16_bf16(O + (size_t)row * 512 + col, o, 1.f);
  }
};
struct EpiA {
  bf16_t *KD, *KKA, *KK; const float *a0, *k_k, *k_a; const bf16_t* za; int writekk;
  DEV void operator()(int row, int col, const f32x4 (&v)[4]) const {
    const bf16_t* kp = za + (size_t)row * 2048 + 512 + col;
    const u32x4 k0 = *(const u32x4*)kp, k1 = *(const u32x4*)(kp + 8);
    float kf[16];
    kf[0] = lo16(k0.x); kf[1] = hi16(k0.x); kf[2] = lo16(k0.y); kf[3] = hi16(k0.y); kf[4] = lo16(k0.z); kf[5] = hi16(k0.z); kf[6] = lo16(k0.w); kf[7] = hi16(k0.w);
    kf[8] = lo16(k1.x); kf[9] = hi16(k1.x); kf[10] = lo16(k1.y); kf[11] = hi16(k1.y); kf[12] = lo16(k1.z); kf[13] = hi16(k1.z); kf[14] = lo16(k1.w); kf[15] = hi16(k1.w);
    float kr[16], ss = 0.f;
#pragma unroll
    for (int i = 0; i < 16; ++i) { kr[i] = kf[i] * k_k[col + i]; ss += kr[i] * kr[i]; }
    ss += __shfl_xor(ss, 16);
    ss += __shfl_xor(ss, 32);
    const float rn = rsqrtf(ss + 1e-12f);
    f32x4 okd[4], okka[4], okk[4];
#pragma unroll
    for (int j = 0; j < 4; ++j)
#pragma unroll
      for (int r = 0; r < 4; ++r) {
        const int i = 4 * j + r;
        const float a = sigmoidf_(a0[col + i] + v[j][r]);
        const float kk = kr[i] * rn;
        okd[j][r] = kf[i] * (1.f + (a - 1.f) * k_a[col + i]);
        okka[j][r] = kk * a;
        okk[j][r] = kk;
      }
    store16_bf16(KD + (size_t)row * 512 + col, okd, 1.f);
    store16_bf16(KKA + (size_t)row * 512 + col, okka, 1.f);
    if (writekk) store16_bf16(KK + (size_t)row * 512 + col, okk, 1.f);
  }
};
struct EpiDftc {
  bf16_t* CST; int g;
  DEV void operator()(int row, int col, const f32x4 (&v)[4]) const {
    const int b = col >> 12, s = col & 4095;
    store16_bf16(CST + ((size_t)((b * 2 + (row >> 7)) * 1024 + g * 128 + (row & 127)) * 4096 + s), v, 1.f);
  }
};

DEV void transpose_convert(char* lds, const float* __restrict__ W, int K, int N, bf16_t* __restrict__ Wt, int ldt, int rot, bool glu_perm = false) {
  float* tile = (float*)lds;
  const int tn_n = N >> 6, nt = (K >> 6) * tn_n, tid = threadIdx.x;
  for (int t = (blockIdx.x + rot) % gridDim.x; t < nt; t += gridDim.x) {
    const int tk = t / tn_n, tn = t % tn_n;
    for (int i = tid; i < 4096; i += NTHR) {
      const int r = i >> 6, cc = i & 63;
      tile[r * 65 + cc] = W[(size_t)(tk * 64 + r) * N + tn * 64 + cc];
    }
    __syncthreads();
    int nbase = tn * 64;
    if (glu_perm) { const int c = tn * 64; nbase = (c < 2816) ? ((c >> 7) * 256 + (c & 127)) : (((c - 2816) >> 7) * 256 + 128 + ((c - 2816) & 127)); }
    for (int i = tid; i < 4096; i += NTHR) {
      const int n = i >> 6, k = i & 63;
      Wt[(size_t)(nbase + n) * ldt + tk * 64 + k] = f2bf(tile[k * 65 + n]);
    }
    __syncthreads();
  }
}

DEV void compute_mod(char* lds, const P& p) {
  float* cs = (float*)lds;
  float* red = (float*)(lds + 32768);
  const int tid = threadIdx.x;
  float* mod = (float*)(p.ws + W_MOD);
  bool have = false;
  for (int item = blockIdx.x; item < 192; item += gridDim.x) {
    if (!have) {
      for (int i = tid; i < 8192; i += NTHR) { const float cv = p.c[i]; cs[i] = cv / (1.f + expf(-cv)); }
      __syncthreads();
      have = true;
    }
    const int l = item / 96, cb = item % 96, col = cb * 64 + (tid & 63), kg = tid >> 6;
    float a0 = 0, a1 = 0, a2 = 0, a3 = 0, a4 = 0, a5 = 0, a6 = 0, a7 = 0;
    const float* wp = p.ada_w + ((size_t)l * 1024 + kg * 128) * 6144 + col;
    for (int k = 0; k < 128; ++k) {
      const float wv = wp[(size_t)k * 6144];
      const int kk = kg * 128 + k;
      a0 += cs[kk] * wv; a1 += cs[1024 + kk] * wv; a2 += cs[2048 + kk] * wv; a3 += cs[3072 + kk] * wv;
      a4 += cs[4096 + kk] * wv; a5 += cs[5120 + kk] * wv; a6 += cs[6144 + kk] * wv; a7 += cs[7168 + kk] * wv;
    }
    float* rp = red + kg * 512 + (tid & 63);
    rp[0] = a0; rp[64] = a1; rp[128] = a2; rp[192] = a3; rp[256] = a4; rp[320] = a5; rp[384] = a6; rp[448] = a7;
    __syncthreads();
    {
      const int b = tid >> 6, cc = tid & 63;
      float s = 0.f;
#pragma unroll
      for (int g = 0; g < 8; ++g) s += red[g * 512 + b * 64 + cc];
      mod[(size_t)(l * 8 + b) * 6144 + cb * 64 + cc] = s + p.ada_b[l * 6144 + cb * 64 + cc];
    }
    __syncthreads();
  }
}

template <bool HAS_Y, bool HAS_H>
DEV void rowpass(const float* __restrict__ xin, const bf16_t* __restrict__ yf, const float* __restrict__ gy, const float* __restrict__ gate,
                 float* __restrict__ xout, const float* __restrict__ gh, const float* __restrict__ sc, const float* __restrict__ sh,
                 bf16_t* __restrict__ h) {
  const int lane = threadIdx.x & 63, gw = blockIdx.x * 8 + (threadIdx.x >> 6), nw = gridDim.x * 8;
  for (int row = gw; row < MT; row += nw) {
    const int b = row >> 12;
    f32x4 xv[4];
#pragma unroll
    for (int i = 0; i < 4; ++i) xv[i] = *(const f32x4*)(xin + (size_t)row * 1024 + i * 256 + lane * 4);
    if (HAS_Y) {
      f32x4 yv[4];
      float ss = 0.f;
#pragma unroll
      for (int i = 0; i < 4; ++i) {
        const u32x2 yu = *(const u32x2*)(yf + (size_t)row * 1024 + i * 256 + lane * 4);
        yv[i] = (f32x4){lo16(yu.x), hi16(yu.x), lo16(yu.y), hi16(yu.y)};
        ss += yv[i][0] * yv[i][0] + yv[i][1] * yv[i][1] + yv[i][2] * yv[i][2] + yv[i][3] * yv[i][3];
      }
      ss = wave_sum(ss);
      const float rs = rsqrtf(ss * (1.f / 1024.f) + 1e-6f);
#pragma unroll
      for (int i = 0; i < 4; ++i) {
        const int col = i * 256 + lane * 4;
        const f32x4 g4 = *(const f32x4*)(gy + col), gt = *(const f32x4*)(gate + (size_t)b * 6144 + col);
        xv[i] = xv[i] + gt * (yv[i] * rs * g4);
        *(f32x4*)(xout + (size_t)row * 1024 + col) = xv[i];
      }
    }
    if (HAS_H) {
      float ss = 0.f;
#pragma unroll
      for (int i = 0; i < 4; ++i) ss += xv[i][0] * xv[i][0] + xv[i][1] * xv[i][1] + xv[i][2] * xv[i][2] + xv[i][3] * xv[i][3];
      ss = wave_sum(ss);
      const float rs = rsqrtf(ss * (1.f / 1024.f) + 1e-6f);
#pragma unroll
      for (int i = 0; i < 4; ++i) {
        const int col = i * 256 + lane * 4;
        const f32x4 g4 = *(const f32x4*)(gh + col), s4 = *(const f32x4*)(sc + (size_t)b * 6144 + col), h4 = *(const f32x4*)(sh + (size_t)b * 6144 + col);
        const f32x4 o = (xv[i] * rs * g4) * (s4 + 1.f) + h4;
        u32x2 pk;
        pk.x = pk2(o[0], o[1]); pk.y = pk2(o[2], o[3]);
        *(u32x2*)(h + (size_t)row * 1024 + col) = pk;
      }
    }
  }
}

DEV void unpack8(const u32x4 u, float (&f)[8]) {
  f[0] = lo16(u.x); f[1] = hi16(u.x); f[2] = lo16(u.y); f[3] = hi16(u.y); f[4] = lo16(u.z); f[5] = hi16(u.z); f[6] = lo16(u.w); f[7] = hi16(u.w);
}
DEV u32x4 pack8(const float (&f)[8]) {
  u32x4 u;
  u.x = pk2(f[0], f[1]); u.y = pk2(f[2], f[3]); u.z = pk2(f[4], f[5]); u.w = pk2(f[6], f[7]);
  return u;
}

DEV void prep1(const P& p) {
  const bf16_t* z = (const bf16_t*)(p.ws + O_Z);
  bf16_t* za = (bf16_t*)p.out;
  bf16_t* qr = (bf16_t*)(p.ws + O_QR);
  bf16_t* kr = (bf16_t*)(p.ws + O_KR);
  bf16_t* vt = (bf16_t*)(p.ws + O_VT);
  const float* rope = (const float*)(p.ws + W_ROPE);
  const int gt = blockIdx.x * NTHR + threadIdx.x, ngt = gridDim.x * NTHR;
  for (int idx = gt; idx < MT * 256; idx += ngt) {
    const int tok = idx >> 8, c8 = (idx & 255) * 8, s = tok & 4095;
    const bf16_t* zp = z + (size_t)tok * INC + c8;
    float zc[8], zm[8], zn[8], o[8];
    unpack8(*(const u32x4*)zp, zc);
    if (s > 0) unpack8(*(const u32x4*)(zp - INC), zm); else { for (int i = 0; i < 8; ++i) zm[i] = 0.f; }
    if (s < 4095) unpack8(*(const u32x4*)(zp + INC), zn); else { for (int i = 0; i < 8; ++i) zn[i] = 0.f; }
#pragma unroll
    for (int i = 0; i < 8; ++i) o[i] = zm[i] * p.mix_conv[c8 + i] + zc[i] * p.mix_conv[2048 + c8 + i] + zn[i] * p.mix_conv[4096 + c8 + i];
    *(u32x4*)(za + (size_t)tok * 2048 + c8) = pack8(o);
  }
  for (int idx = gt; idx < MT * 64; idx += ngt) {
    const int e8 = idx & 3, which = (idx >> 2) & 1, h = (idx >> 3) & 7, tok = idx >> 6, s = tok & 4095;
    const bf16_t* src = z + (size_t)tok * INC + 2048 + which * 512 + h * 64 + e8 * 8;
    float x1[8], x2[8], o1[8], o2[8];
    unpack8(*(const u32x4*)src, x1);
    unpack8(*(const u32x4*)(src + 32), x2);
    const float* rp = rope + ((size_t)s * 32 + e8 * 8) * 2;
    const float scl = which ? 1.f : 0.125f;
#pragma unroll
    for (int i = 0; i < 8; ++i) {
      const float cv = rp[2 * i], sv = rp[2 * i + 1];
      o1[i] = (x1[i] * cv - x2[i] * sv) * scl;
      o2[i] = (x2[i] * cv + x1[i] * sv) * scl;
    }
    bf16_t* dst = (which ? kr : qr) + (size_t)tok * 512 + h * 64 + e8 * 8;
    *(u32x4*)dst = pack8(o1);
    *(u32x4*)(dst + 32) = pack8(o2);
  }
  {
    const int lane = threadIdx.x & 63, gw = blockIdx.x * 8 + (threadIdx.x >> 6), nw = gridDim.x * 8;
    for (int item = gw; item < 3 * 4096; item += nw) {
      const int br = item >> 12, rem = item & 4095, b = rem >> 9, h = (rem >> 6) & 7, nb = rem & 63;
      const int dsh = 2 * br;
      const int Mr = 4096 >> dsh;
      const int pp = nb * 64 + lane, rsd = pp / Mr, m = pp % Mr, s = (m << dsh) + rsd;
      const bf16_t* src = z + (size_t)(b * 4096 + s) * INC + 3072 + h * 64;
      bf16_t* dst = vt + ((size_t)((br * 8 + b) * 8 + h) * 64) * 4096 + pp;
#pragma unroll
      for (int c = 0; c < 8; ++c) {
        const u32x4 u = *(const u32x4*)(src + c * 8);
        dst[(size_t)(c * 8 + 0) * 4096] = (bf16_t)(u.x & 0xffff); dst[(size_t)(c * 8 + 1) * 4096] = (bf16_t)(u.x >> 16);
        dst[(size_t)(c * 8 + 2) * 4096] = (bf16_t)(u.y & 0xffff); dst[(size_t)(c * 8 + 3) * 4096] = (bf16_t)(u.y >> 16);
        dst[(size_t)(c * 8 + 4) * 4096] = (bf16_t)(u.z & 0xffff); dst[(size_t)(c * 8 + 5) * 4096] = (bf16_t)(u.z >> 16);
        dst[(size_t)(c * 8 + 6) * 4096] = (bf16_t)(u.w & 0xffff); dst[(size_t)(c * 8 + 7) * 4096] = (bf16_t)(u.w >> 16);
      }
    }
  }
}

DEV void attention(char* lds, const P& p) {
  const bf16_t* qr = (const bf16_t*)(p.ws + O_QR);
  const bf16_t* kr = (const bf16_t*)(p.ws + O_KR);
  const bf16_t* vt = (const bf16_t*)(p.ws + O_VT);
  float* num = (float*)(p.ws + O_NUM);
  float* md = (float*)(p.ws + O_MD);
  constexpr int UNIT_LDS = 24576 + 64 * 400;
  const int tid = threadIdx.x, w = tid >> 6, lane = tid & 63, lr = lane & 15, lq = lane >> 4;
  const int uh = tid >> 8, lt = tid & 255, mt = w & 3;
  char* ul = lds + uh * UNIT_LDS;
  u32x4 pre[12];
  auto load_pair = [&](int pi) {
    const int unit = pi * 2 + uh;
    const int nb = unit & 63, h = (unit >> 6) & 7, b = (unit >> 9) & 7, br = unit >> 12;
    const int dsh = 2 * br, Mr = 4096 >> dsh;
    const int seg = (nb * 64) / Mr, segstart = seg * Mr, segend = segstart + Mr;
    const bool pv_ok = (nb * 64 - 64 >= segstart), nx_ok = (nb * 64 + 128 <= segend);
    const bf16_t* vbase = vt + ((size_t)((br * 8 + b) * 8 + h) * 64) * 4096;
#pragma unroll
    for (int j = 0; j < 6; ++j) {
      const int pc = lt + 256 * j, key = pc >> 3, ch = pc & 7, kb = key >> 6;
      int blk = nb + kb - 1;
      if ((kb == 0 && !pv_ok) || (kb == 2 && !nx_ok)) blk = nb;
      const int kp = blk * 64 + (key & 63);
      const int ktok = b * 4096 + (((kp - segstart) << dsh) + seg);
      pre[j] = *(const u32x4*)(kr + (size_t)ktok * 512 + h * 64 + ch * 8);
    }
#pragma unroll
    for (int j = 0; j < 6; ++j) {
      const int pc = lt + 256 * j, e = pc / 24, ch = pc - e * 24, kb = ch >> 3;
      int blk = nb + kb - 1;
      if ((kb == 0 && !pv_ok) || (kb == 2 && !nx_ok)) blk = nb;
      pre[6 + j] = *(const u32x4*)(vbase + (size_t)e * 4096 + blk * 64 + (ch & 7) * 8);
    }
  };
  const int npairs = 3 * 4096 / 2;
  int pi = blockIdx.x;
  if (pi < npairs) load_pair(pi);
  for (; pi < npairs; pi += gridDim.x) {
#pragma unroll
    for (int j = 0; j < 6; ++j) {
      const int pc = lt + 256 * j, key = pc >> 3, ch = pc & 7;
      *(u32x4*)(ul + key * 128 + ((ch ^ (key & 7)) * 16)) = pre[j];
    }
#pragma unroll
    for (int j = 0; j < 6; ++j) {
      const int pc = lt + 256 * j, e = pc / 24, ch = pc - e * 24;
      *(u32x4*)(ul + 24576 + e * 400 + ch * 16) = pre[6 + j];
    }
    __syncthreads();
    const int unit = pi * 2 + uh;
    const int nb = unit & 63, h = (unit >> 6) & 7, b = (unit >> 9) & 7, br = unit >> 12;
    const int dsh = 2 * br, Mr = 4096 >> dsh;
    const int seg = (nb * 64) / Mr, segstart = seg * Mr, segend = segstart + Mr;
    const bool pv_ok = (nb * 64 - 64 >= segstart), nx_ok = (nb * 64 + 128 <= segend);
    const int qp = nb * 64 + mt * 16 + lr;
    const int qtok = b * 4096 + (((qp - segstart) << dsh) + seg);
    bf16x8 qf[2];
    qf[0] = *(const bf16x8*)(qr + (size_t)qtok * 512 + h * 64 + lq * 8);
    qf[1] = *(const bf16x8*)(qr + (size_t)qtok * 512 + h * 64 + 32 + lq * 8);
    if (pi + (int)gridDim.x < npairs) load_pair(pi + gridDim.x);
    f32x4 sacc[12];
#pragma unroll
    for (int kt = 0; kt < 12; ++kt) {
      const int key = kt * 16 + lr;
      const bf16x8 k0 = *(const bf16x8*)(ul + key * 128 + ((lq ^ (key & 7)) * 16));
      const bf16x8 k1 = *(const bf16x8*)(ul + key * 128 + (((4 + lq) ^ (key & 7)) * 16));
      f32x4 a = (f32x4){0.f, 0.f, 0.f, 0.f};
      a = __builtin_amdgcn_mfma_f32_16x16x32_bf16(k0, qf[0], a, 0, 0, 0);
      a = __builtin_amdgcn_mfma_f32_16x16x32_bf16(k1, qf[1], a, 0, 0, 0);
      sacc[kt] = a;
    }
    const int qi = mt * 16 + lr;
    float mx = -1e30f;
#pragma unroll
    for (int kt = 0; kt < 12; ++kt) {
      const int kb = kt >> 2;
#pragma unroll
      for (int r = 0; r < 4; ++r) {
        const int kj = (kt & 3) * 16 + lq * 4 + r;
        bool ok = true;
        if (kb == 0) ok = pv_ok && (kj >= qi);
        if (kb == 2) ok = nx_ok && (kj <= qi);
        const float sv = ok ? sacc[kt][r] : -1e30f;
        sacc[kt][r] = sv;
        mx = fmaxf(mx, sv);
      }
    }
    mx = fmaxf(mx, __shfl_xor(mx, 16));
    mx = fmaxf(mx, __shfl_xor(mx, 32));
    float den = 0.f;
#pragma unroll
    for (int kt = 0; kt < 12; ++kt)
#pragma unroll
      for (int r = 0; r < 4; ++r) {
        const float pe = __expf(sacc[kt][r] - mx);
        sacc[kt][r] = pe;
        den += pe;
      }
    den += __shfl_xor(den, 16);
    den += __shfl_xor(den, 32);
    f32x4 oacc[4];
#pragma unroll
    for (int et = 0; et < 4; ++et) oacc[et] = (f32x4){0.f, 0.f, 0.f, 0.f};
#pragma unroll
    for (int t = 0; t < 6; ++t) {
      u32x4 pu;
      pu.x = pk2(sacc[2 * t][0], sacc[2 * t][1]); pu.y = pk2(sacc[2 * t][2], sacc[2 * t][3]);
      pu.z = pk2(sacc[2 * t + 1][0], sacc[2 * t + 1][1]); pu.w = pk2(sacc[2 * t + 1][2], sacc[2 * t + 1][3]);
      const bf16x8 pf = __builtin_bit_cast(bf16x8, pu);
#pragma unroll
      for (int et = 0; et < 4; ++et) {
        const char* vrow = ul + 24576 + (et * 16 + lr) * 400 + t * 64 + lq * 8;
        const u32x2 v0 = *(const u32x2*)vrow, v1 = *(const u32x2*)(vrow + 32);
        u32x4 vu;
        vu.x = v0.x; vu.y = v0.y; vu.z = v1.x; vu.w = v1.y;
        oacc[et] = __builtin_amdgcn_mfma_f32_16x16x32_bf16(__builtin_bit_cast(bf16x8, vu), pf, oacc[et], 0, 0, 0);
      }
    }
    float* np = num + ((size_t)br * MT + qtok) * 512 + h * 64 + lq * 4;
#pragma unroll
    for (int et = 0; et < 4; ++et) *(f32x4*)(np + et * 16) = oacc[et];
    if (lq == 0) {
      f32x2 o;
      o.x = mx; o.y = den;
      *(f32x2*)(md + (((size_t)br * MT + qtok) * 8 + h) * 2) = o;
    }
    __syncthreads();
  }
}

DEV void combineA(const P& p) {
  const float* num = (const float*)(p.ws + O_NUM);
  const float* md = (const float*)(p.ws + O_MD);
  bf16_t* ycat = (bf16_t*)(p.ws + O_YCAT);
  const int gt = blockIdx.x * NTHR + threadIdx.x, ngt = gridDim.x * NTHR;
  for (int idx = gt; idx < MT * 128; idx += ngt) {
    const int e4 = idx & 15, h = (idx >> 4) & 7, tok = idx >> 7;
    f32x2 m0 = *(const f32x2*)(md + (((size_t)0 * MT + tok) * 8 + h) * 2);
    f32x2 m1 = *(const f32x2*)(md + (((size_t)1 * MT + tok) * 8 + h) * 2);
    f32x2 m2 = *(const f32x2*)(md + (((size_t)2 * MT + tok) * 8 + h) * 2);
    const float ma = fmaxf(m0.x, fmaxf(m1.x, m2.x));
    const float e0 = __expf(m0.x - ma), e1 = __expf(m1.x - ma), e2 = __expf(m2.x - ma);
    const float dn = e0 * m0.y + e1 * m1.y + e2 * m2.y;
    const f32x4 n0 = *(const f32x4*)(num + ((size_t)0 * MT + tok) * 512 + h * 64 + e4 * 4);
    const f32x4 n1 = *(const f32x4*)(num + ((size_t)1 * MT + tok) * 512 + h * 64 + e4 * 4);
    const f32x4 n2 = *(const f32x4*)(num + ((size_t)2 * MT + tok) * 512 + h * 64 + e4 * 4);
    const f32x4 o = (n0 * e0 + n1 * e1 + n2 * e2) * (1.f / dn);
    u32x2 pk;
    pk.x = pk2(o[0], o[1]); pk.y = pk2(o[2], o[3]);
    *(u32x2*)(ycat + (size_t)tok * 1024 + 512 + h * 64 + e4 * 4) = pk;
  }
}

DEV float dpp_allreduce16(float x) {
  x += __int_as_float(__builtin_amdgcn_update_dpp(0, __float_as_int(x), 0xB1, 0xF, 0xF, true));
  x += __int_as_float(__builtin_amdgcn_update_dpp(0, __float_as_int(x), 0x4E, 0xF, 0xF, true));
  x += __int_as_float(__builtin_amdgcn_update_dpp(0, __float_as_int(x), 0x141, 0xF, 0xF, true));
  x += __int_as_float(__builtin_amdgcn_update_dpp(0, __float_as_int(x), 0x140, 0xF, 0xF, true));
  return x;
}

DEV void scan_phase(char* lds, const P& p) {
  const bf16_t* omw = (const bf16_t*)(p.ws + O_OMW);
  const bf16_t* kd = (const bf16_t*)(p.ws + O_KD);
  const bf16_t* kka = (const bf16_t*)(p.ws + O_KKA);
  const bf16_t* kk = (const bf16_t*)(p.ws + O_KK);
  const bf16_t* za = (const bf16_t*)p.out;
  float* Y = (float*)(p.ws + O_Y);
  float* inb = (float*)lds;
  float* ypart = (float*)(lds + 98304);
  const int tid = threadIdx.x, w = tid >> 6, lane = tid & 63, rg = lane >> 4, jl = lane & 15, j0 = jl * 4;
  for (int it = blockIdx.x; it < 256; it += gridDim.x) {
    const int sc = it >> 1, half = it & 1, d = sc >> 6, b = (sc >> 3) & 7, h = sc & 7;
    if (w >= 4) {
      const int lt = tid - 256;
      const bf16_t* src[6];
      int dsto[6], stepi[6], isw[6];
#pragma unroll
      for (int q = 0; q < 6; ++q) {
        const int pid = lt + q * 256, i = pid / 48, rem = pid % 48, arr = rem >> 3, pc = rem & 7;
        const bf16_t* base;
        size_t ld;
        if (arr == 0) { base = omw + (size_t)d * MT * 512 + h * 64; ld = 512; }
        else if (arr == 1) { base = kd + (size_t)d * MT * 512 + h * 64; ld = 512; }
        else if (arr == 2) { base = kka + (size_t)d * MT * 512 + h * 64; ld = 512; }
        else if (arr == 3) { base = kk + h * 64; ld = 512; }
        else if (arr == 4) { base = za + h * 64; ld = 2048; }
        else { base = za + 1024 + h * 64; ld = 2048; }
        const int t0 = d ? (4095 - i) : i;
        src[q] = base + ((size_t)(b * 4096 + t0)) * ld + pc * 8;
        stepi[q] = (int)ld * 32 * (d ? -1 : 1);
        dsto[q] = i * 384 + arr * 64 + pc * 8;
        isw[q] = (arr == 0);
      }
      u32x4 rr[6];
#pragma unroll
      for (int q = 0; q < 6; ++q) rr[q] = *(const u32x4*)(src[q]);
#pragma unroll
      for (int q = 0; q < 6; ++q) {
        float f[8];
        unpack8(rr[q], f);
        if (isw[q]) { for (int i = 0; i < 8; ++i) f[i] = 1.f - f[i]; }
        *(f32x4*)(inb + dsto[q]) = (f32x4){f[0], f[1], f[2], f[3]};
        *(f32x4*)(inb + dsto[q] + 4) = (f32x4){f[4], f[5], f[6], f[7]};
      }
#pragma unroll
      for (int q = 0; q < 6; ++q) rr[q] = *(const u32x4*)(src[q] + (ptrdiff_t)stepi[q]);
      __syncthreads();
      for (int c = 0; c < 128; ++c) {
        if (c + 1 < 128) {
          float* nb_ = inb + ((c + 1) & 1) * 12288;
#pragma unroll
          for (int q = 0; q < 6; ++q) {
            float f[8];
            unpack8(rr[q], f);
            if (isw[q]) { for (int i = 0; i < 8; ++i) f[i] = 1.f - f[i]; }
            *(f32x4*)(nb_ + dsto[q]) = (f32x4){f[0], f[1], f[2], f[3]};
            *(f32x4*)(nb_ + dsto[q] + 4) = (f32x4){f[4], f[5], f[6], f[7]};
          }
        }
        if (c + 2 < 128) {
#pragma unroll
          for (int q = 0; q < 6; ++q) rr[q] = *(const u32x4*)(src[q] + (ptrdiff_t)stepi[q] * (c + 2));
        }
        if (c > 0) {
          const int cc = c - 1, idx = lt * 4, i = idx >> 5, rl = idx & 31;
          const int t = d ? (4095 - (cc * 32 + i)) : (cc * 32 + i);
          const float* q = ypart + (cc & 1) * 4096 + i * 128 + rl;
          const f32x4 o = (*(const f32x4*)q + *(const f32x4*)(q + 32)) + (*(const f32x4*)(q + 64) + *(const f32x4*)(q + 96));
          *(f32x4*)(Y + ((size_t)d * MT + b * 4096 + t) * 512 + h * 64 + half * 32 + rl) = o;
        }
        __syncthreads();
      }
      {
        const int cc = 127, idx = lt * 4, i = idx >> 5, rl = idx & 31;
        const int t = d ? (4095 - (cc * 32 + i)) : (cc * 32 + i);
        const float* q = ypart + (cc & 1) * 4096 + i * 128 + rl;
        const f32x4 o = (*(const f32x4*)q + *(const f32x4*)(q + 32)) + (*(const f32x4*)(q + 64) + *(const f32x4*)(q + 96));
        *(f32x4*)(Y + ((size_t)d * MT + b * 4096 + t) * 512 + h * 64 + half * 32 + rl) = o;
      }
    } else {
      const int rowl = w * 8 + rg * 2, row = half * 32 + rowl;
      f32x2 a01 = (f32x2){0.f, 0.f}, a23 = a01, b01 = a01, b23 = a01;
      __syncthreads();
      for (int c = 0; c < 128; ++c) {
        const float* cur = inb + (c & 1) * 12288;
        float* yp = ypart + (c & 1) * 4096 + (jl >> 2) * 32 + rowl;
        f32x4 w4 = *(const f32x4*)(cur + j0), kd4 = *(const f32x4*)(cur + 64 + j0), ka4 = *(const f32x4*)(cur + 128 + j0),
              kk4 = *(const f32x4*)(cur + 192 + j0), r4 = *(const f32x4*)(cur + 256 + j0);
        f32x2 v2 = *(const f32x2*)(cur + 320 + row);
#pragma unroll 8
        for (int i = 0; i < 32; ++i) {
          const float* sn = cur + ((i + 1) & 31) * 384;
          const f32x4 nw4 = *(const f32x4*)(sn + j0), nkd4 = *(const f32x4*)(sn + 64 + j0), nka4 = *(const f32x4*)(sn + 128 + j0),
                      nkk4 = *(const f32x4*)(sn + 192 + j0), nr4 = *(const f32x4*)(sn + 256 + j0);
          const f32x2 nv2 = *(const f32x2*)(sn + 320 + row);
          const f32x2 ta = a01 * kk4.xy + a23 * kk4.zw, tb = b01 * kk4.xy + b23 * kk4.zw;
          const float ska = dpp_allreduce16(ta.x + ta.y), skb = dpp_allreduce16(tb.x + tb.y);
          a01 = a01 * w4.xy + (kd4.xy * v2.x - ka4.xy * ska);
          a23 = a23 * w4.zw + (kd4.zw * v2.x - ka4.zw * ska);
          b01 = b01 * w4.xy + (kd4.xy * v2.y - ka4.xy * skb);
          b23 = b23 * w4.zw + (kd4.zw * v2.y - ka4.zw * skb);
          const f32x2 ua = a01 * r4.xy + a23 * r4.zw, ub = b01 * r4.xy + b23 * r4.zw;
          f32x2 y;
          y.x = ua.x + ua.y; y.y = ub.x + ub.y;
          y.x += __int_as_float(__builtin_amdgcn_update_dpp(0, __float_as_int(y.x), 0xB1, 0xF, 0xF, true));
          y.y += __int_as_float(__builtin_amdgcn_update_dpp(0, __float_as_int(y.y), 0xB1, 0xF, 0xF, true));
          y.x += __int_as_float(__builtin_amdgcn_update_dpp(0, __float_as_int(y.x), 0x4E, 0xF, 0xF, true));
          y.y += __int_as_float(__builtin_amdgcn_update_dpp(0, __float_as_int(y.y), 0x4E, 0xF, 0xF, true));
          *(f32x2*)(yp + i * 128) = y;
          w4 = nw4; kd4 = nkd4; ka4 = nka4; kk4 = nkk4; r4 = nr4; v2 = nv2;
        }
        __syncthreads();
      }
    }
    __syncthreads();
  }
}

DEV void postB(const P& p) {
  const float* Y = (const float*)(p.ws + O_Y);
  const bf16_t* kd = (const bf16_t*)(p.ws + O_KD);
  const bf16_t* gg = (const bf16_t*)(p.ws + O_G);
  const bf16_t* za = (const bf16_t*)p.out;
  bf16_t* ycat = (bf16_t*)(p.ws + O_YCAT);
  const int lane = threadIdx.x & 63, sub = lane >> 4, jl = lane & 15, gw = blockIdx.x * 8 + (threadIdx.x >> 6), nw = gridDim.x * 8;
  for (int it = gw; it < MT * 2; it += nw) {
    const int item = it * 4 + sub, tok = item >> 3, h = item & 7, c = h * 64 + jl * 4;
    const f32x4 y0 = *(const f32x4*)(Y + (size_t)tok * 512 + c), y1 = *(const f32x4*)(Y + ((size_t)MT + tok) * 512 + c);
    const u32x2 k0 = *(const u32x2*)(kd + (size_t)tok * 512 + c), k1 = *(const u32x2*)(kd + ((size_t)MT + tok) * 512 + c);
    const u32x2 ru = *(const u32x2*)(za + (size_t)tok * 2048 + c), vu = *(const u32x2*)(za + (size_t)tok * 2048 + 1024 + c), gu = *(const u32x2*)(gg + (size_t)tok * 512 + c);
    const f32x4 lw = *(const f32x4*)(p.lnx_w + c), lb = *(const f32x4*)(p.lnx_b + c), rk = *(const f32x4*)(p.r_k + c);
    const f32x4 y = y0 + y1;
    const float mu = dpp_allreduce16((y[0] + y[1]) + (y[2] + y[3])) * (1.f / 64.f);
    const f32x4 dv = y - mu;
    const float var = dpp_allreduce16((dv[0] * dv[0] + dv[1] * dv[1]) + (dv[2] * dv[2] + dv[3] * dv[3])) * (1.f / 64.f);
    const float rs = rsqrtf(var + 64e-5f);
    const f32x4 r = (f32x4){lo16(ru.x), hi16(ru.x), lo16(ru.y), hi16(ru.y)}, v = (f32x4){lo16(vu.x), hi16(vu.x), lo16(vu.y), hi16(vu.y)};
    const f32x4 g = (f32x4){lo16(gu.x), hi16(gu.x), lo16(gu.y), hi16(gu.y)};
    const f32x4 kds = (f32x4){lo16(k0.x) + lo16(k1.x), hi16(k0.x) + hi16(k1.x), lo16(k0.y) + lo16(k1.y), hi16(k0.y) + hi16(k1.y)};
    const f32x4 t = r * kds * rk;
    const float bs = dpp_allreduce16((t[0] + t[1]) + (t[2] + t[3]));
    const f32x4 o = (dv * rs * lw + lb + v * bs) * g;
    u32x2 pk;
    pk.x = pk2(o[0], o[1]); pk.y = pk2(o[2], o[3]);
    *(u32x2*)(ycat + (size_t)tok * 1024 + c) = pk;
  }
}

DEV void glu_fixup(const P& p, int l) {
  const bf16_t* sb = (const bf16_t*)(p.ws + O_SB);
  bf16_t* act = (bf16_t*)(p.ws + O_ACT);
  const float* cw = p.ffn_conv + (size_t)l * 3 * 5632;
  const int gt = blockIdx.x * NTHR + threadIdx.x, ngt = gridDim.x * NTHR;
  for (int item = gt; item < 512 * 2 * 352; item += ngt) {
    const int strip = item / 704, rem = item - strip * 704, e = rem / 352, c8 = (rem - e * 352) * 8;
    const int R = strip * 64 + (e ? 63 : 0), s = R & 4095;
    const int colg = (c8 >> 7) * 256 + (c8 & 127);
    const bf16_t* pc = sb + ((size_t)strip * 4 + (e ? 3 : 0)) * 5632 + colg;
    const bf16_t* pp = e ? (pc - 5632) : (pc - 5632);
    const bf16_t* pn = e ? (pc + 5632) : (pc + 5632);
    const u32x4 z0 = (u32x4){0u, 0u, 0u, 0u};
    const bool hasp = e ? true : (s > 0), hasn = e ? (s < 4095) : true;
    float gm[8], gc[8], gn[8], vm[8], vc[8], vn[8], o[8];
    unpack8(hasp ? *(const u32x4*)pp : z0, gm); unpack8(hasp ? *(const u32x4*)(pp + 128) : z0, vm);
    unpack8(*(const u32x4*)pc, gc); unpack8(*(const u32x4*)(pc + 128), vc);
    unpack8(hasn ? *(const u32x4*)pn : z0, gn); unpack8(hasn ? *(const u32x4*)(pn + 128) : z0, vn);
#pragma unroll
    for (int i = 0; i < 8; ++i) {
      const float g = gm[i] * cw[c8 + i] + gc[i] * cw[5632 + c8 + i] + gn[i] * cw[11264 + c8 + i];
      const float vv = vm[i] * cw[2816 + c8 + i] + vc[i] * cw[5632 + 2816 + c8 + i] + vn[i] * cw[11264 + 2816 + c8 + i];
      const float u2 = -1.5957691216057308f * (g + 0.044715f * g * g * g);
      o[i] = g * __builtin_amdgcn_rcpf(1.f + __expf(u2)) * vv;
    }
    *(u32x4*)(act + (size_t)R * 2816 + c8) = pack8(o);
  }
}

template <class Epi>
DEV void gemm_grid(char* lds, const bf16_t* A, int lda, const bf16_t* Bt, int ldb, int K, int tilesM, int tilesN, const Epi& epi) {
  const int nt = tilesM * tilesN;
  for (int t = blockIdx.x; t < nt; t += gridDim.x) {
    const int tm = t / tilesN, tn = t % tilesN;
    gemm_tile(lds, A + (size_t)tm * 256 * lda, lda, Bt + (size_t)tn * 128 * ldb, ldb, K, tm * 256, tn * 128, epi);
  }
}


DEV void dft_combine(const P& p) {
  const float* EO = (const float*)(p.ws + O_EO);
  const bf16_t* CST = (const bf16_t*)(p.ws + O_CST);
  bf16_t* f = (bf16_t*)(p.ws + O_F);
  for (int idx = blockIdx.x * NTHR + threadIdx.x; idx < 8 * 2048 * 256; idx += gridDim.x * NTHR) {
    const int c4 = (idx & 255) * 4, k1 = (idx >> 8) & 2047, b = idx >> 19;
    const f32x4 e = *(const f32x4*)(EO + ((size_t)(b * 2) * 2048 + k1) * 1024 + c4), o = *(const f32x4*)(EO + ((size_t)(b * 2 + 1) * 2048 + k1) * 1024 + c4);
    const f32x4 d = e - o, s = e + o;
    u32x2 pk;
    pk.x = pk2(d[0], d[1]); pk.y = pk2(d[2], d[3]);
    *(u32x2*)(f + ((size_t)b * 4096 + k1) * 1024 + c4) = pk;
    if (k1 > 0) {
      pk.x = pk2(s[0], s[1]); pk.y = pk2(s[2], s[3]);
      *(u32x2*)(f + ((size_t)b * 4096 + 4096 - k1) * 1024 + c4) = pk;
    }
  }
  {
    const int lane = threadIdx.x & 63, gw = blockIdx.x * 8 + (threadIdx.x >> 6), nw = gridDim.x * 8;
    for (int r = gw; r < 8 * 1024; r += nw) {
      const int b = r >> 10, n = r & 1023;
      const bf16_t* cp = CST + ((size_t)(b * 2) * 1024 + n) * 4096;
      float acc = 0.f;
#pragma unroll
      for (int j = 0; j < 8; ++j) {
        const u32x4 u = *(const u32x4*)(cp + j * 512 + lane * 8);
        acc += (lo16(u.x) - hi16(u.x)) + (lo16(u.y) - hi16(u.y)) + (lo16(u.z) - hi16(u.z)) + (lo16(u.w) - hi16(u.w));
      }
      acc = wave_sum(acc);
      if (lane == 0) f[((size_t)b * 4096 + 2048) * 1024 + n] = f2bf(acc * (1.f / 64.f));
    }
  }
}

#define LDSP ((PG8_LAS unsigned char*)lds)
template <class Epi>
DEV void pgemm(char* lds, const bf16_t* A, const bf16_t* Bt, int M_, int N_, int K_, const Epi& E) {
  pg8::Gemm g{A, Bt, M_, N_, K_};
  pg8::StaticOrder S;
  S.init(M_, N_, (int)gridDim.x, (int)blockIdx.x);
  pg8::gemm_phase<Epi, pg8::StaticOrder, true, true>(LDSP, g, S, E);
}

DEV void ffn(char* lds, const XcdBarrier& xbar, const P& p, int l) {
  const bf16_t* h = (const bf16_t*)(p.ws + O_H);
  bf16_t* act = (bf16_t*)(p.ws + O_ACT);
  bf16_t* yf = (bf16_t*)(p.ws + O_YF);
  const bf16_t* upt = (const bf16_t*)(p.ws + W_UP) + (size_t)l * 5632 * 1024;
  const bf16_t* dnt = (const bf16_t*)(p.ws + W_DOWN) + (size_t)l * 1024 * 2816;
  pgemm(lds, h, upt, MT, 5632, 1024, pg8::PEpiGlu{act, (bf16_t*)(p.ws + O_SB), p.ffn_conv + (size_t)l * 3 * 5632});
  xcd_barrier(xbar);
  glu_fixup(p, l);
  xcd_barrier(xbar);
  pgemm(lds, act, dnt, MT, 1024, 2816, pg8::PEpiBf16<false>{yf, 1024});
  xcd_barrier(xbar);
}

__global__ void __launch_bounds__(NTHR) mega(P p) {
  extern __shared__ __attribute__((aligned(16))) char lds[];
  cg::grid_group grid = cg::this_grid();
  char* ws = p.ws;
  if (threadIdx.x < 4) ((unsigned*)(lds + 131072))[threadIdx.x] = 0u;
  __syncthreads();
  const XcdBarrier xbar = xcd_barrier_post((unsigned*)(ws + W_BAR), (volatile XLAS unsigned*)(lds + 131072));
  float* mod = (float*)(ws + W_MOD);
  const int gt = blockIdx.x * NTHR + threadIdx.x, ngt = gridDim.x * NTHR;

  compute_mod(lds, p);
  transpose_convert(lds, p.mix_in, 1024, 3584, (bf16_t*)(ws + W_MIXIN), 1024, 0);
  for (int l = 0; l < 2; ++l) {
    transpose_convert(lds, p.ffn_up + (size_t)l * 1024 * 5632, 1024, 5632, (bf16_t*)(ws + W_UP) + (size_t)l * 5632 * 1024, 1024, 64 * l, true);
    transpose_convert(lds, p.ffn_down + (size_t)l * 2816 * 1024, 2816, 1024, (bf16_t*)(ws + W_DOWN) + (size_t)l * 1024 * 2816, 2816, 128 + 64 * l);
  }
  transpose_convert(lds, p.mix_out, 1024, 1024, (bf16_t*)(ws + W_MIXOUT), 1024, 32);
  transpose_convert(lds, p.fnet_w, 1024, 1024, (bf16_t*)(ws + W_FNET), 1024, 96);
  for (int d = 0; d < 2; ++d) {
    transpose_convert(lds, p.w1 + (size_t)d * 512 * 64, 512, 64, (bf16_t*)(ws + W_L1) + (size_t)(d * 64) * 512, 512, 8 * d);
    transpose_convert(lds, p.a1 + (size_t)d * 512 * 64, 512, 64, (bf16_t*)(ws + W_L1) + (size_t)(128 + d * 64) * 512, 512, 16 + 8 * d);
    transpose_convert(lds, p.w2 + (size_t)d * 64 * 512, 64, 512, (bf16_t*)(ws + W_W2) + (size_t)d * 512 * 64, 64, 48 + 8 * d);
    transpose_convert(lds, p.a2 + (size_t)d * 64 * 512, 64, 512, (bf16_t*)(ws + W_A2) + (size_t)d * 512 * 64, 64, 64 + 8 * d);
  }
  transpose_convert(lds, p.g1, 512, 128, (bf16_t*)(ws + W_L1) + (size_t)256 * 512, 512, 32);
  transpose_convert(lds, p.g2, 128, 512, (bf16_t*)(ws + W_G2), 128, 80);
  {
    float* rope = (float*)(ws + W_ROPE);
    for (int idx = gt; idx < 4096 * 32; idx += ngt) {
      const int s = idx >> 5, e = idx & 31;
      const float inv = powf(10000.f, -(float)e / 32.f);
      const float ang = (float)s * inv;
      float sv, cv;
      sincosf(ang, &sv, &cv);
      rope[2 * idx] = cv;
      rope[2 * idx + 1] = sv;
    }
    bf16_t* dftc = (bf16_t*)(ws + W_DFTC);
    for (int idx = gt; idx < 256 * 128; idx += ngt) {
      const int n = idx >> 7, c = idx & 127, k2 = n & 127;
      const float ph = (float)((k2 * c) & 127) * (1.f / 64.f);
      const float v = (n < 128) ? cospif(ph) : sinpif(ph);
      dftc[idx] = f2bf(v * 0.08838834764831845f);
    }
  }
  grid.sync();
  for (int rep_ = 0; rep_ < REP_ROW; ++rep_) { rowpass<false, true>(p.x, nullptr, nullptr, nullptr, nullptr, p.norm_g, mod + 1024, mod, (bf16_t*)(ws + O_H0)); xcd_barrier(xbar); }
  pgemm(lds, (const bf16_t*)(ws + O_H0), (const bf16_t*)(ws + W_MIXIN), MT, INC, 1024, pg8::PEpiBf16<false>{(bf16_t*)(ws + O_Z), INC});
  xcd_barrier(xbar);
  for (int rep_ = 0; rep_ < REP_PREP; ++rep_) { prep1(p); xcd_barrier(xbar); }
  for (int rep_ = 0; rep_ < REP_ATT; ++rep_) { attention(lds, p); xcd_barrier(xbar); }
  combineA(p);
  gemm_grid(lds, (const bf16_t*)p.out + 1536, 2048, (const bf16_t*)(ws + W_L1), 512, 512, 128, 3, EpiLora1{(bf16_t*)(ws + O_L1)});
  xcd_barrier(xbar);
  for (int d = 0; d < 2; ++d) {
    gemm_grid(lds, (const bf16_t*)(ws + O_L1) + d * 64, 384, (const bf16_t*)(ws + W_W2) + (size_t)d * 512 * 64, 64, 64, 128, 4,
              EpiDecay{(bf16_t*)(ws + O_OMW) + (size_t)d * MT * 512, p.w0 + d * 512});
    gemm_grid(lds, (const bf16_t*)(ws + O_L1) + 128 + d * 64, 384, (const bf16_t*)(ws + W_A2) + (size_t)d * 512 * 64, 64, 64, 128, 4,
              EpiA{(bf16_t*)(ws + O_KD) + (size_t)d * MT * 512, (bf16_t*)(ws + O_KKA) + (size_t)d * MT * 512, (bf16_t*)(ws + O_KK), p.a0 + d * 512,
                   p.k_k, p.k_a, (const bf16_t*)p.out, d == 0});
  }
  gemm_grid(lds, (const bf16_t*)(ws + O_L1) + 256, 384, (const bf16_t*)(ws + W_G2), 128, 128, 128, 4, EpiBf16{(bf16_t*)(ws + O_G), 512});
  xcd_barrier(xbar);
  for (int rep_ = 0; rep_ < REP_SCAN; ++rep_) { scan_phase(lds, p); xcd_barrier(xbar); }
  for (int rep_ = 0; rep_ < REP_SYNC; ++rep_) xcd_barrier(xbar);
  postB(p);
  xcd_barrier(xbar);
  pgemm(lds, (const bf16_t*)(ws + O_YCAT), (const bf16_t*)(ws + W_MIXOUT), MT, 1024, 1024, pg8::PEpiBf16<false>{(bf16_t*)(ws + O_YF), 1024});
  xcd_barrier(xbar);
  rowpass<true, true>(p.x, (const bf16_t*)(ws + O_YF), p.norm_g + 1024, mod + 2048, p.out, p.norm_g + 2048, mod + 4096, mod + 3072, (bf16_t*)(ws + O_H));
  xcd_barrier(xbar);
  ffn(lds, xbar, p, 0);
  {
    const float* mod1 = mod + 8 * 6144;
    rowpass<true, true>(p.out, (const bf16_t*)(ws + O_YF), p.norm_g + 3072, mod + 5120, p.out, p.norm_g + 4096, mod1 + 1024, mod1, (bf16_t*)(ws + O_H));
    bf16_t* cs = (bf16_t*)(ws + O_COSSIN);
    for (int idx = blockIdx.x * NTHR + threadIdx.x; idx < 4096 * 512; idx += gridDim.x * NTHR) {
      const int rr = idx >> 9, s8 = (idx & 511) * 8, k1 = rr & 2047;
      float o[8];
#pragma unroll
      for (int i = 0; i < 8; ++i) {
        const float ph = (float)((k1 * (s8 + i)) & 4095) * (1.f / 2048.f);
        o[i] = ((rr < 2048) ? cospif(ph) : sinpif(ph)) * (1.f / 64.f);
      }
      *(u32x4*)(cs + (size_t)rr * 4096 + s8) = pack8(o);
    }
    xcd_barrier(xbar);
    for (int t = blockIdx.x; t < 8 * 256; t += gridDim.x) {
      const int g = t >> 8, tn = t & 255;
      gemm_tile(lds, (const bf16_t*)(ws + W_DFTC), 128, (const bf16_t*)(ws + O_H) + (size_t)tn * 128 * 1024 + g * 128, 1024, 128, 0, tn * 128,
                EpiDftc{(bf16_t*)(ws + O_CST), g});
    }
    xcd_barrier(xbar);
    {
      pg8::Gemm g{(const bf16_t*)(ws + O_COSSIN), (const bf16_t*)(ws + O_CST), 4096, 16384, 4096};
      pg8::BatchOrder S{(int)gridDim.x, (int)blockIdx.x};
      pg8::gemm_phase<pg8::PEpiF32B, pg8::BatchOrder, true, true>(LDSP, g, S, pg8::PEpiF32B{(float*)(ws + O_EO)});
    }
    xcd_barrier(xbar);
    dft_combine(p);
    xcd_barrier(xbar);
    pgemm(lds, (const bf16_t*)(ws + O_F), (const bf16_t*)(ws + W_FNET), MT, 1024, 1024, pg8::PEpiBf16<false>{(bf16_t*)(ws + O_YF), 1024});
    xcd_barrier(xbar);
    rowpass<true, true>(p.out, (const bf16_t*)(ws + O_YF), p.norm_g + 4096 + 1024, mod1 + 2048, p.out, p.norm_g + 4096 + 2048, mod1 + 4096, mod1 + 3072,
                        (bf16_t*)(ws + O_H));
    xcd_barrier(xbar);
    ffn(lds, xbar, p, 1);
    rowpass<true, false>(p.out, (const bf16_t*)(ws + O_YF), p.norm_g + 4096 + 3072, mod1 + 5120, p.out, nullptr, nullptr, nullptr, nullptr);
  }
}

extern "C" void kernel_launch(void* const* d_in, const int* in_sizes, int n_in, void* d_out, int out_size, void* d_ws, size_t ws_size,
                              hipStream_t stream) {
  static int grid_blocks = 0;
  if (!grid_blocks) {
    int dev = 0, cus = 0, per_cu = 0;
    hipGetDevice(&dev);
    hipDeviceGetAttribute(&cus, hipDeviceAttributeMultiprocessorCount, dev);
    hipFuncSetAttribute((const void*)mega, hipFuncAttributeMaxDynamicSharedMemorySize, LDS_BYTES);
    hipOccupancyMaxActiveBlocksPerMultiprocessor(&per_cu, (const void*)mega, NTHR, LDS_BYTES);
    if (per_cu < 1) { fprintf(stderr, "occupancy query returned %d\n", per_cu); per_cu = 1; }
    if (per_cu > 1) per_cu = 1;
    grid_blocks = cus * per_cu;
  }
  P p{};
  const float** pp = (const float**)&p;
  for (int i = 0; i < 25; ++i) pp[i] = (const float*)d_in[i];
  p.out = (float*)d_out;
  p.ws = (char*)d_ws;
  (void)hipMemsetAsync((char*)d_ws + W_BAR, 0, XCD_BAR_WORDS * sizeof(unsigned), stream);
  void* args[] = {&p};
  hipError_t e = hipLaunchCooperativeKernel((const void*)mega, dim3(grid_blocks), dim3(NTHR), args, LDS_BYTES, stream);
  if (e != hipSuccess) fprintf(stderr, "cooperative launch failed: %s (grid %d)\n", hipGetErrorString(e), grid_blocks);
}
```

```cpp
#include <hip/hip_runtime.h>
#include <hip/hip_cooperative_groups.h>
#include <stdint.h>
#include <cstdio>
namespace cg = cooperative_groups;

typedef unsigned short bf16_t;
typedef short bf16x8 __attribute__((ext_vector_type(8)));
typedef short s16x4 __attribute__((ext_vector_type(4)));
typedef float f32x4 __attribute__((ext_vector_type(4)));
typedef float f32x2 __attribute__((ext_vector_type(2)));
typedef unsigned u32x4 __attribute__((ext_vector_type(4)));
typedef unsigned u32x2 __attribute__((ext_vector_type(2)));

#define DEV __device__ __forceinline__
__device__ __forceinline__ int tidx() { int t = threadIdx.x; asm volatile("" : "+v"(t)); return t; }

constexpr int NB = 8, SEQ = 4096, DM = 1024, MT = NB * SEQ, DFF = 2816, INC = 3584;
constexpr size_t MiB = 1024 * 1024;
constexpr int NTHR = 512;
constexpr int LDS_BYTES = 131072 + 16;
constexpr size_t W_BAR = 47 * 1024 * 1024;
#ifndef REP_SCAN
#define REP_SCAN 1
#endif
#ifndef REP_ATT
#define REP_ATT 1
#endif
#ifndef REP_SYNC
#define REP_SYNC 0
#endif
#ifndef REP_PREP
#define REP_PREP 1
#endif
#ifndef REP_LORA
#define REP_LORA 1
#endif
#ifndef REP_GLU
#define REP_GLU 1
#endif
#ifndef REP_PRO
#define REP_PRO 1
#endif
#ifndef REP_ROW
#define REP_ROW 1
#endif

constexpr size_t W_MIXIN = 0;
constexpr size_t W_UP = 7 * MiB;
constexpr size_t W_DOWN = 29 * MiB;
constexpr size_t W_MIXOUT = 40 * MiB;
constexpr size_t W_FNET = 42 * MiB;
constexpr size_t W_L1 = 44 * MiB;
constexpr size_t W_W2 = W_L1 + 512 * 1024;
constexpr size_t W_A2 = W_W2 + 128 * 1024;
constexpr size_t W_G2 = W_A2 + 128 * 1024;
constexpr size_t W_DFTC = W_G2 + 128 * 1024;
constexpr size_t W_MOD = 45 * MiB;
constexpr size_t W_ROPE = 46 * MiB;
constexpr size_t R0 = 48 * MiB;
constexpr size_t O_H0 = R0;
constexpr size_t O_Z = 112 * MiB;
constexpr size_t O_QR = 336 * MiB, O_KR = 368 * MiB, O_VT = 400 * MiB;
constexpr size_t O_NUM = R0;
constexpr size_t O_MD = 240 * MiB;
constexpr size_t O_YCAT = 448 * MiB;
constexpr size_t O_OMW = 48 * MiB, O_KD = 112 * MiB, O_KKA = 176 * MiB, O_KK = 240 * MiB, O_G = 272 * MiB, O_L1 = 304 * MiB, O_Y = 304 * MiB;
constexpr size_t O_YF = 48 * MiB;
constexpr size_t O_H = 176 * MiB;
constexpr size_t O_ZF = 240 * MiB;
constexpr size_t O_ACT = 240 * MiB;
constexpr size_t O_SB = 416 * MiB;
constexpr size_t O_COSSIN = 240 * MiB;
constexpr size_t O_CST = 304 * MiB;
constexpr size_t O_F = 432 * MiB;
constexpr size_t O_CSTF = 432 * MiB;
constexpr size_t O_C2048 = 272 * MiB;
constexpr size_t O_EO = 48 * MiB;

struct P {
  const float *x, *c, *ada_w, *ada_b, *norm_g, *mix_in, *mix_conv, *w0, *w1, *w2, *a0, *a1, *a2, *g1, *g2, *k_k, *k_a, *r_k, *lnx_w,
      *lnx_b, *mix_out, *fnet_w, *ffn_up, *ffn_conv, *ffn_down;
  float* out;
  char* ws;
};

DEV float bf2f(bf16_t h) { return __uint_as_float(((unsigned)h) << 16); }
DEV bf16_t f2bf(float f) {
  unsigned u = __float_as_uint(f);
  u += 0x7fffu + ((u >> 16) & 1u);
  return (bf16_t)(u >> 16);
}
DEV unsigned pk2(float a, float b) { return (unsigned)f2bf(a) | ((unsigned)f2bf(b) << 16); }
DEV float lo16(unsigned u) { return __uint_as_float(u << 16); }
DEV float hi16(unsigned u) { return __uint_as_float(u & 0xffff0000u); }
DEV float wave_sum(float v) {
#pragma unroll
  for (int o = 32; o; o >>= 1) v += __shfl_xor(v, o);
  return v;
}
DEV float sigmoidf_(float x) { return __builtin_amdgcn_rcpf(1.f + __expf(-x)); }

#include <cstdint>
#include <cstdlib>
#include <vector>

#define XB_TMO      128
#define XB_XCNT(j)  (256  + 64 * (j))
#define XB_XSUB(j)  (1280 + 64 * (j))
#define XB_XGEN(j)  (2304 + 64 * (j))
#define XB_TOP      3328
#define XB_TOPGEN   3392
#define XCD_BAR_WORDS 3456
#define XB_SPIN_CAP (1u << 18)
#define XLAS __attribute__((address_space(3)))

__device__ __forceinline__ unsigned xb_ld(unsigned* p)              { return __hip_atomic_load(p, __ATOMIC_RELAXED, __HIP_MEMORY_SCOPE_AGENT); }
__device__ __forceinline__ unsigned xb_add(unsigned* p, unsigned v) { return __hip_atomic_fetch_add(p, v, __ATOMIC_RELAXED, __HIP_MEMORY_SCOPE_AGENT); }
__device__ __forceinline__ unsigned xb_xcc_id() { return (unsigned)__builtin_amdgcn_s_getreg((3 << 11) | 20) & 0xFu; }
#define XB_SPIN(cond, bar) do { unsigned _sp = 0; while (cond) { __builtin_amdgcn_s_sleep(1); \
    if ((++_sp & 255u) == 0u) { if (xb_ld(&(bar)[XB_TMO])) break; if (_sp > XB_SPIN_CAP) { atomicAdd(&(bar)[XB_TMO], 1u); break; } } } } while (0)

struct XcdBarrier {
    unsigned* bar; unsigned x;
    volatile XLAS unsigned* st;
};

__device__ __forceinline__ XcdBarrier xcd_barrier_post(unsigned* bar, volatile XLAS unsigned* st) {
    XcdBarrier b; b.bar = bar; b.x = xb_xcc_id(); b.st = st;
    if (threadIdx.x == 0) (void)xb_add(&bar[XB_XCNT(b.x)], 1u);
    return b;
}
__device__ __forceinline__ void xcd_barrier_complete(unsigned* bar, unsigned x, unsigned& nloc, unsigned& nx) {
    const unsigned G = gridDim.x * gridDim.y * gridDim.z;
    unsigned sum, cnt, mine, sp = 0u;
    for (;;) {
        sum = 0u; cnt = 0u; mine = 0u;
#pragma unroll
        for (unsigned j = 0; j < 16; ++j) { const unsigned c = xb_ld(&bar[XB_XCNT(j)]); sum += c; cnt += (c > 0u) ? 1u : 0u; mine = (j == x) ? c : mine; }
        if (sum == G) break;
        __builtin_amdgcn_s_sleep(1);
        if ((++sp & 255u) == 0u) { if (xb_ld(&bar[XB_TMO])) break; if (sp > XB_SPIN_CAP) { atomicAdd(&bar[XB_TMO], 1u); break; } }
    }
    nloc = mine > 0u ? mine : 1u; nx = cnt > 0u ? cnt : 1u;
}

__device__ __forceinline__ void xcd_barrier(const XcdBarrier& b) {
    asm volatile("s_waitcnt vmcnt(0)" ::: "memory");
    __syncthreads();
    if (threadIdx.x == 0) {
        unsigned* bar = b.bar;
        __builtin_amdgcn_s_waitcnt(0);
        unsigned nloc = b.st[0], nx = b.st[1];
        if (nloc == 0u) { xcd_barrier_complete(bar, b.x, nloc, nx); b.st[0] = nloc; b.st[1] = nx; }
        const unsigned old = xb_add(&bar[XB_XSUB(b.x)], 1u);
        const unsigned gen = old / nloc;
        if (old + 1u == (gen + 1u) * nloc) {
            __builtin_amdgcn_fence(__ATOMIC_RELEASE, "agent");
            asm volatile("s_waitcnt vmcnt(0)" ::: "memory");
            const unsigned og = xb_add(&bar[XB_TOP], 1u);
            const unsigned tg = og / nx;
            if (og + 1u == (tg + 1u) * nx) xb_add(&bar[XB_TOPGEN], 1u);
            else XB_SPIN(xb_ld(&bar[XB_TOPGEN]) == tg, bar);
            __builtin_amdgcn_fence(__ATOMIC_ACQUIRE, "agent");
            xb_add(&bar[XB_XGEN(b.x)], 1u);
            asm volatile("s_waitcnt vmcnt(0)" ::: "memory");
        } else {
            XB_SPIN(xb_ld(&bar[XB_XGEN(b.x)]) == gen, bar);
            __builtin_amdgcn_fence(__ATOMIC_ACQUIRE, "agent");
            asm volatile("s_waitcnt vmcnt(0)" ::: "memory");
        }
    }
    __syncthreads();
}

namespace pg8 {
#define PG8_LAS __attribute__((address_space(3)))
typedef unsigned short bf16_t;
typedef short bf16x8 __attribute__((ext_vector_type(8)));
typedef float f32x4 __attribute__((ext_vector_type(4)));
typedef unsigned u32x4 __attribute__((ext_vector_type(4)));
constexpr int BM = 256, BK = 64, HALF = 128, HTB = HALF * BK * 2  , STAGE_BYTES = 8 * HTB, NXCD = 8, WGM = 8;

__host__ __device__ __forceinline__ int lds_byte(int r, int c) { const int st = (r >> 4) * 2 + (c >> 5), rr = r & 15, cc = c & 31, ob = rr * 64 + cc * 2; return st * 1024 + (ob ^ (((ob >> 9) & 1) << 5)); }
__host__ __device__ __forceinline__ void stage_rc(int b, int& R, int& C) { const int st = b / 1024, sb = b % 1024, swz = sb ^ (((sb >> 9) & 1) << 5); R = (st >> 1) * 16 + swz / 64; C = (st & 1) * 32 + (swz % 64) / 2; }
__host__ __device__ __forceinline__ int perm32(int rho) { const int n = rho >> 4, i = rho & 15; return 8 * (i >> 2) + 4 * n + (i & 3); }

struct Unit { int pm, pn; };
struct Gemm { const bf16_t* A; const bf16_t* Bt; int M, N, K; };

struct StaticOrder {
    int nM, nN, nwg, G, c;
    __host__ __device__ void init(int M, int N, int G_, int c_) { nM = M / BM; nN = N / BM; nwg = nM * nN; G = G_; c = c_; }
    __host__ __device__ bool next(int i, Unit& u) const {
        const long L = (long)i * G + c; if (L >= nwg) return false;
        int wgid = (int)L; { const int q = nwg / NXCD, r = nwg % NXCD, xcd = wgid % NXCD, off = wgid / NXCD; wgid = (xcd < r ? xcd * (q + 1) : r * (q + 1) + (xcd - r) * q) + off; }
        const int nig = WGM * nN, gid = wgid / nig, fm = gid * WGM, gsz = (nM - fm) < WGM ? (nM - fm) : WGM;
        u.pm = fm + ((wgid % nig) % gsz); u.pn = (wgid % nig) / gsz; return true;
    }
    __device__ __forceinline__ void a_ready(const Unit&) const {}
    __device__ __forceinline__ void done(const Unit&) const {}
};

__device__ __forceinline__ unsigned cvt_pk_bf16(float lo, float hi) { unsigned r; asm volatile("v_cvt_pk_bf16_f32 %0, %1, %2" : "=v"(r) : "v"(lo), "v"(hi)); return r; }

template <bool BATCHED> struct PEpiBf16 {
    static constexpr bool PERM = true, AFTER_DRAIN = false;
    bf16_t* O; int ldc;
    __device__ __forceinline__ void operator()(const f32x4 (&acc)[2][2][4][2], const Unit& u, int wr, int wc, int fr, int fq) const {
        const int rb = BATCHED ? ((u.pn >> 2) * 4096 + u.pm * 256) : u.pm * 256, cb = BATCHED ? (u.pn & 3) * 256 : u.pn * 256;
        const int row0 = rb + wr * 64 + fr, col0 = cb + wc * 32 + 8 * fq;
#pragma unroll
        for (int ai = 0; ai < 2; ++ai)
#pragma unroll
            for (int m = 0; m < 4; ++m) { bf16_t* rowp = O + (size_t)(row0 + ai * HALF + m * 16) * ldc + col0;
#pragma unroll
                for (int bj = 0; bj < 2; ++bj) { const f32x4 v0 = acc[ai][bj][m][0], v1 = acc[ai][bj][m][1];
                    u32x4 w; w.x = cvt_pk_bf16(v0[0], v0[1]); w.y = cvt_pk_bf16(v0[2], v0[3]); w.z = cvt_pk_bf16(v1[0], v1[1]); w.w = cvt_pk_bf16(v1[2], v1[3]);
                    *(u32x4*)(rowp + bj * HALF) = w; } }
    }
};
struct PEpiF32 {
    static constexpr bool PERM = true, AFTER_DRAIN = false;
    float* O; int ldc;
    __device__ __forceinline__ void operator()(const f32x4 (&acc)[2][2][4][2], const Unit& u, int wr, int wc, int fr, int fq) const {
        const int row0 = u.pm * 256 + wr * 64 + fr, col0 = u.pn * 256 + wc * 32 + 8 * fq;
#pragma unroll
        for (int ai = 0; ai < 2; ++ai)
#pragma unroll
            for (int m = 0; m < 4; ++m) { float* rowp = O + (size_t)(row0 + ai * HALF + m * 16) * ldc + col0;
#pragma unroll
                for (int bj = 0; bj < 2; ++bj) { *(f32x4*)(rowp + bj * HALF) = acc[ai][bj][m][0]; *(f32x4*)(rowp + bj * HALF + 4) = acc[ai][bj][m][1]; } }
    }
};
template <int CTRL> __device__ __forceinline__ float dppz(float x) { return __int_as_float(__builtin_amdgcn_update_dpp(0, __float_as_int(x), CTRL, 0xF, 0xF, true)); }
template <int CTRL> __device__ __forceinline__ float dppo(float old, float x) { return __int_as_float(__builtin_amdgcn_update_dpp(__float_as_int(old), __float_as_int(x), CTRL, 0xF, 0xF, false)); }
struct PEpiGlu {
    static constexpr bool PERM = true, AFTER_DRAIN = false;
    bf16_t* act; bf16_t* sb; const float* cw;
    __device__ __forceinline__ void operator()(const f32x4 (&acc)[2][2][4][2], const Unit& u, int wr, int wc, int fr, int fq) const {
        const int chb = u.pn * 128 + wc * 32 + 8 * fq, colp = u.pn * 256 + wc * 32 + 8 * fq;
#pragma unroll
        for (int n = 0; n < 2; ++n) {
            const int ch = chb + 4 * n;
            const f32x4 g0 = *(const f32x4*)(cw + ch), g1 = *(const f32x4*)(cw + 5632 + ch), g2 = *(const f32x4*)(cw + 11264 + ch);
            const f32x4 v0 = *(const f32x4*)(cw + 2816 + ch), v1 = *(const f32x4*)(cw + 5632 + 2816 + ch), v2 = *(const f32x4*)(cw + 11264 + 2816 + ch);
#pragma unroll
            for (int ai = 0; ai < 2; ++ai) {
                const int strip = u.pm * 4 + ai * 2 + wr, rowbase = u.pm * 256 + ai * HALF + wr * 64;
#pragma unroll
                for (int m = 0; m < 4; ++m) {
                    float o[4];
#pragma unroll
                    for (int r = 0; r < 4; ++r) {
                        const float gc = acc[ai][0][m][n][r], vc = acc[ai][1][m][n][r];
                        float gx = 0.f, vx = 0.f, gy = 0.f, vy = 0.f;
                        if (m > 0) { gx = dppz<0x121>(acc[ai][0][m - 1][n][r]); vx = dppz<0x121>(acc[ai][1][m - 1][n][r]); }
                        const float gp = dppo<0x111>(gx, gc), vp = dppo<0x111>(vx, vc);
                        if (m < 3) { gy = dppz<0x12F>(acc[ai][0][m + 1][n][r]); vy = dppz<0x12F>(acc[ai][1][m + 1][n][r]); }
                        const float gn = dppo<0x101>(gy, gc), vn = dppo<0x101>(vy, vc);
                        const float g = gp * g0[r] + gc * g1[r] + gn * g2[r];
                        const float v = vp * v0[r] + vc * v1[r] + vn * v2[r];
                        const float u2 = -1.5957691216057308f * (g + 0.044715f * g * g * g);
                        o[r] = g * __builtin_amdgcn_rcpf(1.f + __expf(u2)) * v;
                    }
                    u32x2 w; w.x = cvt_pk_bf16(o[0], o[1]); w.y = cvt_pk_bf16(o[2], o[3]);
                    *(u32x2*)(act + (size_t)(rowbase + m * 16 + fr) * 2816 + ch) = w;
                }
                if (fr < 2) {
                    bf16_t* sp = sb + ((size_t)strip * 4 + fr) * 5632 + colp + 4 * n;
                    u32x2 w; w.x = cvt_pk_bf16(acc[ai][0][0][n][0], acc[ai][0][0][n][1]); w.y = cvt_pk_bf16(acc[ai][0][0][n][2], acc[ai][0][0][n][3]);
                    *(u32x2*)sp = w;
                    w.x = cvt_pk_bf16(acc[ai][1][0][n][0], acc[ai][1][0][n][1]); w.y = cvt_pk_bf16(acc[ai][1][0][n][2], acc[ai][1][0][n][3]);
                    *(u32x2*)(sp + 128) = w;
                }
                if (fr >= 14) {
                    bf16_t* sp = sb + ((size_t)strip * 4 + (fr - 12)) * 5632 + colp + 4 * n;
                    u32x2 w; w.x = cvt_pk_bf16(acc[ai][0][3][n][0], acc[ai][0][3][n][1]); w.y = cvt_pk_bf16(acc[ai][0][3][n][2], acc[ai][0][3][n][3]);
                    *(u32x2*)sp = w;
                    w.x = cvt_pk_bf16(acc[ai][1][3][n][0], acc[ai][1][3][n][1]); w.y = cvt_pk_bf16(acc[ai][1][3][n][2], acc[ai][1][3][n][3]);
                    *(u32x2*)(sp + 128) = w;
                }
            }
        }
    }
};
struct PEpiF32B {
    static constexpr bool PERM = true, AFTER_DRAIN = false;
    float* O;
    __device__ __forceinline__ void operator()(const f32x4 (&acc)[2][2][4][2], const Unit& u, int wr, int wc, int fr, int fq) const {
        const int row0 = (u.pn >> 2) * 2048 + (u.pm & 7) * 256 + wr * 64 + fr, col0 = (u.pn & 3) * 256 + wc * 32 + 8 * fq;
#pragma unroll
        for (int ai = 0; ai < 2; ++ai)
#pragma unroll
            for (int m = 0; m < 4; ++m) { float* rowp = O + (size_t)(row0 + ai * HALF + m * 16) * 1024 + col0;
#pragma unroll
                for (int bj = 0; bj < 2; ++bj) { *(f32x4*)(rowp + bj * HALF) = acc[ai][bj][m][0]; *(f32x4*)(rowp + bj * HALF + 4) = acc[ai][bj][m][1]; } }
    }
};
struct BatchOrder {
    int G, c;
    __device__ __forceinline__ bool next(int i, Unit& u) const { const int L = i * G + c; if (L >= 512) return false; const int be = L >> 5, r = L & 31; u.pm = (be & 1) * 8 + (r >> 2); u.pn = be * 4 + (r & 3); return true; }
    __device__ __forceinline__ void a_ready(const Unit&) const {}
    __device__ __forceinline__ void done(const Unit&) const {}
};
template <class Epi, class Sched, bool ALIGN_EPI = false, bool SP2 = false>
__device__ __forceinline__ void gemm_phase(PG8_LAS unsigned char* lds, const Gemm g, const Sched& S, const Epi& E) {
    int tid_ = threadIdx.x; asm volatile("" : "+v"(tid_));
    const int tid = tid_, wid = __builtin_amdgcn_readfirstlane(tid >> 6), lane = tid & 63, wr = wid >> 2, wc = wid & 3, fr = lane & 15, fq = lane >> 4;
    const int K = g.K, nt = K / BK;
    unsigned voffA[2], voffB[2];
#pragma unroll
    for (int i = 0; i < 2; ++i) { int R, C; stage_rc(tid * 16 + i * 8192, R, C); const int Rb = Epi::PERM ? ((R & ~31) + perm32(R & 31)) : R;
        voffA[i] = (unsigned)(R * K + C) * 2u; voffB[i] = (unsigned)(Rb * K + C) * 2u; }
    const size_t kstep = (size_t)(BK * 2);
    const size_t hstep = (size_t)HALF * K * 2;
    const size_t tstep = 2 * hstep;
    const unsigned ldsw = (unsigned)wid * 1024u;
    const int aoff = lds_byte(wr * 64 + fr, fq * 8), boff = lds_byte(wc * 32 + fr, fq * 8);
#define PG8_SA(b, h) (((b) * 2 + (h)) * HTB)
#define PG8_SB(b, h) ((4 + (b) * 2 + (h)) * HTB)
#define PG8_STAGE(bufoff, gbase, voff) do { _Pragma("unroll") for (int _i = 0; _i < 2; ++_i) \
        __builtin_amdgcn_global_load_lds((const unsigned*)((const char*)(gbase) + (voff)[_i]), (PG8_LAS unsigned*)(lds + (bufoff) + ldsw + _i * 8192), 16, 0, 0); } while (0)
#define PG8_LDA(dst, b, h) do { _Pragma("unroll") for (int m = 0; m < 4; ++m) _Pragma("unroll") for (int k = 0; k < 2; ++k) dst[m][k] = *(const PG8_LAS bf16x8*)(lds + PG8_SA(b, h) + aoff + m * 2048 + k * 1024); } while (0)
#define PG8_LDB(dst, b, h) do { _Pragma("unroll") for (int n = 0; n < 2; ++n) _Pragma("unroll") for (int k = 0; k < 2; ++k) dst[n][k] = *(const PG8_LAS bf16x8*)(lds + PG8_SB(b, h) + boff + n * 2048 + k * 1024); } while (0)
#define PG8_MMA(ai, bj, At, Bt) do { __builtin_amdgcn_s_setprio(1); _Pragma("unroll") for (int m = 0; m < 4; ++m) _Pragma("unroll") for (int n = 0; n < 2; ++n) _Pragma("unroll") for (int k = 0; k < 2; ++k) \
        acc[ai][bj][m][n] = __builtin_amdgcn_mfma_f32_16x16x32_bf16(Bt[n][k], At[m][k], acc[ai][bj][m][n], 0, 0, 0); __builtin_amdgcn_s_setprio(0); } while (0)
#define PG8_WAIT_V(n) asm volatile("s_waitcnt vmcnt(" #n ")" ::: "memory")
#define PG8_WAIT_L(n) asm volatile("s_waitcnt lgkmcnt(" #n ")" ::: "memory")
#define PG8_BAR __builtin_amdgcn_s_barrier()
#define PG8_SCHED __builtin_amdgcn_sched_barrier(0)
    Unit cur, nxt; int ui = 0;
    if (!S.next(0, cur)) return;
    f32x4 acc[2][2][4][2];
#pragma unroll
    for (int a = 0; a < 2; ++a)
#pragma unroll
        for (int b = 0; b < 2; ++b)
#pragma unroll
            for (int m = 0; m < 4; ++m)
#pragma unroll
                for (int n = 0; n < 2; ++n) acc[a][b][m][n] = (f32x4){0.f, 0.f, 0.f, 0.f};
    bf16x8 At[4][2], B0[2][2], B1[2][2];
    const char* cA = (const char*)g.A + (size_t)cur.pm * tstep; const char* cB = (const char*)g.Bt + (size_t)cur.pn * tstep;
    S.a_ready(cur);
    if constexpr (SP2) {
        PG8_STAGE(PG8_SB(0, 0), cB, voffB); PG8_STAGE(PG8_SB(0, 1), cB + hstep, voffB); PG8_STAGE(PG8_SA(0, 0), cA, voffA); PG8_STAGE(PG8_SA(0, 1), cA + hstep, voffA);
        if (wr == 1) PG8_BAR;
        PG8_WAIT_V(2); PG8_BAR;
        PG8_STAGE(PG8_SB(1, 0), cB + kstep, voffB); PG8_STAGE(PG8_SA(1, 0), cA + kstep, voffA); PG8_STAGE(PG8_SB(1, 1), cB + hstep + kstep, voffB);
        PG8_WAIT_V(6); PG8_BAR;
    } else {
        PG8_STAGE(PG8_SB(0, 0), cB, voffB); PG8_STAGE(PG8_SA(0, 0), cA, voffA); PG8_STAGE(PG8_SB(0, 1), cB + hstep, voffB); PG8_STAGE(PG8_SA(0, 1), cA + hstep, voffA);
        if (wr == 1) PG8_BAR;
        PG8_WAIT_V(4); PG8_BAR;
        PG8_STAGE(PG8_SB(1, 0), cB + kstep, voffB); PG8_STAGE(PG8_SA(1, 0), cA + kstep, voffA); PG8_STAGE(PG8_SB(1, 1), cB + hstep + kstep, voffB);
        PG8_WAIT_V(6); PG8_BAR;
    }
    for (;;) {
        const bool has_next = S.next(ui + 1, nxt);
        const char* nA = has_next ? (const char*)g.A + (size_t)nxt.pm * tstep : cA; const char* nB = has_next ? (const char*)g.Bt + (size_t)nxt.pn * tstep : cB;
        for (int t = 0; t < nt; t += 2) {
            const bool last = (t == nt - 2);
            const char* a1 = cA + (size_t)(t + 1) * kstep;
            const char* a2 = last ? nA : cA + (size_t)(t + 2) * kstep; const char* b2 = last ? nB : cB + (size_t)(t + 2) * kstep;
            const char* a3 = a2 + kstep; const char* b3 = b2 + kstep;
            if (last && has_next) S.a_ready(nxt);
            if constexpr (SP2) {
            PG8_LDB(B0, 0, 0); PG8_LDB(B1, 0, 1); PG8_SCHED; PG8_LDA(At, 0, 0); PG8_STAGE(PG8_SA(1, 1), a1 + hstep, voffA);
            PG8_WAIT_V(8); PG8_WAIT_L(0); PG8_BAR; PG8_MMA(0, 0, At, B0); PG8_MMA(0, 1, At, B1); PG8_BAR; PG8_SCHED;
            PG8_LDA(At, 0, 1); PG8_STAGE(PG8_SB(0, 0), b2, voffB); PG8_STAGE(PG8_SB(0, 1), b2 + hstep, voffB); PG8_STAGE(PG8_SA(0, 0), a2, voffA);
            PG8_WAIT_V(8); PG8_WAIT_L(0); PG8_BAR; PG8_MMA(1, 0, At, B0); PG8_MMA(1, 1, At, B1); PG8_BAR; PG8_SCHED;
            PG8_LDB(B0, 1, 0); PG8_LDB(B1, 1, 1); PG8_SCHED; PG8_LDA(At, 1, 0); PG8_STAGE(PG8_SA(0, 1), a2 + hstep, voffA);
            PG8_WAIT_V(8); PG8_WAIT_L(0); PG8_BAR; PG8_MMA(0, 0, At, B0); PG8_MMA(0, 1, At, B1); PG8_BAR; PG8_SCHED;
            PG8_LDA(At, 1, 1); PG8_STAGE(PG8_SB(1, 0), b3, voffB); PG8_STAGE(PG8_SB(1, 1), b3 + hstep, voffB); PG8_STAGE(PG8_SA(1, 0), a3, voffA);
            PG8_WAIT_V(8); PG8_WAIT_L(0); PG8_BAR; PG8_MMA(1, 0, At, B0); PG8_MMA(1, 1, At, B1); PG8_BAR; PG8_SCHED;
            } else {
            PG8_LDB(B0, 0, 0); PG8_SCHED; PG8_LDA(At, 0, 0); PG8_STAGE(PG8_SA(1, 1), a1 + hstep, voffA);
            PG8_WAIT_L(8); PG8_BAR; PG8_WAIT_L(0); PG8_MMA(0, 0, At, B0); PG8_BAR; PG8_SCHED;
            PG8_LDB(B1, 0, 1); PG8_STAGE(PG8_SB(0, 0), b2, voffB);
            PG8_BAR; PG8_WAIT_L(0); PG8_MMA(0, 1, At, B1); PG8_BAR;
            PG8_LDA(At, 0, 1); PG8_STAGE(PG8_SA(0, 0), a2, voffA);
            PG8_BAR; PG8_WAIT_L(0); PG8_MMA(1, 0, At, B0); PG8_BAR; PG8_SCHED;
            PG8_STAGE(PG8_SB(0, 1), b2 + hstep, voffB);
            PG8_WAIT_V(6); PG8_BAR; PG8_MMA(1, 1, At, B1); PG8_BAR;
            PG8_LDB(B0, 1, 0); PG8_SCHED; PG8_LDA(At, 1, 0); PG8_STAGE(PG8_SA(0, 1), a2 + hstep, voffA);
            PG8_WAIT_L(8); PG8_BAR; PG8_WAIT_L(0); PG8_MMA(0, 0, At, B0); PG8_BAR; PG8_SCHED;
            PG8_LDB(B1, 1, 1); PG8_STAGE(PG8_SB(1, 0), b3, voffB);
            PG8_BAR; PG8_WAIT_L(0); PG8_MMA(0, 1, At, B1); PG8_BAR;
            PG8_LDA(At, 1, 1); PG8_STAGE(PG8_SA(1, 0), a3, voffA);
            PG8_BAR; PG8_WAIT_L(0); PG8_MMA(1, 0, At, B0); PG8_BAR; PG8_SCHED;
            PG8_STAGE(PG8_SB(1, 1), b3 + hstep, voffB);
            PG8_WAIT_V(6); PG8_BAR; PG8_MMA(1, 1, At, B1); PG8_BAR;
            }
        }
        if constexpr (ALIGN_EPI) { if (wr == 0) PG8_BAR; }
        if constexpr (!Epi::AFTER_DRAIN) { E(acc, cur, wr, wc, fr, fq); S.done(cur); }
        if (!has_next) break;
#pragma unroll
        for (int a = 0; a < 2; ++a)
#pragma unroll
            for (int b = 0; b < 2; ++b)
#pragma unroll
                for (int m = 0; m < 4; ++m)
#pragma unroll
                    for (int n = 0; n < 2; ++n) acc[a][b][m][n] = (f32x4){0.f, 0.f, 0.f, 0.f};
        cur = nxt; cA = nA; cB = nB; ++ui;
        if constexpr (ALIGN_EPI) { if (wr == 1) PG8_BAR; }
    }
    PG8_WAIT_V(0);
    if constexpr (!ALIGN_EPI) { if (wr == 0) PG8_BAR; }
    PG8_BAR;
    if constexpr (Epi::AFTER_DRAIN) { E.fused(acc, cur, wr, wc, fr, fq, lds, wid, lane); S.done(cur); }
#undef PG8_SA
#undef PG8_SB
#undef PG8_STAGE
#undef PG8_LDA
#undef PG8_LDB
#undef PG8_MMA
#undef PG8_WAIT_V
#undef PG8_WAIT_L
#undef PG8_BAR
#undef PG8_SCHED
}
}

template <class Epi>
DEV void gemm_tile(char* lds, const bf16_t* __restrict__ A, int lda, const bf16_t* __restrict__ Bt, int ldb, int K, int trow, int tcol,
                   const Epi& epi) {
  const int tid = tidx(), w = tid >> 6, l = tid & 63, wm = w >> 1, wn = w & 1, lr = l & 15, lq = l >> 4;
  const bf16_t* ga[4];
  const bf16_t* gb[2];
#pragma unroll
  for (int j = 0; j < 4; ++j) {
    const int c = w * 4 + j, mt = c >> 1, sl = c & 1;
    ga[j] = A + (size_t)(mt * 16 + lr) * lda + sl * 32 + lq * 8;
  }
#pragma unroll
  for (int j = 0; j < 2; ++j) {
    const int nt = w, sl = j;
    const int rowb = (nt >> 2) * 64 + (lr >> 2) * 16 + (nt & 3) * 4 + (lr & 3);
    gb[j] = Bt + (size_t)rowb * ldb + sl * 32 + lq * 8;
  }
  f32x4 acc[4][4];
#pragma unroll
  for (int i = 0; i < 4; ++i)
#pragma unroll
    for (int j = 0; j < 4; ++j) acc[i][j] = (f32x4){0.f, 0.f, 0.f, 0.f};
  u32x4 ra[4], rb[2];
  const int nk = K >> 6;
#pragma unroll
  for (int j = 0; j < 4; ++j) ra[j] = *(const u32x4*)(ga[j]);
#pragma unroll
  for (int j = 0; j < 2; ++j) rb[j] = *(const u32x4*)(gb[j]);
#pragma unroll
  for (int j = 0; j < 4; ++j) *(u32x4*)(lds + (w * 4 + j) * 1024 + l * 16) = ra[j];
#pragma unroll
  for (int j = 0; j < 2; ++j) *(u32x4*)(lds + 32768 + (w * 2 + j) * 1024 + l * 16) = rb[j];
  __syncthreads();
  for (int kt = 0; kt < nk; ++kt) {
    char* cur = lds + (kt & 1) * 49152;
    const bool more = (kt + 1 < nk);
    if (more) {
#pragma unroll
      for (int j = 0; j < 4; ++j) ra[j] = *(const u32x4*)(ga[j] + (kt + 1) * 64);
#pragma unroll
      for (int j = 0; j < 2; ++j) rb[j] = *(const u32x4*)(gb[j] + (kt + 1) * 64);
    }
#pragma unroll
    for (int s = 0; s < 2; ++s) {
      bf16x8 af[4], bfr[4];
#pragma unroll
      for (int i = 0; i < 4; ++i) af[i] = *(const bf16x8*)(cur + ((wm * 4 + i) * 2 + s) * 1024 + l * 16);
#pragma unroll
      for (int j = 0; j < 4; ++j) bfr[j] = *(const bf16x8*)(cur + 32768 + ((wn * 4 + j) * 2 + s) * 1024 + l * 16);
#pragma unroll
      for (int i = 0; i < 4; ++i)
#pragma unroll
        for (int j = 0; j < 4; ++j) acc[i][j] = __builtin_amdgcn_mfma_f32_16x16x32_bf16(bfr[j], af[i], acc[i][j], 0, 0, 0);
    }
    if (more) {
      char* nxt = lds + ((kt + 1) & 1) * 49152;
#pragma unroll
      for (int j = 0; j < 4; ++j) *(u32x4*)(nxt + (w * 4 + j) * 1024 + l * 16) = ra[j];
#pragma unroll
      for (int j = 0; j < 2; ++j) *(u32x4*)(nxt + 32768 + (w * 2 + j) * 1024 + l * 16) = rb[j];
    }
    __syncthreads();
  }
#pragma unroll
  for (int i = 0; i < 4; ++i) epi(trow + wm * 64 + i * 16 + lr, tcol + wn * 64 + lq * 16, acc[i]);
}

DEV void store16_bf16(bf16_t* dst, const f32x4 (&v)[4], float sc) {
  u32x4 a, b;
  a.x = pk2(v[0][0] * sc, v[0][1] * sc); a.y = pk2(v[0][2] * sc, v[0][3] * sc);
  a.z = pk2(v[1][0] * sc, v[1][1] * sc); a.w = pk2(v[1][2] * sc, v[1][3] * sc);
  b.x = pk2(v[2][0] * sc, v[2][1] * sc); b.y = pk2(v[2][2] * sc, v[2][3] * sc);
  b.z = pk2(v[3][0] * sc, v[3][1] * sc); b.w = pk2(v[3][2] * sc, v[3][3] * sc);
  *(u32x4*)dst = a;
  *(u32x4*)(dst + 8) = b;
}

struct EpiBf16 {
  bf16_t* O; int ldo;
  DEV void operator()(int row, int col, const f32x4 (&v)[4]) const { store16_bf16(O + (size_t)row * ldo + col, v, 1.f); }
};
struct EpiF32 {
  float* O; int ldo;
  DEV void operator()(int row, int col, const f32x4 (&v)[4]) const {
    float* d = O + (size_t)row * ldo + col;
#pragma unroll
    for (int j = 0; j < 4; ++j) *(f32x4*)(d + 4 * j) = v[j];
  }
};
struct EpiLora1 {
  bf16_t* O;
  DEV void operator()(int row, int col, const f32x4 (&v)[4]) const {
    f32x4 o[4];
#pragma unroll
    for (int j = 0; j < 4; ++j)
#pragma unroll
      for (int r = 0; r < 4; ++r) {
        const float t = v[j][r];
        o[j][r] = (col < 128) ? (1.f - 2.f * __builtin_amdgcn_rcpf(1.f + __expf(2.f * t))) : ((col < 256) ? t : sigmoidf_(t));
      }
    store16_bf16(O + (size_t)row * 384 + col, o, 1.f);
  }
};
struct EpiDecay {
  bf16_t* O; const float* w0;
  DEV void operator()(int row, int col, const f32x4 (&v)[4]) const {
    f32x4 o[4];
    float w0v[16];
#pragma unroll
    for (int i = 0; i < 16; i += 4) *(f32x4*)(w0v + i) = *(const f32x4*)(w0 + col + i);
#pragma unroll
    for (int j = 0; j < 4; ++j)
#pragma unroll
      for (int r = 0; r < 4; ++r) {
        const float xx = w0v[4 * j + r] + v[j][r];
        const float nx = -xx;
        const float sp = (nx > 20.f) ? nx : __logf(1.f + __expf(nx));
        const float e = __expf(-sp - 0.5f);
        o[j][r] = 1.f - __expf(-e);
      }
    store16_bf16(O + (size_t)row * 512 + col, o, 1.f);
  }
};
struct EpiA {
  bf16_t *KD, *KKA, *KK; const float *a0, *k_k, *k_a; const bf16_t* za; int writekk;
  DEV void operator()(int row, int col, const f32x4 (&v)[4]) const {
    const bf16_t* kp = za + (size_t)row * 2048 + 512 + col;
    const u32x4 k0 = *(const u32x4*)kp, k1 = *(const u32x4*)(kp + 8);
    float kf[16];
    kf[0] = lo16(k0.x); kf[1] = hi16(k0.x); kf[2] = lo16(k0.y); kf[3] = hi16(k0.y); kf[4] = lo16(k0.z); kf[5] = hi16(k0.z); kf[6] = lo16(k0.w); kf[7] = hi16(k0.w);
    kf[8] = lo16(k1.x); kf[9] = hi16(k1.x); kf[10] = lo16(k1.y); kf[11] = hi16(k1.y); kf[12] = lo16(k1.z); kf[13] = hi16(k1.z); kf[14] = lo16(k1.w); kf[15] = hi16(k1.w);
    float kkv[16], a0v[16], kav[16];
#pragma unroll
    for (int i = 0; i < 16; i += 4) { *(f32x4*)(kkv + i) = *(const f32x4*)(k_k + col + i); *(f32x4*)(a0v + i) = *(const f32x4*)(a0 + col + i); *(f32x4*)(kav + i) = *(const f32x4*)(k_a + col + i); }
    float kr[16], ss = 0.f;
#pragma unroll
    for (int i = 0; i < 16; ++i) { kr[i] = kf[i] * kkv[i]; ss += kr[i] * kr[i]; }
    ss += __shfl_xor(ss, 16);
    ss += __shfl_xor(ss, 32);
    const float rn = rsqrtf(ss + 1e-12f);
    f32x4 okd[4], okka[4], okk[4];
#pragma unroll
    for (int j = 0; j < 4; ++j)
#pragma unroll
      for (int r = 0; r < 4; ++r) {
        const int i = 4 * j + r;
        const float a = sigmoidf_(a0v[i] + v[j][r]);
        const float kk = kr[i] * rn;
        okd[j][r] = kf[i] * (1.f + (a - 1.f) * kav[i]);
        okka[j][r] = kk * a;
        okk[j][r] = kk;
      }
    store16_bf16(KD + (size_t)row * 512 + col, okd, 1.f);
    store16_bf16(KKA + (size_t)row * 512 + col, okka, 1.f);
    if (writekk) store16_bf16(KK + (size_t)row * 512 + col, okk, 1.f);
  }
};
struct EpiDftc {
  bf16_t* CST; int g;
  DEV void operator()(int row, int col, const f32x4 (&v)[4]) const {
    const int b = col >> 12, s = col & 4095;
    store16_bf16(CST + ((size_t)((b * 2 + (row >> 7)) * 1024 + g * 128 + (row & 127)) * 4096 + s), v, 1.f);
  }
};

DEV void transpose_convert(char* lds, const float* __restrict__ W, int K, int N, bf16_t* __restrict__ Wt, int ldt, int rot, bool glu_perm = false) {
  float* tile = (float*)lds;
  const int tn_n = N >> 6, nt = (K >> 6) * tn_n, tid = tidx();
  const int r0 = tid >> 4, c4 = (tid & 15) * 4;
  int t = (blockIdx.x + rot) % gridDim.x;
  f32x4 ra, rb;
  if (t < nt) {
    const int tk = t / tn_n, tn = t % tn_n;
    const float* src = W + (size_t)(tk * 64 + r0) * N + tn * 64 + c4;
    ra = *(const f32x4*)src; rb = *(const f32x4*)(src + (size_t)32 * N);
  }
  for (; t < nt; t += gridDim.x) {
    const int tk = t / tn_n, tn = t % tn_n;
#pragma unroll
    for (int i = 0; i < 4; ++i) { tile[r0 * 65 + c4 + i] = ra[i]; tile[(r0 + 32) * 65 + c4 + i] = rb[i]; }
    __syncthreads();
    const int t2 = t + gridDim.x;
    if (t2 < nt) {
      const int tk2 = t2 / tn_n, tn2 = t2 % tn_n;
      const float* src = W + (size_t)(tk2 * 64 + r0) * N + tn2 * 64 + c4;
      ra = *(const f32x4*)src; rb = *(const f32x4*)(src + (size_t)32 * N);
    }
    int nbase = tn * 64;
    if (glu_perm) { const int c = tn * 64; nbase = (c < 2816) ? ((c >> 7) * 256 + (c & 127)) : (((c - 2816) >> 7) * 256 + 128 + ((c - 2816) & 127)); }
#pragma unroll
    for (int j = 0; j < 2; ++j) {
      const int n = r0 + 32 * j;
      u32x2 pk;
      pk.x = pk2(tile[(c4 + 0) * 65 + n], tile[(c4 + 1) * 65 + n]);
      pk.y = pk2(tile[(c4 + 2) * 65 + n], tile[(c4 + 3) * 65 + n]);
      *(u32x2*)(Wt + (size_t)(nbase + n) * ldt + tk * 64 + c4) = pk;
    }
    __syncthreads();
  }
}

DEV void compute_mod(char* lds, const P& p) {
  float* cs = (float*)lds;
  float* red = (float*)(lds + 32768);
  const int tid = tidx();
  float* mod = (float*)(p.ws + W_MOD);
  bool have = false;
  for (int item = blockIdx.x; item < 192; item += gridDim.x) {
    if (!have) {
      for (int i = tid; i < 8192; i += NTHR) { const float cv = p.c[i]; cs[i] = cv / (1.f + expf(-cv)); }
      __syncthreads();
      have = true;
    }
    const int l = item / 96, cb = item % 96, col = cb * 64 + (tid & 63), kg = tid >> 6;
    float a0 = 0, a1 = 0, a2 = 0, a3 = 0, a4 = 0, a5 = 0, a6 = 0, a7 = 0;
    const float* wp = p.ada_w + ((size_t)l * 1024 + kg * 128) * 6144 + col;
    for (int k = 0; k < 128; ++k) {
      const float wv = wp[(size_t)k * 6144];
      const int kk = kg * 128 + k;
      a0 += cs[kk] * wv; a1 += cs[1024 + kk] * wv; a2 += cs[2048 + kk] * wv; a3 += cs[3072 + kk] * wv;
      a4 += cs[4096 + kk] * wv; a5 += cs[5120 + kk] * wv; a6 += cs[6144 + kk] * wv; a7 += cs[7168 + kk] * wv;
    }
    float* rp = red + kg * 512 + (tid & 63);
    rp[0] = a0; rp[64] = a1; rp[128] = a2; rp[192] = a3; rp[256] = a4; rp[320] = a5; rp[384] = a6; rp[448] = a7;
    __syncthreads();
    {
      const int b = tid >> 6, cc = tid & 63;
      float s = 0.f;
#pragma unroll
      for (int g = 0; g < 8; ++g) s += red[g * 512 + b * 64 + cc];
      mod[(size_t)(l * 8 + b) * 6144 + cb * 64 + cc] = s + p.ada_b[l * 6144 + cb * 64 + cc];
    }
    __syncthreads();
  }
}

template <bool HAS_Y, bool HAS_H>
DEV void rowpass(const float* __restrict__ xin, const bf16_t* __restrict__ yf, const float* __restrict__ gy, const float* __restrict__ gate,
                 float* __restrict__ xout, const float* __restrict__ gh, const float* __restrict__ sc, const float* __restrict__ sh,
                 bf16_t* __restrict__ h) {
  const int lane = tidx() & 63, gw = blockIdx.x * 8 + (tidx() >> 6), nw = gridDim.x * 8;
  for (int row = gw; row < MT; row += nw) {
    const int b = row >> 12;
    f32x4 xv[4];
#pragma unroll
    for (int i = 0; i < 4; ++i) xv[i] = *(const f32x4*)(xin + (size_t)row * 1024 + i * 256 + lane * 4);
    if (HAS_Y) {
      f32x4 yv[4];
      float ss = 0.f;
#pragma unroll
      for (int i = 0; i < 4; ++i) {
        const u32x2 yu = *(const u32x2*)(yf + (size_t)row * 1024 + i * 256 + lane * 4);
        yv[i] = (f32x4){lo16(yu.x), hi16(yu.x), lo16(yu.y), hi16(yu.y)};
        ss += yv[i][0] * yv[i][0] + yv[i][1] * yv[i][1] + yv[i][2] * yv[i][2] + yv[i][3] * yv[i][3];
      }
      ss = wave_sum(ss);
      const float rs = rsqrtf(ss * (1.f / 1024.f) + 1e-6f);
#pragma unroll
      for (int i = 0; i < 4; ++i) {
        const int col = i * 256 + lane * 4;
        const f32x4 g4 = *(const f32x4*)(gy + col), gt = *(const f32x4*)(gate + (size_t)b * 6144 + col);
        xv[i] = xv[i] + gt * (yv[i] * rs * g4);
        *(f32x4*)(xout + (size_t)row * 1024 + col) = xv[i];
      }
    }
    if (HAS_H) {
      float ss = 0.f;
#pragma unroll
      for (int i = 0; i < 4; ++i) ss += xv[i][0] * xv[i][0] + xv[i][1] * xv[i][1] + xv[i][2] * xv[i][2] + xv[i][3] * xv[i][3];
      ss = wave_sum(ss);
      const float rs = rsqrtf(ss * (1.f / 1024.f) + 1e-6f);
#pragma unroll
      for (int i = 0; i < 4; ++i) {
        const int col = i * 256 + lane * 4;
        const f32x4 g4 = *(const f32x4*)(gh + col), s4 = *(const f32x4*)(sc + (size_t)b * 6144 + col), h4 = *(const f32x4*)(sh + (size_t)b * 6144 + col);
        const f32x4 o = (xv[i] * rs * g4) * (s4 + 1.f) + h4;
        u32x2 pk;
        pk.x = pk2(o[0], o[1]); pk.y = pk2(o[2], o[3]);
        *(u32x2*)(h + (size_t)row * 1024 + col) = pk;
      }
    }
  }
}

DEV void unpack8(const u32x4 u, float (&f)[8]) {
  f[0] = lo16(u.x); f[1] = hi16(u.x); f[2] = lo16(u.y); f[3] = hi16(u.y); f[4] = lo16(u.z); f[5] = hi16(u.z); f[6] = lo16(u.w); f[7] = hi16(u.w);
}
DEV u32x4 pack8(const float (&f)[8]) {
  u32x4 u;
  u.x = pk2(f[0], f[1]); u.y = pk2(f[2], f[3]); u.z = pk2(f[4], f[5]); u.w = pk2(f[6], f[7]);
  return u;
}

DEV void prep1(const P& p) {
  const bf16_t* z = (const bf16_t*)(p.ws + O_Z);
  bf16_t* za = (bf16_t*)p.out;
  bf16_t* qr = (bf16_t*)(p.ws + O_QR);
  bf16_t* kr = (bf16_t*)(p.ws + O_KR);
  bf16_t* vt = (bf16_t*)(p.ws + O_VT);
  const float* rope = (const float*)(p.ws + W_ROPE);
  const int gt = blockIdx.x * NTHR + tidx(), ngt = gridDim.x * NTHR;
  for (int idx = gt; idx < MT * 256; idx += ngt) {
    const int tok = idx >> 8, c8 = (idx & 255) * 8, s = tok & 4095;
    const bf16_t* zp = z + (size_t)tok * INC + c8;
    float zc[8], zm[8], zn[8], o[8];
    unpack8(*(const u32x4*)zp, zc);
    if (s > 0) unpack8(*(const u32x4*)(zp - INC), zm); else { for (int i = 0; i < 8; ++i) zm[i] = 0.f; }
    if (s < 4095) unpack8(*(const u32x4*)(zp + INC), zn); else { for (int i = 0; i < 8; ++i) zn[i] = 0.f; }
    float w0[8], w1[8], w2[8];
    *(f32x4*)w0 = *(const f32x4*)(p.mix_conv + c8); *(f32x4*)(w0 + 4) = *(const f32x4*)(p.mix_conv + c8 + 4);
    *(f32x4*)w1 = *(const f32x4*)(p.mix_conv + 2048 + c8); *(f32x4*)(w1 + 4) = *(const f32x4*)(p.mix_conv + 2048 + c8 + 4);
    *(f32x4*)w2 = *(const f32x4*)(p.mix_conv + 4096 + c8); *(f32x4*)(w2 + 4) = *(const f32x4*)(p.mix_conv + 4096 + c8 + 4);
#pragma unroll
    for (int i = 0; i < 8; ++i) o[i] = zm[i] * w0[i] + zc[i] * w1[i] + zn[i] * w2[i];
    *(u32x4*)(za + (size_t)tok * 2048 + c8) = pack8(o);
  }
  for (int idx = gt; idx < MT * 64; idx += ngt) {
    const int e8 = idx & 3, which = (idx >> 2) & 1, h = (idx >> 3) & 7, tok = idx >> 6, s = tok & 4095;
    const bf16_t* src = z + (size_t)tok * INC + 2048 + which * 512 + h * 64 + e8 * 8;
    float x1[8], x2[8], o1[8], o2[8];
    unpack8(*(const u32x4*)src, x1);
    unpack8(*(const u32x4*)(src + 32), x2);
    const float* rp = rope + ((size_t)s * 32 + e8 * 8) * 2;
    const float scl = which ? 1.f : 0.125f;
#pragma unroll
    for (int i = 0; i < 8; ++i) {
      const float cv = rp[2 * i], sv = rp[2 * i + 1];
      o1[i] = (x1[i] * cv - x2[i] * sv) * scl;
      o2[i] = (x2[i] * cv + x1[i] * sv) * scl;
    }
    bf16_t* dst = (which ? kr : qr) + (size_t)tok * 512 + h * 64 + e8 * 8;
    *(u32x4*)dst = pack8(o1);
    *(u32x4*)(dst + 32) = pack8(o2);
  }
  {
    const int lane = tidx() & 63, gw = blockIdx.x * 8 + (tidx() >> 6), nw = gridDim.x * 8;
    for (int item = gw; item < 3 * 4096; item += nw) {
      const int br = item >> 12, rem = item & 4095, b = rem >> 9, h = (rem >> 6) & 7, nb = rem & 63;
      const int dsh = 2 * br;
      const int Mr = 4096 >> dsh;
      const int pp = nb * 64 + lane, rsd = pp / Mr, m = pp % Mr, s = (m << dsh) + rsd;
      const bf16_t* src = z + (size_t)(b * 4096 + s) * INC + 3072 + h * 64;
      bf16_t* dst = vt + ((size_t)((br * 8 + b) * 8 + h) * 64) * 4096 + pp;
#pragma unroll
      for (int c = 0; c < 8; ++c) {
        const u32x4 u = *(const u32x4*)(src + c * 8);
        dst[(size_t)(c * 8 + 0) * 4096] = (bf16_t)(u.x & 0xffff); dst[(size_t)(c * 8 + 1) * 4096] = (bf16_t)(u.x >> 16);
        dst[(size_t)(c * 8 + 2) * 4096] = (bf16_t)(u.y & 0xffff); dst[(size_t)(c * 8 + 3) * 4096] = (bf16_t)(u.y >> 16);
        dst[(size_t)(c * 8 + 4) * 4096] = (bf16_t)(u.z & 0xffff); dst[(size_t)(c * 8 + 5) * 4096] = (bf16_t)(u.z >> 16);
        dst[(size_t)(c * 8 + 6) * 4096] = (bf16_t)(u.w & 0xffff); dst[(size_t)(c * 8 + 7) * 4096] = (bf16_t)(u.w >> 16);
      }
    }
  }
}

DEV void attention(char* lds, const P& p) {
  const bf16_t* qr = (const bf16_t*)(p.ws + O_QR);
  const bf16_t* kr = (const bf16_t*)(p.ws + O_KR);
  const bf16_t* vt = (const bf16_t*)(p.ws + O_VT);
  float* num = (float*)(p.ws + O_NUM);
  float* md = (float*)(p.ws + O_MD);
  constexpr int UNIT_LDS = 24576 + 64 * 400;
  const int tid = tidx(), w = tid >> 6, lane = tid & 63, lr = lane & 15, lq = lane >> 4;
  const int uh = tid >> 8, lt = tid & 255, mt = w & 3;
  char* ul = lds + uh * UNIT_LDS;
  u32x4 pre[12];
  auto load_pair = [&](int pi) {
    const int unit = pi * 2 + uh;
    const int nb = unit & 63, h = (unit >> 6) & 7, b = (unit >> 9) & 7, br = unit >> 12;
    const int dsh = 2 * br, Mr = 4096 >> dsh;
    const int seg = (nb * 64) / Mr, segstart = seg * Mr, segend = segstart + Mr;
    const bool pv_ok = (nb * 64 - 64 >= segstart), nx_ok = (nb * 64 + 128 <= segend);
    const bf16_t* vbase = vt + ((size_t)((br * 8 + b) * 8 + h) * 64) * 4096;
#pragma unroll
    for (int j = 0; j < 6; ++j) {
      const int pc = lt + 256 * j, key = pc >> 3, ch = pc & 7, kb = key >> 6;
      int blk = nb + kb - 1;
      if ((kb == 0 && !pv_ok) || (kb == 2 && !nx_ok)) blk = nb;
      const int kp = blk * 64 + (key & 63);
      const int ktok = b * 4096 + (((kp - segstart) << dsh) + seg);
      pre[j] = *(const u32x4*)(kr + (size_t)ktok * 512 + h * 64 + ch * 8);
    }
#pragma unroll
    for (int j = 0; j < 6; ++j) {
      const int pc = lt + 256 * j, e = pc / 24, ch = pc - e * 24, kb = ch >> 3;
      int blk = nb + kb - 1;
      if ((kb == 0 && !pv_ok) || (kb == 2 && !nx_ok)) blk = nb;
      pre[6 + j] = *(const u32x4*)(vbase + (size_t)e * 4096 + blk * 64 + (ch & 7) * 8);
    }
  };
  const int npairs = 3 * 4096 / 2;
  int pi = blockIdx.x;
  if (pi < npairs) load_pair(pi);
  for (; pi < npairs; pi += gridDim.x) {
#pragma unroll
    for (int j = 0; j < 6; ++j) {
      const int pc = lt + 256 * j, key = pc >> 3, ch = pc & 7;
      *(u32x4*)(ul + key * 128 + ((ch ^ (key & 7)) * 16)) = pre[j];
    }
#pragma unroll
    for (int j = 0; j < 6; ++j) {
      const int pc = lt + 256 * j, e = pc / 24, ch = pc - e * 24;
      *(u32x4*)(ul + 24576 + e * 400 + ch * 16) = pre[6 + j];
    }
    __syncthreads();
    const int unit = pi * 2 + uh;
    const int nb = unit & 63, h = (unit >> 6) & 7, b = (unit >> 9) & 7, br = unit >> 12;
    const int dsh = 2 * br, Mr = 4096 >> dsh;
    const int seg = (nb * 64) / Mr, segstart = seg * Mr, segend = segstart + Mr;
    const bool pv_ok = (nb * 64 - 64 >= segstart), nx_ok = (nb * 64 + 128 <= segend);
    const int qp = nb * 64 + mt * 16 + lr;
    const int qtok = b * 4096 + (((qp - segstart) << dsh) + seg);
    bf16x8 qf[2];
    qf[0] = *(const bf16x8*)(qr + (size_t)qtok * 512 + h * 64 + lq * 8);
    qf[1] = *(const bf16x8*)(qr + (size_t)qtok * 512 + h * 64 + 32 + lq * 8);
    if (pi + (int)gridDim.x < npairs) load_pair(pi + gridDim.x);
    f32x4 sacc[12];
#pragma unroll
    for (int kt = 0; kt < 12; ++kt) {
      const int key = kt * 16 + lr;
      const bf16x8 k0 = *(const bf16x8*)(ul + key * 128 + ((lq ^ (key & 7)) * 16));
      const bf16x8 k1 = *(const bf16x8*)(ul + key * 128 + (((4 + lq) ^ (key & 7)) * 16));
      f32x4 a = (f32x4){0.f, 0.f, 0.f, 0.f};
      a = __builtin_amdgcn_mfma_f32_16x16x32_bf16(k0, qf[0], a, 0, 0, 0);
      a = __builtin_amdgcn_mfma_f32_16x16x32_bf16(k1, qf[1], a, 0, 0, 0);
      sacc[kt] = a;
    }
    const int qi = mt * 16 + lr;
    float mx = -1e30f;
#pragma unroll
    for (int kt = 0; kt < 12; ++kt) {
      const int kb = kt >> 2;
#pragma unroll
      for (int r = 0; r < 4; ++r) {
        const int kj = (kt & 3) * 16 + lq * 4 + r;
        bool ok = true;
        if (kb == 0) ok = pv_ok && (kj >= qi);
        if (kb == 2) ok = nx_ok && (kj <= qi);
        const float sv = ok ? sacc[kt][r] : -1e30f;
        sacc[kt][r] = sv;
        mx = fmaxf(mx, sv);
      }
    }
    mx = fmaxf(mx, __shfl_xor(mx, 16));
    mx = fmaxf(mx, __shfl_xor(mx, 32));
    float den = 0.f;
#pragma unroll
    for (int kt = 0; kt < 12; ++kt)
#pragma unroll
      for (int r = 0; r < 4; ++r) {
        const float pe = __expf(sacc[kt][r] - mx);
        sacc[kt][r] = pe;
        den += pe;
      }
    den += __shfl_xor(den, 16);
    den += __shfl_xor(den, 32);
    f32x4 oacc[4];
#pragma unroll
    for (int et = 0; et < 4; ++et) oacc[et] = (f32x4){0.f, 0.f, 0.f, 0.f};
#pragma unroll
    for (int t = 0; t < 6; ++t) {
      u32x4 pu;
      pu.x = pk2(sacc[2 * t][0], sacc[2 * t][1]); pu.y = pk2(sacc[2 * t][2], sacc[2 * t][3]);
      pu.z = pk2(sacc[2 * t + 1][0], sacc[2 * t + 1][1]); pu.w = pk2(sacc[2 * t + 1][2], sacc[2 * t + 1][3]);
      const bf16x8 pf = __builtin_bit_cast(bf16x8, pu);
#pragma unroll
      for (int et = 0; et < 4; ++et) {
        const char* vrow = ul + 24576 + (et * 16 + lr) * 400 + t * 64 + lq * 8;
        const u32x2 v0 = *(const u32x2*)vrow, v1 = *(const u32x2*)(vrow + 32);
        u32x4 vu;
        vu.x = v0.x; vu.y = v0.y; vu.z = v1.x; vu.w = v1.y;
        oacc[et] = __builtin_amdgcn_mfma_f32_16x16x32_bf16(__builtin_bit_cast(bf16x8, vu), pf, oacc[et], 0, 0, 0);
      }
    }
    float* np = num + ((size_t)br * MT + qtok) * 512 + h * 64 + lq * 4;
#pragma unroll
    for (int et = 0; et < 4; ++et) *(f32x4*)(np + et * 16) = oacc[et];
    if (lq == 0) {
      f32x2 o;
      o.x = mx; o.y = den;
      *(f32x2*)(md + (((size_t)br * MT + qtok) * 8 + h) * 2) = o;
    }
    __syncthreads();
  }
}

DEV void combineA(const P& p) {
  const float* num = (const float*)(p.ws + O_NUM);
  const float* md = (const float*)(p.ws + O_MD);
  bf16_t* ycat = (bf16_t*)(p.ws + O_YCAT);
  const int gt = blockIdx.x * NTHR + tidx(), ngt = gridDim.x * NTHR;
  for (int idx = gt; idx < MT * 128; idx += ngt) {
    const int e4 = idx & 15, h = (idx >> 4) & 7, tok = idx >> 7;
    f32x2 m0 = *(const f32x2*)(md + (((size_t)0 * MT + tok) * 8 + h) * 2);
    f32x2 m1 = *(const f32x2*)(md + (((size_t)1 * MT + tok) * 8 + h) * 2);
    f32x2 m2 = *(const f32x2*)(md + (((size_t)2 * MT + tok) * 8 + h) * 2);
    const float ma = fmaxf(m0.x, fmaxf(m1.x, m2.x));
    const float e0 = __expf(m0.x - ma), e1 = __expf(m1.x - ma), e2 = __expf(m2.x - ma);
    const float dn = e0 * m0.y + e1 * m1.y + e2 * m2.y;
    const f32x4 n0 = *(const f32x4*)(num + ((size_t)0 * MT + tok) * 512 + h * 64 + e4 * 4);
    const f32x4 n1 = *(const f32x4*)(num + ((size_t)1 * MT + tok) * 512 + h * 64 + e4 * 4);
    const f32x4 n2 = *(const f32x4*)(num + ((size_t)2 * MT + tok) * 512 + h * 64 + e4 * 4);
    const f32x4 o = (n0 * e0 + n1 * e1 + n2 * e2) * (1.f / dn);
    u32x2 pk;
    pk.x = pk2(o[0], o[1]); pk.y = pk2(o[2], o[3]);
    *(u32x2*)(ycat + (size_t)tok * 1024 + 512 + h * 64 + e4 * 4) = pk;
  }
}

DEV float dpp_allreduce16(float x) {
  x += __int_as_float(__builtin_amdgcn_update_dpp(0, __float_as_int(x), 0xB1, 0xF, 0xF, true));
  x += __int_as_float(__builtin_amdgcn_update_dpp(0, __float_as_int(x), 0x4E, 0xF, 0xF, true));
  x += __int_as_float(__builtin_amdgcn_update_dpp(0, __float_as_int(x), 0x141, 0xF, 0xF, true));
  x += __int_as_float(__builtin_amdgcn_update_dpp(0, __float_as_int(x), 0x140, 0xF, 0xF, true));
  return x;
}

DEV void scan_phase(char* lds, const P& p) {
  const bf16_t* omw = (const bf16_t*)(p.ws + O_OMW);
  const bf16_t* kd = (const bf16_t*)(p.ws + O_KD);
  const bf16_t* kka = (const bf16_t*)(p.ws + O_KKA);
  const bf16_t* kk = (const bf16_t*)(p.ws + O_KK);
  const bf16_t* za = (const bf16_t*)p.out;
  float* Y = (float*)(p.ws + O_Y);
  float* inb = (float*)lds;
  float* ypart = (float*)(lds + 98304);
  const int tid = tidx(), w = tid >> 6, lane = tid & 63, rg = lane >> 4, jl = lane & 15, j0 = jl * 4;
  for (int it = blockIdx.x; it < 256; it += gridDim.x) {
    const int sc = it >> 1, half = it & 1, d = sc >> 6, b = (sc >> 3) & 7, h = sc & 7;
    if (w >= 4) {
      const int lt = tid - 256;
      const bf16_t* src[6];
      int dsto[6], stepi[6], isw[6];
#pragma unroll
      for (int q = 0; q < 6; ++q) {
        const int pid = lt + q * 256, i = pid / 48, rem = pid % 48, arr = rem >> 3, pc = rem & 7;
        const bf16_t* base;
        size_t ld;
        if (arr == 0) { base = omw + (size_t)d * MT * 512 + h * 64; ld = 512; }
        else if (arr == 1) { base = kd + (size_t)d * MT * 512 + h * 64; ld = 512; }
        else if (arr == 2) { base = kka + (size_t)d * MT * 512 + h * 64; ld = 512; }
        else if (arr == 3) { base = kk + h * 64; ld = 512; }
        else if (arr == 4) { base = za + h * 64; ld = 2048; }
        else { base = za + 1024 + h * 64; ld = 2048; }
        const int t0 = d ? (4095 - i) : i;
        src[q] = base + ((size_t)(b * 4096 + t0)) * ld + pc * 8;
        stepi[q] = (int)ld * 32 * (d ? -1 : 1);
        dsto[q] = i * 384 + arr * 64 + pc * 8;
        isw[q] = (arr == 0);
      }
      u32x4 rr[6];
#pragma unroll
      for (int q = 0; q < 6; ++q) rr[q] = *(const u32x4*)(src[q]);
#pragma unroll
      for (int q = 0; q < 6; ++q) {
        float f[8];
        unpack8(rr[q], f);
        if (isw[q]) { for (int i = 0; i < 8; ++i) f[i] = 1.f - f[i]; }
        *(f32x4*)(inb + dsto[q]) = (f32x4){f[0], f[1], f[2], f[3]};
        *(f32x4*)(inb + dsto[q] + 4) = (f32x4){f[4], f[5], f[6], f[7]};
      }
#pragma unroll
      for (int q = 0; q < 6; ++q) rr[q] = *(const u32x4*)(src[q] + (ptrdiff_t)stepi[q]);
      __syncthreads();
      for (int c = 0; c < 128; ++c) {
        if (c + 1 < 128) {
          float* nb_ = inb + ((c + 1) & 1) * 12288;
#pragma unroll
          for (int q = 0; q < 6; ++q) {
            float f[8];
            unpack8(rr[q], f);
            if (isw[q]) { for (int i = 0; i < 8; ++i) f[i] = 1.f - f[i]; }
            *(f32x4*)(nb_ + dsto[q]) = (f32x4){f[0], f[1], f[2], f[3]};
            *(f32x4*)(nb_ + dsto[q] + 4) = (f32x4){f[4], f[5], f[6], f[7]};
          }
        }
        if (c + 2 < 128) {
#pragma unroll
          for (int q = 0; q < 6; ++q) rr[q] = *(const u32x4*)(src[q] + (ptrdiff_t)stepi[q] * (c + 2));
        }
        if (c > 0) {
          const int cc = c - 1, idx = lt * 4, i = idx >> 5, rl = idx & 31;
          const int t = d ? (4095 - (cc * 32 + i)) : (cc * 32 + i);
          const float* q = ypart + (cc & 1) * 4096 + i * 128 + rl;
          const f32x4 o = (*(const f32x4*)q + *(const f32x4*)(q + 32)) + (*(const f32x4*)(q + 64) + *(const f32x4*)(q + 96));
          *(f32x4*)(Y + ((size_t)d * MT + b * 4096 + t) * 512 + h * 64 + half * 32 + rl) = o;
        }
        __syncthreads();
      }
      {
        const int cc = 127, idx = lt * 4, i = idx >> 5, rl = idx & 31;
        const int t = d ? (4095 - (cc * 32 + i)) : (cc * 32 + i);
        const float* q = ypart + (cc & 1) * 4096 + i * 128 + rl;
        const f32x4 o = (*(const f32x4*)q + *(const f32x4*)(q + 32)) + (*(const f32x4*)(q + 64) + *(const f32x4*)(q + 96));
        *(f32x4*)(Y + ((size_t)d * MT + b * 4096 + t) * 512 + h * 64 + half * 32 + rl) = o;
      }
    } else {
      const int rowl = w * 8 + rg * 2, row = half * 32 + rowl;
      f32x2 a01 = (f32x2){0.f, 0.f}, a23 = a01, b01 = a01, b23 = a01;
      __syncthreads();
      for (int c = 0; c < 128; ++c) {
        const float* cur = inb + (c & 1) * 12288;
        float* yp = ypart + (c & 1) * 4096 + (jl >> 2) * 32 + rowl;
        f32x4 w4 = *(const f32x4*)(cur + j0), kd4 = *(const f32x4*)(cur + 64 + j0), ka4 = *(const f32x4*)(cur + 128 + j0),
              kk4 = *(const f32x4*)(cur + 192 + j0), r4 = *(const f32x4*)(cur + 256 + j0);
        f32x2 v2 = *(const f32x2*)(cur + 320 + row);
#pragma unroll 8
        for (int i = 0; i < 32; ++i) {
          const float* sn = cur + ((i + 1) & 31) * 384;
          const f32x4 nw4 = *(const f32x4*)(sn + j0), nkd4 = *(const f32x4*)(sn + 64 + j0), nka4 = *(const f32x4*)(sn + 128 + j0),
                      nkk4 = *(const f32x4*)(sn + 192 + j0), nr4 = *(const f32x4*)(sn + 256 + j0);
          const f32x2 nv2 = *(const f32x2*)(sn + 320 + row);
          const f32x2 ta = a01 * kk4.xy + a23 * kk4.zw, tb = b01 * kk4.xy + b23 * kk4.zw;
          const float ska = dpp_allreduce16(ta.x + ta.y), skb = dpp_allreduce16(tb.x + tb.y);
          a01 = a01 * w4.xy + (kd4.xy * v2.x - ka4.xy * ska);
          a23 = a23 * w4.zw + (kd4.zw * v2.x - ka4.zw * ska);
          b01 = b01 * w4.xy + (kd4.xy * v2.y - ka4.xy * skb);
          b23 = b23 * w4.zw + (kd4.zw * v2.y - ka4.zw * skb);
          const f32x2 ua = a01 * r4.xy + a23 * r4.zw, ub = b01 * r4.xy + b23 * r4.zw;
          f32x2 y;
          y.x = ua.x + ua.y; y.y = ub.x + ub.y;
          y.x += __int_as_float(__builtin_amdgcn_update_dpp(0, __float_as_int(y.x), 0xB1, 0xF, 0xF, true));
          y.y += __int_as_float(__builtin_amdgcn_update_dpp(0, __float_as_int(y.y), 0xB1, 0xF, 0xF, true));
          y.x += __int_as_float(__builtin_amdgcn_update_dpp(0, __float_as_int(y.x), 0x4E, 0xF, 0xF, true));
          y.y += __int_as_float(__builtin_amdgcn_update_dpp(0, __float_as_int(y.y), 0x4E, 0xF, 0xF, true));
          *(f32x2*)(yp + i * 128) = y;
          w4 = nw4; kd4 = nkd4; ka4 = nka4; kk4 = nkk4; r4 = nr4; v2 = nv2;
        }
        __syncthreads();
      }
    }
    __syncthreads();
  }
}

DEV void postB(const P& p) {
  const float* Y = (const float*)(p.ws + O_Y);
  const bf16_t* kd = (const bf16_t*)(p.ws + O_KD);
  const bf16_t* gg = (const bf16_t*)(p.ws + O_G);
  const bf16_t* za = (const bf16_t*)p.out;
  bf16_t* ycat = (bf16_t*)(p.ws + O_YCAT);
  const int lane = tidx() & 63, sub = lane >> 4, jl = lane & 15, gw = blockIdx.x * 8 + (tidx() >> 6), nw = gridDim.x * 8;
  for (int it = gw; it < MT * 2; it += nw) {
    const int item = it * 4 + sub, tok = item >> 3, h = item & 7, c = h * 64 + jl * 4;
    const f32x4 y0 = *(const f32x4*)(Y + (size_t)tok * 512 + c), y1 = *(const f32x4*)(Y + ((size_t)MT + tok) * 512 + c);
    const u32x2 k0 = *(const u32x2*)(kd + (size_t)tok * 512 + c), k1 = *(const u32x2*)(kd + ((size_t)MT + tok) * 512 + c);
    const u32x2 ru = *(const u32x2*)(za + (size_t)tok * 2048 + c), vu = *(const u32x2*)(za + (size_t)tok * 2048 + 1024 + c), gu = *(const u32x2*)(gg + (size_t)tok * 512 + c);
    const f32x4 lw = *(const f32x4*)(p.lnx_w + c), lb = *(const f32x4*)(p.lnx_b + c), rk = *(const f32x4*)(p.r_k + c);
    const f32x4 y = y0 + y1;
    const float mu = dpp_allreduce16((y[0] + y[1]) + (y[2] + y[3])) * (1.f / 64.f);
    const f32x4 dv = y - mu;
    const float var = dpp_allreduce16((dv[0] * dv[0] + dv[1] * dv[1]) + (dv[2] * dv[2] + dv[3] * dv[3])) * (1.f / 64.f);
    const float rs = rsqrtf(var + 64e-5f);
    const f32x4 r = (f32x4){lo16(ru.x), hi16(ru.x), lo16(ru.y), hi16(ru.y)}, v = (f32x4){lo16(vu.x), hi16(vu.x), lo16(vu.y), hi16(vu.y)};
    const f32x4 g = (f32x4){lo16(gu.x), hi16(gu.x), lo16(gu.y), hi16(gu.y)};
    const f32x4 kds = (f32x4){lo16(k0.x) + lo16(k1.x), hi16(k0.x) + hi16(k1.x), lo16(k0.y) + lo16(k1.y), hi16(k0.y) + hi16(k1.y)};
    const f32x4 t = r * kds * rk;
    const float bs = dpp_allreduce16((t[0] + t[1]) + (t[2] + t[3]));
    const f32x4 o = (dv * rs * lw + lb + v * bs) * g;
    u32x2 pk;
    pk.x = pk2(o[0], o[1]); pk.y = pk2(o[2], o[3]);
    *(u32x2*)(ycat + (size_t)tok * 1024 + c) = pk;
  }
}

DEV void glu_fixup(const P& p, int l) {
  const bf16_t* sb = (const bf16_t*)(p.ws + O_SB);
  bf16_t* act = (bf16_t*)(p.ws + O_ACT);
  const float* cw = p.ffn_conv + (size_t)l * 3 * 5632;
  const int gt = blockIdx.x * NTHR + tidx(), ngt = gridDim.x * NTHR;
  for (int item = gt; item < 512 * 2 * 352; item += ngt) {
    const int strip = item / 704, rem = item - strip * 704, e = rem / 352, c8 = (rem - e * 352) * 8;
    const int R = strip * 64 + (e ? 63 : 0), s = R & 4095;
    const int colg = (c8 >> 7) * 256 + (c8 & 127);
    const bf16_t* pc = sb + ((size_t)strip * 4 + (e ? 3 : 0)) * 5632 + colg;
    const bf16_t* pp = e ? (pc - 5632) : (pc - 5632);
    const bf16_t* pn = e ? (pc + 5632) : (pc + 5632);
    const u32x4 z0 = (u32x4){0u, 0u, 0u, 0u};
    const bool hasp = e ? true : (s > 0), hasn = e ? (s < 4095) : true;
    float gm[8], gc[8], gn[8], vm[8], vc[8], vn[8], o[8];
    unpack8(hasp ? *(const u32x4*)pp : z0, gm); unpack8(hasp ? *(const u32x4*)(pp + 128) : z0, vm);
    unpack8(*(const u32x4*)pc, gc); unpack8(*(const u32x4*)(pc + 128), vc);
    unpack8(hasn ? *(const u32x4*)pn : z0, gn); unpack8(hasn ? *(const u32x4*)(pn + 128) : z0, vn);
#pragma unroll
    for (int i = 0; i < 8; ++i) {
      const float g = gm[i] * cw[c8 + i] + gc[i] * cw[5632 + c8 + i] + gn[i] * cw[11264 + c8 + i];
      const float vv = vm[i] * cw[2816 + c8 + i] + vc[i] * cw[5632 + 2816 + c8 + i] + vn[i] * cw[11264 + 2816 + c8 + i];
      const float u2 = -1.5957691216057308f * (g + 0.044715f * g * g * g);
      o[i] = g * __builtin_amdgcn_rcpf(1.f + __expf(u2)) * vv;
    }
    *(u32x4*)(act + (size_t)R * 2816 + c8) = pack8(o);
  }
}

template <class Epi>
DEV void gemm_grid(char* lds, const bf16_t* A, int lda, const bf16_t* Bt, int ldb, int K, int tilesM, int tilesN, const Epi& epi) {
  const int nt = tilesM * tilesN;
  for (int t = blockIdx.x; t < nt; t += gridDim.x) {
    const int tm = t / tilesN, tn = t % tilesN;
    gemm_tile(lds, A + (size_t)tm * 256 * lda, lda, Bt + (size_t)tn * 128 * ldb, ldb, K, tm * 256, tn * 128, epi);
  }
}


DEV void dft_fold(const P& p) {
  const bf16_t* CST = (const bf16_t*)(p.ws + O_CST);
  bf16_t* CF = (bf16_t*)(p.ws + O_CSTF);
  for (int idx = blockIdx.x * NTHR + tidx(); idx < 16384 * 256; idx += gridDim.x * NTHR) {
    const int r = idx >> 8, s8 = (idx & 255) * 8, eo = (r >> 10) & 1;
    const bf16_t* src = CST + (size_t)r * 4096;
    float a[8], bq[8], o[8];
    unpack8(*(const u32x4*)(src + s8), a);
    if (s8 == 0) {
      unpack8(*(const u32x4*)(src + 4088), bq);
      o[0] = eo ? 0.f : a[0];
#pragma unroll
      for (int i = 1; i < 8; ++i) o[i] = eo ? (a[i] - bq[8 - i]) : (a[i] + bq[8 - i]);
      if (!eo) ((float*)(p.ws + O_C2048))[(r >> 11) * 1024 + (r & 1023)] = bf2f(src[2048]) * (1.f / 64.f);
    } else {
      unpack8(*(const u32x4*)(src + 4096 - s8 - 8), bq);
      const float b0 = bf2f(src[4096 - s8]);
      o[0] = eo ? (a[0] - b0) : (a[0] + b0);
#pragma unroll
      for (int i = 1; i < 8; ++i) o[i] = eo ? (a[i] - bq[8 - i]) : (a[i] + bq[8 - i]);
    }
    *(u32x4*)(CF + (size_t)r * 2048 + s8) = pack8(o);
  }
}

DEV void dft_combine(const P& p) {
  const float* EO = (const float*)(p.ws + O_EO);
  const bf16_t* CST = (const bf16_t*)(p.ws + O_CST);
  bf16_t* f = (bf16_t*)(p.ws + O_F);
  for (int idx = blockIdx.x * NTHR + tidx(); idx < 8 * 2048 * 256; idx += gridDim.x * NTHR) {
    const int c4 = (idx & 255) * 4, k1 = (idx >> 8) & 2047, b = idx >> 19;
    f32x4 e = *(const f32x4*)(EO + ((size_t)(b * 2) * 2048 + k1) * 1024 + c4);
    const f32x4 o = *(const f32x4*)(EO + ((size_t)(b * 2 + 1) * 2048 + k1) * 1024 + c4);
    {
      const f32x4 cm = *(const f32x4*)((const float*)(p.ws + O_C2048) + b * 1024 + c4);
      e = (k1 & 1) ? (e - cm) : (e + cm);
    }
    const f32x4 d = e - o, s = e + o;
    u32x2 pk;
    pk.x = pk2(d[0], d[1]); pk.y = pk2(d[2], d[3]);
    *(u32x2*)(f + ((size_t)b * 4096 + k1) * 1024 + c4) = pk;
    if (k1 > 0) {
      pk.x = pk2(s[0], s[1]); pk.y = pk2(s[2], s[3]);
      *(u32x2*)(f + ((size_t)b * 4096 + 4096 - k1) * 1024 + c4) = pk;
    }
  }
  {
    const int lane = tidx() & 63, gw = blockIdx.x * 8 + (tidx() >> 6), nw = gridDim.x * 8;
    for (int r = gw; r < 8 * 1024; r += nw) {
      const int b = r >> 10, n = r & 1023;
      const bf16_t* cp = CST + ((size_t)(b * 2) * 1024 + n) * 4096;
      float acc = 0.f;
#pragma unroll
      for (int j = 0; j < 8; ++j) {
        const u32x4 u = *(const u32x4*)(cp + j * 512 + lane * 8);
        acc += (lo16(u.x) - hi16(u.x)) + (lo16(u.y) - hi16(u.y)) + (lo16(u.z) - hi16(u.z)) + (lo16(u.w) - hi16(u.w));
      }
      acc = wave_sum(acc);
      if (lane == 0) f[((size_t)b * 4096 + 2048) * 1024 + n] = f2bf(acc * (1.f / 64.f));
    }
  }
}

#define LDSP ((PG8_LAS unsigned char*)lds)
template <class Epi>
DEV void pgemm(char* lds, const bf16_t* A, const bf16_t* Bt, int M_, int N_, int K_, const Epi& E) {
  pg8::Gemm g{A, Bt, M_, N_, K_};
  pg8::StaticOrder S;
  S.init(M_, N_, (int)gridDim.x, (int)blockIdx.x);
  pg8::gemm_phase<Epi, pg8::StaticOrder, true, true>(LDSP, g, S, E);
}

DEV void ffn(char* lds, const XcdBarrier& xbar, const P& p, int l) {
  const bf16_t* h = (const bf16_t*)(p.ws + O_H);
  bf16_t* act = (bf16_t*)(p.ws + O_ACT);
  bf16_t* yf = (bf16_t*)(p.ws + O_YF);
  const bf16_t* upt = (const bf16_t*)(p.ws + W_UP) + (size_t)l * 5632 * 1024;
  const bf16_t* dnt = (const bf16_t*)(p.ws + W_DOWN) + (size_t)l * 1024 * 2816;
  pgemm(lds, h, upt, MT, 5632, 1024, pg8::PEpiGlu{act, (bf16_t*)(p.ws + O_SB), p.ffn_conv + (size_t)l * 3 * 5632});
  xcd_barrier(xbar);
  glu_fixup(p, l);
  xcd_barrier(xbar);
  pgemm(lds, act, dnt, MT, 1024, 2816, pg8::PEpiBf16<false>{yf, 1024});
  xcd_barrier(xbar);
}

DEV const P& kargs() {
  auto q = __builtin_amdgcn_kernarg_segment_ptr();
  asm volatile("" : "+s"(q));
  return *(const P*)q;
}
#define p (kargs())
__global__ void __launch_bounds__(NTHR) mega(P parg_unused) {
  extern __shared__ __attribute__((aligned(16))) char lds[];
  cg::grid_group grid = cg::this_grid();
  char* ws = p.ws;
  if (tidx() < 4) ((unsigned*)(lds + 131072))[tidx()] = 0u;
  __syncthreads();
  const XcdBarrier xbar = xcd_barrier_post((unsigned*)(ws + W_BAR), (volatile XLAS unsigned*)(lds + 131072));
  float* mod = (float*)(ws + W_MOD);
  const int gt = blockIdx.x * NTHR + tidx(), ngt = gridDim.x * NTHR;

  for (int rep_ = 0; rep_ < REP_PRO; ++rep_) {
  if (rep_ > 0) xcd_barrier(xbar);
  compute_mod(lds, p);
  transpose_convert(lds, p.mix_in, 1024, 3584, (bf16_t*)(ws + W_MIXIN), 1024, 0);
  for (int l = 0; l < 2; ++l) {
    transpose_convert(lds, p.ffn_up + (size_t)l * 1024 * 5632, 1024, 5632, (bf16_t*)(ws + W_UP) + (size_t)l * 5632 * 1024, 1024, 64 * l, true);
    transpose_convert(lds, p.ffn_down + (size_t)l * 2816 * 1024, 2816, 1024, (bf16_t*)(ws + W_DOWN) + (size_t)l * 1024 * 2816, 2816, 128 + 64 * l);
  }
  transpose_convert(lds, p.mix_out, 1024, 1024, (bf16_t*)(ws + W_MIXOUT), 1024, 32);
  transpose_convert(lds, p.fnet_w, 1024, 1024, (bf16_t*)(ws + W_FNET), 1024, 96);
  for (int d = 0; d < 2; ++d) {
    transpose_convert(lds, p.w1 + (size_t)d * 512 * 64, 512, 64, (bf16_t*)(ws + W_L1) + (size_t)(d * 64) * 512, 512, 8 * d);
    transpose_convert(lds, p.a1 + (size_t)d * 512 * 64, 512, 64, (bf16_t*)(ws + W_L1) + (size_t)(128 + d * 64) * 512, 512, 16 + 8 * d);
    transpose_convert(lds, p.w2 + (size_t)d * 64 * 512, 64, 512, (bf16_t*)(ws + W_W2) + (size_t)d * 512 * 64, 64, 48 + 8 * d);
    transpose_convert(lds, p.a2 + (size_t)d * 64 * 512, 64, 512, (bf16_t*)(ws + W_A2) + (size_t)d * 512 * 64, 64, 64 + 8 * d);
  }
  transpose_convert(lds, p.g1, 512, 128, (bf16_t*)(ws + W_L1) + (size_t)256 * 512, 512, 32);
  transpose_convert(lds, p.g2, 128, 512, (bf16_t*)(ws + W_G2), 128, 80);
  {
    float* rope = (float*)(ws + W_ROPE);
    for (int idx = gt; idx < 4096 * 32; idx += ngt) {
      const int s = idx >> 5, e = idx & 31;
      const float inv = powf(10000.f, -(float)e / 32.f);
      const float ang = (float)s * inv;
      float sv, cv;
      sincosf(ang, &sv, &cv);
      rope[2 * idx] = cv;
      rope[2 * idx + 1] = sv;
    }
    bf16_t* dftc = (bf16_t*)(ws + W_DFTC);
    for (int idx = gt; idx < 256 * 128; idx += ngt) {
      const int n = idx >> 7, c = idx & 127, k2 = n & 127;
      const float ph = (float)((k2 * c) & 127) * (1.f / 64.f);
      const float v = (n < 128) ? cospif(ph) : sinpif(ph);
      dftc[idx] = f2bf(v * 0.08838834764831845f);
    }
  }
  }
  grid.sync();
  for (int rep_ = 0; rep_ < REP_ROW; ++rep_) { rowpass<false, true>(p.x, nullptr, nullptr, nullptr, nullptr, p.norm_g, mod + 1024, mod, (bf16_t*)(ws + O_H0)); xcd_barrier(xbar); }
  pgemm(lds, (const bf16_t*)(ws + O_H0), (const bf16_t*)(ws + W_MIXIN), MT, INC, 1024, pg8::PEpiBf16<false>{(bf16_t*)(ws + O_Z), INC});
  xcd_barrier(xbar);
  for (int rep_ = 0; rep_ < REP_PREP; ++rep_) { prep1(p); xcd_barrier(xbar); }
  for (int rep_ = 0; rep_ < REP_ATT; ++rep_) { attention(lds, p); xcd_barrier(xbar); }
  combineA(p);
  gemm_grid(lds, (const bf16_t*)p.out + 1536, 2048, (const bf16_t*)(ws + W_L1), 512, 512, 128, 3, EpiLora1{(bf16_t*)(ws + O_L1)});
  xcd_barrier(xbar);
  for (int rep_ = 0; rep_ < REP_LORA; ++rep_) {
  for (int d = 0; d < 2; ++d) {
    gemm_grid(lds, (const bf16_t*)(ws + O_L1) + d * 64, 384, (const bf16_t*)(ws + W_W2) + (size_t)d * 512 * 64, 64, 64, 128, 4,
              EpiDecay{(bf16_t*)(ws + O_OMW) + (size_t)d * MT * 512, p.w0 + d * 512});
    gemm_grid(lds, (const bf16_t*)(ws + O_L1) + 128 + d * 64, 384, (const bf16_t*)(ws + W_A2) + (size_t)d * 512 * 64, 64, 64, 128, 4,
              EpiA{(bf16_t*)(ws + O_KD) + (size_t)d * MT * 512, (bf16_t*)(ws + O_KKA) + (size_t)d * MT * 512, (bf16_t*)(ws + O_KK), p.a0 + d * 512,
                   p.k_k, p.k_a, (const bf16_t*)p.out, d == 0});
  }
  gemm_grid(lds, (const bf16_t*)(ws + O_L1) + 256, 384, (const bf16_t*)(ws + W_G2), 128, 128, 128, 4, EpiBf16{(bf16_t*)(ws + O_G), 512});
  xcd_barrier(xbar);
  }
  for (int rep_ = 0; rep_ < REP_SCAN; ++rep_) { scan_phase(lds, p); xcd_barrier(xbar); }
  for (int rep_ = 0; rep_ < REP_SYNC; ++rep_) xcd_barrier(xbar);
  postB(p);
  xcd_barrier(xbar);
  pgemm(lds, (const bf16_t*)(ws + O_YCAT), (const bf16_t*)(ws + W_MIXOUT), MT, 1024, 1024, pg8::PEpiBf16<false>{(bf16_t*)(ws + O_YF), 1024});
  xcd_barrier(xbar);
  rowpass<true, true>(p.x, (const bf16_t*)(ws + O_YF), p.norm_g + 1024, mod + 2048, p.out, p.norm_g + 2048, mod + 4096, mod + 3072, (bf16_t*)(ws + O_H));
  xcd_barrier(xbar);
  ffn(lds, xbar, p, 0);
  {
    const float* mod1 = mod + 8 * 6144;
    rowpass<true, true>(p.out, (const bf16_t*)(ws + O_YF), p.norm_g + 3072, mod + 5120, p.out, p.norm_g + 4096, mod1 + 1024, mod1, (bf16_t*)(ws + O_H));
    bf16_t* cs = (bf16_t*)(ws + O_COSSIN);
    for (int idx = blockIdx.x * NTHR + tidx(); idx < 4096 * 256; idx += gridDim.x * NTHR) {
      const int rr = idx >> 8, s8 = (idx & 255) * 8, k1 = rr & 2047;
      float o[8];
#pragma unroll
      for (int i = 0; i < 8; ++i) {
        const float ph = (float)((k1 * (s8 + i)) & 4095) * (1.f / 2048.f);
        o[i] = ((rr < 2048) ? cospif(ph) : sinpif(ph)) * (1.f / 64.f);
      }
      *(u32x4*)(cs + (size_t)rr * 2048 + s8) = pack8(o);
    }
    xcd_barrier(xbar);
    for (int t = blockIdx.x; t < 8 * 256; t += gridDim.x) {
      const int g = t >> 8, tn = t & 255;
      gemm_tile(lds, (const bf16_t*)(ws + W_DFTC), 128, (const bf16_t*)(ws + O_H) + (size_t)tn * 128 * 1024 + g * 128, 1024, 128, 0, tn * 128,
                EpiDftc{(bf16_t*)(ws + O_CST), g});
    }
    xcd_barrier(xbar);
    dft_fold(p);
    xcd_barrier(xbar);
    {
      pg8::Gemm g{(const bf16_t*)(ws + O_COSSIN), (const bf16_t*)(ws + O_CSTF), 4096, 16384, 2048};
      pg8::BatchOrder S{(int)gridDim.x, (int)blockIdx.x};
      pg8::gemm_phase<pg8::PEpiF32B, pg8::BatchOrder, true, true>(LDSP, g, S, pg8::PEpiF32B{(float*)(ws + O_EO)});
    }
    xcd_barrier(xbar);
    dft_combine(p);
    xcd_barrier(xbar);
    pgemm(lds, (const bf16_t*)(ws + O_F), (const bf16_t*)(ws + W_FNET), MT, 1024, 1024, pg8::PEpiBf16<false>{(bf16_t*)(ws + O_YF), 1024});
    xcd_barrier(xbar);
    rowpass<true, true>(p.out, (const bf16_t*)(ws + O_YF), p.norm_g + 4096 + 1024, mod1 + 2048, p.out, p.norm_g + 4096 + 2048, mod1 + 4096, mod1 + 3072,
                        (bf16_t*)(ws + O_H));
    xcd_barrier(xbar);
    ffn(lds, xbar, p, 1);
    rowpass<true, false>(p.out, (const bf16_t*)(ws + O_YF), p.norm_g + 4096 + 3072, mod1 + 5120, p.out, nullptr, nullptr, nullptr, nullptr);
  }
}

#undef p
extern "C" void kernel_launch(void* const* d_in, const int* in_sizes, int n_in, void* d_out, int out_size, void* d_ws, size_t ws_size,
                              hipStream_t stream) {
  static int grid_blocks = 0;
  if (!grid_blocks) {
    int dev = 0, cus = 0, per_cu = 0;
    hipGetDevice(&dev);
    hipDeviceGetAttribute(&cus, hipDeviceAttributeMultiprocessorCount, dev);
    hipFuncSetAttribute((const void*)mega, hipFuncAttributeMaxDynamicSharedMemorySize, LDS_BYTES);
    hipOccupancyMaxActiveBlocksPerMultiprocessor(&per_cu, (const void*)mega, NTHR, LDS_BYTES);
    if (per_cu < 1) { fprintf(stderr, "occupancy query returned %d\n", per_cu); per_cu = 1; }
    if (per_cu > 1) per_cu = 1;
    grid_blocks = cus * per_cu;
  }
  P p{};
  const float** pp = (const float**)&p;
  for (int i = 0; i < 25; ++i) pp[i] = (const float*)d_in[i];
  p.out = (float*)d_out;
  p.ws = (char*)d_ws;
  (void)hipMemsetAsync((char*)d_ws + W_BAR, 0, XCD_BAR_WORDS * sizeof(unsigned), stream);
  void* args[] = {&p};
  hipError_t e = hipLaunchCooperativeKernel((const void*)mega, dim3(grid_blocks), dim3(NTHR), args, LDS_BYTES, stream);
  if (e != hipSuccess) fprintf(stderr, "cooperative launch failed: %s (grid %d)\n", hipGetErrorString(e), grid_blocks);
}
```

```cpp
#include <hip/hip_runtime.h>
#include <hip/hip_cooperative_groups.h>
#include <stdint.h>
#include <cstdio>
namespace cg = cooperative_groups;

typedef unsigned short bf16_t;
typedef short bf16x8 __attribute__((ext_vector_type(8)));
typedef short s16x4 __attribute__((ext_vector_type(4)));
typedef float f32x4 __attribute__((ext_vector_type(4)));
typedef float f32x2 __attribute__((ext_vector_type(2)));
typedef unsigned u32x4 __attribute__((ext_vector_type(4)));
typedef unsigned u32x2 __attribute__((ext_vector_type(2)));

#define DEV __device__ __forceinline__
__device__ __forceinline__ int tidx() { int t = threadIdx.x; asm volatile("" : "+v"(t)); return t; }

constexpr int NB = 8, SEQ = 4096, DM = 1024, MT = NB * SEQ, DFF = 2816, INC = 3584;
constexpr size_t MiB = 1024 * 1024;
constexpr int NTHR = 512;
constexpr int LDS_BYTES = 131072 + 16;
constexpr size_t W_BAR = 47 * 1024 * 1024;
#ifndef REP_SCAN
#define REP_SCAN 1
#endif
#ifndef REP_ATT
#define REP_ATT 1
#endif
#ifndef REP_SYNC
#define REP_SYNC 0
#endif
#ifndef REP_PREP
#define REP_PREP 1
#endif
#ifndef REP_LORA
#define REP_LORA 1
#endif
#ifndef REP_GLU
#define REP_GLU 1
#endif
#ifndef REP_PRO
#define REP_PRO 1
#endif
#ifndef REP_ROW
#define REP_ROW 1
#endif

constexpr size_t W_MIXIN = 0;
constexpr size_t W_UP = 7 * MiB;
constexpr size_t W_DOWN = 29 * MiB;
constexpr size_t W_MIXOUT = 40 * MiB;
constexpr size_t W_FNET = 42 * MiB;
constexpr size_t W_L1 = 44 * MiB;
constexpr size_t W_W2 = W_L1 + 512 * 1024;
constexpr size_t W_A2 = W_W2 + 128 * 1024;
constexpr size_t W_G2 = W_A2 + 128 * 1024;
constexpr size_t W_DFTC = W_G2 + 128 * 1024;
constexpr size_t W_MOD = 45 * MiB;
constexpr size_t W_ROPE = 46 * MiB;
constexpr size_t R0 = 48 * MiB;
constexpr size_t O_H0 = R0;
constexpr size_t O_Z = 112 * MiB;
constexpr size_t O_QR = 336 * MiB, O_KR = 368 * MiB, O_VT = 400 * MiB;
constexpr size_t O_NUM = R0;
constexpr size_t O_MD = 240 * MiB;
constexpr size_t O_YCAT = 448 * MiB;
constexpr size_t O_OMW = 48 * MiB, O_KD = 112 * MiB, O_KKA = 176 * MiB, O_KK = 240 * MiB, O_G = 272 * MiB, O_L1 = 304 * MiB, O_Y = 304 * MiB;
constexpr size_t O_YF = 48 * MiB;
constexpr size_t O_H = 176 * MiB;
constexpr size_t O_ZF = 240 * MiB;
constexpr size_t O_ACT = 240 * MiB;
constexpr size_t O_SB = 416 * MiB;
constexpr size_t O_COSSIN = 240 * MiB;
constexpr size_t O_CST = 304 * MiB;
constexpr size_t O_F = 432 * MiB;
constexpr size_t O_CSTF = 432 * MiB;
constexpr size_t O_C2048 = 272 * MiB;
constexpr size_t O_EO = 48 * MiB;
constexpr size_t O_XB = 112 * MiB;

struct P {
  const float *x, *c, *ada_w, *ada_b, *norm_g, *mix_in, *mix_conv, *w0, *w1, *w2, *a0, *a1, *a2, *g1, *g2, *k_k, *k_a, *r_k, *lnx_w,
      *lnx_b, *mix_out, *fnet_w, *ffn_up, *ffn_conv, *ffn_down;
  float* out;
  char* ws;
};

DEV float bf2f(bf16_t h) { return __uint_as_float(((unsigned)h) << 16); }
DEV bf16_t f2bf(float f) {
  unsigned u = __float_as_uint(f);
  u += 0x7fffu + ((u >> 16) & 1u);
  return (bf16_t)(u >> 16);
}
DEV unsigned pk2(float a, float b) { return (unsigned)f2bf(a) | ((unsigned)f2bf(b) << 16); }
DEV float lo16(unsigned u) { return __uint_as_float(u << 16); }
DEV float hi16(unsigned u) { return __uint_as_float(u & 0xffff0000u); }
DEV float wave_sum(float v) {
#pragma unroll
  for (int o = 32; o; o >>= 1) v += __shfl_xor(v, o);
  return v;
}
DEV float sigmoidf_(float x) { return __builtin_amdgcn_rcpf(1.f + __expf(-x)); }

#include <cstdint>
#include <cstdlib>
#include <vector>

#define XB_TMO      128
#define XB_XCNT(j)  (256  + 64 * (j))
#define XB_XSUB(j)  (1280 + 64 * (j))
#define XB_XGEN(j)  (2304 + 64 * (j))
#define XB_TOP      3328
#define XB_TOPGEN   3392
#define XCD_BAR_WORDS 3456
#define XB_SPIN_CAP (1u << 18)
#define XLAS __attribute__((address_space(3)))

__device__ __forceinline__ unsigned xb_ld(unsigned* p)              { return __hip_atomic_load(p, __ATOMIC_RELAXED, __HIP_MEMORY_SCOPE_AGENT); }
__device__ __forceinline__ unsigned xb_add(unsigned* p, unsigned v) { return __hip_atomic_fetch_add(p, v, __ATOMIC_RELAXED, __HIP_MEMORY_SCOPE_AGENT); }
__device__ __forceinline__ unsigned xb_xcc_id() { return (unsigned)__builtin_amdgcn_s_getreg((3 << 11) | 20) & 0xFu; }
#define XB_SPIN(cond, bar) do { unsigned _sp = 0; while (cond) { __builtin_amdgcn_s_sleep(1); \
    if ((++_sp & 255u) == 0u) { if (xb_ld(&(bar)[XB_TMO])) break; if (_sp > XB_SPIN_CAP) { atomicAdd(&(bar)[XB_TMO], 1u); break; } } } } while (0)

struct XcdBarrier {
    unsigned* bar; unsigned x;
    volatile XLAS unsigned* st;
};

__device__ __forceinline__ XcdBarrier xcd_barrier_post(unsigned* bar, volatile XLAS unsigned* st) {
    XcdBarrier b; b.bar = bar; b.x = xb_xcc_id(); b.st = st;
    if (threadIdx.x == 0) (void)xb_add(&bar[XB_XCNT(b.x)], 1u);
    return b;
}
__device__ __forceinline__ void xcd_barrier_complete(unsigned* bar, unsigned x, unsigned& nloc, unsigned& nx) {
    const unsigned G = gridDim.x * gridDim.y * gridDim.z;
    unsigned sum, cnt, mine, sp = 0u;
    for (;;) {
        sum = 0u; cnt = 0u; mine = 0u;
#pragma unroll
        for (unsigned j = 0; j < 16; ++j) { const unsigned c = xb_ld(&bar[XB_XCNT(j)]); sum += c; cnt += (c > 0u) ? 1u : 0u; mine = (j == x) ? c : mine; }
        if (sum == G) break;
        __builtin_amdgcn_s_sleep(1);
        if ((++sp & 255u) == 0u) { if (xb_ld(&bar[XB_TMO])) break; if (sp > XB_SPIN_CAP) { atomicAdd(&bar[XB_TMO], 1u); break; } }
    }
    nloc = mine > 0u ? mine : 1u; nx = cnt > 0u ? cnt : 1u;
}

__device__ __forceinline__ void xcd_barrier(const XcdBarrier& b) {
    asm volatile("s_waitcnt vmcnt(0)" ::: "memory");
    __syncthreads();
    if (threadIdx.x == 0) {
        unsigned* bar = b.bar;
        __builtin_amdgcn_s_waitcnt(0);
        unsigned nloc = b.st[0], nx = b.st[1];
        if (nloc == 0u) { xcd_barrier_complete(bar, b.x, nloc, nx); b.st[0] = nloc; b.st[1] = nx; }
        const unsigned old = xb_add(&bar[XB_XSUB(b.x)], 1u);
        const unsigned gen = old / nloc;
        if (old + 1u == (gen + 1u) * nloc) {
            __builtin_amdgcn_fence(__ATOMIC_RELEASE, "agent");
            asm volatile("s_waitcnt vmcnt(0)" ::: "memory");
            const unsigned og = xb_add(&bar[XB_TOP], 1u);
            const unsigned tg = og / nx;
            if (og + 1u == (tg + 1u) * nx) xb_add(&bar[XB_TOPGEN], 1u);
            else XB_SPIN(xb_ld(&bar[XB_TOPGEN]) == tg, bar);
            __builtin_amdgcn_fence(__ATOMIC_ACQUIRE, "agent");
            xb_add(&bar[XB_XGEN(b.x)], 1u);
            asm volatile("s_waitcnt vmcnt(0)" ::: "memory");
        } else {
            XB_SPIN(xb_ld(&bar[XB_XGEN(b.x)]) == gen, bar);
            __builtin_amdgcn_fence(__ATOMIC_ACQUIRE, "agent");
            asm volatile("s_waitcnt vmcnt(0)" ::: "memory");
        }
    }
    __syncthreads();
}

namespace pg8 {
#define PG8_LAS __attribute__((address_space(3)))
typedef unsigned short bf16_t;
typedef short bf16x8 __attribute__((ext_vector_type(8)));
typedef float f32x4 __attribute__((ext_vector_type(4)));
typedef unsigned u32x4 __attribute__((ext_vector_type(4)));
constexpr int BM = 256, BK = 64, HALF = 128, HTB = HALF * BK * 2  , STAGE_BYTES = 8 * HTB, NXCD = 8, WGM = 8;

__host__ __device__ __forceinline__ int lds_byte(int r, int c) { const int st = (r >> 4) * 2 + (c >> 5), rr = r & 15, cc = c & 31, ob = rr * 64 + cc * 2; return st * 1024 + (ob ^ (((ob >> 9) & 1) << 5)); }
__host__ __device__ __forceinline__ void stage_rc(int b, int& R, int& C) { const int st = b / 1024, sb = b % 1024, swz = sb ^ (((sb >> 9) & 1) << 5); R = (st >> 1) * 16 + swz / 64; C = (st & 1) * 32 + (swz % 64) / 2; }
__host__ __device__ __forceinline__ int perm32(int rho) { const int n = rho >> 4, i = rho & 15; return 8 * (i >> 2) + 4 * n + (i & 3); }

struct Unit { int pm, pn; };
struct Gemm { const bf16_t* A; const bf16_t* Bt; int M, N, K; };

struct StaticOrder {
    int nM, nN, nwg, G, c;
    __host__ __device__ void init(int M, int N, int G_, int c_) { nM = M / BM; nN = N / BM; nwg = nM * nN; G = G_; c = c_; }
    __host__ __device__ bool next(int i, Unit& u) const {
        const long L = (long)i * G + c; if (L >= nwg) return false;
        int wgid = (int)L; { const int q = nwg / NXCD, r = nwg % NXCD, xcd = wgid % NXCD, off = wgid / NXCD; wgid = (xcd < r ? xcd * (q + 1) : r * (q + 1) + (xcd - r) * q) + off; }
        const int nig = WGM * nN, gid = wgid / nig, fm = gid * WGM, gsz = (nM - fm) < WGM ? (nM - fm) : WGM;
        u.pm = fm + ((wgid % nig) % gsz); u.pn = (wgid % nig) / gsz; return true;
    }
    __device__ __forceinline__ void a_ready(const Unit&) const {}
    __device__ __forceinline__ void done(const Unit&) const {}
};

__device__ __forceinline__ unsigned cvt_pk_bf16(float lo, float hi) { unsigned r; asm volatile("v_cvt_pk_bf16_f32 %0, %1, %2" : "=v"(r) : "v"(lo), "v"(hi)); return r; }

template <bool BATCHED> struct PEpiBf16 {
    static constexpr bool PERM = true, AFTER_DRAIN = false;
    bf16_t* O; int ldc;
    __device__ __forceinline__ void operator()(const f32x4 (&acc)[2][2][4][2], const Unit& u, int wr, int wc, int fr, int fq) const {
        const int rb = BATCHED ? ((u.pn >> 2) * 4096 + u.pm * 256) : u.pm * 256, cb = BATCHED ? (u.pn & 3) * 256 : u.pn * 256;
        const int row0 = rb + wr * 64 + fr, col0 = cb + wc * 32 + 8 * fq;
#pragma unroll
        for (int ai = 0; ai < 2; ++ai)
#pragma unroll
            for (int m = 0; m < 4; ++m) { bf16_t* rowp = O + (size_t)(row0 + ai * HALF + m * 16) * ldc + col0;
#pragma unroll
                for (int bj = 0; bj < 2; ++bj) { const f32x4 v0 = acc[ai][bj][m][0], v1 = acc[ai][bj][m][1];
                    u32x4 w; w.x = cvt_pk_bf16(v0[0], v0[1]); w.y = cvt_pk_bf16(v0[2], v0[3]); w.z = cvt_pk_bf16(v1[0], v1[1]); w.w = cvt_pk_bf16(v1[2], v1[3]);
                    *(u32x4*)(rowp + bj * HALF) = w; } }
    }
};
struct PEpiF32 {
    static constexpr bool PERM = true, AFTER_DRAIN = false;
    float* O; int ldc;
    __device__ __forceinline__ void operator()(const f32x4 (&acc)[2][2][4][2], const Unit& u, int wr, int wc, int fr, int fq) const {
        const int row0 = u.pm * 256 + wr * 64 + fr, col0 = u.pn * 256 + wc * 32 + 8 * fq;
#pragma unroll
        for (int ai = 0; ai < 2; ++ai)
#pragma unroll
            for (int m = 0; m < 4; ++m) { float* rowp = O + (size_t)(row0 + ai * HALF + m * 16) * ldc + col0;
#pragma unroll
                for (int bj = 0; bj < 2; ++bj) { *(f32x4*)(rowp + bj * HALF) = acc[ai][bj][m][0]; *(f32x4*)(rowp + bj * HALF + 4) = acc[ai][bj][m][1]; } }
    }
};
template <int CTRL> __device__ __forceinline__ float dppz(float x) { return __int_as_float(__builtin_amdgcn_update_dpp(0, __float_as_int(x), CTRL, 0xF, 0xF, true)); }
template <int CTRL> __device__ __forceinline__ float dppo(float old, float x) { return __int_as_float(__builtin_amdgcn_update_dpp(__float_as_int(old), __float_as_int(x), CTRL, 0xF, 0xF, false)); }
struct PEpiGlu {
    static constexpr bool PERM = true, AFTER_DRAIN = false;
    bf16_t* act; bf16_t* sb; const float* cw;
    __device__ __forceinline__ void operator()(const f32x4 (&acc)[2][2][4][2], const Unit& u, int wr, int wc, int fr, int fq) const {
        const int chb = u.pn * 128 + wc * 32 + 8 * fq, colp = u.pn * 256 + wc * 32 + 8 * fq;
#pragma unroll
        for (int n = 0; n < 2; ++n) {
            const int ch = chb + 4 * n;
            const f32x4 g0 = *(const f32x4*)(cw + ch), g1 = *(const f32x4*)(cw + 5632 + ch), g2 = *(const f32x4*)(cw + 11264 + ch);
            const f32x4 v0 = *(const f32x4*)(cw + 2816 + ch), v1 = *(const f32x4*)(cw + 5632 + 2816 + ch), v2 = *(const f32x4*)(cw + 11264 + 2816 + ch);
#pragma unroll
            for (int ai = 0; ai < 2; ++ai) {
                const int strip = u.pm * 4 + ai * 2 + wr, rowbase = u.pm * 256 + ai * HALF + wr * 64;
#pragma unroll
                for (int m = 0; m < 4; ++m) {
                    float o[4];
#pragma unroll
                    for (int r = 0; r < 4; ++r) {
                        const float gc = acc[ai][0][m][n][r], vc = acc[ai][1][m][n][r];
                        float gx = 0.f, vx = 0.f, gy = 0.f, vy = 0.f;
                        if (m > 0) { gx = dppz<0x121>(acc[ai][0][m - 1][n][r]); vx = dppz<0x121>(acc[ai][1][m - 1][n][r]); }
                        const float gp = dppo<0x111>(gx, gc), vp = dppo<0x111>(vx, vc);
                        if (m < 3) { gy = dppz<0x12F>(acc[ai][0][m + 1][n][r]); vy = dppz<0x12F>(acc[ai][1][m + 1][n][r]); }
                        const float gn = dppo<0x101>(gy, gc), vn = dppo<0x101>(vy, vc);
                        const float g = gp * g0[r] + gc * g1[r] + gn * g2[r];
                        const float v = vp * v0[r] + vc * v1[r] + vn * v2[r];
                        const float u2 = -1.5957691216057308f * (g + 0.044715f * g * g * g);
                        o[r] = g * __builtin_amdgcn_rcpf(1.f + __expf(u2)) * v;
                    }
                    u32x2 w; w.x = cvt_pk_bf16(o[0], o[1]); w.y = cvt_pk_bf16(o[2], o[3]);
                    *(u32x2*)(act + (size_t)(rowbase + m * 16 + fr) * 2816 + ch) = w;
                }
                if (fr < 2) {
                    bf16_t* sp = sb + ((size_t)strip * 4 + fr) * 5632 + colp + 4 * n;
                    u32x2 w; w.x = cvt_pk_bf16(acc[ai][0][0][n][0], acc[ai][0][0][n][1]); w.y = cvt_pk_bf16(acc[ai][0][0][n][2], acc[ai][0][0][n][3]);
                    *(u32x2*)sp = w;
                    w.x = cvt_pk_bf16(acc[ai][1][0][n][0], acc[ai][1][0][n][1]); w.y = cvt_pk_bf16(acc[ai][1][0][n][2], acc[ai][1][0][n][3]);
                    *(u32x2*)(sp + 128) = w;
                }
                if (fr >= 14) {
                    bf16_t* sp = sb + ((size_t)strip * 4 + (fr - 12)) * 5632 + colp + 4 * n;
                    u32x2 w; w.x = cvt_pk_bf16(acc[ai][0][3][n][0], acc[ai][0][3][n][1]); w.y = cvt_pk_bf16(acc[ai][0][3][n][2], acc[ai][0][3][n][3]);
                    *(u32x2*)sp = w;
                    w.x = cvt_pk_bf16(acc[ai][1][3][n][0], acc[ai][1][3][n][1]); w.y = cvt_pk_bf16(acc[ai][1][3][n][2], acc[ai][1][3][n][3]);
                    *(u32x2*)(sp + 128) = w;
                }
            }
        }
    }
};
struct PEpiF32B {
    static constexpr bool PERM = true, AFTER_DRAIN = false;
    bf16_t* O;
    __device__ __forceinline__ void operator()(const f32x4 (&acc)[2][2][4][2], const Unit& u, int wr, int wc, int fr, int fq) const {
        const int row0 = (u.pn >> 2) * 2048 + (u.pm & 7) * 256 + wr * 64 + fr, col0 = (u.pn & 3) * 256 + wc * 32 + 8 * fq;
#pragma unroll
        for (int ai = 0; ai < 2; ++ai)
#pragma unroll
            for (int m = 0; m < 4; ++m) { bf16_t* rowp = O + (size_t)(row0 + ai * HALF + m * 16) * 1024 + col0;
#pragma unroll
                for (int bj = 0; bj < 2; ++bj) { const f32x4 v0 = acc[ai][bj][m][0], v1 = acc[ai][bj][m][1];
                    u32x4 w; w.x = cvt_pk_bf16(v0[0], v0[1]); w.y = cvt_pk_bf16(v0[2], v0[3]); w.z = cvt_pk_bf16(v1[0], v1[1]); w.w = cvt_pk_bf16(v1[2], v1[3]);
                    *(u32x4*)(rowp + bj * HALF) = w; } }
    }
};
struct BatchOrder {
    int G, c;
    __device__ __forceinline__ bool next(int i, Unit& u) const { const int L = i * G + c; if (L >= 512) return false; const int be = L >> 5, r = L & 31; u.pm = (be & 1) * 8 + (r >> 2); u.pn = be * 4 + (r & 3); return true; }
    __device__ __forceinline__ void a_ready(const Unit&) const {}
    __device__ __forceinline__ void done(const Unit&) const {}
};
template <class Epi, class Sched, bool ALIGN_EPI = false, bool SP2 = false>
__device__ __forceinline__ void gemm_phase(PG8_LAS unsigned char* lds, const Gemm g, const Sched& S, const Epi& E) {
    int tid_ = threadIdx.x; asm volatile("" : "+v"(tid_));
    const int tid = tid_, wid = __builtin_amdgcn_readfirstlane(tid >> 6), lane = tid & 63, wr = wid >> 2, wc = wid & 3, fr = lane & 15, fq = lane >> 4;
    const int K = g.K, nt = K / BK;
    unsigned voffA[2], voffB[2];
#pragma unroll
    for (int i = 0; i < 2; ++i) { int R, C; stage_rc(tid * 16 + i * 8192, R, C); const int Rb = Epi::PERM ? ((R & ~31) + perm32(R & 31)) : R;
        voffA[i] = (unsigned)(R * K + C) * 2u; voffB[i] = (unsigned)(Rb * K + C) * 2u; }
    const size_t kstep = (size_t)(BK * 2);
    const size_t hstep = (size_t)HALF * K * 2;
    const size_t tstep = 2 * hstep;
    const unsigned ldsw = (unsigned)wid * 1024u;
    const int aoff = lds_byte(wr * 64 + fr, fq * 8), boff = lds_byte(wc * 32 + fr, fq * 8);
#define PG8_SA(b, h) (((b) * 2 + (h)) * HTB)
#define PG8_SB(b, h) ((4 + (b) * 2 + (h)) * HTB)
#define PG8_STAGE(bufoff, gbase, voff) do { _Pragma("unroll") for (int _i = 0; _i < 2; ++_i) \
        __builtin_amdgcn_global_load_lds((const unsigned*)((const char*)(gbase) + (voff)[_i]), (PG8_LAS unsigned*)(lds + (bufoff) + ldsw + _i * 8192), 16, 0, 0); } while (0)
#define PG8_LDA(dst, b, h) do { _Pragma("unroll") for (int m = 0; m < 4; ++m) _Pragma("unroll") for (int k = 0; k < 2; ++k) dst[m][k] = *(const PG8_LAS bf16x8*)(lds + PG8_SA(b, h) + aoff + m * 2048 + k * 1024); } while (0)
#define PG8_LDB(dst, b, h) do { _Pragma("unroll") for (int n = 0; n < 2; ++n) _Pragma("unroll") for (int k = 0; k < 2; ++k) dst[n][k] = *(const PG8_LAS bf16x8*)(lds + PG8_SB(b, h) + boff + n * 2048 + k * 1024); } while (0)
#define PG8_MMA(ai, bj, At, Bt) do { __builtin_amdgcn_s_setprio(1); _Pragma("unroll") for (int m = 0; m < 4; ++m) _Pragma("unroll") for (int n = 0; n < 2; ++n) _Pragma("unroll") for (int k = 0; k < 2; ++k) \
        acc[ai][bj][m][n] = __builtin_amdgcn_mfma_f32_16x16x32_bf16(Bt[n][k], At[m][k], acc[ai][bj][m][n], 0, 0, 0); __builtin_amdgcn_s_setprio(0); } while (0)
#define PG8_WAIT_V(n) asm volatile("s_waitcnt vmcnt(" #n ")" ::: "memory")
#define PG8_WAIT_L(n) asm volatile("s_waitcnt lgkmcnt(" #n ")" ::: "memory")
#define PG8_BAR __builtin_amdgcn_s_barrier()
#define PG8_SCHED __builtin_amdgcn_sched_barrier(0)
    Unit cur, nxt; int ui = 0;
    if (!S.next(0, cur)) return;
    f32x4 acc[2][2][4][2];
#pragma unroll
    for (int a = 0; a < 2; ++a)
#pragma unroll
        for (int b = 0; b < 2; ++b)
#pragma unroll
            for (int m = 0; m < 4; ++m)
#pragma unroll
                for (int n = 0; n < 2; ++n) acc[a][b][m][n] = (f32x4){0.f, 0.f, 0.f, 0.f};
    bf16x8 At[4][2], B0[2][2], B1[2][2];
    const char* cA = (const char*)g.A + (size_t)cur.pm * tstep; const char* cB = (const char*)g.Bt + (size_t)cur.pn * tstep;
    S.a_ready(cur);
    if constexpr (SP2) {
        PG8_STAGE(PG8_SB(0, 0), cB, voffB); PG8_STAGE(PG8_SB(0, 1), cB + hstep, voffB); PG8_STAGE(PG8_SA(0, 0), cA, voffA); PG8_STAGE(PG8_SA(0, 1), cA + hstep, voffA);
        if (wr == 1) PG8_BAR;
        PG8_WAIT_V(2); PG8_BAR;
        PG8_STAGE(PG8_SB(1, 0), cB + kstep, voffB); PG8_STAGE(PG8_SA(1, 0), cA + kstep, voffA); PG8_STAGE(PG8_SB(1, 1), cB + hstep + kstep, voffB);
        PG8_WAIT_V(6); PG8_BAR;
    } else {
        PG8_STAGE(PG8_SB(0, 0), cB, voffB); PG8_STAGE(PG8_SA(0, 0), cA, voffA); PG8_STAGE(PG8_SB(0, 1), cB + hstep, voffB); PG8_STAGE(PG8_SA(0, 1), cA + hstep, voffA);
        if (wr == 1) PG8_BAR;
        PG8_WAIT_V(4); PG8_BAR;
        PG8_STAGE(PG8_SB(1, 0), cB + kstep, voffB); PG8_STAGE(PG8_SA(1, 0), cA + kstep, voffA); PG8_STAGE(PG8_SB(1, 1), cB + hstep + kstep, voffB);
        PG8_WAIT_V(6); PG8_BAR;
    }
    for (;;) {
        const bool has_next = S.next(ui + 1, nxt);
        const char* nA = has_next ? (const char*)g.A + (size_t)nxt.pm * tstep : cA; const char* nB = has_next ? (const char*)g.Bt + (size_t)nxt.pn * tstep : cB;
        for (int t = 0; t < nt; t += 2) {
            const bool last = (t == nt - 2);
            const char* a1 = cA + (size_t)(t + 1) * kstep;
            const char* a2 = last ? nA : cA + (size_t)(t + 2) * kstep; const char* b2 = last ? nB : cB + (size_t)(t + 2) * kstep;
            const char* a3 = a2 + kstep; const char* b3 = b2 + kstep;
            if (last && has_next) S.a_ready(nxt);
            if constexpr (SP2) {
            PG8_LDB(B0, 0, 0); PG8_LDB(B1, 0, 1); PG8_SCHED; PG8_LDA(At, 0, 0); PG8_STAGE(PG8_SA(1, 1), a1 + hstep, voffA);
            PG8_WAIT_V(8); PG8_WAIT_L(0); PG8_BAR; PG8_MMA(0, 0, At, B0); PG8_MMA(0, 1, At, B1); PG8_BAR; PG8_SCHED;
            PG8_LDA(At, 0, 1); PG8_STAGE(PG8_SB(0, 0), b2, voffB); PG8_STAGE(PG8_SB(0, 1), b2 + hstep, voffB); PG8_STAGE(PG8_SA(0, 0), a2, voffA);
            PG8_WAIT_V(8); PG8_WAIT_L(0); PG8_BAR; PG8_MMA(1, 0, At, B0); PG8_MMA(1, 1, At, B1); PG8_BAR; PG8_SCHED;
            PG8_LDB(B0, 1, 0); PG8_LDB(B1, 1, 1); PG8_SCHED; PG8_LDA(At, 1, 0); PG8_STAGE(PG8_SA(0, 1), a2 + hstep, voffA);
            PG8_WAIT_V(8); PG8_WAIT_L(0); PG8_BAR; PG8_MMA(0, 0, At, B0); PG8_MMA(0, 1, At, B1); PG8_BAR; PG8_SCHED;
            PG8_LDA(At, 1, 1); PG8_STAGE(PG8_SB(1, 0), b3, voffB); PG8_STAGE(PG8_SB(1, 1), b3 + hstep, voffB); PG8_STAGE(PG8_SA(1, 0), a3, voffA);
            PG8_WAIT_V(8); PG8_WAIT_L(0); PG8_BAR; PG8_MMA(1, 0, At, B0); PG8_MMA(1, 1, At, B1); PG8_BAR; PG8_SCHED;
            } else {
            PG8_LDB(B0, 0, 0); PG8_SCHED; PG8_LDA(At, 0, 0); PG8_STAGE(PG8_SA(1, 1), a1 + hstep, voffA);
            PG8_WAIT_L(8); PG8_BAR; PG8_WAIT_L(0); PG8_MMA(0, 0, At, B0); PG8_BAR; PG8_SCHED;
            PG8_LDB(B1, 0, 1); PG8_STAGE(PG8_SB(0, 0), b2, voffB);
            PG8_BAR; PG8_WAIT_L(0); PG8_MMA(0, 1, At, B1); PG8_BAR;
            PG8_LDA(At, 0, 1); PG8_STAGE(PG8_SA(0, 0), a2, voffA);
            PG8_BAR; PG8_WAIT_L(0); PG8_MMA(1, 0, At, B0); PG8_BAR; PG8_SCHED;
            PG8_STAGE(PG8_SB(0, 1), b2 + hstep, voffB);
            PG8_WAIT_V(6); PG8_BAR; PG8_MMA(1, 1, At, B1); PG8_BAR;
            PG8_LDB(B0, 1, 0); PG8_SCHED; PG8_LDA(At, 1, 0); PG8_STAGE(PG8_SA(0, 1), a2 + hstep, voffA);
            PG8_WAIT_L(8); PG8_BAR; PG8_WAIT_L(0); PG8_MMA(0, 0, At, B0); PG8_BAR; PG8_SCHED;
            PG8_LDB(B1, 1, 1); PG8_STAGE(PG8_SB(1, 0), b3, voffB);
            PG8_BAR; PG8_WAIT_L(0); PG8_MMA(0, 1, At, B1); PG8_BAR;
            PG8_LDA(At, 1, 1); PG8_STAGE(PG8_SA(1, 0), a3, voffA);
            PG8_BAR; PG8_WAIT_L(0); PG8_MMA(1, 0, At, B0); PG8_BAR; PG8_SCHED;
            PG8_STAGE(PG8_SB(1, 1), b3 + hstep, voffB);
            PG8_WAIT_V(6); PG8_BAR; PG8_MMA(1, 1, At, B1); PG8_BAR;
            }
        }
        if constexpr (ALIGN_EPI) { if (wr == 0) PG8_BAR; }
        if constexpr (!Epi::AFTER_DRAIN) { E(acc, cur, wr, wc, fr, fq); S.done(cur); }
        if (!has_next) break;
#pragma unroll
        for (int a = 0; a < 2; ++a)
#pragma unroll
            for (int b = 0; b < 2; ++b)
#pragma unroll
                for (int m = 0; m < 4; ++m)
#pragma unroll
                    for (int n = 0; n < 2; ++n) acc[a][b][m][n] = (f32x4){0.f, 0.f, 0.f, 0.f};
        cur = nxt; cA = nA; cB = nB; ++ui;
        if constexpr (ALIGN_EPI) { if (wr == 1) PG8_BAR; }
    }
    PG8_WAIT_V(0);
    if constexpr (!ALIGN_EPI) { if (wr == 0) PG8_BAR; }
    PG8_BAR;
    if constexpr (Epi::AFTER_DRAIN) { E.fused(acc, cur, wr, wc, fr, fq, lds, wid, lane); S.done(cur); }
#undef PG8_SA
#undef PG8_SB
#undef PG8_STAGE
#undef PG8_LDA
#undef PG8_LDB
#undef PG8_MMA
#undef PG8_WAIT_V
#undef PG8_WAIT_L
#undef PG8_BAR
#undef PG8_SCHED
}
}

template <class Epi>
DEV void gemm_tile(char* lds, const bf16_t* __restrict__ A, int lda, const bf16_t* __restrict__ Bt, int ldb, int K, int trow, int tcol,
                   const Epi& epi) {
  const int tid = tidx(), w = tid >> 6, l = tid & 63, wm = w >> 1, wn = w & 1, lr = l & 15, lq = l >> 4;
  const bf16_t* ga[4];
  const bf16_t* gb[2];
#pragma unroll
  for (int j = 0; j < 4; ++j) {
    const int c = w * 4 + j, mt = c >> 1, sl = c & 1;
    ga[j] = A + (size_t)(mt * 16 + lr) * lda + sl * 32 + lq * 8;
  }
#pragma unroll
  for (int j = 0; j < 2; ++j) {
    const int nt = w, sl = j;
    const int rowb = (nt >> 2) * 64 + (lr >> 2) * 16 + (nt & 3) * 4 + (lr & 3);
    gb[j] = Bt + (size_t)rowb * ldb + sl * 32 + lq * 8;
  }
  f32x4 acc[4][4];
#pragma unroll
  for (int i = 0; i < 4; ++i)
#pragma unroll
    for (int j = 0; j < 4; ++j) acc[i][j] = (f32x4){0.f, 0.f, 0.f, 0.f};
  u32x4 ra[4], rb[2];
  const int nk = K >> 6;
#pragma unroll
  for (int j = 0; j < 4; ++j) ra[j] = *(const u32x4*)(ga[j]);
#pragma unroll
  for (int j = 0; j < 2; ++j) rb[j] = *(const u32x4*)(gb[j]);
#pragma unroll
  for (int j = 0; j < 4; ++j) *(u32x4*)(lds + (w * 4 + j) * 1024 + l * 16) = ra[j];
#pragma unroll
  for (int j = 0; j < 2; ++j) *(u32x4*)(lds + 32768 + (w * 2 + j) * 1024 + l * 16) = rb[j];
  __syncthreads();
  for (int kt = 0; kt < nk; ++kt) {
    char* cur = lds + (kt & 1) * 49152;
    const bool more = (kt + 1 < nk);
    if (more) {
#pragma unroll
      for (int j = 0; j < 4; ++j) ra[j] = *(const u32x4*)(ga[j] + (kt + 1) * 64);
#pragma unroll
      for (int j = 0; j < 2; ++j) rb[j] = *(const u32x4*)(gb[j] + (kt + 1) * 64);
    }
#pragma unroll
    for (int s = 0; s < 2; ++s) {
      bf16x8 af[4], bfr[4];
#pragma unroll
      for (int i = 0; i < 4; ++i) af[i] = *(const bf16x8*)(cur + ((wm * 4 + i) * 2 + s) * 1024 + l * 16);
#pragma unroll
      for (int j = 0; j < 4; ++j) bfr[j] = *(const bf16x8*)(cur + 32768 + ((wn * 4 + j) * 2 + s) * 1024 + l * 16);
#pragma unroll
      for (int i = 0; i < 4; ++i)
#pragma unroll
        for (int j = 0; j < 4; ++j) acc[i][j] = __builtin_amdgcn_mfma_f32_16x16x32_bf16(bfr[j], af[i], acc[i][j], 0, 0, 0);
    }
    if (more) {
      char* nxt = lds + ((kt + 1) & 1) * 49152;
#pragma unroll
      for (int j = 0; j < 4; ++j) *(u32x4*)(nxt + (w * 4 + j) * 1024 + l * 16) = ra[j];
#pragma unroll
      for (int j = 0; j < 2; ++j) *(u32x4*)(nxt + 32768 + (w * 2 + j) * 1024 + l * 16) = rb[j];
    }
    __syncthreads();
  }
#pragma unroll
  for (int i = 0; i < 4; ++i) epi(trow + wm * 64 + i * 16 + lr, tcol + wn * 64 + lq * 16, acc[i]);
}

DEV void store16_bf16(bf16_t* dst, const f32x4 (&v)[4], float sc) {
  u32x4 a, b;
  a.x = pk2(v[0][0] * sc, v[0][1] * sc); a.y = pk2(v[0][2] * sc, v[0][3] * sc);
  a.z = pk2(v[1][0] * sc, v[1][1] * sc); a.w = pk2(v[1][2] * sc, v[1][3] * sc);
  b.x = pk2(v[2][0] * sc, v[2][1] * sc); b.y = pk2(v[2][2] * sc, v[2][3] * sc);
  b.z = pk2(v[3][0] * sc, v[3][1] * sc); b.w = pk2(v[3][2] * sc, v[3][3] * sc);
  *(u32x4*)dst = a;
  *(u32x4*)(dst + 8) = b;
}

struct EpiBf16 {
  bf16_t* O; int ldo;
  DEV void operator()(int row, int col, const f32x4 (&v)[4]) const { store16_bf16(O + (size_t)row * ldo + col, v, 1.f); }
};
struct EpiF32 {
  float* O; int ldo;
  DEV void operator()(int row, int col, const f32x4 (&v)[4]) const {
    float* d = O + (size_t)row * ldo + col;
#pragma unroll
    for (int j = 0; j < 4; ++j) *(f32x4*)(d + 4 * j) = v[j];
  }
};
struct EpiLora1 {
  bf16_t* O;
  DEV void operator()(int row, int col, const f32x4 (&v)[4]) const {
    f32x4 o[4];
#pragma unroll
    for (int j = 0; j < 4; ++j)
#pragma unroll
      for (int r = 0; r < 4; ++r) {
        const float t = v[j][r];
        o[j][r] = (col < 128) ? (1.f - 2.f * __builtin_amdgcn_rcpf(1.f + __expf(2.f * t))) : ((col < 256) ? t : sigmoidf_(t));
      }
    store16_bf16(O + (size_t)row * 384 + col, o, 1.f);
  }
};
struct EpiDecay {
  bf16_t* O; const float* w0;
  DEV void operator()(int row, int col, const f32x4 (&v)[4]) const {
    f32x4 o[4];
    float w0v[16];
#pragma unroll
    for (int i = 0; i < 16; i += 4) *(f32x4*)(w0v + i) = *(const f32x4*)(w0 + col + i);
#pragma unroll
    for (int j = 0; j < 4; ++j)
#pragma unroll
      for (int r = 0; r < 4; ++r) {
        const float xx = w0v[4 * j + r] + v[j][r];
        const float nx = -xx;
        const float sp = (nx > 20.f) ? nx : __logf(1.f + __expf(nx));
        const float e = __expf(-sp - 0.5f);
        o[j][r] = 1.f - __expf(-e);
      }
    store16_bf16(O + (size_t)row * 512 + col, o, 1.f);
  }
};
struct EpiA {
  bf16_t *KD, *KKA, *KK; const float *a0, *k_k, *k_a; const bf16_t* za; int writekk;
  DEV void operator()(int row, int col, const f32x4 (&v)[4]) const {
    const bf16_t* kp = za + (size_t)row * 2048 + 512 + col;
    const u32x4 k0 = *(const u32x4*)kp, k1 = *(const u32x4*)(kp + 8);
    float kf[16];
    kf[0] = lo16(k0.x); kf[1] = hi16(k0.x); kf[2] = lo16(k0.y); kf[3] = hi16(k0.y); kf[4] = lo16(k0.z); kf[5] = hi16(k0.z); kf[6] = lo16(k0.w); kf[7] = hi16(k0.w);
    kf[8] = lo16(k1.x); kf[9] = hi16(k1.x); kf[10] = lo16(k1.y); kf[11] = hi16(k1.y); kf[12] = lo16(k1.z); kf[13] = hi16(k1.z); kf[14] = lo16(k1.w); kf[15] = hi16(k1.w);
    float kkv[16], a0v[16], kav[16];
#pragma unroll
    for (int i = 0; i < 16; i += 4) { *(f32x4*)(kkv + i) = *(const f32x4*)(k_k + col + i); *(f32x4*)(a0v + i) = *(const f32x4*)(a0 + col + i); *(f32x4*)(kav + i) = *(const f32x4*)(k_a + col + i); }
    float kr[16], ss = 0.f;
#pragma unroll
    for (int i = 0; i < 16; ++i) { kr[i] = kf[i] * kkv[i]; ss += kr[i] * kr[i]; }
    ss += __shfl_xor(ss, 16);
    ss += __shfl_xor(ss, 32);
    const float rn = rsqrtf(ss + 1e-12f);
    f32x4 okd[4], okka[4], okk[4];
#pragma unroll
    for (int j = 0; j < 4; ++j)
#pragma unroll
      for (int r = 0; r < 4; ++r) {
        const int i = 4 * j + r;
        const float a = sigmoidf_(a0v[i] + v[j][r]);
        const float kk = kr[i] * rn;
        okd[j][r] = kf[i] * (1.f + (a - 1.f) * kav[i]);
        okka[j][r] = kk * a;
        okk[j][r] = kk;
      }
    store16_bf16(KD + (size_t)row * 512 + col, okd, 1.f);
    store16_bf16(KKA + (size_t)row * 512 + col, okka, 1.f);
    if (writekk) store16_bf16(KK + (size_t)row * 512 + col, okk, 1.f);
  }
};
struct EpiDftc {
  bf16_t* CST; int g;
  DEV void operator()(int row, int col, const f32x4 (&v)[4]) const {
    const int b = col >> 12, s = col & 4095;
    store16_bf16(CST + ((size_t)((b * 2 + (row >> 7)) * 1024 + g * 128 + (row & 127)) * 4096 + s), v, 1.f);
  }
};

DEV void transpose_convert(char* lds, const float* __restrict__ W, int K, int N, bf16_t* __restrict__ Wt, int ldt, int rot, bool glu_perm = false) {
  float* tile = (float*)lds;
  const int tn_n = N >> 6, nt = (K >> 6) * tn_n, tid = tidx();
  const int r0 = tid >> 4, c4 = (tid & 15) * 4;
  int t = (blockIdx.x + rot) % gridDim.x;
  f32x4 ra, rb;
  if (t < nt) {
    const int tk = t / tn_n, tn = t % tn_n;
    const float* src = W + (size_t)(tk * 64 + r0) * N + tn * 64 + c4;
    ra = *(const f32x4*)src; rb = *(const f32x4*)(src + (size_t)32 * N);
  }
  for (; t < nt; t += gridDim.x) {
    const int tk = t / tn_n, tn = t % tn_n;
#pragma unroll
    for (int i = 0; i < 4; ++i) { tile[r0 * 65 + c4 + i] = ra[i]; tile[(r0 + 32) * 65 + c4 + i] = rb[i]; }
    __syncthreads();
    const int t2 = t + gridDim.x;
    if (t2 < nt) {
      const int tk2 = t2 / tn_n, tn2 = t2 % tn_n;
      const float* src = W + (size_t)(tk2 * 64 + r0) * N + tn2 * 64 + c4;
      ra = *(const f32x4*)src; rb = *(const f32x4*)(src + (size_t)32 * N);
    }
    int nbase = tn * 64;
    if (glu_perm) { const int c = tn * 64; nbase = (c < 2816) ? ((c >> 7) * 256 + (c & 127)) : (((c - 2816) >> 7) * 256 + 128 + ((c - 2816) & 127)); }
#pragma unroll
    for (int j = 0; j < 2; ++j) {
      const int n = r0 + 32 * j;
      u32x2 pk;
      pk.x = pk2(tile[(c4 + 0) * 65 + n], tile[(c4 + 1) * 65 + n]);
      pk.y = pk2(tile[(c4 + 2) * 65 + n], tile[(c4 + 3) * 65 + n]);
      *(u32x2*)(Wt + (size_t)(nbase + n) * ldt + tk * 64 + c4) = pk;
    }
    __syncthreads();
  }
}

DEV void compute_mod(char* lds, const P& p) {
  float* cs = (float*)lds;
  float* red = (float*)(lds + 32768);
  const int tid = tidx();
  float* mod = (float*)(p.ws + W_MOD);
  bool have = false;
  for (int item = blockIdx.x; item < 192; item += gridDim.x) {
    if (!have) {
      for (int i = tid; i < 8192; i += NTHR) { const float cv = p.c[i]; cs[i] = cv / (1.f + expf(-cv)); }
      __syncthreads();
      have = true;
    }
    const int l = item / 96, cb = item % 96, col = cb * 64 + (tid & 63), kg = tid >> 6;
    float a0 = 0, a1 = 0, a2 = 0, a3 = 0, a4 = 0, a5 = 0, a6 = 0, a7 = 0;
    const float* wp = p.ada_w + ((size_t)l * 1024 + kg * 128) * 6144 + col;
    for (int k = 0; k < 128; ++k) {
      const float wv = wp[(size_t)k * 6144];
      const int kk = kg * 128 + k;
      a0 += cs[kk] * wv; a1 += cs[1024 + kk] * wv; a2 += cs[2048 + kk] * wv; a3 += cs[3072 + kk] * wv;
      a4 += cs[4096 + kk] * wv; a5 += cs[5120 + kk] * wv; a6 += cs[6144 + kk] * wv; a7 += cs[7168 + kk] * wv;
    }
    float* rp = red + kg * 512 + (tid & 63);
    rp[0] = a0; rp[64] = a1; rp[128] = a2; rp[192] = a3; rp[256] = a4; rp[320] = a5; rp[384] = a6; rp[448] = a7;
    __syncthreads();
    {
      const int b = tid >> 6, cc = tid & 63;
      float s = 0.f;
#pragma unroll
      for (int g = 0; g < 8; ++g) s += red[g * 512 + b * 64 + cc];
      mod[(size_t)(l * 8 + b) * 6144 + cb * 64 + cc] = s + p.ada_b[l * 6144 + cb * 64 + cc];
    }
    __syncthreads();
  }
}

template <bool HAS_Y, bool HAS_H, bool XIN_BF = false, bool XOUT_BF = false>
DEV void rowpass(const void* __restrict__ xin_, const bf16_t* __restrict__ yf, const float* __restrict__ gy, const float* __restrict__ gate,
                 void* __restrict__ xout_, const float* __restrict__ gh, const float* __restrict__ sc, const float* __restrict__ sh,
                 bf16_t* __restrict__ h) {
  const float* xin = (const float*)xin_; const bf16_t* xinb = (const bf16_t*)xin_;
  float* xout = (float*)xout_; bf16_t* xoutb = (bf16_t*)xout_;
  const int lane = tidx() & 63, gw = blockIdx.x * 8 + (tidx() >> 6), nw = gridDim.x * 8;
  for (int row = gw; row < MT; row += nw) {
    const int b = row >> 12;
    f32x4 xv[4];
#pragma unroll
    for (int i = 0; i < 4; ++i) {
      if (XIN_BF) { const u32x2 xu = *(const u32x2*)(xinb + (size_t)row * 1024 + i * 256 + lane * 4); xv[i] = (f32x4){lo16(xu.x), hi16(xu.x), lo16(xu.y), hi16(xu.y)}; }
      else xv[i] = *(const f32x4*)(xin + (size_t)row * 1024 + i * 256 + lane * 4);
    }
    if (HAS_Y) {
      f32x4 yv[4];
      float ss = 0.f;
#pragma unroll
      for (int i = 0; i < 4; ++i) {
        const u32x2 yu = *(const u32x2*)(yf + (size_t)row * 1024 + i * 256 + lane * 4);
        yv[i] = (f32x4){lo16(yu.x), hi16(yu.x), lo16(yu.y), hi16(yu.y)};
        ss += yv[i][0] * yv[i][0] + yv[i][1] * yv[i][1] + yv[i][2] * yv[i][2] + yv[i][3] * yv[i][3];
      }
      ss = wave_sum(ss);
      const float rs = rsqrtf(ss * (1.f / 1024.f) + 1e-6f);
#pragma unroll
      for (int i = 0; i < 4; ++i) {
        const int col = i * 256 + lane * 4;
        const f32x4 g4 = *(const f32x4*)(gy + col), gt = *(const f32x4*)(gate + (size_t)b * 6144 + col);
        xv[i] = xv[i] + gt * (yv[i] * rs * g4);
        if (XOUT_BF) { u32x2 pk; pk.x = pk2(xv[i][0], xv[i][1]); pk.y = pk2(xv[i][2], xv[i][3]); *(u32x2*)(xoutb + (size_t)row * 1024 + col) = pk;
                       xv[i] = (f32x4){lo16(pk.x), hi16(pk.x), lo16(pk.y), hi16(pk.y)}; }
        else *(f32x4*)(xout + (size_t)row * 1024 + col) = xv[i];
      }
    }
    if (HAS_H) {
      float ss = 0.f;
#pragma unroll
      for (int i = 0; i < 4; ++i) ss += xv[i][0] * xv[i][0] + xv[i][1] * xv[i][1] + xv[i][2] * xv[i][2] + xv[i][3] * xv[i][3];
      ss = wave_sum(ss);
      const float rs = rsqrtf(ss * (1.f / 1024.f) + 1e-6f);
#pragma unroll
      for (int i = 0; i < 4; ++i) {
        const int col = i * 256 + lane * 4;
        const f32x4 g4 = *(const f32x4*)(gh + col), s4 = *(const f32x4*)(sc + (size_t)b * 6144 + col), h4 = *(const f32x4*)(sh + (size_t)b * 6144 + col);
        const f32x4 o = (xv[i] * rs * g4) * (s4 + 1.f) + h4;
        u32x2 pk;
        pk.x = pk2(o[0], o[1]); pk.y = pk2(o[2], o[3]);
        *(u32x2*)(h + (size_t)row * 1024 + col) = pk;
      }
    }
  }
}

DEV void unpack8(const u32x4 u, float (&f)[8]) {
  f[0] = lo16(u.x); f[1] = hi16(u.x); f[2] = lo16(u.y); f[3] = hi16(u.y); f[4] = lo16(u.z); f[5] = hi16(u.z); f[6] = lo16(u.w); f[7] = hi16(u.w);
}
DEV u32x4 pack8(const float (&f)[8]) {
  u32x4 u;
  u.x = pk2(f[0], f[1]); u.y = pk2(f[2], f[3]); u.z = pk2(f[4], f[5]); u.w = pk2(f[6], f[7]);
  return u;
}

DEV void prep1(const P& p) {
  const bf16_t* z = (const bf16_t*)(p.ws + O_Z);
  bf16_t* za = (bf16_t*)p.out;
  bf16_t* qr = (bf16_t*)(p.ws + O_QR);
  bf16_t* kr = (bf16_t*)(p.ws + O_KR);
  bf16_t* vt = (bf16_t*)(p.ws + O_VT);
  const float* rope = (const float*)(p.ws + W_ROPE);
  const int gt = blockIdx.x * NTHR + tidx(), ngt = gridDim.x * NTHR;
  for (int idx = gt; idx < MT * 256; idx += ngt) {
    const int tok = idx >> 8, c8 = (idx & 255) * 8, s = tok & 4095;
    const bf16_t* zp = z + (size_t)tok * INC + c8;
    float zc[8], zm[8], zn[8], o[8];
    unpack8(*(const u32x4*)zp, zc);
    if (s > 0) unpack8(*(const u32x4*)(zp - INC), zm); else { for (int i = 0; i < 8; ++i) zm[i] = 0.f; }
    if (s < 4095) unpack8(*(const u32x4*)(zp + INC), zn); else { for (int i = 0; i < 8; ++i) zn[i] = 0.f; }
    float w0[8], w1[8], w2[8];
    *(f32x4*)w0 = *(const f32x4*)(p.mix_conv + c8); *(f32x4*)(w0 + 4) = *(const f32x4*)(p.mix_conv + c8 + 4);
    *(f32x4*)w1 = *(const f32x4*)(p.mix_conv + 2048 + c8); *(f32x4*)(w1 + 4) = *(const f32x4*)(p.mix_conv + 2048 + c8 + 4);
    *(f32x4*)w2 = *(const f32x4*)(p.mix_conv + 4096 + c8); *(f32x4*)(w2 + 4) = *(const f32x4*)(p.mix_conv + 4096 + c8 + 4);
#pragma unroll
    for (int i = 0; i < 8; ++i) o[i] = zm[i] * w0[i] + zc[i] * w1[i] + zn[i] * w2[i];
    *(u32x4*)(za + (size_t)tok * 2048 + c8) = pack8(o);
  }
  for (int idx = gt; idx < MT * 64; idx += ngt) {
    const int e8 = idx & 3, which = (idx >> 2) & 1, h = (idx >> 3) & 7, tok = idx >> 6, s = tok & 4095;
    const bf16_t* src = z + (size_t)tok * INC + 2048 + which * 512 + h * 64 + e8 * 8;
    float x1[8], x2[8], o1[8], o2[8];
    unpack8(*(const u32x4*)src, x1);
    unpack8(*(const u32x4*)(src + 32), x2);
    const float* rp = rope + ((size_t)s * 32 + e8 * 8) * 2;
    const float scl = which ? 1.f : 0.125f;
#pragma unroll
    for (int i = 0; i < 8; ++i) {
      const float cv = rp[2 * i], sv = rp[2 * i + 1];
      o1[i] = (x1[i] * cv - x2[i] * sv) * scl;
      o2[i] = (x2[i] * cv + x1[i] * sv) * scl;
    }
    bf16_t* dst = (which ? kr : qr) + (size_t)tok * 512 + h * 64 + e8 * 8;
    *(u32x4*)dst = pack8(o1);
    *(u32x4*)(dst + 32) = pack8(o2);
  }
  {
    bf16_t* vr = (bf16_t*)(p.ws + O_VT);
    for (int idx = gt; idx < MT * 64; idx += ngt) {
      const int tok = idx >> 6, c8 = (idx & 63) * 8;
      *(u32x4*)(vr + (size_t)tok * 512 + c8) = *(const u32x4*)(z + (size_t)tok * INC + 3072 + c8);
    }
  }
}

DEV void attention(char* lds, const P& p) {
  const bf16_t* qr = (const bf16_t*)(p.ws + O_QR);
  const bf16_t* kr = (const bf16_t*)(p.ws + O_KR);
  const bf16_t* vt = (const bf16_t*)(p.ws + O_VT);
  float* num = (float*)(p.ws + O_NUM);
  float* md = (float*)(p.ws + O_MD);
  constexpr int UNIT_LDS = 24576 + 64 * 400;
  const int tid = tidx(), w = tid >> 6, lane = tid & 63, lr = lane & 15, lq = lane >> 4;
  const int uh = tid >> 8, lt = tid & 255, mt = w & 3;
  char* ul = lds + uh * UNIT_LDS;
  u32x4 pre[12];
  auto load_pair = [&](int pi) {
    const int unit = pi * 2 + uh;
    const int nb = unit & 63, h = (unit >> 6) & 7, b = (unit >> 9) & 7, br = unit >> 12;
    const int dsh = 2 * br, Mr = 4096 >> dsh;
    const int seg = (nb * 64) / Mr, segstart = seg * Mr, segend = segstart + Mr;
    const bool pv_ok = (nb * 64 - 64 >= segstart), nx_ok = (nb * 64 + 128 <= segend);
#pragma unroll
    for (int j = 0; j < 6; ++j) {
      const int pc = lt + 256 * j, key = pc >> 3, ch = pc & 7, kb = key >> 6;
      int blk = nb + kb - 1;
      if ((kb == 0 && !pv_ok) || (kb == 2 && !nx_ok)) blk = nb;
      const int kp = blk * 64 + (key & 63);
      const int ktok = b * 4096 + (((kp - segstart) << dsh) + seg);
      pre[j] = *(const u32x4*)(kr + (size_t)ktok * 512 + h * 64 + ch * 8);
      pre[6 + j] = *(const u32x4*)(vt + (size_t)ktok * 512 + h * 64 + ch * 8);
    }
  };
  const int npairs = 3 * 4096 / 2;
  int pi = blockIdx.x;
  if (pi < npairs) load_pair(pi);
  for (; pi < npairs; pi += gridDim.x) {
#pragma unroll
    for (int j = 0; j < 6; ++j) {
      const int pc = lt + 256 * j, key = pc >> 3, ch = pc & 7;
      *(u32x4*)(ul + key * 128 + ((ch ^ (key & 7)) * 16)) = pre[j];
    }
#pragma unroll
    for (int j = 0; j < 6; ++j) {
      const int pc = lt + 256 * j, key = pc >> 3, ch = pc & 7;
      bf16_t* vd = (bf16_t*)(ul + 24576 + (ch * 8) * 400) + (key ^ (ch << 2));
      const u32x4 u = pre[6 + j];
      vd[0 * 200] = (bf16_t)(u.x & 0xffff); vd[1 * 200] = (bf16_t)(u.x >> 16); vd[2 * 200] = (bf16_t)(u.y & 0xffff); vd[3 * 200] = (bf16_t)(u.y >> 16);
      vd[4 * 200] = (bf16_t)(u.z & 0xffff); vd[5 * 200] = (bf16_t)(u.z >> 16); vd[6 * 200] = (bf16_t)(u.w & 0xffff); vd[7 * 200] = (bf16_t)(u.w >> 16);
    }
    __syncthreads();
    const int unit = pi * 2 + uh;
    const int nb = unit & 63, h = (unit >> 6) & 7, b = (unit >> 9) & 7, br = unit >> 12;
    const int dsh = 2 * br, Mr = 4096 >> dsh;
    const int seg = (nb * 64) / Mr, segstart = seg * Mr, segend = segstart + Mr;
    const bool pv_ok = (nb * 64 - 64 >= segstart), nx_ok = (nb * 64 + 128 <= segend);
    const int qp = nb * 64 + mt * 16 + lr;
    const int qtok = b * 4096 + (((qp - segstart) << dsh) + seg);
    bf16x8 qf[2];
    qf[0] = *(const bf16x8*)(qr + (size_t)qtok * 512 + h * 64 + lq * 8);
    qf[1] = *(const bf16x8*)(qr + (size_t)qtok * 512 + h * 64 + 32 + lq * 8);
    if (pi + (int)gridDim.x < npairs) load_pair(pi + gridDim.x);
    f32x4 sacc[12];
#pragma unroll
    for (int kt = 0; kt < 12; ++kt) {
      const int key = kt * 16 + lr;
      const bf16x8 k0 = *(const bf16x8*)(ul + key * 128 + ((lq ^ (key & 7)) * 16));
      const bf16x8 k1 = *(const bf16x8*)(ul + key * 128 + (((4 + lq) ^ (key & 7)) * 16));
      f32x4 a = (f32x4){0.f, 0.f, 0.f, 0.f};
      a = __builtin_amdgcn_mfma_f32_16x16x32_bf16(k0, qf[0], a, 0, 0, 0);
      a = __builtin_amdgcn_mfma_f32_16x16x32_bf16(k1, qf[1], a, 0, 0, 0);
      sacc[kt] = a;
    }
    const int qi = mt * 16 + lr;
    float mx = -1e30f;
#pragma unroll
    for (int kt = 0; kt < 12; ++kt) {
      const int kb = kt >> 2;
#pragma unroll
      for (int r = 0; r < 4; ++r) {
        const int kj = (kt & 3) * 16 + lq * 4 + r;
        bool ok = true;
        if (kb == 0) ok = pv_ok && (kj >= qi);
        if (kb == 2) ok = nx_ok && (kj <= qi);
        const float sv = ok ? sacc[kt][r] : -1e30f;
        sacc[kt][r] = sv;
        mx = fmaxf(mx, sv);
      }
    }
    mx = fmaxf(mx, __shfl_xor(mx, 16));
    mx = fmaxf(mx, __shfl_xor(mx, 32));
    float den = 0.f;
#pragma unroll
    for (int kt = 0; kt < 12; ++kt)
#pragma unroll
      for (int r = 0; r < 4; ++r) {
        const float pe = __expf(sacc[kt][r] - mx);
        sacc[kt][r] = pe;
        den += pe;
      }
    den += __shfl_xor(den, 16);
    den += __shfl_xor(den, 32);
    f32x4 oacc[4];
#pragma unroll
    for (int et = 0; et < 4; ++et) oacc[et] = (f32x4){0.f, 0.f, 0.f, 0.f};
#pragma unroll
    for (int t = 0; t < 6; ++t) {
      u32x4 pu;
      pu.x = pk2(sacc[2 * t][0], sacc[2 * t][1]); pu.y = pk2(sacc[2 * t][2], sacc[2 * t][3]);
      pu.z = pk2(sacc[2 * t + 1][0], sacc[2 * t + 1][1]); pu.w = pk2(sacc[2 * t + 1][2], sacc[2 * t + 1][3]);
      const bf16x8 pf = __builtin_bit_cast(bf16x8, pu);
#pragma unroll
      for (int et = 0; et < 4; ++et) {
        const char* vrow = ul + 24576 + (et * 16 + lr) * 400;
        const int sw = ((et * 2 + (lr >> 3)) & 7) << 2;
        const u32x2 v0 = *(const u32x2*)(vrow + (((2 * t) * 16 + lq * 4) ^ sw) * 2), v1 = *(const u32x2*)(vrow + (((2 * t + 1) * 16 + lq * 4) ^ sw) * 2);
        u32x4 vu;
        vu.x = v0.x; vu.y = v0.y; vu.z = v1.x; vu.w = v1.y;
        oacc[et] = __builtin_amdgcn_mfma_f32_16x16x32_bf16(__builtin_bit_cast(bf16x8, vu), pf, oacc[et], 0, 0, 0);
      }
    }
    float* np = num + ((size_t)br * MT + qtok) * 512 + h * 64 + lq * 4;
#pragma unroll
    for (int et = 0; et < 4; ++et) *(f32x4*)(np + et * 16) = oacc[et];
    if (lq == 0) {
      f32x2 o;
      o.x = mx; o.y = den;
      *(f32x2*)(md + (((size_t)br * MT + qtok) * 8 + h) * 2) = o;
    }
    __syncthreads();
  }
}

DEV void combineA(const P& p) {
  const float* num = (const float*)(p.ws + O_NUM);
  const float* md = (const float*)(p.ws + O_MD);
  bf16_t* ycat = (bf16_t*)(p.ws + O_YCAT);
  const int gt = blockIdx.x * NTHR + tidx(), ngt = gridDim.x * NTHR;
  for (int idx = gt; idx < MT * 128; idx += ngt) {
    const int e4 = idx & 15, h = (idx >> 4) & 7, tok = idx >> 7;
    f32x2 m0 = *(const f32x2*)(md + (((size_t)0 * MT + tok) * 8 + h) * 2);
    f32x2 m1 = *(const f32x2*)(md + (((size_t)1 * MT + tok) * 8 + h) * 2);
    f32x2 m2 = *(const f32x2*)(md + (((size_t)2 * MT + tok) * 8 + h) * 2);
    const float ma = fmaxf(m0.x, fmaxf(m1.x, m2.x));
    const float e0 = __expf(m0.x - ma), e1 = __expf(m1.x - ma), e2 = __expf(m2.x - ma);
    const float dn = e0 * m0.y + e1 * m1.y + e2 * m2.y;
    const f32x4 n0 = *(const f32x4*)(num + ((size_t)0 * MT + tok) * 512 + h * 64 + e4 * 4);
    const f32x4 n1 = *(const f32x4*)(num + ((size_t)1 * MT + tok) * 512 + h * 64 + e4 * 4);
    const f32x4 n2 = *(const f32x4*)(num + ((size_t)2 * MT + tok) * 512 + h * 64 + e4 * 4);
    const f32x4 o = (n0 * e0 + n1 * e1 + n2 * e2) * (1.f / dn);
    u32x2 pk;
    pk.x = pk2(o[0], o[1]); pk.y = pk2(o[2], o[3]);
    *(u32x2*)(ycat + (size_t)tok * 1024 + 512 + h * 64 + e4 * 4) = pk;
  }
}

DEV float dpp_allreduce16(float x) {
  x += __int_as_float(__builtin_amdgcn_update_dpp(0, __float_as_int(x), 0xB1, 0xF, 0xF, true));
  x += __int_as_float(__builtin_amdgcn_update_dpp(0, __float_as_int(x), 0x4E, 0xF, 0xF, true));
  x += __int_as_float(__builtin_amdgcn_update_dpp(0, __float_as_int(x), 0x141, 0xF, 0xF, true));
  x += __int_as_float(__builtin_amdgcn_update_dpp(0, __float_as_int(x), 0x140, 0xF, 0xF, true));
  return x;
}

DEV void scan_phase(char* lds, const P& p) {
  const bf16_t* omw = (const bf16_t*)(p.ws + O_OMW);
  const bf16_t* kd = (const bf16_t*)(p.ws + O_KD);
  const bf16_t* kka = (const bf16_t*)(p.ws + O_KKA);
  const bf16_t* kk = (const bf16_t*)(p.ws + O_KK);
  const bf16_t* za = (const bf16_t*)p.out;
  float* Y = (float*)(p.ws + O_Y);
  float* inb = (float*)lds;
  float* ypart = (float*)(lds + 98304);
  const int tid = tidx(), w = tid >> 6, lane = tid & 63, rg = lane >> 4, jl = lane & 15, j0 = jl * 4;
  for (int it = blockIdx.x; it < 256; it += gridDim.x) {
    const int sc = it >> 1, half = it & 1, d = sc >> 6, b = (sc >> 3) & 7, h = sc & 7;
    if (w >= 4) {
      const int lt = tid - 256;
      const bf16_t* src[6];
      int dsto[6], stepi[6], isw[6];
#pragma unroll
      for (int q = 0; q < 6; ++q) {
        const int pid = lt + q * 256, i = pid / 48, rem = pid % 48, arr = rem >> 3, pc = rem & 7;
        const bf16_t* base;
        size_t ld;
        if (arr == 0) { base = omw + (size_t)d * MT * 512 + h * 64; ld = 512; }
        else if (arr == 1) { base = kd + (size_t)d * MT * 512 + h * 64; ld = 512; }
        else if (arr == 2) { base = kka + (size_t)d * MT * 512 + h * 64; ld = 512; }
        else if (arr == 3) { base = kk + h * 64; ld = 512; }
        else if (arr == 4) { base = za + h * 64; ld = 2048; }
        else { base = za + 1024 + h * 64; ld = 2048; }
        const int t0 = d ? (4095 - i) : i;
        src[q] = base + ((size_t)(b * 4096 + t0)) * ld + pc * 8;
        stepi[q] = (int)ld * 32 * (d ? -1 : 1);
        dsto[q] = i * 384 + arr * 64 + pc * 8;
        isw[q] = (arr == 0);
      }
      u32x4 rr[6];
#pragma unroll
      for (int q = 0; q < 6; ++q) rr[q] = *(const u32x4*)(src[q]);
#pragma unroll
      for (int q = 0; q < 6; ++q) {
        float f[8];
        unpack8(rr[q], f);
        if (isw[q]) { for (int i = 0; i < 8; ++i) f[i] = 1.f - f[i]; }
        *(f32x4*)(inb + dsto[q]) = (f32x4){f[0], f[1], f[2], f[3]};
        *(f32x4*)(inb + dsto[q] + 4) = (f32x4){f[4], f[5], f[6], f[7]};
      }
#pragma unroll
      for (int q = 0; q < 6; ++q) rr[q] = *(const u32x4*)(src[q] + (ptrdiff_t)stepi[q]);
      __syncthreads();
      for (int c = 0; c < 128; ++c) {
        if (c + 1 < 128) {
          float* nb_ = inb + ((c + 1) & 1) * 12288;
#pragma unroll
          for (int q = 0; q < 6; ++q) {
            float f[8];
            unpack8(rr[q], f);
            if (isw[q]) { for (int i = 0; i < 8; ++i) f[i] = 1.f - f[i]; }
            *(f32x4*)(nb_ + dsto[q]) = (f32x4){f[0], f[1], f[2], f[3]};
            *(f32x4*)(nb_ + dsto[q] + 4) = (f32x4){f[4], f[5], f[6], f[7]};
          }
        }
        if (c + 2 < 128) {
#pragma unroll
          for (int q = 0; q < 6; ++q) rr[q] = *(const u32x4*)(src[q] + (ptrdiff_t)stepi[q] * (c + 2));
        }
        if (c > 0) {
          const int cc = c - 1, idx = lt * 4, i = idx >> 5, rl = idx & 31;
          const int t = d ? (4095 - (cc * 32 + i)) : (cc * 32 + i);
          const float* q = ypart + (cc & 1) * 4096 + i * 128 + rl;
          const f32x4 o = (*(const f32x4*)q + *(const f32x4*)(q + 32)) + (*(const f32x4*)(q + 64) + *(const f32x4*)(q + 96));
          *(f32x4*)(Y + ((size_t)d * MT + b * 4096 + t) * 512 + h * 64 + half * 32 + rl) = o;
        }
        __syncthreads();
      }
      {
        const int cc = 127, idx = lt * 4, i = idx >> 5, rl = idx & 31;
        const int t = d ? (4095 - (cc * 32 + i)) : (cc * 32 + i);
        const float* q = ypart + (cc & 1) * 4096 + i * 128 + rl;
        const f32x4 o = (*(const f32x4*)q + *(const f32x4*)(q + 32)) + (*(const f32x4*)(q + 64) + *(const f32x4*)(q + 96));
        *(f32x4*)(Y + ((size_t)d * MT + b * 4096 + t) * 512 + h * 64 + half * 32 + rl) = o;
      }
    } else {
      const int rowl = w * 8 + rg * 2, row = half * 32 + rowl;
      f32x2 a01 = (f32x2){0.f, 0.f}, a23 = a01, b01 = a01, b23 = a01;
      __syncthreads();
      for (int c = 0; c < 128; ++c) {
        const float* cur = inb + (c & 1) * 12288;
        float* yp = ypart + (c & 1) * 4096 + (jl >> 2) * 32 + rowl;
        f32x4 w4 = *(const f32x4*)(cur + j0), kd4 = *(const f32x4*)(cur + 64 + j0), ka4 = *(const f32x4*)(cur + 128 + j0),
              kk4 = *(const f32x4*)(cur + 192 + j0), r4 = *(const f32x4*)(cur + 256 + j0);
        f32x2 v2 = *(const f32x2*)(cur + 320 + row);
#pragma unroll 8
        for (int i = 0; i < 32; ++i) {
          const float* sn = cur + ((i + 1) & 31) * 384;
          const f32x4 nw4 = *(const f32x4*)(sn + j0), nkd4 = *(const f32x4*)(sn + 64 + j0), nka4 = *(const f32x4*)(sn + 128 + j0),
                      nkk4 = *(const f32x4*)(sn + 192 + j0), nr4 = *(const f32x4*)(sn + 256 + j0);
          const f32x2 nv2 = *(const f32x2*)(sn + 320 + row);
          const f32x2 ta = a01 * kk4.xy + a23 * kk4.zw, tb = b01 * kk4.xy + b23 * kk4.zw;
          const float ska = dpp_allreduce16(ta.x + ta.y), skb = dpp_allreduce16(tb.x + tb.y);
          a01 = a01 * w4.xy + (kd4.xy * v2.x - ka4.xy * ska);
          a23 = a23 * w4.zw + (kd4.zw * v2.x - ka4.zw * ska);
          b01 = b01 * w4.xy + (kd4.xy * v2.y - ka4.xy * skb);
          b23 = b23 * w4.zw + (kd4.zw * v2.y - ka4.zw * skb);
          const f32x2 ua = a01 * r4.xy + a23 * r4.zw, ub = b01 * r4.xy + b23 * r4.zw;
          f32x2 y;
          y.x = ua.x + ua.y; y.y = ub.x + ub.y;
          y.x += __int_as_float(__builtin_amdgcn_update_dpp(0, __float_as_int(y.x), 0xB1, 0xF, 0xF, true));
          y.y += __int_as_float(__builtin_amdgcn_update_dpp(0, __float_as_int(y.y), 0xB1, 0xF, 0xF, true));
          y.x += __int_as_float(__builtin_amdgcn_update_dpp(0, __float_as_int(y.x), 0x4E, 0xF, 0xF, true));
          y.y += __int_as_float(__builtin_amdgcn_update_dpp(0, __float_as_int(y.y), 0x4E, 0xF, 0xF, true));
          *(f32x2*)(yp + i * 128) = y;
          w4 = nw4; kd4 = nkd4; ka4 = nka4; kk4 = nkk4; r4 = nr4; v2 = nv2;
        }
        __syncthreads();
      }
    }
    __syncthreads();
  }
}

DEV void postB(const P& p) {
  const float* Y = (const float*)(p.ws + O_Y);
  const bf16_t* kd = (const bf16_t*)(p.ws + O_KD);
  const bf16_t* gg = (const bf16_t*)(p.ws + O_G);
  const bf16_t* za = (const bf16_t*)p.out;
  bf16_t* ycat = (bf16_t*)(p.ws + O_YCAT);
  const int lane = tidx() & 63, sub = lane >> 4, jl = lane & 15, gw = blockIdx.x * 8 + (tidx() >> 6), nw = gridDim.x * 8;
  for (int it = gw; it < MT * 2; it += nw) {
    const int item = it * 4 + sub, tok = item >> 3, h = item & 7, c = h * 64 + jl * 4;
    const f32x4 y0 = *(const f32x4*)(Y + (size_t)tok * 512 + c), y1 = *(const f32x4*)(Y + ((size_t)MT + tok) * 512 + c);
    const u32x2 k0 = *(const u32x2*)(kd + (size_t)tok * 512 + c), k1 = *(const u32x2*)(kd + ((size_t)MT + tok) * 512 + c);
    const u32x2 ru = *(const u32x2*)(za + (size_t)tok * 2048 + c), vu = *(const u32x2*)(za + (size_t)tok * 2048 + 1024 + c), gu = *(const u32x2*)(gg + (size_t)tok * 512 + c);
    const f32x4 lw = *(const f32x4*)(p.lnx_w + c), lb = *(const f32x4*)(p.lnx_b + c), rk = *(const f32x4*)(p.r_k + c);
    const f32x4 y = y0 + y1;
    const float mu = dpp_allreduce16((y[0] + y[1]) + (y[2] + y[3])) * (1.f / 64.f);
    const f32x4 dv = y - mu;
    const float var = dpp_allreduce16((dv[0] * dv[0] + dv[1] * dv[1]) + (dv[2] * dv[2] + dv[3] * dv[3])) * (1.f / 64.f);
    const float rs = rsqrtf(var + 64e-5f);
    const f32x4 r = (f32x4){lo16(ru.x), hi16(ru.x), lo16(ru.y), hi16(ru.y)}, v = (f32x4){lo16(vu.x), hi16(vu.x), lo16(vu.y), hi16(vu.y)};
    const f32x4 g = (f32x4){lo16(gu.x), hi16(gu.x), lo16(gu.y), hi16(gu.y)};
    const f32x4 kds = (f32x4){lo16(k0.x) + lo16(k1.x), hi16(k0.x) + hi16(k1.x), lo16(k0.y) + lo16(k1.y), hi16(k0.y) + hi16(k1.y)};
    const f32x4 t = r * kds * rk;
    const float bs = dpp_allreduce16((t[0] + t[1]) + (t[2] + t[3]));
    const f32x4 o = (dv * rs * lw + lb + v * bs) * g;
    u32x2 pk;
    pk.x = pk2(o[0], o[1]); pk.y = pk2(o[2], o[3]);
    *(u32x2*)(ycat + (size_t)tok * 1024 + c) = pk;
  }
}

DEV void glu_fixup(const P& p, int l) {
  const bf16_t* sb = (const bf16_t*)(p.ws + O_SB);
  bf16_t* act = (bf16_t*)(p.ws + O_ACT);
  const float* cw = p.ffn_conv + (size_t)l * 3 * 5632;
  const int gt = blockIdx.x * NTHR + tidx(), ngt = gridDim.x * NTHR;
  for (int item = gt; item < 512 * 2 * 352; item += ngt) {
    const int strip = item / 704, rem = item - strip * 704, e = rem / 352, c8 = (rem - e * 352) * 8;
    const int R = strip * 64 + (e ? 63 : 0), s = R & 4095;
    const int colg = (c8 >> 7) * 256 + (c8 & 127);
    const bf16_t* pc = sb + ((size_t)strip * 4 + (e ? 3 : 0)) * 5632 + colg;
    const bf16_t* pp = e ? (pc - 5632) : (pc - 5632);
    const bf16_t* pn = e ? (pc + 5632) : (pc + 5632);
    const u32x4 z0 = (u32x4){0u, 0u, 0u, 0u};
    const bool hasp = e ? true : (s > 0), hasn = e ? (s < 4095) : true;
    float gm[8], gc[8], gn[8], vm[8], vc[8], vn[8], o[8];
    unpack8(hasp ? *(const u32x4*)pp : z0, gm); unpack8(hasp ? *(const u32x4*)(pp + 128) : z0, vm);
    unpack8(*(const u32x4*)pc, gc); unpack8(*(const u32x4*)(pc + 128), vc);
    unpack8(hasn ? *(const u32x4*)pn : z0, gn); unpack8(hasn ? *(const u32x4*)(pn + 128) : z0, vn);
#pragma unroll
    for (int i = 0; i < 8; ++i) {
      const float g = gm[i] * cw[c8 + i] + gc[i] * cw[5632 + c8 + i] + gn[i] * cw[11264 + c8 + i];
      const float vv = vm[i] * cw[2816 + c8 + i] + vc[i] * cw[5632 + 2816 + c8 + i] + vn[i] * cw[11264 + 2816 + c8 + i];
      const float u2 = -1.5957691216057308f * (g + 0.044715f * g * g * g);
      o[i] = g * __builtin_amdgcn_rcpf(1.f + __expf(u2)) * vv;
    }
    *(u32x4*)(act + (size_t)R * 2816 + c8) = pack8(o);
  }
}

template <class Epi>
DEV void gemm_grid(char* lds, const bf16_t* A, int lda, const bf16_t* Bt, int ldb, int K, int tilesM, int tilesN, const Epi& epi) {
  const int nt = tilesM * tilesN;
  for (int t = blockIdx.x; t < nt; t += gridDim.x) {
    const int tm = t / tilesN, tn = t % tilesN;
    gemm_tile(lds, A + (size_t)tm * 256 * lda, lda, Bt + (size_t)tn * 128 * ldb, ldb, K, tm * 256, tn * 128, epi);
  }
}


DEV void dft_fold(const P& p) {
  const bf16_t* CST = (const bf16_t*)(p.ws + O_CST);
  bf16_t* CF = (bf16_t*)(p.ws + O_CSTF);
  for (int idx = blockIdx.x * NTHR + tidx(); idx < 16384 * 256; idx += gridDim.x * NTHR) {
    const int r = idx >> 8, s8 = (idx & 255) * 8, eo = (r >> 10) & 1;
    const bf16_t* src = CST + (size_t)r * 4096;
    float a[8], bq[8], o[8];
    unpack8(*(const u32x4*)(src + s8), a);
    if (s8 == 0) {
      unpack8(*(const u32x4*)(src + 4088), bq);
      o[0] = eo ? 0.f : a[0];
#pragma unroll
      for (int i = 1; i < 8; ++i) o[i] = eo ? (a[i] - bq[8 - i]) : (a[i] + bq[8 - i]);
      if (!eo) ((float*)(p.ws + O_C2048))[(r >> 11) * 1024 + (r & 1023)] = bf2f(src[2048]) * (1.f / 64.f);
    } else {
      unpack8(*(const u32x4*)(src + 4096 - s8 - 8), bq);
      const float b0 = bf2f(src[4096 - s8]);
      o[0] = eo ? (a[0] - b0) : (a[0] + b0);
#pragma unroll
      for (int i = 1; i < 8; ++i) o[i] = eo ? (a[i] - bq[8 - i]) : (a[i] + bq[8 - i]);
    }
    *(u32x4*)(CF + (size_t)r * 2048 + s8) = pack8(o);
  }
}

DEV void dft_combine(const P& p) {
  const bf16_t* EO = (const bf16_t*)(p.ws + O_EO);
  const bf16_t* CST = (const bf16_t*)(p.ws + O_CST);
  bf16_t* f = (bf16_t*)(p.ws + O_F);
  for (int idx = blockIdx.x * NTHR + tidx(); idx < 8 * 2048 * 256; idx += gridDim.x * NTHR) {
    const int c4 = (idx & 255) * 4, k1 = (idx >> 8) & 2047, b = idx >> 19;
    const u32x2 eu = *(const u32x2*)(EO + ((size_t)(b * 2) * 2048 + k1) * 1024 + c4), ou = *(const u32x2*)(EO + ((size_t)(b * 2 + 1) * 2048 + k1) * 1024 + c4);
    f32x4 e = (f32x4){lo16(eu.x), hi16(eu.x), lo16(eu.y), hi16(eu.y)};
    const f32x4 o = (f32x4){lo16(ou.x), hi16(ou.x), lo16(ou.y), hi16(ou.y)};
    {
      const f32x4 cm = *(const f32x4*)((const float*)(p.ws + O_C2048) + b * 1024 + c4);
      e = (k1 & 1) ? (e - cm) : (e + cm);
    }
    const f32x4 d = e - o, s = e + o;
    u32x2 pk;
    pk.x = pk2(d[0], d[1]); pk.y = pk2(d[2], d[3]);
    *(u32x2*)(f + ((size_t)b * 4096 + k1) * 1024 + c4) = pk;
    if (k1 > 0) {
      pk.x = pk2(s[0], s[1]); pk.y = pk2(s[2], s[3]);
      *(u32x2*)(f + ((size_t)b * 4096 + 4096 - k1) * 1024 + c4) = pk;
    }
  }
  {
    const int lane = tidx() & 63, gw = blockIdx.x * 8 + (tidx() >> 6), nw = gridDim.x * 8;
    for (int r = gw; r < 8 * 1024; r += nw) {
      const int b = r >> 10, n = r & 1023;
      const bf16_t* cp = CST + ((size_t)(b * 2) * 1024 + n) * 4096;
      float acc = 0.f;
#pragma unroll
      for (int j = 0; j < 8; ++j) {
        const u32x4 u = *(const u32x4*)(cp + j * 512 + lane * 8);
        acc += (lo16(u.x) - hi16(u.x)) + (lo16(u.y) - hi16(u.y)) + (lo16(u.z) - hi16(u.z)) + (lo16(u.w) - hi16(u.w));
      }
      acc = wave_sum(acc);
      if (lane == 0) f[((size_t)b * 4096 + 2048) * 1024 + n] = f2bf(acc * (1.f / 64.f));
    }
  }
}

#define LDSP ((PG8_LAS unsigned char*)lds)
template <class Epi>
DEV void pgemm(char* lds, const bf16_t* A, const bf16_t* Bt, int M_, int N_, int K_, const Epi& E) {
  pg8::Gemm g{A, Bt, M_, N_, K_};
  pg8::StaticOrder S;
  S.init(M_, N_, (int)gridDim.x, (int)blockIdx.x);
  pg8::gemm_phase<Epi, pg8::StaticOrder, true, true>(LDSP, g, S, E);
}

DEV void ffn(char* lds, const XcdBarrier& xbar, const P& p, int l) {
  const bf16_t* h = (const bf16_t*)(p.ws + O_H);
  bf16_t* act = (bf16_t*)(p.ws + O_ACT);
  bf16_t* yf = (bf16_t*)(p.ws + O_YF);
  const bf16_t* upt = (const bf16_t*)(p.ws + W_UP) + (size_t)l * 5632 * 1024;
  const bf16_t* dnt = (const bf16_t*)(p.ws + W_DOWN) + (size_t)l * 1024 * 2816;
  pgemm(lds, h, upt, MT, 5632, 1024, pg8::PEpiGlu{act, (bf16_t*)(p.ws + O_SB), p.ffn_conv + (size_t)l * 3 * 5632});
  xcd_barrier(xbar);
  glu_fixup(p, l);
  xcd_barrier(xbar);
  pgemm(lds, act, dnt, MT, 1024, 2816, pg8::PEpiBf16<false>{yf, 1024});
  xcd_barrier(xbar);
}

DEV const P& kargs() {
  auto q = __builtin_amdgcn_kernarg_segment_ptr();
  asm volatile("" : "+s"(q));
  return *(const P*)q;
}
#define p (kargs())
__global__ void __launch_bounds__(NTHR) mega(P parg_unused) {
  extern __shared__ __attribute__((aligned(16))) char lds[];
  cg::grid_group grid = cg::this_grid();
  char* ws = p.ws;
  if (tidx() < 4) ((unsigned*)(lds + 131072))[tidx()] = 0u;
  __syncthreads();
  const XcdBarrier xbar = xcd_barrier_post((unsigned*)(ws + W_BAR), (volatile XLAS unsigned*)(lds + 131072));
  float* mod = (float*)(ws + W_MOD);
  const int gt = blockIdx.x * NTHR + tidx(), ngt = gridDim.x * NTHR;

  for (int rep_ = 0; rep_ < REP_PRO; ++rep_) {
  if (rep_ > 0) xcd_barrier(xbar);
  compute_mod(lds, p);
  transpose_convert(lds, p.mix_in, 1024, 3584, (bf16_t*)(ws + W_MIXIN), 1024, 0);
  for (int l = 0; l < 2; ++l) {
    transpose_convert(lds, p.ffn_up + (size_t)l * 1024 * 5632, 1024, 5632, (bf16_t*)(ws + W_UP) + (size_t)l * 5632 * 1024, 1024, 64 * l, true);
    transpose_convert(lds, p.ffn_down + (size_t)l * 2816 * 1024, 2816, 1024, (bf16_t*)(ws + W_DOWN) + (size_t)l * 1024 * 2816, 2816, 128 + 64 * l);
  }
  transpose_convert(lds, p.mix_out, 1024, 1024, (bf16_t*)(ws + W_MIXOUT), 1024, 32);
  transpose_convert(lds, p.fnet_w, 1024, 1024, (bf16_t*)(ws + W_FNET), 1024, 96);
  for (int d = 0; d < 2; ++d) {
    transpose_convert(lds, p.w1 + (size_t)d * 512 * 64, 512, 64, (bf16_t*)(ws + W_L1) + (size_t)(d * 64) * 512, 512, 8 * d);
    transpose_convert(lds, p.a1 + (size_t)d * 512 * 64, 512, 64, (bf16_t*)(ws + W_L1) + (size_t)(128 + d * 64) * 512, 512, 16 + 8 * d);
    transpose_convert(lds, p.w2 + (size_t)d * 64 * 512, 64, 512, (bf16_t*)(ws + W_W2) + (size_t)d * 512 * 64, 64, 48 + 8 * d);
    transpose_convert(lds, p.a2 + (size_t)d * 64 * 512, 64, 512, (bf16_t*)(ws + W_A2) + (size_t)d * 512 * 64, 64, 64 + 8 * d);
  }
  transpose_convert(lds, p.g1, 512, 128, (bf16_t*)(ws + W_L1) + (size_t)256 * 512, 512, 32);
  transpose_convert(lds, p.g2, 128, 512, (bf16_t*)(ws + W_G2), 128, 80);
  {
    float* rope = (float*)(ws + W_ROPE);
    for (int idx = gt; idx < 4096 * 32; idx += ngt) {
      const int s = idx >> 5, e = idx & 31;
      const float inv = powf(10000.f, -(float)e / 32.f);
      const float ang = (float)s * inv;
      float sv, cv;
      sincosf(ang, &sv, &cv);
      rope[2 * idx] = cv;
      rope[2 * idx + 1] = sv;
    }
    bf16_t* dftc = (bf16_t*)(ws + W_DFTC);
    for (int idx = gt; idx < 256 * 128; idx += ngt) {
      const int n = idx >> 7, c = idx & 127, k2 = n & 127;
      const float ph = (float)((k2 * c) & 127) * (1.f / 64.f);
      const float v = (n < 128) ? cospif(ph) : sinpif(ph);
      dftc[idx] = f2bf(v * 0.08838834764831845f);
    }
  }
  }
  grid.sync();
  for (int rep_ = 0; rep_ < REP_ROW; ++rep_) { rowpass<false, true>(p.x, nullptr, nullptr, nullptr, nullptr, p.norm_g, mod + 1024, mod, (bf16_t*)(ws + O_H0)); xcd_barrier(xbar); }
  pgemm(lds, (const bf16_t*)(ws + O_H0), (const bf16_t*)(ws + W_MIXIN), MT, INC, 1024, pg8::PEpiBf16<false>{(bf16_t*)(ws + O_Z), INC});
  xcd_barrier(xbar);
  for (int rep_ = 0; rep_ < REP_PREP; ++rep_) { prep1(p); xcd_barrier(xbar); }
  for (int rep_ = 0; rep_ < REP_ATT; ++rep_) { attention(lds, p); xcd_barrier(xbar); }
  combineA(p);
  gemm_grid(lds, (const bf16_t*)p.out + 1536, 2048, (const bf16_t*)(ws + W_L1), 512, 512, 128, 3, EpiLora1{(bf16_t*)(ws + O_L1)});
  xcd_barrier(xbar);
  for (int rep_ = 0; rep_ < REP_LORA; ++rep_) {
  for (int d = 0; d < 2; ++d) {
    gemm_grid(lds, (const bf16_t*)(ws + O_L1) + d * 64, 384, (const bf16_t*)(ws + W_W2) + (size_t)d * 512 * 64, 64, 64, 128, 4,
              EpiDecay{(bf16_t*)(ws + O_OMW) + (size_t)d * MT * 512, p.w0 + d * 512});
    gemm_grid(lds, (const bf16_t*)(ws + O_L1) + 128 + d * 64, 384, (const bf16_t*)(ws + W_A2) + (size_t)d * 512 * 64, 64, 64, 128, 4,
              EpiA{(bf16_t*)(ws + O_KD) + (size_t)d * MT * 512, (bf16_t*)(ws + O_KKA) + (size_t)d * MT * 512, (bf16_t*)(ws + O_KK), p.a0 + d * 512,
                   p.k_k, p.k_a, (const bf16_t*)p.out, d == 0});
  }
  gemm_grid(lds, (const bf16_t*)(ws + O_L1) + 256, 384, (const bf16_t*)(ws + W_G2), 128, 128, 128, 4, EpiBf16{(bf16_t*)(ws + O_G), 512});
  xcd_barrier(xbar);
  }
  for (int rep_ = 0; rep_ < REP_SCAN; ++rep_) { scan_phase(lds, p); xcd_barrier(xbar); }
  for (int rep_ = 0; rep_ < REP_SYNC; ++rep_) xcd_barrier(xbar);
  postB(p);
  xcd_barrier(xbar);
  pgemm(lds, (const bf16_t*)(ws + O_YCAT), (const bf16_t*)(ws + W_MIXOUT), MT, 1024, 1024, pg8::PEpiBf16<false>{(bf16_t*)(ws + O_YF), 1024});
  xcd_barrier(xbar);
  rowpass<true, true, false, true>(p.x, (const bf16_t*)(ws + O_YF), p.norm_g + 1024, mod + 2048, ws + O_XB, p.norm_g + 2048, mod + 4096, mod + 3072, (bf16_t*)(ws + O_H));
  xcd_barrier(xbar);
  ffn(lds, xbar, p, 0);
  {
    const float* mod1 = mod + 8 * 6144;
    rowpass<true, true, true, true>(ws + O_XB, (const bf16_t*)(ws + O_YF), p.norm_g + 3072, mod + 5120, ws + O_XB, p.norm_g + 4096, mod1 + 1024, mod1, (bf16_t*)(ws + O_H));
    bf16_t* cs = (bf16_t*)(ws + O_COSSIN);
    for (int idx = blockIdx.x * NTHR + tidx(); idx < 4096 * 256; idx += gridDim.x * NTHR) {
      const int rr = idx >> 8, s8 = (idx & 255) * 8, k1 = rr & 2047;
      float o[8];
#pragma unroll
      for (int i = 0; i < 8; ++i) {
        const float ph = (float)((k1 * (s8 + i)) & 4095) * (1.f / 2048.f);
        o[i] = ((rr < 2048) ? cospif(ph) : sinpif(ph)) * (1.f / 64.f);
      }
      *(u32x4*)(cs + (size_t)rr * 2048 + s8) = pack8(o);
    }
    xcd_barrier(xbar);
    for (int t = blockIdx.x; t < 8 * 256; t += gridDim.x) {
      const int g = t >> 8, tn = t & 255;
      gemm_tile(lds, (const bf16_t*)(ws + W_DFTC), 128, (const bf16_t*)(ws + O_H) + (size_t)tn * 128 * 1024 + g * 128, 1024, 128, 0, tn * 128,
                EpiDftc{(bf16_t*)(ws + O_CST), g});
    }
    xcd_barrier(xbar);
    dft_fold(p);
    xcd_barrier(xbar);
    {
      pg8::Gemm g{(const bf16_t*)(ws + O_COSSIN), (const bf16_t*)(ws + O_CSTF), 4096, 16384, 2048};
      pg8::BatchOrder S{(int)gridDim.x, (int)blockIdx.x};
      pg8::gemm_phase<pg8::PEpiF32B, pg8::BatchOrder, true, true>(LDSP, g, S, pg8::PEpiF32B{(bf16_t*)(ws + O_EO)});
    }
    xcd_barrier(xbar);
    dft_combine(p);
    xcd_barrier(xbar);
    pgemm(lds, (const bf16_t*)(ws + O_F), (const bf16_t*)(ws + W_FNET), MT, 1024, 1024, pg8::PEpiBf16<false>{(bf16_t*)(ws + O_YF), 1024});
    xcd_barrier(xbar);
    rowpass<true, true, true, true>(ws + O_XB, (const bf16_t*)(ws + O_YF), p.norm_g + 4096 + 1024, mod1 + 2048, ws + O_XB, p.norm_g + 4096 + 2048, mod1 + 4096, mod1 + 3072,
                        (bf16_t*)(ws + O_H));
    xcd_barrier(xbar);
    ffn(lds, xbar, p, 1);
    rowpass<true, false, true, false>(ws + O_XB, (const bf16_t*)(ws + O_YF), p.norm_g + 4096 + 3072, mod1 + 5120, p.out, nullptr, nullptr, nullptr, nullptr);
  }
}

#undef p
extern "C" void kernel_launch(void* const* d_in, const int* in_sizes, int n_in, void* d_out, int out_size, void* d_ws, size_t ws_size,
                              hipStream_t stream) {
  static int grid_blocks = 0;
  if (!grid_blocks) {
    int dev = 0, cus = 0, per_cu = 0;
    hipGetDevice(&dev);
    hipDeviceGetAttribute(&cus, hipDeviceAttributeMultiprocessorCount, dev);
    hipFuncSetAttribute((const void*)mega, hipFuncAttributeMaxDynamicSharedMemorySize, LDS_BYTES);
    hipOccupancyMaxActiveBlocksPerMultiprocessor(&per_cu, (const void*)mega, NTHR, LDS_BYTES);
    if (per_cu < 1) { fprintf(stderr, "occupancy query returned %d\n", per_cu); per_cu = 1; }
    if (per_cu > 1) per_cu = 1;
    grid_blocks = cus * per_cu;
  }
  P p{};
  const float** pp = (const float**)&p;
  for (int i = 0; i < 25; ++i) pp[i] = (const float*)d_in[i];
  p.out = (float*)d_out;
  p.ws = (char*)d_ws;
  (void)hipMemsetAsync((char*)d_ws + W_BAR, 0, XCD_BAR_WORDS * sizeof(unsigned), stream);
  void* args[] = {&p};
  hipError_t e = hipLaunchCooperativeKernel((const void*)mega, dim3(grid_blocks), dim3(NTHR), args, LDS_BYTES, stream);
  if (e != hipSuccess) fprintf(stderr, "cooperative launch failed: %s (grid %d)\n", hipGetErrorString(e), grid_blocks);
}
```

```cpp
#include <hip/hip_runtime.h>
#include <hip/hip_cooperative_groups.h>
#include <stdint.h>
#include <cstdio>
namespace cg = cooperative_groups;

typedef unsigned short bf16_t;
typedef short bf16x8 __attribute__((ext_vector_type(8)));
typedef short s16x4 __attribute__((ext_vector_type(4)));
typedef float f32x4 __attribute__((ext_vector_type(4)));
typedef float f32x2 __attribute__((ext_vector_type(2)));
typedef unsigned u32x4 __attribute__((ext_vector_type(4)));
typedef unsigned u32x2 __attribute__((ext_vector_type(2)));

#define DEV __device__ __forceinline__
__device__ __forceinline__ int tidx() { int t = threadIdx.x; asm volatile("" : "+v"(t)); return t; }

constexpr int NB = 8, SEQ = 4096, DM = 1024, MT = NB * SEQ, DFF = 2816, INC = 3584;
constexpr size_t MiB = 1024 * 1024;
constexpr int NTHR = 512;
constexpr int LDS_BYTES = 131072 + 16;
constexpr size_t W_BAR = 47 * 1024 * 1024;
#ifndef REP_SCAN
#define REP_SCAN 1
#endif
#ifndef REP_ATT
#define REP_ATT 1
#endif
#ifndef REP_SYNC
#define REP_SYNC 0
#endif
#ifndef REP_PREP
#define REP_PREP 1
#endif
#ifndef REP_LORA
#define REP_LORA 1
#endif
#ifndef REP_GLU
#define REP_GLU 1
#endif
#ifndef REP_PRO
#define REP_PRO 1
#endif
#ifndef REP_ROW
#define REP_ROW 1
#endif

constexpr size_t W_MIXIN = 0;
constexpr size_t W_UP = 7 * MiB;
constexpr size_t W_DOWN = 29 * MiB;
constexpr size_t W_MIXOUT = 40 * MiB;
constexpr size_t W_FNET = 42 * MiB;
constexpr size_t W_L1 = 44 * MiB;
constexpr size_t W_W2 = W_L1 + 512 * 1024;
constexpr size_t W_A2 = W_W2 + 128 * 1024;
constexpr size_t W_G2 = W_A2 + 128 * 1024;
constexpr size_t W_DFTC = W_G2 + 128 * 1024;
constexpr size_t W_MOD = 45 * MiB;
constexpr size_t W_ROPE = 46 * MiB;
constexpr size_t R0 = 48 * MiB;
constexpr size_t O_H0 = R0;
constexpr size_t O_Z = 112 * MiB;
constexpr size_t O_QR = 336 * MiB, O_KR = 368 * MiB, O_VT = 400 * MiB;
constexpr size_t O_NUM = R0;
constexpr size_t O_MD = 240 * MiB;
constexpr size_t O_YCAT = 448 * MiB;
constexpr size_t O_OMW = 48 * MiB, O_KD = 112 * MiB, O_KKA = 176 * MiB, O_KK = 240 * MiB, O_G = 272 * MiB, O_L1 = 304 * MiB, O_Y = 304 * MiB;
constexpr size_t O_YF = 48 * MiB;
constexpr size_t O_H = 176 * MiB;
constexpr size_t O_ZF = 240 * MiB;
constexpr size_t O_ACT = 240 * MiB;
constexpr size_t O_SB = 416 * MiB;
constexpr size_t O_COSSIN = 240 * MiB;
constexpr size_t O_CST = 304 * MiB;
constexpr size_t O_F = 432 * MiB;
constexpr size_t O_CSTF = 432 * MiB;
constexpr size_t O_C2048 = 272 * MiB;
constexpr size_t O_EO = 48 * MiB;
constexpr size_t O_XB = 112 * MiB;

struct P {
  const float *x, *c, *ada_w, *ada_b, *norm_g, *mix_in, *mix_conv, *w0, *w1, *w2, *a0, *a1, *a2, *g1, *g2, *k_k, *k_a, *r_k, *lnx_w,
      *lnx_b, *mix_out, *fnet_w, *ffn_up, *ffn_conv, *ffn_down;
  float* out;
  char* ws;
};

DEV float bf2f(bf16_t h) { return __uint_as_float(((unsigned)h) << 16); }
DEV bf16_t f2bf(float f) {
  unsigned u = __float_as_uint(f);
  u += 0x7fffu + ((u >> 16) & 1u);
  return (bf16_t)(u >> 16);
}
DEV unsigned pk2(float a, float b) { return (unsigned)f2bf(a) | ((unsigned)f2bf(b) << 16); }
DEV float lo16(unsigned u) { return __uint_as_float(u << 16); }
DEV float hi16(unsigned u) { return __uint_as_float(u & 0xffff0000u); }
DEV float wave_sum(float v) {
#pragma unroll
  for (int o = 32; o; o >>= 1) v += __shfl_xor(v, o);
  return v;
}
DEV float sigmoidf_(float x) { return __builtin_amdgcn_rcpf(1.f + __expf(-x)); }

#include <cstdint>
#include <cstdlib>
#include <vector>

#define XB_TMO      128
#define XB_XCNT(j)  (256  + 64 * (j))
#define XB_XSUB(j)  (1280 + 64 * (j))
#define XB_XGEN(j)  (2304 + 64 * (j))
#define XB_TOP      3328
#define XB_TOPGEN   3392
#define XCD_BAR_WORDS 3456
#define XB_SPIN_CAP (1u << 18)
#define XLAS __attribute__((address_space(3)))

__device__ __forceinline__ unsigned xb_ld(unsigned* p)              { return __hip_atomic_load(p, __ATOMIC_RELAXED, __HIP_MEMORY_SCOPE_AGENT); }
__device__ __forceinline__ unsigned xb_add(unsigned* p, unsigned v) { return __hip_atomic_fetch_add(p, v, __ATOMIC_RELAXED, __HIP_MEMORY_SCOPE_AGENT); }
__device__ __forceinline__ unsigned xb_xcc_id() { return (unsigned)__builtin_amdgcn_s_getreg((3 << 11) | 20) & 0xFu; }
#define XB_SPIN(cond, bar) do { unsigned _sp = 0; while (cond) { __builtin_amdgcn_s_sleep(1); \
    if ((++_sp & 255u) == 0u) { if (xb_ld(&(bar)[XB_TMO])) break; if (_sp > XB_SPIN_CAP) { atomicAdd(&(bar)[XB_TMO], 1u); break; } } } } while (0)

struct XcdBarrier {
    unsigned* bar; unsigned x;
    volatile XLAS unsigned* st;
};

__device__ __forceinline__ XcdBarrier xcd_barrier_post(unsigned* bar, volatile XLAS unsigned* st) {
    XcdBarrier b; b.bar = bar; b.x = xb_xcc_id(); b.st = st;
    if (threadIdx.x == 0) (void)xb_add(&bar[XB_XCNT(b.x)], 1u);
    return b;
}
__device__ __forceinline__ void xcd_barrier_complete(unsigned* bar, unsigned x, unsigned& nloc, unsigned& nx) {
    const unsigned G = gridDim.x * gridDim.y * gridDim.z;
    unsigned sum, cnt, mine, sp = 0u;
    for (;;) {
        sum = 0u; cnt = 0u; mine = 0u;
#pragma unroll
        for (unsigned j = 0; j < 16; ++j) { const unsigned c = xb_ld(&bar[XB_XCNT(j)]); sum += c; cnt += (c > 0u) ? 1u : 0u; mine = (j == x) ? c : mine; }
        if (sum == G) break;
        __builtin_amdgcn_s_sleep(1);
        if ((++sp & 255u) == 0u) { if (xb_ld(&bar[XB_TMO])) break; if (sp > XB_SPIN_CAP) { atomicAdd(&bar[XB_TMO], 1u); break; } }
    }
    nloc = mine > 0u ? mine : 1u; nx = cnt > 0u ? cnt : 1u;
}

__device__ __forceinline__ void xcd_barrier(const XcdBarrier& b) {
    asm volatile("s_waitcnt vmcnt(0)" ::: "memory");
    __syncthreads();
    if (threadIdx.x == 0) {
        unsigned* bar = b.bar;
        __builtin_amdgcn_s_waitcnt(0);
        unsigned nloc = b.st[0], nx = b.st[1];
        if (nloc == 0u) { xcd_barrier_complete(bar, b.x, nloc, nx); b.st[0] = nloc; b.st[1] = nx; }
        const unsigned old = xb_add(&bar[XB_XSUB(b.x)], 1u);
        const unsigned gen = old / nloc;
        if (old + 1u == (gen + 1u) * nloc) {
            __builtin_amdgcn_fence(__ATOMIC_RELEASE, "agent");
            asm volatile("s_waitcnt vmcnt(0)" ::: "memory");
            const unsigned og = xb_add(&bar[XB_TOP], 1u);
            const unsigned tg = og / nx;
            if (og + 1u == (tg + 1u) * nx) xb_add(&bar[XB_TOPGEN], 1u);
            else XB_SPIN(xb_ld(&bar[XB_TOPGEN]) == tg, bar);
            __builtin_amdgcn_fence(__ATOMIC_ACQUIRE, "agent");
            xb_add(&bar[XB_XGEN(b.x)], 1u);
            asm volatile("s_waitcnt vmcnt(0)" ::: "memory");
        } else {
            XB_SPIN(xb_ld(&bar[XB_XGEN(b.x)]) == gen, bar);
            __builtin_amdgcn_fence(__ATOMIC_ACQUIRE, "agent");
            asm volatile("s_waitcnt vmcnt(0)" ::: "memory");
        }
    }
    __syncthreads();
}

namespace pg8 {
#define PG8_LAS __attribute__((address_space(3)))
typedef unsigned short bf16_t;
typedef short bf16x8 __attribute__((ext_vector_type(8)));
typedef float f32x4 __attribute__((ext_vector_type(4)));
typedef unsigned u32x4 __attribute__((ext_vector_type(4)));
constexpr int BM = 256, BK = 64, HALF = 128, HTB = HALF * BK * 2  , STAGE_BYTES = 8 * HTB, NXCD = 8, WGM = 8;

__host__ __device__ __forceinline__ int lds_byte(int r, int c) { const int st = (r >> 4) * 2 + (c >> 5), rr = r & 15, cc = c & 31, ob = rr * 64 + cc * 2; return st * 1024 + (ob ^ (((ob >> 9) & 1) << 5)); }
__host__ __device__ __forceinline__ void stage_rc(int b, int& R, int& C) { const int st = b / 1024, sb = b % 1024, swz = sb ^ (((sb >> 9) & 1) << 5); R = (st >> 1) * 16 + swz / 64; C = (st & 1) * 32 + (swz % 64) / 2; }
__host__ __device__ __forceinline__ int perm32(int rho) { const int n = rho >> 4, i = rho & 15; return 8 * (i >> 2) + 4 * n + (i & 3); }

struct Unit { int pm, pn; };
struct Gemm { const bf16_t* A; const bf16_t* Bt; int M, N, K; };

struct StaticOrder {
    int nM, nN, nwg, G, c;
    __host__ __device__ void init(int M, int N, int G_, int c_) { nM = M / BM; nN = N / BM; nwg = nM * nN; G = G_; c = c_; }
    __host__ __device__ bool next(int i, Unit& u) const {
        const long L = (long)i * G + c; if (L >= nwg) return false;
        int wgid = (int)L; { const int q = nwg / NXCD, r = nwg % NXCD, xcd = wgid % NXCD, off = wgid / NXCD; wgid = (xcd < r ? xcd * (q + 1) : r * (q + 1) + (xcd - r) * q) + off; }
        const int nig = WGM * nN, gid = wgid / nig, fm = gid * WGM, gsz = (nM - fm) < WGM ? (nM - fm) : WGM;
        u.pm = fm + ((wgid % nig) % gsz); u.pn = (wgid % nig) / gsz; return true;
    }
    __device__ __forceinline__ void a_ready(const Unit&) const {}
    __device__ __forceinline__ void done(const Unit&) const {}
};

__device__ __forceinline__ unsigned cvt_pk_bf16(float lo, float hi) { unsigned r; asm volatile("v_cvt_pk_bf16_f32 %0, %1, %2" : "=v"(r) : "v"(lo), "v"(hi)); return r; }

template <bool BATCHED> struct PEpiBf16 {
    static constexpr bool PERM = true, AFTER_DRAIN = false;
    bf16_t* O; int ldc;
    __device__ __forceinline__ void operator()(const f32x4 (&acc)[2][2][4][2], const Unit& u, int wr, int wc, int fr, int fq) const {
        const int rb = BATCHED ? ((u.pn >> 2) * 4096 + u.pm * 256) : u.pm * 256, cb = BATCHED ? (u.pn & 3) * 256 : u.pn * 256;
        const int row0 = rb + wr * 64 + fr, col0 = cb + wc * 32 + 8 * fq;
#pragma unroll
        for (int ai = 0; ai < 2; ++ai)
#pragma unroll
            for (int m = 0; m < 4; ++m) { bf16_t* rowp = O + (size_t)(row0 + ai * HALF + m * 16) * ldc + col0;
#pragma unroll
                for (int bj = 0; bj < 2; ++bj) { const f32x4 v0 = acc[ai][bj][m][0], v1 = acc[ai][bj][m][1];
                    u32x4 w; w.x = cvt_pk_bf16(v0[0], v0[1]); w.y = cvt_pk_bf16(v0[2], v0[3]); w.z = cvt_pk_bf16(v1[0], v1[1]); w.w = cvt_pk_bf16(v1[2], v1[3]);
                    *(u32x4*)(rowp + bj * HALF) = w; } }
    }
};
struct PEpiF32 {
    static constexpr bool PERM = true, AFTER_DRAIN = false;
    float* O; int ldc;
    __device__ __forceinline__ void operator()(const f32x4 (&acc)[2][2][4][2], const Unit& u, int wr, int wc, int fr, int fq) const {
        const int row0 = u.pm * 256 + wr * 64 + fr, col0 = u.pn * 256 + wc * 32 + 8 * fq;
#pragma unroll
        for (int ai = 0; ai < 2; ++ai)
#pragma unroll
            for (int m = 0; m < 4; ++m) { float* rowp = O + (size_t)(row0 + ai * HALF + m * 16) * ldc + col0;
#pragma unroll
                for (int bj = 0; bj < 2; ++bj) { *(f32x4*)(rowp + bj * HALF) = acc[ai][bj][m][0]; *(f32x4*)(rowp + bj * HALF + 4) = acc[ai][bj][m][1]; } }
    }
};
template <int CTRL> __device__ __forceinline__ float dppz(float x) { return __int_as_float(__builtin_amdgcn_update_dpp(0, __float_as_int(x), CTRL, 0xF, 0xF, true)); }
template <int CTRL> __device__ __forceinline__ float dppo(float old, float x) { return __int_as_float(__builtin_amdgcn_update_dpp(__float_as_int(old), __float_as_int(x), CTRL, 0xF, 0xF, false)); }
struct PEpiGlu {
    static constexpr bool PERM = true, AFTER_DRAIN = false;
    bf16_t* act; bf16_t* sb; const float* cw;
    __device__ __forceinline__ void operator()(const f32x4 (&acc)[2][2][4][2], const Unit& u, int wr, int wc, int fr, int fq) const {
        const int chb = u.pn * 128 + wc * 32 + 8 * fq, colp = u.pn * 256 + wc * 32 + 8 * fq;
#pragma unroll
        for (int n = 0; n < 2; ++n) {
            const int ch = chb + 4 * n;
            const f32x4 g0 = *(const f32x4*)(cw + ch), g1 = *(const f32x4*)(cw + 5632 + ch), g2 = *(const f32x4*)(cw + 11264 + ch);
            const f32x4 v0 = *(const f32x4*)(cw + 2816 + ch), v1 = *(const f32x4*)(cw + 5632 + 2816 + ch), v2 = *(const f32x4*)(cw + 11264 + 2816 + ch);
#pragma unroll
            for (int ai = 0; ai < 2; ++ai) {
                const int strip = u.pm * 4 + ai * 2 + wr, rowbase = u.pm * 256 + ai * HALF + wr * 64;
#pragma unroll
                for (int m = 0; m < 4; ++m) {
                    float o[4];
#pragma unroll
                    for (int r = 0; r < 4; ++r) {
                        const float gc = acc[ai][0][m][n][r], vc = acc[ai][1][m][n][r];
                        float gx = 0.f, vx = 0.f, gy = 0.f, vy = 0.f;
                        if (m > 0) { gx = dppz<0x121>(acc[ai][0][m - 1][n][r]); vx = dppz<0x121>(acc[ai][1][m - 1][n][r]); }
                        const float gp = dppo<0x111>(gx, gc), vp = dppo<0x111>(vx, vc);
                        if (m < 3) { gy = dppz<0x12F>(acc[ai][0][m + 1][n][r]); vy = dppz<0x12F>(acc[ai][1][m + 1][n][r]); }
                        const float gn = dppo<0x101>(gy, gc), vn = dppo<0x101>(vy, vc);
                        const float g = gp * g0[r] + gc * g1[r] + gn * g2[r];
                        const float v = vp * v0[r] + vc * v1[r] + vn * v2[r];
                        const float u2 = -1.5957691216057308f * (g + 0.044715f * g * g * g);
                        o[r] = g * __builtin_amdgcn_rcpf(1.f + __expf(u2)) * v;
                    }
                    u32x2 w; w.x = cvt_pk_bf16(o[0], o[1]); w.y = cvt_pk_bf16(o[2], o[3]);
                    *(u32x2*)(act + (size_t)(rowbase + m * 16 + fr) * 2816 + ch) = w;
                }
                if (fr < 2) {
                    bf16_t* sp = sb + ((size_t)strip * 4 + fr) * 5632 + colp + 4 * n;
                    u32x2 w; w.x = cvt_pk_bf16(acc[ai][0][0][n][0], acc[ai][0][0][n][1]); w.y = cvt_pk_bf16(acc[ai][0][0][n][2], acc[ai][0][0][n][3]);
                    *(u32x2*)sp = w;
                    w.x = cvt_pk_bf16(acc[ai][1][0][n][0], acc[ai][1][0][n][1]); w.y = cvt_pk_bf16(acc[ai][1][0][n][2], acc[ai][1][0][n][3]);
                    *(u32x2*)(sp + 128) = w;
                }
                if (fr >= 14) {
                    bf16_t* sp = sb + ((size_t)strip * 4 + (fr - 12)) * 5632 + colp + 4 * n;
                    u32x2 w; w.x = cvt_pk_bf16(acc[ai][0][3][n][0], acc[ai][0][3][n][1]); w.y = cvt_pk_bf16(acc[ai][0][3][n][2], acc[ai][0][3][n][3]);
                    *(u32x2*)sp = w;
                    w.x = cvt_pk_bf16(acc[ai][1][3][n][0], acc[ai][1][3][n][1]); w.y = cvt_pk_bf16(acc[ai][1][3][n][2], acc[ai][1][3][n][3]);
                    *(u32x2*)(sp + 128) = w;
                }
            }
        }
    }
};
struct PEpiF32B {
    static constexpr bool PERM = true, AFTER_DRAIN = false;
    bf16_t* O;
    __device__ __forceinline__ void operator()(const f32x4 (&acc)[2][2][4][2], const Unit& u, int wr, int wc, int fr, int fq) const {
        const int row0 = (u.pn >> 2) * 2048 + (u.pm & 7) * 256 + wr * 64 + fr, col0 = (u.pn & 3) * 256 + wc * 32 + 8 * fq;
#pragma unroll
        for (int ai = 0; ai < 2; ++ai)
#pragma unroll
            for (int m = 0; m < 4; ++m) { bf16_t* rowp = O + (size_t)(row0 + ai * HALF + m * 16) * 1024 + col0;
#pragma unroll
                for (int bj = 0; bj < 2; ++bj) { const f32x4 v0 = acc[ai][bj][m][0], v1 = acc[ai][bj][m][1];
                    u32x4 w; w.x = cvt_pk_bf16(v0[0], v0[1]); w.y = cvt_pk_bf16(v0[2], v0[3]); w.z = cvt_pk_bf16(v1[0], v1[1]); w.w = cvt_pk_bf16(v1[2], v1[3]);
                    *(u32x4*)(rowp + bj * HALF) = w; } }
    }
};
struct BatchOrder {
    int G, c;
    __device__ __forceinline__ bool next(int i, Unit& u) const { const int L = i * G + c; if (L >= 512) return false; const int be = L >> 5, r = L & 31; u.pm = (be & 1) * 8 + (r >> 2); u.pn = be * 4 + (r & 3); return true; }
    __device__ __forceinline__ void a_ready(const Unit&) const {}
    __device__ __forceinline__ void done(const Unit&) const {}
};
template <class Epi, class Sched, bool ALIGN_EPI = false, bool SP2 = false>
__device__ __forceinline__ void gemm_phase(PG8_LAS unsigned char* lds, const Gemm g, const Sched& S, const Epi& E) {
    int tid_ = threadIdx.x; asm volatile("" : "+v"(tid_));
    const int tid = tid_, wid = __builtin_amdgcn_readfirstlane(tid >> 6), lane = tid & 63, wr = wid >> 2, wc = wid & 3, fr = lane & 15, fq = lane >> 4;
    const int K = g.K, nt = K / BK;
    unsigned voffA[2], voffB[2];
#pragma unroll
    for (int i = 0; i < 2; ++i) { int R, C; stage_rc(tid * 16 + i * 8192, R, C); const int Rb = Epi::PERM ? ((R & ~31) + perm32(R & 31)) : R;
        voffA[i] = (unsigned)(R * K + C) * 2u; voffB[i] = (unsigned)(Rb * K + C) * 2u; }
    const size_t kstep = (size_t)(BK * 2);
    const size_t hstep = (size_t)HALF * K * 2;
    const size_t tstep = 2 * hstep;
    const unsigned ldsw = (unsigned)wid * 1024u;
    const int aoff = lds_byte(wr * 64 + fr, fq * 8), boff = lds_byte(wc * 32 + fr, fq * 8);
#define PG8_SA(b, h) (((b) * 2 + (h)) * HTB)
#define PG8_SB(b, h) ((4 + (b) * 2 + (h)) * HTB)
#define PG8_STAGE(bufoff, gbase, voff) do { _Pragma("unroll") for (int _i = 0; _i < 2; ++_i) \
        __builtin_amdgcn_global_load_lds((const unsigned*)((const char*)(gbase) + (voff)[_i]), (PG8_LAS unsigned*)(lds + (bufoff) + ldsw + _i * 8192), 16, 0, 0); } while (0)
#define PG8_LDA(dst, b, h) do { _Pragma("unroll") for (int m = 0; m < 4; ++m) _Pragma("unroll") for (int k = 0; k < 2; ++k) dst[m][k] = *(const PG8_LAS bf16x8*)(lds + PG8_SA(b, h) + aoff + m * 2048 + k * 1024); } while (0)
#define PG8_LDB(dst, b, h) do { _Pragma("unroll") for (int n = 0; n < 2; ++n) _Pragma("unroll") for (int k = 0; k < 2; ++k) dst[n][k] = *(const PG8_LAS bf16x8*)(lds + PG8_SB(b, h) + boff + n * 2048 + k * 1024); } while (0)
#define PG8_MMA(ai, bj, At, Bt) do { __builtin_amdgcn_s_setprio(1); _Pragma("unroll") for (int m = 0; m < 4; ++m) _Pragma("unroll") for (int n = 0; n < 2; ++n) _Pragma("unroll") for (int k = 0; k < 2; ++k) \
        acc[ai][bj][m][n] = __builtin_amdgcn_mfma_f32_16x16x32_bf16(Bt[n][k], At[m][k], acc[ai][bj][m][n], 0, 0, 0); __builtin_amdgcn_s_setprio(0); } while (0)
#define PG8_WAIT_V(n) asm volatile("s_waitcnt vmcnt(" #n ")" ::: "memory")
#define PG8_WAIT_L(n) asm volatile("s_waitcnt lgkmcnt(" #n ")" ::: "memory")
#define PG8_BAR __builtin_amdgcn_s_barrier()
#define PG8_SCHED __builtin_amdgcn_sched_barrier(0)
    Unit cur, nxt; int ui = 0;
    if (!S.next(0, cur)) return;
    f32x4 acc[2][2][4][2];
#pragma unroll
    for (int a = 0; a < 2; ++a)
#pragma unroll
        for (int b = 0; b < 2; ++b)
#pragma unroll
            for (int m = 0; m < 4; ++m)
#pragma unroll
                for (int n = 0; n < 2; ++n) acc[a][b][m][n] = (f32x4){0.f, 0.f, 0.f, 0.f};
    bf16x8 At[4][2], B0[2][2], B1[2][2];
    const char* cA = (const char*)g.A + (size_t)cur.pm * tstep; const char* cB = (const char*)g.Bt + (size_t)cur.pn * tstep;
    S.a_ready(cur);
    if constexpr (SP2) {
        PG8_STAGE(PG8_SB(0, 0), cB, voffB); PG8_STAGE(PG8_SB(0, 1), cB + hstep, voffB); PG8_STAGE(PG8_SA(0, 0), cA, voffA); PG8_STAGE(PG8_SA(0, 1), cA + hstep, voffA);
        if (wr == 1) PG8_BAR;
        PG8_WAIT_V(2); PG8_BAR;
        PG8_STAGE(PG8_SB(1, 0), cB + kstep, voffB); PG8_STAGE(PG8_SA(1, 0), cA + kstep, voffA); PG8_STAGE(PG8_SB(1, 1), cB + hstep + kstep, voffB);
        PG8_WAIT_V(6); PG8_BAR;
    } else {
        PG8_STAGE(PG8_SB(0, 0), cB, voffB); PG8_STAGE(PG8_SA(0, 0), cA, voffA); PG8_STAGE(PG8_SB(0, 1), cB + hstep, voffB); PG8_STAGE(PG8_SA(0, 1), cA + hstep, voffA);
        if (wr == 1) PG8_BAR;
        PG8_WAIT_V(4); PG8_BAR;
        PG8_STAGE(PG8_SB(1, 0), cB + kstep, voffB); PG8_STAGE(PG8_SA(1, 0), cA + kstep, voffA); PG8_STAGE(PG8_SB(1, 1), cB + hstep + kstep, voffB);
        PG8_WAIT_V(6); PG8_BAR;
    }
    for (;;) {
        const bool has_next = S.next(ui + 1, nxt);
        const char* nA = has_next ? (const char*)g.A + (size_t)nxt.pm * tstep : cA; const char* nB = has_next ? (const char*)g.Bt + (size_t)nxt.pn * tstep : cB;
        for (int t = 0; t < nt; t += 2) {
            const bool last = (t == nt - 2);
            const char* a1 = cA + (size_t)(t + 1) * kstep;
            const char* a2 = last ? nA : cA + (size_t)(t + 2) * kstep; const char* b2 = last ? nB : cB + (size_t)(t + 2) * kstep;
            const char* a3 = a2 + kstep; const char* b3 = b2 + kstep;
            if (last && has_next) S.a_ready(nxt);
            if constexpr (SP2) {
            PG8_LDB(B0, 0, 0); PG8_LDB(B1, 0, 1); PG8_SCHED; PG8_LDA(At, 0, 0); PG8_STAGE(PG8_SA(1, 1), a1 + hstep, voffA);
            PG8_WAIT_V(8); PG8_WAIT_L(0); PG8_BAR; PG8_MMA(0, 0, At, B0); PG8_MMA(0, 1, At, B1); PG8_BAR; PG8_SCHED;
            PG8_LDA(At, 0, 1); PG8_STAGE(PG8_SB(0, 0), b2, voffB); PG8_STAGE(PG8_SB(0, 1), b2 + hstep, voffB); PG8_STAGE(PG8_SA(0, 0), a2, voffA);
            PG8_WAIT_V(8); PG8_WAIT_L(0); PG8_BAR; PG8_MMA(1, 0, At, B0); PG8_MMA(1, 1, At, B1); PG8_BAR; PG8_SCHED;
            PG8_LDB(B0, 1, 0); PG8_LDB(B1, 1, 1); PG8_SCHED; PG8_LDA(At, 1, 0); PG8_STAGE(PG8_SA(0, 1), a2 + hstep, voffA);
            PG8_WAIT_V(8); PG8_WAIT_L(0); PG8_BAR; PG8_MMA(0, 0, At, B0); PG8_MMA(0, 1, At, B1); PG8_BAR; PG8_SCHED;
            PG8_LDA(At, 1, 1); PG8_STAGE(PG8_SB(1, 0), b3, voffB); PG8_STAGE(PG8_SB(1, 1), b3 + hstep, voffB); PG8_STAGE(PG8_SA(1, 0), a3, voffA);
            PG8_WAIT_V(8); PG8_WAIT_L(0); PG8_BAR; PG8_MMA(1, 0, At, B0); PG8_MMA(1, 1, At, B1); PG8_BAR; PG8_SCHED;
            } else {
            PG8_LDB(B0, 0, 0); PG8_SCHED; PG8_LDA(At, 0, 0); PG8_STAGE(PG8_SA(1, 1), a1 + hstep, voffA);
            PG8_WAIT_L(8); PG8_BAR; PG8_WAIT_L(0); PG8_MMA(0, 0, At, B0); PG8_BAR; PG8_SCHED;
            PG8_LDB(B1, 0, 1); PG8_STAGE(PG8_SB(0, 0), b2, voffB);
            PG8_BAR; PG8_WAIT_L(0); PG8_MMA(0, 1, At, B1); PG8_BAR;
            PG8_LDA(At, 0, 1); PG8_STAGE(PG8_SA(0, 0), a2, voffA);
            PG8_BAR; PG8_WAIT_L(0); PG8_MMA(1, 0, At, B0); PG8_BAR; PG8_SCHED;
            PG8_STAGE(PG8_SB(0, 1), b2 + hstep, voffB);
            PG8_WAIT_V(6); PG8_BAR; PG8_MMA(1, 1, At, B1); PG8_BAR;
            PG8_LDB(B0, 1, 0); PG8_SCHED; PG8_LDA(At, 1, 0); PG8_STAGE(PG8_SA(0, 1), a2 + hstep, voffA);
            PG8_WAIT_L(8); PG8_BAR; PG8_WAIT_L(0); PG8_MMA(0, 0, At, B0); PG8_BAR; PG8_SCHED;
            PG8_LDB(B1, 1, 1); PG8_STAGE(PG8_SB(1, 0), b3, voffB);
            PG8_BAR; PG8_WAIT_L(0); PG8_MMA(0, 1, At, B1); PG8_BAR;
            PG8_LDA(At, 1, 1); PG8_STAGE(PG8_SA(1, 0), a3, voffA);
            PG8_BAR; PG8_WAIT_L(0); PG8_MMA(1, 0, At, B0); PG8_BAR; PG8_SCHED;
            PG8_STAGE(PG8_SB(1, 1), b3 + hstep, voffB);
            PG8_WAIT_V(6); PG8_BAR; PG8_MMA(1, 1, At, B1); PG8_BAR;
            }
        }
        if constexpr (ALIGN_EPI) { if (wr == 0) PG8_BAR; }
        if constexpr (!Epi::AFTER_DRAIN) { E(acc, cur, wr, wc, fr, fq); S.done(cur); }
        if (!has_next) break;
#pragma unroll
        for (int a = 0; a < 2; ++a)
#pragma unroll
            for (int b = 0; b < 2; ++b)
#pragma unroll
                for (int m = 0; m < 4; ++m)
#pragma unroll
                    for (int n = 0; n < 2; ++n) acc[a][b][m][n] = (f32x4){0.f, 0.f, 0.f, 0.f};
        cur = nxt; cA = nA; cB = nB; ++ui;
        if constexpr (ALIGN_EPI) { if (wr == 1) PG8_BAR; }
    }
    PG8_WAIT_V(0);
    if constexpr (!ALIGN_EPI) { if (wr == 0) PG8_BAR; }
    PG8_BAR;
    if constexpr (Epi::AFTER_DRAIN) { E.fused(acc, cur, wr, wc, fr, fq, lds, wid, lane); S.done(cur); }
#undef PG8_SA
#undef PG8_SB
#undef PG8_STAGE
#undef PG8_LDA
#undef PG8_LDB
#undef PG8_MMA
#undef PG8_WAIT_V
#undef PG8_WAIT_L
#undef PG8_BAR
#undef PG8_SCHED
}
}

DEV void gemm_first_load(const bf16_t* __restrict__ A, int lda, const bf16_t* __restrict__ Bt, int ldb, u32x4 (&ra)[4], u32x4 (&rb)[2]) {
  const int tid = tidx(), w = tid >> 6, l = tid & 63, lr = l & 15, lq = l >> 4;
#pragma unroll
  for (int j = 0; j < 4; ++j) {
    const int c = w * 4 + j, mt = c >> 1, sl = c & 1;
    ra[j] = *(const u32x4*)(A + (size_t)(mt * 16 + lr) * lda + sl * 32 + lq * 8);
  }
#pragma unroll
  for (int j = 0; j < 2; ++j) {
    const int nt = w, sl = j;
    const int rowb = (nt >> 2) * 64 + (lr >> 2) * 16 + (nt & 3) * 4 + (lr & 3);
    rb[j] = *(const u32x4*)(Bt + (size_t)rowb * ldb + sl * 32 + lq * 8);
  }
}
template <class Epi>
DEV void gemm_tile(char* lds, const bf16_t* __restrict__ A, int lda, const bf16_t* __restrict__ Bt, int ldb, int K, int trow, int tcol,
                   const Epi& epi, u32x4 (&ra)[4], u32x4 (&rb)[2], const bf16_t* __restrict__ An, const bf16_t* __restrict__ Bn) {
  const int tid = tidx(), w = tid >> 6, l = tid & 63, wm = w >> 1, wn = w & 1, lr = l & 15, lq = l >> 4;
  const bf16_t* ga[4];
  const bf16_t* gb[2];
#pragma unroll
  for (int j = 0; j < 4; ++j) {
    const int c = w * 4 + j, mt = c >> 1, sl = c & 1;
    ga[j] = A + (size_t)(mt * 16 + lr) * lda + sl * 32 + lq * 8;
  }
#pragma unroll
  for (int j = 0; j < 2; ++j) {
    const int nt = w, sl = j;
    const int rowb = (nt >> 2) * 64 + (lr >> 2) * 16 + (nt & 3) * 4 + (lr & 3);
    gb[j] = Bt + (size_t)rowb * ldb + sl * 32 + lq * 8;
  }
  f32x4 acc[4][4];
#pragma unroll
  for (int i = 0; i < 4; ++i)
#pragma unroll
    for (int j = 0; j < 4; ++j) acc[i][j] = (f32x4){0.f, 0.f, 0.f, 0.f};
  const int nk = K >> 6;
#pragma unroll
  for (int j = 0; j < 4; ++j) *(u32x4*)(lds + (w * 4 + j) * 1024 + l * 16) = ra[j];
#pragma unroll
  for (int j = 0; j < 2; ++j) *(u32x4*)(lds + 32768 + (w * 2 + j) * 1024 + l * 16) = rb[j];
  __syncthreads();
  for (int kt = 0; kt < nk; ++kt) {
    char* cur = lds + (kt & 1) * 49152;
    const bool more = (kt + 1 < nk);
    if (more) {
#pragma unroll
      for (int j = 0; j < 4; ++j) ra[j] = *(const u32x4*)(ga[j] + (kt + 1) * 64);
#pragma unroll
      for (int j = 0; j < 2; ++j) rb[j] = *(const u32x4*)(gb[j] + (kt + 1) * 64);
    }
#pragma unroll
    for (int s = 0; s < 2; ++s) {
      bf16x8 af[4], bfr[4];
#pragma unroll
      for (int i = 0; i < 4; ++i) af[i] = *(const bf16x8*)(cur + ((wm * 4 + i) * 2 + s) * 1024 + l * 16);
#pragma unroll
      for (int j = 0; j < 4; ++j) bfr[j] = *(const bf16x8*)(cur + 32768 + ((wn * 4 + j) * 2 + s) * 1024 + l * 16);
#pragma unroll
      for (int i = 0; i < 4; ++i)
#pragma unroll
        for (int j = 0; j < 4; ++j) acc[i][j] = __builtin_amdgcn_mfma_f32_16x16x32_bf16(bfr[j], af[i], acc[i][j], 0, 0, 0);
    }
    if (more) {
      char* nxt = lds + ((kt + 1) & 1) * 49152;
#pragma unroll
      for (int j = 0; j < 4; ++j) *(u32x4*)(nxt + (w * 4 + j) * 1024 + l * 16) = ra[j];
#pragma unroll
      for (int j = 0; j < 2; ++j) *(u32x4*)(nxt + 32768 + (w * 2 + j) * 1024 + l * 16) = rb[j];
    }
    __syncthreads();
  }
  if (An) gemm_first_load(An, lda, Bn, ldb, ra, rb);
#pragma unroll
  for (int i = 0; i < 4; ++i) epi(trow + wm * 64 + i * 16 + lr, tcol + wn * 64 + lq * 16, acc[i]);
}

DEV void store16_bf16(bf16_t* dst, const f32x4 (&v)[4], float sc) {
  u32x4 a, b;
  a.x = pk2(v[0][0] * sc, v[0][1] * sc); a.y = pk2(v[0][2] * sc, v[0][3] * sc);
  a.z = pk2(v[1][0] * sc, v[1][1] * sc); a.w = pk2(v[1][2] * sc, v[1][3] * sc);
  b.x = pk2(v[2][0] * sc, v[2][1] * sc); b.y = pk2(v[2][2] * sc, v[2][3] * sc);
  b.z = pk2(v[3][0] * sc, v[3][1] * sc); b.w = pk2(v[3][2] * sc, v[3][3] * sc);
  *(u32x4*)dst = a;
  *(u32x4*)(dst + 8) = b;
}

struct EpiBf16 {
  bf16_t* O; int ldo;
  DEV void operator()(int row, int col, const f32x4 (&v)[4]) const { store16_bf16(O + (size_t)row * ldo + col, v, 1.f); }
};
struct EpiF32 {
  float* O; int ldo;
  DEV void operator()(int row, int col, const f32x4 (&v)[4]) const {
    float* d = O + (size_t)row * ldo + col;
#pragma unroll
    for (int j = 0; j < 4; ++j) *(f32x4*)(d + 4 * j) = v[j];
  }
};
struct EpiLora1 {
  bf16_t* O;
  DEV void operator()(int row, int col, const f32x4 (&v)[4]) const {
    f32x4 o[4];
#pragma unroll
    for (int j = 0; j < 4; ++j)
#pragma unroll
      for (int r = 0; r < 4; ++r) {
        const float t = v[j][r];
        o[j][r] = (col < 128) ? (1.f - 2.f * __builtin_amdgcn_rcpf(1.f + __expf(2.f * t))) : ((col < 256) ? t : sigmoidf_(t));
      }
    store16_bf16(O + (size_t)row * 384 + col, o, 1.f);
  }
};
struct EpiDecay {
  bf16_t* O; const float* w0;
  DEV void operator()(int row, int col, const f32x4 (&v)[4]) const {
    f32x4 o[4];
    float w0v[16];
#pragma unroll
    for (int i = 0; i < 16; i += 4) *(f32x4*)(w0v + i) = *(const f32x4*)(w0 + col + i);
#pragma unroll
    for (int j = 0; j < 4; ++j)
#pragma unroll
      for (int r = 0; r < 4; ++r) {
        const float xx = w0v[4 * j + r] + v[j][r];
        const float nx = -xx;
        const float sp = (nx > 20.f) ? nx : __logf(1.f + __expf(nx));
        const float e = __expf(-sp - 0.5f);
        o[j][r] = 1.f - __expf(-e);
      }
    store16_bf16(O + (size_t)row * 512 + col, o, 1.f);
  }
};
struct EpiA {
  bf16_t *KD, *KKA, *KK; const float *a0, *k_k, *k_a; const bf16_t* za; int writekk;
  DEV void operator()(int row, int col, const f32x4 (&v)[4]) const {
    const bf16_t* kp = za + (size_t)row * 2048 + 512 + col;
    const u32x4 k0 = *(const u32x4*)kp, k1 = *(const u32x4*)(kp + 8);
    float kf[16];
    kf[0] = lo16(k0.x); kf[1] = hi16(k0.x); kf[2] = lo16(k0.y); kf[3] = hi16(k0.y); kf[4] = lo16(k0.z); kf[5] = hi16(k0.z); kf[6] = lo16(k0.w); kf[7] = hi16(k0.w);
    kf[8] = lo16(k1.x); kf[9] = hi16(k1.x); kf[10] = lo16(k1.y); kf[11] = hi16(k1.y); kf[12] = lo16(k1.z); kf[13] = hi16(k1.z); kf[14] = lo16(k1.w); kf[15] = hi16(k1.w);
    float kkv[16], a0v[16], kav[16];
#pragma unroll
    for (int i = 0; i < 16; i += 4) { *(f32x4*)(kkv + i) = *(const f32x4*)(k_k + col + i); *(f32x4*)(a0v + i) = *(const f32x4*)(a0 + col + i); *(f32x4*)(kav + i) = *(const f32x4*)(k_a + col + i); }
    float kr[16], ss = 0.f;
#pragma unroll
    for (int i = 0; i < 16; ++i) { kr[i] = kf[i] * kkv[i]; ss += kr[i] * kr[i]; }
    ss += __shfl_xor(ss, 16);
    ss += __shfl_xor(ss, 32);
    const float rn = rsqrtf(ss + 1e-12f);
    f32x4 okd[4], okka[4], okk[4];
#pragma unroll
    for (int j = 0; j < 4; ++j)
#pragma unroll
      for (int r = 0; r < 4; ++r) {
        const int i = 4 * j + r;
        const float a = sigmoidf_(a0v[i] + v[j][r]);
        const float kk = kr[i] * rn;
        okd[j][r] = kf[i] * (1.f + (a - 1.f) * kav[i]);
        okka[j][r] = kk * a;
        okk[j][r] = kk;
      }
    store16_bf16(KD + (size_t)row * 512 + col, okd, 1.f);
    store16_bf16(KKA + (size_t)row * 512 + col, okka, 1.f);
    if (writekk) store16_bf16(KK + (size_t)row * 512 + col, okk, 1.f);
  }
};
struct EpiDftc {
  bf16_t* CST; int g;
  DEV void operator()(int row, int col, const f32x4 (&v)[4]) const {
    const int b = col >> 12, s = col & 4095;
    store16_bf16(CST + ((size_t)((b * 2 + (row >> 7)) * 1024 + g * 128 + (row & 127)) * 4096 + s), v, 1.f);
  }
};

DEV void transpose_convert(char* lds, const float* __restrict__ W, int K, int N, bf16_t* __restrict__ Wt, int ldt, int rot, bool glu_perm = false) {
  float* tile = (float*)lds;
  const int tn_n = N >> 6, nt = (K >> 6) * tn_n, tid = tidx();
  const int r0 = tid >> 4, c4 = (tid & 15) * 4;
  int t = (blockIdx.x + rot) % gridDim.x;
  f32x4 ra, rb;
  if (t < nt) {
    const int tk = t / tn_n, tn = t % tn_n;
    const float* src = W + (size_t)(tk * 64 + r0) * N + tn * 64 + c4;
    ra = *(const f32x4*)src; rb = *(const f32x4*)(src + (size_t)32 * N);
  }
  for (; t < nt; t += gridDim.x) {
    const int tk = t / tn_n, tn = t % tn_n;
#pragma unroll
    for (int i = 0; i < 4; ++i) { tile[r0 * 65 + c4 + i] = ra[i]; tile[(r0 + 32) * 65 + c4 + i] = rb[i]; }
    __syncthreads();
    const int t2 = t + gridDim.x;
    if (t2 < nt) {
      const int tk2 = t2 / tn_n, tn2 = t2 % tn_n;
      const float* src = W + (size_t)(tk2 * 64 + r0) * N + tn2 * 64 + c4;
      ra = *(const f32x4*)src; rb = *(const f32x4*)(src + (size_t)32 * N);
    }
    int nbase = tn * 64;
    if (glu_perm) { const int c = tn * 64; nbase = (c < 2816) ? ((c >> 7) * 256 + (c & 127)) : (((c - 2816) >> 7) * 256 + 128 + ((c - 2816) & 127)); }
#pragma unroll
    for (int j = 0; j < 2; ++j) {
      const int n = r0 + 32 * j;
      u32x2 pk;
      pk.x = pk2(tile[(c4 + 0) * 65 + n], tile[(c4 + 1) * 65 + n]);
      pk.y = pk2(tile[(c4 + 2) * 65 + n], tile[(c4 + 3) * 65 + n]);
      *(u32x2*)(Wt + (size_t)(nbase + n) * ldt + tk * 64 + c4) = pk;
    }
    __syncthreads();
  }
}

DEV void compute_mod(char* lds, const P& p) {
  float* cs = (float*)lds;
  float* red = (float*)(lds + 32768);
  const int tid = tidx();
  float* mod = (float*)(p.ws + W_MOD);
  bool have = false;
  for (int item = blockIdx.x; item < 192; item += gridDim.x) {
    if (!have) {
      for (int i = tid; i < 8192; i += NTHR) { const float cv = p.c[i]; cs[i] = cv / (1.f + expf(-cv)); }
      __syncthreads();
      have = true;
    }
    const int l = item / 96, cb = item % 96, col = cb * 64 + (tid & 63), kg = tid >> 6;
    float a0 = 0, a1 = 0, a2 = 0, a3 = 0, a4 = 0, a5 = 0, a6 = 0, a7 = 0;
    const float* wp = p.ada_w + ((size_t)l * 1024 + kg * 128) * 6144 + col;
    for (int k = 0; k < 128; ++k) {
      const float wv = wp[(size_t)k * 6144];
      const int kk = kg * 128 + k;
      a0 += cs[kk] * wv; a1 += cs[1024 + kk] * wv; a2 += cs[2048 + kk] * wv; a3 += cs[3072 + kk] * wv;
      a4 += cs[4096 + kk] * wv; a5 += cs[5120 + kk] * wv; a6 += cs[6144 + kk] * wv; a7 += cs[7168 + kk] * wv;
    }
    float* rp = red + kg * 512 + (tid & 63);
    rp[0] = a0; rp[64] = a1; rp[128] = a2; rp[192] = a3; rp[256] = a4; rp[320] = a5; rp[384] = a6; rp[448] = a7;
    __syncthreads();
    {
      const int b = tid >> 6, cc = tid & 63;
      float s = 0.f;
#pragma unroll
      for (int g = 0; g < 8; ++g) s += red[g * 512 + b * 64 + cc];
      mod[(size_t)(l * 8 + b) * 6144 + cb * 64 + cc] = s + p.ada_b[l * 6144 + cb * 64 + cc];
    }
    __syncthreads();
  }
}

template <bool HAS_Y, bool HAS_H, bool XIN_BF = false, bool XOUT_BF = false>
DEV void rowpass(const void* __restrict__ xin_, const bf16_t* __restrict__ yf, const float* __restrict__ gy, const float* __restrict__ gate,
                 void* __restrict__ xout_, const float* __restrict__ gh, const float* __restrict__ sc, const float* __restrict__ sh,
                 bf16_t* __restrict__ h) {
  const float* xin = (const float*)xin_; const bf16_t* xinb = (const bf16_t*)xin_;
  float* xout = (float*)xout_; bf16_t* xoutb = (bf16_t*)xout_;
  const int lane = tidx() & 63, gw = blockIdx.x * 8 + (tidx() >> 6), nw = gridDim.x * 8;
  for (int row = gw; row < MT; row += nw) {
    const int b = row >> 12;
    f32x4 xv[4];
#pragma unroll
    for (int i = 0; i < 4; ++i) {
      if (XIN_BF) { const u32x2 xu = *(const u32x2*)(xinb + (size_t)row * 1024 + i * 256 + lane * 4); xv[i] = (f32x4){lo16(xu.x), hi16(xu.x), lo16(xu.y), hi16(xu.y)}; }
      else xv[i] = *(const f32x4*)(xin + (size_t)row * 1024 + i * 256 + lane * 4);
    }
    if (HAS_Y) {
      f32x4 yv[4];
      float ss = 0.f;
#pragma unroll
      for (int i = 0; i < 4; ++i) {
        const u32x2 yu = *(const u32x2*)(yf + (size_t)row * 1024 + i * 256 + lane * 4);
        yv[i] = (f32x4){lo16(yu.x), hi16(yu.x), lo16(yu.y), hi16(yu.y)};
        ss += yv[i][0] * yv[i][0] + yv[i][1] * yv[i][1] + yv[i][2] * yv[i][2] + yv[i][3] * yv[i][3];
      }
      ss = wave_sum(ss);
      const float rs = rsqrtf(ss * (1.f / 1024.f) + 1e-6f);
#pragma unroll
      for (int i = 0; i < 4; ++i) {
        const int col = i * 256 + lane * 4;
        const f32x4 g4 = *(const f32x4*)(gy + col), gt = *(const f32x4*)(gate + (size_t)b * 6144 + col);
        xv[i] = xv[i] + gt * (yv[i] * rs * g4);
        if (XOUT_BF) { u32x2 pk; pk.x = pk2(xv[i][0], xv[i][1]); pk.y = pk2(xv[i][2], xv[i][3]); *(u32x2*)(xoutb + (size_t)row * 1024 + col) = pk;
                       xv[i] = (f32x4){lo16(pk.x), hi16(pk.x), lo16(pk.y), hi16(pk.y)}; }
        else *(f32x4*)(xout + (size_t)row * 1024 + col) = xv[i];
      }
    }
    if (HAS_H) {
      float ss = 0.f;
#pragma unroll
      for (int i = 0; i < 4; ++i) ss += xv[i][0] * xv[i][0] + xv[i][1] * xv[i][1] + xv[i][2] * xv[i][2] + xv[i][3] * xv[i][3];
      ss = wave_sum(ss);
      const float rs = rsqrtf(ss * (1.f / 1024.f) + 1e-6f);
#pragma unroll
      for (int i = 0; i < 4; ++i) {
        const int col = i * 256 + lane * 4;
        const f32x4 g4 = *(const f32x4*)(gh + col), s4 = *(const f32x4*)(sc + (size_t)b * 6144 + col), h4 = *(const f32x4*)(sh + (size_t)b * 6144 + col);
        const f32x4 o = (xv[i] * rs * g4) * (s4 + 1.f) + h4;
        u32x2 pk;
        pk.x = pk2(o[0], o[1]); pk.y = pk2(o[2], o[3]);
        *(u32x2*)(h + (size_t)row * 1024 + col) = pk;
      }
    }
  }
}

DEV void unpack8(const u32x4 u, float (&f)[8]) {
  f[0] = lo16(u.x); f[1] = hi16(u.x); f[2] = lo16(u.y); f[3] = hi16(u.y); f[4] = lo16(u.z); f[5] = hi16(u.z); f[6] = lo16(u.w); f[7] = hi16(u.w);
}
DEV u32x4 pack8(const float (&f)[8]) {
  u32x4 u;
  u.x = pk2(f[0], f[1]); u.y = pk2(f[2], f[3]); u.z = pk2(f[4], f[5]); u.w = pk2(f[6], f[7]);
  return u;
}

DEV void prep1(const P& p) {
  const bf16_t* z = (const bf16_t*)(p.ws + O_Z);
  bf16_t* za = (bf16_t*)p.out;
  bf16_t* qr = (bf16_t*)(p.ws + O_QR);
  bf16_t* kr = (bf16_t*)(p.ws + O_KR);
  bf16_t* vt = (bf16_t*)(p.ws + O_VT);
  const float* rope = (const float*)(p.ws + W_ROPE);
  const int gt = blockIdx.x * NTHR + tidx(), ngt = gridDim.x * NTHR;
  for (int idx = gt; idx < MT * 256; idx += ngt) {
    const int tok = idx >> 8, c8 = (idx & 255) * 8, s = tok & 4095;
    const bf16_t* zp = z + (size_t)tok * INC + c8;
    float zc[8], zm[8], zn[8], o[8];
    unpack8(*(const u32x4*)zp, zc);
    if (s > 0) unpack8(*(const u32x4*)(zp - INC), zm); else { for (int i = 0; i < 8; ++i) zm[i] = 0.f; }
    if (s < 4095) unpack8(*(const u32x4*)(zp + INC), zn); else { for (int i = 0; i < 8; ++i) zn[i] = 0.f; }
    float w0[8], w1[8], w2[8];
    *(f32x4*)w0 = *(const f32x4*)(p.mix_conv + c8); *(f32x4*)(w0 + 4) = *(const f32x4*)(p.mix_conv + c8 + 4);
    *(f32x4*)w1 = *(const f32x4*)(p.mix_conv + 2048 + c8); *(f32x4*)(w1 + 4) = *(const f32x4*)(p.mix_conv + 2048 + c8 + 4);
    *(f32x4*)w2 = *(const f32x4*)(p.mix_conv + 4096 + c8); *(f32x4*)(w2 + 4) = *(const f32x4*)(p.mix_conv + 4096 + c8 + 4);
#pragma unroll
    for (int i = 0; i < 8; ++i) o[i] = zm[i] * w0[i] + zc[i] * w1[i] + zn[i] * w2[i];
    *(u32x4*)(za + (size_t)tok * 2048 + c8) = pack8(o);
  }
  for (int idx = gt; idx < MT * 64; idx += ngt) {
    const int e8 = idx & 3, which = (idx >> 2) & 1, h = (idx >> 3) & 7, tok = idx >> 6, s = tok & 4095;
    const bf16_t* src = z + (size_t)tok * INC + 2048 + which * 512 + h * 64 + e8 * 8;
    float x1[8], x2[8], o1[8], o2[8];
    unpack8(*(const u32x4*)src, x1);
    unpack8(*(const u32x4*)(src + 32), x2);
    const float* rp = rope + ((size_t)s * 32 + e8 * 8) * 2;
    const float scl = which ? 1.f : 0.125f;
#pragma unroll
    for (int i = 0; i < 8; ++i) {
      const float cv = rp[2 * i], sv = rp[2 * i + 1];
      o1[i] = (x1[i] * cv - x2[i] * sv) * scl;
      o2[i] = (x2[i] * cv + x1[i] * sv) * scl;
    }
    bf16_t* dst = (which ? kr : qr) + (size_t)tok * 512 + h * 64 + e8 * 8;
    *(u32x4*)dst = pack8(o1);
    *(u32x4*)(dst + 32) = pack8(o2);
  }
  {
    bf16_t* vr = (bf16_t*)(p.ws + O_VT);
    for (int idx = gt; idx < MT * 64; idx += ngt) {
      const int tok = idx >> 6, c8 = (idx & 63) * 8;
      *(u32x4*)(vr + (size_t)tok * 512 + c8) = *(const u32x4*)(z + (size_t)tok * INC + 3072 + c8);
    }
  }
}

DEV void attention(char* lds, const P& p) {
  const bf16_t* qr = (const bf16_t*)(p.ws + O_QR);
  const bf16_t* kr = (const bf16_t*)(p.ws + O_KR);
  const bf16_t* vt = (const bf16_t*)(p.ws + O_VT);
  float* num = (float*)(p.ws + O_NUM);
  float* md = (float*)(p.ws + O_MD);
  constexpr int UNIT_LDS = 24576 + 64 * 400;
  const int tid = tidx(), w = tid >> 6, lane = tid & 63, lr = lane & 15, lq = lane >> 4;
  const int uh = tid >> 8, lt = tid & 255, mt = w & 3;
  char* ul = lds + uh * UNIT_LDS;
  u32x4 pre[12];
  auto load_pair = [&](int pi) {
    const int unit = pi * 2 + uh;
    const int nb = unit & 63, h = (unit >> 6) & 7, b = (unit >> 9) & 7, br = unit >> 12;
    const int dsh = 2 * br, Mr = 4096 >> dsh;
    const int seg = (nb * 64) / Mr, segstart = seg * Mr, segend = segstart + Mr;
    const bool pv_ok = (nb * 64 - 64 >= segstart), nx_ok = (nb * 64 + 128 <= segend);
#pragma unroll
    for (int j = 0; j < 6; ++j) {
      const int pc = lt + 256 * j, key = pc >> 3, ch = pc & 7, kb = key >> 6;
      int blk = nb + kb - 1;
      if ((kb == 0 && !pv_ok) || (kb == 2 && !nx_ok)) blk = nb;
      const int kp = blk * 64 + (key & 63);
      const int ktok = b * 4096 + (((kp - segstart) << dsh) + seg);
      pre[j] = *(const u32x4*)(kr + (size_t)ktok * 512 + h * 64 + ch * 8);
      pre[6 + j] = *(const u32x4*)(vt + (size_t)ktok * 512 + h * 64 + ch * 8);
    }
  };
  const int npairs = 3 * 4096 / 2;
  int pi = blockIdx.x;
  if (pi < npairs) load_pair(pi);
  for (; pi < npairs; pi += gridDim.x) {
#pragma unroll
    for (int j = 0; j < 6; ++j) {
      const int pc = lt + 256 * j, key = pc >> 3, ch = pc & 7;
      *(u32x4*)(ul + key * 128 + ((ch ^ (key & 7)) * 16)) = pre[j];
    }
#pragma unroll
    for (int j = 0; j < 6; ++j) {
      const int pc = lt + 256 * j, key = pc >> 3, ch = pc & 7;
      bf16_t* vd = (bf16_t*)(ul + 24576 + (ch * 8) * 400) + (key ^ (ch << 2));
      const u32x4 u = pre[6 + j];
      vd[0 * 200] = (bf16_t)(u.x & 0xffff); vd[1 * 200] = (bf16_t)(u.x >> 16); vd[2 * 200] = (bf16_t)(u.y & 0xffff); vd[3 * 200] = (bf16_t)(u.y >> 16);
      vd[4 * 200] = (bf16_t)(u.z & 0xffff); vd[5 * 200] = (bf16_t)(u.z >> 16); vd[6 * 200] = (bf16_t)(u.w & 0xffff); vd[7 * 200] = (bf16_t)(u.w >> 16);
    }
    __syncthreads();
    const int unit = pi * 2 + uh;
    const int nb = unit & 63, h = (unit >> 6) & 7, b = (unit >> 9) & 7, br = unit >> 12;
    const int dsh = 2 * br, Mr = 4096 >> dsh;
    const int seg = (nb * 64) / Mr, segstart = seg * Mr, segend = segstart + Mr;
    const bool pv_ok = (nb * 64 - 64 >= segstart), nx_ok = (nb * 64 + 128 <= segend);
    const int qp = nb * 64 + mt * 16 + lr;
    const int qtok = b * 4096 + (((qp - segstart) << dsh) + seg);
    bf16x8 qf[2];
    qf[0] = *(const bf16x8*)(qr + (size_t)qtok * 512 + h * 64 + lq * 8);
    qf[1] = *(const bf16x8*)(qr + (size_t)qtok * 512 + h * 64 + 32 + lq * 8);
    if (pi + (int)gridDim.x < npairs) load_pair(pi + gridDim.x);
    f32x4 sacc[12];
#pragma unroll
    for (int kt = 0; kt < 12; ++kt) {
      const int key = kt * 16 + lr;
      const bf16x8 k0 = *(const bf16x8*)(ul + key * 128 + ((lq ^ (key & 7)) * 16));
      const bf16x8 k1 = *(const bf16x8*)(ul + key * 128 + (((4 + lq) ^ (key & 7)) * 16));
      f32x4 a = (f32x4){0.f, 0.f, 0.f, 0.f};
      a = __builtin_amdgcn_mfma_f32_16x16x32_bf16(k0, qf[0], a, 0, 0, 0);
      a = __builtin_amdgcn_mfma_f32_16x16x32_bf16(k1, qf[1], a, 0, 0, 0);
      sacc[kt] = a;
    }
    const int qi = mt * 16 + lr;
    float mx = -1e30f;
#pragma unroll
    for (int kt = 0; kt < 12; ++kt) {
      const int kb = kt >> 2;
#pragma unroll
      for (int r = 0; r < 4; ++r) {
        const int kj = (kt & 3) * 16 + lq * 4 + r;
        bool ok = true;
        if (kb == 0) ok = pv_ok && (kj >= qi);
        if (kb == 2) ok = nx_ok && (kj <= qi);
        const float sv = ok ? sacc[kt][r] : -1e30f;
        sacc[kt][r] = sv;
        mx = fmaxf(mx, sv);
      }
    }
    mx = fmaxf(mx, __shfl_xor(mx, 16));
    mx = fmaxf(mx, __shfl_xor(mx, 32));
    float den = 0.f;
#pragma unroll
    for (int kt = 0; kt < 12; ++kt)
#pragma unroll
      for (int r = 0; r < 4; ++r) {
        const float pe = __expf(sacc[kt][r] - mx);
        sacc[kt][r] = pe;
        den += pe;
      }
    den += __shfl_xor(den, 16);
    den += __shfl_xor(den, 32);
    f32x4 oacc[4];
#pragma unroll
    for (int et = 0; et < 4; ++et) oacc[et] = (f32x4){0.f, 0.f, 0.f, 0.f};
#pragma unroll
    for (int t = 0; t < 6; ++t) {
      u32x4 pu;
      pu.x = pk2(sacc[2 * t][0], sacc[2 * t][1]); pu.y = pk2(sacc[2 * t][2], sacc[2 * t][3]);
      pu.z = pk2(sacc[2 * t + 1][0], sacc[2 * t + 1][1]); pu.w = pk2(sacc[2 * t + 1][2], sacc[2 * t + 1][3]);
      const bf16x8 pf = __builtin_bit_cast(bf16x8, pu);
#pragma unroll
      for (int et = 0; et < 4; ++et) {
        const char* vrow = ul + 24576 + (et * 16 + lr) * 400;
        const int sw = ((et * 2 + (lr >> 3)) & 7) << 2;
        const u32x2 v0 = *(const u32x2*)(vrow + (((2 * t) * 16 + lq * 4) ^ sw) * 2), v1 = *(const u32x2*)(vrow + (((2 * t + 1) * 16 + lq * 4) ^ sw) * 2);
        u32x4 vu;
        vu.x = v0.x; vu.y = v0.y; vu.z = v1.x; vu.w = v1.y;
        oacc[et] = __builtin_amdgcn_mfma_f32_16x16x32_bf16(__builtin_bit_cast(bf16x8, vu), pf, oacc[et], 0, 0, 0);
      }
    }
    float* np = num + ((size_t)br * MT + qtok) * 512 + h * 64 + lq * 4;
#pragma unroll
    for (int et = 0; et < 4; ++et) *(f32x4*)(np + et * 16) = oacc[et];
    if (lq == 0) {
      f32x2 o;
      o.x = mx; o.y = den;
      *(f32x2*)(md + (((size_t)br * MT + qtok) * 8 + h) * 2) = o;
    }
    __syncthreads();
  }
}

DEV void combineA(const P& p) {
  const float* num = (const float*)(p.ws + O_NUM);
  const float* md = (const float*)(p.ws + O_MD);
  bf16_t* ycat = (bf16_t*)(p.ws + O_YCAT);
  const int gt = blockIdx.x * NTHR + tidx(), ngt = gridDim.x * NTHR;
  for (int idx = gt; idx < MT * 128; idx += ngt) {
    const int e4 = idx & 15, h = (idx >> 4) & 7, tok = idx >> 7;
    f32x2 m0 = *(const f32x2*)(md + (((size_t)0 * MT + tok) * 8 + h) * 2);
    f32x2 m1 = *(const f32x2*)(md + (((size_t)1 * MT + tok) * 8 + h) * 2);
    f32x2 m2 = *(const f32x2*)(md + (((size_t)2 * MT + tok) * 8 + h) * 2);
    const float ma = fmaxf(m0.x, fmaxf(m1.x, m2.x));
    const float e0 = __expf(m0.x - ma), e1 = __expf(m1.x - ma), e2 = __expf(m2.x - ma);
    const float dn = e0 * m0.y + e1 * m1.y + e2 * m2.y;
    const f32x4 n0 = *(const f32x4*)(num + ((size_t)0 * MT + tok) * 512 + h * 64 + e4 * 4);
    const f32x4 n1 = *(const f32x4*)(num + ((size_t)1 * MT + tok) * 512 + h * 64 + e4 * 4);
    const f32x4 n2 = *(const f32x4*)(num + ((size_t)2 * MT + tok) * 512 + h * 64 + e4 * 4);
    const f32x4 o = (n0 * e0 + n1 * e1 + n2 * e2) * (1.f / dn);
    u32x2 pk;
    pk.x = pk2(o[0], o[1]); pk.y = pk2(o[2], o[3]);
    *(u32x2*)(ycat + (size_t)tok * 1024 + 512 + h * 64 + e4 * 4) = pk;
  }
}

DEV float dpp_allreduce16(float x) {
  x += __int_as_float(__builtin_amdgcn_update_dpp(0, __float_as_int(x), 0xB1, 0xF, 0xF, true));
  x += __int_as_float(__builtin_amdgcn_update_dpp(0, __float_as_int(x), 0x4E, 0xF, 0xF, true));
  x += __int_as_float(__builtin_amdgcn_update_dpp(0, __float_as_int(x), 0x141, 0xF, 0xF, true));
  x += __int_as_float(__builtin_amdgcn_update_dpp(0, __float_as_int(x), 0x140, 0xF, 0xF, true));
  return x;
}

DEV void scan_phase(char* lds, const P& p) {
  const bf16_t* omw = (const bf16_t*)(p.ws + O_OMW);
  const bf16_t* kd = (const bf16_t*)(p.ws + O_KD);
  const bf16_t* kka = (const bf16_t*)(p.ws + O_KKA);
  const bf16_t* kk = (const bf16_t*)(p.ws + O_KK);
  const bf16_t* za = (const bf16_t*)p.out;
  float* Y = (float*)(p.ws + O_Y);
  float* inb = (float*)lds;
  float* ypart = (float*)(lds + 98304);
  const int tid = tidx(), w = tid >> 6, lane = tid & 63, rg = lane >> 4, jl = lane & 15, j0 = jl * 4;
  for (int it = blockIdx.x; it < 256; it += gridDim.x) {
    const int sc = it >> 1, half = it & 1, d = sc >> 6, b = (sc >> 3) & 7, h = sc & 7;
    if (w >= 4) {
      const int lt = tid - 256;
      const bf16_t* src[6];
      int dsto[6], stepi[6], isw[6];
#pragma unroll
      for (int q = 0; q < 6; ++q) {
        const int pid = lt + q * 256, i = pid / 48, rem = pid % 48, arr = rem >> 3, pc = rem & 7;
        const bf16_t* base;
        size_t ld;
        if (arr == 0) { base = omw + (size_t)d * MT * 512 + h * 64; ld = 512; }
        else if (arr == 1) { base = kd + (size_t)d * MT * 512 + h * 64; ld = 512; }
        else if (arr == 2) { base = kka + (size_t)d * MT * 512 + h * 64; ld = 512; }
        else if (arr == 3) { base = kk + h * 64; ld = 512; }
        else if (arr == 4) { base = za + h * 64; ld = 2048; }
        else { base = za + 1024 + h * 64; ld = 2048; }
        const int t0 = d ? (4095 - i) : i;
        src[q] = base + ((size_t)(b * 4096 + t0)) * ld + pc * 8;
        stepi[q] = (int)ld * 32 * (d ? -1 : 1);
        dsto[q] = i * 384 + arr * 64 + pc * 8;
        isw[q] = (arr == 0);
      }
      u32x4 rr[6];
#pragma unroll
      for (int q = 0; q < 6; ++q) rr[q] = *(const u32x4*)(src[q]);
#pragma unroll
      for (int q = 0; q < 6; ++q) {
        float f[8];
        unpack8(rr[q], f);
        if (isw[q]) { for (int i = 0; i < 8; ++i) f[i] = 1.f - f[i]; }
        *(f32x4*)(inb + dsto[q]) = (f32x4){f[0], f[1], f[2], f[3]};
        *(f32x4*)(inb + dsto[q] + 4) = (f32x4){f[4], f[5], f[6], f[7]};
      }
#pragma unroll
      for (int q = 0; q < 6; ++q) rr[q] = *(const u32x4*)(src[q] + (ptrdiff_t)stepi[q]);
      __syncthreads();
      for (int c = 0; c < 128; ++c) {
        if (c + 1 < 128) {
          float* nb_ = inb + ((c + 1) & 1) * 12288;
#pragma unroll
          for (int q = 0; q < 6; ++q) {
            float f[8];
            unpack8(rr[q], f);
            if (isw[q]) { for (int i = 0; i < 8; ++i) f[i] = 1.f - f[i]; }
            *(f32x4*)(nb_ + dsto[q]) = (f32x4){f[0], f[1], f[2], f[3]};
            *(f32x4*)(nb_ + dsto[q] + 4) = (f32x4){f[4], f[5], f[6], f[7]};
          }
        }
        if (c + 2 < 128) {
#pragma unroll
          for (int q = 0; q < 6; ++q) rr[q] = *(const u32x4*)(src[q] + (ptrdiff_t)stepi[q] * (c + 2));
        }
        if (c > 0) {
          const int cc = c - 1, idx = lt * 4, i = idx >> 5, rl = idx & 31;
          const int t = d ? (4095 - (cc * 32 + i)) : (cc * 32 + i);
          const float* q = ypart + (cc & 1) * 4096 + i * 128 + rl;
          const f32x4 o = (*(const f32x4*)q + *(const f32x4*)(q + 32)) + (*(const f32x4*)(q + 64) + *(const f32x4*)(q + 96));
          *(f32x4*)(Y + ((size_t)d * MT + b * 4096 + t) * 512 + h * 64 + half * 32 + rl) = o;
        }
        __syncthreads();
      }
      {
        const int cc = 127, idx = lt * 4, i = idx >> 5, rl = idx & 31;
        const int t = d ? (4095 - (cc * 32 + i)) : (cc * 32 + i);
        const float* q = ypart + (cc & 1) * 4096 + i * 128 + rl;
        const f32x4 o = (*(const f32x4*)q + *(const f32x4*)(q + 32)) + (*(const f32x4*)(q + 64) + *(const f32x4*)(q + 96));
        *(f32x4*)(Y + ((size_t)d * MT + b * 4096 + t) * 512 + h * 64 + half * 32 + rl) = o;
      }
    } else {
      const int rowl = w * 8 + rg * 2, row = half * 32 + rowl;
      f32x2 a01 = (f32x2){0.f, 0.f}, a23 = a01, b01 = a01, b23 = a01;
      __syncthreads();
      for (int c = 0; c < 128; ++c) {
        const float* cur = inb + (c & 1) * 12288;
        float* yp = ypart + (c & 1) * 4096 + (jl >> 2) * 32 + rowl;
        f32x4 w4 = *(const f32x4*)(cur + j0), kd4 = *(const f32x4*)(cur + 64 + j0), ka4 = *(const f32x4*)(cur + 128 + j0),
              kk4 = *(const f32x4*)(cur + 192 + j0), r4 = *(const f32x4*)(cur + 256 + j0);
        f32x2 v2 = *(const f32x2*)(cur + 320 + row);
#pragma unroll 8
        for (int i = 0; i < 32; ++i) {
          const float* sn = cur + ((i + 1) & 31) * 384;
          const f32x4 nw4 = *(const f32x4*)(sn + j0), nkd4 = *(const f32x4*)(sn + 64 + j0), nka4 = *(const f32x4*)(sn + 128 + j0),
                      nkk4 = *(const f32x4*)(sn + 192 + j0), nr4 = *(const f32x4*)(sn + 256 + j0);
          const f32x2 nv2 = *(const f32x2*)(sn + 320 + row);
          const f32x2 ta = a01 * kk4.xy + a23 * kk4.zw, tb = b01 * kk4.xy + b23 * kk4.zw;
          const float ska = dpp_allreduce16(ta.x + ta.y), skb = dpp_allreduce16(tb.x + tb.y);
          a01 = a01 * w4.xy + (kd4.xy * v2.x - ka4.xy * ska);
          a23 = a23 * w4.zw + (kd4.zw * v2.x - ka4.zw * ska);
          b01 = b01 * w4.xy + (kd4.xy * v2.y - ka4.xy * skb);
          b23 = b23 * w4.zw + (kd4.zw * v2.y - ka4.zw * skb);
          const f32x2 ua = a01 * r4.xy + a23 * r4.zw, ub = b01 * r4.xy + b23 * r4.zw;
          f32x2 y;
          y.x = ua.x + ua.y; y.y = ub.x + ub.y;
          y.x += __int_as_float(__builtin_amdgcn_update_dpp(0, __float_as_int(y.x), 0xB1, 0xF, 0xF, true));
          y.y += __int_as_float(__builtin_amdgcn_update_dpp(0, __float_as_int(y.y), 0xB1, 0xF, 0xF, true));
          y.x += __int_as_float(__builtin_amdgcn_update_dpp(0, __float_as_int(y.x), 0x4E, 0xF, 0xF, true));
          y.y += __int_as_float(__builtin_amdgcn_update_dpp(0, __float_as_int(y.y), 0x4E, 0xF, 0xF, true));
          *(f32x2*)(yp + i * 128) = y;
          w4 = nw4; kd4 = nkd4; ka4 = nka4; kk4 = nkk4; r4 = nr4; v2 = nv2;
        }
        __syncthreads();
      }
    }
    __syncthreads();
  }
}

DEV void postB(const P& p) {
  const float* Y = (const float*)(p.ws + O_Y);
  const bf16_t* kd = (const bf16_t*)(p.ws + O_KD);
  const bf16_t* gg = (const bf16_t*)(p.ws + O_G);
  const bf16_t* za = (const bf16_t*)p.out;
  bf16_t* ycat = (bf16_t*)(p.ws + O_YCAT);
  const int lane = tidx() & 63, sub = lane >> 4, jl = lane & 15, gw = blockIdx.x * 8 + (tidx() >> 6), nw = gridDim.x * 8;
  for (int it = gw; it < MT * 2; it += nw) {
    const int item = it * 4 + sub, tok = item >> 3, h = item & 7, c = h * 64 + jl * 4;
    const f32x4 y0 = *(const f32x4*)(Y + (size_t)tok * 512 + c), y1 = *(const f32x4*)(Y + ((size_t)MT + tok) * 512 + c);
    const u32x2 k0 = *(const u32x2*)(kd + (size_t)tok * 512 + c), k1 = *(const u32x2*)(kd + ((size_t)MT + tok) * 512 + c);
    const u32x2 ru = *(const u32x2*)(za + (size_t)tok * 2048 + c), vu = *(const u32x2*)(za + (size_t)tok * 2048 + 1024 + c), gu = *(const u32x2*)(gg + (size_t)tok * 512 + c);
    const f32x4 lw = *(const f32x4*)(p.lnx_w + c), lb = *(const f32x4*)(p.lnx_b + c), rk = *(const f32x4*)(p.r_k + c);
    const f32x4 y = y0 + y1;
    const float mu = dpp_allreduce16((y[0] + y[1]) + (y[2] + y[3])) * (1.f / 64.f);
    const f32x4 dv = y - mu;
    const float var = dpp_allreduce16((dv[0] * dv[0] + dv[1] * dv[1]) + (dv[2] * dv[2] + dv[3] * dv[3])) * (1.f / 64.f);
    const float rs = rsqrtf(var + 64e-5f);
    const f32x4 r = (f32x4){lo16(ru.x), hi16(ru.x), lo16(ru.y), hi16(ru.y)}, v = (f32x4){lo16(vu.x), hi16(vu.x), lo16(vu.y), hi16(vu.y)};
    const f32x4 g = (f32x4){lo16(gu.x), hi16(gu.x), lo16(gu.y), hi16(gu.y)};
    const f32x4 kds = (f32x4){lo16(k0.x) + lo16(k1.x), hi16(k0.x) + hi16(k1.x), lo16(k0.y) + lo16(k1.y), hi16(k0.y) + hi16(k1.y)};
    const f32x4 t = r * kds * rk;
    const float bs = dpp_allreduce16((t[0] + t[1]) + (t[2] + t[3]));
    const f32x4 o = (dv * rs * lw + lb + v * bs) * g;
    u32x2 pk;
    pk.x = pk2(o[0], o[1]); pk.y = pk2(o[2], o[3]);
    *(u32x2*)(ycat + (size_t)tok * 1024 + c) = pk;
  }
}

DEV void glu_fixup(const P& p, int l) {
  const bf16_t* sb = (const bf16_t*)(p.ws + O_SB);
  bf16_t* act = (bf16_t*)(p.ws + O_ACT);
  const float* cw = p.ffn_conv + (size_t)l * 3 * 5632;
  const int gt = blockIdx.x * NTHR + tidx(), ngt = gridDim.x * NTHR;
  for (int item = gt; item < 512 * 2 * 352; item += ngt) {
    const int strip = item / 704, rem = item - strip * 704, e = rem / 352, c8 = (rem - e * 352) * 8;
    const int R = strip * 64 + (e ? 63 : 0), s = R & 4095;
    const int colg = (c8 >> 7) * 256 + (c8 & 127);
    const bf16_t* pc = sb + ((size_t)strip * 4 + (e ? 3 : 0)) * 5632 + colg;
    const bf16_t* pp = e ? (pc - 5632) : (pc - 5632);
    const bf16_t* pn = e ? (pc + 5632) : (pc + 5632);
    const u32x4 z0 = (u32x4){0u, 0u, 0u, 0u};
    const bool hasp = e ? true : (s > 0), hasn = e ? (s < 4095) : true;
    float gm[8], gc[8], gn[8], vm[8], vc[8], vn[8], o[8];
    unpack8(hasp ? *(const u32x4*)pp : z0, gm); unpack8(hasp ? *(const u32x4*)(pp + 128) : z0, vm);
    unpack8(*(const u32x4*)pc, gc); unpack8(*(const u32x4*)(pc + 128), vc);
    unpack8(hasn ? *(const u32x4*)pn : z0, gn); unpack8(hasn ? *(const u32x4*)(pn + 128) : z0, vn);
#pragma unroll
    for (int i = 0; i < 8; ++i) {
      const float g = gm[i] * cw[c8 + i] + gc[i] * cw[5632 + c8 + i] + gn[i] * cw[11264 + c8 + i];
      const float vv = vm[i] * cw[2816 + c8 + i] + vc[i] * cw[5632 + 2816 + c8 + i] + vn[i] * cw[11264 + 2816 + c8 + i];
      const float u2 = -1.5957691216057308f * (g + 0.044715f * g * g * g);
      o[i] = g * __builtin_amdgcn_rcpf(1.f + __expf(u2)) * vv;
    }
    *(u32x4*)(act + (size_t)R * 2816 + c8) = pack8(o);
  }
}

template <class Epi>
DEV void gemm_grid(char* lds, const bf16_t* A, int lda, const bf16_t* Bt, int ldb, int K, int tilesM, int tilesN, const Epi& epi) {
  const int nt = tilesM * tilesN;
  u32x4 ra[4], rb[2];
  int t = blockIdx.x;
  if (t < nt) gemm_first_load(A + (size_t)(t / tilesN) * 256 * lda, lda, Bt + (size_t)(t % tilesN) * 128 * ldb, ldb, ra, rb);
  for (; t < nt; t += gridDim.x) {
    const int tm = t / tilesN, tn = t % tilesN, t2 = t + gridDim.x;
    const bf16_t* An = (t2 < nt) ? A + (size_t)(t2 / tilesN) * 256 * lda : nullptr;
    const bf16_t* Bn = (t2 < nt) ? Bt + (size_t)(t2 % tilesN) * 128 * ldb : nullptr;
    gemm_tile(lds, A + (size_t)tm * 256 * lda, lda, Bt + (size_t)tn * 128 * ldb, ldb, K, tm * 256, tn * 128, epi, ra, rb, An, Bn);
  }
}


DEV void dft_fold(const P& p) {
  const bf16_t* CST = (const bf16_t*)(p.ws + O_CST);
  bf16_t* CF = (bf16_t*)(p.ws + O_CSTF);
  for (int idx = blockIdx.x * NTHR + tidx(); idx < 16384 * 256; idx += gridDim.x * NTHR) {
    const int r = idx >> 8, s8 = (idx & 255) * 8, eo = (r >> 10) & 1;
    const bf16_t* src = CST + (size_t)r * 4096;
    float a[8], bq[8], o[8];
    unpack8(*(const u32x4*)(src + s8), a);
    if (s8 == 0) {
      unpack8(*(const u32x4*)(src + 4088), bq);
      o[0] = eo ? 0.f : a[0];
#pragma unroll
      for (int i = 1; i < 8; ++i) o[i] = eo ? (a[i] - bq[8 - i]) : (a[i] + bq[8 - i]);
      if (!eo) ((float*)(p.ws + O_C2048))[(r >> 11) * 1024 + (r & 1023)] = bf2f(src[2048]) * (1.f / 64.f);
    } else {
      unpack8(*(const u32x4*)(src + 4096 - s8 - 8), bq);
      const float b0 = bf2f(src[4096 - s8]);
      o[0] = eo ? (a[0] - b0) : (a[0] + b0);
#pragma unroll
      for (int i = 1; i < 8; ++i) o[i] = eo ? (a[i] - bq[8 - i]) : (a[i] + bq[8 - i]);
    }
    *(u32x4*)(CF + (size_t)r * 2048 + s8) = pack8(o);
  }
}

DEV void dft_combine(const P& p) {
  const bf16_t* EO = (const bf16_t*)(p.ws + O_EO);
  const bf16_t* CST = (const bf16_t*)(p.ws + O_CST);
  bf16_t* f = (bf16_t*)(p.ws + O_F);
  for (int idx = blockIdx.x * NTHR + tidx(); idx < 8 * 2048 * 256; idx += gridDim.x * NTHR) {
    const int c4 = (idx & 255) * 4, k1 = (idx >> 8) & 2047, b = idx >> 19;
    const u32x2 eu = *(const u32x2*)(EO + ((size_t)(b * 2) * 2048 + k1) * 1024 + c4), ou = *(const u32x2*)(EO + ((size_t)(b * 2 + 1) * 2048 + k1) * 1024 + c4);
    f32x4 e = (f32x4){lo16(eu.x), hi16(eu.x), lo16(eu.y), hi16(eu.y)};
    const f32x4 o = (f32x4){lo16(ou.x), hi16(ou.x), lo16(ou.y), hi16(ou.y)};
    {
      const f32x4 cm = *(const f32x4*)((const float*)(p.ws + O_C2048) + b * 1024 + c4);
      e = (k1 & 1) ? (e - cm) : (e + cm);
    }
    const f32x4 d = e - o, s = e + o;
    u32x2 pk;
    pk.x = pk2(d[0], d[1]); pk.y = pk2(d[2], d[3]);
    *(u32x2*)(f + ((size_t)b * 4096 + k1) * 1024 + c4) = pk;
    if (k1 > 0) {
      pk.x = pk2(s[0], s[1]); pk.y = pk2(s[2], s[3]);
      *(u32x2*)(f + ((size_t)b * 4096 + 4096 - k1) * 1024 + c4) = pk;
    }
  }
  {
    const int lane = tidx() & 63, gw = blockIdx.x * 8 + (tidx() >> 6), nw = gridDim.x * 8;
    for (int r = gw; r < 8 * 1024; r += nw) {
      const int b = r >> 10, n = r & 1023;
      const bf16_t* cp = CST + ((size_t)(b * 2) * 1024 + n) * 4096;
      float acc = 0.f;
#pragma unroll
      for (int j = 0; j < 8; ++j) {
        const u32x4 u = *(const u32x4*)(cp + j * 512 + lane * 8);
        acc += (lo16(u.x) - hi16(u.x)) + (lo16(u.y) - hi16(u.y)) + (lo16(u.z) - hi16(u.z)) + (lo16(u.w) - hi16(u.w));
      }
      acc = wave_sum(acc);
      if (lane == 0) f[((size_t)b * 4096 + 2048) * 1024 + n] = f2bf(acc * (1.f / 64.f));
    }
  }
}

#define LDSP ((PG8_LAS unsigned char*)lds)
template <class Epi>
DEV void pgemm(char* lds, const bf16_t* A, const bf16_t* Bt, int M_, int N_, int K_, const Epi& E) {
  pg8::Gemm g{A, Bt, M_, N_, K_};
  pg8::StaticOrder S;
  S.init(M_, N_, (int)gridDim.x, (int)blockIdx.x);
  pg8::gemm_phase<Epi, pg8::StaticOrder, true, true>(LDSP, g, S, E);
}

DEV void ffn(char* lds, const XcdBarrier& xbar, const P& p, int l) {
  const bf16_t* h = (const bf16_t*)(p.ws + O_H);
  bf16_t* act = (bf16_t*)(p.ws + O_ACT);
  bf16_t* yf = (bf16_t*)(p.ws + O_YF);
  const bf16_t* upt = (const bf16_t*)(p.ws + W_UP) + (size_t)l * 5632 * 1024;
  const bf16_t* dnt = (const bf16_t*)(p.ws + W_DOWN) + (size_t)l * 1024 * 2816;
  pgemm(lds, h, upt, MT, 5632, 1024, pg8::PEpiGlu{act, (bf16_t*)(p.ws + O_SB), p.ffn_conv + (size_t)l * 3 * 5632});
  xcd_barrier(xbar);
  glu_fixup(p, l);
  xcd_barrier(xbar);
  pgemm(lds, act, dnt, MT, 1024, 2816, pg8::PEpiBf16<false>{yf, 1024});
  xcd_barrier(xbar);
}

DEV const P& kargs() {
  auto q = __builtin_amdgcn_kernarg_segment_ptr();
  asm volatile("" : "+s"(q));
  return *(const P*)q;
}
#define p (kargs())
__global__ void __launch_bounds__(NTHR) mega(P parg_unused) {
  extern __shared__ __attribute__((aligned(16))) char lds[];
  cg::grid_group grid = cg::this_grid();
  char* ws = p.ws;
  if (tidx() < 4) ((unsigned*)(lds + 131072))[tidx()] = 0u;
  __syncthreads();
  const XcdBarrier xbar = xcd_barrier_post((unsigned*)(ws + W_BAR), (volatile XLAS unsigned*)(lds + 131072));
  float* mod = (float*)(ws + W_MOD);
  const int gt = blockIdx.x * NTHR + tidx(), ngt = gridDim.x * NTHR;

  for (int rep_ = 0; rep_ < REP_PRO; ++rep_) {
  if (rep_ > 0) xcd_barrier(xbar);
  compute_mod(lds, p);
  transpose_convert(lds, p.mix_in, 1024, 3584, (bf16_t*)(ws + W_MIXIN), 1024, 0);
  for (int l = 0; l < 2; ++l) {
    transpose_convert(lds, p.ffn_up + (size_t)l * 1024 * 5632, 1024, 5632, (bf16_t*)(ws + W_UP) + (size_t)l * 5632 * 1024, 1024, 64 * l, true);
    transpose_convert(lds, p.ffn_down + (size_t)l * 2816 * 1024, 2816, 1024, (bf16_t*)(ws + W_DOWN) + (size_t)l * 1024 * 2816, 2816, 128 + 64 * l);
  }
  transpose_convert(lds, p.mix_out, 1024, 1024, (bf16_t*)(ws + W_MIXOUT), 1024, 32);
  transpose_convert(lds, p.fnet_w, 1024, 1024, (bf16_t*)(ws + W_FNET), 1024, 96);
  for (int d = 0; d < 2; ++d) {
    transpose_convert(lds, p.w1 + (size_t)d * 512 * 64, 512, 64, (bf16_t*)(ws + W_L1) + (size_t)(d * 64) * 512, 512, 8 * d);
    transpose_convert(lds, p.a1 + (size_t)d * 512 * 64, 512, 64, (bf16_t*)(ws + W_L1) + (size_t)(128 + d * 64) * 512, 512, 16 + 8 * d);
    transpose_convert(lds, p.w2 + (size_t)d * 64 * 512, 64, 512, (bf16_t*)(ws + W_W2) + (size_t)d * 512 * 64, 64, 48 + 8 * d);
    transpose_convert(lds, p.a2 + (size_t)d * 64 * 512, 64, 512, (bf16_t*)(ws + W_A2) + (size_t)d * 512 * 64, 64, 64 + 8 * d);
  }
  transpose_convert(lds, p.g1, 512, 128, (bf16_t*)(ws + W_L1) + (size_t)256 * 512, 512, 32);
  transpose_convert(lds, p.g2, 128, 512, (bf16_t*)(ws + W_G2), 128, 80);
  {
    float* rope = (float*)(ws + W_ROPE);
    for (int idx = gt; idx < 4096 * 32; idx += ngt) {
      const int s = idx >> 5, e = idx & 31;
      const float inv = powf(10000.f, -(float)e / 32.f);
      const float ang = (float)s * inv;
      float sv, cv;
      sincosf(ang, &sv, &cv);
      rope[2 * idx] = cv;
      rope[2 * idx + 1] = sv;
    }
    bf16_t* dftc = (bf16_t*)(ws + W_DFTC);
    for (int idx = gt; idx < 256 * 128; idx += ngt) {
      const int n = idx >> 7, c = idx & 127, k2 = n & 127;
      const float ph = (float)((k2 * c) & 127) * (1.f / 64.f);
      const float v = (n < 128) ? cospif(ph) : sinpif(ph);
      dftc[idx] = f2bf(v * 0.08838834764831845f);
    }
  }
  }
  grid.sync();
  for (int rep_ = 0; rep_ < REP_ROW; ++rep_) { rowpass<false, true>(p.x, nullptr, nullptr, nullptr, nullptr, p.norm_g, mod + 1024, mod, (bf16_t*)(ws + O_H0)); xcd_barrier(xbar); }
  pgemm(lds, (const bf16_t*)(ws + O_H0), (const bf16_t*)(ws + W_MIXIN), MT, INC, 1024, pg8::PEpiBf16<false>{(bf16_t*)(ws + O_Z), INC});
  xcd_barrier(xbar);
  for (int rep_ = 0; rep_ < REP_PREP; ++rep_) { prep1(p); xcd_barrier(xbar); }
  for (int rep_ = 0; rep_ < REP_ATT; ++rep_) { attention(lds, p); xcd_barrier(xbar); }
  combineA(p);
  gemm_grid(lds, (const bf16_t*)p.out + 1536, 2048, (const bf16_t*)(ws + W_L1), 512, 512, 128, 3, EpiLora1{(bf16_t*)(ws + O_L1)});
  xcd_barrier(xbar);
  for (int rep_ = 0; rep_ < REP_LORA; ++rep_) {
  for (int d = 0; d < 2; ++d) {
    gemm_grid(lds, (const bf16_t*)(ws + O_L1) + d * 64, 384, (const bf16_t*)(ws + W_W2) + (size_t)d * 512 * 64, 64, 64, 128, 4,
              EpiDecay{(bf16_t*)(ws + O_OMW) + (size_t)d * MT * 512, p.w0 + d * 512});
    gemm_grid(lds, (const bf16_t*)(ws + O_L1) + 128 + d * 64, 384, (const bf16_t*)(ws + W_A2) + (size_t)d * 512 * 64, 64, 64, 128, 4,
              EpiA{(bf16_t*)(ws + O_KD) + (size_t)d * MT * 512, (bf16_t*)(ws + O_KKA) + (size_t)d * MT * 512, (bf16_t*)(ws + O_KK), p.a0 + d * 512,
                   p.k_k, p.k_a, (const bf16_t*)p.out, d == 0});
  }
  gemm_grid(lds, (const bf16_t*)(ws + O_L1) + 256, 384, (const bf16_t*)(ws + W_G2), 128, 128, 128, 4, EpiBf16{(bf16_t*)(ws + O_G), 512});
  xcd_barrier(xbar);
  }
  for (int rep_ = 0; rep_ < REP_SCAN; ++rep_) { scan_phase(lds, p); xcd_barrier(xbar); }
  for (int rep_ = 0; rep_ < REP_SYNC; ++rep_) xcd_barrier(xbar);
  postB(p);
  xcd_barrier(xbar);
  pgemm(lds, (const bf16_t*)(ws + O_YCAT), (const bf16_t*)(ws + W_MIXOUT), MT, 1024, 1024, pg8::PEpiBf16<false>{(bf16_t*)(ws + O_YF), 1024});
  xcd_barrier(xbar);
  rowpass<true, true, false, true>(p.x, (const bf16_t*)(ws + O_YF), p.norm_g + 1024, mod + 2048, ws + O_XB, p.norm_g + 2048, mod + 4096, mod + 3072, (bf16_t*)(ws + O_H));
  xcd_barrier(xbar);
  ffn(lds, xbar, p, 0);
  {
    const float* mod1 = mod + 8 * 6144;
    rowpass<true, true, true, true>(ws + O_XB, (const bf16_t*)(ws + O_YF), p.norm_g + 3072, mod + 5120, ws + O_XB, p.norm_g + 4096, mod1 + 1024, mod1, (bf16_t*)(ws + O_H));
    bf16_t* cs = (bf16_t*)(ws + O_COSSIN);
    for (int idx = blockIdx.x * NTHR + tidx(); idx < 4096 * 256; idx += gridDim.x * NTHR) {
      const int rr = idx >> 8, s8 = (idx & 255) * 8, k1 = rr & 2047;
      float o[8];
#pragma unroll
      for (int i = 0; i < 8; ++i) {
        const float ph = (float)((k1 * (s8 + i)) & 4095) * (1.f / 2048.f);
        o[i] = ((rr < 2048) ? cospif(ph) : sinpif(ph)) * (1.f / 64.f);
      }
      *(u32x4*)(cs + (size_t)rr * 2048 + s8) = pack8(o);
    }
    xcd_barrier(xbar);
    {
      const bf16_t* dA = (const bf16_t*)(ws + W_DFTC);
      const bf16_t* hB = (const bf16_t*)(ws + O_H);
      u32x4 ra[4], rb[2];
      int t = blockIdx.x;
      if (t < 8 * 256) gemm_first_load(dA, 128, hB + (size_t)(t & 255) * 128 * 1024 + (t >> 8) * 128, 1024, ra, rb);
      for (; t < 8 * 256; t += gridDim.x) {
        const int g = t >> 8, tn = t & 255, t2 = t + gridDim.x;
        const bf16_t* Bn = (t2 < 8 * 256) ? hB + (size_t)(t2 & 255) * 128 * 1024 + (t2 >> 8) * 128 : nullptr;
        gemm_tile(lds, dA, 128, hB + (size_t)tn * 128 * 1024 + g * 128, 1024, 128, 0, tn * 128, EpiDftc{(bf16_t*)(ws + O_CST), g}, ra, rb,
                  Bn ? dA : nullptr, Bn);
      }
    }
    xcd_barrier(xbar);
    dft_fold(p);
    xcd_barrier(xbar);
    {
      pg8::Gemm g{(const bf16_t*)(ws + O_COSSIN), (const bf16_t*)(ws + O_CSTF), 4096, 16384, 2048};
      pg8::BatchOrder S{(int)gridDim.x, (int)blockIdx.x};
      pg8::gemm_phase<pg8::PEpiF32B, pg8::BatchOrder, true, true>(LDSP, g, S, pg8::PEpiF32B{(bf16_t*)(ws + O_EO)});
    }
    xcd_barrier(xbar);
    dft_combine(p);
    xcd_barrier(xbar);
    pgemm(lds, (const bf16_t*)(ws + O_F), (const bf16_t*)(ws + W_FNET), MT, 1024, 1024, pg8::PEpiBf16<false>{(bf16_t*)(ws + O_YF), 1024});
    xcd_barrier(xbar);
    rowpass<true, true, true, true>(ws + O_XB, (const bf16_t*)(ws + O_YF), p.norm_g + 4096 + 1024, mod1 + 2048, ws + O_XB, p.norm_g + 4096 + 2048, mod1 + 4096, mod1 + 3072,
                        (bf16_t*)(ws + O_H));
    xcd_barrier(xbar);
    ffn(lds, xbar, p, 1);
    rowpass<true, false, true, false>(ws + O_XB, (const bf16_t*)(ws + O_YF), p.norm_g + 4096 + 3072, mod1 + 5120, p.out, nullptr, nullptr, nullptr, nullptr);
  }
}

#undef p
extern "C" void kernel_launch(void* const* d_in, const int* in_sizes, int n_in, void* d_out, int out_size, void* d_ws, size_t ws_size,
                              hipStream_t stream) {
  static int grid_blocks = 0;
  if (!grid_blocks) {
    int dev = 0, cus = 0, per_cu = 0;
    hipGetDevice(&dev);
    hipDeviceGetAttribute(&cus, hipDeviceAttributeMultiprocessorCount, dev);
    hipFuncSetAttribute((const void*)mega, hipFuncAttributeMaxDynamicSharedMemorySize, LDS_BYTES);
    hipOccupancyMaxActiveBlocksPerMultiprocessor(&per_cu, (const void*)mega, NTHR, LDS_BYTES);
    if (per_cu < 1) { fprintf(stderr, "occupancy query returned %d\n", per_cu); per_cu = 1; }
    if (per_cu > 1) per_cu = 1;
    grid_blocks = cus * per_cu;
  }
  P p{};
  const float** pp = (const float**)&p;
  for (int i = 0; i < 25; ++i) pp[i] = (const float*)d_in[i];
  p.out = (float*)d_out;
  p.ws = (char*)d_ws;
  (void)hipMemsetAsync((char*)d_ws + W_BAR, 0, XCD_BAR_WORDS * sizeof(unsigned), stream);
  void* args[] = {&p};
  hipError_t e = hipLaunchCooperativeKernel((const void*)mega, dim3(grid_blocks), dim3(NTHR), args, LDS_BYTES, stream);
  if (e != hipSuccess) fprintf(stderr, "cooperative launch failed: %s (grid %d)\n", hipGetErrorString(e), grid_blocks);
}
```

```cpp
#include <hip/hip_runtime.h>
#include <hip/hip_cooperative_groups.h>
#include <stdint.h>
#include <cstdio>
namespace cg = cooperative_groups;

typedef unsigned short bf16_t;
typedef short bf16x8 __attribute__((ext_vector_type(8)));
typedef short s16x4 __attribute__((ext_vector_type(4)));
typedef float f32x4 __attribute__((ext_vector_type(4)));
typedef float f32x2 __attribute__((ext_vector_type(2)));
typedef unsigned u32x4 __attribute__((ext_vector_type(4)));
typedef unsigned u32x2 __attribute__((ext_vector_type(2)));

#define DEV __device__ __forceinline__
__device__ __forceinline__ int tidx() { int t = threadIdx.x; asm volatile("" : "+v"(t)); return t; }

constexpr int NB = 8, SEQ = 4096, DM = 1024, MT = NB * SEQ, DFF = 2816, INC = 3584;
constexpr size_t MiB = 1024 * 1024;
constexpr int NTHR = 512;
constexpr int LDS_BYTES = 131072 + 16;
constexpr size_t W_BAR = 47 * 1024 * 1024;
#ifndef REP_SCAN
#define REP_SCAN 1
#endif
#ifndef REP_ATT
#define REP_ATT 1
#endif
#ifndef REP_SYNC
#define REP_SYNC 0
#endif
#ifndef REP_PREP
#define REP_PREP 1
#endif
#ifndef REP_LORA
#define REP_LORA 1
#endif
#ifndef REP_GLU
#define REP_GLU 1
#endif
#ifndef REP_PRO
#define REP_PRO 1
#endif
#ifndef REP_ROW
#define REP_ROW 1
#endif

constexpr size_t W_MIXIN = 0;
constexpr size_t W_UP = 7 * MiB;
constexpr size_t W_DOWN = 29 * MiB;
constexpr size_t W_MIXOUT = 40 * MiB;
constexpr size_t W_FNET = 42 * MiB;
constexpr size_t W_L1 = 44 * MiB;
constexpr size_t W_W2 = W_L1 + 512 * 1024;
constexpr size_t W_A2 = W_W2 + 128 * 1024;
constexpr size_t W_G2 = W_A2 + 128 * 1024;
constexpr size_t W_DFTC = W_G2 + 128 * 1024;
constexpr size_t W_MOD = 45 * MiB;
constexpr size_t W_ROPE = 46 * MiB;
constexpr size_t R0 = 48 * MiB;
constexpr size_t O_H0 = R0;
constexpr size_t O_Z = 112 * MiB;
constexpr size_t O_SBZ = 304 * MiB;
constexpr size_t O_QR = 336 * MiB, O_KR = 368 * MiB, O_VT = 400 * MiB;
constexpr size_t O_NUM = R0;
constexpr size_t O_MD = 240 * MiB;
constexpr size_t O_YCAT = 448 * MiB;
constexpr size_t O_OMW = 48 * MiB, O_KD = 112 * MiB, O_KKA = 176 * MiB, O_KK = 240 * MiB, O_G = 272 * MiB, O_L1 = 304 * MiB, O_Y = 304 * MiB;
constexpr size_t O_YF = 48 * MiB;
constexpr size_t O_H = 176 * MiB;
constexpr size_t O_ZF = 240 * MiB;
constexpr size_t O_ACT = 240 * MiB;
constexpr size_t O_SB = 416 * MiB;
constexpr size_t O_COSSIN = 240 * MiB;
constexpr size_t O_CST = 304 * MiB;
constexpr size_t O_F = 432 * MiB;
constexpr size_t O_CSTF = 432 * MiB;
constexpr size_t O_C2048 = 272 * MiB;
constexpr size_t O_EO = 48 * MiB;
constexpr size_t O_XB = 112 * MiB;

struct P {
  const float *x, *c, *ada_w, *ada_b, *norm_g, *mix_in, *mix_conv, *w0, *w1, *w2, *a0, *a1, *a2, *g1, *g2, *k_k, *k_a, *r_k, *lnx_w,
      *lnx_b, *mix_out, *fnet_w, *ffn_up, *ffn_conv, *ffn_down;
  float* out;
  char* ws;
};

DEV float bf2f(bf16_t h) { return __uint_as_float(((unsigned)h) << 16); }
DEV bf16_t f2bf(float f) {
  unsigned u = __float_as_uint(f);
  u += 0x7fffu + ((u >> 16) & 1u);
  return (bf16_t)(u >> 16);
}
DEV unsigned pk2(float a, float b) { return (unsigned)f2bf(a) | ((unsigned)f2bf(b) << 16); }
DEV float lo16(unsigned u) { return __uint_as_float(u << 16); }
DEV float hi16(unsigned u) { return __uint_as_float(u & 0xffff0000u); }
DEV float wave_sum(float v) {
#pragma unroll
  for (int o = 32; o; o >>= 1) v += __shfl_xor(v, o);
  return v;
}
DEV float sigmoidf_(float x) { return __builtin_amdgcn_rcpf(1.f + __expf(-x)); }

#include <cstdint>
#include <cstdlib>
#include <vector>

#define XB_TMO      128
#define XB_XCNT(j)  (256  + 64 * (j))
#define XB_XSUB(j)  (1280 + 64 * (j))
#define XB_XGEN(j)  (2304 + 64 * (j))
#define XB_TOP      3328
#define XB_TOPGEN   3392
#define XCD_BAR_WORDS 3456
#define XB_SPIN_CAP (1u << 18)
#define XLAS __attribute__((address_space(3)))

__device__ __forceinline__ unsigned xb_ld(unsigned* p)              { return __hip_atomic_load(p, __ATOMIC_RELAXED, __HIP_MEMORY_SCOPE_AGENT); }
__device__ __forceinline__ unsigned xb_add(unsigned* p, unsigned v) { return __hip_atomic_fetch_add(p, v, __ATOMIC_RELAXED, __HIP_MEMORY_SCOPE_AGENT); }
__device__ __forceinline__ unsigned xb_xcc_id() { return (unsigned)__builtin_amdgcn_s_getreg((3 << 11) | 20) & 0xFu; }
#define XB_SPIN(cond, bar) do { unsigned _sp = 0; while (cond) { __builtin_amdgcn_s_sleep(1); \
    if ((++_sp & 255u) == 0u) { if (xb_ld(&(bar)[XB_TMO])) break; if (_sp > XB_SPIN_CAP) { atomicAdd(&(bar)[XB_TMO], 1u); break; } } } } while (0)

struct XcdBarrier {
    unsigned* bar; unsigned x;
    volatile XLAS unsigned* st;
};

__device__ __forceinline__ XcdBarrier xcd_barrier_post(unsigned* bar, volatile XLAS unsigned* st) {
    XcdBarrier b; b.bar = bar; b.x = xb_xcc_id(); b.st = st;
    if (threadIdx.x == 0) (void)xb_add(&bar[XB_XCNT(b.x)], 1u);
    return b;
}
__device__ __forceinline__ void xcd_barrier_complete(unsigned* bar, unsigned x, unsigned& nloc, unsigned& nx) {
    const unsigned G = gridDim.x * gridDim.y * gridDim.z;
    unsigned sum, cnt, mine, sp = 0u;
    for (;;) {
        sum = 0u; cnt = 0u; mine = 0u;
#pragma unroll
        for (unsigned j = 0; j < 16; ++j) { const unsigned c = xb_ld(&bar[XB_XCNT(j)]); sum += c; cnt += (c > 0u) ? 1u : 0u; mine = (j == x) ? c : mine; }
        if (sum == G) break;
        __builtin_amdgcn_s_sleep(1);
        if ((++sp & 255u) == 0u) { if (xb_ld(&bar[XB_TMO])) break; if (sp > XB_SPIN_CAP) { atomicAdd(&bar[XB_TMO], 1u); break; } }
    }
    nloc = mine > 0u ? mine : 1u; nx = cnt > 0u ? cnt : 1u;
}

__device__ __forceinline__ void xcd_barrier(const XcdBarrier& b) {
    asm volatile("s_waitcnt vmcnt(0)" ::: "memory");
    __syncthreads();
    if (threadIdx.x == 0) {
        unsigned* bar = b.bar;
        __builtin_amdgcn_s_waitcnt(0);
        unsigned nloc = b.st[0], nx = b.st[1];
        if (nloc == 0u) { xcd_barrier_complete(bar, b.x, nloc, nx); b.st[0] = nloc; b.st[1] = nx; }
        const unsigned old = xb_add(&bar[XB_XSUB(b.x)], 1u);
        const unsigned gen = old / nloc;
        if (old + 1u == (gen + 1u) * nloc) {
            __builtin_amdgcn_fence(__ATOMIC_RELEASE, "agent");
            asm volatile("s_waitcnt vmcnt(0)" ::: "memory");
            const unsigned og = xb_add(&bar[XB_TOP], 1u);
            const unsigned tg = og / nx;
            if (og + 1u == (tg + 1u) * nx) xb_add(&bar[XB_TOPGEN], 1u);
            else XB_SPIN(xb_ld(&bar[XB_TOPGEN]) == tg, bar);
            __builtin_amdgcn_fence(__ATOMIC_ACQUIRE, "agent");
            xb_add(&bar[XB_XGEN(b.x)], 1u);
            asm volatile("s_waitcnt vmcnt(0)" ::: "memory");
        } else {
            XB_SPIN(xb_ld(&bar[XB_XGEN(b.x)]) == gen, bar);
            __builtin_amdgcn_fence(__ATOMIC_ACQUIRE, "agent");
            asm volatile("s_waitcnt vmcnt(0)" ::: "memory");
        }
    }
    __syncthreads();
}

namespace pg8 {
#define PG8_LAS __attribute__((address_space(3)))
typedef unsigned short bf16_t;
typedef short bf16x8 __attribute__((ext_vector_type(8)));
typedef float f32x4 __attribute__((ext_vector_type(4)));
typedef unsigned u32x4 __attribute__((ext_vector_type(4)));
constexpr int BM = 256, BK = 64, HALF = 128, HTB = HALF * BK * 2  , STAGE_BYTES = 8 * HTB, NXCD = 8, WGM = 8;

__host__ __device__ __forceinline__ int lds_byte(int r, int c) { const int st = (r >> 4) * 2 + (c >> 5), rr = r & 15, cc = c & 31, ob = rr * 64 + cc * 2; return st * 1024 + (ob ^ (((ob >> 9) & 1) << 5)); }
__host__ __device__ __forceinline__ void stage_rc(int b, int& R, int& C) { const int st = b / 1024, sb = b % 1024, swz = sb ^ (((sb >> 9) & 1) << 5); R = (st >> 1) * 16 + swz / 64; C = (st & 1) * 32 + (swz % 64) / 2; }
__host__ __device__ __forceinline__ int perm32(int rho) { const int n = rho >> 4, i = rho & 15; return 8 * (i >> 2) + 4 * n + (i & 3); }

struct Unit { int pm, pn; };
struct Gemm { const bf16_t* A; const bf16_t* Bt; int M, N, K; };

struct StaticOrder {
    int nM, nN, nwg, G, c;
    __host__ __device__ void init(int M, int N, int G_, int c_) { nM = M / BM; nN = N / BM; nwg = nM * nN; G = G_; c = c_; }
    __host__ __device__ bool next(int i, Unit& u) const {
        const long L = (long)i * G + c; if (L >= nwg) return false;
        int wgid = (int)L; { const int q = nwg / NXCD, r = nwg % NXCD, xcd = wgid % NXCD, off = wgid / NXCD; wgid = (xcd < r ? xcd * (q + 1) : r * (q + 1) + (xcd - r) * q) + off; }
        const int nig = WGM * nN, gid = wgid / nig, fm = gid * WGM, gsz = (nM - fm) < WGM ? (nM - fm) : WGM;
        u.pm = fm + ((wgid % nig) % gsz); u.pn = (wgid % nig) / gsz; return true;
    }
    __device__ __forceinline__ void a_ready(const Unit&) const {}
    __device__ __forceinline__ void done(const Unit&) const {}
};

__device__ __forceinline__ unsigned cvt_pk_bf16(float lo, float hi) { unsigned r; asm volatile("v_cvt_pk_bf16_f32 %0, %1, %2" : "=v"(r) : "v"(lo), "v"(hi)); return r; }

template <bool BATCHED> struct PEpiBf16 {
    static constexpr bool PERM = true, AFTER_DRAIN = false;
    bf16_t* O; int ldc;
    __device__ __forceinline__ void operator()(const f32x4 (&acc)[2][2][4][2], const Unit& u, int wr, int wc, int fr, int fq) const {
        const int rb = BATCHED ? ((u.pn >> 2) * 4096 + u.pm * 256) : u.pm * 256, cb = BATCHED ? (u.pn & 3) * 256 : u.pn * 256;
        const int row0 = rb + wr * 64 + fr, col0 = cb + wc * 32 + 8 * fq;
#pragma unroll
        for (int ai = 0; ai < 2; ++ai)
#pragma unroll
            for (int m = 0; m < 4; ++m) { bf16_t* rowp = O + (size_t)(row0 + ai * HALF + m * 16) * ldc + col0;
#pragma unroll
                for (int bj = 0; bj < 2; ++bj) { const f32x4 v0 = acc[ai][bj][m][0], v1 = acc[ai][bj][m][1];
                    u32x4 w; w.x = cvt_pk_bf16(v0[0], v0[1]); w.y = cvt_pk_bf16(v0[2], v0[3]); w.z = cvt_pk_bf16(v1[0], v1[1]); w.w = cvt_pk_bf16(v1[2], v1[3]);
                    *(u32x4*)(rowp + bj * HALF) = w; } }
    }
};
struct PEpiF32 {
    static constexpr bool PERM = true, AFTER_DRAIN = false;
    float* O; int ldc;
    __device__ __forceinline__ void operator()(const f32x4 (&acc)[2][2][4][2], const Unit& u, int wr, int wc, int fr, int fq) const {
        const int row0 = u.pm * 256 + wr * 64 + fr, col0 = u.pn * 256 + wc * 32 + 8 * fq;
#pragma unroll
        for (int ai = 0; ai < 2; ++ai)
#pragma unroll
            for (int m = 0; m < 4; ++m) { float* rowp = O + (size_t)(row0 + ai * HALF + m * 16) * ldc + col0;
#pragma unroll
                for (int bj = 0; bj < 2; ++bj) { *(f32x4*)(rowp + bj * HALF) = acc[ai][bj][m][0]; *(f32x4*)(rowp + bj * HALF + 4) = acc[ai][bj][m][1]; } }
    }
};
template <int CTRL> __device__ __forceinline__ float dppz(float x) { return __int_as_float(__builtin_amdgcn_update_dpp(0, __float_as_int(x), CTRL, 0xF, 0xF, true)); }
template <int CTRL> __device__ __forceinline__ float dppo(float old, float x) { return __int_as_float(__builtin_amdgcn_update_dpp(__float_as_int(old), __float_as_int(x), CTRL, 0xF, 0xF, false)); }
struct PEpiGlu {
    static constexpr bool PERM = true, AFTER_DRAIN = false;
    bf16_t* act; bf16_t* sb; const float* cw;
    __device__ __forceinline__ void operator()(const f32x4 (&acc)[2][2][4][2], const Unit& u, int wr, int wc, int fr, int fq) const {
        const int chb = u.pn * 128 + wc * 32 + 8 * fq, colp = u.pn * 256 + wc * 32 + 8 * fq;
#pragma unroll
        for (int n = 0; n < 2; ++n) {
            const int ch = chb + 4 * n;
            const f32x4 g0 = *(const f32x4*)(cw + ch), g1 = *(const f32x4*)(cw + 5632 + ch), g2 = *(const f32x4*)(cw + 11264 + ch);
            const f32x4 v0 = *(const f32x4*)(cw + 2816 + ch), v1 = *(const f32x4*)(cw + 5632 + 2816 + ch), v2 = *(const f32x4*)(cw + 11264 + 2816 + ch);
#pragma unroll
            for (int ai = 0; ai < 2; ++ai) {
                const int strip = u.pm * 4 + ai * 2 + wr, rowbase = u.pm * 256 + ai * HALF + wr * 64;
#pragma unroll
                for (int m = 0; m < 4; ++m) {
                    float o[4];
#pragma unroll
                    for (int r = 0; r < 4; ++r) {
                        const float gc = acc[ai][0][m][n][r], vc = acc[ai][1][m][n][r];
                        float gx = 0.f, vx = 0.f, gy = 0.f, vy = 0.f;
                        if (m > 0) { gx = dppz<0x121>(acc[ai][0][m - 1][n][r]); vx = dppz<0x121>(acc[ai][1][m - 1][n][r]); }
                        const float gp = dppo<0x111>(gx, gc), vp = dppo<0x111>(vx, vc);
                        if (m < 3) { gy = dppz<0x12F>(acc[ai][0][m + 1][n][r]); vy = dppz<0x12F>(acc[ai][1][m + 1][n][r]); }
                        const float gn = dppo<0x101>(gy, gc), vn = dppo<0x101>(vy, vc);
                        const float g = gp * g0[r] + gc * g1[r] + gn * g2[r];
                        const float v = vp * v0[r] + vc * v1[r] + vn * v2[r];
                        const float u2 = -1.5957691216057308f * (g + 0.044715f * g * g * g);
                        o[r] = g * __builtin_amdgcn_rcpf(1.f + __expf(u2)) * v;
                    }
                    u32x2 w; w.x = cvt_pk_bf16(o[0], o[1]); w.y = cvt_pk_bf16(o[2], o[3]);
                    *(u32x2*)(act + (size_t)(rowbase + m * 16 + fr) * 2816 + ch) = w;
                }
                if (fr < 2) {
                    bf16_t* sp = sb + ((size_t)strip * 4 + fr) * 5632 + colp + 4 * n;
                    u32x2 w; w.x = cvt_pk_bf16(acc[ai][0][0][n][0], acc[ai][0][0][n][1]); w.y = cvt_pk_bf16(acc[ai][0][0][n][2], acc[ai][0][0][n][3]);
                    *(u32x2*)sp = w;
                    w.x = cvt_pk_bf16(acc[ai][1][0][n][0], acc[ai][1][0][n][1]); w.y = cvt_pk_bf16(acc[ai][1][0][n][2], acc[ai][1][0][n][3]);
                    *(u32x2*)(sp + 128) = w;
                }
                if (fr >= 14) {
                    bf16_t* sp = sb + ((size_t)strip * 4 + (fr - 12)) * 5632 + colp + 4 * n;
                    u32x2 w; w.x = cvt_pk_bf16(acc[ai][0][3][n][0], acc[ai][0][3][n][1]); w.y = cvt_pk_bf16(acc[ai][0][3][n][2], acc[ai][0][3][n][3]);
                    *(u32x2*)sp = w;
                    w.x = cvt_pk_bf16(acc[ai][1][3][n][0], acc[ai][1][3][n][1]); w.y = cvt_pk_bf16(acc[ai][1][3][n][2], acc[ai][1][3][n][3]);
                    *(u32x2*)(sp + 128) = w;
                }
            }
        }
    }
};
struct PEpiMixIn {
    static constexpr bool PERM = true, AFTER_DRAIN = false;
    bf16_t *za, *sbz, *qr, *kr, *vr; const float *cw, *rope;
    __device__ __forceinline__ void operator()(const f32x4 (&acc)[2][2][4][2], const Unit& u, int wr, int wc, int fr, int fq) const {
        if (u.pn < 8) {
#pragma unroll
            for (int bj = 0; bj < 2; ++bj)
#pragma unroll
                for (int n = 0; n < 2; ++n) {
                    const int col = u.pn * 256 + bj * HALF + wc * 32 + 8 * fq + 4 * n;
                    const f32x4 w0 = *(const f32x4*)(cw + col), w1 = *(const f32x4*)(cw + 2048 + col), w2 = *(const f32x4*)(cw + 4096 + col);
#pragma unroll
                    for (int ai = 0; ai < 2; ++ai) {
                        const int strip = u.pm * 4 + ai * 2 + wr, rowbase = u.pm * 256 + ai * HALF + wr * 64;
#pragma unroll
                        for (int m = 0; m < 4; ++m) {
                            float o[4];
#pragma unroll
                            for (int r = 0; r < 4; ++r) {
                                const float c = acc[ai][bj][m][n][r];
                                float x = 0.f, y = 0.f;
                                if (m > 0) x = dppz<0x121>(acc[ai][bj][m - 1][n][r]);
                                const float pv = dppo<0x111>(x, c);
                                if (m < 3) y = dppz<0x12F>(acc[ai][bj][m + 1][n][r]);
                                const float nx = dppo<0x101>(y, c);
                                o[r] = pv * w0[r] + c * w1[r] + nx * w2[r];
                            }
                            u32x2 w; w.x = cvt_pk_bf16(o[0], o[1]); w.y = cvt_pk_bf16(o[2], o[3]);
                            *(u32x2*)(za + (size_t)(rowbase + m * 16 + fr) * 2048 + col) = w;
                        }
                        if (fr < 2) { u32x2 w; w.x = cvt_pk_bf16(acc[ai][bj][0][n][0], acc[ai][bj][0][n][1]); w.y = cvt_pk_bf16(acc[ai][bj][0][n][2], acc[ai][bj][0][n][3]);
                            *(u32x2*)(sbz + ((size_t)strip * 4 + fr) * 2048 + col) = w; }
                        if (fr >= 14) { u32x2 w; w.x = cvt_pk_bf16(acc[ai][bj][3][n][0], acc[ai][bj][3][n][1]); w.y = cvt_pk_bf16(acc[ai][bj][3][n][2], acc[ai][bj][3][n][3]);
                            *(u32x2*)(sbz + ((size_t)strip * 4 + (fr - 12)) * 2048 + col) = w; }
                    }
                }
        } else if (u.pn < 12) {
            const int which = (u.pn - 8) >> 1;
            bf16_t* dst = which ? kr : qr;
            const float scl = which ? 1.f : 0.125f;
#pragma unroll
            for (int bj = 0; bj < 2; ++bj) {
                const int cq = ((u.pn - 8) & 1) * 256 + bj * HALF + wc * 32 + 8 * fq, h = cq >> 6, j0 = (cq & 63) >> 1;
#pragma unroll
                for (int ai = 0; ai < 2; ++ai)
#pragma unroll
                    for (int m = 0; m < 4; ++m) {
                        const int row = u.pm * 256 + ai * HALF + wr * 64 + m * 16 + fr, s = row & 4095;
                        const float* rp = rope + ((size_t)s * 32 + j0) * 2;
                        const f32x4 t0 = *(const f32x4*)rp, t1 = *(const f32x4*)(rp + 4);
                        const f32x4 a = acc[ai][bj][m][0], b = acc[ai][bj][m][1];
                        float o1[4], o2[4];
                        o1[0] = (a[0] * t0[0] - a[1] * t0[1]) * scl; o2[0] = (a[1] * t0[0] + a[0] * t0[1]) * scl;
                        o1[1] = (a[2] * t0[2] - a[3] * t0[3]) * scl; o2[1] = (a[3] * t0[2] + a[2] * t0[3]) * scl;
                        o1[2] = (b[0] * t1[0] - b[1] * t1[1]) * scl; o2[2] = (b[1] * t1[0] + b[0] * t1[1]) * scl;
                        o1[3] = (b[2] * t1[2] - b[3] * t1[3]) * scl; o2[3] = (b[3] * t1[2] + b[2] * t1[3]) * scl;
                        bf16_t* dp = dst + (size_t)row * 512 + h * 64 + j0;
                        u32x2 w; w.x = cvt_pk_bf16(o1[0], o1[1]); w.y = cvt_pk_bf16(o1[2], o1[3]); *(u32x2*)dp = w;
                        w.x = cvt_pk_bf16(o2[0], o2[1]); w.y = cvt_pk_bf16(o2[2], o2[3]); *(u32x2*)(dp + 32) = w;
                    }
            }
        } else {
#pragma unroll
            for (int bj = 0; bj < 2; ++bj) {
                const int cv = (u.pn - 12) * 256 + bj * HALF + wc * 32 + 8 * fq;
#pragma unroll
                for (int ai = 0; ai < 2; ++ai)
#pragma unroll
                    for (int m = 0; m < 4; ++m) {
                        const int row = u.pm * 256 + ai * HALF + wr * 64 + m * 16 + fr;
                        const f32x4 v0 = acc[ai][bj][m][0], v1 = acc[ai][bj][m][1];
                        u32x4 w; w.x = cvt_pk_bf16(v0[0], v0[1]); w.y = cvt_pk_bf16(v0[2], v0[3]); w.z = cvt_pk_bf16(v1[0], v1[1]); w.w = cvt_pk_bf16(v1[2], v1[3]);
                        *(u32x4*)(vr + (size_t)row * 512 + cv) = w;
                    }
            }
        }
    }
};
struct PEpiF32B {
    static constexpr bool PERM = true, AFTER_DRAIN = false;
    bf16_t* O;
    __device__ __forceinline__ void operator()(const f32x4 (&acc)[2][2][4][2], const Unit& u, int wr, int wc, int fr, int fq) const {
        const int row0 = (u.pn >> 2) * 2048 + (u.pm & 7) * 256 + wr * 64 + fr, col0 = (u.pn & 3) * 256 + wc * 32 + 8 * fq;
#pragma unroll
        for (int ai = 0; ai < 2; ++ai)
#pragma unroll
            for (int m = 0; m < 4; ++m) { bf16_t* rowp = O + (size_t)(row0 + ai * HALF + m * 16) * 1024 + col0;
#pragma unroll
                for (int bj = 0; bj < 2; ++bj) { const f32x4 v0 = acc[ai][bj][m][0], v1 = acc[ai][bj][m][1];
                    u32x4 w; w.x = cvt_pk_bf16(v0[0], v0[1]); w.y = cvt_pk_bf16(v0[2], v0[3]); w.z = cvt_pk_bf16(v1[0], v1[1]); w.w = cvt_pk_bf16(v1[2], v1[3]);
                    *(u32x4*)(rowp + bj * HALF) = w; } }
    }
};
struct BatchOrder {
    int G, c;
    __device__ __forceinline__ bool next(int i, Unit& u) const { const int L = i * G + c; if (L >= 512) return false; const int be = L >> 5, r = L & 31; u.pm = (be & 1) * 8 + (r >> 2); u.pn = be * 4 + (r & 3); return true; }
    __device__ __forceinline__ void a_ready(const Unit&) const {}
    __device__ __forceinline__ void done(const Unit&) const {}
};
template <class Epi, class Sched, bool ALIGN_EPI = false, bool SP2 = false>
__device__ __forceinline__ void gemm_phase(PG8_LAS unsigned char* lds, const Gemm g, const Sched& S, const Epi& E) {
    int tid_ = threadIdx.x; asm volatile("" : "+v"(tid_));
    const int tid = tid_, wid = __builtin_amdgcn_readfirstlane(tid >> 6), lane = tid & 63, wr = wid >> 2, wc = wid & 3, fr = lane & 15, fq = lane >> 4;
    const int K = g.K, nt = K / BK;
    unsigned voffA[2], voffB[2];
#pragma unroll
    for (int i = 0; i < 2; ++i) { int R, C; stage_rc(tid * 16 + i * 8192, R, C); const int Rb = Epi::PERM ? ((R & ~31) + perm32(R & 31)) : R;
        voffA[i] = (unsigned)(R * K + C) * 2u; voffB[i] = (unsigned)(Rb * K + C) * 2u; }
    const size_t kstep = (size_t)(BK * 2);
    const size_t hstep = (size_t)HALF * K * 2;
    const size_t tstep = 2 * hstep;
    const unsigned ldsw = (unsigned)wid * 1024u;
    const int aoff = lds_byte(wr * 64 + fr, fq * 8), boff = lds_byte(wc * 32 + fr, fq * 8);
#define PG8_SA(b, h) (((b) * 2 + (h)) * HTB)
#define PG8_SB(b, h) ((4 + (b) * 2 + (h)) * HTB)
#define PG8_STAGE(bufoff, gbase, voff) do { _Pragma("unroll") for (int _i = 0; _i < 2; ++_i) \
        __builtin_amdgcn_global_load_lds((const unsigned*)((const char*)(gbase) + (voff)[_i]), (PG8_LAS unsigned*)(lds + (bufoff) + ldsw + _i * 8192), 16, 0, 0); } while (0)
#define PG8_LDA(dst, b, h) do { _Pragma("unroll") for (int m = 0; m < 4; ++m) _Pragma("unroll") for (int k = 0; k < 2; ++k) dst[m][k] = *(const PG8_LAS bf16x8*)(lds + PG8_SA(b, h) + aoff + m * 2048 + k * 1024); } while (0)
#define PG8_LDB(dst, b, h) do { _Pragma("unroll") for (int n = 0; n < 2; ++n) _Pragma("unroll") for (int k = 0; k < 2; ++k) dst[n][k] = *(const PG8_LAS bf16x8*)(lds + PG8_SB(b, h) + boff + n * 2048 + k * 1024); } while (0)
#define PG8_MMA(ai, bj, At, Bt) do { __builtin_amdgcn_s_setprio(1); _Pragma("unroll") for (int m = 0; m < 4; ++m) _Pragma("unroll") for (int n = 0; n < 2; ++n) _Pragma("unroll") for (int k = 0; k < 2; ++k) \
        acc[ai][bj][m][n] = __builtin_amdgcn_mfma_f32_16x16x32_bf16(Bt[n][k], At[m][k], acc[ai][bj][m][n], 0, 0, 0); __builtin_amdgcn_s_setprio(0); } while (0)
#define PG8_WAIT_V(n) asm volatile("s_waitcnt vmcnt(" #n ")" ::: "memory")
#define PG8_WAIT_L(n) asm volatile("s_waitcnt lgkmcnt(" #n ")" ::: "memory")
#define PG8_BAR __builtin_amdgcn_s_barrier()
#define PG8_SCHED __builtin_amdgcn_sched_barrier(0)
    Unit cur, nxt; int ui = 0;
    if (!S.next(0, cur)) return;
    f32x4 acc[2][2][4][2];
#pragma unroll
    for (int a = 0; a < 2; ++a)
#pragma unroll
        for (int b = 0; b < 2; ++b)
#pragma unroll
            for (int m = 0; m < 4; ++m)
#pragma unroll
                for (int n = 0; n < 2; ++n) acc[a][b][m][n] = (f32x4){0.f, 0.f, 0.f, 0.f};
    bf16x8 At[4][2], B0[2][2], B1[2][2];
    const char* cA = (const char*)g.A + (size_t)cur.pm * tstep; const char* cB = (const char*)g.Bt + (size_t)cur.pn * tstep;
    S.a_ready(cur);
    if constexpr (SP2) {
        PG8_STAGE(PG8_SB(0, 0), cB, voffB); PG8_STAGE(PG8_SB(0, 1), cB + hstep, voffB); PG8_STAGE(PG8_SA(0, 0), cA, voffA); PG8_STAGE(PG8_SA(0, 1), cA + hstep, voffA);
        if (wr == 1) PG8_BAR;
        PG8_WAIT_V(2); PG8_BAR;
        PG8_STAGE(PG8_SB(1, 0), cB + kstep, voffB); PG8_STAGE(PG8_SA(1, 0), cA + kstep, voffA); PG8_STAGE(PG8_SB(1, 1), cB + hstep + kstep, voffB);
        PG8_WAIT_V(6); PG8_BAR;
    } else {
        PG8_STAGE(PG8_SB(0, 0), cB, voffB); PG8_STAGE(PG8_SA(0, 0), cA, voffA); PG8_STAGE(PG8_SB(0, 1), cB + hstep, voffB); PG8_STAGE(PG8_SA(0, 1), cA + hstep, voffA);
        if (wr == 1) PG8_BAR;
        PG8_WAIT_V(4); PG8_BAR;
        PG8_STAGE(PG8_SB(1, 0), cB + kstep, voffB); PG8_STAGE(PG8_SA(1, 0), cA + kstep, voffA); PG8_STAGE(PG8_SB(1, 1), cB + hstep + kstep, voffB);
        PG8_WAIT_V(6); PG8_BAR;
    }
    for (;;) {
        const bool has_next = S.next(ui + 1, nxt);
        const char* nA = has_next ? (const char*)g.A + (size_t)nxt.pm * tstep : cA; const char* nB = has_next ? (const char*)g.Bt + (size_t)nxt.pn * tstep : cB;
        for (int t = 0; t < nt; t += 2) {
            const bool last = (t == nt - 2);
            const char* a1 = cA + (size_t)(t + 1) * kstep;
            const char* a2 = last ? nA : cA + (size_t)(t + 2) * kstep; const char* b2 = last ? nB : cB + (size_t)(t + 2) * kstep;
            const char* a3 = a2 + kstep; const char* b3 = b2 + kstep;
            if (last && has_next) S.a_ready(nxt);
            if constexpr (SP2) {
            PG8_LDB(B0, 0, 0); PG8_LDB(B1, 0, 1); PG8_SCHED; PG8_LDA(At, 0, 0); PG8_STAGE(PG8_SA(1, 1), a1 + hstep, voffA);
            PG8_WAIT_V(8); PG8_WAIT_L(0); PG8_BAR; PG8_MMA(0, 0, At, B0); PG8_MMA(0, 1, At, B1); PG8_BAR; PG8_SCHED;
            PG8_LDA(At, 0, 1); PG8_STAGE(PG8_SB(0, 0), b2, voffB); PG8_STAGE(PG8_SB(0, 1), b2 + hstep, voffB); PG8_STAGE(PG8_SA(0, 0), a2, voffA);
            PG8_WAIT_V(8); PG8_WAIT_L(0); PG8_BAR; PG8_MMA(1, 0, At, B0); PG8_MMA(1, 1, At, B1); PG8_BAR; PG8_SCHED;
            PG8_LDB(B0, 1, 0); PG8_LDB(B1, 1, 1); PG8_SCHED; PG8_LDA(At, 1, 0); PG8_STAGE(PG8_SA(0, 1), a2 + hstep, voffA);
            PG8_WAIT_V(8); PG8_WAIT_L(0); PG8_BAR; PG8_MMA(0, 0, At, B0); PG8_MMA(0, 1, At, B1); PG8_BAR; PG8_SCHED;
            PG8_LDA(At, 1, 1); PG8_STAGE(PG8_SB(1, 0), b3, voffB); PG8_STAGE(PG8_SB(1, 1), b3 + hstep, voffB); PG8_STAGE(PG8_SA(1, 0), a3, voffA);
            PG8_WAIT_V(8); PG8_WAIT_L(0); PG8_BAR; PG8_MMA(1, 0, At, B0); PG8_MMA(1, 1, At, B1); PG8_BAR; PG8_SCHED;
            } else {
            PG8_LDB(B0, 0, 0); PG8_SCHED; PG8_LDA(At, 0, 0); PG8_STAGE(PG8_SA(1, 1), a1 + hstep, voffA);
            PG8_WAIT_L(8); PG8_BAR; PG8_WAIT_L(0); PG8_MMA(0, 0, At, B0); PG8_BAR; PG8_SCHED;
            PG8_LDB(B1, 0, 1); PG8_STAGE(PG8_SB(0, 0), b2, voffB);
            PG8_BAR; PG8_WAIT_L(0); PG8_MMA(0, 1, At, B1); PG8_BAR;
            PG8_LDA(At, 0, 1); PG8_STAGE(PG8_SA(0, 0), a2, voffA);
            PG8_BAR; PG8_WAIT_L(0); PG8_MMA(1, 0, At, B0); PG8_BAR; PG8_SCHED;
            PG8_STAGE(PG8_SB(0, 1), b2 + hstep, voffB);
            PG8_WAIT_V(6); PG8_BAR; PG8_MMA(1, 1, At, B1); PG8_BAR;
            PG8_LDB(B0, 1, 0); PG8_SCHED; PG8_LDA(At, 1, 0); PG8_STAGE(PG8_SA(0, 1), a2 + hstep, voffA);
            PG8_WAIT_L(8); PG8_BAR; PG8_WAIT_L(0); PG8_MMA(0, 0, At, B0); PG8_BAR; PG8_SCHED;
            PG8_LDB(B1, 1, 1); PG8_STAGE(PG8_SB(1, 0), b3, voffB);
            PG8_BAR; PG8_WAIT_L(0); PG8_MMA(0, 1, At, B1); PG8_BAR;
            PG8_LDA(At, 1, 1); PG8_STAGE(PG8_SA(1, 0), a3, voffA);
            PG8_BAR; PG8_WAIT_L(0); PG8_MMA(1, 0, At, B0); PG8_BAR; PG8_SCHED;
            PG8_STAGE(PG8_SB(1, 1), b3 + hstep, voffB);
            PG8_WAIT_V(6); PG8_BAR; PG8_MMA(1, 1, At, B1); PG8_BAR;
            }
        }
        if constexpr (ALIGN_EPI) { if (wr == 0) PG8_BAR; }
        if constexpr (!Epi::AFTER_DRAIN) { E(acc, cur, wr, wc, fr, fq); S.done(cur); }
        if (!has_next) break;
#pragma unroll
        for (int a = 0; a < 2; ++a)
#pragma unroll
            for (int b = 0; b < 2; ++b)
#pragma unroll
                for (int m = 0; m < 4; ++m)
#pragma unroll
                    for (int n = 0; n < 2; ++n) acc[a][b][m][n] = (f32x4){0.f, 0.f, 0.f, 0.f};
        cur = nxt; cA = nA; cB = nB; ++ui;
        if constexpr (ALIGN_EPI) { if (wr == 1) PG8_BAR; }
    }
    PG8_WAIT_V(0);
    if constexpr (!ALIGN_EPI) { if (wr == 0) PG8_BAR; }
    PG8_BAR;
    if constexpr (Epi::AFTER_DRAIN) { E.fused(acc, cur, wr, wc, fr, fq, lds, wid, lane); S.done(cur); }
#undef PG8_SA
#undef PG8_SB
#undef PG8_STAGE
#undef PG8_LDA
#undef PG8_LDB
#undef PG8_MMA
#undef PG8_WAIT_V
#undef PG8_WAIT_L
#undef PG8_BAR
#undef PG8_SCHED
}
}

DEV void gemm_first_load(const bf16_t* __restrict__ A, int lda, const bf16_t* __restrict__ Bt, int ldb, u32x4 (&ra)[4], u32x4 (&rb)[2]) {
  const int tid = tidx(), w = tid >> 6, l = tid & 63, lr = l & 15, lq = l >> 4;
#pragma unroll
  for (int j = 0; j < 4; ++j) {
    const int c = w * 4 + j, mt = c >> 1, sl = c & 1;
    ra[j] = *(const u32x4*)(A + (size_t)(mt * 16 + lr) * lda + sl * 32 + lq * 8);
  }
#pragma unroll
  for (int j = 0; j < 2; ++j) {
    const int nt = w, sl = j;
    const int rowb = (nt >> 2) * 64 + (lr >> 2) * 16 + (nt & 3) * 4 + (lr & 3);
    rb[j] = *(const u32x4*)(Bt + (size_t)rowb * ldb + sl * 32 + lq * 8);
  }
}
template <class Epi>
DEV void gemm_tile(char* lds, const bf16_t* __restrict__ A, int lda, const bf16_t* __restrict__ Bt, int ldb, int K, int trow, int tcol,
                   const Epi& epi, u32x4 (&ra)[4], u32x4 (&rb)[2], const bf16_t* __restrict__ An, const bf16_t* __restrict__ Bn) {
  const int tid = tidx(), w = tid >> 6, l = tid & 63, wm = w >> 1, wn = w & 1, lr = l & 15, lq = l >> 4;
  const bf16_t* ga[4];
  const bf16_t* gb[2];
#pragma unroll
  for (int j = 0; j < 4; ++j) {
    const int c = w * 4 + j, mt = c >> 1, sl = c & 1;
    ga[j] = A + (size_t)(mt * 16 + lr) * lda + sl * 32 + lq * 8;
  }
#pragma unroll
  for (int j = 0; j < 2; ++j) {
    const int nt = w, sl = j;
    const int rowb = (nt >> 2) * 64 + (lr >> 2) * 16 + (nt & 3) * 4 + (lr & 3);
    gb[j] = Bt + (size_t)rowb * ldb + sl * 32 + lq * 8;
  }
  f32x4 acc[4][4];
#pragma unroll
  for (int i = 0; i < 4; ++i)
#pragma unroll
    for (int j = 0; j < 4; ++j) acc[i][j] = (f32x4){0.f, 0.f, 0.f, 0.f};
  const int nk = K >> 6;
#pragma unroll
  for (int j = 0; j < 4; ++j) *(u32x4*)(lds + (w * 4 + j) * 1024 + l * 16) = ra[j];
#pragma unroll
  for (int j = 0; j < 2; ++j) *(u32x4*)(lds + 32768 + (w * 2 + j) * 1024 + l * 16) = rb[j];
  __syncthreads();
  for (int kt = 0; kt < nk; ++kt) {
    char* cur = lds + (kt & 1) * 49152;
    const bool more = (kt + 1 < nk);
    if (more) {
#pragma unroll
      for (int j = 0; j < 4; ++j) ra[j] = *(const u32x4*)(ga[j] + (kt + 1) * 64);
#pragma unroll
      for (int j = 0; j < 2; ++j) rb[j] = *(const u32x4*)(gb[j] + (kt + 1) * 64);
    }
#pragma unroll
    for (int s = 0; s < 2; ++s) {
      bf16x8 af[4], bfr[4];
#pragma unroll
      for (int i = 0; i < 4; ++i) af[i] = *(const bf16x8*)(cur + ((wm * 4 + i) * 2 + s) * 1024 + l * 16);
#pragma unroll
      for (int j = 0; j < 4; ++j) bfr[j] = *(const bf16x8*)(cur + 32768 + ((wn * 4 + j) * 2 + s) * 1024 + l * 16);
#pragma unroll
      for (int i = 0; i < 4; ++i)
#pragma unroll
        for (int j = 0; j < 4; ++j) acc[i][j] = __builtin_amdgcn_mfma_f32_16x16x32_bf16(bfr[j], af[i], acc[i][j], 0, 0, 0);
    }
    if (more) {
      char* nxt = lds + ((kt + 1) & 1) * 49152;
#pragma unroll
      for (int j = 0; j < 4; ++j) *(u32x4*)(nxt + (w * 4 + j) * 1024 + l * 16) = ra[j];
#pragma unroll
      for (int j = 0; j < 2; ++j) *(u32x4*)(nxt + 32768 + (w * 2 + j) * 1024 + l * 16) = rb[j];
    }
    __syncthreads();
  }
  if (An) gemm_first_load(An, lda, Bn, ldb, ra, rb);
#pragma unroll
  for (int i = 0; i < 4; ++i) epi(trow + wm * 64 + i * 16 + lr, tcol + wn * 64 + lq * 16, acc[i]);
}

DEV void store16_bf16(bf16_t* dst, const f32x4 (&v)[4], float sc) {
  u32x4 a, b;
  a.x = pk2(v[0][0] * sc, v[0][1] * sc); a.y = pk2(v[0][2] * sc, v[0][3] * sc);
  a.z = pk2(v[1][0] * sc, v[1][1] * sc); a.w = pk2(v[1][2] * sc, v[1][3] * sc);
  b.x = pk2(v[2][0] * sc, v[2][1] * sc); b.y = pk2(v[2][2] * sc, v[2][3] * sc);
  b.z = pk2(v[3][0] * sc, v[3][1] * sc); b.w = pk2(v[3][2] * sc, v[3][3] * sc);
  *(u32x4*)dst = a;
  *(u32x4*)(dst + 8) = b;
}

struct EpiBf16 {
  bf16_t* O; int ldo;
  DEV void operator()(int row, int col, const f32x4 (&v)[4]) const { store16_bf16(O + (size_t)row * ldo + col, v, 1.f); }
};
struct EpiF32 {
  float* O; int ldo;
  DEV void operator()(int row, int col, const f32x4 (&v)[4]) const {
    float* d = O + (size_t)row * ldo + col;
#pragma unroll
    for (int j = 0; j < 4; ++j) *(f32x4*)(d + 4 * j) = v[j];
  }
};
struct EpiLora1 {
  bf16_t* O;
  DEV void operator()(int row, int col, const f32x4 (&v)[4]) const {
    f32x4 o[4];
#pragma unroll
    for (int j = 0; j < 4; ++j)
#pragma unroll
      for (int r = 0; r < 4; ++r) {
        const float t = v[j][r];
        o[j][r] = (col < 128) ? (1.f - 2.f * __builtin_amdgcn_rcpf(1.f + __expf(2.f * t))) : ((col < 256) ? t : sigmoidf_(t));
      }
    store16_bf16(O + (size_t)row * 384 + col, o, 1.f);
  }
};
struct EpiDecay {
  bf16_t* O; const float* w0;
  DEV void operator()(int row, int col, const f32x4 (&v)[4]) const {
    f32x4 o[4];
    float w0v[16];
#pragma unroll
    for (int i = 0; i < 16; i += 4) *(f32x4*)(w0v + i) = *(const f32x4*)(w0 + col + i);
#pragma unroll
    for (int j = 0; j < 4; ++j)
#pragma unroll
      for (int r = 0; r < 4; ++r) {
        const float xx = w0v[4 * j + r] + v[j][r];
        const float nx = -xx;
        const float sp = (nx > 20.f) ? nx : __logf(1.f + __expf(nx));
        const float e = __expf(-sp - 0.5f);
        o[j][r] = 1.f - __expf(-e);
      }
    store16_bf16(O + (size_t)row * 512 + col, o, 1.f);
  }
};
struct EpiA {
  bf16_t *KD, *KKA, *KK; const float *a0, *k_k, *k_a; const bf16_t* za; int writekk;
  DEV void operator()(int row, int col, const f32x4 (&v)[4]) const {
    const bf16_t* kp = za + (size_t)row * 2048 + 512 + col;
    const u32x4 k0 = *(const u32x4*)kp, k1 = *(const u32x4*)(kp + 8);
    float kf[16];
    kf[0] = lo16(k0.x); kf[1] = hi16(k0.x); kf[2] = lo16(k0.y); kf[3] = hi16(k0.y); kf[4] = lo16(k0.z); kf[5] = hi16(k0.z); kf[6] = lo16(k0.w); kf[7] = hi16(k0.w);
    kf[8] = lo16(k1.x); kf[9] = hi16(k1.x); kf[10] = lo16(k1.y); kf[11] = hi16(k1.y); kf[12] = lo16(k1.z); kf[13] = hi16(k1.z); kf[14] = lo16(k1.w); kf[15] = hi16(k1.w);
    float kkv[16], a0v[16], kav[16];
#pragma unroll
    for (int i = 0; i < 16; i += 4) { *(f32x4*)(kkv + i) = *(const f32x4*)(k_k + col + i); *(f32x4*)(a0v + i) = *(const f32x4*)(a0 + col + i); *(f32x4*)(kav + i) = *(const f32x4*)(k_a + col + i); }
    float kr[16], ss = 0.f;
#pragma unroll
    for (int i = 0; i < 16; ++i) { kr[i] = kf[i] * kkv[i]; ss += kr[i] * kr[i]; }
    ss += __shfl_xor(ss, 16);
    ss += __shfl_xor(ss, 32);
    const float rn = rsqrtf(ss + 1e-12f);
    f32x4 okd[4], okka[4], okk[4];
#pragma unroll
    for (int j = 0; j < 4; ++j)
#pragma unroll
      for (int r = 0; r < 4; ++r) {
        const int i = 4 * j + r;
        const float a = sigmoidf_(a0v[i] + v[j][r]);
        const float kk = kr[i] * rn;
        okd[j][r] = kf[i] * (1.f + (a - 1.f) * kav[i]);
        okka[j][r] = kk * a;
        okk[j][r] = kk;
      }
    store16_bf16(KD + (size_t)row * 512 + col, okd, 1.f);
    store16_bf16(KKA + (size_t)row * 512 + col, okka, 1.f);
    if (writekk) store16_bf16(KK + (size_t)row * 512 + col, okk, 1.f);
  }
};
struct EpiDftc {
  bf16_t* CST; int g;
  DEV void operator()(int row, int col, const f32x4 (&v)[4]) const {
    const int b = col >> 12, s = col & 4095;
    store16_bf16(CST + ((size_t)((b * 2 + (row >> 7)) * 1024 + g * 128 + (row & 127)) * 4096 + s), v, 1.f);
  }
};

DEV void transpose_convert(char* lds, const float* __restrict__ W, int K, int N, bf16_t* __restrict__ Wt, int ldt, int rot, int mode = 0) {
  float* tile = (float*)lds;
  const int tn_n = N >> 6, nt = (K >> 6) * tn_n, tid = tidx();
  const int r0 = tid >> 4, c4 = (tid & 15) * 4;
  int t = (blockIdx.x + rot) % gridDim.x;
  f32x4 ra, rb;
  if (t < nt) {
    const int tk = t / tn_n, tn = t % tn_n;
    const float* src = W + (size_t)(tk * 64 + r0) * N + tn * 64 + c4;
    ra = *(const f32x4*)src; rb = *(const f32x4*)(src + (size_t)32 * N);
  }
  for (; t < nt; t += gridDim.x) {
    const int tk = t / tn_n, tn = t % tn_n;
#pragma unroll
    for (int i = 0; i < 4; ++i) { tile[r0 * 65 + c4 + i] = ra[i]; tile[(r0 + 32) * 65 + c4 + i] = rb[i]; }
    __syncthreads();
    const int t2 = t + gridDim.x;
    if (t2 < nt) {
      const int tk2 = t2 / tn_n, tn2 = t2 % tn_n;
      const float* src = W + (size_t)(tk2 * 64 + r0) * N + tn2 * 64 + c4;
      ra = *(const f32x4*)src; rb = *(const f32x4*)(src + (size_t)32 * N);
    }
    int nbase = tn * 64;
    if (mode == 1) { const int c = tn * 64; nbase = (c < 2816) ? ((c >> 7) * 256 + (c & 127)) : (((c - 2816) >> 7) * 256 + 128 + ((c - 2816) & 127)); }
    const bool qk = (mode == 2) && (tn * 64 >= 2048) && (tn * 64 < 3072);
#pragma unroll
    for (int j = 0; j < 2; ++j) {
      const int ns = r0 + 32 * j;
      const int n = qk ? (2 * (ns & 31) + (ns >> 5)) : ns;
      u32x2 pk;
      pk.x = pk2(tile[(c4 + 0) * 65 + ns], tile[(c4 + 1) * 65 + ns]);
      pk.y = pk2(tile[(c4 + 2) * 65 + ns], tile[(c4 + 3) * 65 + ns]);
      *(u32x2*)(Wt + (size_t)(nbase + n) * ldt + tk * 64 + c4) = pk;
    }
    __syncthreads();
  }
}

DEV void compute_mod(char* lds, const P& p) {
  float* cs = (float*)lds;
  float* red = (float*)(lds + 32768);
  const int tid = tidx();
  float* mod = (float*)(p.ws + W_MOD);
  bool have = false;
  for (int item = blockIdx.x; item < 192; item += gridDim.x) {
    if (!have) {
      for (int i = tid; i < 8192; i += NTHR) { const float cv = p.c[i]; cs[i] = cv / (1.f + expf(-cv)); }
      __syncthreads();
      have = true;
    }
    const int l = item / 96, cb = item % 96, col = cb * 64 + (tid & 63), kg = tid >> 6;
    float a0 = 0, a1 = 0, a2 = 0, a3 = 0, a4 = 0, a5 = 0, a6 = 0, a7 = 0;
    const float* wp = p.ada_w + ((size_t)l * 1024 + kg * 128) * 6144 + col;
    for (int k = 0; k < 128; ++k) {
      const float wv = wp[(size_t)k * 6144];
      const int kk = kg * 128 + k;
      a0 += cs[kk] * wv; a1 += cs[1024 + kk] * wv; a2 += cs[2048 + kk] * wv; a3 += cs[3072 + kk] * wv;
      a4 += cs[4096 + kk] * wv; a5 += cs[5120 + kk] * wv; a6 += cs[6144 + kk] * wv; a7 += cs[7168 + kk] * wv;
    }
    float* rp = red + kg * 512 + (tid & 63);
    rp[0] = a0; rp[64] = a1; rp[128] = a2; rp[192] = a3; rp[256] = a4; rp[320] = a5; rp[384] = a6; rp[448] = a7;
    __syncthreads();
    {
      const int b = tid >> 6, cc = tid & 63;
      float s = 0.f;
#pragma unroll
      for (int g = 0; g < 8; ++g) s += red[g * 512 + b * 64 + cc];
      mod[(size_t)(l * 8 + b) * 6144 + cb * 64 + cc] = s + p.ada_b[l * 6144 + cb * 64 + cc];
    }
    __syncthreads();
  }
}

template <bool HAS_Y, bool HAS_H, bool XIN_BF = false, bool XOUT_BF = false>
DEV void rowpass(const void* __restrict__ xin_, const bf16_t* __restrict__ yf, const float* __restrict__ gy, const float* __restrict__ gate,
                 void* __restrict__ xout_, const float* __restrict__ gh, const float* __restrict__ sc, const float* __restrict__ sh,
                 bf16_t* __restrict__ h) {
  const float* xin = (const float*)xin_; const bf16_t* xinb = (const bf16_t*)xin_;
  float* xout = (float*)xout_; bf16_t* xoutb = (bf16_t*)xout_;
  const int lane = tidx() & 63, gw = blockIdx.x * 8 + (tidx() >> 6), nw = gridDim.x * 8;
  for (int row = gw; row < MT; row += nw) {
    const int b = row >> 12;
    f32x4 xv[4];
#pragma unroll
    for (int i = 0; i < 4; ++i) {
      if (XIN_BF) { const u32x2 xu = *(const u32x2*)(xinb + (size_t)row * 1024 + i * 256 + lane * 4); xv[i] = (f32x4){lo16(xu.x), hi16(xu.x), lo16(xu.y), hi16(xu.y)}; }
      else xv[i] = *(const f32x4*)(xin + (size_t)row * 1024 + i * 256 + lane * 4);
    }
    if (HAS_Y) {
      f32x4 yv[4];
      float ss = 0.f;
#pragma unroll
      for (int i = 0; i < 4; ++i) {
        const u32x2 yu = *(const u32x2*)(yf + (size_t)row * 1024 + i * 256 + lane * 4);
        yv[i] = (f32x4){lo16(yu.x), hi16(yu.x), lo16(yu.y), hi16(yu.y)};
        ss += yv[i][0] * yv[i][0] + yv[i][1] * yv[i][1] + yv[i][2] * yv[i][2] + yv[i][3] * yv[i][3];
      }
      ss = wave_sum(ss);
      const float rs = rsqrtf(ss * (1.f / 1024.f) + 1e-6f);
#pragma unroll
      for (int i = 0; i < 4; ++i) {
        const int col = i * 256 + lane * 4;
        const f32x4 g4 = *(const f32x4*)(gy + col), gt = *(const f32x4*)(gate + (size_t)b * 6144 + col);
        xv[i] = xv[i] + gt * (yv[i] * rs * g4);
        if (XOUT_BF) { u32x2 pk; pk.x = pk2(xv[i][0], xv[i][1]); pk.y = pk2(xv[i][2], xv[i][3]); *(u32x2*)(xoutb + (size_t)row * 1024 + col) = pk;
                       xv[i] = (f32x4){lo16(pk.x), hi16(pk.x), lo16(pk.y), hi16(pk.y)}; }
        else *(f32x4*)(xout + (size_t)row * 1024 + col) = xv[i];
      }
    }
    if (HAS_H) {
      float ss = 0.f;
#pragma unroll
      for (int i = 0; i < 4; ++i) ss += xv[i][0] * xv[i][0] + xv[i][1] * xv[i][1] + xv[i][2] * xv[i][2] + xv[i][3] * xv[i][3];
      ss = wave_sum(ss);
      const float rs = rsqrtf(ss * (1.f / 1024.f) + 1e-6f);
#pragma unroll
      for (int i = 0; i < 4; ++i) {
        const int col = i * 256 + lane * 4;
        const f32x4 g4 = *(const f32x4*)(gh + col), s4 = *(const f32x4*)(sc + (size_t)b * 6144 + col), h4 = *(const f32x4*)(sh + (size_t)b * 6144 + col);
        const f32x4 o = (xv[i] * rs * g4) * (s4 + 1.f) + h4;
        u32x2 pk;
        pk.x = pk2(o[0], o[1]); pk.y = pk2(o[2], o[3]);
        *(u32x2*)(h + (size_t)row * 1024 + col) = pk;
      }
    }
  }
}

DEV void unpack8(const u32x4 u, float (&f)[8]) {
  f[0] = lo16(u.x); f[1] = hi16(u.x); f[2] = lo16(u.y); f[3] = hi16(u.y); f[4] = lo16(u.z); f[5] = hi16(u.z); f[6] = lo16(u.w); f[7] = hi16(u.w);
}
DEV u32x4 pack8(const float (&f)[8]) {
  u32x4 u;
  u.x = pk2(f[0], f[1]); u.y = pk2(f[2], f[3]); u.z = pk2(f[4], f[5]); u.w = pk2(f[6], f[7]);
  return u;
}

DEV void prep1(const P& p) {
  const bf16_t* z = (const bf16_t*)(p.ws + O_Z);
  bf16_t* za = (bf16_t*)p.out;
  bf16_t* qr = (bf16_t*)(p.ws + O_QR);
  bf16_t* kr = (bf16_t*)(p.ws + O_KR);
  bf16_t* vt = (bf16_t*)(p.ws + O_VT);
  const float* rope = (const float*)(p.ws + W_ROPE);
  const int gt = blockIdx.x * NTHR + tidx(), ngt = gridDim.x * NTHR;
  for (int idx = gt; idx < MT * 256; idx += ngt) {
    const int tok = idx >> 8, c8 = (idx & 255) * 8, s = tok & 4095;
    const bf16_t* zp = z + (size_t)tok * INC + c8;
    float zc[8], zm[8], zn[8], o[8];
    unpack8(*(const u32x4*)zp, zc);
    if (s > 0) unpack8(*(const u32x4*)(zp - INC), zm); else { for (int i = 0; i < 8; ++i) zm[i] = 0.f; }
    if (s < 4095) unpack8(*(const u32x4*)(zp + INC), zn); else { for (int i = 0; i < 8; ++i) zn[i] = 0.f; }
    float w0[8], w1[8], w2[8];
    *(f32x4*)w0 = *(const f32x4*)(p.mix_conv + c8); *(f32x4*)(w0 + 4) = *(const f32x4*)(p.mix_conv + c8 + 4);
    *(f32x4*)w1 = *(const f32x4*)(p.mix_conv + 2048 + c8); *(f32x4*)(w1 + 4) = *(const f32x4*)(p.mix_conv + 2048 + c8 + 4);
    *(f32x4*)w2 = *(const f32x4*)(p.mix_conv + 4096 + c8); *(f32x4*)(w2 + 4) = *(const f32x4*)(p.mix_conv + 4096 + c8 + 4);
#pragma unroll
    for (int i = 0; i < 8; ++i) o[i] = zm[i] * w0[i] + zc[i] * w1[i] + zn[i] * w2[i];
    *(u32x4*)(za + (size_t)tok * 2048 + c8) = pack8(o);
  }
  for (int idx = gt; idx < MT * 64; idx += ngt) {
    const int e8 = idx & 3, which = (idx >> 2) & 1, h = (idx >> 3) & 7, tok = idx >> 6, s = tok & 4095;
    const bf16_t* src = z + (size_t)tok * INC + 2048 + which * 512 + h * 64 + e8 * 8;
    float x1[8], x2[8], o1[8], o2[8];
    unpack8(*(const u32x4*)src, x1);
    unpack8(*(const u32x4*)(src + 32), x2);
    const float* rp = rope + ((size_t)s * 32 + e8 * 8) * 2;
    const float scl = which ? 1.f : 0.125f;
#pragma unroll
    for (int i = 0; i < 8; ++i) {
      const float cv = rp[2 * i], sv = rp[2 * i + 1];
      o1[i] = (x1[i] * cv - x2[i] * sv) * scl;
      o2[i] = (x2[i] * cv + x1[i] * sv) * scl;
    }
    bf16_t* dst = (which ? kr : qr) + (size_t)tok * 512 + h * 64 + e8 * 8;
    *(u32x4*)dst = pack8(o1);
    *(u32x4*)(dst + 32) = pack8(o2);
  }
  {
    bf16_t* vr = (bf16_t*)(p.ws + O_VT);
    for (int idx = gt; idx < MT * 64; idx += ngt) {
      const int tok = idx >> 6, c8 = (idx & 63) * 8;
      *(u32x4*)(vr + (size_t)tok * 512 + c8) = *(const u32x4*)(z + (size_t)tok * INC + 3072 + c8);
    }
  }
}

DEV void za_fixup(const P& p) {
  const bf16_t* sb = (const bf16_t*)(p.ws + O_SBZ);
  bf16_t* za = (bf16_t*)p.out;
  const int gt = blockIdx.x * NTHR + tidx(), ngt = gridDim.x * NTHR;
  for (int item = gt; item < 512 * 2 * 256; item += ngt) {
    const int strip = item >> 9, e = (item >> 8) & 1, c8 = (item & 255) * 8;
    const int R = strip * 64 + (e ? 63 : 0), s = R & 4095;
    const bf16_t* pc = sb + ((size_t)strip * 4 + (e ? 3 : 0)) * 2048 + c8;
    const u32x4 z0 = (u32x4){0u, 0u, 0u, 0u};
    const bool hasp = e ? true : (s > 0), hasn = e ? (s < 4095) : true;
    float zm[8], zc[8], zn[8], o[8], w0[8], w1[8], w2[8];
    unpack8(hasp ? *(const u32x4*)(pc - 2048) : z0, zm);
    unpack8(*(const u32x4*)pc, zc);
    unpack8(hasn ? *(const u32x4*)(pc + 2048) : z0, zn);
    *(f32x4*)w0 = *(const f32x4*)(p.mix_conv + c8); *(f32x4*)(w0 + 4) = *(const f32x4*)(p.mix_conv + c8 + 4);
    *(f32x4*)w1 = *(const f32x4*)(p.mix_conv + 2048 + c8); *(f32x4*)(w1 + 4) = *(const f32x4*)(p.mix_conv + 2048 + c8 + 4);
    *(f32x4*)w2 = *(const f32x4*)(p.mix_conv + 4096 + c8); *(f32x4*)(w2 + 4) = *(const f32x4*)(p.mix_conv + 4096 + c8 + 4);
#pragma unroll
    for (int i = 0; i < 8; ++i) o[i] = zm[i] * w0[i] + zc[i] * w1[i] + zn[i] * w2[i];
    *(u32x4*)(za + (size_t)R * 2048 + c8) = pack8(o);
  }
}

DEV void attention(char* lds, const P& p) {
  const bf16_t* qr = (const bf16_t*)(p.ws + O_QR);
  const bf16_t* kr = (const bf16_t*)(p.ws + O_KR);
  const bf16_t* vt = (const bf16_t*)(p.ws + O_VT);
  float* num = (float*)(p.ws + O_NUM);
  float* md = (float*)(p.ws + O_MD);
  constexpr int UNIT_LDS = 24576 + 64 * 400;
  const int tid = tidx(), w = tid >> 6, lane = tid & 63, lr = lane & 15, lq = lane >> 4;
  const int uh = tid >> 8, lt = tid & 255, mt = w & 3;
  char* ul = lds + uh * UNIT_LDS;
  u32x4 pre[12];
  auto load_pair = [&](int pi) {
    const int unit = pi * 2 + uh;
    const int nb = unit & 63, h = (unit >> 6) & 7, b = (unit >> 9) & 7, br = unit >> 12;
    const int dsh = 2 * br, Mr = 4096 >> dsh;
    const int seg = (nb * 64) / Mr, segstart = seg * Mr, segend = segstart + Mr;
    const bool pv_ok = (nb * 64 - 64 >= segstart), nx_ok = (nb * 64 + 128 <= segend);
#pragma unroll
    for (int j = 0; j < 6; ++j) {
      const int pc = lt + 256 * j, key = pc >> 3, ch = pc & 7, kb = key >> 6;
      int blk = nb + kb - 1;
      if ((kb == 0 && !pv_ok) || (kb == 2 && !nx_ok)) blk = nb;
      const int kp = blk * 64 + (key & 63);
      const int ktok = b * 4096 + (((kp - segstart) << dsh) + seg);
      pre[j] = *(const u32x4*)(kr + (size_t)ktok * 512 + h * 64 + ch * 8);
      pre[6 + j] = *(const u32x4*)(vt + (size_t)ktok * 512 + h * 64 + ch * 8);
    }
  };
  const int npairs = 3 * 4096 / 2;
  int pi = blockIdx.x;
  if (pi < npairs) load_pair(pi);
  for (; pi < npairs; pi += gridDim.x) {
#pragma unroll
    for (int j = 0; j < 6; ++j) {
      const int pc = lt + 256 * j, key = pc >> 3, ch = pc & 7;
      *(u32x4*)(ul + key * 128 + ((ch ^ (key & 7)) * 16)) = pre[j];
    }
#pragma unroll
    for (int j = 0; j < 6; ++j) {
      const int pc = lt + 256 * j, key = pc >> 3, ch = pc & 7;
      bf16_t* vd = (bf16_t*)(ul + 24576 + (ch * 8) * 400) + (key ^ (ch << 2));
      const u32x4 u = pre[6 + j];
      vd[0 * 200] = (bf16_t)(u.x & 0xffff); vd[1 * 200] = (bf16_t)(u.x >> 16); vd[2 * 200] = (bf16_t)(u.y & 0xffff); vd[3 * 200] = (bf16_t)(u.y >> 16);
      vd[4 * 200] = (bf16_t)(u.z & 0xffff); vd[5 * 200] = (bf16_t)(u.z >> 16); vd[6 * 200] = (bf16_t)(u.w & 0xffff); vd[7 * 200] = (bf16_t)(u.w >> 16);
    }
    __syncthreads();
    const int unit = pi * 2 + uh;
    const int nb = unit & 63, h = (unit >> 6) & 7, b = (unit >> 9) & 7, br = unit >> 12;
    const int dsh = 2 * br, Mr = 4096 >> dsh;
    const int seg = (nb * 64) / Mr, segstart = seg * Mr, segend = segstart + Mr;
    const bool pv_ok = (nb * 64 - 64 >= segstart), nx_ok = (nb * 64 + 128 <= segend);
    const int qp = nb * 64 + mt * 16 + lr;
    const int qtok = b * 4096 + (((qp - segstart) << dsh) + seg);
    bf16x8 qf[2];
    qf[0] = *(const bf16x8*)(qr + (size_t)qtok * 512 + h * 64 + lq * 8);
    qf[1] = *(const bf16x8*)(qr + (size_t)qtok * 512 + h * 64 + 32 + lq * 8);
    if (pi + (int)gridDim.x < npairs) load_pair(pi + gridDim.x);
    f32x4 sacc[12];
#pragma unroll
    for (int kt = 0; kt < 12; ++kt) {
      const int key = kt * 16 + lr;
      const bf16x8 k0 = *(const bf16x8*)(ul + key * 128 + ((lq ^ (key & 7)) * 16));
      const bf16x8 k1 = *(const bf16x8*)(ul + key * 128 + (((4 + lq) ^ (key & 7)) * 16));
      f32x4 a = (f32x4){0.f, 0.f, 0.f, 0.f};
      a = __builtin_amdgcn_mfma_f32_16x16x32_bf16(k0, qf[0], a, 0, 0, 0);
      a = __builtin_amdgcn_mfma_f32_16x16x32_bf16(k1, qf[1], a, 0, 0, 0);
      sacc[kt] = a;
    }
    const int qi = mt * 16 + lr;
    float mx = -1e30f;
#pragma unroll
    for (int kt = 0; kt < 12; ++kt) {
      const int kb = kt >> 2;
#pragma unroll
      for (int r = 0; r < 4; ++r) {
        const int kj = (kt & 3) * 16 + lq * 4 + r;
        bool ok = true;
        if (kb == 0) ok = pv_ok && (kj >= qi);
        if (kb == 2) ok = nx_ok && (kj <= qi);
        const float sv = ok ? sacc[kt][r] : -1e30f;
        sacc[kt][r] = sv;
        mx = fmaxf(mx, sv);
      }
    }
    mx = fmaxf(mx, __shfl_xor(mx, 16));
    mx = fmaxf(mx, __shfl_xor(mx, 32));
    float den = 0.f;
#pragma unroll
    for (int kt = 0; kt < 12; ++kt)
#pragma unroll
      for (int r = 0; r < 4; ++r) {
        const float pe = __expf(sacc[kt][r] - mx);
        sacc[kt][r] = pe;
        den += pe;
      }
    den += __shfl_xor(den, 16);
    den += __shfl_xor(den, 32);
    f32x4 oacc[4];
#pragma unroll
    for (int et = 0; et < 4; ++et) oacc[et] = (f32x4){0.f, 0.f, 0.f, 0.f};
#pragma unroll
    for (int t = 0; t < 6; ++t) {
      u32x4 pu;
      pu.x = pk2(sacc[2 * t][0], sacc[2 * t][1]); pu.y = pk2(sacc[2 * t][2], sacc[2 * t][3]);
      pu.z = pk2(sacc[2 * t + 1][0], sacc[2 * t + 1][1]); pu.w = pk2(sacc[2 * t + 1][2], sacc[2 * t + 1][3]);
      const bf16x8 pf = __builtin_bit_cast(bf16x8, pu);
#pragma unroll
      for (int et = 0; et < 4; ++et) {
        const char* vrow = ul + 24576 + (et * 16 + lr) * 400;
        const int sw = ((et * 2 + (lr >> 3)) & 7) << 2;
        const u32x2 v0 = *(const u32x2*)(vrow + (((2 * t) * 16 + lq * 4) ^ sw) * 2), v1 = *(const u32x2*)(vrow + (((2 * t + 1) * 16 + lq * 4) ^ sw) * 2);
        u32x4 vu;
        vu.x = v0.x; vu.y = v0.y; vu.z = v1.x; vu.w = v1.y;
        oacc[et] = __builtin_amdgcn_mfma_f32_16x16x32_bf16(__builtin_bit_cast(bf16x8, vu), pf, oacc[et], 0, 0, 0);
      }
    }
    float* np = num + ((size_t)br * MT + qtok) * 512 + h * 64 + lq * 4;
#pragma unroll
    for (int et = 0; et < 4; ++et) *(f32x4*)(np + et * 16) = oacc[et];
    if (lq == 0) {
      f32x2 o;
      o.x = mx; o.y = den;
      *(f32x2*)(md + (((size_t)br * MT + qtok) * 8 + h) * 2) = o;
    }
    __syncthreads();
  }
}

DEV void combineA(const P& p) {
  const float* num = (const float*)(p.ws + O_NUM);
  const float* md = (const float*)(p.ws + O_MD);
  bf16_t* ycat = (bf16_t*)(p.ws + O_YCAT);
  const int gt = blockIdx.x * NTHR + tidx(), ngt = gridDim.x * NTHR;
  for (int idx = gt; idx < MT * 128; idx += ngt) {
    const int e4 = idx & 15, h = (idx >> 4) & 7, tok = idx >> 7;
    f32x2 m0 = *(const f32x2*)(md + (((size_t)0 * MT + tok) * 8 + h) * 2);
    f32x2 m1 = *(const f32x2*)(md + (((size_t)1 * MT + tok) * 8 + h) * 2);
    f32x2 m2 = *(const f32x2*)(md + (((size_t)2 * MT + tok) * 8 + h) * 2);
    const float ma = fmaxf(m0.x, fmaxf(m1.x, m2.x));
    const float e0 = __expf(m0.x - ma), e1 = __expf(m1.x - ma), e2 = __expf(m2.x - ma);
    const float dn = e0 * m0.y + e1 * m1.y + e2 * m2.y;
    const f32x4 n0 = *(const f32x4*)(num + ((size_t)0 * MT + tok) * 512 + h * 64 + e4 * 4);
    const f32x4 n1 = *(const f32x4*)(num + ((size_t)1 * MT + tok) * 512 + h * 64 + e4 * 4);
    const f32x4 n2 = *(const f32x4*)(num + ((size_t)2 * MT + tok) * 512 + h * 64 + e4 * 4);
    const f32x4 o = (n0 * e0 + n1 * e1 + n2 * e2) * (1.f / dn);
    u32x2 pk;
    pk.x = pk2(o[0], o[1]); pk.y = pk2(o[2], o[3]);
    *(u32x2*)(ycat + (size_t)tok * 1024 + 512 + h * 64 + e4 * 4) = pk;
  }
}

DEV float dpp_allreduce16(float x) {
  x += __int_as_float(__builtin_amdgcn_update_dpp(0, __float_as_int(x), 0xB1, 0xF, 0xF, true));
  x += __int_as_float(__builtin_amdgcn_update_dpp(0, __float_as_int(x), 0x4E, 0xF, 0xF, true));
  x += __int_as_float(__builtin_amdgcn_update_dpp(0, __float_as_int(x), 0x141, 0xF, 0xF, true));
  x += __int_as_float(__builtin_amdgcn_update_dpp(0, __float_as_int(x), 0x140, 0xF, 0xF, true));
  return x;
}

DEV void scan_phase(char* lds, const P& p) {
  const bf16_t* omw = (const bf16_t*)(p.ws + O_OMW);
  const bf16_t* kd = (const bf16_t*)(p.ws + O_KD);
  const bf16_t* kka = (const bf16_t*)(p.ws + O_KKA);
  const bf16_t* kk = (const bf16_t*)(p.ws + O_KK);
  const bf16_t* za = (const bf16_t*)p.out;
  float* Y = (float*)(p.ws + O_Y);
  float* inb = (float*)lds;
  float* ypart = (float*)(lds + 98304);
  const int tid = tidx(), w = tid >> 6, lane = tid & 63, rg = lane >> 4, jl = lane & 15, j0 = jl * 4;
  for (int it = blockIdx.x; it < 256; it += gridDim.x) {
    const int sc = it >> 1, half = it & 1, d = sc >> 6, b = (sc >> 3) & 7, h = sc & 7;
    if (w >= 4) {
      const int lt = tid - 256;
      const bf16_t* src[6];
      int dsto[6], stepi[6], isw[6];
#pragma unroll
      for (int q = 0; q < 6; ++q) {
        const int pid = lt + q * 256, i = pid / 48, rem = pid % 48, arr = rem >> 3, pc = rem & 7;
        const bf16_t* base;
        size_t ld;
        if (arr == 0) { base = omw + (size_t)d * MT * 512 + h * 64; ld = 512; }
        else if (arr == 1) { base = kd + (size_t)d * MT * 512 + h * 64; ld = 512; }
        else if (arr == 2) { base = kka + (size_t)d * MT * 512 + h * 64; ld = 512; }
        else if (arr == 3) { base = kk + h * 64; ld = 512; }
        else if (arr == 4) { base = za + h * 64; ld = 2048; }
        else { base = za + 1024 + h * 64; ld = 2048; }
        const int t0 = d ? (4095 - i) : i;
        src[q] = base + ((size_t)(b * 4096 + t0)) * ld + pc * 8;
        stepi[q] = (int)ld * 32 * (d ? -1 : 1);
        dsto[q] = i * 384 + arr * 64 + pc * 8;
        isw[q] = (arr == 0);
      }
      u32x4 rr[6];
#pragma unroll
      for (int q = 0; q < 6; ++q) rr[q] = *(const u32x4*)(src[q]);
#pragma unroll
      for (int q = 0; q < 6; ++q) {
        float f[8];
        unpack8(rr[q], f);
        if (isw[q]) { for (int i = 0; i < 8; ++i) f[i] = 1.f - f[i]; }
        *(f32x4*)(inb + dsto[q]) = (f32x4){f[0], f[1], f[2], f[3]};
        *(f32x4*)(inb + dsto[q] + 4) = (f32x4){f[4], f[5], f[6], f[7]};
      }
#pragma unroll
      for (int q = 0; q < 6; ++q) rr[q] = *(const u32x4*)(src[q] + (ptrdiff_t)stepi[q]);
      __syncthreads();
      for (int c = 0; c < 128; ++c) {
        if (c + 1 < 128) {
          float* nb_ = inb + ((c + 1) & 1) * 12288;
#pragma unroll
          for (int q = 0; q < 6; ++q) {
            float f[8];
            unpack8(rr[q], f);
            if (isw[q]) { for (int i = 0; i < 8; ++i) f[i] = 1.f - f[i]; }
            *(f32x4*)(nb_ + dsto[q]) = (f32x4){f[0], f[1], f[2], f[3]};
            *(f32x4*)(nb_ + dsto[q] + 4) = (f32x4){f[4], f[5], f[6], f[7]};
          }
        }
        if (c + 2 < 128) {
#pragma unroll
          for (int q = 0; q < 6; ++q) rr[q] = *(const u32x4*)(src[q] + (ptrdiff_t)stepi[q] * (c + 2));
        }
        if (c > 0) {
          const int cc = c - 1, idx = lt * 4, i = idx >> 5, rl = idx & 31;
          const int t = d ? (4095 - (cc * 32 + i)) : (cc * 32 + i);
          const float* q = ypart + (cc & 1) * 4096 + i * 128 + rl;
          const f32x4 o = (*(const f32x4*)q + *(const f32x4*)(q + 32)) + (*(const f32x4*)(q + 64) + *(const f32x4*)(q + 96));
          *(f32x4*)(Y + ((size_t)d * MT + b * 4096 + t) * 512 + h * 64 + half * 32 + rl) = o;
        }
        __syncthreads();
      }
      {
        const int cc = 127, idx = lt * 4, i = idx >> 5, rl = idx & 31;
        const int t = d ? (4095 - (cc * 32 + i)) : (cc * 32 + i);
        const float* q = ypart + (cc & 1) * 4096 + i * 128 + rl;
        const f32x4 o = (*(const f32x4*)q + *(const f32x4*)(q + 32)) + (*(const f32x4*)(q + 64) + *(const f32x4*)(q + 96));
        *(f32x4*)(Y + ((size_t)d * MT + b * 4096 + t) * 512 + h * 64 + half * 32 + rl) = o;
      }
    } else {
      const int rowl = w * 8 + rg * 2, row = half * 32 + rowl;
      f32x2 a01 = (f32x2){0.f, 0.f}, a23 = a01, b01 = a01, b23 = a01;
      __syncthreads();
      for (int c = 0; c < 128; ++c) {
        const float* cur = inb + (c & 1) * 12288;
        float* yp = ypart + (c & 1) * 4096 + (jl >> 2) * 32 + rowl;
        f32x4 w4 = *(const f32x4*)(cur + j0), kd4 = *(const f32x4*)(cur + 64 + j0), ka4 = *(const f32x4*)(cur + 128 + j0),
              kk4 = *(const f32x4*)(cur + 192 + j0), r4 = *(const f32x4*)(cur + 256 + j0);
        f32x2 v2 = *(const f32x2*)(cur + 320 + row);
#pragma unroll 8
        for (int i = 0; i < 32; ++i) {
          const float* sn = cur + ((i + 1) & 31) * 384;
          const f32x4 nw4 = *(const f32x4*)(sn + j0), nkd4 = *(const f32x4*)(sn + 64 + j0), nka4 = *(const f32x4*)(sn + 128 + j0),
                      nkk4 = *(const f32x4*)(sn + 192 + j0), nr4 = *(const f32x4*)(sn + 256 + j0);
          const f32x2 nv2 = *(const f32x2*)(sn + 320 + row);
          const f32x2 ta = a01 * kk4.xy + a23 * kk4.zw, tb = b01 * kk4.xy + b23 * kk4.zw;
          const float ska = dpp_allreduce16(ta.x + ta.y), skb = dpp_allreduce16(tb.x + tb.y);
          a01 = a01 * w4.xy + (kd4.xy * v2.x - ka4.xy * ska);
          a23 = a23 * w4.zw + (kd4.zw * v2.x - ka4.zw * ska);
          b01 = b01 * w4.xy + (kd4.xy * v2.y - ka4.xy * skb);
          b23 = b23 * w4.zw + (kd4.zw * v2.y - ka4.zw * skb);
          const f32x2 ua = a01 * r4.xy + a23 * r4.zw, ub = b01 * r4.xy + b23 * r4.zw;
          f32x2 y;
          y.x = ua.x + ua.y; y.y = ub.x + ub.y;
          y.x += __int_as_float(__builtin_amdgcn_update_dpp(0, __float_as_int(y.x), 0xB1, 0xF, 0xF, true));
          y.y += __int_as_float(__builtin_amdgcn_update_dpp(0, __float_as_int(y.y), 0xB1, 0xF, 0xF, true));
          y.x += __int_as_float(__builtin_amdgcn_update_dpp(0, __float_as_int(y.x), 0x4E, 0xF, 0xF, true));
          y.y += __int_as_float(__builtin_amdgcn_update_dpp(0, __float_as_int(y.y), 0x4E, 0xF, 0xF, true));
          *(f32x2*)(yp + i * 128) = y;
          w4 = nw4; kd4 = nkd4; ka4 = nka4; kk4 = nkk4; r4 = nr4; v2 = nv2;
        }
        __syncthreads();
      }
    }
    __syncthreads();
  }
}

DEV void postB(const P& p) {
  const float* Y = (const float*)(p.ws + O_Y);
  const bf16_t* kd = (const bf16_t*)(p.ws + O_KD);
  const bf16_t* gg = (const bf16_t*)(p.ws + O_G);
  const bf16_t* za = (const bf16_t*)p.out;
  bf16_t* ycat = (bf16_t*)(p.ws + O_YCAT);
  const int lane = tidx() & 63, sub = lane >> 4, jl = lane & 15, gw = blockIdx.x * 8 + (tidx() >> 6), nw = gridDim.x * 8;
  for (int it = gw; it < MT * 2; it += nw) {
    const int item = it * 4 + sub, tok = item >> 3, h = item & 7, c = h * 64 + jl * 4;
    const f32x4 y0 = *(const f32x4*)(Y + (size_t)tok * 512 + c), y1 = *(const f32x4*)(Y + ((size_t)MT + tok) * 512 + c);
    const u32x2 k0 = *(const u32x2*)(kd + (size_t)tok * 512 + c), k1 = *(const u32x2*)(kd + ((size_t)MT + tok) * 512 + c);
    const u32x2 ru = *(const u32x2*)(za + (size_t)tok * 2048 + c), vu = *(const u32x2*)(za + (size_t)tok * 2048 + 1024 + c), gu = *(const u32x2*)(gg + (size_t)tok * 512 + c);
    const f32x4 lw = *(const f32x4*)(p.lnx_w + c), lb = *(const f32x4*)(p.lnx_b + c), rk = *(const f32x4*)(p.r_k + c);
    const f32x4 y = y0 + y1;
    const float mu = dpp_allreduce16((y[0] + y[1]) + (y[2] + y[3])) * (1.f / 64.f);
    const f32x4 dv = y - mu;
    const float var = dpp_allreduce16((dv[0] * dv[0] + dv[1] * dv[1]) + (dv[2] * dv[2] + dv[3] * dv[3])) * (1.f / 64.f);
    const float rs = rsqrtf(var + 64e-5f);
    const f32x4 r = (f32x4){lo16(ru.x), hi16(ru.x), lo16(ru.y), hi16(ru.y)}, v = (f32x4){lo16(vu.x), hi16(vu.x), lo16(vu.y), hi16(vu.y)};
    const f32x4 g = (f32x4){lo16(gu.x), hi16(gu.x), lo16(gu.y), hi16(gu.y)};
    const f32x4 kds = (f32x4){lo16(k0.x) + lo16(k1.x), hi16(k0.x) + hi16(k1.x), lo16(k0.y) + lo16(k1.y), hi16(k0.y) + hi16(k1.y)};
    const f32x4 t = r * kds * rk;
    const float bs = dpp_allreduce16((t[0] + t[1]) + (t[2] + t[3]));
    const f32x4 o = (dv * rs * lw + lb + v * bs) * g;
    u32x2 pk;
    pk.x = pk2(o[0], o[1]); pk.y = pk2(o[2], o[3]);
    *(u32x2*)(ycat + (size_t)tok * 1024 + c) = pk;
  }
}

DEV void glu_fixup(const P& p, int l) {
  const bf16_t* sb = (const bf16_t*)(p.ws + O_SB);
  bf16_t* act = (bf16_t*)(p.ws + O_ACT);
  const float* cw = p.ffn_conv + (size_t)l * 3 * 5632;
  const int gt = blockIdx.x * NTHR + tidx(), ngt = gridDim.x * NTHR;
  for (int item = gt; item < 512 * 2 * 352; item += ngt) {
    const int strip = item / 704, rem = item - strip * 704, e = rem / 352, c8 = (rem - e * 352) * 8;
    const int R = strip * 64 + (e ? 63 : 0), s = R & 4095;
    const int colg = (c8 >> 7) * 256 + (c8 & 127);
    const bf16_t* pc = sb + ((size_t)strip * 4 + (e ? 3 : 0)) * 5632 + colg;
    const bf16_t* pp = e ? (pc - 5632) : (pc - 5632);
    const bf16_t* pn = e ? (pc + 5632) : (pc + 5632);
    const u32x4 z0 = (u32x4){0u, 0u, 0u, 0u};
    const bool hasp = e ? true : (s > 0), hasn = e ? (s < 4095) : true;
    float gm[8], gc[8], gn[8], vm[8], vc[8], vn[8], o[8];
    unpack8(hasp ? *(const u32x4*)pp : z0, gm); unpack8(hasp ? *(const u32x4*)(pp + 128) : z0, vm);
    unpack8(*(const u32x4*)pc, gc); unpack8(*(const u32x4*)(pc + 128), vc);
    unpack8(hasn ? *(const u32x4*)pn : z0, gn); unpack8(hasn ? *(const u32x4*)(pn + 128) : z0, vn);
#pragma unroll
    for (int i = 0; i < 8; ++i) {
      const float g = gm[i] * cw[c8 + i] + gc[i] * cw[5632 + c8 + i] + gn[i] * cw[11264 + c8 + i];
      const float vv = vm[i] * cw[2816 + c8 + i] + vc[i] * cw[5632 + 2816 + c8 + i] + vn[i] * cw[11264 + 2816 + c8 + i];
      const float u2 = -1.5957691216057308f * (g + 0.044715f * g * g * g);
      o[i] = g * __builtin_amdgcn_rcpf(1.f + __expf(u2)) * vv;
    }
    *(u32x4*)(act + (size_t)R * 2816 + c8) = pack8(o);
  }
}

template <class Epi>
DEV void gemm_grid(char* lds, const bf16_t* A, int lda, const bf16_t* Bt, int ldb, int K, int tilesM, int tilesN, const Epi& epi) {
  const int nt = tilesM * tilesN;
  u32x4 ra[4], rb[2];
  int t = blockIdx.x;
  if (t < nt) gemm_first_load(A + (size_t)(t / tilesN) * 256 * lda, lda, Bt + (size_t)(t % tilesN) * 128 * ldb, ldb, ra, rb);
  for (; t < nt; t += gridDim.x) {
    const int tm = t / tilesN, tn = t % tilesN, t2 = t + gridDim.x;
    const bf16_t* An = (t2 < nt) ? A + (size_t)(t2 / tilesN) * 256 * lda : nullptr;
    const bf16_t* Bn = (t2 < nt) ? Bt + (size_t)(t2 % tilesN) * 128 * ldb : nullptr;
    gemm_tile(lds, A + (size_t)tm * 256 * lda, lda, Bt + (size_t)tn * 128 * ldb, ldb, K, tm * 256, tn * 128, epi, ra, rb, An, Bn);
  }
}


DEV void dft_fold(const P& p) {
  const bf16_t* CST = (const bf16_t*)(p.ws + O_CST);
  bf16_t* CF = (bf16_t*)(p.ws + O_CSTF);
  for (int idx = blockIdx.x * NTHR + tidx(); idx < 16384 * 256; idx += gridDim.x * NTHR) {
    const int r = idx >> 8, s8 = (idx & 255) * 8, eo = (r >> 10) & 1;
    const bf16_t* src = CST + (size_t)r * 4096;
    float a[8], bq[8], o[8];
    unpack8(*(const u32x4*)(src + s8), a);
    if (s8 == 0) {
      unpack8(*(const u32x4*)(src + 4088), bq);
      o[0] = eo ? 0.f : a[0];
#pragma unroll
      for (int i = 1; i < 8; ++i) o[i] = eo ? (a[i] - bq[8 - i]) : (a[i] + bq[8 - i]);
      if (!eo) ((float*)(p.ws + O_C2048))[(r >> 11) * 1024 + (r & 1023)] = bf2f(src[2048]) * (1.f / 64.f);
    } else {
      unpack8(*(const u32x4*)(src + 4096 - s8 - 8), bq);
      const float b0 = bf2f(src[4096 - s8]);
      o[0] = eo ? (a[0] - b0) : (a[0] + b0);
#pragma unroll
      for (int i = 1; i < 8; ++i) o[i] = eo ? (a[i] - bq[8 - i]) : (a[i] + bq[8 - i]);
    }
    *(u32x4*)(CF + (size_t)r * 2048 + s8) = pack8(o);
  }
}

DEV void dft_combine(const P& p) {
  const bf16_t* EO = (const bf16_t*)(p.ws + O_EO);
  const bf16_t* CST = (const bf16_t*)(p.ws + O_CST);
  bf16_t* f = (bf16_t*)(p.ws + O_F);
  for (int idx = blockIdx.x * NTHR + tidx(); idx < 8 * 2048 * 256; idx += gridDim.x * NTHR) {
    const int c4 = (idx & 255) * 4, k1 = (idx >> 8) & 2047, b = idx >> 19;
    const u32x2 eu = *(const u32x2*)(EO + ((size_t)(b * 2) * 2048 + k1) * 1024 + c4), ou = *(const u32x2*)(EO + ((size_t)(b * 2 + 1) * 2048 + k1) * 1024 + c4);
    f32x4 e = (f32x4){lo16(eu.x), hi16(eu.x), lo16(eu.y), hi16(eu.y)};
    const f32x4 o = (f32x4){lo16(ou.x), hi16(ou.x), lo16(ou.y), hi16(ou.y)};
    {
      const f32x4 cm = *(const f32x4*)((const float*)(p.ws + O_C2048) + b * 1024 + c4);
      e = (k1 & 1) ? (e - cm) : (e + cm);
    }
    const f32x4 d = e - o, s = e + o;
    u32x2 pk;
    pk.x = pk2(d[0], d[1]); pk.y = pk2(d[2], d[3]);
    *(u32x2*)(f + ((size_t)b * 4096 + k1) * 1024 + c4) = pk;
    if (k1 > 0) {
      pk.x = pk2(s[0], s[1]); pk.y = pk2(s[2], s[3]);
      *(u32x2*)(f + ((size_t)b * 4096 + 4096 - k1) * 1024 + c4) = pk;
    }
  }
  {
    const int lane = tidx() & 63, gw = blockIdx.x * 8 + (tidx() >> 6), nw = gridDim.x * 8;
    for (int r = gw; r < 8 * 1024; r += nw) {
      const int b = r >> 10, n = r & 1023;
      const bf16_t* cp = CST + ((size_t)(b * 2) * 1024 + n) * 4096;
      float acc = 0.f;
#pragma unroll
      for (int j = 0; j < 8; ++j) {
        const u32x4 u = *(const u32x4*)(cp + j * 512 + lane * 8);
        acc += (lo16(u.x) - hi16(u.x)) + (lo16(u.y) - hi16(u.y)) + (lo16(u.z) - hi16(u.z)) + (lo16(u.w) - hi16(u.w));
      }
      acc = wave_sum(acc);
      if (lane == 0) f[((size_t)b * 4096 + 2048) * 1024 + n] = f2bf(acc * (1.f / 64.f));
    }
  }
}

#define LDSP ((PG8_LAS unsigned char*)lds)
template <class Epi>
DEV void pgemm(char* lds, const bf16_t* A, const bf16_t* Bt, int M_, int N_, int K_, const Epi& E) {
  pg8::Gemm g{A, Bt, M_, N_, K_};
  pg8::StaticOrder S;
  S.init(M_, N_, (int)gridDim.x, (int)blockIdx.x);
  pg8::gemm_phase<Epi, pg8::StaticOrder, true, true>(LDSP, g, S, E);
}

DEV void ffn(char* lds, const XcdBarrier& xbar, const P& p, int l) {
  const bf16_t* h = (const bf16_t*)(p.ws + O_H);
  bf16_t* act = (bf16_t*)(p.ws + O_ACT);
  bf16_t* yf = (bf16_t*)(p.ws + O_YF);
  const bf16_t* upt = (const bf16_t*)(p.ws + W_UP) + (size_t)l * 5632 * 1024;
  const bf16_t* dnt = (const bf16_t*)(p.ws + W_DOWN) + (size_t)l * 1024 * 2816;
  pgemm(lds, h, upt, MT, 5632, 1024, pg8::PEpiGlu{act, (bf16_t*)(p.ws + O_SB), p.ffn_conv + (size_t)l * 3 * 5632});
  xcd_barrier(xbar);
  glu_fixup(p, l);
  xcd_barrier(xbar);
  pgemm(lds, act, dnt, MT, 1024, 2816, pg8::PEpiBf16<false>{yf, 1024});
  xcd_barrier(xbar);
}

DEV const P& kargs() {
  auto q = __builtin_amdgcn_kernarg_segment_ptr();
  asm volatile("" : "+s"(q));
  return *(const P*)q;
}
#define p (kargs())
__global__ void __launch_bounds__(NTHR) mega(P parg_unused) {
  extern __shared__ __attribute__((aligned(16))) char lds[];
  cg::grid_group grid = cg::this_grid();
  char* ws = p.ws;
  if (tidx() < 4) ((unsigned*)(lds + 131072))[tidx()] = 0u;
  __syncthreads();
  const XcdBarrier xbar = xcd_barrier_post((unsigned*)(ws + W_BAR), (volatile XLAS unsigned*)(lds + 131072));
  float* mod = (float*)(ws + W_MOD);
  const int gt = blockIdx.x * NTHR + tidx(), ngt = gridDim.x * NTHR;

  for (int rep_ = 0; rep_ < REP_PRO; ++rep_) {
  if (rep_ > 0) xcd_barrier(xbar);
  compute_mod(lds, p);
  transpose_convert(lds, p.mix_in, 1024, 3584, (bf16_t*)(ws + W_MIXIN), 1024, 0, 2);
  for (int l = 0; l < 2; ++l) {
    transpose_convert(lds, p.ffn_up + (size_t)l * 1024 * 5632, 1024, 5632, (bf16_t*)(ws + W_UP) + (size_t)l * 5632 * 1024, 1024, 64 * l, 1);
    transpose_convert(lds, p.ffn_down + (size_t)l * 2816 * 1024, 2816, 1024, (bf16_t*)(ws + W_DOWN) + (size_t)l * 1024 * 2816, 2816, 128 + 64 * l);
  }
  transpose_convert(lds, p.mix_out, 1024, 1024, (bf16_t*)(ws + W_MIXOUT), 1024, 32);
  transpose_convert(lds, p.fnet_w, 1024, 1024, (bf16_t*)(ws + W_FNET), 1024, 96);
  for (int d = 0; d < 2; ++d) {
    transpose_convert(lds, p.w1 + (size_t)d * 512 * 64, 512, 64, (bf16_t*)(ws + W_L1) + (size_t)(d * 64) * 512, 512, 8 * d);
    transpose_convert(lds, p.a1 + (size_t)d * 512 * 64, 512, 64, (bf16_t*)(ws + W_L1) + (size_t)(128 + d * 64) * 512, 512, 16 + 8 * d);
    transpose_convert(lds, p.w2 + (size_t)d * 64 * 512, 64, 512, (bf16_t*)(ws + W_W2) + (size_t)d * 512 * 64, 64, 48 + 8 * d);
    transpose_convert(lds, p.a2 + (size_t)d * 64 * 512, 64, 512, (bf16_t*)(ws + W_A2) + (size_t)d * 512 * 64, 64, 64 + 8 * d);
  }
  transpose_convert(lds, p.g1, 512, 128, (bf16_t*)(ws + W_L1) + (size_t)256 * 512, 512, 32);
  transpose_convert(lds, p.g2, 128, 512, (bf16_t*)(ws + W_G2), 128, 80);
  {
    float* rope = (float*)(ws + W_ROPE);
    for (int idx = gt; idx < 4096 * 32; idx += ngt) {
      const int s = idx >> 5, e = idx & 31;
      const float inv = powf(10000.f, -(float)e / 32.f);
      const float ang = (float)s * inv;
      float sv, cv;
      sincosf(ang, &sv, &cv);
      rope[2 * idx] = cv;
      rope[2 * idx + 1] = sv;
    }
    bf16_t* dftc = (bf16_t*)(ws + W_DFTC);
    for (int idx = gt; idx < 256 * 128; idx += ngt) {
      const int n = idx >> 7, c = idx & 127, k2 = n & 127;
      const float ph = (float)((k2 * c) & 127) * (1.f / 64.f);
      const float v = (n < 128) ? cospif(ph) : sinpif(ph);
      dftc[idx] = f2bf(v * 0.08838834764831845f);
    }
  }
  }
  grid.sync();
  for (int rep_ = 0; rep_ < REP_ROW; ++rep_) { rowpass<false, true>(p.x, nullptr, nullptr, nullptr, nullptr, p.norm_g, mod + 1024, mod, (bf16_t*)(ws + O_H0)); xcd_barrier(xbar); }
  pgemm(lds, (const bf16_t*)(ws + O_H0), (const bf16_t*)(ws + W_MIXIN), MT, INC, 1024,
        pg8::PEpiMixIn{(bf16_t*)p.out, (bf16_t*)(ws + O_SBZ), (bf16_t*)(ws + O_QR), (bf16_t*)(ws + O_KR), (bf16_t*)(ws + O_VT), p.mix_conv, (const float*)(ws + W_ROPE)});
  xcd_barrier(xbar);
  za_fixup(p);
  for (int rep_ = 0; rep_ < REP_ATT; ++rep_) { attention(lds, p); xcd_barrier(xbar); }
  combineA(p);
  gemm_grid(lds, (const bf16_t*)p.out + 1536, 2048, (const bf16_t*)(ws + W_L1), 512, 512, 128, 3, EpiLora1{(bf16_t*)(ws + O_L1)});
  xcd_barrier(xbar);
  for (int rep_ = 0; rep_ < REP_LORA; ++rep_) {
  for (int d = 0; d < 2; ++d) {
    gemm_grid(lds, (const bf16_t*)(ws + O_L1) + d * 64, 384, (const bf16_t*)(ws + W_W2) + (size_t)d * 512 * 64, 64, 64, 128, 4,
              EpiDecay{(bf16_t*)(ws + O_OMW) + (size_t)d * MT * 512, p.w0 + d * 512});
    gemm_grid(lds, (const bf16_t*)(ws + O_L1) + 128 + d * 64, 384, (const bf16_t*)(ws + W_A2) + (size_t)d * 512 * 64, 64, 64, 128, 4,
              EpiA{(bf16_t*)(ws + O_KD) + (size_t)d * MT * 512, (bf16_t*)(ws + O_KKA) + (size_t)d * MT * 512, (bf16_t*)(ws + O_KK), p.a0 + d * 512,
                   p.k_k, p.k_a, (const bf16_t*)p.out, d == 0});
  }
  gemm_grid(lds, (const bf16_t*)(ws + O_L1) + 256, 384, (const bf16_t*)(ws + W_G2), 128, 128, 128, 4, EpiBf16{(bf16_t*)(ws + O_G), 512});
  xcd_barrier(xbar);
  }
  for (int rep_ = 0; rep_ < REP_SCAN; ++rep_) { scan_phase(lds, p); xcd_barrier(xbar); }
  for (int rep_ = 0; rep_ < REP_SYNC; ++rep_) xcd_barrier(xbar);
  postB(p);
  xcd_barrier(xbar);
  pgemm(lds, (const bf16_t*)(ws + O_YCAT), (const bf16_t*)(ws + W_MIXOUT), MT, 1024, 1024, pg8::PEpiBf16<false>{(bf16_t*)(ws + O_YF), 1024});
  xcd_barrier(xbar);
  rowpass<true, true, false, true>(p.x, (const bf16_t*)(ws + O_YF), p.norm_g + 1024, mod + 2048, ws + O_XB, p.norm_g + 2048, mod + 4096, mod + 3072, (bf16_t*)(ws + O_H));
  xcd_barrier(xbar);
  ffn(lds, xbar, p, 0);
  {
    const float* mod1 = mod + 8 * 6144;
    rowpass<true, true, true, true>(ws + O_XB, (const bf16_t*)(ws + O_YF), p.norm_g + 3072, mod + 5120, ws + O_XB, p.norm_g + 4096, mod1 + 1024, mod1, (bf16_t*)(ws + O_H));
    bf16_t* cs = (bf16_t*)(ws + O_COSSIN);
    for (int idx = blockIdx.x * NTHR + tidx(); idx < 4096 * 256; idx += gridDim.x * NTHR) {
      const int rr = idx >> 8, s8 = (idx & 255) * 8, k1 = rr & 2047;
      float o[8];
#pragma unroll
      for (int i = 0; i < 8; ++i) {
        const float ph = (float)((k1 * (s8 + i)) & 4095) * (1.f / 2048.f);
        o[i] = ((rr < 2048) ? cospif(ph) : sinpif(ph)) * (1.f / 64.f);
      }
      *(u32x4*)(cs + (size_t)rr * 2048 + s8) = pack8(o);
    }
    xcd_barrier(xbar);
    {
      const bf16_t* dA = (const bf16_t*)(ws + W_DFTC);
      const bf16_t* hB = (const bf16_t*)(ws + O_H);
      u32x4 ra[4], rb[2];
      int t = blockIdx.x;
      if (t < 8 * 256) gemm_first_load(dA, 128, hB + (size_t)(t & 255) * 128 * 1024 + (t >> 8) * 128, 1024, ra, rb);
      for (; t < 8 * 256; t += gridDim.x) {
        const int g = t >> 8, tn = t & 255, t2 = t + gridDim.x;
        const bf16_t* Bn = (t2 < 8 * 256) ? hB + (size_t)(t2 & 255) * 128 * 1024 + (t2 >> 8) * 128 : nullptr;
        gemm_tile(lds, dA, 128, hB + (size_t)tn * 128 * 1024 + g * 128, 1024, 128, 0, tn * 128, EpiDftc{(bf16_t*)(ws + O_CST), g}, ra, rb,
                  Bn ? dA : nullptr, Bn);
      }
    }
    xcd_barrier(xbar);
    dft_fold(p);
    xcd_barrier(xbar);
    {
      pg8::Gemm g{(const bf16_t*)(ws + O_COSSIN), (const bf16_t*)(ws + O_CSTF), 4096, 16384, 2048};
      pg8::BatchOrder S{(int)gridDim.x, (int)blockIdx.x};
      pg8::gemm_phase<pg8::PEpiF32B, pg8::BatchOrder, true, true>(LDSP, g, S, pg8::PEpiF32B{(bf16_t*)(ws + O_EO)});
    }
    xcd_barrier(xbar);
    dft_combine(p);
    xcd_barrier(xbar);
    pgemm(lds, (const bf16_t*)(ws + O_F), (const bf16_t*)(ws + W_FNET), MT, 1024, 1024, pg8::PEpiBf16<false>{(bf16_t*)(ws + O_YF), 1024});
    xcd_barrier(xbar);
    rowpass<true, true, true, true>(ws + O_XB, (const bf16_t*)(ws + O_YF), p.norm_g + 4096 + 1024, mod1 + 2048, ws + O_XB, p.norm_g + 4096 + 2048, mod1 + 4096, mod1 + 3072,
                        (bf16_t*)(ws + O_H));
    xcd_barrier(xbar);
    ffn(lds, xbar, p, 1);
    rowpass<true, false, true, false>(ws + O_XB, (const bf16_t*)(ws + O_YF), p.norm_g + 4096 + 3072, mod1 + 5120, p.out, nullptr, nullptr, nullptr, nullptr);
  }
}

#undef p
extern "C" void kernel_launch(void* const* d_in, const int* in_sizes, int n_in, void* d_out, int out_size, void* d_ws, size_t ws_size,
                              hipStream_t stream) {
  static int grid_blocks = 0;
  if (!grid_blocks) {
    int dev = 0, cus = 0, per_cu = 0;
    hipGetDevice(&dev);
    hipDeviceGetAttribute(&cus, hipDeviceAttributeMultiprocessorCount, dev);
    hipFuncSetAttribute((const void*)mega, hipFuncAttributeMaxDynamicSharedMemorySize, LDS_BYTES);
    hipOccupancyMaxActiveBlocksPerMultiprocessor(&per_cu, (const void*)mega, NTHR, LDS_BYTES);
    if (per_cu < 1) { fprintf(stderr, "occupancy query returned %d\n", per_cu); per_cu = 1; }
    if (per_cu > 1) per_cu = 1;
    grid_blocks = cus * per_cu;
  }
  P p{};
  const float** pp = (const float**)&p;
  for (int i = 0; i < 25; ++i) pp[i] = (const float*)d_in[i];
  p.out = (float*)d_out;
  p.ws = (char*)d_ws;
  (void)hipMemsetAsync((char*)d_ws + W_BAR, 0, XCD_BAR_WORDS * sizeof(unsigned), stream);
  void* args[] = {&p};
  hipError_t e = hipLaunchCooperativeKernel((const void*)mega, dim3(grid_blocks), dim3(NTHR), args, LDS_BYTES, stream);
  if (e != hipSuccess) fprintf(stderr, "cooperative launch failed: %s (grid %d)\n", hipGetErrorString(e), grid_blocks);
}
```

```cpp
#include <hip/hip_runtime.h>
#include <hip/hip_cooperative_groups.h>
#include <stdint.h>
#include <cstdio>
namespace cg = cooperative_groups;

typedef unsigned short bf16_t;
typedef short bf16x8 __attribute__((ext_vector_type(8)));
typedef short s16x4 __attribute__((ext_vector_type(4)));
typedef float f32x4 __attribute__((ext_vector_type(4)));
typedef float f32x2 __attribute__((ext_vector_type(2)));
typedef unsigned u32x4 __attribute__((ext_vector_type(4)));
typedef unsigned u32x2 __attribute__((ext_vector_type(2)));

#define DEV __device__ __forceinline__
__device__ __forceinline__ int tidx() { int t = threadIdx.x; asm volatile("" : "+v"(t)); return t; }

constexpr int NB = 8, SEQ = 4096, DM = 1024, MT = NB * SEQ, DFF = 2816, INC = 3584;
constexpr size_t MiB = 1024 * 1024;
constexpr int NTHR = 512;
constexpr int LDS_BYTES = 131072 + 16;
constexpr size_t W_BAR = 47 * 1024 * 1024;
#ifndef REP_SCAN
#define REP_SCAN 1
#endif
#ifndef REP_ATT
#define REP_ATT 1
#endif
#ifndef REP_SYNC
#define REP_SYNC 0
#endif
#ifndef REP_PREP
#define REP_PREP 1
#endif
#ifndef REP_LORA
#define REP_LORA 1
#endif
#ifndef REP_GLU
#define REP_GLU 1
#endif
#ifndef REP_PRO
#define REP_PRO 1
#endif
#ifndef REP_ROW
#define REP_ROW 1
#endif

constexpr size_t W_MIXIN = 0;
constexpr size_t W_UP = 7 * MiB;
constexpr size_t W_DOWN = 29 * MiB;
constexpr size_t W_MIXOUT = 40 * MiB;
constexpr size_t W_FNET = 42 * MiB;
constexpr size_t W_L1 = 44 * MiB;
constexpr size_t W_W2 = W_L1 + 512 * 1024;
constexpr size_t W_A2 = W_W2 + 128 * 1024;
constexpr size_t W_G2 = W_A2 + 128 * 1024;
constexpr size_t W_DFTC = W_G2 + 128 * 1024;
constexpr size_t W_MOD = 45 * MiB;
constexpr size_t W_ROPE = 46 * MiB;
constexpr size_t R0 = 48 * MiB;
constexpr size_t O_H0 = R0;
constexpr size_t O_Z = 112 * MiB;
constexpr size_t O_SBZ = 304 * MiB;
constexpr size_t O_QR = 336 * MiB, O_KR = 368 * MiB, O_VT = 400 * MiB;
constexpr size_t O_NUM = R0;
constexpr size_t O_MD = 240 * MiB;
constexpr size_t O_YCAT = 448 * MiB;
constexpr size_t O_OMW = 48 * MiB, O_KD = 112 * MiB, O_KKA = 176 * MiB, O_KK = 240 * MiB, O_G = 272 * MiB, O_L1 = 304 * MiB, O_Y = 304 * MiB;
constexpr size_t O_YF = 48 * MiB;
constexpr size_t O_H = 176 * MiB;
constexpr size_t O_ZF = 240 * MiB;
constexpr size_t O_ACT = 240 * MiB;
constexpr size_t O_SB = 416 * MiB;
constexpr size_t O_COSSIN = 240 * MiB;
constexpr size_t O_CST = 304 * MiB;
constexpr size_t O_F = 432 * MiB;
constexpr size_t O_CSTF = 432 * MiB;
constexpr size_t O_C2048 = 272 * MiB;
constexpr size_t O_EO = 48 * MiB;
constexpr size_t O_XB = 112 * MiB;

struct P {
  const float *x, *c, *ada_w, *ada_b, *norm_g, *mix_in, *mix_conv, *w0, *w1, *w2, *a0, *a1, *a2, *g1, *g2, *k_k, *k_a, *r_k, *lnx_w,
      *lnx_b, *mix_out, *fnet_w, *ffn_up, *ffn_conv, *ffn_down;
  float* out;
  char* ws;
};

DEV float bf2f(bf16_t h) { return __uint_as_float(((unsigned)h) << 16); }
DEV bf16_t f2bf(float f) {
  unsigned u = __float_as_uint(f);
  u += 0x7fffu + ((u >> 16) & 1u);
  return (bf16_t)(u >> 16);
}
DEV unsigned pk2(float a, float b) { return (unsigned)f2bf(a) | ((unsigned)f2bf(b) << 16); }
DEV float lo16(unsigned u) { return __uint_as_float(u << 16); }
DEV float hi16(unsigned u) { return __uint_as_float(u & 0xffff0000u); }
DEV float wave_sum(float v) {
#pragma unroll
  for (int o = 32; o; o >>= 1) v += __shfl_xor(v, o);
  return v;
}
DEV float sigmoidf_(float x) { return __builtin_amdgcn_rcpf(1.f + __expf(-x)); }

#include <cstdint>
#include <cstdlib>
#include <vector>

#define XB_TMO      128
#define XB_XCNT(j)  (256  + 64 * (j))
#define XB_XSUB(j)  (1280 + 64 * (j))
#define XB_XGEN(j)  (2304 + 64 * (j))
#define XB_TOP      3328
#define XB_TOPGEN   3392
#define XCD_BAR_WORDS 3456
#define XB_SPIN_CAP (1u << 18)
#define XLAS __attribute__((address_space(3)))

__device__ __forceinline__ unsigned xb_ld(unsigned* p)              { return __hip_atomic_load(p, __ATOMIC_RELAXED, __HIP_MEMORY_SCOPE_AGENT); }
__device__ __forceinline__ unsigned xb_add(unsigned* p, unsigned v) { return __hip_atomic_fetch_add(p, v, __ATOMIC_RELAXED, __HIP_MEMORY_SCOPE_AGENT); }
__device__ __forceinline__ unsigned xb_xcc_id() { return (unsigned)__builtin_amdgcn_s_getreg((3 << 11) | 20) & 0xFu; }
#define XB_SPIN(cond, bar) do { unsigned _sp = 0; while (cond) { __builtin_amdgcn_s_sleep(1); \
    if ((++_sp & 255u) == 0u) { if (xb_ld(&(bar)[XB_TMO])) break; if (_sp > XB_SPIN_CAP) { atomicAdd(&(bar)[XB_TMO], 1u); break; } } } } while (0)

struct XcdBarrier {
    unsigned* bar; unsigned x;
    volatile XLAS unsigned* st;
};

__device__ __forceinline__ XcdBarrier xcd_barrier_post(unsigned* bar, volatile XLAS unsigned* st) {
    XcdBarrier b; b.bar = bar; b.x = xb_xcc_id(); b.st = st;
    if (threadIdx.x == 0) (void)xb_add(&bar[XB_XCNT(b.x)], 1u);
    return b;
}
__device__ __forceinline__ void xcd_barrier_complete(unsigned* bar, unsigned x, unsigned& nloc, unsigned& nx) {
    const unsigned G = gridDim.x * gridDim.y * gridDim.z;
    unsigned sum, cnt, mine, sp = 0u;
    for (;;) {
        sum = 0u; cnt = 0u; mine = 0u;
#pragma unroll
        for (unsigned j = 0; j < 16; ++j) { const unsigned c = xb_ld(&bar[XB_XCNT(j)]); sum += c; cnt += (c > 0u) ? 1u : 0u; mine = (j == x) ? c : mine; }
        if (sum == G) break;
        __builtin_amdgcn_s_sleep(1);
        if ((++sp & 255u) == 0u) { if (xb_ld(&bar[XB_TMO])) break; if (sp > XB_SPIN_CAP) { atomicAdd(&bar[XB_TMO], 1u); break; } }
    }
    nloc = mine > 0u ? mine : 1u; nx = cnt > 0u ? cnt : 1u;
}

__device__ __forceinline__ void xcd_barrier(const XcdBarrier& b) {
    asm volatile("s_waitcnt vmcnt(0)" ::: "memory");
    __syncthreads();
    if (threadIdx.x == 0) {
        unsigned* bar = b.bar;
        __builtin_amdgcn_s_waitcnt(0);
        unsigned nloc = b.st[0], nx = b.st[1];
        if (nloc == 0u) { xcd_barrier_complete(bar, b.x, nloc, nx); b.st[0] = nloc; b.st[1] = nx; }
        const unsigned old = xb_add(&bar[XB_XSUB(b.x)], 1u);
        const unsigned gen = old / nloc;
        if (old + 1u == (gen + 1u) * nloc) {
            __builtin_amdgcn_fence(__ATOMIC_RELEASE, "agent");
            asm volatile("s_waitcnt vmcnt(0)" ::: "memory");
            const unsigned og = xb_add(&bar[XB_TOP], 1u);
            const unsigned tg = og / nx;
            if (og + 1u == (tg + 1u) * nx) xb_add(&bar[XB_TOPGEN], 1u);
            else XB_SPIN(xb_ld(&bar[XB_TOPGEN]) == tg, bar);
            __builtin_amdgcn_fence(__ATOMIC_ACQUIRE, "agent");
            xb_add(&bar[XB_XGEN(b.x)], 1u);
            asm volatile("s_waitcnt vmcnt(0)" ::: "memory");
        } else {
            XB_SPIN(xb_ld(&bar[XB_XGEN(b.x)]) == gen, bar);
            __builtin_amdgcn_fence(__ATOMIC_ACQUIRE, "agent");
            asm volatile("s_waitcnt vmcnt(0)" ::: "memory");
        }
    }
    __syncthreads();
}

namespace pg8 {
#define PG8_LAS __attribute__((address_space(3)))
typedef unsigned short bf16_t;
typedef short bf16x8 __attribute__((ext_vector_type(8)));
typedef float f32x4 __attribute__((ext_vector_type(4)));
typedef unsigned u32x4 __attribute__((ext_vector_type(4)));
constexpr int BM = 256, BK = 64, HALF = 128, HTB = HALF * BK * 2  , STAGE_BYTES = 8 * HTB, NXCD = 8, WGM = 8;

__host__ __device__ __forceinline__ int lds_byte(int r, int c) { const int st = (r >> 4) * 2 + (c >> 5), rr = r & 15, cc = c & 31, ob = rr * 64 + cc * 2; return st * 1024 + (ob ^ (((ob >> 9) & 1) << 5)); }
__host__ __device__ __forceinline__ void stage_rc(int b, int& R, int& C) { const int st = b / 1024, sb = b % 1024, swz = sb ^ (((sb >> 9) & 1) << 5); R = (st >> 1) * 16 + swz / 64; C = (st & 1) * 32 + (swz % 64) / 2; }
__host__ __device__ __forceinline__ int perm32(int rho) { const int n = rho >> 4, i = rho & 15; return 8 * (i >> 2) + 4 * n + (i & 3); }

struct Unit { int pm, pn; };
struct Gemm { const bf16_t* A; const bf16_t* Bt; int M, N, K; };

struct StaticOrder {
    int nM, nN, nwg, G, c;
    __host__ __device__ void init(int M, int N, int G_, int c_) { nM = M / BM; nN = N / BM; nwg = nM * nN; G = G_; c = c_; }
    __host__ __device__ bool next(int i, Unit& u) const {
        const long L = (long)i * G + c; if (L >= nwg) return false;
        int wgid = (int)L; { const int q = nwg / NXCD, r = nwg % NXCD, xcd = wgid % NXCD, off = wgid / NXCD; wgid = (xcd < r ? xcd * (q + 1) : r * (q + 1) + (xcd - r) * q) + off; }
        const int nig = WGM * nN, gid = wgid / nig, fm = gid * WGM, gsz = (nM - fm) < WGM ? (nM - fm) : WGM;
        u.pm = fm + ((wgid % nig) % gsz); u.pn = (wgid % nig) / gsz; return true;
    }
    __device__ __forceinline__ void a_ready(const Unit&) const {}
    __device__ __forceinline__ void done(const Unit&) const {}
};

__device__ __forceinline__ unsigned cvt_pk_bf16(float lo, float hi) { unsigned r; asm volatile("v_cvt_pk_bf16_f32 %0, %1, %2" : "=v"(r) : "v"(lo), "v"(hi)); return r; }

template <bool BATCHED> struct PEpiBf16 {
    static constexpr bool PERM = true, AFTER_DRAIN = false;
    bf16_t* O; int ldc;
    __device__ __forceinline__ void operator()(const f32x4 (&acc)[2][2][4][2], const Unit& u, int wr, int wc, int fr, int fq) const {
        const int rb = BATCHED ? ((u.pn >> 2) * 4096 + u.pm * 256) : u.pm * 256, cb = BATCHED ? (u.pn & 3) * 256 : u.pn * 256;
        const int row0 = rb + wr * 64 + fr, col0 = cb + wc * 32 + 8 * fq;
#pragma unroll
        for (int ai = 0; ai < 2; ++ai)
#pragma unroll
            for (int m = 0; m < 4; ++m) { bf16_t* rowp = O + (size_t)(row0 + ai * HALF + m * 16) * ldc + col0;
#pragma unroll
                for (int bj = 0; bj < 2; ++bj) { const f32x4 v0 = acc[ai][bj][m][0], v1 = acc[ai][bj][m][1];
                    u32x4 w; w.x = cvt_pk_bf16(v0[0], v0[1]); w.y = cvt_pk_bf16(v0[2], v0[3]); w.z = cvt_pk_bf16(v1[0], v1[1]); w.w = cvt_pk_bf16(v1[2], v1[3]);
                    *(u32x4*)(rowp + bj * HALF) = w; } }
    }
};
struct PEpiF32 {
    static constexpr bool PERM = true, AFTER_DRAIN = false;
    float* O; int ldc;
    __device__ __forceinline__ void operator()(const f32x4 (&acc)[2][2][4][2], const Unit& u, int wr, int wc, int fr, int fq) const {
        const int row0 = u.pm * 256 + wr * 64 + fr, col0 = u.pn * 256 + wc * 32 + 8 * fq;
#pragma unroll
        for (int ai = 0; ai < 2; ++ai)
#pragma unroll
            for (int m = 0; m < 4; ++m) { float* rowp = O + (size_t)(row0 + ai * HALF + m * 16) * ldc + col0;
#pragma unroll
                for (int bj = 0; bj < 2; ++bj) { *(f32x4*)(rowp + bj * HALF) = acc[ai][bj][m][0]; *(f32x4*)(rowp + bj * HALF + 4) = acc[ai][bj][m][1]; } }
    }
};
template <int CTRL> __device__ __forceinline__ float dppz(float x) { return __int_as_float(__builtin_amdgcn_update_dpp(0, __float_as_int(x), CTRL, 0xF, 0xF, true)); }
template <int CTRL> __device__ __forceinline__ float dppo(float old, float x) { return __int_as_float(__builtin_amdgcn_update_dpp(__float_as_int(old), __float_as_int(x), CTRL, 0xF, 0xF, false)); }
struct PEpiGlu {
    static constexpr bool PERM = true, AFTER_DRAIN = false;
    bf16_t* act; bf16_t* sb; const float* cw;
    __device__ __forceinline__ void operator()(const f32x4 (&acc)[2][2][4][2], const Unit& u, int wr, int wc, int fr, int fq) const {
        const int chb = u.pn * 128 + wc * 32 + 8 * fq, colp = u.pn * 256 + wc * 32 + 8 * fq;
#pragma unroll
        for (int n = 0; n < 2; ++n) {
            const int ch = chb + 4 * n;
            const f32x4 g0 = *(const f32x4*)(cw + ch), g1 = *(const f32x4*)(cw + 5632 + ch), g2 = *(const f32x4*)(cw + 11264 + ch);
            const f32x4 v0 = *(const f32x4*)(cw + 2816 + ch), v1 = *(const f32x4*)(cw + 5632 + 2816 + ch), v2 = *(const f32x4*)(cw + 11264 + 2816 + ch);
#pragma unroll
            for (int ai = 0; ai < 2; ++ai) {
                const int strip = u.pm * 4 + ai * 2 + wr, rowbase = u.pm * 256 + ai * HALF + wr * 64;
#pragma unroll
                for (int m = 0; m < 4; ++m) {
                    float o[4];
#pragma unroll
                    for (int r = 0; r < 4; ++r) {
                        const float gc = acc[ai][0][m][n][r], vc = acc[ai][1][m][n][r];
                        float gx = 0.f, vx = 0.f, gy = 0.f, vy = 0.f;
                        if (m > 0) { gx = dppz<0x121>(acc[ai][0][m - 1][n][r]); vx = dppz<0x121>(acc[ai][1][m - 1][n][r]); }
                        const float gp = dppo<0x111>(gx, gc), vp = dppo<0x111>(vx, vc);
                        if (m < 3) { gy = dppz<0x12F>(acc[ai][0][m + 1][n][r]); vy = dppz<0x12F>(acc[ai][1][m + 1][n][r]); }
                        const float gn = dppo<0x101>(gy, gc), vn = dppo<0x101>(vy, vc);
                        const float g = gp * g0[r] + gc * g1[r] + gn * g2[r];
                        const float v = vp * v0[r] + vc * v1[r] + vn * v2[r];
                        const float u2 = -1.5957691216057308f * (g + 0.044715f * g * g * g);
                        o[r] = g * __builtin_amdgcn_rcpf(1.f + __expf(u2)) * v;
                    }
                    u32x2 w; w.x = cvt_pk_bf16(o[0], o[1]); w.y = cvt_pk_bf16(o[2], o[3]);
                    *(u32x2*)(act + (size_t)(rowbase + m * 16 + fr) * 2816 + ch) = w;
                }
                if (fr < 2) {
                    bf16_t* sp = sb + ((size_t)strip * 4 + fr) * 5632 + colp + 4 * n;
                    u32x2 w; w.x = cvt_pk_bf16(acc[ai][0][0][n][0], acc[ai][0][0][n][1]); w.y = cvt_pk_bf16(acc[ai][0][0][n][2], acc[ai][0][0][n][3]);
                    *(u32x2*)sp = w;
                    w.x = cvt_pk_bf16(acc[ai][1][0][n][0], acc[ai][1][0][n][1]); w.y = cvt_pk_bf16(acc[ai][1][0][n][2], acc[ai][1][0][n][3]);
                    *(u32x2*)(sp + 128) = w;
                }
                if (fr >= 14) {
                    bf16_t* sp = sb + ((size_t)strip * 4 + (fr - 12)) * 5632 + colp + 4 * n;
                    u32x2 w; w.x = cvt_pk_bf16(acc[ai][0][3][n][0], acc[ai][0][3][n][1]); w.y = cvt_pk_bf16(acc[ai][0][3][n][2], acc[ai][0][3][n][3]);
                    *(u32x2*)sp = w;
                    w.x = cvt_pk_bf16(acc[ai][1][3][n][0], acc[ai][1][3][n][1]); w.y = cvt_pk_bf16(acc[ai][1][3][n][2], acc[ai][1][3][n][3]);
                    *(u32x2*)(sp + 128) = w;
                }
            }
        }
    }
};
struct PEpiMixIn {
    static constexpr bool PERM = true, AFTER_DRAIN = false;
    bf16_t *za, *sbz, *qr, *kr, *vr; const float *cw, *rope;
    __device__ __forceinline__ void operator()(const f32x4 (&acc)[2][2][4][2], const Unit& u, int wr, int wc, int fr, int fq) const {
        if (u.pn < 8) {
#pragma unroll
            for (int bj = 0; bj < 2; ++bj)
#pragma unroll
                for (int n = 0; n < 2; ++n) {
                    const int col = u.pn * 256 + bj * HALF + wc * 32 + 8 * fq + 4 * n;
                    const f32x4 w0 = *(const f32x4*)(cw + col), w1 = *(const f32x4*)(cw + 2048 + col), w2 = *(const f32x4*)(cw + 4096 + col);
#pragma unroll
                    for (int ai = 0; ai < 2; ++ai) {
                        const int strip = u.pm * 4 + ai * 2 + wr, rowbase = u.pm * 256 + ai * HALF + wr * 64;
#pragma unroll
                        for (int m = 0; m < 4; ++m) {
                            float o[4];
#pragma unroll
                            for (int r = 0; r < 4; ++r) {
                                const float c = acc[ai][bj][m][n][r];
                                float x = 0.f, y = 0.f;
                                if (m > 0) x = dppz<0x121>(acc[ai][bj][m - 1][n][r]);
                                const float pv = dppo<0x111>(x, c);
                                if (m < 3) y = dppz<0x12F>(acc[ai][bj][m + 1][n][r]);
                                const float nx = dppo<0x101>(y, c);
                                o[r] = pv * w0[r] + c * w1[r] + nx * w2[r];
                            }
                            u32x2 w; w.x = cvt_pk_bf16(o[0], o[1]); w.y = cvt_pk_bf16(o[2], o[3]);
                            *(u32x2*)(za + (size_t)(rowbase + m * 16 + fr) * 2048 + col) = w;
                        }
                        if (fr < 2) { u32x2 w; w.x = cvt_pk_bf16(acc[ai][bj][0][n][0], acc[ai][bj][0][n][1]); w.y = cvt_pk_bf16(acc[ai][bj][0][n][2], acc[ai][bj][0][n][3]);
                            *(u32x2*)(sbz + ((size_t)strip * 4 + fr) * 2048 + col) = w; }
                        if (fr >= 14) { u32x2 w; w.x = cvt_pk_bf16(acc[ai][bj][3][n][0], acc[ai][bj][3][n][1]); w.y = cvt_pk_bf16(acc[ai][bj][3][n][2], acc[ai][bj][3][n][3]);
                            *(u32x2*)(sbz + ((size_t)strip * 4 + (fr - 12)) * 2048 + col) = w; }
                    }
                }
        } else if (u.pn < 12) {
            const int which = (u.pn - 8) >> 1;
            bf16_t* dst = which ? kr : qr;
            const float scl = which ? 1.f : 0.125f;
#pragma unroll
            for (int bj = 0; bj < 2; ++bj) {
                const int cq = ((u.pn - 8) & 1) * 256 + bj * HALF + wc * 32 + 8 * fq, h = cq >> 6, j0 = (cq & 63) >> 1;
#pragma unroll
                for (int ai = 0; ai < 2; ++ai)
#pragma unroll
                    for (int m = 0; m < 4; ++m) {
                        const int row = u.pm * 256 + ai * HALF + wr * 64 + m * 16 + fr, s = row & 4095;
                        const float* rp = rope + ((size_t)s * 32 + j0) * 2;
                        const f32x4 t0 = *(const f32x4*)rp, t1 = *(const f32x4*)(rp + 4);
                        const f32x4 a = acc[ai][bj][m][0], b = acc[ai][bj][m][1];
                        float o1[4], o2[4];
                        o1[0] = (a[0] * t0[0] - a[1] * t0[1]) * scl; o2[0] = (a[1] * t0[0] + a[0] * t0[1]) * scl;
                        o1[1] = (a[2] * t0[2] - a[3] * t0[3]) * scl; o2[1] = (a[3] * t0[2] + a[2] * t0[3]) * scl;
                        o1[2] = (b[0] * t1[0] - b[1] * t1[1]) * scl; o2[2] = (b[1] * t1[0] + b[0] * t1[1]) * scl;
                        o1[3] = (b[2] * t1[2] - b[3] * t1[3]) * scl; o2[3] = (b[3] * t1[2] + b[2] * t1[3]) * scl;
                        bf16_t* dp = dst + (size_t)row * 512 + h * 64 + j0;
                        u32x2 w; w.x = cvt_pk_bf16(o1[0], o1[1]); w.y = cvt_pk_bf16(o1[2], o1[3]); *(u32x2*)dp = w;
                        w.x = cvt_pk_bf16(o2[0], o2[1]); w.y = cvt_pk_bf16(o2[2], o2[3]); *(u32x2*)(dp + 32) = w;
                    }
            }
        } else {
#pragma unroll
            for (int bj = 0; bj < 2; ++bj) {
                const int cv = (u.pn - 12) * 256 + bj * HALF + wc * 32 + 8 * fq;
#pragma unroll
                for (int ai = 0; ai < 2; ++ai)
#pragma unroll
                    for (int m = 0; m < 4; ++m) {
                        const int row = u.pm * 256 + ai * HALF + wr * 64 + m * 16 + fr;
                        const f32x4 v0 = acc[ai][bj][m][0], v1 = acc[ai][bj][m][1];
                        u32x4 w; w.x = cvt_pk_bf16(v0[0], v0[1]); w.y = cvt_pk_bf16(v0[2], v0[3]); w.z = cvt_pk_bf16(v1[0], v1[1]); w.w = cvt_pk_bf16(v1[2], v1[3]);
                        *(u32x4*)(vr + (size_t)row * 512 + cv) = w;
                    }
            }
        }
    }
};
struct PEpiF32B {
    static constexpr bool PERM = true, AFTER_DRAIN = false;
    bf16_t* O;
    __device__ __forceinline__ void operator()(const f32x4 (&acc)[2][2][4][2], const Unit& u, int wr, int wc, int fr, int fq) const {
        const int row0 = (u.pn >> 2) * 2048 + (u.pm & 7) * 256 + wr * 64 + fr, col0 = (u.pn & 3) * 256 + wc * 32 + 8 * fq;
#pragma unroll
        for (int ai = 0; ai < 2; ++ai)
#pragma unroll
            for (int m = 0; m < 4; ++m) { bf16_t* rowp = O + (size_t)(row0 + ai * HALF + m * 16) * 1024 + col0;
#pragma unroll
                for (int bj = 0; bj < 2; ++bj) { const f32x4 v0 = acc[ai][bj][m][0], v1 = acc[ai][bj][m][1];
                    u32x4 w; w.x = cvt_pk_bf16(v0[0], v0[1]); w.y = cvt_pk_bf16(v0[2], v0[3]); w.z = cvt_pk_bf16(v1[0], v1[1]); w.w = cvt_pk_bf16(v1[2], v1[3]);
                    *(u32x4*)(rowp + bj * HALF) = w; } }
    }
};
struct BatchOrder {
    int G, c;
    __device__ __forceinline__ bool next(int i, Unit& u) const { const int L = i * G + c; if (L >= 512) return false; const int be = L >> 5, r = L & 31; u.pm = (be & 1) * 8 + (r >> 2); u.pn = be * 4 + (r & 3); return true; }
    __device__ __forceinline__ void a_ready(const Unit&) const {}
    __device__ __forceinline__ void done(const Unit&) const {}
};
template <class Epi, class Sched, bool ALIGN_EPI = false, bool SP2 = false>
__device__ __forceinline__ void gemm_phase(PG8_LAS unsigned char* lds, const Gemm g, const Sched& S, const Epi& E) {
    int tid_ = threadIdx.x; asm volatile("" : "+v"(tid_));
    const int tid = tid_, wid = __builtin_amdgcn_readfirstlane(tid >> 6), lane = tid & 63, wr = wid >> 2, wc = wid & 3, fr = lane & 15, fq = lane >> 4;
    const int K = g.K, nt = K / BK;
    unsigned voffA[2], voffB[2];
#pragma unroll
    for (int i = 0; i < 2; ++i) { int R, C; stage_rc(tid * 16 + i * 8192, R, C); const int Rb = Epi::PERM ? ((R & ~31) + perm32(R & 31)) : R;
        voffA[i] = (unsigned)(R * K + C) * 2u; voffB[i] = (unsigned)(Rb * K + C) * 2u; }
    const size_t kstep = (size_t)(BK * 2);
    const size_t hstep = (size_t)HALF * K * 2;
    const size_t tstep = 2 * hstep;
    const unsigned ldsw = (unsigned)wid * 1024u;
    const int aoff = lds_byte(wr * 64 + fr, fq * 8), boff = lds_byte(wc * 32 + fr, fq * 8);
#define PG8_SA(b, h) (((b) * 2 + (h)) * HTB)
#define PG8_SB(b, h) ((4 + (b) * 2 + (h)) * HTB)
#define PG8_STAGE(bufoff, gbase, voff) do { _Pragma("unroll") for (int _i = 0; _i < 2; ++_i) \
        __builtin_amdgcn_global_load_lds((const unsigned*)((const char*)(gbase) + (voff)[_i]), (PG8_LAS unsigned*)(lds + (bufoff) + ldsw + _i * 8192), 16, 0, 0); } while (0)
#define PG8_LDA(dst, b, h) do { _Pragma("unroll") for (int m = 0; m < 4; ++m) _Pragma("unroll") for (int k = 0; k < 2; ++k) dst[m][k] = *(const PG8_LAS bf16x8*)(lds + PG8_SA(b, h) + aoff + m * 2048 + k * 1024); } while (0)
#define PG8_LDB(dst, b, h) do { _Pragma("unroll") for (int n = 0; n < 2; ++n) _Pragma("unroll") for (int k = 0; k < 2; ++k) dst[n][k] = *(const PG8_LAS bf16x8*)(lds + PG8_SB(b, h) + boff + n * 2048 + k * 1024); } while (0)
#define PG8_MMA(ai, bj, At, Bt) do { __builtin_amdgcn_s_setprio(1); _Pragma("unroll") for (int m = 0; m < 4; ++m) _Pragma("unroll") for (int n = 0; n < 2; ++n) _Pragma("unroll") for (int k = 0; k < 2; ++k) \
        acc[ai][bj][m][n] = __builtin_amdgcn_mfma_f32_16x16x32_bf16(Bt[n][k], At[m][k], acc[ai][bj][m][n], 0, 0, 0); __builtin_amdgcn_s_setprio(0); } while (0)
#define PG8_WAIT_V(n) asm volatile("s_waitcnt vmcnt(" #n ")" ::: "memory")
#define PG8_WAIT_L(n) asm volatile("s_waitcnt lgkmcnt(" #n ")" ::: "memory")
#define PG8_BAR __builtin_amdgcn_s_barrier()
#define PG8_SCHED __builtin_amdgcn_sched_barrier(0)
    Unit cur, nxt; int ui = 0;
    if (!S.next(0, cur)) return;
    f32x4 acc[2][2][4][2];
#pragma unroll
    for (int a = 0; a < 2; ++a)
#pragma unroll
        for (int b = 0; b < 2; ++b)
#pragma unroll
            for (int m = 0; m < 4; ++m)
#pragma unroll
                for (int n = 0; n < 2; ++n) acc[a][b][m][n] = (f32x4){0.f, 0.f, 0.f, 0.f};
    bf16x8 At[4][2], B0[2][2], B1[2][2];
    const char* cA = (const char*)g.A + (size_t)cur.pm * tstep; const char* cB = (const char*)g.Bt + (size_t)cur.pn * tstep;
    S.a_ready(cur);
    if constexpr (SP2) {
        PG8_STAGE(PG8_SB(0, 0), cB, voffB); PG8_STAGE(PG8_SB(0, 1), cB + hstep, voffB); PG8_STAGE(PG8_SA(0, 0), cA, voffA); PG8_STAGE(PG8_SA(0, 1), cA + hstep, voffA);
        if (wr == 1) PG8_BAR;
        PG8_WAIT_V(2); PG8_BAR;
        PG8_STAGE(PG8_SB(1, 0), cB + kstep, voffB); PG8_STAGE(PG8_SA(1, 0), cA + kstep, voffA); PG8_STAGE(PG8_SB(1, 1), cB + hstep + kstep, voffB);
        PG8_WAIT_V(6); PG8_BAR;
    } else {
        PG8_STAGE(PG8_SB(0, 0), cB, voffB); PG8_STAGE(PG8_SA(0, 0), cA, voffA); PG8_STAGE(PG8_SB(0, 1), cB + hstep, voffB); PG8_STAGE(PG8_SA(0, 1), cA + hstep, voffA);
        if (wr == 1) PG8_BAR;
        PG8_WAIT_V(4); PG8_BAR;
        PG8_STAGE(PG8_SB(1, 0), cB + kstep, voffB); PG8_STAGE(PG8_SA(1, 0), cA + kstep, voffA); PG8_STAGE(PG8_SB(1, 1), cB + hstep + kstep, voffB);
        PG8_WAIT_V(6); PG8_BAR;
    }
    for (;;) {
        const bool has_next = S.next(ui + 1, nxt);
        const char* nA = has_next ? (const char*)g.A + (size_t)nxt.pm * tstep : cA; const char* nB = has_next ? (const char*)g.Bt + (size_t)nxt.pn * tstep : cB;
        for (int t = 0; t < nt; t += 2) {
            const bool last = (t == nt - 2);
            const char* a1 = cA + (size_t)(t + 1) * kstep;
            const char* a2 = last ? nA : cA + (size_t)(t + 2) * kstep; const char* b2 = last ? nB : cB + (size_t)(t + 2) * kstep;
            const char* a3 = a2 + kstep; const char* b3 = b2 + kstep;
            if (last && has_next) S.a_ready(nxt);
            if constexpr (SP2) {
            PG8_LDB(B0, 0, 0); PG8_LDB(B1, 0, 1); PG8_SCHED; PG8_LDA(At, 0, 0); PG8_STAGE(PG8_SA(1, 1), a1 + hstep, voffA);
            PG8_WAIT_V(8); PG8_WAIT_L(0); PG8_BAR; PG8_MMA(0, 0, At, B0); PG8_MMA(0, 1, At, B1); PG8_BAR; PG8_SCHED;
            PG8_LDA(At, 0, 1); PG8_STAGE(PG8_SB(0, 0), b2, voffB); PG8_STAGE(PG8_SB(0, 1), b2 + hstep, voffB); PG8_STAGE(PG8_SA(0, 0), a2, voffA);
            PG8_WAIT_V(8); PG8_WAIT_L(0); PG8_BAR; PG8_MMA(1, 0, At, B0); PG8_MMA(1, 1, At, B1); PG8_BAR; PG8_SCHED;
            PG8_LDB(B0, 1, 0); PG8_LDB(B1, 1, 1); PG8_SCHED; PG8_LDA(At, 1, 0); PG8_STAGE(PG8_SA(0, 1), a2 + hstep, voffA);
            PG8_WAIT_V(8); PG8_WAIT_L(0); PG8_BAR; PG8_MMA(0, 0, At, B0); PG8_MMA(0, 1, At, B1); PG8_BAR; PG8_SCHED;
            PG8_LDA(At, 1, 1); PG8_STAGE(PG8_SB(1, 0), b3, voffB); PG8_STAGE(PG8_SB(1, 1), b3 + hstep, voffB); PG8_STAGE(PG8_SA(1, 0), a3, voffA);
            PG8_WAIT_V(8); PG8_WAIT_L(0); PG8_BAR; PG8_MMA(1, 0, At, B0); PG8_MMA(1, 1, At, B1); PG8_BAR; PG8_SCHED;
            } else {
            PG8_LDB(B0, 0, 0); PG8_SCHED; PG8_LDA(At, 0, 0); PG8_STAGE(PG8_SA(1, 1), a1 + hstep, voffA);
            PG8_WAIT_L(8); PG8_BAR; PG8_WAIT_L(0); PG8_MMA(0, 0, At, B0); PG8_BAR; PG8_SCHED;
            PG8_LDB(B1, 0, 1); PG8_STAGE(PG8_SB(0, 0), b2, voffB);
            PG8_BAR; PG8_WAIT_L(0); PG8_MMA(0, 1, At, B1); PG8_BAR;
            PG8_LDA(At, 0, 1); PG8_STAGE(PG8_SA(0, 0), a2, voffA);
            PG8_BAR; PG8_WAIT_L(0); PG8_MMA(1, 0, At, B0); PG8_BAR; PG8_SCHED;
            PG8_STAGE(PG8_SB(0, 1), b2 + hstep, voffB);
            PG8_WAIT_V(6); PG8_BAR; PG8_MMA(1, 1, At, B1); PG8_BAR;
            PG8_LDB(B0, 1, 0); PG8_SCHED; PG8_LDA(At, 1, 0); PG8_STAGE(PG8_SA(0, 1), a2 + hstep, voffA);
            PG8_WAIT_L(8); PG8_BAR; PG8_WAIT_L(0); PG8_MMA(0, 0, At, B0); PG8_BAR; PG8_SCHED;
            PG8_LDB(B1, 1, 1); PG8_STAGE(PG8_SB(1, 0), b3, voffB);
            PG8_BAR; PG8_WAIT_L(0); PG8_MMA(0, 1, At, B1); PG8_BAR;
            PG8_LDA(At, 1, 1); PG8_STAGE(PG8_SA(1, 0), a3, voffA);
            PG8_BAR; PG8_WAIT_L(0); PG8_MMA(1, 0, At, B0); PG8_BAR; PG8_SCHED;
            PG8_STAGE(PG8_SB(1, 1), b3 + hstep, voffB);
            PG8_WAIT_V(6); PG8_BAR; PG8_MMA(1, 1, At, B1); PG8_BAR;
            }
        }
        if constexpr (ALIGN_EPI) { if (wr == 0) PG8_BAR; }
        if constexpr (!Epi::AFTER_DRAIN) { E(acc, cur, wr, wc, fr, fq); S.done(cur); }
        if (!has_next) break;
#pragma unroll
        for (int a = 0; a < 2; ++a)
#pragma unroll
            for (int b = 0; b < 2; ++b)
#pragma unroll
                for (int m = 0; m < 4; ++m)
#pragma unroll
                    for (int n = 0; n < 2; ++n) acc[a][b][m][n] = (f32x4){0.f, 0.f, 0.f, 0.f};
        cur = nxt; cA = nA; cB = nB; ++ui;
        if constexpr (ALIGN_EPI) { if (wr == 1) PG8_BAR; }
    }
    PG8_WAIT_V(0);
    if constexpr (!ALIGN_EPI) { if (wr == 0) PG8_BAR; }
    PG8_BAR;
    if constexpr (Epi::AFTER_DRAIN) { E.fused(acc, cur, wr, wc, fr, fq, lds, wid, lane); S.done(cur); }
#undef PG8_SA
#undef PG8_SB
#undef PG8_STAGE
#undef PG8_LDA
#undef PG8_LDB
#undef PG8_MMA
#undef PG8_WAIT_V
#undef PG8_WAIT_L
#undef PG8_BAR
#undef PG8_SCHED
}
}

DEV void gemm_first_load(const bf16_t* __restrict__ A, int lda, const bf16_t* __restrict__ Bt, int ldb, u32x4 (&ra)[4], u32x4 (&rb)[2]) {
  const int tid = tidx(), w = tid >> 6, l = tid & 63, lr = l & 15, lq = l >> 4;
#pragma unroll
  for (int j = 0; j < 4; ++j) {
    const int c = w * 4 + j, mt = c >> 1, sl = c & 1;
    ra[j] = *(const u32x4*)(A + (size_t)(mt * 16 + lr) * lda + sl * 32 + lq * 8);
  }
#pragma unroll
  for (int j = 0; j < 2; ++j) {
    const int nt = w, sl = j;
    const int rowb = (nt >> 2) * 64 + (lr >> 2) * 16 + (nt & 3) * 4 + (lr & 3);
    rb[j] = *(const u32x4*)(Bt + (size_t)rowb * ldb + sl * 32 + lq * 8);
  }
}
template <class Epi>
DEV void gemm_tile(char* lds, const bf16_t* __restrict__ A, int lda, const bf16_t* __restrict__ Bt, int ldb, int K, int trow, int tcol,
                   const Epi& epi, u32x4 (&ra)[4], u32x4 (&rb)[2], const bf16_t* __restrict__ An, const bf16_t* __restrict__ Bn) {
  const int tid = tidx(), w = tid >> 6, l = tid & 63, wm = w >> 1, wn = w & 1, lr = l & 15, lq = l >> 4;
  const bf16_t* ga[4];
  const bf16_t* gb[2];
#pragma unroll
  for (int j = 0; j < 4; ++j) {
    const int c = w * 4 + j, mt = c >> 1, sl = c & 1;
    ga[j] = A + (size_t)(mt * 16 + lr) * lda + sl * 32 + lq * 8;
  }
#pragma unroll
  for (int j = 0; j < 2; ++j) {
    const int nt = w, sl = j;
    const int rowb = (nt >> 2) * 64 + (lr >> 2) * 16 + (nt & 3) * 4 + (lr & 3);
    gb[j] = Bt + (size_t)rowb * ldb + sl * 32 + lq * 8;
  }
  f32x4 acc[4][4];
#pragma unroll
  for (int i = 0; i < 4; ++i)
#pragma unroll
    for (int j = 0; j < 4; ++j) acc[i][j] = (f32x4){0.f, 0.f, 0.f, 0.f};
  const int nk = K >> 6;
#pragma unroll
  for (int j = 0; j < 4; ++j) *(u32x4*)(lds + (w * 4 + j) * 1024 + l * 16) = ra[j];
#pragma unroll
  for (int j = 0; j < 2; ++j) *(u32x4*)(lds + 32768 + (w * 2 + j) * 1024 + l * 16) = rb[j];
  __syncthreads();
  for (int kt = 0; kt < nk; ++kt) {
    char* cur = lds + (kt & 1) * 49152;
    const bool more = (kt + 1 < nk);
    if (more) {
#pragma unroll
      for (int j = 0; j < 4; ++j) ra[j] = *(const u32x4*)(ga[j] + (kt + 1) * 64);
#pragma unroll
      for (int j = 0; j < 2; ++j) rb[j] = *(const u32x4*)(gb[j] + (kt + 1) * 64);
    }
#pragma unroll
    for (int s = 0; s < 2; ++s) {
      bf16x8 af[4], bfr[4];
#pragma unroll
      for (int i = 0; i < 4; ++i) af[i] = *(const bf16x8*)(cur + ((wm * 4 + i) * 2 + s) * 1024 + l * 16);
#pragma unroll
      for (int j = 0; j < 4; ++j) bfr[j] = *(const bf16x8*)(cur + 32768 + ((wn * 4 + j) * 2 + s) * 1024 + l * 16);
#pragma unroll
      for (int i = 0; i < 4; ++i)
#pragma unroll
        for (int j = 0; j < 4; ++j) acc[i][j] = __builtin_amdgcn_mfma_f32_16x16x32_bf16(bfr[j], af[i], acc[i][j], 0, 0, 0);
    }
    if (more) {
      char* nxt = lds + ((kt + 1) & 1) * 49152;
#pragma unroll
      for (int j = 0; j < 4; ++j) *(u32x4*)(nxt + (w * 4 + j) * 1024 + l * 16) = ra[j];
#pragma unroll
      for (int j = 0; j < 2; ++j) *(u32x4*)(nxt + 32768 + (w * 2 + j) * 1024 + l * 16) = rb[j];
    }
    __syncthreads();
  }
  if (An) gemm_first_load(An, lda, Bn, ldb, ra, rb);
#pragma unroll
  for (int i = 0; i < 4; ++i) epi(trow + wm * 64 + i * 16 + lr, tcol + wn * 64 + lq * 16, acc[i]);
}

DEV void store16_bf16(bf16_t* dst, const f32x4 (&v)[4], float sc) {
  u32x4 a, b;
  a.x = pk2(v[0][0] * sc, v[0][1] * sc); a.y = pk2(v[0][2] * sc, v[0][3] * sc);
  a.z = pk2(v[1][0] * sc, v[1][1] * sc); a.w = pk2(v[1][2] * sc, v[1][3] * sc);
  b.x = pk2(v[2][0] * sc, v[2][1] * sc); b.y = pk2(v[2][2] * sc, v[2][3] * sc);
  b.z = pk2(v[3][0] * sc, v[3][1] * sc); b.w = pk2(v[3][2] * sc, v[3][3] * sc);
  *(u32x4*)dst = a;
  *(u32x4*)(dst + 8) = b;
}

struct EpiBf16 {
  bf16_t* O; int ldo;
  DEV void operator()(int row, int col, const f32x4 (&v)[4]) const { store16_bf16(O + (size_t)row * ldo + col, v, 1.f); }
};
struct EpiF32 {
  float* O; int ldo;
  DEV void operator()(int row, int col, const f32x4 (&v)[4]) const {
    float* d = O + (size_t)row * ldo + col;
#pragma unroll
    for (int j = 0; j < 4; ++j) *(f32x4*)(d + 4 * j) = v[j];
  }
};
struct EpiLora1 {
  bf16_t* O;
  DEV void operator()(int row, int col, const f32x4 (&v)[4]) const {
    f32x4 o[4];
#pragma unroll
    for (int j = 0; j < 4; ++j)
#pragma unroll
      for (int r = 0; r < 4; ++r) {
        const float t = v[j][r];
        o[j][r] = (col < 128) ? (1.f - 2.f * __builtin_amdgcn_rcpf(1.f + __expf(2.f * t))) : ((col < 256) ? t : sigmoidf_(t));
      }
    store16_bf16(O + (size_t)row * 384 + col, o, 1.f);
  }
};
struct EpiDecay {
  bf16_t* O; const float* w0;
  DEV void operator()(int row, int col, const f32x4 (&v)[4]) const {
    f32x4 o[4];
    float w0v[16];
#pragma unroll
    for (int i = 0; i < 16; i += 4) *(f32x4*)(w0v + i) = *(const f32x4*)(w0 + col + i);
#pragma unroll
    for (int j = 0; j < 4; ++j)
#pragma unroll
      for (int r = 0; r < 4; ++r) {
        const float xx = w0v[4 * j + r] + v[j][r];
        const float nx = -xx;
        const float sp = (nx > 20.f) ? nx : __logf(1.f + __expf(nx));
        const float e = __expf(-sp - 0.5f);
        o[j][r] = 1.f - __expf(-e);
      }
    store16_bf16(O + (size_t)row * 512 + col, o, 1.f);
  }
};
struct EpiA {
  bf16_t *KD, *KKA, *KK; const float *a0, *k_k, *k_a; const bf16_t* za; int writekk;
  DEV void operator()(int row, int col, const f32x4 (&v)[4]) const {
    const bf16_t* kp = za + (size_t)row * 2048 + 512 + col;
    const u32x4 k0 = *(const u32x4*)kp, k1 = *(const u32x4*)(kp + 8);
    float kf[16];
    kf[0] = lo16(k0.x); kf[1] = hi16(k0.x); kf[2] = lo16(k0.y); kf[3] = hi16(k0.y); kf[4] = lo16(k0.z); kf[5] = hi16(k0.z); kf[6] = lo16(k0.w); kf[7] = hi16(k0.w);
    kf[8] = lo16(k1.x); kf[9] = hi16(k1.x); kf[10] = lo16(k1.y); kf[11] = hi16(k1.y); kf[12] = lo16(k1.z); kf[13] = hi16(k1.z); kf[14] = lo16(k1.w); kf[15] = hi16(k1.w);
    float kkv[16], a0v[16], kav[16];
#pragma unroll
    for (int i = 0; i < 16; i += 4) { *(f32x4*)(kkv + i) = *(const f32x4*)(k_k + col + i); *(f32x4*)(a0v + i) = *(const f32x4*)(a0 + col + i); *(f32x4*)(kav + i) = *(const f32x4*)(k_a + col + i); }
    float kr[16], ss = 0.f;
#pragma unroll
    for (int i = 0; i < 16; ++i) { kr[i] = kf[i] * kkv[i]; ss += kr[i] * kr[i]; }
    ss += __shfl_xor(ss, 16);
    ss += __shfl_xor(ss, 32);
    const float rn = rsqrtf(ss + 1e-12f);
    f32x4 okd[4], okka[4], okk[4];
#pragma unroll
    for (int j = 0; j < 4; ++j)
#pragma unroll
      for (int r = 0; r < 4; ++r) {
        const int i = 4 * j + r;
        const float a = sigmoidf_(a0v[i] + v[j][r]);
        const float kk = kr[i] * rn;
        okd[j][r] = kf[i] * (1.f + (a - 1.f) * kav[i]);
        okka[j][r] = kk * a;
        okk[j][r] = kk;
      }
    store16_bf16(KD + (size_t)row * 512 + col, okd, 1.f);
    store16_bf16(KKA + (size_t)row * 512 + col, okka, 1.f);
    if (writekk) store16_bf16(KK + (size_t)row * 512 + col, okk, 1.f);
  }
};
struct EpiDftc {
  bf16_t* CST; int g;
  DEV void operator()(int row, int col, const f32x4 (&v)[4]) const {
    const int b = col >> 11, s = col & 2047;
    store16_bf16(CST + ((size_t)((b * 2 + (row >> 7)) * 1024 + g * 128 + (row & 127)) * 2048 + s), v, 1.f);
  }
};

DEV void transpose_convert(char* lds, const float* __restrict__ W, int K, int N, bf16_t* __restrict__ Wt, int ldt, int rot, int mode = 0) {
  float* tile = (float*)lds;
  const int tn_n = N >> 6, nt = (K >> 6) * tn_n, tid = tidx();
  const int r0 = tid >> 4, c4 = (tid & 15) * 4;
  int t = (blockIdx.x + rot) % gridDim.x;
  f32x4 ra, rb;
  if (t < nt) {
    const int tk = t / tn_n, tn = t % tn_n;
    const float* src = W + (size_t)(tk * 64 + r0) * N + tn * 64 + c4;
    ra = *(const f32x4*)src; rb = *(const f32x4*)(src + (size_t)32 * N);
  }
  for (; t < nt; t += gridDim.x) {
    const int tk = t / tn_n, tn = t % tn_n;
#pragma unroll
    for (int i = 0; i < 4; ++i) { tile[r0 * 65 + c4 + i] = ra[i]; tile[(r0 + 32) * 65 + c4 + i] = rb[i]; }
    __syncthreads();
    const int t2 = t + gridDim.x;
    if (t2 < nt) {
      const int tk2 = t2 / tn_n, tn2 = t2 % tn_n;
      const float* src = W + (size_t)(tk2 * 64 + r0) * N + tn2 * 64 + c4;
      ra = *(const f32x4*)src; rb = *(const f32x4*)(src + (size_t)32 * N);
    }
    int nbase = tn * 64;
    if (mode == 1) { const int c = tn * 64; nbase = (c < 2816) ? ((c >> 7) * 256 + (c & 127)) : (((c - 2816) >> 7) * 256 + 128 + ((c - 2816) & 127)); }
    const bool qk = (mode == 2) && (tn * 64 >= 2048) && (tn * 64 < 3072);
#pragma unroll
    for (int j = 0; j < 2; ++j) {
      const int ns = r0 + 32 * j;
      const int n = qk ? (2 * (ns & 31) + (ns >> 5)) : ns;
      u32x2 pk;
      pk.x = pk2(tile[(c4 + 0) * 65 + ns], tile[(c4 + 1) * 65 + ns]);
      pk.y = pk2(tile[(c4 + 2) * 65 + ns], tile[(c4 + 3) * 65 + ns]);
      *(u32x2*)(Wt + (size_t)(nbase + n) * ldt + tk * 64 + c4) = pk;
    }
    __syncthreads();
  }
}

DEV void compute_mod(char* lds, const P& p) {
  float* cs = (float*)lds;
  float* red = (float*)(lds + 32768);
  const int tid = tidx();
  float* mod = (float*)(p.ws + W_MOD);
  bool have = false;
  for (int item = blockIdx.x; item < 192; item += gridDim.x) {
    if (!have) {
      for (int i = tid; i < 8192; i += NTHR) { const float cv = p.c[i]; cs[i] = cv / (1.f + expf(-cv)); }
      __syncthreads();
      have = true;
    }
    const int l = item / 96, cb = item % 96, col = cb * 64 + (tid & 63), kg = tid >> 6;
    float a0 = 0, a1 = 0, a2 = 0, a3 = 0, a4 = 0, a5 = 0, a6 = 0, a7 = 0;
    const float* wp = p.ada_w + ((size_t)l * 1024 + kg * 128) * 6144 + col;
    for (int k = 0; k < 128; ++k) {
      const float wv = wp[(size_t)k * 6144];
      const int kk = kg * 128 + k;
      a0 += cs[kk] * wv; a1 += cs[1024 + kk] * wv; a2 += cs[2048 + kk] * wv; a3 += cs[3072 + kk] * wv;
      a4 += cs[4096 + kk] * wv; a5 += cs[5120 + kk] * wv; a6 += cs[6144 + kk] * wv; a7 += cs[7168 + kk] * wv;
    }
    float* rp = red + kg * 512 + (tid & 63);
    rp[0] = a0; rp[64] = a1; rp[128] = a2; rp[192] = a3; rp[256] = a4; rp[320] = a5; rp[384] = a6; rp[448] = a7;
    __syncthreads();
    {
      const int b = tid >> 6, cc = tid & 63;
      float s = 0.f;
#pragma unroll
      for (int g = 0; g < 8; ++g) s += red[g * 512 + b * 64 + cc];
      mod[(size_t)(l * 8 + b) * 6144 + cb * 64 + cc] = s + p.ada_b[l * 6144 + cb * 64 + cc];
    }
    __syncthreads();
  }
}

template <bool HAS_Y, bool HAS_H, bool XIN_BF = false, bool XOUT_BF = false>
DEV void rowpass(const void* __restrict__ xin_, const bf16_t* __restrict__ yf, const float* __restrict__ gy, const float* __restrict__ gate,
                 void* __restrict__ xout_, const float* __restrict__ gh, const float* __restrict__ sc, const float* __restrict__ sh,
                 bf16_t* __restrict__ h) {
  const float* xin = (const float*)xin_; const bf16_t* xinb = (const bf16_t*)xin_;
  float* xout = (float*)xout_; bf16_t* xoutb = (bf16_t*)xout_;
  const int lane = tidx() & 63, gw = blockIdx.x * 8 + (tidx() >> 6), nw = gridDim.x * 8;
  for (int row = gw; row < MT; row += nw) {
    const int b = row >> 12;
    f32x4 xv[4];
#pragma unroll
    for (int i = 0; i < 4; ++i) {
      if (XIN_BF) { const u32x2 xu = *(const u32x2*)(xinb + (size_t)row * 1024 + i * 256 + lane * 4); xv[i] = (f32x4){lo16(xu.x), hi16(xu.x), lo16(xu.y), hi16(xu.y)}; }
      else xv[i] = *(const f32x4*)(xin + (size_t)row * 1024 + i * 256 + lane * 4);
    }
    if (HAS_Y) {
      f32x4 yv[4];
      float ss = 0.f;
#pragma unroll
      for (int i = 0; i < 4; ++i) {
        const u32x2 yu = *(const u32x2*)(yf + (size_t)row * 1024 + i * 256 + lane * 4);
        yv[i] = (f32x4){lo16(yu.x), hi16(yu.x), lo16(yu.y), hi16(yu.y)};
        ss += yv[i][0] * yv[i][0] + yv[i][1] * yv[i][1] + yv[i][2] * yv[i][2] + yv[i][3] * yv[i][3];
      }
      ss = wave_sum(ss);
      const float rs = rsqrtf(ss * (1.f / 1024.f) + 1e-6f);
#pragma unroll
      for (int i = 0; i < 4; ++i) {
        const int col = i * 256 + lane * 4;
        const f32x4 g4 = *(const f32x4*)(gy + col), gt = *(const f32x4*)(gate + (size_t)b * 6144 + col);
        xv[i] = xv[i] + gt * (yv[i] * rs * g4);
        if (XOUT_BF) { u32x2 pk; pk.x = pk2(xv[i][0], xv[i][1]); pk.y = pk2(xv[i][2], xv[i][3]); *(u32x2*)(xoutb + (size_t)row * 1024 + col) = pk;
                       xv[i] = (f32x4){lo16(pk.x), hi16(pk.x), lo16(pk.y), hi16(pk.y)}; }
        else *(f32x4*)(xout + (size_t)row * 1024 + col) = xv[i];
      }
    }
    if (HAS_H) {
      float ss = 0.f;
#pragma unroll
      for (int i = 0; i < 4; ++i) ss += xv[i][0] * xv[i][0] + xv[i][1] * xv[i][1] + xv[i][2] * xv[i][2] + xv[i][3] * xv[i][3];
      ss = wave_sum(ss);
      const float rs = rsqrtf(ss * (1.f / 1024.f) + 1e-6f);
#pragma unroll
      for (int i = 0; i < 4; ++i) {
        const int col = i * 256 + lane * 4;
        const f32x4 g4 = *(const f32x4*)(gh + col), s4 = *(const f32x4*)(sc + (size_t)b * 6144 + col), h4 = *(const f32x4*)(sh + (size_t)b * 6144 + col);
        const f32x4 o = (xv[i] * rs * g4) * (s4 + 1.f) + h4;
        u32x2 pk;
        pk.x = pk2(o[0], o[1]); pk.y = pk2(o[2], o[3]);
        *(u32x2*)(h + (size_t)row * 1024 + col) = pk;
      }
    }
  }
}

DEV void row_xh(int row, bf16_t* __restrict__ xb, const bf16_t* __restrict__ yf, const float* __restrict__ gy, const float* __restrict__ gate,
                const float* __restrict__ gh, const float* __restrict__ sc, const float* __restrict__ sh, int lane, f32x4 (&hv)[4]) {
  const int b = row >> 12;
  f32x4 xv[4], yv[4];
  float ss = 0.f;
#pragma unroll
  for (int i = 0; i < 4; ++i) {
    const u32x2 xu = *(const u32x2*)(xb + (size_t)row * 1024 + i * 256 + lane * 4), yu = *(const u32x2*)(yf + (size_t)row * 1024 + i * 256 + lane * 4);
    xv[i] = (f32x4){lo16(xu.x), hi16(xu.x), lo16(xu.y), hi16(xu.y)};
    yv[i] = (f32x4){lo16(yu.x), hi16(yu.x), lo16(yu.y), hi16(yu.y)};
    ss += yv[i][0] * yv[i][0] + yv[i][1] * yv[i][1] + yv[i][2] * yv[i][2] + yv[i][3] * yv[i][3];
  }
  ss = wave_sum(ss);
  const float rs = rsqrtf(ss * (1.f / 1024.f) + 1e-6f);
  float s2 = 0.f;
#pragma unroll
  for (int i = 0; i < 4; ++i) {
    const int col = i * 256 + lane * 4;
    const f32x4 g4 = *(const f32x4*)(gy + col), gt = *(const f32x4*)(gate + (size_t)b * 6144 + col);
    const f32x4 xn = xv[i] + gt * (yv[i] * rs * g4);
    u32x2 pk; pk.x = pk2(xn[0], xn[1]); pk.y = pk2(xn[2], xn[3]);
    *(u32x2*)(xb + (size_t)row * 1024 + col) = pk;
    xv[i] = (f32x4){lo16(pk.x), hi16(pk.x), lo16(pk.y), hi16(pk.y)};
    s2 += xv[i][0] * xv[i][0] + xv[i][1] * xv[i][1] + xv[i][2] * xv[i][2] + xv[i][3] * xv[i][3];
  }
  s2 = wave_sum(s2);
  const float r2 = rsqrtf(s2 * (1.f / 1024.f) + 1e-6f);
#pragma unroll
  for (int i = 0; i < 4; ++i) {
    const int col = i * 256 + lane * 4;
    const f32x4 g4 = *(const f32x4*)(gh + col), s4 = *(const f32x4*)(sc + (size_t)b * 6144 + col), h4 = *(const f32x4*)(sh + (size_t)b * 6144 + col);
    hv[i] = (xv[i] * r2 * g4) * (s4 + 1.f) + h4;
  }
}
DEV void rowpass_fold(bf16_t* __restrict__ xb, const bf16_t* __restrict__ yf, const float* __restrict__ gy, const float* __restrict__ gate,
                      const float* __restrict__ gh, const float* __restrict__ sc, const float* __restrict__ sh, bf16_t* __restrict__ hfd, float* __restrict__ h2048) {
  const int lane = tidx() & 63, gw = blockIdx.x * 8 + (tidx() >> 6), nw = gridDim.x * 8;
  for (int item = gw; item < 8 * 2048; item += nw) {
    const int b = item >> 11, s = item & 2047;
    const int rowA = b * 4096 + s, rowB = b * 4096 + (s ? 4096 - s : 2048);
    f32x4 ha[4], hb[4];
    row_xh(rowA, xb, yf, gy, gate, gh, sc, sh, lane, ha);
    row_xh(rowB, xb, yf, gy, gate, gh, sc, sh, lane, hb);
#pragma unroll
    for (int i = 0; i < 4; ++i) {
      const int col = i * 256 + lane * 4, g = col >> 7, c = col & 127;
      f32x4 f = ha[i] + hb[i], dd = ha[i] - hb[i];
      if (s == 0) { f = ha[i]; dd = (f32x4){0.f, 0.f, 0.f, 0.f}; *(f32x4*)(h2048 + b * 1024 + col) = hb[i]; }
      bf16_t* dp = hfd + (size_t)(b * 2048 + s) * 2048 + g * 256 + c;
      u32x2 pk;
      pk.x = pk2(f[0], f[1]); pk.y = pk2(f[2], f[3]); *(u32x2*)dp = pk;
      pk.x = pk2(dd[0], dd[1]); pk.y = pk2(dd[2], dd[3]); *(u32x2*)(dp + 128) = pk;
    }
  }
}

DEV void unpack8(const u32x4 u, float (&f)[8]) {
  f[0] = lo16(u.x); f[1] = hi16(u.x); f[2] = lo16(u.y); f[3] = hi16(u.y); f[4] = lo16(u.z); f[5] = hi16(u.z); f[6] = lo16(u.w); f[7] = hi16(u.w);
}
DEV u32x4 pack8(const float (&f)[8]) {
  u32x4 u;
  u.x = pk2(f[0], f[1]); u.y = pk2(f[2], f[3]); u.z = pk2(f[4], f[5]); u.w = pk2(f[6], f[7]);
  return u;
}

DEV void prep1(const P& p) {
  const bf16_t* z = (const bf16_t*)(p.ws + O_Z);
  bf16_t* za = (bf16_t*)p.out;
  bf16_t* qr = (bf16_t*)(p.ws + O_QR);
  bf16_t* kr = (bf16_t*)(p.ws + O_KR);
  bf16_t* vt = (bf16_t*)(p.ws + O_VT);
  const float* rope = (const float*)(p.ws + W_ROPE);
  const int gt = blockIdx.x * NTHR + tidx(), ngt = gridDim.x * NTHR;
  for (int idx = gt; idx < MT * 256; idx += ngt) {
    const int tok = idx >> 8, c8 = (idx & 255) * 8, s = tok & 4095;
    const bf16_t* zp = z + (size_t)tok * INC + c8;
    float zc[8], zm[8], zn[8], o[8];
    unpack8(*(const u32x4*)zp, zc);
    if (s > 0) unpack8(*(const u32x4*)(zp - INC), zm); else { for (int i = 0; i < 8; ++i) zm[i] = 0.f; }
    if (s < 4095) unpack8(*(const u32x4*)(zp + INC), zn); else { for (int i = 0; i < 8; ++i) zn[i] = 0.f; }
    float w0[8], w1[8], w2[8];
    *(f32x4*)w0 = *(const f32x4*)(p.mix_conv + c8); *(f32x4*)(w0 + 4) = *(const f32x4*)(p.mix_conv + c8 + 4);
    *(f32x4*)w1 = *(const f32x4*)(p.mix_conv + 2048 + c8); *(f32x4*)(w1 + 4) = *(const f32x4*)(p.mix_conv + 2048 + c8 + 4);
    *(f32x4*)w2 = *(const f32x4*)(p.mix_conv + 4096 + c8); *(f32x4*)(w2 + 4) = *(const f32x4*)(p.mix_conv + 4096 + c8 + 4);
#pragma unroll
    for (int i = 0; i < 8; ++i) o[i] = zm[i] * w0[i] + zc[i] * w1[i] + zn[i] * w2[i];
    *(u32x4*)(za + (size_t)tok * 2048 + c8) = pack8(o);
  }
  for (int idx = gt; idx < MT * 64; idx += ngt) {
    const int e8 = idx & 3, which = (idx >> 2) & 1, h = (idx >> 3) & 7, tok = idx >> 6, s = tok & 4095;
    const bf16_t* src = z + (size_t)tok * INC + 2048 + which * 512 + h * 64 + e8 * 8;
    float x1[8], x2[8], o1[8], o2[8];
    unpack8(*(const u32x4*)src, x1);
    unpack8(*(const u32x4*)(src + 32), x2);
    const float* rp = rope + ((size_t)s * 32 + e8 * 8) * 2;
    const float scl = which ? 1.f : 0.125f;
#pragma unroll
    for (int i = 0; i < 8; ++i) {
      const float cv = rp[2 * i], sv = rp[2 * i + 1];
      o1[i] = (x1[i] * cv - x2[i] * sv) * scl;
      o2[i] = (x2[i] * cv + x1[i] * sv) * scl;
    }
    bf16_t* dst = (which ? kr : qr) + (size_t)tok * 512 + h * 64 + e8 * 8;
    *(u32x4*)dst = pack8(o1);
    *(u32x4*)(dst + 32) = pack8(o2);
  }
  {
    bf16_t* vr = (bf16_t*)(p.ws + O_VT);
    for (int idx = gt; idx < MT * 64; idx += ngt) {
      const int tok = idx >> 6, c8 = (idx & 63) * 8;
      *(u32x4*)(vr + (size_t)tok * 512 + c8) = *(const u32x4*)(z + (size_t)tok * INC + 3072 + c8);
    }
  }
}

DEV void za_fixup(const P& p) {
  const bf16_t* sb = (const bf16_t*)(p.ws + O_SBZ);
  bf16_t* za = (bf16_t*)p.out;
  const int gt = blockIdx.x * NTHR + tidx(), ngt = gridDim.x * NTHR;
  for (int item = gt; item < 512 * 2 * 256; item += ngt) {
    const int strip = item >> 9, e = (item >> 8) & 1, c8 = (item & 255) * 8;
    const int R = strip * 64 + (e ? 63 : 0), s = R & 4095;
    const bf16_t* pc = sb + ((size_t)strip * 4 + (e ? 3 : 0)) * 2048 + c8;
    const u32x4 z0 = (u32x4){0u, 0u, 0u, 0u};
    const bool hasp = e ? true : (s > 0), hasn = e ? (s < 4095) : true;
    float zm[8], zc[8], zn[8], o[8], w0[8], w1[8], w2[8];
    unpack8(hasp ? *(const u32x4*)(pc - 2048) : z0, zm);
    unpack8(*(const u32x4*)pc, zc);
    unpack8(hasn ? *(const u32x4*)(pc + 2048) : z0, zn);
    *(f32x4*)w0 = *(const f32x4*)(p.mix_conv + c8); *(f32x4*)(w0 + 4) = *(const f32x4*)(p.mix_conv + c8 + 4);
    *(f32x4*)w1 = *(const f32x4*)(p.mix_conv + 2048 + c8); *(f32x4*)(w1 + 4) = *(const f32x4*)(p.mix_conv + 2048 + c8 + 4);
    *(f32x4*)w2 = *(const f32x4*)(p.mix_conv + 4096 + c8); *(f32x4*)(w2 + 4) = *(const f32x4*)(p.mix_conv + 4096 + c8 + 4);
#pragma unroll
    for (int i = 0; i < 8; ++i) o[i] = zm[i] * w0[i] + zc[i] * w1[i] + zn[i] * w2[i];
    *(u32x4*)(za + (size_t)R * 2048 + c8) = pack8(o);
  }
}

DEV void attention(char* lds, const P& p) {
  const bf16_t* qr = (const bf16_t*)(p.ws + O_QR);
  const bf16_t* kr = (const bf16_t*)(p.ws + O_KR);
  const bf16_t* vt = (const bf16_t*)(p.ws + O_VT);
  bf16_t* num = (bf16_t*)(p.ws + O_NUM);
  float* md = (float*)(p.ws + O_MD);
  constexpr int UNIT_LDS = 24576 + 64 * 400;
  const int tid = tidx(), w = tid >> 6, lane = tid & 63, lr = lane & 15, lq = lane >> 4;
  const int uh = tid >> 8, lt = tid & 255, mt = w & 3;
  char* ul = lds + uh * UNIT_LDS;
  u32x4 pre[12];
  bf16x8 qn[2];
  auto load_pair = [&](int pi) {
    const int unit = pi * 2 + uh;
    const int nb = unit & 63, h = (unit >> 6) & 7, b = (unit >> 9) & 7, br = unit >> 12;
    const int dsh = 2 * br, Mr = 4096 >> dsh;
    const int seg = (nb * 64) / Mr, segstart = seg * Mr, segend = segstart + Mr;
    const bool pv_ok = (nb * 64 - 64 >= segstart), nx_ok = (nb * 64 + 128 <= segend);
#pragma unroll
    for (int j = 0; j < 6; ++j) {
      const int pc = lt + 256 * j, key = pc >> 3, ch = pc & 7, kb = key >> 6;
      int blk = nb + kb - 1;
      if ((kb == 0 && !pv_ok) || (kb == 2 && !nx_ok)) blk = nb;
      const int kp = blk * 64 + (key & 63);
      const int ktok = b * 4096 + (((kp - segstart) << dsh) + seg);
      pre[j] = *(const u32x4*)(kr + (size_t)ktok * 512 + h * 64 + ch * 8);
      pre[6 + j] = *(const u32x4*)(vt + (size_t)ktok * 512 + h * 64 + ch * 8);
    }
    {
      const int qp = nb * 64 + mt * 16 + lr;
      const int qtok = b * 4096 + (((qp - segstart) << dsh) + seg);
      qn[0] = *(const bf16x8*)(qr + (size_t)qtok * 512 + h * 64 + lq * 8);
      qn[1] = *(const bf16x8*)(qr + (size_t)qtok * 512 + h * 64 + 32 + lq * 8);
    }
  };
  const int npairs = 3 * 4096 / 2;
  int pi = blockIdx.x;
  if (pi < npairs) load_pair(pi);
  for (; pi < npairs; pi += gridDim.x) {
#pragma unroll
    for (int j = 0; j < 6; ++j) {
      const int pc = lt + 256 * j, key = pc >> 3, ch = pc & 7;
      *(u32x4*)(ul + key * 128 + ((ch ^ (key & 7)) * 16)) = pre[j];
    }
#pragma unroll
    for (int j = 0; j < 6; ++j) {
      const int pc = lt + 256 * j, key = pc >> 3, ch = pc & 7;
      bf16_t* vd = (bf16_t*)(ul + 24576 + (ch * 8) * 400) + (key ^ (ch << 2));
      const u32x4 u = pre[6 + j];
      vd[0 * 200] = (bf16_t)(u.x & 0xffff); vd[1 * 200] = (bf16_t)(u.x >> 16); vd[2 * 200] = (bf16_t)(u.y & 0xffff); vd[3 * 200] = (bf16_t)(u.y >> 16);
      vd[4 * 200] = (bf16_t)(u.z & 0xffff); vd[5 * 200] = (bf16_t)(u.z >> 16); vd[6 * 200] = (bf16_t)(u.w & 0xffff); vd[7 * 200] = (bf16_t)(u.w >> 16);
    }
    __syncthreads();
    const int unit = pi * 2 + uh;
    const int nb = unit & 63, h = (unit >> 6) & 7, b = (unit >> 9) & 7, br = unit >> 12;
    const int dsh = 2 * br, Mr = 4096 >> dsh;
    const int seg = (nb * 64) / Mr, segstart = seg * Mr, segend = segstart + Mr;
    const bool pv_ok = (nb * 64 - 64 >= segstart), nx_ok = (nb * 64 + 128 <= segend);
    const int qp = nb * 64 + mt * 16 + lr;
    const int qtok = b * 4096 + (((qp - segstart) << dsh) + seg);
    bf16x8 qf[2];
    qf[0] = qn[0]; qf[1] = qn[1];
    if (pi + (int)gridDim.x < npairs) load_pair(pi + gridDim.x);
    f32x4 sacc[12];
#pragma unroll
    for (int kt = 0; kt < 12; ++kt) {
      const int key = kt * 16 + lr;
      const bf16x8 k0 = *(const bf16x8*)(ul + key * 128 + ((lq ^ (key & 7)) * 16));
      const bf16x8 k1 = *(const bf16x8*)(ul + key * 128 + (((4 + lq) ^ (key & 7)) * 16));
      f32x4 a = (f32x4){0.f, 0.f, 0.f, 0.f};
      a = __builtin_amdgcn_mfma_f32_16x16x32_bf16(k0, qf[0], a, 0, 0, 0);
      a = __builtin_amdgcn_mfma_f32_16x16x32_bf16(k1, qf[1], a, 0, 0, 0);
      sacc[kt] = a;
    }
    const int qi = mt * 16 + lr;
    float mx = -1e30f;
#pragma unroll
    for (int kt = 0; kt < 12; ++kt) {
      const int kb = kt >> 2;
#pragma unroll
      for (int r = 0; r < 4; ++r) {
        const int kj = (kt & 3) * 16 + lq * 4 + r;
        bool ok = true;
        if (kb == 0) ok = pv_ok && (kj >= qi);
        if (kb == 2) ok = nx_ok && (kj <= qi);
        const float sv = ok ? sacc[kt][r] : -1e30f;
        sacc[kt][r] = sv;
        mx = fmaxf(mx, sv);
      }
    }
    mx = fmaxf(mx, __shfl_xor(mx, 16));
    mx = fmaxf(mx, __shfl_xor(mx, 32));
    float den = 0.f;
#pragma unroll
    for (int kt = 0; kt < 12; ++kt)
#pragma unroll
      for (int r = 0; r < 4; ++r) {
        const float pe = __expf(sacc[kt][r] - mx);
        sacc[kt][r] = pe;
        den += pe;
      }
    den += __shfl_xor(den, 16);
    den += __shfl_xor(den, 32);
    f32x4 oacc[4];
#pragma unroll
    for (int et = 0; et < 4; ++et) oacc[et] = (f32x4){0.f, 0.f, 0.f, 0.f};
#pragma unroll
    for (int t = 0; t < 6; ++t) {
      u32x4 pu;
      pu.x = pk2(sacc[2 * t][0], sacc[2 * t][1]); pu.y = pk2(sacc[2 * t][2], sacc[2 * t][3]);
      pu.z = pk2(sacc[2 * t + 1][0], sacc[2 * t + 1][1]); pu.w = pk2(sacc[2 * t + 1][2], sacc[2 * t + 1][3]);
      const bf16x8 pf = __builtin_bit_cast(bf16x8, pu);
#pragma unroll
      for (int et = 0; et < 4; ++et) {
        const char* vrow = ul + 24576 + (et * 16 + lr) * 400;
        const int sw = ((et * 2 + (lr >> 3)) & 7) << 2;
        const u32x2 v0 = *(const u32x2*)(vrow + (((2 * t) * 16 + lq * 4) ^ sw) * 2), v1 = *(const u32x2*)(vrow + (((2 * t + 1) * 16 + lq * 4) ^ sw) * 2);
        u32x4 vu;
        vu.x = v0.x; vu.y = v0.y; vu.z = v1.x; vu.w = v1.y;
        oacc[et] = __builtin_amdgcn_mfma_f32_16x16x32_bf16(__builtin_bit_cast(bf16x8, vu), pf, oacc[et], 0, 0, 0);
      }
    }
    bf16_t* np = num + ((size_t)br * MT + qtok) * 512 + h * 64 + lq * 4;
#pragma unroll
    for (int et = 0; et < 4; ++et) { u32x2 w; w.x = pk2(oacc[et][0], oacc[et][1]); w.y = pk2(oacc[et][2], oacc[et][3]); *(u32x2*)(np + et * 16) = w; }
    if (lq == 0) {
      f32x2 o;
      o.x = mx; o.y = den;
      *(f32x2*)(md + (((size_t)br * MT + qtok) * 8 + h) * 2) = o;
    }
    __syncthreads();
  }
}

DEV void combineA(const P& p) {
  const bf16_t* num = (const bf16_t*)(p.ws + O_NUM);
  const float* md = (const float*)(p.ws + O_MD);
  bf16_t* ycat = (bf16_t*)(p.ws + O_YCAT);
  const int gt = blockIdx.x * NTHR + tidx(), ngt = gridDim.x * NTHR;
  for (int idx = gt; idx < MT * 128; idx += ngt) {
    const int e4 = idx & 15, h = (idx >> 4) & 7, tok = idx >> 7;
    f32x2 m0 = *(const f32x2*)(md + (((size_t)0 * MT + tok) * 8 + h) * 2);
    f32x2 m1 = *(const f32x2*)(md + (((size_t)1 * MT + tok) * 8 + h) * 2);
    f32x2 m2 = *(const f32x2*)(md + (((size_t)2 * MT + tok) * 8 + h) * 2);
    const float ma = fmaxf(m0.x, fmaxf(m1.x, m2.x));
    const float e0 = __expf(m0.x - ma), e1 = __expf(m1.x - ma), e2 = __expf(m2.x - ma);
    const float dn = e0 * m0.y + e1 * m1.y + e2 * m2.y;
    const u32x2 u0 = *(const u32x2*)(num + ((size_t)0 * MT + tok) * 512 + h * 64 + e4 * 4);
    const u32x2 u1 = *(const u32x2*)(num + ((size_t)1 * MT + tok) * 512 + h * 64 + e4 * 4);
    const u32x2 u2 = *(const u32x2*)(num + ((size_t)2 * MT + tok) * 512 + h * 64 + e4 * 4);
    const f32x4 n0 = (f32x4){lo16(u0.x), hi16(u0.x), lo16(u0.y), hi16(u0.y)}, n1 = (f32x4){lo16(u1.x), hi16(u1.x), lo16(u1.y), hi16(u1.y)},
                n2 = (f32x4){lo16(u2.x), hi16(u2.x), lo16(u2.y), hi16(u2.y)};
    const f32x4 o = (n0 * e0 + n1 * e1 + n2 * e2) * (1.f / dn);
    u32x2 pk;
    pk.x = pk2(o[0], o[1]); pk.y = pk2(o[2], o[3]);
    *(u32x2*)(ycat + (size_t)tok * 1024 + 512 + h * 64 + e4 * 4) = pk;
  }
}

DEV float dpp_allreduce16(float x) {
  x += __int_as_float(__builtin_amdgcn_update_dpp(0, __float_as_int(x), 0xB1, 0xF, 0xF, true));
  x += __int_as_float(__builtin_amdgcn_update_dpp(0, __float_as_int(x), 0x4E, 0xF, 0xF, true));
  x += __int_as_float(__builtin_amdgcn_update_dpp(0, __float_as_int(x), 0x141, 0xF, 0xF, true));
  x += __int_as_float(__builtin_amdgcn_update_dpp(0, __float_as_int(x), 0x140, 0xF, 0xF, true));
  return x;
}

DEV void scan_phase(char* lds, const P& p) {
  const bf16_t* omw = (const bf16_t*)(p.ws + O_OMW);
  const bf16_t* kd = (const bf16_t*)(p.ws + O_KD);
  const bf16_t* kka = (const bf16_t*)(p.ws + O_KKA);
  const bf16_t* kk = (const bf16_t*)(p.ws + O_KK);
  const bf16_t* za = (const bf16_t*)p.out;
  bf16_t* Y = (bf16_t*)(p.ws + O_Y);
  float* inb = (float*)lds;
  float* ypart = (float*)(lds + 98304);
  const int tid = tidx(), w = tid >> 6, lane = tid & 63, rg = lane >> 4, jl = lane & 15, j0 = jl * 4;
  for (int it = blockIdx.x; it < 256; it += gridDim.x) {
    const int sc = it >> 1, half = it & 1, d = sc >> 6, b = (sc >> 3) & 7, h = sc & 7;
    if (w >= 4) {
      const int lt = tid - 256;
      const bf16_t* src[6];
      int dsto[6], stepi[6], isw[6];
#pragma unroll
      for (int q = 0; q < 6; ++q) {
        const int pid = lt + q * 256, i = pid / 48, rem = pid % 48, arr = rem >> 3, pc = rem & 7;
        const bf16_t* base;
        size_t ld;
        if (arr == 0) { base = omw + (size_t)d * MT * 512 + h * 64; ld = 512; }
        else if (arr == 1) { base = kd + (size_t)d * MT * 512 + h * 64; ld = 512; }
        else if (arr == 2) { base = kka + (size_t)d * MT * 512 + h * 64; ld = 512; }
        else if (arr == 3) { base = kk + h * 64; ld = 512; }
        else if (arr == 4) { base = za + h * 64; ld = 2048; }
        else { base = za + 1024 + h * 64; ld = 2048; }
        const int t0 = d ? (4095 - i) : i;
        src[q] = base + ((size_t)(b * 4096 + t0)) * ld + pc * 8;
        stepi[q] = (int)ld * 32 * (d ? -1 : 1);
        dsto[q] = i * 384 + arr * 64 + pc * 8;
        isw[q] = (arr == 0);
      }
      u32x4 rr[6];
#pragma unroll
      for (int q = 0; q < 6; ++q) rr[q] = *(const u32x4*)(src[q]);
#pragma unroll
      for (int q = 0; q < 6; ++q) {
        float f[8];
        unpack8(rr[q], f);
        if (isw[q]) { for (int i = 0; i < 8; ++i) f[i] = 1.f - f[i]; }
        *(f32x4*)(inb + dsto[q]) = (f32x4){f[0], f[1], f[2], f[3]};
        *(f32x4*)(inb + dsto[q] + 4) = (f32x4){f[4], f[5], f[6], f[7]};
      }
#pragma unroll
      for (int q = 0; q < 6; ++q) rr[q] = *(const u32x4*)(src[q] + (ptrdiff_t)stepi[q]);
      __syncthreads();
      for (int c = 0; c < 128; ++c) {
        if (c + 1 < 128) {
          float* nb_ = inb + ((c + 1) & 1) * 12288;
#pragma unroll
          for (int q = 0; q < 6; ++q) {
            float f[8];
            unpack8(rr[q], f);
            if (isw[q]) { for (int i = 0; i < 8; ++i) f[i] = 1.f - f[i]; }
            *(f32x4*)(nb_ + dsto[q]) = (f32x4){f[0], f[1], f[2], f[3]};
            *(f32x4*)(nb_ + dsto[q] + 4) = (f32x4){f[4], f[5], f[6], f[7]};
          }
        }
        if (c + 2 < 128) {
#pragma unroll
          for (int q = 0; q < 6; ++q) rr[q] = *(const u32x4*)(src[q] + (ptrdiff_t)stepi[q] * (c + 2));
        }
        if (c > 0) {
          const int cc = c - 1, idx = lt * 4, i = idx >> 5, rl = idx & 31;
          const int t = d ? (4095 - (cc * 32 + i)) : (cc * 32 + i);
          const float* q = ypart + (cc & 1) * 4096 + i * 128 + rl;
          const f32x4 o = (*(const f32x4*)q + *(const f32x4*)(q + 32)) + (*(const f32x4*)(q + 64) + *(const f32x4*)(q + 96));
          u32x2 ow; ow.x = pk2(o[0], o[1]); ow.y = pk2(o[2], o[3]);
          *(u32x2*)(Y + ((size_t)d * MT + b * 4096 + t) * 512 + h * 64 + half * 32 + rl) = ow;
        }
        __syncthreads();
      }
      {
        const int cc = 127, idx = lt * 4, i = idx >> 5, rl = idx & 31;
        const int t = d ? (4095 - (cc * 32 + i)) : (cc * 32 + i);
        const float* q = ypart + (cc & 1) * 4096 + i * 128 + rl;
        const f32x4 o = (*(const f32x4*)q + *(const f32x4*)(q + 32)) + (*(const f32x4*)(q + 64) + *(const f32x4*)(q + 96));
        u32x2 ow; ow.x = pk2(o[0], o[1]); ow.y = pk2(o[2], o[3]);
        *(u32x2*)(Y + ((size_t)d * MT + b * 4096 + t) * 512 + h * 64 + half * 32 + rl) = ow;
      }
    } else {
      const int rowl = w * 8 + rg * 2, row = half * 32 + rowl;
      f32x2 a01 = (f32x2){0.f, 0.f}, a23 = a01, b01 = a01, b23 = a01;
      __syncthreads();
      for (int c = 0; c < 128; ++c) {
        const float* cur = inb + (c & 1) * 12288;
        float* yp = ypart + (c & 1) * 4096 + (jl >> 2) * 32 + rowl;
        f32x4 w4 = *(const f32x4*)(cur + j0), kd4 = *(const f32x4*)(cur + 64 + j0), ka4 = *(const f32x4*)(cur + 128 + j0),
              kk4 = *(const f32x4*)(cur + 192 + j0), r4 = *(const f32x4*)(cur + 256 + j0);
        f32x2 v2 = *(const f32x2*)(cur + 320 + row);
#pragma unroll 8
        for (int i = 0; i < 32; ++i) {
          const float* sn = cur + ((i + 1) & 31) * 384;
          const f32x4 nw4 = *(const f32x4*)(sn + j0), nkd4 = *(const f32x4*)(sn + 64 + j0), nka4 = *(const f32x4*)(sn + 128 + j0),
                      nkk4 = *(const f32x4*)(sn + 192 + j0), nr4 = *(const f32x4*)(sn + 256 + j0);
          const f32x2 nv2 = *(const f32x2*)(sn + 320 + row);
          const f32x2 ta = a01 * kk4.xy + a23 * kk4.zw, tb = b01 * kk4.xy + b23 * kk4.zw;
          const float ska = dpp_allreduce16(ta.x + ta.y), skb = dpp_allreduce16(tb.x + tb.y);
          a01 = a01 * w4.xy + (kd4.xy * v2.x - ka4.xy * ska);
          a23 = a23 * w4.zw + (kd4.zw * v2.x - ka4.zw * ska);
          b01 = b01 * w4.xy + (kd4.xy * v2.y - ka4.xy * skb);
          b23 = b23 * w4.zw + (kd4.zw * v2.y - ka4.zw * skb);
          const f32x2 ua = a01 * r4.xy + a23 * r4.zw, ub = b01 * r4.xy + b23 * r4.zw;
          f32x2 y;
          y.x = ua.x + ua.y; y.y = ub.x + ub.y;
          y.x += __int_as_float(__builtin_amdgcn_update_dpp(0, __float_as_int(y.x), 0xB1, 0xF, 0xF, true));
          y.y += __int_as_float(__builtin_amdgcn_update_dpp(0, __float_as_int(y.y), 0xB1, 0xF, 0xF, true));
          y.x += __int_as_float(__builtin_amdgcn_update_dpp(0, __float_as_int(y.x), 0x4E, 0xF, 0xF, true));
          y.y += __int_as_float(__builtin_amdgcn_update_dpp(0, __float_as_int(y.y), 0x4E, 0xF, 0xF, true));
          *(f32x2*)(yp + i * 128) = y;
          w4 = nw4; kd4 = nkd4; ka4 = nka4; kk4 = nkk4; r4 = nr4; v2 = nv2;
        }
        __syncthreads();
      }
    }
    __syncthreads();
  }
}

DEV void postB(const P& p) {
  const bf16_t* Y = (const bf16_t*)(p.ws + O_Y);
  const bf16_t* kd = (const bf16_t*)(p.ws + O_KD);
  const bf16_t* gg = (const bf16_t*)(p.ws + O_G);
  const bf16_t* za = (const bf16_t*)p.out;
  bf16_t* ycat = (bf16_t*)(p.ws + O_YCAT);
  const int lane = tidx() & 63, sub = lane >> 4, jl = lane & 15, gw = blockIdx.x * 8 + (tidx() >> 6), nw = gridDim.x * 8;
  for (int it = gw; it < MT * 2; it += nw) {
    const int item = it * 4 + sub, tok = item >> 3, h = item & 7, c = h * 64 + jl * 4;
    const u32x2 yu0 = *(const u32x2*)(Y + (size_t)tok * 512 + c), yu1 = *(const u32x2*)(Y + ((size_t)MT + tok) * 512 + c);
    const f32x4 y0 = (f32x4){lo16(yu0.x), hi16(yu0.x), lo16(yu0.y), hi16(yu0.y)}, y1 = (f32x4){lo16(yu1.x), hi16(yu1.x), lo16(yu1.y), hi16(yu1.y)};
    const u32x2 k0 = *(const u32x2*)(kd + (size_t)tok * 512 + c), k1 = *(const u32x2*)(kd + ((size_t)MT + tok) * 512 + c);
    const u32x2 ru = *(const u32x2*)(za + (size_t)tok * 2048 + c), vu = *(const u32x2*)(za + (size_t)tok * 2048 + 1024 + c), gu = *(const u32x2*)(gg + (size_t)tok * 512 + c);
    const f32x4 lw = *(const f32x4*)(p.lnx_w + c), lb = *(const f32x4*)(p.lnx_b + c), rk = *(const f32x4*)(p.r_k + c);
    const f32x4 y = y0 + y1;
    const float mu = dpp_allreduce16((y[0] + y[1]) + (y[2] + y[3])) * (1.f / 64.f);
    const f32x4 dv = y - mu;
    const float var = dpp_allreduce16((dv[0] * dv[0] + dv[1] * dv[1]) + (dv[2] * dv[2] + dv[3] * dv[3])) * (1.f / 64.f);
    const float rs = rsqrtf(var + 64e-5f);
    const f32x4 r = (f32x4){lo16(ru.x), hi16(ru.x), lo16(ru.y), hi16(ru.y)}, v = (f32x4){lo16(vu.x), hi16(vu.x), lo16(vu.y), hi16(vu.y)};
    const f32x4 g = (f32x4){lo16(gu.x), hi16(gu.x), lo16(gu.y), hi16(gu.y)};
    const f32x4 kds = (f32x4){lo16(k0.x) + lo16(k1.x), hi16(k0.x) + hi16(k1.x), lo16(k0.y) + lo16(k1.y), hi16(k0.y) + hi16(k1.y)};
    const f32x4 t = r * kds * rk;
    const float bs = dpp_allreduce16((t[0] + t[1]) + (t[2] + t[3]));
    const f32x4 o = (dv * rs * lw + lb + v * bs) * g;
    u32x2 pk;
    pk.x = pk2(o[0], o[1]); pk.y = pk2(o[2], o[3]);
    *(u32x2*)(ycat + (size_t)tok * 1024 + c) = pk;
  }
}

DEV void glu_fixup(const P& p, int l) {
  const bf16_t* sb = (const bf16_t*)(p.ws + O_SB);
  bf16_t* act = (bf16_t*)(p.ws + O_ACT);
  const float* cw = p.ffn_conv + (size_t)l * 3 * 5632;
  const int gt = blockIdx.x * NTHR + tidx(), ngt = gridDim.x * NTHR;
  for (int item = gt; item < 512 * 2 * 352; item += ngt) {
    const int strip = item / 704, rem = item - strip * 704, e = rem / 352, c8 = (rem - e * 352) * 8;
    const int R = strip * 64 + (e ? 63 : 0), s = R & 4095;
    const int colg = (c8 >> 7) * 256 + (c8 & 127);
    const bf16_t* pc = sb + ((size_t)strip * 4 + (e ? 3 : 0)) * 5632 + colg;
    const bf16_t* pp = e ? (pc - 5632) : (pc - 5632);
    const bf16_t* pn = e ? (pc + 5632) : (pc + 5632);
    const u32x4 z0 = (u32x4){0u, 0u, 0u, 0u};
    const bool hasp = e ? true : (s > 0), hasn = e ? (s < 4095) : true;
    float gm[8], gc[8], gn[8], vm[8], vc[8], vn[8], o[8];
    unpack8(hasp ? *(const u32x4*)pp : z0, gm); unpack8(hasp ? *(const u32x4*)(pp + 128) : z0, vm);
    unpack8(*(const u32x4*)pc, gc); unpack8(*(const u32x4*)(pc + 128), vc);
    unpack8(hasn ? *(const u32x4*)pn : z0, gn); unpack8(hasn ? *(const u32x4*)(pn + 128) : z0, vn);
#pragma unroll
    for (int i = 0; i < 8; ++i) {
      const float g = gm[i] * cw[c8 + i] + gc[i] * cw[5632 + c8 + i] + gn[i] * cw[11264 + c8 + i];
      const float vv = vm[i] * cw[2816 + c8 + i] + vc[i] * cw[5632 + 2816 + c8 + i] + vn[i] * cw[11264 + 2816 + c8 + i];
      const float u2 = -1.5957691216057308f * (g + 0.044715f * g * g * g);
      o[i] = g * __builtin_amdgcn_rcpf(1.f + __expf(u2)) * vv;
    }
    *(u32x4*)(act + (size_t)R * 2816 + c8) = pack8(o);
  }
}

template <class Epi>
DEV void gemm_grid(char* lds, const bf16_t* A, int lda, const bf16_t* Bt, int ldb, int K, int tilesM, int tilesN, const Epi& epi) {
  const int nt = tilesM * tilesN;
  u32x4 ra[4], rb[2];
  int t = blockIdx.x;
  if (t < nt) gemm_first_load(A + (size_t)(t / tilesN) * 256 * lda, lda, Bt + (size_t)(t % tilesN) * 128 * ldb, ldb, ra, rb);
  for (; t < nt; t += gridDim.x) {
    const int tm = t / tilesN, tn = t % tilesN, t2 = t + gridDim.x;
    const bf16_t* An = (t2 < nt) ? A + (size_t)(t2 / tilesN) * 256 * lda : nullptr;
    const bf16_t* Bn = (t2 < nt) ? Bt + (size_t)(t2 % tilesN) * 128 * ldb : nullptr;
    gemm_tile(lds, A + (size_t)tm * 256 * lda, lda, Bt + (size_t)tn * 128 * ldb, ldb, K, tm * 256, tn * 128, epi, ra, rb, An, Bn);
  }
}


DEV void dft_fold(const P& p) {
  const bf16_t* CST = (const bf16_t*)(p.ws + O_CST);
  bf16_t* CF = (bf16_t*)(p.ws + O_CSTF);
  for (int idx = blockIdx.x * NTHR + tidx(); idx < 16384 * 256; idx += gridDim.x * NTHR) {
    const int r = idx >> 8, s8 = (idx & 255) * 8, eo = (r >> 10) & 1;
    const bf16_t* src = CST + (size_t)r * 4096;
    float a[8], bq[8], o[8];
    unpack8(*(const u32x4*)(src + s8), a);
    if (s8 == 0) {
      unpack8(*(const u32x4*)(src + 4088), bq);
      o[0] = eo ? 0.f : a[0];
#pragma unroll
      for (int i = 1; i < 8; ++i) o[i] = eo ? (a[i] - bq[8 - i]) : (a[i] + bq[8 - i]);
      if (!eo) ((float*)(p.ws + O_C2048))[(r >> 11) * 1024 + (r & 1023)] = bf2f(src[2048]) * (1.f / 64.f);
    } else {
      unpack8(*(const u32x4*)(src + 4096 - s8 - 8), bq);
      const float b0 = bf2f(src[4096 - s8]);
      o[0] = eo ? (a[0] - b0) : (a[0] + b0);
#pragma unroll
      for (int i = 1; i < 8; ++i) o[i] = eo ? (a[i] - bq[8 - i]) : (a[i] + bq[8 - i]);
    }
    *(u32x4*)(CF + (size_t)r * 2048 + s8) = pack8(o);
  }
}

DEV void dft_combine(const P& p) {
  const bf16_t* EO = (const bf16_t*)(p.ws + O_EO);
  const bf16_t* CST = (const bf16_t*)(p.ws + O_CST);
  bf16_t* f = (bf16_t*)(p.ws + O_F);
  for (int idx = blockIdx.x * NTHR + tidx(); idx < 8 * 2048 * 256; idx += gridDim.x * NTHR) {
    const int c4 = (idx & 255) * 4, k1 = (idx >> 8) & 2047, b = idx >> 19;
    const u32x2 eu = *(const u32x2*)(EO + ((size_t)(b * 2) * 2048 + k1) * 1024 + c4), ou = *(const u32x2*)(EO + ((size_t)(b * 2 + 1) * 2048 + k1) * 1024 + c4);
    f32x4 e = (f32x4){lo16(eu.x), hi16(eu.x), lo16(eu.y), hi16(eu.y)};
    const f32x4 o = (f32x4){lo16(ou.x), hi16(ou.x), lo16(ou.y), hi16(ou.y)};
    {
      const f32x4 cm = *(const f32x4*)((const float*)(p.ws + O_C2048) + b * 1024 + c4);
      e = (k1 & 1) ? (e - cm) : (e + cm);
    }
    const f32x4 d = e - o, s = e + o;
    u32x2 pk;
    pk.x = pk2(d[0], d[1]); pk.y = pk2(d[2], d[3]);
    *(u32x2*)(f + ((size_t)b * 4096 + k1) * 1024 + c4) = pk;
    if (k1 > 0) {
      pk.x = pk2(s[0], s[1]); pk.y = pk2(s[2], s[3]);
      *(u32x2*)(f + ((size_t)b * 4096 + 4096 - k1) * 1024 + c4) = pk;
    }
  }
  for (int r = blockIdx.x * NTHR + tidx(); r < 8 * 1024; r += gridDim.x * NTHR) {
    const float* cc = (const float*)(p.ws + O_C2048);
    f[((size_t)(r >> 10) * 4096 + 2048) * 1024 + (r & 1023)] = f2bf(cc[16384 + r] + cc[r]);
  }
}
DEV void dft_altsum(const P& p) {
  const int lane = tidx() & 63, gw = blockIdx.x * 8 + (tidx() >> 6), nw = gridDim.x * 8;
  const bf16_t* CF = (const bf16_t*)(p.ws + O_CSTF);
  for (int r = gw; r < 8 * 1024; r += nw) {
    const int b = r >> 10, n = r & 1023;
    const bf16_t* cp = CF + ((size_t)(b * 2) * 1024 + n) * 2048;
    float acc = 0.f;
#pragma unroll
    for (int j = 0; j < 4; ++j) {
      const u32x4 u = *(const u32x4*)(cp + j * 512 + lane * 8);
      acc += (lo16(u.x) - hi16(u.x)) + (lo16(u.y) - hi16(u.y)) + (lo16(u.z) - hi16(u.z)) + (lo16(u.w) - hi16(u.w));
    }
    acc = wave_sum(acc);
    if (lane == 0) ((float*)(p.ws + O_C2048))[16384 + r] = acc * (1.f / 64.f);
  }
}

#define LDSP ((PG8_LAS unsigned char*)lds)
template <class Epi>
DEV void pgemm(char* lds, const bf16_t* A, const bf16_t* Bt, int M_, int N_, int K_, const Epi& E) {
  pg8::Gemm g{A, Bt, M_, N_, K_};
  pg8::StaticOrder S;
  S.init(M_, N_, (int)gridDim.x, (int)blockIdx.x);
  pg8::gemm_phase<Epi, pg8::StaticOrder, true, true>(LDSP, g, S, E);
}

DEV void ffn(char* lds, const XcdBarrier& xbar, const P& p, int l) {
  const bf16_t* h = (const bf16_t*)(p.ws + O_H);
  bf16_t* act = (bf16_t*)(p.ws + O_ACT);
  bf16_t* yf = (bf16_t*)(p.ws + O_YF);
  const bf16_t* upt = (const bf16_t*)(p.ws + W_UP) + (size_t)l * 5632 * 1024;
  const bf16_t* dnt = (const bf16_t*)(p.ws + W_DOWN) + (size_t)l * 1024 * 2816;
  pgemm(lds, h, upt, MT, 5632, 1024, pg8::PEpiGlu{act, (bf16_t*)(p.ws + O_SB), p.ffn_conv + (size_t)l * 3 * 5632});
  xcd_barrier(xbar);
  glu_fixup(p, l);
  xcd_barrier(xbar);
  pgemm(lds, act, dnt, MT, 1024, 2816, pg8::PEpiBf16<false>{yf, 1024});
  xcd_barrier(xbar);
}

DEV const P& kargs() {
  auto q = __builtin_amdgcn_kernarg_segment_ptr();
  asm volatile("" : "+s"(q));
  return *(const P*)q;
}
#define p (kargs())
__global__ void __launch_bounds__(NTHR) mega(P parg_unused) {
  extern __shared__ __attribute__((aligned(16))) char lds[];
  cg::grid_group grid = cg::this_grid();
  char* ws = p.ws;
  if (tidx() < 4) ((unsigned*)(lds + 131072))[tidx()] = 0u;
  __syncthreads();
  const XcdBarrier xbar = xcd_barrier_post((unsigned*)(ws + W_BAR), (volatile XLAS unsigned*)(lds + 131072));
  float* mod = (float*)(ws + W_MOD);
  const int gt = blockIdx.x * NTHR + tidx(), ngt = gridDim.x * NTHR;

  for (int rep_ = 0; rep_ < REP_PRO; ++rep_) {
  if (rep_ > 0) xcd_barrier(xbar);
  compute_mod(lds, p);
  transpose_convert(lds, p.mix_in, 1024, 3584, (bf16_t*)(ws + W_MIXIN), 1024, 0, 2);
  for (int l = 0; l < 2; ++l) {
    transpose_convert(lds, p.ffn_up + (size_t)l * 1024 * 5632, 1024, 5632, (bf16_t*)(ws + W_UP) + (size_t)l * 5632 * 1024, 1024, 64 * l, 1);
    transpose_convert(lds, p.ffn_down + (size_t)l * 2816 * 1024, 2816, 1024, (bf16_t*)(ws + W_DOWN) + (size_t)l * 1024 * 2816, 2816, 128 + 64 * l);
  }
  transpose_convert(lds, p.mix_out, 1024, 1024, (bf16_t*)(ws + W_MIXOUT), 1024, 32);
  transpose_convert(lds, p.fnet_w, 1024, 1024, (bf16_t*)(ws + W_FNET), 1024, 96);
  for (int d = 0; d < 2; ++d) {
    transpose_convert(lds, p.w1 + (size_t)d * 512 * 64, 512, 64, (bf16_t*)(ws + W_L1) + (size_t)(d * 64) * 512, 512, 8 * d);
    transpose_convert(lds, p.a1 + (size_t)d * 512 * 64, 512, 64, (bf16_t*)(ws + W_L1) + (size_t)(128 + d * 64) * 512, 512, 16 + 8 * d);
    transpose_convert(lds, p.w2 + (size_t)d * 64 * 512, 64, 512, (bf16_t*)(ws + W_W2) + (size_t)d * 512 * 64, 64, 48 + 8 * d);
    transpose_convert(lds, p.a2 + (size_t)d * 64 * 512, 64, 512, (bf16_t*)(ws + W_A2) + (size_t)d * 512 * 64, 64, 64 + 8 * d);
  }
  transpose_convert(lds, p.g1, 512, 128, (bf16_t*)(ws + W_L1) + (size_t)256 * 512, 512, 32);
  transpose_convert(lds, p.g2, 128, 512, (bf16_t*)(ws + W_G2), 128, 80);
  {
    float* rope = (float*)(ws + W_ROPE);
    for (int idx = gt; idx < 4096 * 32; idx += ngt) {
      const int s = idx >> 5, e = idx & 31;
      const float inv = powf(10000.f, -(float)e / 32.f);
      const float ang = (float)s * inv;
      float sv, cv;
      sincosf(ang, &sv, &cv);
      rope[2 * idx] = cv;
      rope[2 * idx + 1] = sv;
    }
    bf16_t* dftc = (bf16_t*)(ws + W_DFTC);
    for (int idx = gt; idx < 256 * 256; idx += ngt) {
      const int n = idx >> 8, cc = idx & 255, c = cc & 127, k2 = n & 127;
      const float ph = (float)((k2 * c) & 127) * (1.f / 64.f);
      float v = 0.f;
      if (n < 128 && cc < 128) v = cospif(ph);
      if (n >= 128 && cc >= 128) v = sinpif(ph);
      dftc[idx] = f2bf(v * 0.08838834764831845f);
    }
  }
  }
  grid.sync();
  for (int rep_ = 0; rep_ < REP_ROW; ++rep_) { rowpass<false, true>(p.x, nullptr, nullptr, nullptr, nullptr, p.norm_g, mod + 1024, mod, (bf16_t*)(ws + O_H0)); xcd_barrier(xbar); }
  pgemm(lds, (const bf16_t*)(ws + O_H0), (const bf16_t*)(ws + W_MIXIN), MT, INC, 1024,
        pg8::PEpiMixIn{(bf16_t*)p.out, (bf16_t*)(ws + O_SBZ), (bf16_t*)(ws + O_QR), (bf16_t*)(ws + O_KR), (bf16_t*)(ws + O_VT), p.mix_conv, (const float*)(ws + W_ROPE)});
  xcd_barrier(xbar);
  za_fixup(p);
  for (int rep_ = 0; rep_ < REP_ATT; ++rep_) { attention(lds, p); xcd_barrier(xbar); }
  combineA(p);
  gemm_grid(lds, (const bf16_t*)p.out + 1536, 2048, (const bf16_t*)(ws + W_L1), 512, 512, 128, 3, EpiLora1{(bf16_t*)(ws + O_L1)});
  xcd_barrier(xbar);
  for (int rep_ = 0; rep_ < REP_LORA; ++rep_) {
  for (int d = 0; d < 2; ++d) {
    gemm_grid(lds, (const bf16_t*)(ws + O_L1) + d * 64, 384, (const bf16_t*)(ws + W_W2) + (size_t)d * 512 * 64, 64, 64, 128, 4,
              EpiDecay{(bf16_t*)(ws + O_OMW) + (size_t)d * MT * 512, p.w0 + d * 512});
    gemm_grid(lds, (const bf16_t*)(ws + O_L1) + 128 + d * 64, 384, (const bf16_t*)(ws + W_A2) + (size_t)d * 512 * 64, 64, 64, 128, 4,
              EpiA{(bf16_t*)(ws + O_KD) + (size_t)d * MT * 512, (bf16_t*)(ws + O_KKA) + (size_t)d * MT * 512, (bf16_t*)(ws + O_KK), p.a0 + d * 512,
                   p.k_k, p.k_a, (const bf16_t*)p.out, d == 0});
  }
  gemm_grid(lds, (const bf16_t*)(ws + O_L1) + 256, 384, (const bf16_t*)(ws + W_G2), 128, 128, 128, 4, EpiBf16{(bf16_t*)(ws + O_G), 512});
  xcd_barrier(xbar);
  }
  for (int rep_ = 0; rep_ < REP_SCAN; ++rep_) { scan_phase(lds, p); xcd_barrier(xbar); }
  for (int rep_ = 0; rep_ < REP_SYNC; ++rep_) xcd_barrier(xbar);
  postB(p);
  xcd_barrier(xbar);
  pgemm(lds, (const bf16_t*)(ws + O_YCAT), (const bf16_t*)(ws + W_MIXOUT), MT, 1024, 1024, pg8::PEpiBf16<false>{(bf16_t*)(ws + O_YF), 1024});
  xcd_barrier(xbar);
  rowpass<true, true, false, true>(p.x, (const bf16_t*)(ws + O_YF), p.norm_g + 1024, mod + 2048, ws + O_XB, p.norm_g + 2048, mod + 4096, mod + 3072, (bf16_t*)(ws + O_H));
  xcd_barrier(xbar);
  ffn(lds, xbar, p, 0);
  {
    const float* mod1 = mod + 8 * 6144;
    rowpass_fold((bf16_t*)(ws + O_XB), (const bf16_t*)(ws + O_YF), p.norm_g + 3072, mod + 5120, p.norm_g + 4096, mod1 + 1024, mod1, (bf16_t*)(ws + O_H),
                 (float*)(ws + O_C2048) + 8192);
    bf16_t* cs = (bf16_t*)(ws + O_COSSIN);
    for (int idx = blockIdx.x * NTHR + tidx(); idx < 4096 * 256; idx += gridDim.x * NTHR) {
      const int rr = idx >> 8, s8 = (idx & 255) * 8, k1 = rr & 2047;
      float o[8];
#pragma unroll
      for (int i = 0; i < 8; ++i) {
        const float ph = (float)((k1 * (s8 + i)) & 4095) * (1.f / 2048.f);
        o[i] = ((rr < 2048) ? cospif(ph) : sinpif(ph)) * (1.f / 64.f);
      }
      *(u32x4*)(cs + (size_t)rr * 2048 + s8) = pack8(o);
    }
    xcd_barrier(xbar);
    {
      const bf16_t* dA = (const bf16_t*)(ws + W_DFTC);
      const bf16_t* hB = (const bf16_t*)(ws + O_H);
      u32x4 ra[4], rb[2];
      int t = blockIdx.x;
      if (t < 8 * 128) gemm_first_load(dA, 256, hB + (size_t)(t & 127) * 128 * 2048 + (t >> 7) * 256, 2048, ra, rb);
      for (; t < 8 * 128; t += gridDim.x) {
        const int g = t >> 7, tn = t & 127, t2 = t + gridDim.x;
        const bf16_t* Bn = (t2 < 8 * 128) ? hB + (size_t)(t2 & 127) * 128 * 2048 + (t2 >> 7) * 256 : nullptr;
        gemm_tile(lds, dA, 256, hB + (size_t)tn * 128 * 2048 + g * 256, 2048, 256, 0, tn * 128, EpiDftc{(bf16_t*)(ws + O_CSTF), g}, ra, rb,
                  Bn ? dA : nullptr, Bn);
      }
      const float* h2048 = (const float*)(ws + O_C2048) + 8192;
      for (int idx = blockIdx.x * NTHR + tidx(); idx < 8192; idx += gridDim.x * NTHR) {
        const int bb = idx >> 10, n = idx & 1023, g = n >> 7, k2 = n & 127;
        float acc = 0.f;
        for (int c = 0; c < 128; ++c) acc += h2048[bb * 1024 + g * 128 + c] * bf2f(dA[k2 * 256 + c]);
        ((float*)(ws + O_C2048))[idx] = acc * (1.f / 64.f);
      }
    }
    xcd_barrier(xbar);
    dft_altsum(p);
    {
      pg8::Gemm g{(const bf16_t*)(ws + O_COSSIN), (const bf16_t*)(ws + O_CSTF), 4096, 16384, 2048};
      pg8::BatchOrder S{(int)gridDim.x, (int)blockIdx.x};
      pg8::gemm_phase<pg8::PEpiF32B, pg8::BatchOrder, true, true>(LDSP, g, S, pg8::PEpiF32B{(bf16_t*)(ws + O_EO)});
    }
    xcd_barrier(xbar);
    dft_combine(p);
    xcd_barrier(xbar);
    pgemm(lds, (const bf16_t*)(ws + O_F), (const bf16_t*)(ws + W_FNET), MT, 1024, 1024, pg8::PEpiBf16<false>{(bf16_t*)(ws + O_YF), 1024});
    xcd_barrier(xbar);
    rowpass<true, true, true, true>(ws + O_XB, (const bf16_t*)(ws + O_YF), p.norm_g + 4096 + 1024, mod1 + 2048, ws + O_XB, p.norm_g + 4096 + 2048, mod1 + 4096, mod1 + 3072,
                        (bf16_t*)(ws + O_H));
    xcd_barrier(xbar);
    ffn(lds, xbar, p, 1);
    rowpass<true, false, true, false>(ws + O_XB, (const bf16_t*)(ws + O_YF), p.norm_g + 4096 + 3072, mod1 + 5120, p.out, nullptr, nullptr, nullptr, nullptr);
  }
}

#undef p
extern "C" void kernel_launch(void* const* d_in, const int* in_sizes, int n_in, void* d_out, int out_size, void* d_ws, size_t ws_size,
                              hipStream_t stream) {
  static int grid_blocks = 0;
  if (!grid_blocks) {
    int dev = 0, cus = 0, per_cu = 0;
    hipGetDevice(&dev);
    hipDeviceGetAttribute(&cus, hipDeviceAttributeMultiprocessorCount, dev);
    hipFuncSetAttribute((const void*)mega, hipFuncAttributeMaxDynamicSharedMemorySize, LDS_BYTES);
    hipOccupancyMaxActiveBlocksPerMultiprocessor(&per_cu, (const void*)mega, NTHR, LDS_BYTES);
    if (per_cu < 1) { fprintf(stderr, "occupancy query returned %d\n", per_cu); per_cu = 1; }
    if (per_cu > 1) per_cu = 1;
    grid_blocks = cus * per_cu;
  }
  P p{};
  const float** pp = (const float**)&p;
  for (int i = 0; i < 25; ++i) pp[i] = (const float*)d_in[i];
  p.out = (float*)d_out;
  p.ws = (char*)d_ws;
  (void)hipMemsetAsync((char*)d_ws + W_BAR, 0, XCD_BAR_WORDS * sizeof(unsigned), stream);
  void* args[] = {&p};
  hipError_t e = hipLaunchCooperativeKernel((const void*)mega, dim3(grid_blocks), dim3(NTHR), args, LDS_BYTES, stream);
  if (e != hipSuccess) fprintf(stderr, "cooperative launch failed: %s (grid %d)\n", hipGetErrorString(e), grid_blocks);
}
```

```cpp
#include <hip/hip_runtime.h>
#include <hip/hip_cooperative_groups.h>
#include <stdint.h>
#include <cstdio>
namespace cg = cooperative_groups;

typedef unsigned short bf16_t;
typedef short bf16x8 __attribute__((ext_vector_type(8)));
typedef short s16x4 __attribute__((ext_vector_type(4)));
typedef float f32x4 __attribute__((ext_vector_type(4)));
typedef float f32x2 __attribute__((ext_vector_type(2)));
typedef unsigned u32x4 __attribute__((ext_vector_type(4)));
typedef unsigned u32x2 __attribute__((ext_vector_type(2)));

#define DEV __device__ __forceinline__
__device__ __forceinline__ int tidx() { int t = threadIdx.x; asm volatile("" : "+v"(t)); return t; }

constexpr int NB = 8, SEQ = 4096, DM = 1024, MT = NB * SEQ, DFF = 2816, INC = 3584;
constexpr size_t MiB = 1024 * 1024;
constexpr int NTHR = 512;
constexpr int LDS_BYTES = 131072 + 16;
constexpr size_t W_BAR = 47 * 1024 * 1024;
#ifndef REP_SCAN
#define REP_SCAN 1
#endif
#ifndef REP_ATT
#define REP_ATT 1
#endif
#ifndef REP_SYNC
#define REP_SYNC 0
#endif
#ifndef REP_PREP
#define REP_PREP 1
#endif
#ifndef REP_LORA
#define REP_LORA 1
#endif
#ifndef REP_GLU
#define REP_GLU 1
#endif
#ifndef REP_PRO
#define REP_PRO 1
#endif
#ifndef REP_ROW
#define REP_ROW 1
#endif

constexpr size_t W_MIXIN = 0;
constexpr size_t W_UP = 7 * MiB;
constexpr size_t W_DOWN = 29 * MiB;
constexpr size_t W_MIXOUT = 40 * MiB;
constexpr size_t W_FNET = 42 * MiB;
constexpr size_t W_L1 = 44 * MiB;
constexpr size_t W_W2 = W_L1 + 512 * 1024;
constexpr size_t W_A2 = W_W2 + 128 * 1024;
constexpr size_t W_G2 = W_A2 + 128 * 1024;
constexpr size_t W_DFTC = W_G2 + 128 * 1024;
constexpr size_t W_MOD = 45 * MiB;
constexpr size_t W_ROPE = 46 * MiB;
constexpr size_t R0 = 48 * MiB;
constexpr size_t O_H0 = R0;
constexpr size_t O_Z = 112 * MiB;
constexpr size_t O_SBZ = 304 * MiB;
constexpr size_t O_QR = 336 * MiB, O_KR = 368 * MiB, O_VT = 400 * MiB;
constexpr size_t O_NUM = R0;
constexpr size_t O_MD = 240 * MiB;
constexpr size_t O_YCAT = 448 * MiB;
constexpr size_t O_OMW = 48 * MiB, O_KD = 112 * MiB, O_KKA = 176 * MiB, O_KK = 240 * MiB, O_G = 272 * MiB, O_L1 = 304 * MiB, O_Y = 304 * MiB;
constexpr size_t O_YF = 48 * MiB;
constexpr size_t O_H = 176 * MiB;
constexpr size_t O_ZF = 240 * MiB;
constexpr size_t O_ACT = 240 * MiB;
constexpr size_t O_SB = 416 * MiB;
constexpr size_t O_COSSIN = 240 * MiB;
constexpr size_t O_CST = 304 * MiB;
constexpr size_t O_F = 176 * MiB;
constexpr size_t O_CSTF = 432 * MiB;
constexpr size_t O_C2048 = 272 * MiB;
constexpr size_t O_EO = 48 * MiB;
constexpr size_t O_XB = 112 * MiB;

struct P {
  const float *x, *c, *ada_w, *ada_b, *norm_g, *mix_in, *mix_conv, *w0, *w1, *w2, *a0, *a1, *a2, *g1, *g2, *k_k, *k_a, *r_k, *lnx_w,
      *lnx_b, *mix_out, *fnet_w, *ffn_up, *ffn_conv, *ffn_down;
  float* out;
  char* ws;
};

DEV float bf2f(bf16_t h) { return __uint_as_float(((unsigned)h) << 16); }
DEV bf16_t f2bf(float f) {
  unsigned u = __float_as_uint(f);
  u += 0x7fffu + ((u >> 16) & 1u);
  return (bf16_t)(u >> 16);
}
DEV unsigned pk2(float a, float b) { return (unsigned)f2bf(a) | ((unsigned)f2bf(b) << 16); }
DEV float lo16(unsigned u) { return __uint_as_float(u << 16); }
DEV float hi16(unsigned u) { return __uint_as_float(u & 0xffff0000u); }
DEV float wave_sum(float v) {
#pragma unroll
  for (int o = 32; o; o >>= 1) v += __shfl_xor(v, o);
  return v;
}
DEV float sigmoidf_(float x) { return __builtin_amdgcn_rcpf(1.f + __expf(-x)); }

#include <cstdint>
#include <cstdlib>
#include <vector>

#define XB_TMO      128
#define XB_XCNT(j)  (256  + 64 * (j))
#define XB_XSUB(j)  (1280 + 64 * (j))
#define XB_XGEN(j)  (2304 + 64 * (j))
#define XB_TOP      3328
#define XB_TOPGEN   3392
#define XCD_BAR_WORDS 3456
#define XB_SPIN_CAP (1u << 18)
#define XLAS __attribute__((address_space(3)))

__device__ __forceinline__ unsigned xb_ld(unsigned* p)              { return __hip_atomic_load(p, __ATOMIC_RELAXED, __HIP_MEMORY_SCOPE_AGENT); }
__device__ __forceinline__ unsigned xb_add(unsigned* p, unsigned v) { return __hip_atomic_fetch_add(p, v, __ATOMIC_RELAXED, __HIP_MEMORY_SCOPE_AGENT); }
__device__ __forceinline__ unsigned xb_xcc_id() { return (unsigned)__builtin_amdgcn_s_getreg((3 << 11) | 20) & 0xFu; }
#define XB_SPIN(cond, bar) do { unsigned _sp = 0; while (cond) { __builtin_amdgcn_s_sleep(1); \
    if ((++_sp & 255u) == 0u) { if (xb_ld(&(bar)[XB_TMO])) break; if (_sp > XB_SPIN_CAP) { atomicAdd(&(bar)[XB_TMO], 1u); break; } } } } while (0)

struct XcdBarrier {
    unsigned* bar; unsigned x;
    volatile XLAS unsigned* st;
};

__device__ __forceinline__ XcdBarrier xcd_barrier_post(unsigned* bar, volatile XLAS unsigned* st) {
    XcdBarrier b; b.bar = bar; b.x = xb_xcc_id(); b.st = st;
    if (threadIdx.x == 0) (void)xb_add(&bar[XB_XCNT(b.x)], 1u);
    return b;
}
__device__ __forceinline__ void xcd_barrier_complete(unsigned* bar, unsigned x, unsigned& nloc, unsigned& nx) {
    const unsigned G = gridDim.x * gridDim.y * gridDim.z;
    unsigned sum, cnt, mine, sp = 0u;
    for (;;) {
        sum = 0u; cnt = 0u; mine = 0u;
#pragma unroll
        for (unsigned j = 0; j < 16; ++j) { const unsigned c = xb_ld(&bar[XB_XCNT(j)]); sum += c; cnt += (c > 0u) ? 1u : 0u; mine = (j == x) ? c : mine; }
        if (sum == G) break;
        __builtin_amdgcn_s_sleep(1);
        if ((++sp & 255u) == 0u) { if (xb_ld(&bar[XB_TMO])) break; if (sp > XB_SPIN_CAP) { atomicAdd(&bar[XB_TMO], 1u); break; } }
    }
    nloc = mine > 0u ? mine : 1u; nx = cnt > 0u ? cnt : 1u;
}

__device__ __forceinline__ void xcd_barrier(const XcdBarrier& b) {
    asm volatile("s_waitcnt vmcnt(0)" ::: "memory");
    __syncthreads();
    if (threadIdx.x == 0) {
        unsigned* bar = b.bar;
        __builtin_amdgcn_s_waitcnt(0);
        unsigned nloc = b.st[0], nx = b.st[1];
        if (nloc == 0u) { xcd_barrier_complete(bar, b.x, nloc, nx); b.st[0] = nloc; b.st[1] = nx; }
        const unsigned old = xb_add(&bar[XB_XSUB(b.x)], 1u);
        const unsigned gen = old / nloc;
        if (old + 1u == (gen + 1u) * nloc) {
            __builtin_amdgcn_fence(__ATOMIC_RELEASE, "agent");
            asm volatile("s_waitcnt vmcnt(0)" ::: "memory");
            const unsigned og = xb_add(&bar[XB_TOP], 1u);
            const unsigned tg = og / nx;
            if (og + 1u == (tg + 1u) * nx) xb_add(&bar[XB_TOPGEN], 1u);
            else XB_SPIN(xb_ld(&bar[XB_TOPGEN]) == tg, bar);
            __builtin_amdgcn_fence(__ATOMIC_ACQUIRE, "agent");
            xb_add(&bar[XB_XGEN(b.x)], 1u);
            asm volatile("s_waitcnt vmcnt(0)" ::: "memory");
        } else {
            XB_SPIN(xb_ld(&bar[XB_XGEN(b.x)]) == gen, bar);
            __builtin_amdgcn_fence(__ATOMIC_ACQUIRE, "agent");
            asm volatile("s_waitcnt vmcnt(0)" ::: "memory");
        }
    }
    __syncthreads();
}

namespace pg8 {
#define PG8_LAS __attribute__((address_space(3)))
typedef unsigned short bf16_t;
typedef short bf16x8 __attribute__((ext_vector_type(8)));
typedef float f32x4 __attribute__((ext_vector_type(4)));
typedef unsigned u32x4 __attribute__((ext_vector_type(4)));
constexpr int BM = 256, BK = 64, HALF = 128, HTB = HALF * BK * 2  , STAGE_BYTES = 8 * HTB, NXCD = 8, WGM = 8;

__host__ __device__ __forceinline__ int lds_byte(int r, int c) { const int st = (r >> 4) * 2 + (c >> 5), rr = r & 15, cc = c & 31, ob = rr * 64 + cc * 2; return st * 1024 + (ob ^ (((ob >> 9) & 1) << 5)); }
__host__ __device__ __forceinline__ void stage_rc(int b, int& R, int& C) { const int st = b / 1024, sb = b % 1024, swz = sb ^ (((sb >> 9) & 1) << 5); R = (st >> 1) * 16 + swz / 64; C = (st & 1) * 32 + (swz % 64) / 2; }
__host__ __device__ __forceinline__ int perm32(int rho) { const int n = rho >> 4, i = rho & 15; return 8 * (i >> 2) + 4 * n + (i & 3); }

struct Unit { int pm, pn; };
struct Gemm { const bf16_t* A; const bf16_t* Bt; int M, N, K; };

struct StaticOrder {
    int nM, nN, nwg, G, c;
    __host__ __device__ void init(int M, int N, int G_, int c_) { nM = M / BM; nN = N / BM; nwg = nM * nN; G = G_; c = c_; }
    __host__ __device__ bool next(int i, Unit& u) const {
        const long L = (long)i * G + c; if (L >= nwg) return false;
        int wgid = (int)L; { const int q = nwg / NXCD, r = nwg % NXCD, xcd = wgid % NXCD, off = wgid / NXCD; wgid = (xcd < r ? xcd * (q + 1) : r * (q + 1) + (xcd - r) * q) + off; }
        const int nig = WGM * nN, gid = wgid / nig, fm = gid * WGM, gsz = (nM - fm) < WGM ? (nM - fm) : WGM;
        u.pm = fm + ((wgid % nig) % gsz); u.pn = (wgid % nig) / gsz; return true;
    }
    __device__ __forceinline__ void a_ready(const Unit&) const {}
    __device__ __forceinline__ void done(const Unit&) const {}
};

__device__ __forceinline__ unsigned cvt_pk_bf16(float lo, float hi) { unsigned r; asm volatile("v_cvt_pk_bf16_f32 %0, %1, %2" : "=v"(r) : "v"(lo), "v"(hi)); return r; }

template <bool BATCHED> struct PEpiBf16 {
    static constexpr bool PERM = true, AFTER_DRAIN = false;
    bf16_t* O; int ldc;
    __device__ __forceinline__ void operator()(const f32x4 (&acc)[2][2][4][2], const Unit& u, int wr, int wc, int fr, int fq) const {
        const int rb = BATCHED ? ((u.pn >> 2) * 4096 + u.pm * 256) : u.pm * 256, cb = BATCHED ? (u.pn & 3) * 256 : u.pn * 256;
        const int row0 = rb + wr * 64 + fr, col0 = cb + wc * 32 + 8 * fq;
#pragma unroll
        for (int ai = 0; ai < 2; ++ai)
#pragma unroll
            for (int m = 0; m < 4; ++m) { bf16_t* rowp = O + (size_t)(row0 + ai * HALF + m * 16) * ldc + col0;
#pragma unroll
                for (int bj = 0; bj < 2; ++bj) { const f32x4 v0 = acc[ai][bj][m][0], v1 = acc[ai][bj][m][1];
                    u32x4 w; w.x = cvt_pk_bf16(v0[0], v0[1]); w.y = cvt_pk_bf16(v0[2], v0[3]); w.z = cvt_pk_bf16(v1[0], v1[1]); w.w = cvt_pk_bf16(v1[2], v1[3]);
                    *(u32x4*)(rowp + bj * HALF) = w; } }
    }
};
struct PEpiF32 {
    static constexpr bool PERM = true, AFTER_DRAIN = false;
    float* O; int ldc;
    __device__ __forceinline__ void operator()(const f32x4 (&acc)[2][2][4][2], const Unit& u, int wr, int wc, int fr, int fq) const {
        const int row0 = u.pm * 256 + wr * 64 + fr, col0 = u.pn * 256 + wc * 32 + 8 * fq;
#pragma unroll
        for (int ai = 0; ai < 2; ++ai)
#pragma unroll
            for (int m = 0; m < 4; ++m) { float* rowp = O + (size_t)(row0 + ai * HALF + m * 16) * ldc + col0;
#pragma unroll
                for (int bj = 0; bj < 2; ++bj) { *(f32x4*)(rowp + bj * HALF) = acc[ai][bj][m][0]; *(f32x4*)(rowp + bj * HALF + 4) = acc[ai][bj][m][1]; } }
    }
};
template <int CTRL> __device__ __forceinline__ float dppz(float x) { return __int_as_float(__builtin_amdgcn_update_dpp(0, __float_as_int(x), CTRL, 0xF, 0xF, true)); }
template <int CTRL> __device__ __forceinline__ float dppo(float old, float x) { return __int_as_float(__builtin_amdgcn_update_dpp(__float_as_int(old), __float_as_int(x), CTRL, 0xF, 0xF, false)); }
struct PEpiGlu {
    static constexpr bool PERM = true, AFTER_DRAIN = false;
    bf16_t* act; bf16_t* sb; const float* cw;
    __device__ __forceinline__ void operator()(const f32x4 (&acc)[2][2][4][2], const Unit& u, int wr, int wc, int fr, int fq) const {
        const int chb = u.pn * 128 + wc * 32 + 8 * fq, colp = u.pn * 256 + wc * 32 + 8 * fq;
#pragma unroll
        for (int n = 0; n < 2; ++n) {
            const int ch = chb + 4 * n;
            const f32x4 g0 = *(const f32x4*)(cw + ch), g1 = *(const f32x4*)(cw + 5632 + ch), g2 = *(const f32x4*)(cw + 11264 + ch);
            const f32x4 v0 = *(const f32x4*)(cw + 2816 + ch), v1 = *(const f32x4*)(cw + 5632 + 2816 + ch), v2 = *(const f32x4*)(cw + 11264 + 2816 + ch);
#pragma unroll
            for (int ai = 0; ai < 2; ++ai) {
                const int strip = u.pm * 4 + ai * 2 + wr, rowbase = u.pm * 256 + ai * HALF + wr * 64;
#pragma unroll
                for (int m = 0; m < 4; ++m) {
                    float o[4];
#pragma unroll
                    for (int r = 0; r < 4; ++r) {
                        const float gc = acc[ai][0][m][n][r], vc = acc[ai][1][m][n][r];
                        float gx = 0.f, vx = 0.f, gy = 0.f, vy = 0.f;
                        if (m > 0) { gx = dppz<0x121>(acc[ai][0][m - 1][n][r]); vx = dppz<0x121>(acc[ai][1][m - 1][n][r]); }
                        const float gp = dppo<0x111>(gx, gc), vp = dppo<0x111>(vx, vc);
                        if (m < 3) { gy = dppz<0x12F>(acc[ai][0][m + 1][n][r]); vy = dppz<0x12F>(acc[ai][1][m + 1][n][r]); }
                        const float gn = dppo<0x101>(gy, gc), vn = dppo<0x101>(vy, vc);
                        const float g = gp * g0[r] + gc * g1[r] + gn * g2[r];
                        const float v = vp * v0[r] + vc * v1[r] + vn * v2[r];
                        const float u2 = -1.5957691216057308f * (g + 0.044715f * g * g * g);
                        o[r] = g * __builtin_amdgcn_rcpf(1.f + __expf(u2)) * v;
                    }
                    u32x2 w; w.x = cvt_pk_bf16(o[0], o[1]); w.y = cvt_pk_bf16(o[2], o[3]);
                    *(u32x2*)(act + (size_t)(rowbase + m * 16 + fr) * 2816 + ch) = w;
                }
                if (fr < 2) {
                    bf16_t* sp = sb + ((size_t)strip * 4 + fr) * 5632 + colp + 4 * n;
                    u32x2 w; w.x = cvt_pk_bf16(acc[ai][0][0][n][0], acc[ai][0][0][n][1]); w.y = cvt_pk_bf16(acc[ai][0][0][n][2], acc[ai][0][0][n][3]);
                    *(u32x2*)sp = w;
                    w.x = cvt_pk_bf16(acc[ai][1][0][n][0], acc[ai][1][0][n][1]); w.y = cvt_pk_bf16(acc[ai][1][0][n][2], acc[ai][1][0][n][3]);
                    *(u32x2*)(sp + 128) = w;
                }
                if (fr >= 14) {
                    bf16_t* sp = sb + ((size_t)strip * 4 + (fr - 12)) * 5632 + colp + 4 * n;
                    u32x2 w; w.x = cvt_pk_bf16(acc[ai][0][3][n][0], acc[ai][0][3][n][1]); w.y = cvt_pk_bf16(acc[ai][0][3][n][2], acc[ai][0][3][n][3]);
                    *(u32x2*)sp = w;
                    w.x = cvt_pk_bf16(acc[ai][1][3][n][0], acc[ai][1][3][n][1]); w.y = cvt_pk_bf16(acc[ai][1][3][n][2], acc[ai][1][3][n][3]);
                    *(u32x2*)(sp + 128) = w;
                }
            }
        }
    }
};
struct PEpiMixIn {
    static constexpr bool PERM = true, AFTER_DRAIN = false;
    bf16_t *za, *sbz, *qr, *kr, *vr; const float *cw, *rope;
    __device__ __forceinline__ void operator()(const f32x4 (&acc)[2][2][4][2], const Unit& u, int wr, int wc, int fr, int fq) const {
        if (u.pn < 8) {
#pragma unroll
            for (int bj = 0; bj < 2; ++bj)
#pragma unroll
                for (int n = 0; n < 2; ++n) {
                    const int col = u.pn * 256 + bj * HALF + wc * 32 + 8 * fq + 4 * n;
                    const f32x4 w0 = *(const f32x4*)(cw + col), w1 = *(const f32x4*)(cw + 2048 + col), w2 = *(const f32x4*)(cw + 4096 + col);
#pragma unroll
                    for (int ai = 0; ai < 2; ++ai) {
                        const int strip = u.pm * 4 + ai * 2 + wr, rowbase = u.pm * 256 + ai * HALF + wr * 64;
#pragma unroll
                        for (int m = 0; m < 4; ++m) {
                            float o[4];
#pragma unroll
                            for (int r = 0; r < 4; ++r) {
                                const float c = acc[ai][bj][m][n][r];
                                float x = 0.f, y = 0.f;
                                if (m > 0) x = dppz<0x121>(acc[ai][bj][m - 1][n][r]);
                                const float pv = dppo<0x111>(x, c);
                                if (m < 3) y = dppz<0x12F>(acc[ai][bj][m + 1][n][r]);
                                const float nx = dppo<0x101>(y, c);
                                o[r] = pv * w0[r] + c * w1[r] + nx * w2[r];
                            }
                            u32x2 w; w.x = cvt_pk_bf16(o[0], o[1]); w.y = cvt_pk_bf16(o[2], o[3]);
                            *(u32x2*)(za + (size_t)(rowbase + m * 16 + fr) * 2048 + col) = w;
                        }
                        if (fr < 2) { u32x2 w; w.x = cvt_pk_bf16(acc[ai][bj][0][n][0], acc[ai][bj][0][n][1]); w.y = cvt_pk_bf16(acc[ai][bj][0][n][2], acc[ai][bj][0][n][3]);
                            *(u32x2*)(sbz + ((size_t)strip * 4 + fr) * 2048 + col) = w; }
                        if (fr >= 14) { u32x2 w; w.x = cvt_pk_bf16(acc[ai][bj][3][n][0], acc[ai][bj][3][n][1]); w.y = cvt_pk_bf16(acc[ai][bj][3][n][2], acc[ai][bj][3][n][3]);
                            *(u32x2*)(sbz + ((size_t)strip * 4 + (fr - 12)) * 2048 + col) = w; }
                    }
                }
        } else if (u.pn < 12) {
            const int which = (u.pn - 8) >> 1;
            bf16_t* dst = which ? kr : qr;
            const float scl = which ? 1.f : 0.125f;
#pragma unroll
            for (int bj = 0; bj < 2; ++bj) {
                const int cq = ((u.pn - 8) & 1) * 256 + bj * HALF + wc * 32 + 8 * fq, h = cq >> 6, j0 = (cq & 63) >> 1;
#pragma unroll
                for (int ai = 0; ai < 2; ++ai)
#pragma unroll
                    for (int m = 0; m < 4; ++m) {
                        const int row = u.pm * 256 + ai * HALF + wr * 64 + m * 16 + fr, s = row & 4095;
                        const float* rp = rope + ((size_t)s * 32 + j0) * 2;
                        const f32x4 t0 = *(const f32x4*)rp, t1 = *(const f32x4*)(rp + 4);
                        const f32x4 a = acc[ai][bj][m][0], b = acc[ai][bj][m][1];
                        float o1[4], o2[4];
                        o1[0] = (a[0] * t0[0] - a[1] * t0[1]) * scl; o2[0] = (a[1] * t0[0] + a[0] * t0[1]) * scl;
                        o1[1] = (a[2] * t0[2] - a[3] * t0[3]) * scl; o2[1] = (a[3] * t0[2] + a[2] * t0[3]) * scl;
                        o1[2] = (b[0] * t1[0] - b[1] * t1[1]) * scl; o2[2] = (b[1] * t1[0] + b[0] * t1[1]) * scl;
                        o1[3] = (b[2] * t1[2] - b[3] * t1[3]) * scl; o2[3] = (b[3] * t1[2] + b[2] * t1[3]) * scl;
                        bf16_t* dp = dst + (size_t)row * 512 + h * 64 + j0;
                        u32x2 w; w.x = cvt_pk_bf16(o1[0], o1[1]); w.y = cvt_pk_bf16(o1[2], o1[3]); *(u32x2*)dp = w;
                        w.x = cvt_pk_bf16(o2[0], o2[1]); w.y = cvt_pk_bf16(o2[2], o2[3]); *(u32x2*)(dp + 32) = w;
                    }
            }
        } else {
#pragma unroll
            for (int bj = 0; bj < 2; ++bj) {
                const int cv = (u.pn - 12) * 256 + bj * HALF + wc * 32 + 8 * fq;
#pragma unroll
                for (int ai = 0; ai < 2; ++ai)
#pragma unroll
                    for (int m = 0; m < 4; ++m) {
                        const int row = u.pm * 256 + ai * HALF + wr * 64 + m * 16 + fr;
                        const f32x4 v0 = acc[ai][bj][m][0], v1 = acc[ai][bj][m][1];
                        u32x4 w; w.x = cvt_pk_bf16(v0[0], v0[1]); w.y = cvt_pk_bf16(v0[2], v0[3]); w.z = cvt_pk_bf16(v1[0], v1[1]); w.w = cvt_pk_bf16(v1[2], v1[3]);
                        *(u32x4*)(vr + (size_t)row * 512 + cv) = w;
                    }
            }
        }
    }
};
struct PEpiDft {
    static constexpr bool PERM = true, AFTER_DRAIN = false;
    bf16_t* E; bf16_t* f; const float* c2048;
    __device__ __forceinline__ void operator()(const f32x4 (&acc)[2][2][4][2], const Unit& u, int wr, int wc, int fr, int fq) const {
        const int be = u.pn >> 2, eo = be & 1, b = be >> 1;
        const int k0 = (u.pm & 7) * 256 + wr * 64 + fr, col0 = (u.pn & 3) * 256 + wc * 32 + 8 * fq;
#pragma unroll
        for (int ai = 0; ai < 2; ++ai)
#pragma unroll
            for (int m = 0; m < 4; ++m) {
                const int k1 = k0 + ai * HALF + m * 16;
#pragma unroll
                for (int bj = 0; bj < 2; ++bj) {
                    const int col = col0 + bj * HALF;
                    const f32x4 v0 = acc[ai][bj][m][0], v1 = acc[ai][bj][m][1];
                    bf16_t* ep = E + ((size_t)(b * 2048 + k1) * 1024 + col);
                    if (eo == 0) {
                        u32x4 w; w.x = cvt_pk_bf16(v0[0], v0[1]); w.y = cvt_pk_bf16(v0[2], v0[3]); w.z = cvt_pk_bf16(v1[0], v1[1]); w.w = cvt_pk_bf16(v1[2], v1[3]);
                        *(u32x4*)ep = w;
                    } else {
                        const u32x4 eu = *(const u32x4*)ep;
                        const f32x4 c0 = *(const f32x4*)(c2048 + b * 1024 + col), c1 = *(const f32x4*)(c2048 + b * 1024 + col + 4);
                        f32x4 e0 = (f32x4){__uint_as_float(eu.x << 16), __uint_as_float(eu.x & 0xffff0000u), __uint_as_float(eu.y << 16), __uint_as_float(eu.y & 0xffff0000u)};
                        f32x4 e1 = (f32x4){__uint_as_float(eu.z << 16), __uint_as_float(eu.z & 0xffff0000u), __uint_as_float(eu.w << 16), __uint_as_float(eu.w & 0xffff0000u)};
                        if (k1 & 1) { e0 = e0 - c0; e1 = e1 - c1; } else { e0 = e0 + c0; e1 = e1 + c1; }
                        const f32x4 d0 = e0 - v0, d1 = e1 - v1, s0 = e0 + v0, s1 = e1 + v1;
                        u32x4 w; w.x = cvt_pk_bf16(d0[0], d0[1]); w.y = cvt_pk_bf16(d0[2], d0[3]); w.z = cvt_pk_bf16(d1[0], d1[1]); w.w = cvt_pk_bf16(d1[2], d1[3]);
                        *(u32x4*)(f + ((size_t)(b * 4096 + k1) * 1024 + col)) = w;
                        if (k1 > 0) {
                            w.x = cvt_pk_bf16(s0[0], s0[1]); w.y = cvt_pk_bf16(s0[2], s0[3]); w.z = cvt_pk_bf16(s1[0], s1[1]); w.w = cvt_pk_bf16(s1[2], s1[3]);
                            *(u32x4*)(f + ((size_t)(b * 4096 + 4096 - k1) * 1024 + col)) = w;
                        }
                    }
                }
            }
    }
};
struct BatchOrder {
    int G, c;
    __device__ __forceinline__ bool next(int i, Unit& u) const { const int T = (i >> 1) * G + c, eo = i & 1; if (T >= 256) return false;
        const int b = T >> 5, r = T & 31, be = b * 2 + eo; u.pm = eo * 8 + (r >> 2); u.pn = be * 4 + (r & 3); return true; }
    __device__ __forceinline__ void a_ready(const Unit&) const {}
    __device__ __forceinline__ void done(const Unit&) const {}
};

template <class Epi, class Sched, bool ALIGN_EPI = false, bool SP2 = false>
__device__ __forceinline__ void gemm_phase(PG8_LAS unsigned char* lds, const Gemm g, const Sched& S, const Epi& E) {
    int tid_ = threadIdx.x; asm volatile("" : "+v"(tid_));
    const int tid = tid_, wid = __builtin_amdgcn_readfirstlane(tid >> 6), lane = tid & 63, wr = wid >> 2, wc = wid & 3, fr = lane & 15, fq = lane >> 4;
    const int K = g.K, nt = K / BK;
    unsigned voffA[2], voffB[2];
#pragma unroll
    for (int i = 0; i < 2; ++i) { int R, C; stage_rc(tid * 16 + i * 8192, R, C); const int Rb = Epi::PERM ? ((R & ~31) + perm32(R & 31)) : R;
        voffA[i] = (unsigned)(R * K + C) * 2u; voffB[i] = (unsigned)(Rb * K + C) * 2u; }
    const size_t kstep = (size_t)(BK * 2);
    const size_t hstep = (size_t)HALF * K * 2;
    const size_t tstep = 2 * hstep;
    const unsigned ldsw = (unsigned)wid * 1024u;
    const int aoff = lds_byte(wr * 64 + fr, fq * 8), boff = lds_byte(wc * 32 + fr, fq * 8);
#define PG8_SA(b, h) (((b) * 2 + (h)) * HTB)
#define PG8_SB(b, h) ((4 + (b) * 2 + (h)) * HTB)
#define PG8_STAGE(bufoff, gbase, voff) do { _Pragma("unroll") for (int _i = 0; _i < 2; ++_i) \
        __builtin_amdgcn_global_load_lds((const unsigned*)((const char*)(gbase) + (voff)[_i]), (PG8_LAS unsigned*)(lds + (bufoff) + ldsw + _i * 8192), 16, 0, 0); } while (0)
#define PG8_LDA(dst, b, h) do { _Pragma("unroll") for (int m = 0; m < 4; ++m) _Pragma("unroll") for (int k = 0; k < 2; ++k) dst[m][k] = *(const PG8_LAS bf16x8*)(lds + PG8_SA(b, h) + aoff + m * 2048 + k * 1024); } while (0)
#define PG8_LDB(dst, b, h) do { _Pragma("unroll") for (int n = 0; n < 2; ++n) _Pragma("unroll") for (int k = 0; k < 2; ++k) dst[n][k] = *(const PG8_LAS bf16x8*)(lds + PG8_SB(b, h) + boff + n * 2048 + k * 1024); } while (0)
#define PG8_MMA(ai, bj, At, Bt) do { __builtin_amdgcn_s_setprio(1); _Pragma("unroll") for (int m = 0; m < 4; ++m) _Pragma("unroll") for (int n = 0; n < 2; ++n) _Pragma("unroll") for (int k = 0; k < 2; ++k) \
        acc[ai][bj][m][n] = __builtin_amdgcn_mfma_f32_16x16x32_bf16(Bt[n][k], At[m][k], acc[ai][bj][m][n], 0, 0, 0); __builtin_amdgcn_s_setprio(0); } while (0)
#define PG8_WAIT_V(n) asm volatile("s_waitcnt vmcnt(" #n ")" ::: "memory")
#define PG8_WAIT_L(n) asm volatile("s_waitcnt lgkmcnt(" #n ")" ::: "memory")
#define PG8_BAR __builtin_amdgcn_s_barrier()
#define PG8_SCHED __builtin_amdgcn_sched_barrier(0)
    Unit cur, nxt; int ui = 0;
    if (!S.next(0, cur)) return;
    f32x4 acc[2][2][4][2];
#pragma unroll
    for (int a = 0; a < 2; ++a)
#pragma unroll
        for (int b = 0; b < 2; ++b)
#pragma unroll
            for (int m = 0; m < 4; ++m)
#pragma unroll
                for (int n = 0; n < 2; ++n) acc[a][b][m][n] = (f32x4){0.f, 0.f, 0.f, 0.f};
    bf16x8 At[4][2], B0[2][2], B1[2][2];
    const char* cA = (const char*)g.A + (size_t)cur.pm * tstep; const char* cB = (const char*)g.Bt + (size_t)cur.pn * tstep;
    S.a_ready(cur);
    if constexpr (SP2) {
        PG8_STAGE(PG8_SB(0, 0), cB, voffB); PG8_STAGE(PG8_SB(0, 1), cB + hstep, voffB); PG8_STAGE(PG8_SA(0, 0), cA, voffA); PG8_STAGE(PG8_SA(0, 1), cA + hstep, voffA);
        if (wr == 1) PG8_BAR;
        PG8_WAIT_V(2); PG8_BAR;
        PG8_STAGE(PG8_SB(1, 0), cB + kstep, voffB); PG8_STAGE(PG8_SA(1, 0), cA + kstep, voffA); PG8_STAGE(PG8_SB(1, 1), cB + hstep + kstep, voffB);
        PG8_WAIT_V(6); PG8_BAR;
    } else {
        PG8_STAGE(PG8_SB(0, 0), cB, voffB); PG8_STAGE(PG8_SA(0, 0), cA, voffA); PG8_STAGE(PG8_SB(0, 1), cB + hstep, voffB); PG8_STAGE(PG8_SA(0, 1), cA + hstep, voffA);
        if (wr == 1) PG8_BAR;
        PG8_WAIT_V(4); PG8_BAR;
        PG8_STAGE(PG8_SB(1, 0), cB + kstep, voffB); PG8_STAGE(PG8_SA(1, 0), cA + kstep, voffA); PG8_STAGE(PG8_SB(1, 1), cB + hstep + kstep, voffB);
        PG8_WAIT_V(6); PG8_BAR;
    }
    for (;;) {
        const bool has_next = S.next(ui + 1, nxt);
        const char* nA = has_next ? (const char*)g.A + (size_t)nxt.pm * tstep : cA; const char* nB = has_next ? (const char*)g.Bt + (size_t)nxt.pn * tstep : cB;
        for (int t = 0; t < nt; t += 2) {
            const bool last = (t == nt - 2);
            const char* a1 = cA + (size_t)(t + 1) * kstep;
            const char* a2 = last ? nA : cA + (size_t)(t + 2) * kstep; const char* b2 = last ? nB : cB + (size_t)(t + 2) * kstep;
            const char* a3 = a2 + kstep; const char* b3 = b2 + kstep;
            if (last && has_next) S.a_ready(nxt);
            if constexpr (SP2) {
            PG8_LDB(B0, 0, 0); PG8_LDB(B1, 0, 1); PG8_SCHED; PG8_LDA(At, 0, 0); PG8_STAGE(PG8_SA(1, 1), a1 + hstep, voffA);
            PG8_WAIT_V(8); PG8_WAIT_L(0); PG8_BAR; PG8_MMA(0, 0, At, B0); PG8_MMA(0, 1, At, B1); PG8_BAR; PG8_SCHED;
            PG8_LDA(At, 0, 1); PG8_STAGE(PG8_SB(0, 0), b2, voffB); PG8_STAGE(PG8_SB(0, 1), b2 + hstep, voffB); PG8_STAGE(PG8_SA(0, 0), a2, voffA);
            PG8_WAIT_V(8); PG8_WAIT_L(0); PG8_BAR; PG8_MMA(1, 0, At, B0); PG8_MMA(1, 1, At, B1); PG8_BAR; PG8_SCHED;
            PG8_LDB(B0, 1, 0); PG8_LDB(B1, 1, 1); PG8_SCHED; PG8_LDA(At, 1, 0); PG8_STAGE(PG8_SA(0, 1), a2 + hstep, voffA);
            PG8_WAIT_V(8); PG8_WAIT_L(0); PG8_BAR; PG8_MMA(0, 0, At, B0); PG8_MMA(0, 1, At, B1); PG8_BAR; PG8_SCHED;
            PG8_LDA(At, 1, 1); PG8_STAGE(PG8_SB(1, 0), b3, voffB); PG8_STAGE(PG8_SB(1, 1), b3 + hstep, voffB); PG8_STAGE(PG8_SA(1, 0), a3, voffA);
            PG8_WAIT_V(8); PG8_WAIT_L(0); PG8_BAR; PG8_MMA(1, 0, At, B0); PG8_MMA(1, 1, At, B1); PG8_BAR; PG8_SCHED;
            } else {
            PG8_LDB(B0, 0, 0); PG8_SCHED; PG8_LDA(At, 0, 0); PG8_STAGE(PG8_SA(1, 1), a1 + hstep, voffA);
            PG8_WAIT_L(8); PG8_BAR; PG8_WAIT_L(0); PG8_MMA(0, 0, At, B0); PG8_BAR; PG8_SCHED;
            PG8_LDB(B1, 0, 1); PG8_STAGE(PG8_SB(0, 0), b2, voffB);
            PG8_BAR; PG8_WAIT_L(0); PG8_MMA(0, 1, At, B1); PG8_BAR;
            PG8_LDA(At, 0, 1); PG8_STAGE(PG8_SA(0, 0), a2, voffA);
            PG8_BAR; PG8_WAIT_L(0); PG8_MMA(1, 0, At, B0); PG8_BAR; PG8_SCHED;
            PG8_STAGE(PG8_SB(0, 1), b2 + hstep, voffB);
            PG8_WAIT_V(6); PG8_BAR; PG8_MMA(1, 1, At, B1); PG8_BAR;
            PG8_LDB(B0, 1, 0); PG8_SCHED; PG8_LDA(At, 1, 0); PG8_STAGE(PG8_SA(0, 1), a2 + hstep, voffA);
            PG8_WAIT_L(8); PG8_BAR; PG8_WAIT_L(0); PG8_MMA(0, 0, At, B0); PG8_BAR; PG8_SCHED;
            PG8_LDB(B1, 1, 1); PG8_STAGE(PG8_SB(1, 0), b3, voffB);
            PG8_BAR; PG8_WAIT_L(0); PG8_MMA(0, 1, At, B1); PG8_BAR;
            PG8_LDA(At, 1, 1); PG8_STAGE(PG8_SA(1, 0), a3, voffA);
            PG8_BAR; PG8_WAIT_L(0); PG8_MMA(1, 0, At, B0); PG8_BAR; PG8_SCHED;
            PG8_STAGE(PG8_SB(1, 1), b3 + hstep, voffB);
            PG8_WAIT_V(6); PG8_BAR; PG8_MMA(1, 1, At, B1); PG8_BAR;
            }
        }
        if constexpr (ALIGN_EPI) { if (wr == 0) PG8_BAR; }
        if constexpr (!Epi::AFTER_DRAIN) { E(acc, cur, wr, wc, fr, fq); S.done(cur); }
        if (!has_next) break;
#pragma unroll
        for (int a = 0; a < 2; ++a)
#pragma unroll
            for (int b = 0; b < 2; ++b)
#pragma unroll
                for (int m = 0; m < 4; ++m)
#pragma unroll
                    for (int n = 0; n < 2; ++n) acc[a][b][m][n] = (f32x4){0.f, 0.f, 0.f, 0.f};
        cur = nxt; cA = nA; cB = nB; ++ui;
        if constexpr (ALIGN_EPI) { if (wr == 1) PG8_BAR; }
    }
    PG8_WAIT_V(0);
    if constexpr (!ALIGN_EPI) { if (wr == 0) PG8_BAR; }
    PG8_BAR;
    if constexpr (Epi::AFTER_DRAIN) { E.fused(acc, cur, wr, wc, fr, fq, lds, wid, lane); S.done(cur); }
#undef PG8_SA
#undef PG8_SB
#undef PG8_STAGE
#undef PG8_LDA
#undef PG8_LDB
#undef PG8_MMA
#undef PG8_WAIT_V
#undef PG8_WAIT_L
#undef PG8_BAR
#undef PG8_SCHED
}
}

DEV void gemm_first_load(const bf16_t* __restrict__ A, int lda, const bf16_t* __restrict__ Bt, int ldb, u32x4 (&ra)[4], u32x4 (&rb)[2]) {
  const int tid = tidx(), w = tid >> 6, l = tid & 63, lr = l & 15, lq = l >> 4;
#pragma unroll
  for (int j = 0; j < 4; ++j) {
    const int c = w * 4 + j, mt = c >> 1, sl = c & 1;
    ra[j] = *(const u32x4*)(A + (size_t)(mt * 16 + lr) * lda + sl * 32 + lq * 8);
  }
#pragma unroll
  for (int j = 0; j < 2; ++j) {
    const int nt = w, sl = j;
    const int rowb = (nt >> 2) * 64 + (lr >> 2) * 16 + (nt & 3) * 4 + (lr & 3);
    rb[j] = *(const u32x4*)(Bt + (size_t)rowb * ldb + sl * 32 + lq * 8);
  }
}
template <class Epi>
DEV void gemm_tile(char* lds, const bf16_t* __restrict__ A, int lda, const bf16_t* __restrict__ Bt, int ldb, int K, int trow, int tcol,
                   const Epi& epi, u32x4 (&ra)[4], u32x4 (&rb)[2], const bf16_t* __restrict__ An, const bf16_t* __restrict__ Bn) {
  const int tid = tidx(), w = tid >> 6, l = tid & 63, wm = w >> 1, wn = w & 1, lr = l & 15, lq = l >> 4;
  const bf16_t* ga[4];
  const bf16_t* gb[2];
#pragma unroll
  for (int j = 0; j < 4; ++j) {
    const int c = w * 4 + j, mt = c >> 1, sl = c & 1;
    ga[j] = A + (size_t)(mt * 16 + lr) * lda + sl * 32 + lq * 8;
  }
#pragma unroll
  for (int j = 0; j < 2; ++j) {
    const int nt = w, sl = j;
    const int rowb = (nt >> 2) * 64 + (lr >> 2) * 16 + (nt & 3) * 4 + (lr & 3);
    gb[j] = Bt + (size_t)rowb * ldb + sl * 32 + lq * 8;
  }
  f32x4 acc[4][4];
#pragma unroll
  for (int i = 0; i < 4; ++i)
#pragma unroll
    for (int j = 0; j < 4; ++j) acc[i][j] = (f32x4){0.f, 0.f, 0.f, 0.f};
  const int nk = K >> 6;
#pragma unroll
  for (int j = 0; j < 4; ++j) *(u32x4*)(lds + (w * 4 + j) * 1024 + l * 16) = ra[j];
#pragma unroll
  for (int j = 0; j < 2; ++j) *(u32x4*)(lds + 32768 + (w * 2 + j) * 1024 + l * 16) = rb[j];
  __syncthreads();
  for (int kt = 0; kt < nk; ++kt) {
    char* cur = lds + (kt & 1) * 49152;
    const bool more = (kt + 1 < nk);
    if (more) {
#pragma unroll
      for (int j = 0; j < 4; ++j) ra[j] = *(const u32x4*)(ga[j] + (kt + 1) * 64);
#pragma unroll
      for (int j = 0; j < 2; ++j) rb[j] = *(const u32x4*)(gb[j] + (kt + 1) * 64);
    }
#pragma unroll
    for (int s = 0; s < 2; ++s) {
      bf16x8 af[4], bfr[4];
#pragma unroll
      for (int i = 0; i < 4; ++i) af[i] = *(const bf16x8*)(cur + ((wm * 4 + i) * 2 + s) * 1024 + l * 16);
#pragma unroll
      for (int j = 0; j < 4; ++j) bfr[j] = *(const bf16x8*)(cur + 32768 + ((wn * 4 + j) * 2 + s) * 1024 + l * 16);
#pragma unroll
      for (int i = 0; i < 4; ++i)
#pragma unroll
        for (int j = 0; j < 4; ++j) acc[i][j] = __builtin_amdgcn_mfma_f32_16x16x32_bf16(bfr[j], af[i], acc[i][j], 0, 0, 0);
    }
    if (more) {
      char* nxt = lds + ((kt + 1) & 1) * 49152;
#pragma unroll
      for (int j = 0; j < 4; ++j) *(u32x4*)(nxt + (w * 4 + j) * 1024 + l * 16) = ra[j];
#pragma unroll
      for (int j = 0; j < 2; ++j) *(u32x4*)(nxt + 32768 + (w * 2 + j) * 1024 + l * 16) = rb[j];
    }
    __syncthreads();
  }
  if (An) gemm_first_load(An, lda, Bn, ldb, ra, rb);
#pragma unroll
  for (int i = 0; i < 4; ++i) epi(trow + wm * 64 + i * 16 + lr, tcol + wn * 64 + lq * 16, acc[i]);
}

DEV void store16_bf16(bf16_t* dst, const f32x4 (&v)[4], float sc) {
  u32x4 a, b;
  a.x = pk2(v[0][0] * sc, v[0][1] * sc); a.y = pk2(v[0][2] * sc, v[0][3] * sc);
  a.z = pk2(v[1][0] * sc, v[1][1] * sc); a.w = pk2(v[1][2] * sc, v[1][3] * sc);
  b.x = pk2(v[2][0] * sc, v[2][1] * sc); b.y = pk2(v[2][2] * sc, v[2][3] * sc);
  b.z = pk2(v[3][0] * sc, v[3][1] * sc); b.w = pk2(v[3][2] * sc, v[3][3] * sc);
  *(u32x4*)dst = a;
  *(u32x4*)(dst + 8) = b;
}

struct EpiBf16 {
  bf16_t* O; int ldo;
  DEV void operator()(int row, int col, const f32x4 (&v)[4]) const { store16_bf16(O + (size_t)row * ldo + col, v, 1.f); }
};
struct EpiF32 {
  float* O; int ldo;
  DEV void operator()(int row, int col, const f32x4 (&v)[4]) const {
    float* d = O + (size_t)row * ldo + col;
#pragma unroll
    for (int j = 0; j < 4; ++j) *(f32x4*)(d + 4 * j) = v[j];
  }
};
struct EpiLora1 {
  bf16_t* O;
  DEV void operator()(int row, int col, const f32x4 (&v)[4]) const {
    f32x4 o[4];
#pragma unroll
    for (int j = 0; j < 4; ++j)
#pragma unroll
      for (int r = 0; r < 4; ++r) {
        const float t = v[j][r];
        o[j][r] = (col < 128) ? (1.f - 2.f * __builtin_amdgcn_rcpf(1.f + __expf(2.f * t))) : ((col < 256) ? t : sigmoidf_(t));
      }
    store16_bf16(O + (size_t)row * 384 + col, o, 1.f);
  }
};
struct EpiDecay {
  bf16_t* O; const float* w0;
  DEV void operator()(int row, int col, const f32x4 (&v)[4]) const {
    f32x4 o[4];
    float w0v[16];
#pragma unroll
    for (int i = 0; i < 16; i += 4) *(f32x4*)(w0v + i) = *(const f32x4*)(w0 + col + i);
#pragma unroll
    for (int j = 0; j < 4; ++j)
#pragma unroll
      for (int r = 0; r < 4; ++r) {
        const float xx = w0v[4 * j + r] + v[j][r];
        const float nx = -xx;
        const float sp = (nx > 20.f) ? nx : __logf(1.f + __expf(nx));
        const float e = __expf(-sp - 0.5f);
        o[j][r] = 1.f - __expf(-e);
      }
    store16_bf16(O + (size_t)row * 512 + col, o, 1.f);
  }
};
struct EpiA {
  bf16_t *KD, *KKA, *KK; const float *a0, *k_k, *k_a; const bf16_t* za; int writekk;
  DEV void operator()(int row, int col, const f32x4 (&v)[4]) const {
    const bf16_t* kp = za + (size_t)row * 2048 + 512 + col;
    const u32x4 k0 = *(const u32x4*)kp, k1 = *(const u32x4*)(kp + 8);
    float kf[16];
    kf[0] = lo16(k0.x); kf[1] = hi16(k0.x); kf[2] = lo16(k0.y); kf[3] = hi16(k0.y); kf[4] = lo16(k0.z); kf[5] = hi16(k0.z); kf[6] = lo16(k0.w); kf[7] = hi16(k0.w);
    kf[8] = lo16(k1.x); kf[9] = hi16(k1.x); kf[10] = lo16(k1.y); kf[11] = hi16(k1.y); kf[12] = lo16(k1.z); kf[13] = hi16(k1.z); kf[14] = lo16(k1.w); kf[15] = hi16(k1.w);
    float kkv[16], a0v[16], kav[16];
#pragma unroll
    for (int i = 0; i < 16; i += 4) { *(f32x4*)(kkv + i) = *(const f32x4*)(k_k + col + i); *(f32x4*)(a0v + i) = *(const f32x4*)(a0 + col + i); *(f32x4*)(kav + i) = *(const f32x4*)(k_a + col + i); }
    float kr[16], ss = 0.f;
#pragma unroll
    for (int i = 0; i < 16; ++i) { kr[i] = kf[i] * kkv[i]; ss += kr[i] * kr[i]; }
    ss += __shfl_xor(ss, 16);
    ss += __shfl_xor(ss, 32);
    const float rn = rsqrtf(ss + 1e-12f);
    f32x4 okd[4], okka[4], okk[4];
#pragma unroll
    for (int j = 0; j < 4; ++j)
#pragma unroll
      for (int r = 0; r < 4; ++r) {
        const int i = 4 * j + r;
        const float a = sigmoidf_(a0v[i] + v[j][r]);
        const float kk = kr[i] * rn;
        okd[j][r] = kf[i] * (1.f + (a - 1.f) * kav[i]);
        okka[j][r] = kk * a;
        okk[j][r] = kk;
      }
    store16_bf16(KD + (size_t)row * 512 + col, okd, 1.f);
    store16_bf16(KKA + (size_t)row * 512 + col, okka, 1.f);
    if (writekk) store16_bf16(KK + (size_t)row * 512 + col, okk, 1.f);
  }
};
struct EpiDftc {
  bf16_t* CST; int g;
  DEV void operator()(int row, int col, const f32x4 (&v)[4]) const {
    const int b = col >> 11, s = col & 2047;
    store16_bf16(CST + ((size_t)((b * 2 + (row >> 7)) * 1024 + g * 128 + (row & 127)) * 2048 + s), v, 1.f);
  }
};

DEV void transpose_convert(char* lds, const float* __restrict__ W, int K, int N, bf16_t* __restrict__ Wt, int ldt, int rot, int mode = 0) {
  float* tile = (float*)lds;
  const int tn_n = N >> 6, nt = (K >> 6) * tn_n, tid = tidx();
  const int r0 = tid >> 4, c4 = (tid & 15) * 4;
  int t = (blockIdx.x + rot) % gridDim.x;
  f32x4 ra, rb;
  if (t < nt) {
    const int tk = t / tn_n, tn = t % tn_n;
    const float* src = W + (size_t)(tk * 64 + r0) * N + tn * 64 + c4;
    ra = *(const f32x4*)src; rb = *(const f32x4*)(src + (size_t)32 * N);
  }
  for (; t < nt; t += gridDim.x) {
    const int tk = t / tn_n, tn = t % tn_n;
#pragma unroll
    for (int i = 0; i < 4; ++i) { tile[r0 * 65 + c4 + i] = ra[i]; tile[(r0 + 32) * 65 + c4 + i] = rb[i]; }
    __syncthreads();
    const int t2 = t + gridDim.x;
    if (t2 < nt) {
      const int tk2 = t2 / tn_n, tn2 = t2 % tn_n;
      const float* src = W + (size_t)(tk2 * 64 + r0) * N + tn2 * 64 + c4;
      ra = *(const f32x4*)src; rb = *(const f32x4*)(src + (size_t)32 * N);
    }
    int nbase = tn * 64;
    if (mode == 1) { const int c = tn * 64; nbase = (c < 2816) ? ((c >> 7) * 256 + (c & 127)) : (((c - 2816) >> 7) * 256 + 128 + ((c - 2816) & 127)); }
    const bool qk = (mode == 2) && (tn * 64 >= 2048) && (tn * 64 < 3072);
#pragma unroll
    for (int j = 0; j < 2; ++j) {
      const int ns = r0 + 32 * j;
      const int n = qk ? (2 * (ns & 31) + (ns >> 5)) : ns;
      u32x2 pk;
      pk.x = pk2(tile[(c4 + 0) * 65 + ns], tile[(c4 + 1) * 65 + ns]);
      pk.y = pk2(tile[(c4 + 2) * 65 + ns], tile[(c4 + 3) * 65 + ns]);
      *(u32x2*)(Wt + (size_t)(nbase + n) * ldt + tk * 64 + c4) = pk;
    }
    __syncthreads();
  }
}

DEV void compute_mod(char* lds, const P& p) {
  float* cs = (float*)lds;
  float* red = (float*)(lds + 32768);
  const int tid = tidx();
  float* mod = (float*)(p.ws + W_MOD);
  bool have = false;
  for (int item = blockIdx.x; item < 192; item += gridDim.x) {
    if (!have) {
      for (int i = tid; i < 8192; i += NTHR) { const float cv = p.c[i]; cs[i] = cv / (1.f + expf(-cv)); }
      __syncthreads();
      have = true;
    }
    const int l = item / 96, cb = item % 96, col = cb * 64 + (tid & 63), kg = tid >> 6;
    float a0 = 0, a1 = 0, a2 = 0, a3 = 0, a4 = 0, a5 = 0, a6 = 0, a7 = 0;
    const float* wp = p.ada_w + ((size_t)l * 1024 + kg * 128) * 6144 + col;
    for (int k = 0; k < 128; ++k) {
      const float wv = wp[(size_t)k * 6144];
      const int kk = kg * 128 + k;
      a0 += cs[kk] * wv; a1 += cs[1024 + kk] * wv; a2 += cs[2048 + kk] * wv; a3 += cs[3072 + kk] * wv;
      a4 += cs[4096 + kk] * wv; a5 += cs[5120 + kk] * wv; a6 += cs[6144 + kk] * wv; a7 += cs[7168 + kk] * wv;
    }
    float* rp = red + kg * 512 + (tid & 63);
    rp[0] = a0; rp[64] = a1; rp[128] = a2; rp[192] = a3; rp[256] = a4; rp[320] = a5; rp[384] = a6; rp[448] = a7;
    __syncthreads();
    {
      const int b = tid >> 6, cc = tid & 63;
      float s = 0.f;
#pragma unroll
      for (int g = 0; g < 8; ++g) s += red[g * 512 + b * 64 + cc];
      mod[(size_t)(l * 8 + b) * 6144 + cb * 64 + cc] = s + p.ada_b[l * 6144 + cb * 64 + cc];
    }
    __syncthreads();
  }
}

template <bool HAS_Y, bool HAS_H, bool XIN_BF = false, bool XOUT_BF = false>
DEV void rowpass(const void* __restrict__ xin_, const bf16_t* __restrict__ yf, const float* __restrict__ gy, const float* __restrict__ gate,
                 void* __restrict__ xout_, const float* __restrict__ gh, const float* __restrict__ sc, const float* __restrict__ sh,
                 bf16_t* __restrict__ h) {
  const float* xin = (const float*)xin_; const bf16_t* xinb = (const bf16_t*)xin_;
  float* xout = (float*)xout_; bf16_t* xoutb = (bf16_t*)xout_;
  const int lane = tidx() & 63, gw = blockIdx.x * 8 + (tidx() >> 6), nw = gridDim.x * 8;
  for (int row = gw; row < MT; row += nw) {
    const int b = row >> 12;
    f32x4 xv[4];
#pragma unroll
    for (int i = 0; i < 4; ++i) {
      if (XIN_BF) { const u32x2 xu = *(const u32x2*)(xinb + (size_t)row * 1024 + i * 256 + lane * 4); xv[i] = (f32x4){lo16(xu.x), hi16(xu.x), lo16(xu.y), hi16(xu.y)}; }
      else xv[i] = *(const f32x4*)(xin + (size_t)row * 1024 + i * 256 + lane * 4);
    }
    if (HAS_Y) {
      f32x4 yv[4];
      float ss = 0.f;
#pragma unroll
      for (int i = 0; i < 4; ++i) {
        const u32x2 yu = *(const u32x2*)(yf + (size_t)row * 1024 + i * 256 + lane * 4);
        yv[i] = (f32x4){lo16(yu.x), hi16(yu.x), lo16(yu.y), hi16(yu.y)};
        ss += yv[i][0] * yv[i][0] + yv[i][1] * yv[i][1] + yv[i][2] * yv[i][2] + yv[i][3] * yv[i][3];
      }
      ss = wave_sum(ss);
      const float rs = rsqrtf(ss * (1.f / 1024.f) + 1e-6f);
#pragma unroll
      for (int i = 0; i < 4; ++i) {
        const int col = i * 256 + lane * 4;
        const f32x4 g4 = *(const f32x4*)(gy + col), gt = *(const f32x4*)(gate + (size_t)b * 6144 + col);
        xv[i] = xv[i] + gt * (yv[i] * rs * g4);
        if (XOUT_BF) { u32x2 pk; pk.x = pk2(xv[i][0], xv[i][1]); pk.y = pk2(xv[i][2], xv[i][3]); *(u32x2*)(xoutb + (size_t)row * 1024 + col) = pk;
                       xv[i] = (f32x4){lo16(pk.x), hi16(pk.x), lo16(pk.y), hi16(pk.y)}; }
        else *(f32x4*)(xout + (size_t)row * 1024 + col) = xv[i];
      }
    }
    if (HAS_H) {
      float ss = 0.f;
#pragma unroll
      for (int i = 0; i < 4; ++i) ss += xv[i][0] * xv[i][0] + xv[i][1] * xv[i][1] + xv[i][2] * xv[i][2] + xv[i][3] * xv[i][3];
      ss = wave_sum(ss);
      const float rs = rsqrtf(ss * (1.f / 1024.f) + 1e-6f);
#pragma unroll
      for (int i = 0; i < 4; ++i) {
        const int col = i * 256 + lane * 4;
        const f32x4 g4 = *(const f32x4*)(gh + col), s4 = *(const f32x4*)(sc + (size_t)b * 6144 + col), h4 = *(const f32x4*)(sh + (size_t)b * 6144 + col);
        const f32x4 o = (xv[i] * rs * g4) * (s4 + 1.f) + h4;
        u32x2 pk;
        pk.x = pk2(o[0], o[1]); pk.y = pk2(o[2], o[3]);
        *(u32x2*)(h + (size_t)row * 1024 + col) = pk;
      }
    }
  }
}

DEV void row_xh(int row, bf16_t* __restrict__ xb, const bf16_t* __restrict__ yf, const float* __restrict__ gy, const float* __restrict__ gate,
                const float* __restrict__ gh, const float* __restrict__ sc, const float* __restrict__ sh, int lane, f32x4 (&hv)[4]) {
  const int b = row >> 12;
  f32x4 xv[4], yv[4];
  float ss = 0.f;
#pragma unroll
  for (int i = 0; i < 4; ++i) {
    const u32x2 xu = *(const u32x2*)(xb + (size_t)row * 1024 + i * 256 + lane * 4), yu = *(const u32x2*)(yf + (size_t)row * 1024 + i * 256 + lane * 4);
    xv[i] = (f32x4){lo16(xu.x), hi16(xu.x), lo16(xu.y), hi16(xu.y)};
    yv[i] = (f32x4){lo16(yu.x), hi16(yu.x), lo16(yu.y), hi16(yu.y)};
    ss += yv[i][0] * yv[i][0] + yv[i][1] * yv[i][1] + yv[i][2] * yv[i][2] + yv[i][3] * yv[i][3];
  }
  ss = wave_sum(ss);
  const float rs = rsqrtf(ss * (1.f / 1024.f) + 1e-6f);
  float s2 = 0.f;
#pragma unroll
  for (int i = 0; i < 4; ++i) {
    const int col = i * 256 + lane * 4;
    const f32x4 g4 = *(const f32x4*)(gy + col), gt = *(const f32x4*)(gate + (size_t)b * 6144 + col);
    const f32x4 xn = xv[i] + gt * (yv[i] * rs * g4);
    u32x2 pk; pk.x = pk2(xn[0], xn[1]); pk.y = pk2(xn[2], xn[3]);
    *(u32x2*)(xb + (size_t)row * 1024 + col) = pk;
    xv[i] = (f32x4){lo16(pk.x), hi16(pk.x), lo16(pk.y), hi16(pk.y)};
    s2 += xv[i][0] * xv[i][0] + xv[i][1] * xv[i][1] + xv[i][2] * xv[i][2] + xv[i][3] * xv[i][3];
  }
  s2 = wave_sum(s2);
  const float r2 = rsqrtf(s2 * (1.f / 1024.f) + 1e-6f);
#pragma unroll
  for (int i = 0; i < 4; ++i) {
    const int col = i * 256 + lane * 4;
    const f32x4 g4 = *(const f32x4*)(gh + col), s4 = *(const f32x4*)(sc + (size_t)b * 6144 + col), h4 = *(const f32x4*)(sh + (size_t)b * 6144 + col);
    hv[i] = (xv[i] * r2 * g4) * (s4 + 1.f) + h4;
  }
}
DEV void rowpass_fold(bf16_t* __restrict__ xb, const bf16_t* __restrict__ yf, const float* __restrict__ gy, const float* __restrict__ gate,
                      const float* __restrict__ gh, const float* __restrict__ sc, const float* __restrict__ sh, bf16_t* __restrict__ hfd, float* __restrict__ h2048) {
  const int lane = tidx() & 63, gw = blockIdx.x * 8 + (tidx() >> 6), nw = gridDim.x * 8;
  for (int item = gw; item < 8 * 2048; item += nw) {
    const int b = item >> 11, s = item & 2047;
    const int rowA = b * 4096 + s, rowB = b * 4096 + (s ? 4096 - s : 2048);
    f32x4 ha[4], hb[4];
    row_xh(rowA, xb, yf, gy, gate, gh, sc, sh, lane, ha);
    row_xh(rowB, xb, yf, gy, gate, gh, sc, sh, lane, hb);
#pragma unroll
    for (int i = 0; i < 4; ++i) {
      const int col = i * 256 + lane * 4, g = col >> 7, c = col & 127;
      f32x4 f = ha[i] + hb[i], dd = ha[i] - hb[i];
      if (s == 0) { f = ha[i]; dd = (f32x4){0.f, 0.f, 0.f, 0.f}; *(f32x4*)(h2048 + b * 1024 + col) = hb[i]; }
      bf16_t* dp = hfd + (size_t)(b * 2048 + s) * 2048 + g * 256 + c;
      u32x2 pk;
      pk.x = pk2(f[0], f[1]); pk.y = pk2(f[2], f[3]); *(u32x2*)dp = pk;
      pk.x = pk2(dd[0], dd[1]); pk.y = pk2(dd[2], dd[3]); *(u32x2*)(dp + 128) = pk;
    }
  }
}

DEV void unpack8(const u32x4 u, float (&f)[8]) {
  f[0] = lo16(u.x); f[1] = hi16(u.x); f[2] = lo16(u.y); f[3] = hi16(u.y); f[4] = lo16(u.z); f[5] = hi16(u.z); f[6] = lo16(u.w); f[7] = hi16(u.w);
}
DEV u32x4 pack8(const float (&f)[8]) {
  u32x4 u;
  u.x = pk2(f[0], f[1]); u.y = pk2(f[2], f[3]); u.z = pk2(f[4], f[5]); u.w = pk2(f[6], f[7]);
  return u;
}

DEV void prep1(const P& p) {
  const bf16_t* z = (const bf16_t*)(p.ws + O_Z);
  bf16_t* za = (bf16_t*)p.out;
  bf16_t* qr = (bf16_t*)(p.ws + O_QR);
  bf16_t* kr = (bf16_t*)(p.ws + O_KR);
  bf16_t* vt = (bf16_t*)(p.ws + O_VT);
  const float* rope = (const float*)(p.ws + W_ROPE);
  const int gt = blockIdx.x * NTHR + tidx(), ngt = gridDim.x * NTHR;
  for (int idx = gt; idx < MT * 256; idx += ngt) {
    const int tok = idx >> 8, c8 = (idx & 255) * 8, s = tok & 4095;
    const bf16_t* zp = z + (size_t)tok * INC + c8;
    float zc[8], zm[8], zn[8], o[8];
    unpack8(*(const u32x4*)zp, zc);
    if (s > 0) unpack8(*(const u32x4*)(zp - INC), zm); else { for (int i = 0; i < 8; ++i) zm[i] = 0.f; }
    if (s < 4095) unpack8(*(const u32x4*)(zp + INC), zn); else { for (int i = 0; i < 8; ++i) zn[i] = 0.f; }
    float w0[8], w1[8], w2[8];
    *(f32x4*)w0 = *(const f32x4*)(p.mix_conv + c8); *(f32x4*)(w0 + 4) = *(const f32x4*)(p.mix_conv + c8 + 4);
    *(f32x4*)w1 = *(const f32x4*)(p.mix_conv + 2048 + c8); *(f32x4*)(w1 + 4) = *(const f32x4*)(p.mix_conv + 2048 + c8 + 4);
    *(f32x4*)w2 = *(const f32x4*)(p.mix_conv + 4096 + c8); *(f32x4*)(w2 + 4) = *(const f32x4*)(p.mix_conv + 4096 + c8 + 4);
#pragma unroll
    for (int i = 0; i < 8; ++i) o[i] = zm[i] * w0[i] + zc[i] * w1[i] + zn[i] * w2[i];
    *(u32x4*)(za + (size_t)tok * 2048 + c8) = pack8(o);
  }
  for (int idx = gt; idx < MT * 64; idx += ngt) {
    const int e8 = idx & 3, which = (idx >> 2) & 1, h = (idx >> 3) & 7, tok = idx >> 6, s = tok & 4095;
    const bf16_t* src = z + (size_t)tok * INC + 2048 + which * 512 + h * 64 + e8 * 8;
    float x1[8], x2[8], o1[8], o2[8];
    unpack8(*(const u32x4*)src, x1);
    unpack8(*(const u32x4*)(src + 32), x2);
    const float* rp = rope + ((size_t)s * 32 + e8 * 8) * 2;
    const float scl = which ? 1.f : 0.125f;
#pragma unroll
    for (int i = 0; i < 8; ++i) {
      const float cv = rp[2 * i], sv = rp[2 * i + 1];
      o1[i] = (x1[i] * cv - x2[i] * sv) * scl;
      o2[i] = (x2[i] * cv + x1[i] * sv) * scl;
    }
    bf16_t* dst = (which ? kr : qr) + (size_t)tok * 512 + h * 64 + e8 * 8;
    *(u32x4*)dst = pack8(o1);
    *(u32x4*)(dst + 32) = pack8(o2);
  }
  {
    bf16_t* vr = (bf16_t*)(p.ws + O_VT);
    for (int idx = gt; idx < MT * 64; idx += ngt) {
      const int tok = idx >> 6, c8 = (idx & 63) * 8;
      *(u32x4*)(vr + (size_t)tok * 512 + c8) = *(const u32x4*)(z + (size_t)tok * INC + 3072 + c8);
    }
  }
}

DEV void za_fixup(const P& p) {
  const bf16_t* sb = (const bf16_t*)(p.ws + O_SBZ);
  bf16_t* za = (bf16_t*)p.out;
  const int gt = blockIdx.x * NTHR + tidx(), ngt = gridDim.x * NTHR;
  for (int item = gt; item < 512 * 2 * 256; item += ngt) {
    const int strip = item >> 9, e = (item >> 8) & 1, c8 = (item & 255) * 8;
    const int R = strip * 64 + (e ? 63 : 0), s = R & 4095;
    const bf16_t* pc = sb + ((size_t)strip * 4 + (e ? 3 : 0)) * 2048 + c8;
    const u32x4 z0 = (u32x4){0u, 0u, 0u, 0u};
    const bool hasp = e ? true : (s > 0), hasn = e ? (s < 4095) : true;
    float zm[8], zc[8], zn[8], o[8], w0[8], w1[8], w2[8];
    unpack8(hasp ? *(const u32x4*)(pc - 2048) : z0, zm);
    unpack8(*(const u32x4*)pc, zc);
    unpack8(hasn ? *(const u32x4*)(pc + 2048) : z0, zn);
    *(f32x4*)w0 = *(const f32x4*)(p.mix_conv + c8); *(f32x4*)(w0 + 4) = *(const f32x4*)(p.mix_conv + c8 + 4);
    *(f32x4*)w1 = *(const f32x4*)(p.mix_conv + 2048 + c8); *(f32x4*)(w1 + 4) = *(const f32x4*)(p.mix_conv + 2048 + c8 + 4);
    *(f32x4*)w2 = *(const f32x4*)(p.mix_conv + 4096 + c8); *(f32x4*)(w2 + 4) = *(const f32x4*)(p.mix_conv + 4096 + c8 + 4);
#pragma unroll
    for (int i = 0; i < 8; ++i) o[i] = zm[i] * w0[i] + zc[i] * w1[i] + zn[i] * w2[i];
    *(u32x4*)(za + (size_t)R * 2048 + c8) = pack8(o);
  }
}

DEV void attention(char* lds, const P& p) {
  const bf16_t* qr = (const bf16_t*)(p.ws + O_QR);
  const bf16_t* kr = (const bf16_t*)(p.ws + O_KR);
  const bf16_t* vt = (const bf16_t*)(p.ws + O_VT);
  bf16_t* num = (bf16_t*)(p.ws + O_NUM);
  float* md = (float*)(p.ws + O_MD);
  constexpr int UNIT_LDS = 24576 + 64 * 400;
  const int tid = tidx(), w = tid >> 6, lane = tid & 63, lr = lane & 15, lq = lane >> 4;
  const int uh = tid >> 8, lt = tid & 255, mt = w & 3;
  char* ul = lds + uh * UNIT_LDS;
  u32x4 pre[12];
  bf16x8 qn[2];
  auto load_pair = [&](int pi) {
    const int unit = pi * 2 + uh;
    const int nb = unit & 63, h = (unit >> 6) & 7, b = (unit >> 9) & 7, br = unit >> 12;
    const int dsh = 2 * br, Mr = 4096 >> dsh;
    const int seg = (nb * 64) / Mr, segstart = seg * Mr, segend = segstart + Mr;
    const bool pv_ok = (nb * 64 - 64 >= segstart), nx_ok = (nb * 64 + 128 <= segend);
#pragma unroll
    for (int j = 0; j < 6; ++j) {
      const int pc = lt + 256 * j, key = pc >> 3, ch = pc & 7, kb = key >> 6;
      int blk = nb + kb - 1;
      if ((kb == 0 && !pv_ok) || (kb == 2 && !nx_ok)) blk = nb;
      const int kp = blk * 64 + (key & 63);
      const int ktok = b * 4096 + (((kp - segstart) << dsh) + seg);
      pre[j] = *(const u32x4*)(kr + (size_t)ktok * 512 + h * 64 + ch * 8);
      pre[6 + j] = *(const u32x4*)(vt + (size_t)ktok * 512 + h * 64 + ch * 8);
    }
    {
      const int qp = nb * 64 + mt * 16 + lr;
      const int qtok = b * 4096 + (((qp - segstart) << dsh) + seg);
      qn[0] = *(const bf16x8*)(qr + (size_t)qtok * 512 + h * 64 + lq * 8);
      qn[1] = *(const bf16x8*)(qr + (size_t)qtok * 512 + h * 64 + 32 + lq * 8);
    }
  };
  const int npairs = 3 * 4096 / 2;
  int pi = blockIdx.x;
  if (pi < npairs) load_pair(pi);
  for (; pi < npairs; pi += gridDim.x) {
#pragma unroll
    for (int j = 0; j < 6; ++j) {
      const int pc = lt + 256 * j, key = pc >> 3, ch = pc & 7;
      *(u32x4*)(ul + key * 128 + ((ch ^ (key & 7)) * 16)) = pre[j];
    }
#pragma unroll
    for (int j = 0; j < 6; ++j) {
      const int pc = lt + 256 * j, key = pc >> 3, ch = pc & 7;
      bf16_t* vd = (bf16_t*)(ul + 24576 + (ch * 8) * 400) + (key ^ (ch << 2));
      const u32x4 u = pre[6 + j];
      vd[0 * 200] = (bf16_t)(u.x & 0xffff); vd[1 * 200] = (bf16_t)(u.x >> 16); vd[2 * 200] = (bf16_t)(u.y & 0xffff); vd[3 * 200] = (bf16_t)(u.y >> 16);
      vd[4 * 200] = (bf16_t)(u.z & 0xffff); vd[5 * 200] = (bf16_t)(u.z >> 16); vd[6 * 200] = (bf16_t)(u.w & 0xffff); vd[7 * 200] = (bf16_t)(u.w >> 16);
    }
    __syncthreads();
    const int unit = pi * 2 + uh;
    const int nb = unit & 63, h = (unit >> 6) & 7, b = (unit >> 9) & 7, br = unit >> 12;
    const int dsh = 2 * br, Mr = 4096 >> dsh;
    const int seg = (nb * 64) / Mr, segstart = seg * Mr, segend = segstart + Mr;
    const bool pv_ok = (nb * 64 - 64 >= segstart), nx_ok = (nb * 64 + 128 <= segend);
    const int qp = nb * 64 + mt * 16 + lr;
    const int qtok = b * 4096 + (((qp - segstart) << dsh) + seg);
    bf16x8 qf[2];
    qf[0] = qn[0]; qf[1] = qn[1];
    if (pi + (int)gridDim.x < npairs) load_pair(pi + gridDim.x);
    f32x4 sacc[12];
#pragma unroll
    for (int kt = 0; kt < 12; ++kt) {
      const int key = kt * 16 + lr;
      const bf16x8 k0 = *(const bf16x8*)(ul + key * 128 + ((lq ^ (key & 7)) * 16));
      const bf16x8 k1 = *(const bf16x8*)(ul + key * 128 + (((4 + lq) ^ (key & 7)) * 16));
      f32x4 a = (f32x4){0.f, 0.f, 0.f, 0.f};
      a = __builtin_amdgcn_mfma_f32_16x16x32_bf16(k0, qf[0], a, 0, 0, 0);
      a = __builtin_amdgcn_mfma_f32_16x16x32_bf16(k1, qf[1], a, 0, 0, 0);
      sacc[kt] = a;
    }
    const int qi = mt * 16 + lr;
    float mx = -1e30f;
#pragma unroll
    for (int kt = 0; kt < 12; ++kt) {
      const int kb = kt >> 2;
#pragma unroll
      for (int r = 0; r < 4; ++r) {
        const int kj = (kt & 3) * 16 + lq * 4 + r;
        bool ok = true;
        if (kb == 0) ok = pv_ok && (kj >= qi);
        if (kb == 2) ok = nx_ok && (kj <= qi);
        const float sv = ok ? sacc[kt][r] : -1e30f;
        sacc[kt][r] = sv;
        mx = fmaxf(mx, sv);
      }
    }
    mx = fmaxf(mx, __shfl_xor(mx, 16));
    mx = fmaxf(mx, __shfl_xor(mx, 32));
    float den = 0.f;
#pragma unroll
    for (int kt = 0; kt < 12; ++kt)
#pragma unroll
      for (int r = 0; r < 4; ++r) {
        const float pe = __expf(sacc[kt][r] - mx);
        sacc[kt][r] = pe;
        den += pe;
      }
    den += __shfl_xor(den, 16);
    den += __shfl_xor(den, 32);
    f32x4 oacc[4];
#pragma unroll
    for (int et = 0; et < 4; ++et) oacc[et] = (f32x4){0.f, 0.f, 0.f, 0.f};
#pragma unroll
    for (int t = 0; t < 6; ++t) {
      u32x4 pu;
      pu.x = pk2(sacc[2 * t][0], sacc[2 * t][1]); pu.y = pk2(sacc[2 * t][2], sacc[2 * t][3]);
      pu.z = pk2(sacc[2 * t + 1][0], sacc[2 * t + 1][1]); pu.w = pk2(sacc[2 * t + 1][2], sacc[2 * t + 1][3]);
      const bf16x8 pf = __builtin_bit_cast(bf16x8, pu);
#pragma unroll
      for (int et = 0; et < 4; ++et) {
        const char* vrow = ul + 24576 + (et * 16 + lr) * 400;
        const int sw = ((et * 2 + (lr >> 3)) & 7) << 2;
        const u32x2 v0 = *(const u32x2*)(vrow + (((2 * t) * 16 + lq * 4) ^ sw) * 2), v1 = *(const u32x2*)(vrow + (((2 * t + 1) * 16 + lq * 4) ^ sw) * 2);
        u32x4 vu;
        vu.x = v0.x; vu.y = v0.y; vu.z = v1.x; vu.w = v1.y;
        oacc[et] = __builtin_amdgcn_mfma_f32_16x16x32_bf16(__builtin_bit_cast(bf16x8, vu), pf, oacc[et], 0, 0, 0);
      }
    }
    bf16_t* np = num + ((size_t)br * MT + qtok) * 512 + h * 64 + lq * 4;
#pragma unroll
    for (int et = 0; et < 4; ++et) { u32x2 w; w.x = pk2(oacc[et][0], oacc[et][1]); w.y = pk2(oacc[et][2], oacc[et][3]); *(u32x2*)(np + et * 16) = w; }
    if (lq == 0) {
      f32x2 o;
      o.x = mx; o.y = den;
      *(f32x2*)(md + (((size_t)br * MT + qtok) * 8 + h) * 2) = o;
    }
    __syncthreads();
  }
}

DEV void combineA(const P& p) {
  const bf16_t* num = (const bf16_t*)(p.ws + O_NUM);
  const float* md = (const float*)(p.ws + O_MD);
  bf16_t* ycat = (bf16_t*)(p.ws + O_YCAT);
  const int gt = blockIdx.x * NTHR + tidx(), ngt = gridDim.x * NTHR;
  for (int idx = gt; idx < MT * 128; idx += ngt) {
    const int e4 = idx & 15, h = (idx >> 4) & 7, tok = idx >> 7;
    f32x2 m0 = *(const f32x2*)(md + (((size_t)0 * MT + tok) * 8 + h) * 2);
    f32x2 m1 = *(const f32x2*)(md + (((size_t)1 * MT + tok) * 8 + h) * 2);
    f32x2 m2 = *(const f32x2*)(md + (((size_t)2 * MT + tok) * 8 + h) * 2);
    const float ma = fmaxf(m0.x, fmaxf(m1.x, m2.x));
    const float e0 = __expf(m0.x - ma), e1 = __expf(m1.x - ma), e2 = __expf(m2.x - ma);
    const float dn = e0 * m0.y + e1 * m1.y + e2 * m2.y;
    const u32x2 u0 = *(const u32x2*)(num + ((size_t)0 * MT + tok) * 512 + h * 64 + e4 * 4);
    const u32x2 u1 = *(const u32x2*)(num + ((size_t)1 * MT + tok) * 512 + h * 64 + e4 * 4);
    const u32x2 u2 = *(const u32x2*)(num + ((size_t)2 * MT + tok) * 512 + h * 64 + e4 * 4);
    const f32x4 n0 = (f32x4){lo16(u0.x), hi16(u0.x), lo16(u0.y), hi16(u0.y)}, n1 = (f32x4){lo16(u1.x), hi16(u1.x), lo16(u1.y), hi16(u1.y)},
                n2 = (f32x4){lo16(u2.x), hi16(u2.x), lo16(u2.y), hi16(u2.y)};
    const f32x4 o = (n0 * e0 + n1 * e1 + n2 * e2) * (1.f / dn);
    u32x2 pk;
    pk.x = pk2(o[0], o[1]); pk.y = pk2(o[2], o[3]);
    *(u32x2*)(ycat + (size_t)tok * 1024 + 512 + h * 64 + e4 * 4) = pk;
  }
}

DEV float dpp_allreduce16(float x) {
  x += __int_as_float(__builtin_amdgcn_update_dpp(0, __float_as_int(x), 0xB1, 0xF, 0xF, true));
  x += __int_as_float(__builtin_amdgcn_update_dpp(0, __float_as_int(x), 0x4E, 0xF, 0xF, true));
  x += __int_as_float(__builtin_amdgcn_update_dpp(0, __float_as_int(x), 0x141, 0xF, 0xF, true));
  x += __int_as_float(__builtin_amdgcn_update_dpp(0, __float_as_int(x), 0x140, 0xF, 0xF, true));
  return x;
}

DEV void scan_phase(char* lds, const P& p) {
  const bf16_t* omw = (const bf16_t*)(p.ws + O_OMW);
  const bf16_t* kd = (const bf16_t*)(p.ws + O_KD);
  const bf16_t* kka = (const bf16_t*)(p.ws + O_KKA);
  const bf16_t* kk = (const bf16_t*)(p.ws + O_KK);
  const bf16_t* za = (const bf16_t*)p.out;
  bf16_t* Y = (bf16_t*)(p.ws + O_Y);
  float* inb = (float*)lds;
  float* ypart = (float*)(lds + 98304);
  const int tid = tidx(), w = tid >> 6, lane = tid & 63, rg = lane >> 4, jl = lane & 15, j0 = jl * 4;
  for (int it = blockIdx.x; it < 256; it += gridDim.x) {
    const int sc = it >> 1, half = it & 1, d = sc >> 6, b = (sc >> 3) & 7, h = sc & 7;
    if (w >= 4) {
      const int lt = tid - 256;
      const bf16_t* src[6];
      int dsto[6], stepi[6], isw[6];
#pragma unroll
      for (int q = 0; q < 6; ++q) {
        const int pid = lt + q * 256, i = pid / 48, rem = pid % 48, arr = rem >> 3, pc = rem & 7;
        const bf16_t* base;
        size_t ld;
        if (arr == 0) { base = omw + (size_t)d * MT * 512 + h * 64; ld = 512; }
        else if (arr == 1) { base = kd + (size_t)d * MT * 512 + h * 64; ld = 512; }
        else if (arr == 2) { base = kka + (size_t)d * MT * 512 + h * 64; ld = 512; }
        else if (arr == 3) { base = kk + h * 64; ld = 512; }
        else if (arr == 4) { base = za + h * 64; ld = 2048; }
        else { base = za + 1024 + h * 64; ld = 2048; }
        const int t0 = d ? (4095 - i) : i;
        src[q] = base + ((size_t)(b * 4096 + t0)) * ld + pc * 8;
        stepi[q] = (int)ld * 32 * (d ? -1 : 1);
        dsto[q] = i * 384 + arr * 64 + pc * 8;
        isw[q] = (arr == 0);
      }
      u32x4 rr[6];
#pragma unroll
      for (int q = 0; q < 6; ++q) rr[q] = *(const u32x4*)(src[q]);
#pragma unroll
      for (int q = 0; q < 6; ++q) {
        float f[8];
        unpack8(rr[q], f);
        if (isw[q]) { for (int i = 0; i < 8; ++i) f[i] = 1.f - f[i]; }
        *(f32x4*)(inb + dsto[q]) = (f32x4){f[0], f[1], f[2], f[3]};
        *(f32x4*)(inb + dsto[q] + 4) = (f32x4){f[4], f[5], f[6], f[7]};
      }
#pragma unroll
      for (int q = 0; q < 6; ++q) rr[q] = *(const u32x4*)(src[q] + (ptrdiff_t)stepi[q]);
      __syncthreads();
      for (int c = 0; c < 128; ++c) {
        if (c + 1 < 128) {
          float* nb_ = inb + ((c + 1) & 1) * 12288;
#pragma unroll
          for (int q = 0; q < 6; ++q) {
            float f[8];
            unpack8(rr[q], f);
            if (isw[q]) { for (int i = 0; i < 8; ++i) f[i] = 1.f - f[i]; }
            *(f32x4*)(nb_ + dsto[q]) = (f32x4){f[0], f[1], f[2], f[3]};
            *(f32x4*)(nb_ + dsto[q] + 4) = (f32x4){f[4], f[5], f[6], f[7]};
          }
        }
        if (c + 2 < 128) {
#pragma unroll
          for (int q = 0; q < 6; ++q) rr[q] = *(const u32x4*)(src[q] + (ptrdiff_t)stepi[q] * (c + 2));
        }
        if (c > 0) {
          const int cc = c - 1, idx = lt * 4, i = idx >> 5, rl = idx & 31;
          const int t = d ? (4095 - (cc * 32 + i)) : (cc * 32 + i);
          const float* q = ypart + (cc & 1) * 4096 + i * 128 + rl;
          const f32x4 o = (*(const f32x4*)q + *(const f32x4*)(q + 32)) + (*(const f32x4*)(q + 64) + *(const f32x4*)(q + 96));
          u32x2 ow; ow.x = pk2(o[0], o[1]); ow.y = pk2(o[2], o[3]);
          *(u32x2*)(Y + ((size_t)d * MT + b * 4096 + t) * 512 + h * 64 + half * 32 + rl) = ow;
        }
        __syncthreads();
      }
      {
        const int cc = 127, idx = lt * 4, i = idx >> 5, rl = idx & 31;
        const int t = d ? (4095 - (cc * 32 + i)) : (cc * 32 + i);
        const float* q = ypart + (cc & 1) * 4096 + i * 128 + rl;
        const f32x4 o = (*(const f32x4*)q + *(const f32x4*)(q + 32)) + (*(const f32x4*)(q + 64) + *(const f32x4*)(q + 96));
        u32x2 ow; ow.x = pk2(o[0], o[1]); ow.y = pk2(o[2], o[3]);
        *(u32x2*)(Y + ((size_t)d * MT + b * 4096 + t) * 512 + h * 64 + half * 32 + rl) = ow;
      }
    } else {
      const int rowl = w * 8 + rg * 2, row = half * 32 + rowl;
      f32x2 a01 = (f32x2){0.f, 0.f}, a23 = a01, b01 = a01, b23 = a01;
      __syncthreads();
      for (int c = 0; c < 128; ++c) {
        const float* cur = inb + (c & 1) * 12288;
        float* yp = ypart + (c & 1) * 4096 + (jl >> 2) * 32 + rowl;
        f32x4 w4 = *(const f32x4*)(cur + j0), kd4 = *(const f32x4*)(cur + 64 + j0), ka4 = *(const f32x4*)(cur + 128 + j0),
              kk4 = *(const f32x4*)(cur + 192 + j0), r4 = *(const f32x4*)(cur + 256 + j0);
        f32x2 v2 = *(const f32x2*)(cur + 320 + row);
#pragma unroll 8
        for (int i = 0; i < 32; ++i) {
          const float* sn = cur + ((i + 1) & 31) * 384;
          const f32x4 nw4 = *(const f32x4*)(sn + j0), nkd4 = *(const f32x4*)(sn + 64 + j0), nka4 = *(const f32x4*)(sn + 128 + j0),
                      nkk4 = *(const f32x4*)(sn + 192 + j0), nr4 = *(const f32x4*)(sn + 256 + j0);
          const f32x2 nv2 = *(const f32x2*)(sn + 320 + row);
          const f32x2 ta = a01 * kk4.xy + a23 * kk4.zw, tb = b01 * kk4.xy + b23 * kk4.zw;
          const float ska = dpp_allreduce16(ta.x + ta.y), skb = dpp_allreduce16(tb.x + tb.y);
          a01 = a01 * w4.xy + (kd4.xy * v2.x - ka4.xy * ska);
          a23 = a23 * w4.zw + (kd4.zw * v2.x - ka4.zw * ska);
          b01 = b01 * w4.xy + (kd4.xy * v2.y - ka4.xy * skb);
          b23 = b23 * w4.zw + (kd4.zw * v2.y - ka4.zw * skb);
          const f32x2 ua = a01 * r4.xy + a23 * r4.zw, ub = b01 * r4.xy + b23 * r4.zw;
          f32x2 y;
          y.x = ua.x + ua.y; y.y = ub.x + ub.y;
          y.x += __int_as_float(__builtin_amdgcn_update_dpp(0, __float_as_int(y.x), 0xB1, 0xF, 0xF, true));
          y.y += __int_as_float(__builtin_amdgcn_update_dpp(0, __float_as_int(y.y), 0xB1, 0xF, 0xF, true));
          y.x += __int_as_float(__builtin_amdgcn_update_dpp(0, __float_as_int(y.x), 0x4E, 0xF, 0xF, true));
          y.y += __int_as_float(__builtin_amdgcn_update_dpp(0, __float_as_int(y.y), 0x4E, 0xF, 0xF, true));
          *(f32x2*)(yp + i * 128) = y;
          w4 = nw4; kd4 = nkd4; ka4 = nka4; kk4 = nkk4; r4 = nr4; v2 = nv2;
        }
        __syncthreads();
      }
    }
    __syncthreads();
  }
}

DEV void postB(const P& p) {
  const bf16_t* Y = (const bf16_t*)(p.ws + O_Y);
  const bf16_t* kd = (const bf16_t*)(p.ws + O_KD);
  const bf16_t* gg = (const bf16_t*)(p.ws + O_G);
  const bf16_t* za = (const bf16_t*)p.out;
  bf16_t* ycat = (bf16_t*)(p.ws + O_YCAT);
  const int lane = tidx() & 63, sub = lane >> 4, jl = lane & 15, gw = blockIdx.x * 8 + (tidx() >> 6), nw = gridDim.x * 8;
  for (int it = gw; it < MT * 2; it += nw) {
    const int item = it * 4 + sub, tok = item >> 3, h = item & 7, c = h * 64 + jl * 4;
    const u32x2 yu0 = *(const u32x2*)(Y + (size_t)tok * 512 + c), yu1 = *(const u32x2*)(Y + ((size_t)MT + tok) * 512 + c);
    const f32x4 y0 = (f32x4){lo16(yu0.x), hi16(yu0.x), lo16(yu0.y), hi16(yu0.y)}, y1 = (f32x4){lo16(yu1.x), hi16(yu1.x), lo16(yu1.y), hi16(yu1.y)};
    const u32x2 k0 = *(const u32x2*)(kd + (size_t)tok * 512 + c), k1 = *(const u32x2*)(kd + ((size_t)MT + tok) * 512 + c);
    const u32x2 ru = *(const u32x2*)(za + (size_t)tok * 2048 + c), vu = *(const u32x2*)(za + (size_t)tok * 2048 + 1024 + c), gu = *(const u32x2*)(gg + (size_t)tok * 512 + c);
    const f32x4 lw = *(const f32x4*)(p.lnx_w + c), lb = *(const f32x4*)(p.lnx_b + c), rk = *(const f32x4*)(p.r_k + c);
    const f32x4 y = y0 + y1;
    const float mu = dpp_allreduce16((y[0] + y[1]) + (y[2] + y[3])) * (1.f / 64.f);
    const f32x4 dv = y - mu;
    const float var = dpp_allreduce16((dv[0] * dv[0] + dv[1] * dv[1]) + (dv[2] * dv[2] + dv[3] * dv[3])) * (1.f / 64.f);
    const float rs = rsqrtf(var + 64e-5f);
    const f32x4 r = (f32x4){lo16(ru.x), hi16(ru.x), lo16(ru.y), hi16(ru.y)}, v = (f32x4){lo16(vu.x), hi16(vu.x), lo16(vu.y), hi16(vu.y)};
    const f32x4 g = (f32x4){lo16(gu.x), hi16(gu.x), lo16(gu.y), hi16(gu.y)};
    const f32x4 kds = (f32x4){lo16(k0.x) + lo16(k1.x), hi16(k0.x) + hi16(k1.x), lo16(k0.y) + lo16(k1.y), hi16(k0.y) + hi16(k1.y)};
    const f32x4 t = r * kds * rk;
    const float bs = dpp_allreduce16((t[0] + t[1]) + (t[2] + t[3]));
    const f32x4 o = (dv * rs * lw + lb + v * bs) * g;
    u32x2 pk;
    pk.x = pk2(o[0], o[1]); pk.y = pk2(o[2], o[3]);
    *(u32x2*)(ycat + (size_t)tok * 1024 + c) = pk;
  }
}

DEV void glu_fixup(const P& p, int l) {
  const bf16_t* sb = (const bf16_t*)(p.ws + O_SB);
  bf16_t* act = (bf16_t*)(p.ws + O_ACT);
  const float* cw = p.ffn_conv + (size_t)l * 3 * 5632;
  const int gt = blockIdx.x * NTHR + tidx(), ngt = gridDim.x * NTHR;
  for (int item = gt; item < 512 * 2 * 352; item += ngt) {
    const int strip = item / 704, rem = item - strip * 704, e = rem / 352, c8 = (rem - e * 352) * 8;
    const int R = strip * 64 + (e ? 63 : 0), s = R & 4095;
    const int colg = (c8 >> 7) * 256 + (c8 & 127);
    const bf16_t* pc = sb + ((size_t)strip * 4 + (e ? 3 : 0)) * 5632 + colg;
    const bf16_t* pp = e ? (pc - 5632) : (pc - 5632);
    const bf16_t* pn = e ? (pc + 5632) : (pc + 5632);
    const u32x4 z0 = (u32x4){0u, 0u, 0u, 0u};
    const bool hasp = e ? true : (s > 0), hasn = e ? (s < 4095) : true;
    float gm[8], gc[8], gn[8], vm[8], vc[8], vn[8], o[8];
    unpack8(hasp ? *(const u32x4*)pp : z0, gm); unpack8(hasp ? *(const u32x4*)(pp + 128) : z0, vm);
    unpack8(*(const u32x4*)pc, gc); unpack8(*(const u32x4*)(pc + 128), vc);
    unpack8(hasn ? *(const u32x4*)pn : z0, gn); unpack8(hasn ? *(const u32x4*)(pn + 128) : z0, vn);
#pragma unroll
    for (int i = 0; i < 8; ++i) {
      const float g = gm[i] * cw[c8 + i] + gc[i] * cw[5632 + c8 + i] + gn[i] * cw[11264 + c8 + i];
      const float vv = vm[i] * cw[2816 + c8 + i] + vc[i] * cw[5632 + 2816 + c8 + i] + vn[i] * cw[11264 + 2816 + c8 + i];
      const float u2 = -1.5957691216057308f * (g + 0.044715f * g * g * g);
      o[i] = g * __builtin_amdgcn_rcpf(1.f + __expf(u2)) * vv;
    }
    *(u32x4*)(act + (size_t)R * 2816 + c8) = pack8(o);
  }
}

template <class Epi>
DEV void gemm_grid(char* lds, const bf16_t* A, int lda, const bf16_t* Bt, int ldb, int K, int tilesM, int tilesN, const Epi& epi) {
  const int nt = tilesM * tilesN;
  u32x4 ra[4], rb[2];
  int t = blockIdx.x;
  if (t < nt) gemm_first_load(A + (size_t)(t / tilesN) * 256 * lda, lda, Bt + (size_t)(t % tilesN) * 128 * ldb, ldb, ra, rb);
  for (; t < nt; t += gridDim.x) {
    const int tm = t / tilesN, tn = t % tilesN, t2 = t + gridDim.x;
    const bf16_t* An = (t2 < nt) ? A + (size_t)(t2 / tilesN) * 256 * lda : nullptr;
    const bf16_t* Bn = (t2 < nt) ? Bt + (size_t)(t2 % tilesN) * 128 * ldb : nullptr;
    gemm_tile(lds, A + (size_t)tm * 256 * lda, lda, Bt + (size_t)tn * 128 * ldb, ldb, K, tm * 256, tn * 128, epi, ra, rb, An, Bn);
  }
}


DEV void dft_fold(const P& p) {
  const bf16_t* CST = (const bf16_t*)(p.ws + O_CST);
  bf16_t* CF = (bf16_t*)(p.ws + O_CSTF);
  for (int idx = blockIdx.x * NTHR + tidx(); idx < 16384 * 256; idx += gridDim.x * NTHR) {
    const int r = idx >> 8, s8 = (idx & 255) * 8, eo = (r >> 10) & 1;
    const bf16_t* src = CST + (size_t)r * 4096;
    float a[8], bq[8], o[8];
    unpack8(*(const u32x4*)(src + s8), a);
    if (s8 == 0) {
      unpack8(*(const u32x4*)(src + 4088), bq);
      o[0] = eo ? 0.f : a[0];
#pragma unroll
      for (int i = 1; i < 8; ++i) o[i] = eo ? (a[i] - bq[8 - i]) : (a[i] + bq[8 - i]);
      if (!eo) ((float*)(p.ws + O_C2048))[(r >> 11) * 1024 + (r & 1023)] = bf2f(src[2048]) * (1.f / 64.f);
    } else {
      unpack8(*(const u32x4*)(src + 4096 - s8 - 8), bq);
      const float b0 = bf2f(src[4096 - s8]);
      o[0] = eo ? (a[0] - b0) : (a[0] + b0);
#pragma unroll
      for (int i = 1; i < 8; ++i) o[i] = eo ? (a[i] - bq[8 - i]) : (a[i] + bq[8 - i]);
    }
    *(u32x4*)(CF + (size_t)r * 2048 + s8) = pack8(o);
  }
}

DEV void dft_combine(const P& p) {
  const bf16_t* EO = (const bf16_t*)(p.ws + O_EO);
  const bf16_t* CST = (const bf16_t*)(p.ws + O_CST);
  bf16_t* f = (bf16_t*)(p.ws + O_F);
  for (int idx = blockIdx.x * NTHR + tidx(); idx < 8 * 2048 * 256; idx += gridDim.x * NTHR) {
    const int c4 = (idx & 255) * 4, k1 = (idx >> 8) & 2047, b = idx >> 19;
    const u32x2 eu = *(const u32x2*)(EO + ((size_t)(b * 2) * 2048 + k1) * 1024 + c4), ou = *(const u32x2*)(EO + ((size_t)(b * 2 + 1) * 2048 + k1) * 1024 + c4);
    f32x4 e = (f32x4){lo16(eu.x), hi16(eu.x), lo16(eu.y), hi16(eu.y)};
    const f32x4 o = (f32x4){lo16(ou.x), hi16(ou.x), lo16(ou.y), hi16(ou.y)};
    {
      const f32x4 cm = *(const f32x4*)((const float*)(p.ws + O_C2048) + b * 1024 + c4);
      e = (k1 & 1) ? (e - cm) : (e + cm);
    }
    const f32x4 d = e - o, s = e + o;
    u32x2 pk;
    pk.x = pk2(d[0], d[1]); pk.y = pk2(d[2], d[3]);
    *(u32x2*)(f + ((size_t)b * 4096 + k1) * 1024 + c4) = pk;
    if (k1 > 0) {
      pk.x = pk2(s[0], s[1]); pk.y = pk2(s[2], s[3]);
      *(u32x2*)(f + ((size_t)b * 4096 + 4096 - k1) * 1024 + c4) = pk;
    }
  }
  for (int r = blockIdx.x * NTHR + tidx(); r < 8 * 1024; r += gridDim.x * NTHR) {
    const float* cc = (const float*)(p.ws + O_C2048);
    f[((size_t)(r >> 10) * 4096 + 2048) * 1024 + (r & 1023)] = f2bf(cc[16384 + r] + cc[r]);
  }
}
DEV void dft_altsum(const P& p) {
  const int lane = tidx() & 63, gw = blockIdx.x * 8 + (tidx() >> 6), nw = gridDim.x * 8;
  const bf16_t* CF = (const bf16_t*)(p.ws + O_CSTF);
  for (int r = gw; r < 8 * 1024; r += nw) {
    const int b = r >> 10, n = r & 1023;
    const bf16_t* cp = CF + ((size_t)(b * 2) * 1024 + n) * 2048;
    float acc = 0.f;
#pragma unroll
    for (int j = 0; j < 4; ++j) {
      const u32x4 u = *(const u32x4*)(cp + j * 512 + lane * 8);
      acc += (lo16(u.x) - hi16(u.x)) + (lo16(u.y) - hi16(u.y)) + (lo16(u.z) - hi16(u.z)) + (lo16(u.w) - hi16(u.w));
    }
    acc = wave_sum(acc);
    if (lane == 0) ((bf16_t*)(p.ws + O_F))[((size_t)b * 4096 + 2048) * 1024 + n] = f2bf(acc * (1.f / 64.f) + ((const float*)(p.ws + O_C2048))[r]);
  }
}

#define LDSP ((PG8_LAS unsigned char*)lds)
template <class Epi>
DEV void pgemm(char* lds, const bf16_t* A, const bf16_t* Bt, int M_, int N_, int K_, const Epi& E) {
  pg8::Gemm g{A, Bt, M_, N_, K_};
  pg8::StaticOrder S;
  S.init(M_, N_, (int)gridDim.x, (int)blockIdx.x);
  pg8::gemm_phase<Epi, pg8::StaticOrder, true, true>(LDSP, g, S, E);
}

DEV void ffn(char* lds, const XcdBarrier& xbar, const P& p, int l) {
  const bf16_t* h = (const bf16_t*)(p.ws + O_H);
  bf16_t* act = (bf16_t*)(p.ws + O_ACT);
  bf16_t* yf = (bf16_t*)(p.ws + O_YF);
  const bf16_t* upt = (const bf16_t*)(p.ws + W_UP) + (size_t)l * 5632 * 1024;
  const bf16_t* dnt = (const bf16_t*)(p.ws + W_DOWN) + (size_t)l * 1024 * 2816;
  pgemm(lds, h, upt, MT, 5632, 1024, pg8::PEpiGlu{act, (bf16_t*)(p.ws + O_SB), p.ffn_conv + (size_t)l * 3 * 5632});
  xcd_barrier(xbar);
  glu_fixup(p, l);
  xcd_barrier(xbar);
  pgemm(lds, act, dnt, MT, 1024, 2816, pg8::PEpiBf16<false>{yf, 1024});
  xcd_barrier(xbar);
}

DEV const P& kargs() {
  auto q = __builtin_amdgcn_kernarg_segment_ptr();
  asm volatile("" : "+s"(q));
  return *(const P*)q;
}
#define p (kargs())
__global__ void __launch_bounds__(NTHR) mega(P parg_unused) {
  extern __shared__ __attribute__((aligned(16))) char lds[];
  cg::grid_group grid = cg::this_grid();
  char* ws = p.ws;
  if (tidx() < 4) ((unsigned*)(lds + 131072))[tidx()] = 0u;
  __syncthreads();
  const XcdBarrier xbar = xcd_barrier_post((unsigned*)(ws + W_BAR), (volatile XLAS unsigned*)(lds + 131072));
  float* mod = (float*)(ws + W_MOD);
  const int gt = blockIdx.x * NTHR + tidx(), ngt = gridDim.x * NTHR;

  for (int rep_ = 0; rep_ < REP_PRO; ++rep_) {
  if (rep_ > 0) xcd_barrier(xbar);
  compute_mod(lds, p);
  transpose_convert(lds, p.mix_in, 1024, 3584, (bf16_t*)(ws + W_MIXIN), 1024, 0, 2);
  for (int l = 0; l < 2; ++l) {
    transpose_convert(lds, p.ffn_up + (size_t)l * 1024 * 5632, 1024, 5632, (bf16_t*)(ws + W_UP) + (size_t)l * 5632 * 1024, 1024, 64 * l, 1);
    transpose_convert(lds, p.ffn_down + (size_t)l * 2816 * 1024, 2816, 1024, (bf16_t*)(ws + W_DOWN) + (size_t)l * 1024 * 2816, 2816, 128 + 64 * l);
  }
  transpose_convert(lds, p.mix_out, 1024, 1024, (bf16_t*)(ws + W_MIXOUT), 1024, 32);
  transpose_convert(lds, p.fnet_w, 1024, 1024, (bf16_t*)(ws + W_FNET), 1024, 96);
  for (int d = 0; d < 2; ++d) {
    transpose_convert(lds, p.w1 + (size_t)d * 512 * 64, 512, 64, (bf16_t*)(ws + W_L1) + (size_t)(d * 64) * 512, 512, 8 * d);
    transpose_convert(lds, p.a1 + (size_t)d * 512 * 64, 512, 64, (bf16_t*)(ws + W_L1) + (size_t)(128 + d * 64) * 512, 512, 16 + 8 * d);
    transpose_convert(lds, p.w2 + (size_t)d * 64 * 512, 64, 512, (bf16_t*)(ws + W_W2) + (size_t)d * 512 * 64, 64, 48 + 8 * d);
    transpose_convert(lds, p.a2 + (size_t)d * 64 * 512, 64, 512, (bf16_t*)(ws + W_A2) + (size_t)d * 512 * 64, 64, 64 + 8 * d);
  }
  transpose_convert(lds, p.g1, 512, 128, (bf16_t*)(ws + W_L1) + (size_t)256 * 512, 512, 32);
  transpose_convert(lds, p.g2, 128, 512, (bf16_t*)(ws + W_G2), 128, 80);
  {
    float* rope = (float*)(ws + W_ROPE);
    for (int idx = gt; idx < 4096 * 32; idx += ngt) {
      const int s = idx >> 5, e = idx & 31;
      const float inv = powf(10000.f, -(float)e / 32.f);
      const float ang = (float)s * inv;
      float sv, cv;
      sincosf(ang, &sv, &cv);
      rope[2 * idx] = cv;
      rope[2 * idx + 1] = sv;
    }
    bf16_t* dftc = (bf16_t*)(ws + W_DFTC);
    for (int idx = gt; idx < 256 * 256; idx += ngt) {
      const int n = idx >> 8, cc = idx & 255, c = cc & 127, k2 = n & 127;
      const float ph = (float)((k2 * c) & 127) * (1.f / 64.f);
      float v = 0.f;
      if (n < 128 && cc < 128) v = cospif(ph);
      if (n >= 128 && cc >= 128) v = sinpif(ph);
      dftc[idx] = f2bf(v * 0.08838834764831845f);
    }
  }
  }
  grid.sync();
  for (int rep_ = 0; rep_ < REP_ROW; ++rep_) { rowpass<false, true>(p.x, nullptr, nullptr, nullptr, nullptr, p.norm_g, mod + 1024, mod, (bf16_t*)(ws + O_H0)); xcd_barrier(xbar); }
  pgemm(lds, (const bf16_t*)(ws + O_H0), (const bf16_t*)(ws + W_MIXIN), MT, INC, 1024,
        pg8::PEpiMixIn{(bf16_t*)p.out, (bf16_t*)(ws + O_SBZ), (bf16_t*)(ws + O_QR), (bf16_t*)(ws + O_KR), (bf16_t*)(ws + O_VT), p.mix_conv, (const float*)(ws + W_ROPE)});
  xcd_barrier(xbar);
  za_fixup(p);
  for (int rep_ = 0; rep_ < REP_ATT; ++rep_) { attention(lds, p); xcd_barrier(xbar); }
  combineA(p);
  gemm_grid(lds, (const bf16_t*)p.out + 1536, 2048, (const bf16_t*)(ws + W_L1), 512, 512, 128, 3, EpiLora1{(bf16_t*)(ws + O_L1)});
  xcd_barrier(xbar);
  for (int rep_ = 0; rep_ < REP_LORA; ++rep_) {
  for (int d = 0; d < 2; ++d) {
    gemm_grid(lds, (const bf16_t*)(ws + O_L1) + d * 64, 384, (const bf16_t*)(ws + W_W2) + (size_t)d * 512 * 64, 64, 64, 128, 4,
              EpiDecay{(bf16_t*)(ws + O_OMW) + (size_t)d * MT * 512, p.w0 + d * 512});
    gemm_grid(lds, (const bf16_t*)(ws + O_L1) + 128 + d * 64, 384, (const bf16_t*)(ws + W_A2) + (size_t)d * 512 * 64, 64, 64, 128, 4,
              EpiA{(bf16_t*)(ws + O_KD) + (size_t)d * MT * 512, (bf16_t*)(ws + O_KKA) + (size_t)d * MT * 512, (bf16_t*)(ws + O_KK), p.a0 + d * 512,
                   p.k_k, p.k_a, (const bf16_t*)p.out, d == 0});
  }
  gemm_grid(lds, (const bf16_t*)(ws + O_L1) + 256, 384, (const bf16_t*)(ws + W_G2), 128, 128, 128, 4, EpiBf16{(bf16_t*)(ws + O_G), 512});
  xcd_barrier(xbar);
  }
  for (int rep_ = 0; rep_ < REP_SCAN; ++rep_) { scan_phase(lds, p); xcd_barrier(xbar); }
  for (int rep_ = 0; rep_ < REP_SYNC; ++rep_) xcd_barrier(xbar);
  postB(p);
  xcd_barrier(xbar);
  pgemm(lds, (const bf16_t*)(ws + O_YCAT), (const bf16_t*)(ws + W_MIXOUT), MT, 1024, 1024, pg8::PEpiBf16<false>{(bf16_t*)(ws + O_YF), 1024});
  xcd_barrier(xbar);
  rowpass<true, true, false, true>(p.x, (const bf16_t*)(ws + O_YF), p.norm_g + 1024, mod + 2048, ws + O_XB, p.norm_g + 2048, mod + 4096, mod + 3072, (bf16_t*)(ws + O_H));
  xcd_barrier(xbar);
  ffn(lds, xbar, p, 0);
  {
    const float* mod1 = mod + 8 * 6144;
    rowpass_fold((bf16_t*)(ws + O_XB), (const bf16_t*)(ws + O_YF), p.norm_g + 3072, mod + 5120, p.norm_g + 4096, mod1 + 1024, mod1, (bf16_t*)(ws + O_H),
                 (float*)(ws + O_C2048) + 8192);
    bf16_t* cs = (bf16_t*)(ws + O_COSSIN);
    for (int idx = blockIdx.x * NTHR + tidx(); idx < 4096 * 256; idx += gridDim.x * NTHR) {
      const int rr = idx >> 8, s8 = (idx & 255) * 8, k1 = rr & 2047;
      float o[8];
#pragma unroll
      for (int i = 0; i < 8; ++i) {
        const float ph = (float)((k1 * (s8 + i)) & 4095) * (1.f / 2048.f);
        o[i] = ((rr < 2048) ? cospif(ph) : sinpif(ph)) * (1.f / 64.f);
      }
      *(u32x4*)(cs + (size_t)rr * 2048 + s8) = pack8(o);
    }
    xcd_barrier(xbar);
    {
      const bf16_t* dA = (const bf16_t*)(ws + W_DFTC);
      const bf16_t* hB = (const bf16_t*)(ws + O_H);
      u32x4 ra[4], rb[2];
      int t = blockIdx.x;
      if (t < 8 * 128) gemm_first_load(dA, 256, hB + (size_t)(t & 127) * 128 * 2048 + (t >> 7) * 256, 2048, ra, rb);
      for (; t < 8 * 128; t += gridDim.x) {
        const int g = t >> 7, tn = t & 127, t2 = t + gridDim.x;
        const bf16_t* Bn = (t2 < 8 * 128) ? hB + (size_t)(t2 & 127) * 128 * 2048 + (t2 >> 7) * 256 : nullptr;
        gemm_tile(lds, dA, 256, hB + (size_t)tn * 128 * 2048 + g * 256, 2048, 256, 0, tn * 128, EpiDftc{(bf16_t*)(ws + O_CSTF), g}, ra, rb,
                  Bn ? dA : nullptr, Bn);
      }
      const float* h2048 = (const float*)(ws + O_C2048) + 8192;
      for (int idx = blockIdx.x * NTHR + tidx(); idx < 8192; idx += gridDim.x * NTHR) {
        const int bb = idx >> 10, n = idx & 1023, g = n >> 7, k2 = n & 127;
        float acc = 0.f;
        for (int c = 0; c < 128; ++c) acc += h2048[bb * 1024 + g * 128 + c] * bf2f(dA[k2 * 256 + c]);
        ((float*)(ws + O_C2048))[idx] = acc * (1.f / 64.f);
      }
    }
    xcd_barrier(xbar);
    dft_altsum(p);
    {
      pg8::Gemm g{(const bf16_t*)(ws + O_COSSIN), (const bf16_t*)(ws + O_CSTF), 4096, 16384, 2048};
      pg8::BatchOrder S{(int)gridDim.x, (int)blockIdx.x};
      pg8::gemm_phase<pg8::PEpiDft, pg8::BatchOrder, true, true>(LDSP, g, S, pg8::PEpiDft{(bf16_t*)(ws + O_EO), (bf16_t*)(ws + O_F), (const float*)(ws + O_C2048)});
    }
    xcd_barrier(xbar);
    pgemm(lds, (const bf16_t*)(ws + O_F), (const bf16_t*)(ws + W_FNET), MT, 1024, 1024, pg8::PEpiBf16<false>{(bf16_t*)(ws + O_YF), 1024});
    xcd_barrier(xbar);
    rowpass<true, true, true, true>(ws + O_XB, (const bf16_t*)(ws + O_YF), p.norm_g + 4096 + 1024, mod1 + 2048, ws + O_XB, p.norm_g + 4096 + 2048, mod1 + 4096, mod1 + 3072,
                        (bf16_t*)(ws + O_H));
    xcd_barrier(xbar);
    ffn(lds, xbar, p, 1);
    rowpass<true, false, true, false>(ws + O_XB, (const bf16_t*)(ws + O_YF), p.norm_g + 4096 + 3072, mod1 + 5120, p.out, nullptr, nullptr, nullptr, nullptr);
  }
}

#undef p
extern "C" void kernel_launch(void* const* d_in, const int* in_sizes, int n_in, void* d_out, int out_size, void* d_ws, size_t ws_size,
                              hipStream_t stream) {
  static int grid_blocks = 0;
  if (!grid_blocks) {
    int dev = 0, cus = 0, per_cu = 0;
    hipGetDevice(&dev);
    hipDeviceGetAttribute(&cus, hipDeviceAttributeMultiprocessorCount, dev);
    hipFuncSetAttribute((const void*)mega, hipFuncAttributeMaxDynamicSharedMemorySize, LDS_BYTES);
    hipOccupancyMaxActiveBlocksPerMultiprocessor(&per_cu, (const void*)mega, NTHR, LDS_BYTES);
    if (per_cu < 1) { fprintf(stderr, "occupancy query returned %d\n", per_cu); per_cu = 1; }
    if (per_cu > 1) per_cu = 1;
    grid_blocks = cus * per_cu;
  }
  P p{};
  const float** pp = (const float**)&p;
  for (int i = 0; i < 25; ++i) pp[i] = (const float*)d_in[i];
  p.out = (float*)d_out;
  p.ws = (char*)d_ws;
  (void)hipMemsetAsync((char*)d_ws + W_BAR, 0, XCD_BAR_WORDS * sizeof(unsigned), stream);
  void* args[] = {&p};
  hipError_t e = hipLaunchCooperativeKernel((const void*)mega, dim3(grid_blocks), dim3(NTHR), args, LDS_BYTES, stream);
  if (e != hipSuccess) fprintf(stderr, "cooperative launch failed: %s (grid %d)\n", hipGetErrorString(e), grid_blocks);
}
```

```cpp
#include <hip/hip_runtime.h>
#include <hip/hip_cooperative_groups.h>
#include <stdint.h>
#include <cstdio>
namespace cg = cooperative_groups;

typedef unsigned short bf16_t;
typedef short bf16x8 __attribute__((ext_vector_type(8)));
typedef short s16x4 __attribute__((ext_vector_type(4)));
typedef float f32x4 __attribute__((ext_vector_type(4)));
typedef float f32x2 __attribute__((ext_vector_type(2)));
typedef unsigned u32x4 __attribute__((ext_vector_type(4)));
typedef unsigned u32x2 __attribute__((ext_vector_type(2)));

#define DEV __device__ __forceinline__
__device__ __forceinline__ int tidx() { int t = threadIdx.x; asm volatile("" : "+v"(t)); return t; }

constexpr int NB = 8, SEQ = 4096, DM = 1024, MT = NB * SEQ, DFF = 2816, INC = 3584;
constexpr size_t MiB = 1024 * 1024;
constexpr int NTHR = 512;
constexpr int LDS_BYTES = 131072 + 16;
constexpr size_t W_BAR = 47 * 1024 * 1024;
#ifndef REP_SCAN
#define REP_SCAN 1
#endif
#ifndef REP_ATT
#define REP_ATT 1
#endif
#ifndef REP_SYNC
#define REP_SYNC 0
#endif
#ifndef REP_PREP
#define REP_PREP 1
#endif
#ifndef REP_LORA
#define REP_LORA 1
#endif
#ifndef REP_GLU
#define REP_GLU 1
#endif
#ifndef REP_PRO
#define REP_PRO 1
#endif
#ifndef REP_ROW
#define REP_ROW 1
#endif

constexpr size_t W_MIXIN = 0;
constexpr size_t W_UP = 7 * MiB;
constexpr size_t W_DOWN = 29 * MiB;
constexpr size_t W_MIXOUT = 40 * MiB;
constexpr size_t W_FNET = 42 * MiB;
constexpr size_t W_L1 = 44 * MiB;
constexpr size_t W_W2 = W_L1 + 512 * 1024;
constexpr size_t W_A2 = W_W2 + 128 * 1024;
constexpr size_t W_G2 = W_A2 + 128 * 1024;
constexpr size_t W_DFTC = W_G2 + 128 * 1024;
constexpr size_t W_MOD = 45 * MiB;
constexpr size_t W_ROPE = 46 * MiB;
constexpr size_t R0 = 48 * MiB;
constexpr size_t O_H0 = R0;
constexpr size_t O_Z = 112 * MiB;
constexpr size_t O_SBZ = 304 * MiB;
constexpr size_t O_QR = 336 * MiB, O_KR = 368 * MiB, O_VT = 400 * MiB;
constexpr size_t O_NUM = R0;
constexpr size_t O_MD = 240 * MiB;
constexpr size_t O_YCAT = 448 * MiB;
constexpr size_t O_OMW = 144 * MiB, O_KK = 208 * MiB, O_KKA = 248 * MiB, O_L1 = 312 * MiB, O_KD = 336 * MiB, O_G = 400 * MiB, O_Y = 48 * MiB;
constexpr size_t O_YF = 48 * MiB;
constexpr size_t O_H = 176 * MiB;
constexpr size_t O_ZF = 240 * MiB;
constexpr size_t O_ACT = 240 * MiB;
constexpr size_t O_SB = 416 * MiB;
constexpr size_t O_COSSIN = 240 * MiB;
constexpr size_t O_CST = 304 * MiB;
constexpr size_t O_F = 176 * MiB;
constexpr size_t O_CSTF = 432 * MiB;
constexpr size_t O_C2048 = 272 * MiB;
constexpr size_t O_EO = 48 * MiB;
constexpr size_t O_XB = 112 * MiB;

struct P {
  const float *x, *c, *ada_w, *ada_b, *norm_g, *mix_in, *mix_conv, *w0, *w1, *w2, *a0, *a1, *a2, *g1, *g2, *k_k, *k_a, *r_k, *lnx_w,
      *lnx_b, *mix_out, *fnet_w, *ffn_up, *ffn_conv, *ffn_down;
  float* out;
  char* ws;
};

DEV float bf2f(bf16_t h) { return __uint_as_float(((unsigned)h) << 16); }
DEV bf16_t f2bf(float f) {
  unsigned u = __float_as_uint(f);
  u += 0x7fffu + ((u >> 16) & 1u);
  return (bf16_t)(u >> 16);
}
typedef __bf16 bf16x2_t __attribute__((ext_vector_type(2)));
DEV unsigned pk2(float a, float b) {
  const f32x2 v = {a, b};
  return __builtin_bit_cast(unsigned, __builtin_convertvector(v, bf16x2_t));
}
DEV float lo16(unsigned u) { return __uint_as_float(u << 16); }
DEV float hi16(unsigned u) { return __uint_as_float(u & 0xffff0000u); }
DEV float wave_sum(float v) {
#pragma unroll
  for (int o = 32; o; o >>= 1) v += __shfl_xor(v, o);
  return v;
}
DEV float sigmoidf_(float x) { return __builtin_amdgcn_rcpf(1.f + __expf(-x)); }

#include <cstdint>
#include <cstdlib>
#include <vector>

#define XB_TMO      128
#define XB_XCNT(j)  (256  + 64 * (j))
#define XB_XSUB(j)  (1280 + 64 * (j))
#define XB_XGEN(j)  (2304 + 64 * (j))
#define XB_TOP      3328
#define XB_TOPGEN   3392
#define XCD_BAR_WORDS 3456
#define XB_SPIN_CAP (1u << 18)
#define XLAS __attribute__((address_space(3)))

__device__ __forceinline__ unsigned xb_ld(unsigned* p)              { return __hip_atomic_load(p, __ATOMIC_RELAXED, __HIP_MEMORY_SCOPE_AGENT); }
__device__ __forceinline__ unsigned xb_add(unsigned* p, unsigned v) { return __hip_atomic_fetch_add(p, v, __ATOMIC_RELAXED, __HIP_MEMORY_SCOPE_AGENT); }
__device__ __forceinline__ unsigned xb_xcc_id() { return (unsigned)__builtin_amdgcn_s_getreg((3 << 11) | 20) & 0xFu; }
#define XB_SPIN(cond, bar) do { unsigned _sp = 0; while (cond) { __builtin_amdgcn_s_sleep(1); \
    if ((++_sp & 255u) == 0u) { if (xb_ld(&(bar)[XB_TMO])) break; if (_sp > XB_SPIN_CAP) { atomicAdd(&(bar)[XB_TMO], 1u); break; } } } } while (0)

struct XcdBarrier {
    unsigned* bar; unsigned x;
    volatile XLAS unsigned* st;
};

__device__ __forceinline__ XcdBarrier xcd_barrier_post(unsigned* bar, volatile XLAS unsigned* st) {
    XcdBarrier b; b.bar = bar; b.x = xb_xcc_id(); b.st = st;
    if (threadIdx.x == 0) (void)xb_add(&bar[XB_XCNT(b.x)], 1u);
    return b;
}
__device__ __forceinline__ void xcd_barrier_complete(unsigned* bar, unsigned x, unsigned& nloc, unsigned& nx) {
    const unsigned G = gridDim.x * gridDim.y * gridDim.z;
    unsigned sum, cnt, mine, sp = 0u;
    for (;;) {
        sum = 0u; cnt = 0u; mine = 0u;
#pragma unroll
        for (unsigned j = 0; j < 16; ++j) { const unsigned c = xb_ld(&bar[XB_XCNT(j)]); sum += c; cnt += (c > 0u) ? 1u : 0u; mine = (j == x) ? c : mine; }
        if (sum == G) break;
        __builtin_amdgcn_s_sleep(1);
        if ((++sp & 255u) == 0u) { if (xb_ld(&bar[XB_TMO])) break; if (sp > XB_SPIN_CAP) { atomicAdd(&bar[XB_TMO], 1u); break; } }
    }
    nloc = mine > 0u ? mine : 1u; nx = cnt > 0u ? cnt : 1u;
}

__device__ __forceinline__ void xcd_barrier(const XcdBarrier& b) {
    asm volatile("s_waitcnt vmcnt(0)" ::: "memory");
    __syncthreads();
    if (threadIdx.x == 0) {
        unsigned* bar = b.bar;
        __builtin_amdgcn_s_waitcnt(0);
        unsigned nloc = b.st[0], nx = b.st[1];
        if (nloc == 0u) { xcd_barrier_complete(bar, b.x, nloc, nx); b.st[0] = nloc; b.st[1] = nx; }
        const unsigned old = xb_add(&bar[XB_XSUB(b.x)], 1u);
        const unsigned gen = old / nloc;
        if (old + 1u == (gen + 1u) * nloc) {
            __builtin_amdgcn_fence(__ATOMIC_RELEASE, "agent");
            asm volatile("s_waitcnt vmcnt(0)" ::: "memory");
            const unsigned og = xb_add(&bar[XB_TOP], 1u);
            const unsigned tg = og / nx;
            if (og + 1u == (tg + 1u) * nx) xb_add(&bar[XB_TOPGEN], 1u);
            else XB_SPIN(xb_ld(&bar[XB_TOPGEN]) == tg, bar);
            __builtin_amdgcn_fence(__ATOMIC_ACQUIRE, "agent");
            xb_add(&bar[XB_XGEN(b.x)], 1u);
            asm volatile("s_waitcnt vmcnt(0)" ::: "memory");
        } else {
            XB_SPIN(xb_ld(&bar[XB_XGEN(b.x)]) == gen, bar);
            __builtin_amdgcn_fence(__ATOMIC_ACQUIRE, "agent");
            asm volatile("s_waitcnt vmcnt(0)" ::: "memory");
        }
    }
    __syncthreads();
}

namespace pg8 {
#define PG8_LAS __attribute__((address_space(3)))
typedef unsigned short bf16_t;
typedef short bf16x8 __attribute__((ext_vector_type(8)));
typedef float f32x4 __attribute__((ext_vector_type(4)));
typedef unsigned u32x4 __attribute__((ext_vector_type(4)));
constexpr int BM = 256, BK = 64, HALF = 128, HTB = HALF * BK * 2  , STAGE_BYTES = 8 * HTB, NXCD = 8, WGM = 8;

__host__ __device__ __forceinline__ int lds_byte(int r, int c) { const int st = (r >> 4) * 2 + (c >> 5), rr = r & 15, cc = c & 31, ob = rr * 64 + cc * 2; return st * 1024 + (ob ^ (((ob >> 9) & 1) << 5)); }
__host__ __device__ __forceinline__ void stage_rc(int b, int& R, int& C) { const int st = b / 1024, sb = b % 1024, swz = sb ^ (((sb >> 9) & 1) << 5); R = (st >> 1) * 16 + swz / 64; C = (st & 1) * 32 + (swz % 64) / 2; }
__host__ __device__ __forceinline__ int perm32(int rho) { const int n = rho >> 4, i = rho & 15; return 8 * (i >> 2) + 4 * n + (i & 3); }

struct Unit { int pm, pn; };
struct Gemm { const bf16_t* A; const bf16_t* Bt; int M, N, K; };

struct StaticOrder {
    int nM, nN, nwg, G, c;
    __host__ __device__ void init(int M, int N, int G_, int c_) { nM = M / BM; nN = N / BM; nwg = nM * nN; G = G_; c = c_; }
    __host__ __device__ bool next(int i, Unit& u) const {
        const long L = (long)i * G + c; if (L >= nwg) return false;
        int wgid = (int)L; { const int q = nwg / NXCD, r = nwg % NXCD, xcd = wgid % NXCD, off = wgid / NXCD; wgid = (xcd < r ? xcd * (q + 1) : r * (q + 1) + (xcd - r) * q) + off; }
        const int nig = WGM * nN, gid = wgid / nig, fm = gid * WGM, gsz = (nM - fm) < WGM ? (nM - fm) : WGM;
        u.pm = fm + ((wgid % nig) % gsz); u.pn = (wgid % nig) / gsz; return true;
    }
    __device__ __forceinline__ void a_ready(const Unit&) const {}
    __device__ __forceinline__ void done(const Unit&) const {}
};

__device__ __forceinline__ unsigned cvt_pk_bf16(float lo, float hi) { unsigned r; asm volatile("v_cvt_pk_bf16_f32 %0, %1, %2" : "=v"(r) : "v"(lo), "v"(hi)); return r; }

template <bool BATCHED> struct PEpiBf16 {
    static constexpr bool PERM = true, AFTER_DRAIN = false;
    bf16_t* O; int ldc;
    __device__ __forceinline__ void operator()(const f32x4 (&acc)[2][2][4][2], const Unit& u, int wr, int wc, int fr, int fq) const {
        const int rb = BATCHED ? ((u.pn >> 2) * 4096 + u.pm * 256) : u.pm * 256, cb = BATCHED ? (u.pn & 3) * 256 : u.pn * 256;
        const int row0 = rb + wr * 64 + fr, col0 = cb + wc * 32 + 8 * fq;
#pragma unroll
        for (int ai = 0; ai < 2; ++ai)
#pragma unroll
            for (int m = 0; m < 4; ++m) { bf16_t* rowp = O + (size_t)(row0 + ai * HALF + m * 16) * ldc + col0;
#pragma unroll
                for (int bj = 0; bj < 2; ++bj) { const f32x4 v0 = acc[ai][bj][m][0], v1 = acc[ai][bj][m][1];
                    u32x4 w; w.x = cvt_pk_bf16(v0[0], v0[1]); w.y = cvt_pk_bf16(v0[2], v0[3]); w.z = cvt_pk_bf16(v1[0], v1[1]); w.w = cvt_pk_bf16(v1[2], v1[3]);
                    *(u32x4*)(rowp + bj * HALF) = w; } }
    }
};
struct PEpiF32 {
    static constexpr bool PERM = true, AFTER_DRAIN = false;
    float* O; int ldc;
    __device__ __forceinline__ void operator()(const f32x4 (&acc)[2][2][4][2], const Unit& u, int wr, int wc, int fr, int fq) const {
        const int row0 = u.pm * 256 + wr * 64 + fr, col0 = u.pn * 256 + wc * 32 + 8 * fq;
#pragma unroll
        for (int ai = 0; ai < 2; ++ai)
#pragma unroll
            for (int m = 0; m < 4; ++m) { float* rowp = O + (size_t)(row0 + ai * HALF + m * 16) * ldc + col0;
#pragma unroll
                for (int bj = 0; bj < 2; ++bj) { *(f32x4*)(rowp + bj * HALF) = acc[ai][bj][m][0]; *(f32x4*)(rowp + bj * HALF + 4) = acc[ai][bj][m][1]; } }
    }
};
template <int CTRL> __device__ __forceinline__ float dppz(float x) { return __int_as_float(__builtin_amdgcn_update_dpp(0, __float_as_int(x), CTRL, 0xF, 0xF, true)); }
template <int CTRL> __device__ __forceinline__ float dppo(float old, float x) { return __int_as_float(__builtin_amdgcn_update_dpp(__float_as_int(old), __float_as_int(x), CTRL, 0xF, 0xF, false)); }
struct PEpiGlu {
    static constexpr bool PERM = true, AFTER_DRAIN = false;
    bf16_t* act; bf16_t* sb; const float* cw;
    __device__ __forceinline__ void operator()(const f32x4 (&acc)[2][2][4][2], const Unit& u, int wr, int wc, int fr, int fq) const {
        const int chb = u.pn * 128 + wc * 32 + 8 * fq, colp = u.pn * 256 + wc * 32 + 8 * fq;
#pragma unroll
        for (int n = 0; n < 2; ++n) {
            const int ch = chb + 4 * n;
            const f32x4 g0 = *(const f32x4*)(cw + ch), g1 = *(const f32x4*)(cw + 5632 + ch), g2 = *(const f32x4*)(cw + 11264 + ch);
            const f32x4 v0 = *(const f32x4*)(cw + 2816 + ch), v1 = *(const f32x4*)(cw + 5632 + 2816 + ch), v2 = *(const f32x4*)(cw + 11264 + 2816 + ch);
#pragma unroll
            for (int ai = 0; ai < 2; ++ai) {
                const int strip = u.pm * 4 + ai * 2 + wr, rowbase = u.pm * 256 + ai * HALF + wr * 64;
#pragma unroll
                for (int m = 0; m < 4; ++m) {
                    float o[4];
#pragma unroll
                    for (int r = 0; r < 4; ++r) {
                        const float gc = acc[ai][0][m][n][r], vc = acc[ai][1][m][n][r];
                        float gx = 0.f, vx = 0.f, gy = 0.f, vy = 0.f;
                        if (m > 0) { gx = dppz<0x121>(acc[ai][0][m - 1][n][r]); vx = dppz<0x121>(acc[ai][1][m - 1][n][r]); }
                        const float gp = dppo<0x111>(gx, gc), vp = dppo<0x111>(vx, vc);
                        if (m < 3) { gy = dppz<0x12F>(acc[ai][0][m + 1][n][r]); vy = dppz<0x12F>(acc[ai][1][m + 1][n][r]); }
                        const float gn = dppo<0x101>(gy, gc), vn = dppo<0x101>(vy, vc);
                        const float g = gp * g0[r] + gc * g1[r] + gn * g2[r];
                        const float v = vp * v0[r] + vc * v1[r] + vn * v2[r];
                        const float u2 = -1.5957691216057308f * (g + 0.044715f * g * g * g);
                        o[r] = g * __builtin_amdgcn_rcpf(1.f + __expf(u2)) * v;
                    }
                    u32x2 w; w.x = cvt_pk_bf16(o[0], o[1]); w.y = cvt_pk_bf16(o[2], o[3]);
                    *(u32x2*)(act + (size_t)(rowbase + m * 16 + fr) * 2816 + ch) = w;
                }
                if (fr < 2) {
                    bf16_t* sp = sb + ((size_t)strip * 4 + fr) * 5632 + colp + 4 * n;
                    u32x2 w; w.x = cvt_pk_bf16(acc[ai][0][0][n][0], acc[ai][0][0][n][1]); w.y = cvt_pk_bf16(acc[ai][0][0][n][2], acc[ai][0][0][n][3]);
                    *(u32x2*)sp = w;
                    w.x = cvt_pk_bf16(acc[ai][1][0][n][0], acc[ai][1][0][n][1]); w.y = cvt_pk_bf16(acc[ai][1][0][n][2], acc[ai][1][0][n][3]);
                    *(u32x2*)(sp + 128) = w;
                }
                if (fr >= 14) {
                    bf16_t* sp = sb + ((size_t)strip * 4 + (fr - 12)) * 5632 + colp + 4 * n;
                    u32x2 w; w.x = cvt_pk_bf16(acc[ai][0][3][n][0], acc[ai][0][3][n][1]); w.y = cvt_pk_bf16(acc[ai][0][3][n][2], acc[ai][0][3][n][3]);
                    *(u32x2*)sp = w;
                    w.x = cvt_pk_bf16(acc[ai][1][3][n][0], acc[ai][1][3][n][1]); w.y = cvt_pk_bf16(acc[ai][1][3][n][2], acc[ai][1][3][n][3]);
                    *(u32x2*)(sp + 128) = w;
                }
            }
        }
    }
};
struct PEpiMixIn {
    static constexpr bool PERM = true, AFTER_DRAIN = false;
    bf16_t *za, *sbz, *qr, *kr, *vr; const float *cw, *rope;
    __device__ __forceinline__ void operator()(const f32x4 (&acc)[2][2][4][2], const Unit& u, int wr, int wc, int fr, int fq) const {
        if (u.pn < 8) {
#pragma unroll
            for (int bj = 0; bj < 2; ++bj)
#pragma unroll
                for (int n = 0; n < 2; ++n) {
                    const int col = u.pn * 256 + bj * HALF + wc * 32 + 8 * fq + 4 * n;
                    const f32x4 w0 = *(const f32x4*)(cw + col), w1 = *(const f32x4*)(cw + 2048 + col), w2 = *(const f32x4*)(cw + 4096 + col);
#pragma unroll
                    for (int ai = 0; ai < 2; ++ai) {
                        const int strip = u.pm * 4 + ai * 2 + wr, rowbase = u.pm * 256 + ai * HALF + wr * 64;
#pragma unroll
                        for (int m = 0; m < 4; ++m) {
                            float o[4];
#pragma unroll
                            for (int r = 0; r < 4; ++r) {
                                const float c = acc[ai][bj][m][n][r];
                                float x = 0.f, y = 0.f;
                                if (m > 0) x = dppz<0x121>(acc[ai][bj][m - 1][n][r]);
                                const float pv = dppo<0x111>(x, c);
                                if (m < 3) y = dppz<0x12F>(acc[ai][bj][m + 1][n][r]);
                                const float nx = dppo<0x101>(y, c);
                                o[r] = pv * w0[r] + c * w1[r] + nx * w2[r];
                            }
                            u32x2 w; w.x = cvt_pk_bf16(o[0], o[1]); w.y = cvt_pk_bf16(o[2], o[3]);
                            *(u32x2*)(za + (size_t)(rowbase + m * 16 + fr) * 2048 + col) = w;
                        }
                        if (fr < 2) { u32x2 w; w.x = cvt_pk_bf16(acc[ai][bj][0][n][0], acc[ai][bj][0][n][1]); w.y = cvt_pk_bf16(acc[ai][bj][0][n][2], acc[ai][bj][0][n][3]);
                            *(u32x2*)(sbz + ((size_t)strip * 4 + fr) * 2048 + col) = w; }
                        if (fr >= 14) { u32x2 w; w.x = cvt_pk_bf16(acc[ai][bj][3][n][0], acc[ai][bj][3][n][1]); w.y = cvt_pk_bf16(acc[ai][bj][3][n][2], acc[ai][bj][3][n][3]);
                            *(u32x2*)(sbz + ((size_t)strip * 4 + (fr - 12)) * 2048 + col) = w; }
                    }
                }
        } else if (u.pn < 12) {
            const int which = (u.pn - 8) >> 1;
            bf16_t* dst = which ? kr : qr;
            const float scl = which ? 1.f : 0.125f;
#pragma unroll
            for (int bj = 0; bj < 2; ++bj) {
                const int cq = ((u.pn - 8) & 1) * 256 + bj * HALF + wc * 32 + 8 * fq, h = cq >> 6, j0 = (cq & 63) >> 1;
#pragma unroll
                for (int ai = 0; ai < 2; ++ai)
#pragma unroll
                    for (int m = 0; m < 4; ++m) {
                        const int row = u.pm * 256 + ai * HALF + wr * 64 + m * 16 + fr, s = row & 4095;
                        const float* rp = rope + ((size_t)s * 32 + j0) * 2;
                        const f32x4 t0 = *(const f32x4*)rp, t1 = *(const f32x4*)(rp + 4);
                        const f32x4 a = acc[ai][bj][m][0], b = acc[ai][bj][m][1];
                        float o1[4], o2[4];
                        o1[0] = (a[0] * t0[0] - a[1] * t0[1]) * scl; o2[0] = (a[1] * t0[0] + a[0] * t0[1]) * scl;
                        o1[1] = (a[2] * t0[2] - a[3] * t0[3]) * scl; o2[1] = (a[3] * t0[2] + a[2] * t0[3]) * scl;
                        o1[2] = (b[0] * t1[0] - b[1] * t1[1]) * scl; o2[2] = (b[1] * t1[0] + b[0] * t1[1]) * scl;
                        o1[3] = (b[2] * t1[2] - b[3] * t1[3]) * scl; o2[3] = (b[3] * t1[2] + b[2] * t1[3]) * scl;
                        bf16_t* dp = dst + (size_t)row * 512 + h * 64 + j0;
                        u32x2 w; w.x = cvt_pk_bf16(o1[0], o1[1]); w.y = cvt_pk_bf16(o1[2], o1[3]); *(u32x2*)dp = w;
                        w.x = cvt_pk_bf16(o2[0], o2[1]); w.y = cvt_pk_bf16(o2[2], o2[3]); *(u32x2*)(dp + 32) = w;
                    }
            }
        } else {
#pragma unroll
            for (int bj = 0; bj < 2; ++bj) {
                const int cv = (u.pn - 12) * 256 + bj * HALF + wc * 32 + 8 * fq;
#pragma unroll
                for (int ai = 0; ai < 2; ++ai)
#pragma unroll
                    for (int m = 0; m < 4; ++m) {
                        const int row = u.pm * 256 + ai * HALF + wr * 64 + m * 16 + fr;
                        const f32x4 v0 = acc[ai][bj][m][0], v1 = acc[ai][bj][m][1];
                        u32x4 w; w.x = cvt_pk_bf16(v0[0], v0[1]); w.y = cvt_pk_bf16(v0[2], v0[3]); w.z = cvt_pk_bf16(v1[0], v1[1]); w.w = cvt_pk_bf16(v1[2], v1[3]);
                        *(u32x4*)(vr + (size_t)row * 512 + cv) = w;
                    }
            }
        }
    }
};
struct PEpiDft {
    static constexpr bool PERM = true, AFTER_DRAIN = false;
    bf16_t* E; bf16_t* f; const float* c2048;
    __device__ __forceinline__ void operator()(const f32x4 (&acc)[2][2][4][2], const Unit& u, int wr, int wc, int fr, int fq) const {
        const int be = u.pn >> 2, eo = be & 1, b = be >> 1;
        const int k0 = (u.pm & 7) * 256 + wr * 64 + fr, col0 = (u.pn & 3) * 256 + wc * 32 + 8 * fq;
#pragma unroll
        for (int ai = 0; ai < 2; ++ai)
#pragma unroll
            for (int m = 0; m < 4; ++m) {
                const int k1 = k0 + ai * HALF + m * 16;
#pragma unroll
                for (int bj = 0; bj < 2; ++bj) {
                    const int col = col0 + bj * HALF;
                    const f32x4 v0 = acc[ai][bj][m][0], v1 = acc[ai][bj][m][1];
                    bf16_t* ep = E + ((size_t)(b * 2048 + k1) * 1024 + col);
                    if (eo == 0) {
                        u32x4 w; w.x = cvt_pk_bf16(v0[0], v0[1]); w.y = cvt_pk_bf16(v0[2], v0[3]); w.z = cvt_pk_bf16(v1[0], v1[1]); w.w = cvt_pk_bf16(v1[2], v1[3]);
                        *(u32x4*)ep = w;
                    } else {
                        const u32x4 eu = *(const u32x4*)ep;
                        const f32x4 c0 = *(const f32x4*)(c2048 + b * 1024 + col), c1 = *(const f32x4*)(c2048 + b * 1024 + col + 4);
                        f32x4 e0 = (f32x4){__uint_as_float(eu.x << 16), __uint_as_float(eu.x & 0xffff0000u), __uint_as_float(eu.y << 16), __uint_as_float(eu.y & 0xffff0000u)};
                        f32x4 e1 = (f32x4){__uint_as_float(eu.z << 16), __uint_as_float(eu.z & 0xffff0000u), __uint_as_float(eu.w << 16), __uint_as_float(eu.w & 0xffff0000u)};
                        if (k1 & 1) { e0 = e0 - c0; e1 = e1 - c1; } else { e0 = e0 + c0; e1 = e1 + c1; }
                        const f32x4 d0 = e0 - v0, d1 = e1 - v1, s0 = e0 + v0, s1 = e1 + v1;
                        u32x4 w; w.x = cvt_pk_bf16(d0[0], d0[1]); w.y = cvt_pk_bf16(d0[2], d0[3]); w.z = cvt_pk_bf16(d1[0], d1[1]); w.w = cvt_pk_bf16(d1[2], d1[3]);
                        *(u32x4*)(f + ((size_t)(b * 4096 + k1) * 1024 + col)) = w;
                        if (k1 > 0) {
                            w.x = cvt_pk_bf16(s0[0], s0[1]); w.y = cvt_pk_bf16(s0[2], s0[3]); w.z = cvt_pk_bf16(s1[0], s1[1]); w.w = cvt_pk_bf16(s1[2], s1[3]);
                            *(u32x4*)(f + ((size_t)(b * 4096 + 4096 - k1) * 1024 + col)) = w;
                        }
                    }
                }
            }
    }
};
struct BatchOrder {
    int G, c;
    __device__ __forceinline__ bool next(int i, Unit& u) const { const int T = (i >> 1) * G + c, eo = i & 1; if (T >= 256) return false;
        const int b = T >> 5, r = T & 31, be = b * 2 + eo; u.pm = eo * 8 + (r >> 2); u.pn = be * 4 + (r & 3); return true; }
    __device__ __forceinline__ void a_ready(const Unit&) const {}
    __device__ __forceinline__ void done(const Unit&) const {}
};

template <class Epi, class Sched, bool ALIGN_EPI = false, bool SP2 = false>
__device__ __forceinline__ void gemm_phase(PG8_LAS unsigned char* lds, const Gemm g, const Sched& S, const Epi& E) {
    int tid_ = threadIdx.x; asm volatile("" : "+v"(tid_));
    const int tid = tid_, wid = __builtin_amdgcn_readfirstlane(tid >> 6), lane = tid & 63, wr = wid >> 2, wc = wid & 3, fr = lane & 15, fq = lane >> 4;
    const int K = g.K, nt = K / BK;
    unsigned voffA[2], voffB[2];
#pragma unroll
    for (int i = 0; i < 2; ++i) { int R, C; stage_rc(tid * 16 + i * 8192, R, C); const int Rb = Epi::PERM ? ((R & ~31) + perm32(R & 31)) : R;
        voffA[i] = (unsigned)(R * K + C) * 2u; voffB[i] = (unsigned)(Rb * K + C) * 2u; }
    const size_t kstep = (size_t)(BK * 2);
    const size_t hstep = (size_t)HALF * K * 2;
    const size_t tstep = 2 * hstep;
    const unsigned ldsw = (unsigned)wid * 1024u;
    const int aoff = lds_byte(wr * 64 + fr, fq * 8), boff = lds_byte(wc * 32 + fr, fq * 8);
#define PG8_SA(b, h) (((b) * 2 + (h)) * HTB)
#define PG8_SB(b, h) ((4 + (b) * 2 + (h)) * HTB)
#define PG8_STAGE(bufoff, gbase, voff) do { _Pragma("unroll") for (int _i = 0; _i < 2; ++_i) \
        __builtin_amdgcn_global_load_lds((const unsigned*)((const char*)(gbase) + (voff)[_i]), (PG8_LAS unsigned*)(lds + (bufoff) + ldsw + _i * 8192), 16, 0, 0); } while (0)
#define PG8_LDA(dst, b, h) do { _Pragma("unroll") for (int m = 0; m < 4; ++m) _Pragma("unroll") for (int k = 0; k < 2; ++k) dst[m][k] = *(const PG8_LAS bf16x8*)(lds + PG8_SA(b, h) + aoff + m * 2048 + k * 1024); } while (0)
#define PG8_LDB(dst, b, h) do { _Pragma("unroll") for (int n = 0; n < 2; ++n) _Pragma("unroll") for (int k = 0; k < 2; ++k) dst[n][k] = *(const PG8_LAS bf16x8*)(lds + PG8_SB(b, h) + boff + n * 2048 + k * 1024); } while (0)
#define PG8_MMA(ai, bj, At, Bt) do { __builtin_amdgcn_s_setprio(1); _Pragma("unroll") for (int m = 0; m < 4; ++m) _Pragma("unroll") for (int n = 0; n < 2; ++n) _Pragma("unroll") for (int k = 0; k < 2; ++k) \
        acc[ai][bj][m][n] = __builtin_amdgcn_mfma_f32_16x16x32_bf16(Bt[n][k], At[m][k], acc[ai][bj][m][n], 0, 0, 0); __builtin_amdgcn_s_setprio(0); } while (0)
#define PG8_WAIT_V(n) asm volatile("s_waitcnt vmcnt(" #n ")" ::: "memory")
#define PG8_WAIT_L(n) asm volatile("s_waitcnt lgkmcnt(" #n ")" ::: "memory")
#define PG8_BAR __builtin_amdgcn_s_barrier()
#define PG8_SCHED __builtin_amdgcn_sched_barrier(0)
    Unit cur, nxt; int ui = 0;
    if (!S.next(0, cur)) return;
    f32x4 acc[2][2][4][2];
#pragma unroll
    for (int a = 0; a < 2; ++a)
#pragma unroll
        for (int b = 0; b < 2; ++b)
#pragma unroll
            for (int m = 0; m < 4; ++m)
#pragma unroll
                for (int n = 0; n < 2; ++n) acc[a][b][m][n] = (f32x4){0.f, 0.f, 0.f, 0.f};
    bf16x8 At[4][2], B0[2][2], B1[2][2];
    const char* cA = (const char*)g.A + (size_t)cur.pm * tstep; const char* cB = (const char*)g.Bt + (size_t)cur.pn * tstep;
    S.a_ready(cur);
    if constexpr (SP2) {
        PG8_STAGE(PG8_SB(0, 0), cB, voffB); PG8_STAGE(PG8_SB(0, 1), cB + hstep, voffB); PG8_STAGE(PG8_SA(0, 0), cA, voffA); PG8_STAGE(PG8_SA(0, 1), cA + hstep, voffA);
        if (wr == 1) PG8_BAR;
        PG8_WAIT_V(2); PG8_BAR;
        PG8_STAGE(PG8_SB(1, 0), cB + kstep, voffB); PG8_STAGE(PG8_SA(1, 0), cA + kstep, voffA); PG8_STAGE(PG8_SB(1, 1), cB + hstep + kstep, voffB);
        PG8_WAIT_V(6); PG8_BAR;
    } else {
        PG8_STAGE(PG8_SB(0, 0), cB, voffB); PG8_STAGE(PG8_SA(0, 0), cA, voffA); PG8_STAGE(PG8_SB(0, 1), cB + hstep, voffB); PG8_STAGE(PG8_SA(0, 1), cA + hstep, voffA);
        if (wr == 1) PG8_BAR;
        PG8_WAIT_V(4); PG8_BAR;
        PG8_STAGE(PG8_SB(1, 0), cB + kstep, voffB); PG8_STAGE(PG8_SA(1, 0), cA + kstep, voffA); PG8_STAGE(PG8_SB(1, 1), cB + hstep + kstep, voffB);
        PG8_WAIT_V(6); PG8_BAR;
    }
    for (;;) {
        const bool has_next = S.next(ui + 1, nxt);
        const char* nA = has_next ? (const char*)g.A + (size_t)nxt.pm * tstep : cA; const char* nB = has_next ? (const char*)g.Bt + (size_t)nxt.pn * tstep : cB;
        for (int t = 0; t < nt; t += 2) {
            const bool last = (t == nt - 2);
            const char* a1 = cA + (size_t)(t + 1) * kstep;
            const char* a2 = last ? nA : cA + (size_t)(t + 2) * kstep; const char* b2 = last ? nB : cB + (size_t)(t + 2) * kstep;
            const char* a3 = a2 + kstep; const char* b3 = b2 + kstep;
            if (last && has_next) S.a_ready(nxt);
            if constexpr (SP2) {
            PG8_LDB(B0, 0, 0); PG8_LDB(B1, 0, 1); PG8_SCHED; PG8_LDA(At, 0, 0); PG8_STAGE(PG8_SA(1, 1), a1 + hstep, voffA);
            PG8_WAIT_V(8); PG8_WAIT_L(0); PG8_BAR; PG8_MMA(0, 0, At, B0); PG8_MMA(0, 1, At, B1); PG8_BAR; PG8_SCHED;
            PG8_LDA(At, 0, 1); PG8_STAGE(PG8_SB(0, 0), b2, voffB); PG8_STAGE(PG8_SB(0, 1), b2 + hstep, voffB); PG8_STAGE(PG8_SA(0, 0), a2, voffA);
            PG8_WAIT_V(8); PG8_WAIT_L(0); PG8_BAR; PG8_MMA(1, 0, At, B0); PG8_MMA(1, 1, At, B1); PG8_BAR; PG8_SCHED;
            PG8_LDB(B0, 1, 0); PG8_LDB(B1, 1, 1); PG8_SCHED; PG8_LDA(At, 1, 0); PG8_STAGE(PG8_SA(0, 1), a2 + hstep, voffA);
            PG8_WAIT_V(8); PG8_WAIT_L(0); PG8_BAR; PG8_MMA(0, 0, At, B0); PG8_MMA(0, 1, At, B1); PG8_BAR; PG8_SCHED;
            PG8_LDA(At, 1, 1); PG8_STAGE(PG8_SB(1, 0), b3, voffB); PG8_STAGE(PG8_SB(1, 1), b3 + hstep, voffB); PG8_STAGE(PG8_SA(1, 0), a3, voffA);
            PG8_WAIT_V(8); PG8_WAIT_L(0); PG8_BAR; PG8_MMA(1, 0, At, B0); PG8_MMA(1, 1, At, B1); PG8_BAR; PG8_SCHED;
            } else {
            PG8_LDB(B0, 0, 0); PG8_SCHED; PG8_LDA(At, 0, 0); PG8_STAGE(PG8_SA(1, 1), a1 + hstep, voffA);
            PG8_WAIT_L(8); PG8_BAR; PG8_WAIT_L(0); PG8_MMA(0, 0, At, B0); PG8_BAR; PG8_SCHED;
            PG8_LDB(B1, 0, 1); PG8_STAGE(PG8_SB(0, 0), b2, voffB);
            PG8_BAR; PG8_WAIT_L(0); PG8_MMA(0, 1, At, B1); PG8_BAR;
            PG8_LDA(At, 0, 1); PG8_STAGE(PG8_SA(0, 0), a2, voffA);
            PG8_BAR; PG8_WAIT_L(0); PG8_MMA(1, 0, At, B0); PG8_BAR; PG8_SCHED;
            PG8_STAGE(PG8_SB(0, 1), b2 + hstep, voffB);
            PG8_WAIT_V(6); PG8_BAR; PG8_MMA(1, 1, At, B1); PG8_BAR;
            PG8_LDB(B0, 1, 0); PG8_SCHED; PG8_LDA(At, 1, 0); PG8_STAGE(PG8_SA(0, 1), a2 + hstep, voffA);
            PG8_WAIT_L(8); PG8_BAR; PG8_WAIT_L(0); PG8_MMA(0, 0, At, B0); PG8_BAR; PG8_SCHED;
            PG8_LDB(B1, 1, 1); PG8_STAGE(PG8_SB(1, 0), b3, voffB);
            PG8_BAR; PG8_WAIT_L(0); PG8_MMA(0, 1, At, B1); PG8_BAR;
            PG8_LDA(At, 1, 1); PG8_STAGE(PG8_SA(1, 0), a3, voffA);
            PG8_BAR; PG8_WAIT_L(0); PG8_MMA(1, 0, At, B0); PG8_BAR; PG8_SCHED;
            PG8_STAGE(PG8_SB(1, 1), b3 + hstep, voffB);
            PG8_WAIT_V(6); PG8_BAR; PG8_MMA(1, 1, At, B1); PG8_BAR;
            }
        }
        if constexpr (ALIGN_EPI) { if (wr == 0) PG8_BAR; }
        if constexpr (!Epi::AFTER_DRAIN) { E(acc, cur, wr, wc, fr, fq); S.done(cur); }
        if (!has_next) break;
#pragma unroll
        for (int a = 0; a < 2; ++a)
#pragma unroll
            for (int b = 0; b < 2; ++b)
#pragma unroll
                for (int m = 0; m < 4; ++m)
#pragma unroll
                    for (int n = 0; n < 2; ++n) acc[a][b][m][n] = (f32x4){0.f, 0.f, 0.f, 0.f};
        cur = nxt; cA = nA; cB = nB; ++ui;
        if constexpr (ALIGN_EPI) { if (wr == 1) PG8_BAR; }
    }
    PG8_WAIT_V(0);
    if constexpr (!ALIGN_EPI) { if (wr == 0) PG8_BAR; }
    PG8_BAR;
    if constexpr (Epi::AFTER_DRAIN) { E.fused(acc, cur, wr, wc, fr, fq, lds, wid, lane); S.done(cur); }
#undef PG8_SA
#undef PG8_SB
#undef PG8_STAGE
#undef PG8_LDA
#undef PG8_LDB
#undef PG8_MMA
#undef PG8_WAIT_V
#undef PG8_WAIT_L
#undef PG8_BAR
#undef PG8_SCHED
}
}

template <class E> constexpr bool epi_whole = false;
DEV void gemm_first_load(const bf16_t* __restrict__ A, int lda, const bf16_t* __restrict__ Bt, int ldb, u32x4 (&ra)[4], u32x4 (&rb)[2]) {
  const int tid = tidx(), w = tid >> 6, l = tid & 63, lr = l & 15, lq = l >> 4;
#pragma unroll
  for (int j = 0; j < 4; ++j) {
    const int c = w * 4 + j, mt = c >> 1, sl = c & 1;
    ra[j] = *(const u32x4*)(A + (size_t)(mt * 16 + lr) * lda + sl * 32 + lq * 8);
  }
#pragma unroll
  for (int j = 0; j < 2; ++j) {
    const int nt = w, sl = j;
    const int rowb = (nt >> 2) * 64 + (lr >> 2) * 16 + (nt & 3) * 4 + (lr & 3);
    rb[j] = *(const u32x4*)(Bt + (size_t)rowb * ldb + sl * 32 + lq * 8);
  }
}
template <class Epi>
DEV void gemm_tile(char* lds, const bf16_t* __restrict__ A, int lda, const bf16_t* __restrict__ Bt, int ldb, int K, int trow, int tcol,
                   const Epi& epi, u32x4 (&ra)[4], u32x4 (&rb)[2], const bf16_t* __restrict__ An, const bf16_t* __restrict__ Bn) {
  const int tid = tidx(), w = tid >> 6, l = tid & 63, wm = w >> 1, wn = w & 1, lr = l & 15, lq = l >> 4;
  const bf16_t* ga[4];
  const bf16_t* gb[2];
#pragma unroll
  for (int j = 0; j < 4; ++j) {
    const int c = w * 4 + j, mt = c >> 1, sl = c & 1;
    ga[j] = A + (size_t)(mt * 16 + lr) * lda + sl * 32 + lq * 8;
  }
#pragma unroll
  for (int j = 0; j < 2; ++j) {
    const int nt = w, sl = j;
    const int rowb = (nt >> 2) * 64 + (lr >> 2) * 16 + (nt & 3) * 4 + (lr & 3);
    gb[j] = Bt + (size_t)rowb * ldb + sl * 32 + lq * 8;
  }
  f32x4 acc[4][4];
#pragma unroll
  for (int i = 0; i < 4; ++i)
#pragma unroll
    for (int j = 0; j < 4; ++j) acc[i][j] = (f32x4){0.f, 0.f, 0.f, 0.f};
  const int nk = K >> 6;
#pragma unroll
  for (int j = 0; j < 4; ++j) *(u32x4*)(lds + (w * 4 + j) * 1024 + l * 16) = ra[j];
#pragma unroll
  for (int j = 0; j < 2; ++j) *(u32x4*)(lds + 32768 + (w * 2 + j) * 1024 + l * 16) = rb[j];
  __syncthreads();
  for (int kt = 0; kt < nk; ++kt) {
    char* cur = lds + (kt & 1) * 49152;
    const bool more = (kt + 1 < nk);
    if (more) {
#pragma unroll
      for (int j = 0; j < 4; ++j) ra[j] = *(const u32x4*)(ga[j] + (kt + 1) * 64);
#pragma unroll
      for (int j = 0; j < 2; ++j) rb[j] = *(const u32x4*)(gb[j] + (kt + 1) * 64);
    }
#pragma unroll
    for (int s = 0; s < 2; ++s) {
      bf16x8 af[4], bfr[4];
#pragma unroll
      for (int i = 0; i < 4; ++i) af[i] = *(const bf16x8*)(cur + ((wm * 4 + i) * 2 + s) * 1024 + l * 16);
#pragma unroll
      for (int j = 0; j < 4; ++j) bfr[j] = *(const bf16x8*)(cur + 32768 + ((wn * 4 + j) * 2 + s) * 1024 + l * 16);
#pragma unroll
      for (int i = 0; i < 4; ++i)
#pragma unroll
        for (int j = 0; j < 4; ++j) acc[i][j] = __builtin_amdgcn_mfma_f32_16x16x32_bf16(bfr[j], af[i], acc[i][j], 0, 0, 0);
    }
    if (more) {
      char* nxt = lds + ((kt + 1) & 1) * 49152;
#pragma unroll
      for (int j = 0; j < 4; ++j) *(u32x4*)(nxt + (w * 4 + j) * 1024 + l * 16) = ra[j];
#pragma unroll
      for (int j = 0; j < 2; ++j) *(u32x4*)(nxt + 32768 + (w * 2 + j) * 1024 + l * 16) = rb[j];
    }
    __syncthreads();
  }
  if (An) gemm_first_load(An, lda, Bn, ldb, ra, rb);
  if constexpr (epi_whole<Epi>) epi.whole(trow + wm * 64 + lr, tcol + wn * 64 + lq * 16, acc);
  else {
#pragma unroll
    for (int i = 0; i < 4; ++i) epi(trow + wm * 64 + i * 16 + lr, tcol + wn * 64 + lq * 16, acc[i]);
  }
}

DEV void store16_bf16(bf16_t* dst, const f32x4 (&v)[4], float sc) {
  u32x4 a, b;
  a.x = pk2(v[0][0] * sc, v[0][1] * sc); a.y = pk2(v[0][2] * sc, v[0][3] * sc);
  a.z = pk2(v[1][0] * sc, v[1][1] * sc); a.w = pk2(v[1][2] * sc, v[1][3] * sc);
  b.x = pk2(v[2][0] * sc, v[2][1] * sc); b.y = pk2(v[2][2] * sc, v[2][3] * sc);
  b.z = pk2(v[3][0] * sc, v[3][1] * sc); b.w = pk2(v[3][2] * sc, v[3][3] * sc);
  *(u32x4*)dst = a;
  *(u32x4*)(dst + 8) = b;
}

struct EpiBf16 {
  bf16_t* O; int ldo;
  DEV void operator()(int row, int col, const f32x4 (&v)[4]) const { store16_bf16(O + (size_t)row * ldo + col, v, 1.f); }
};
struct EpiF32 {
  float* O; int ldo;
  DEV void operator()(int row, int col, const f32x4 (&v)[4]) const {
    float* d = O + (size_t)row * ldo + col;
#pragma unroll
    for (int j = 0; j < 4; ++j) *(f32x4*)(d + 4 * j) = v[j];
  }
};
struct EpiLora1 {
  bf16_t* O;
  DEV void operator()(int row, int col, const f32x4 (&v)[4]) const {
    f32x4 o[4];
#pragma unroll
    for (int j = 0; j < 4; ++j)
#pragma unroll
      for (int r = 0; r < 4; ++r) {
        const float t = v[j][r];
        o[j][r] = (col < 128) ? (1.f - 2.f * __builtin_amdgcn_rcpf(1.f + __expf(2.f * t))) : ((col < 256) ? t : sigmoidf_(t));
      }
    store16_bf16(O + (size_t)row * 384 + col, o, 1.f);
  }
};
DEV unsigned pkh(float a, float b) { return (unsigned)(a * 3000.f + 0.5f) | ((unsigned)(b * 3000.f + 0.5f) << 16); }
DEV void unpackh8(const u32x4 u, float (&f)[8]) {
  const float q = 1.f / 3000.f;
  f[0] = (float)(u.x & 0xffffu) * q; f[1] = (float)(u.x >> 16) * q; f[2] = (float)(u.y & 0xffffu) * q; f[3] = (float)(u.y >> 16) * q;
  f[4] = (float)(u.z & 0xffffu) * q; f[5] = (float)(u.z >> 16) * q; f[6] = (float)(u.w & 0xffffu) * q; f[7] = (float)(u.w >> 16) * q;
}
template <int CTRL> DEV float dppz_(float x) { return __int_as_float(__builtin_amdgcn_update_dpp(0, __float_as_int(x), CTRL, 0xF, 0xF, true)); }
struct EpiDecay {
  unsigned short* O; const float* w0; int dir;
  DEV void whole(int row0, int col, const f32x4 (&acc)[4][4]) const {
    float w0v[16];
#pragma unroll
    for (int i = 0; i < 16; i += 4) *(f32x4*)(w0v + i) = *(const f32x4*)(w0 + col + i);
    const int lane = tidx() & 63;
#pragma unroll
    for (int pr = 0; pr < 2; ++pr) {
      float E0[16], E1[16];
#pragma unroll
      for (int j = 0; j < 4; ++j)
#pragma unroll
        for (int r = 0; r < 4; ++r) {
          float e0 = 0.6065306597126334f * sigmoidf_(w0v[4 * j + r] + acc[2 * pr][j][r]);
          float e1 = 0.6065306597126334f * sigmoidf_(w0v[4 * j + r] + acc[2 * pr + 1][j][r]);
          if (dir == 0) {
            e0 += dppz_<0x111>(e0); e0 += dppz_<0x112>(e0); e0 += dppz_<0x114>(e0); e0 += dppz_<0x118>(e0);
            e1 += dppz_<0x111>(e1); e1 += dppz_<0x112>(e1); e1 += dppz_<0x114>(e1); e1 += dppz_<0x118>(e1);
            e1 += __shfl(e0, (lane & 48) | 15);
          } else {
            e0 += dppz_<0x101>(e0); e0 += dppz_<0x102>(e0); e0 += dppz_<0x104>(e0); e0 += dppz_<0x108>(e0);
            e1 += dppz_<0x101>(e1); e1 += dppz_<0x102>(e1); e1 += dppz_<0x104>(e1); e1 += dppz_<0x108>(e1);
            e0 += __shfl(e1, (lane & 48));
          }
          E0[4 * j + r] = e0; E1[4 * j + r] = e1;
        }
      u32x4 p0, p1, q0, q1;
      p0.x = pkh(E0[0], E0[1]); p0.y = pkh(E0[2], E0[3]); p0.z = pkh(E0[4], E0[5]); p0.w = pkh(E0[6], E0[7]);
      p1.x = pkh(E0[8], E0[9]); p1.y = pkh(E0[10], E0[11]); p1.z = pkh(E0[12], E0[13]); p1.w = pkh(E0[14], E0[15]);
      q0.x = pkh(E1[0], E1[1]); q0.y = pkh(E1[2], E1[3]); q0.z = pkh(E1[4], E1[5]); q0.w = pkh(E1[6], E1[7]);
      q1.x = pkh(E1[8], E1[9]); q1.y = pkh(E1[10], E1[11]); q1.z = pkh(E1[12], E1[13]); q1.w = pkh(E1[14], E1[15]);
      unsigned short* d0 = O + (size_t)(row0 + 32 * pr) * 512 + col;
      *(u32x4*)d0 = p0; *(u32x4*)(d0 + 8) = p1;
      *(u32x4*)(d0 + 16 * 512) = q0; *(u32x4*)(d0 + 16 * 512 + 8) = q1;
    }
  }
};
template <> constexpr bool epi_whole<EpiDecay> = true;
struct EpiA {
  bf16_t *AA, *KK; const float *a0, *k_k; const bf16_t* za; int writekk;
  DEV void operator()(int row, int col, const f32x4 (&v)[4]) const {
    float a0v[16];
#pragma unroll
    for (int i = 0; i < 16; i += 4) *(f32x4*)(a0v + i) = *(const f32x4*)(a0 + col + i);
    f32x4 oa[4];
#pragma unroll
    for (int j = 0; j < 4; ++j)
#pragma unroll
      for (int r = 0; r < 4; ++r) oa[j][r] = sigmoidf_(a0v[4 * j + r] + v[j][r]);
    store16_bf16(AA + (size_t)row * 512 + col, oa, 1.f);
    if (writekk) {
      const bf16_t* kp = za + (size_t)row * 2048 + 512 + col;
      const u32x4 k0 = *(const u32x4*)kp, k1 = *(const u32x4*)(kp + 8);
      float kf[16], kkv[16];
      kf[0] = lo16(k0.x); kf[1] = hi16(k0.x); kf[2] = lo16(k0.y); kf[3] = hi16(k0.y); kf[4] = lo16(k0.z); kf[5] = hi16(k0.z); kf[6] = lo16(k0.w); kf[7] = hi16(k0.w);
      kf[8] = lo16(k1.x); kf[9] = hi16(k1.x); kf[10] = lo16(k1.y); kf[11] = hi16(k1.y); kf[12] = lo16(k1.z); kf[13] = hi16(k1.z); kf[14] = lo16(k1.w); kf[15] = hi16(k1.w);
#pragma unroll
      for (int i = 0; i < 16; i += 4) *(f32x4*)(kkv + i) = *(const f32x4*)(k_k + col + i);
      float ss = 0.f;
#pragma unroll
      for (int i = 0; i < 16; ++i) { kf[i] *= kkv[i]; ss += kf[i] * kf[i]; }
      ss += __shfl_xor(ss, 16);
      ss += __shfl_xor(ss, 32);
      const float rn = rsqrtf(ss + 1e-12f);
      f32x4 okk[4];
#pragma unroll
      for (int j = 0; j < 4; ++j)
#pragma unroll
        for (int r = 0; r < 4; ++r) okk[j][r] = kf[4 * j + r] * rn;
      store16_bf16(KK + (size_t)row * 512 + col, okk, 1.f);
    }
  }
};
struct EpiDftc {
  bf16_t* CST; int g;
  DEV void operator()(int row, int col, const f32x4 (&v)[4]) const {
    const int b = col >> 11, s = col & 2047;
    store16_bf16(CST + ((size_t)((b * 2 + (row >> 7)) * 1024 + g * 128 + (row & 127)) * 2048 + s), v, 1.f);
  }
};

DEV void transpose_convert(char* lds, const float* __restrict__ W, int K, int N, bf16_t* __restrict__ Wt, int ldt, int rot, int mode = 0) {
  float* tile = (float*)lds;
  const int tn_n = N >> 6, nt = (K >> 6) * tn_n, tid = tidx();
  const int r0 = tid >> 4, c4 = (tid & 15) * 4;
  int t = (blockIdx.x + rot) % gridDim.x;
  f32x4 ra, rb;
  if (t < nt) {
    const int tk = t / tn_n, tn = t % tn_n;
    const float* src = W + (size_t)(tk * 64 + r0) * N + tn * 64 + c4;
    ra = *(const f32x4*)src; rb = *(const f32x4*)(src + (size_t)32 * N);
  }
  for (; t < nt; t += gridDim.x) {
    const int tk = t / tn_n, tn = t % tn_n;
#pragma unroll
    for (int i = 0; i < 4; ++i) { tile[r0 * 65 + c4 + i] = ra[i]; tile[(r0 + 32) * 65 + c4 + i] = rb[i]; }
    __syncthreads();
    const int t2 = t + gridDim.x;
    if (t2 < nt) {
      const int tk2 = t2 / tn_n, tn2 = t2 % tn_n;
      const float* src = W + (size_t)(tk2 * 64 + r0) * N + tn2 * 64 + c4;
      ra = *(const f32x4*)src; rb = *(const f32x4*)(src + (size_t)32 * N);
    }
    int nbase = tn * 64;
    if (mode == 1) { const int c = tn * 64; nbase = (c < 2816) ? ((c >> 7) * 256 + (c & 127)) : (((c - 2816) >> 7) * 256 + 128 + ((c - 2816) & 127)); }
    const bool qk = (mode == 2) && (tn * 64 >= 2048) && (tn * 64 < 3072);
#pragma unroll
    for (int j = 0; j < 2; ++j) {
      const int ns = r0 + 32 * j;
      const int n = qk ? (2 * (ns & 31) + (ns >> 5)) : ns;
      u32x2 pk;
      pk.x = pk2(tile[(c4 + 0) * 65 + ns], tile[(c4 + 1) * 65 + ns]);
      pk.y = pk2(tile[(c4 + 2) * 65 + ns], tile[(c4 + 3) * 65 + ns]);
      *(u32x2*)(Wt + (size_t)(nbase + n) * ldt + tk * 64 + c4) = pk;
    }
    __syncthreads();
  }
}

DEV void compute_mod(char* lds, const P& p) {
  float* cs = (float*)lds;
  float* red = (float*)(lds + 32768);
  const int tid = tidx();
  float* mod = (float*)(p.ws + W_MOD);
  bool have = false;
  for (int item = blockIdx.x; item < 192; item += gridDim.x) {
    if (!have) {
      for (int i = tid; i < 8192; i += NTHR) { const float cv = p.c[i]; cs[i] = cv / (1.f + expf(-cv)); }
      __syncthreads();
      have = true;
    }
    const int l = item / 96, cb = item % 96, col = cb * 64 + (tid & 63), kg = tid >> 6;
    float a0 = 0, a1 = 0, a2 = 0, a3 = 0, a4 = 0, a5 = 0, a6 = 0, a7 = 0;
    const float* wp = p.ada_w + ((size_t)l * 1024 + kg * 128) * 6144 + col;
    for (int k0 = 0; k0 < 128; k0 += 16) {
      float wv[16];
#pragma unroll
      for (int u = 0; u < 16; ++u) wv[u] = wp[(size_t)(k0 + u) * 6144];
#pragma unroll
      for (int u = 0; u < 16; ++u) {
        const int kk = kg * 128 + k0 + u;
        a0 += cs[kk] * wv[u]; a1 += cs[1024 + kk] * wv[u]; a2 += cs[2048 + kk] * wv[u]; a3 += cs[3072 + kk] * wv[u];
        a4 += cs[4096 + kk] * wv[u]; a5 += cs[5120 + kk] * wv[u]; a6 += cs[6144 + kk] * wv[u]; a7 += cs[7168 + kk] * wv[u];
      }
    }
    float* rp = red + kg * 512 + (tid & 63);
    rp[0] = a0; rp[64] = a1; rp[128] = a2; rp[192] = a3; rp[256] = a4; rp[320] = a5; rp[384] = a6; rp[448] = a7;
    __syncthreads();
    {
      const int b = tid >> 6, cc = tid & 63;
      float s = 0.f;
#pragma unroll
      for (int g = 0; g < 8; ++g) s += red[g * 512 + b * 64 + cc];
      mod[(size_t)(l * 8 + b) * 6144 + cb * 64 + cc] = s + p.ada_b[l * 6144 + cb * 64 + cc];
    }
    __syncthreads();
  }
}

template <bool HAS_Y, bool HAS_H, bool XIN_BF = false, bool XOUT_BF = false>
DEV void rowpass(const void* __restrict__ xin_, const bf16_t* __restrict__ yf, const float* __restrict__ gy, const float* __restrict__ gate,
                 void* __restrict__ xout_, const float* __restrict__ gh, const float* __restrict__ sc, const float* __restrict__ sh,
                 bf16_t* __restrict__ h) {
  const float* xin = (const float*)xin_; const bf16_t* xinb = (const bf16_t*)xin_;
  float* xout = (float*)xout_; bf16_t* xoutb = (bf16_t*)xout_;
  const int lane = tidx() & 63, gw = blockIdx.x * 8 + (tidx() >> 6), nw = gridDim.x * 8;
  for (int row = gw; row < MT; row += nw) {
    const int b = row >> 12;
    f32x4 xv[4];
#pragma unroll
    for (int i = 0; i < 4; ++i) {
      if (XIN_BF) { const u32x2 xu = *(const u32x2*)(xinb + (size_t)row * 1024 + i * 256 + lane * 4); xv[i] = (f32x4){lo16(xu.x), hi16(xu.x), lo16(xu.y), hi16(xu.y)}; }
      else xv[i] = *(const f32x4*)(xin + (size_t)row * 1024 + i * 256 + lane * 4);
    }
    if (HAS_Y) {
      f32x4 yv[4];
      float ss = 0.f;
#pragma unroll
      for (int i = 0; i < 4; ++i) {
        const u32x2 yu = *(const u32x2*)(yf + (size_t)row * 1024 + i * 256 + lane * 4);
        yv[i] = (f32x4){lo16(yu.x), hi16(yu.x), lo16(yu.y), hi16(yu.y)};
        ss += yv[i][0] * yv[i][0] + yv[i][1] * yv[i][1] + yv[i][2] * yv[i][2] + yv[i][3] * yv[i][3];
      }
      ss = wave_sum(ss);
      const float rs = rsqrtf(ss * (1.f / 1024.f) + 1e-6f);
#pragma unroll
      for (int i = 0; i < 4; ++i) {
        const int col = i * 256 + lane * 4;
        const f32x4 g4 = *(const f32x4*)(gy + col), gt = *(const f32x4*)(gate + (size_t)b * 6144 + col);
        xv[i] = xv[i] + gt * (yv[i] * rs * g4);
        if (XOUT_BF) { u32x2 pk; pk.x = pk2(xv[i][0], xv[i][1]); pk.y = pk2(xv[i][2], xv[i][3]); *(u32x2*)(xoutb + (size_t)row * 1024 + col) = pk;
                       xv[i] = (f32x4){lo16(pk.x), hi16(pk.x), lo16(pk.y), hi16(pk.y)}; }
        else *(f32x4*)(xout + (size_t)row * 1024 + col) = xv[i];
      }
    }
    if (HAS_H) {
      float ss = 0.f;
#pragma unroll
      for (int i = 0; i < 4; ++i) ss += xv[i][0] * xv[i][0] + xv[i][1] * xv[i][1] + xv[i][2] * xv[i][2] + xv[i][3] * xv[i][3];
      ss = wave_sum(ss);
      const float rs = rsqrtf(ss * (1.f / 1024.f) + 1e-6f);
#pragma unroll
      for (int i = 0; i < 4; ++i) {
        const int col = i * 256 + lane * 4;
        const f32x4 g4 = *(const f32x4*)(gh + col), s4 = *(const f32x4*)(sc + (size_t)b * 6144 + col), h4 = *(const f32x4*)(sh + (size_t)b * 6144 + col);
        const f32x4 o = (xv[i] * rs * g4) * (s4 + 1.f) + h4;
        u32x2 pk;
        pk.x = pk2(o[0], o[1]); pk.y = pk2(o[2], o[3]);
        *(u32x2*)(h + (size_t)row * 1024 + col) = pk;
      }
    }
  }
}

DEV void row_xh(int row, bf16_t* __restrict__ xb, const bf16_t* __restrict__ yf, const float* __restrict__ gy, const float* __restrict__ gate,
                const float* __restrict__ gh, const float* __restrict__ sc, const float* __restrict__ sh, int lane, f32x4 (&hv)[4]) {
  const int b = row >> 12;
  f32x4 xv[4], yv[4];
  float ss = 0.f;
#pragma unroll
  for (int i = 0; i < 4; ++i) {
    const u32x2 xu = *(const u32x2*)(xb + (size_t)row * 1024 + i * 256 + lane * 4), yu = *(const u32x2*)(yf + (size_t)row * 1024 + i * 256 + lane * 4);
    xv[i] = (f32x4){lo16(xu.x), hi16(xu.x), lo16(xu.y), hi16(xu.y)};
    yv[i] = (f32x4){lo16(yu.x), hi16(yu.x), lo16(yu.y), hi16(yu.y)};
    ss += yv[i][0] * yv[i][0] + yv[i][1] * yv[i][1] + yv[i][2] * yv[i][2] + yv[i][3] * yv[i][3];
  }
  ss = wave_sum(ss);
  const float rs = rsqrtf(ss * (1.f / 1024.f) + 1e-6f);
  float s2 = 0.f;
#pragma unroll
  for (int i = 0; i < 4; ++i) {
    const int col = i * 256 + lane * 4;
    const f32x4 g4 = *(const f32x4*)(gy + col), gt = *(const f32x4*)(gate + (size_t)b * 6144 + col);
    const f32x4 xn = xv[i] + gt * (yv[i] * rs * g4);
    u32x2 pk; pk.x = pk2(xn[0], xn[1]); pk.y = pk2(xn[2], xn[3]);
    *(u32x2*)(xb + (size_t)row * 1024 + col) = pk;
    xv[i] = (f32x4){lo16(pk.x), hi16(pk.x), lo16(pk.y), hi16(pk.y)};
    s2 += xv[i][0] * xv[i][0] + xv[i][1] * xv[i][1] + xv[i][2] * xv[i][2] + xv[i][3] * xv[i][3];
  }
  s2 = wave_sum(s2);
  const float r2 = rsqrtf(s2 * (1.f / 1024.f) + 1e-6f);
#pragma unroll
  for (int i = 0; i < 4; ++i) {
    const int col = i * 256 + lane * 4;
    const f32x4 g4 = *(const f32x4*)(gh + col), s4 = *(const f32x4*)(sc + (size_t)b * 6144 + col), h4 = *(const f32x4*)(sh + (size_t)b * 6144 + col);
    hv[i] = (xv[i] * r2 * g4) * (s4 + 1.f) + h4;
  }
}
DEV void rowpass_fold(bf16_t* __restrict__ xb, const bf16_t* __restrict__ yf, const float* __restrict__ gy, const float* __restrict__ gate,
                      const float* __restrict__ gh, const float* __restrict__ sc, const float* __restrict__ sh, bf16_t* __restrict__ hfd, float* __restrict__ h2048) {
  const int lane = tidx() & 63, gw = blockIdx.x * 8 + (tidx() >> 6), nw = gridDim.x * 8;
  for (int item = gw; item < 8 * 2048; item += nw) {
    const int b = item >> 11, s = item & 2047;
    const int rowA = b * 4096 + s, rowB = b * 4096 + (s ? 4096 - s : 2048);
    f32x4 ha[4], hb[4];
    row_xh(rowA, xb, yf, gy, gate, gh, sc, sh, lane, ha);
    row_xh(rowB, xb, yf, gy, gate, gh, sc, sh, lane, hb);
#pragma unroll
    for (int i = 0; i < 4; ++i) {
      const int col = i * 256 + lane * 4, g = col >> 7, c = col & 127;
      f32x4 f = ha[i] + hb[i], dd = ha[i] - hb[i];
      if (s == 0) { f = ha[i]; dd = (f32x4){0.f, 0.f, 0.f, 0.f}; *(f32x4*)(h2048 + b * 1024 + col) = hb[i]; }
      bf16_t* dp = hfd + (size_t)(b * 2048 + s) * 2048 + g * 256 + c;
      u32x2 pk;
      pk.x = pk2(f[0], f[1]); pk.y = pk2(f[2], f[3]); *(u32x2*)dp = pk;
      pk.x = pk2(dd[0], dd[1]); pk.y = pk2(dd[2], dd[3]); *(u32x2*)(dp + 128) = pk;
    }
  }
}

DEV void unpack8(const u32x4 u, float (&f)[8]) {
  f[0] = lo16(u.x); f[1] = hi16(u.x); f[2] = lo16(u.y); f[3] = hi16(u.y); f[4] = lo16(u.z); f[5] = hi16(u.z); f[6] = lo16(u.w); f[7] = hi16(u.w);
}
DEV u32x4 pack8(const float (&f)[8]) {
  u32x4 u;
  u.x = pk2(f[0], f[1]); u.y = pk2(f[2], f[3]); u.z = pk2(f[4], f[5]); u.w = pk2(f[6], f[7]);
  return u;
}

DEV void prep1(const P& p) {
  const bf16_t* z = (const bf16_t*)(p.ws + O_Z);
  bf16_t* za = (bf16_t*)p.out;
  bf16_t* qr = (bf16_t*)(p.ws + O_QR);
  bf16_t* kr = (bf16_t*)(p.ws + O_KR);
  bf16_t* vt = (bf16_t*)(p.ws + O_VT);
  const float* rope = (const float*)(p.ws + W_ROPE);
  const int gt = blockIdx.x * NTHR + tidx(), ngt = gridDim.x * NTHR;
  for (int idx = gt; idx < MT * 256; idx += ngt) {
    const int tok = idx >> 8, c8 = (idx & 255) * 8, s = tok & 4095;
    const bf16_t* zp = z + (size_t)tok * INC + c8;
    float zc[8], zm[8], zn[8], o[8];
    unpack8(*(const u32x4*)zp, zc);
    if (s > 0) unpack8(*(const u32x4*)(zp - INC), zm); else { for (int i = 0; i < 8; ++i) zm[i] = 0.f; }
    if (s < 4095) unpack8(*(const u32x4*)(zp + INC), zn); else { for (int i = 0; i < 8; ++i) zn[i] = 0.f; }
    float w0[8], w1[8], w2[8];
    *(f32x4*)w0 = *(const f32x4*)(p.mix_conv + c8); *(f32x4*)(w0 + 4) = *(const f32x4*)(p.mix_conv + c8 + 4);
    *(f32x4*)w1 = *(const f32x4*)(p.mix_conv + 2048 + c8); *(f32x4*)(w1 + 4) = *(const f32x4*)(p.mix_conv + 2048 + c8 + 4);
    *(f32x4*)w2 = *(const f32x4*)(p.mix_conv + 4096 + c8); *(f32x4*)(w2 + 4) = *(const f32x4*)(p.mix_conv + 4096 + c8 + 4);
#pragma unroll
    for (int i = 0; i < 8; ++i) o[i] = zm[i] * w0[i] + zc[i] * w1[i] + zn[i] * w2[i];
    *(u32x4*)(za + (size_t)tok * 2048 + c8) = pack8(o);
  }
  for (int idx = gt; idx < MT * 64; idx += ngt) {
    const int e8 = idx & 3, which = (idx >> 2) & 1, h = (idx >> 3) & 7, tok = idx >> 6, s = tok & 4095;
    const bf16_t* src = z + (size_t)tok * INC + 2048 + which * 512 + h * 64 + e8 * 8;
    float x1[8], x2[8], o1[8], o2[8];
    unpack8(*(const u32x4*)src, x1);
    unpack8(*(const u32x4*)(src + 32), x2);
    const float* rp = rope + ((size_t)s * 32 + e8 * 8) * 2;
    const float scl = which ? 1.f : 0.125f;
#pragma unroll
    for (int i = 0; i < 8; ++i) {
      const float cv = rp[2 * i], sv = rp[2 * i + 1];
      o1[i] = (x1[i] * cv - x2[i] * sv) * scl;
      o2[i] = (x2[i] * cv + x1[i] * sv) * scl;
    }
    bf16_t* dst = (which ? kr : qr) + (size_t)tok * 512 + h * 64 + e8 * 8;
    *(u32x4*)dst = pack8(o1);
    *(u32x4*)(dst + 32) = pack8(o2);
  }
  {
    bf16_t* vr = (bf16_t*)(p.ws + O_VT);
    for (int idx = gt; idx < MT * 64; idx += ngt) {
      const int tok = idx >> 6, c8 = (idx & 63) * 8;
      *(u32x4*)(vr + (size_t)tok * 512 + c8) = *(const u32x4*)(z + (size_t)tok * INC + 3072 + c8);
    }
  }
}

DEV void za_fixup(const P& p) {
  const bf16_t* sb = (const bf16_t*)(p.ws + O_SBZ);
  bf16_t* za = (bf16_t*)p.out;
  const int gt = blockIdx.x * NTHR + tidx(), ngt = gridDim.x * NTHR;
  for (int item = gt; item < 512 * 2 * 256; item += ngt) {
    const int strip = item >> 9, e = (item >> 8) & 1, c8 = (item & 255) * 8;
    const int R = strip * 64 + (e ? 63 : 0), s = R & 4095;
    const bf16_t* pc = sb + ((size_t)strip * 4 + (e ? 3 : 0)) * 2048 + c8;
    const u32x4 z0 = (u32x4){0u, 0u, 0u, 0u};
    const bool hasp = e ? true : (s > 0), hasn = e ? (s < 4095) : true;
    float zm[8], zc[8], zn[8], o[8], w0[8], w1[8], w2[8];
    unpack8(hasp ? *(const u32x4*)(pc - 2048) : z0, zm);
    unpack8(*(const u32x4*)pc, zc);
    unpack8(hasn ? *(const u32x4*)(pc + 2048) : z0, zn);
    *(f32x4*)w0 = *(const f32x4*)(p.mix_conv + c8); *(f32x4*)(w0 + 4) = *(const f32x4*)(p.mix_conv + c8 + 4);
    *(f32x4*)w1 = *(const f32x4*)(p.mix_conv + 2048 + c8); *(f32x4*)(w1 + 4) = *(const f32x4*)(p.mix_conv + 2048 + c8 + 4);
    *(f32x4*)w2 = *(const f32x4*)(p.mix_conv + 4096 + c8); *(f32x4*)(w2 + 4) = *(const f32x4*)(p.mix_conv + 4096 + c8 + 4);
#pragma unroll
    for (int i = 0; i < 8; ++i) o[i] = zm[i] * w0[i] + zc[i] * w1[i] + zn[i] * w2[i];
    *(u32x4*)(za + (size_t)R * 2048 + c8) = pack8(o);
  }
}

DEV void za_fixup_u(const P& p, int tm) {
  const bf16_t* sb = (const bf16_t*)(p.ws + O_SBZ);
  bf16_t* za = (bf16_t*)p.out;
  const int item = tidx();
  const int strip = tm * 4 + (item >> 7), e = (item >> 6) & 1, c8 = 1536 + (item & 63) * 8;
  const int R = strip * 64 + (e ? 63 : 0), s = R & 4095;
  const bf16_t* pc = sb + ((size_t)strip * 4 + (e ? 3 : 0)) * 2048 + c8;
  const u32x4 z0 = (u32x4){0u, 0u, 0u, 0u};
  const bool hasp = e ? true : (s > 0), hasn = e ? (s < 4095) : true;
  float zm[8], zc[8], zn[8], o[8], w0[8], w1[8], w2[8];
  unpack8(hasp ? *(const u32x4*)(pc - 2048) : z0, zm);
  unpack8(*(const u32x4*)pc, zc);
  unpack8(hasn ? *(const u32x4*)(pc + 2048) : z0, zn);
  *(f32x4*)w0 = *(const f32x4*)(p.mix_conv + c8); *(f32x4*)(w0 + 4) = *(const f32x4*)(p.mix_conv + c8 + 4);
  *(f32x4*)w1 = *(const f32x4*)(p.mix_conv + 2048 + c8); *(f32x4*)(w1 + 4) = *(const f32x4*)(p.mix_conv + 2048 + c8 + 4);
  *(f32x4*)w2 = *(const f32x4*)(p.mix_conv + 4096 + c8); *(f32x4*)(w2 + 4) = *(const f32x4*)(p.mix_conv + 4096 + c8 + 4);
#pragma unroll
  for (int i = 0; i < 8; ++i) o[i] = zm[i] * w0[i] + zc[i] * w1[i] + zn[i] * w2[i];
  *(u32x4*)(za + (size_t)R * 2048 + c8) = pack8(o);
}

DEV void attention(char* lds, const P& p) {
  const bf16_t* qr = (const bf16_t*)(p.ws + O_QR);
  const bf16_t* kr = (const bf16_t*)(p.ws + O_KR);
  const bf16_t* vt = (const bf16_t*)(p.ws + O_VT);
  bf16_t* num = (bf16_t*)(p.ws + O_NUM);
  float* md = (float*)(p.ws + O_MD);
  constexpr int UNIT_LDS = 24576 + 64 * 400;
  const int tid = tidx(), w = tid >> 6, lane = tid & 63, lr = lane & 15, lq = lane >> 4;
  const int uh = tid >> 8, lt = tid & 255, mt = w & 3;
  char* ul = lds + uh * UNIT_LDS;
  u32x4 pre[12];
  bf16x8 qn[2];
  auto load_pair = [&](int pi) {
    const int unit = pi * 2 + uh;
    const int nb = unit & 63, h = (unit >> 6) & 7, b = (unit >> 9) & 7, br = unit >> 12;
    const int dsh = 2 * br, Mr = 4096 >> dsh;
    const int seg = (nb * 64) / Mr, segstart = seg * Mr, segend = segstart + Mr;
    const bool pv_ok = (nb * 64 - 64 >= segstart), nx_ok = (nb * 64 + 128 <= segend);
#pragma unroll
    for (int j = 0; j < 6; ++j) {
      const int pc = lt + 256 * j, key = pc >> 3, ch = pc & 7, kb = key >> 6;
      int blk = nb + kb - 1;
      if ((kb == 0 && !pv_ok) || (kb == 2 && !nx_ok)) blk = nb;
      const int kp = blk * 64 + (key & 63);
      const int ktok = b * 4096 + (((kp - segstart) << dsh) + seg);
      pre[j] = *(const u32x4*)(kr + (size_t)ktok * 512 + h * 64 + ch * 8);
      pre[6 + j] = *(const u32x4*)(vt + (size_t)ktok * 512 + h * 64 + ch * 8);
    }
    {
      const int qp = nb * 64 + mt * 16 + lr;
      const int qtok = b * 4096 + (((qp - segstart) << dsh) + seg);
      qn[0] = *(const bf16x8*)(qr + (size_t)qtok * 512 + h * 64 + lq * 8);
      qn[1] = *(const bf16x8*)(qr + (size_t)qtok * 512 + h * 64 + 32 + lq * 8);
    }
  };
  const int npairs = 3 * 4096 / 2;
  int pi = blockIdx.x;
  if (pi < npairs) load_pair(pi);
  for (; pi < npairs; pi += gridDim.x) {
#pragma unroll
    for (int j = 0; j < 6; ++j) {
      const int pc = lt + 256 * j, key = pc >> 3, ch = pc & 7;
      *(u32x4*)(ul + key * 128 + ((ch ^ (key & 7)) * 16)) = pre[j];
    }
#pragma unroll
    for (int j = 0; j < 6; ++j) {
      const int pc = lt + 256 * j, key = pc >> 3, ch = pc & 7;
      bf16_t* vd = (bf16_t*)(ul + 24576 + (ch * 8) * 400) + (key ^ (ch << 2));
      const u32x4 u = pre[6 + j];
      vd[0 * 200] = (bf16_t)(u.x & 0xffff); vd[1 * 200] = (bf16_t)(u.x >> 16); vd[2 * 200] = (bf16_t)(u.y & 0xffff); vd[3 * 200] = (bf16_t)(u.y >> 16);
      vd[4 * 200] = (bf16_t)(u.z & 0xffff); vd[5 * 200] = (bf16_t)(u.z >> 16); vd[6 * 200] = (bf16_t)(u.w & 0xffff); vd[7 * 200] = (bf16_t)(u.w >> 16);
    }
    __syncthreads();
    const int unit = pi * 2 + uh;
    const int nb = unit & 63, h = (unit >> 6) & 7, b = (unit >> 9) & 7, br = unit >> 12;
    const int dsh = 2 * br, Mr = 4096 >> dsh;
    const int seg = (nb * 64) / Mr, segstart = seg * Mr, segend = segstart + Mr;
    const bool pv_ok = (nb * 64 - 64 >= segstart), nx_ok = (nb * 64 + 128 <= segend);
    const int qp = nb * 64 + mt * 16 + lr;
    const int qtok = b * 4096 + (((qp - segstart) << dsh) + seg);
    bf16x8 qf[2];
    qf[0] = qn[0]; qf[1] = qn[1];
    if (pi + (int)gridDim.x < npairs) load_pair(pi + gridDim.x);
    f32x4 sacc[12];
#pragma unroll
    for (int kt = 0; kt < 12; ++kt) {
      const int key = kt * 16 + lr;
      const bf16x8 k0 = *(const bf16x8*)(ul + key * 128 + ((lq ^ (key & 7)) * 16));
      const bf16x8 k1 = *(const bf16x8*)(ul + key * 128 + (((4 + lq) ^ (key & 7)) * 16));
      f32x4 a = (f32x4){0.f, 0.f, 0.f, 0.f};
      a = __builtin_amdgcn_mfma_f32_16x16x32_bf16(k0, qf[0], a, 0, 0, 0);
      a = __builtin_amdgcn_mfma_f32_16x16x32_bf16(k1, qf[1], a, 0, 0, 0);
      sacc[kt] = a;
    }
    const int qi = mt * 16 + lr;
    float mx = -1e30f;
#pragma unroll
    for (int kt = 0; kt < 12; ++kt) {
      const int kb = kt >> 2;
#pragma unroll
      for (int r = 0; r < 4; ++r) {
        const int kj = (kt & 3) * 16 + lq * 4 + r;
        bool ok = true;
        if (kb == 0) ok = pv_ok && (kj >= qi);
        if (kb == 2) ok = nx_ok && (kj <= qi);
        const float sv = ok ? sacc[kt][r] : -1e30f;
        sacc[kt][r] = sv;
        mx = fmaxf(mx, sv);
      }
    }
    mx = fmaxf(mx, __shfl_xor(mx, 16));
    mx = fmaxf(mx, __shfl_xor(mx, 32));
    float den = 0.f;
#pragma unroll
    for (int kt = 0; kt < 12; ++kt)
#pragma unroll
      for (int r = 0; r < 4; ++r) {
        const float pe = __expf(sacc[kt][r] - mx);
        sacc[kt][r] = pe;
        den += pe;
      }
    den += __shfl_xor(den, 16);
    den += __shfl_xor(den, 32);
    f32x4 oacc[4];
#pragma unroll
    for (int et = 0; et < 4; ++et) oacc[et] = (f32x4){0.f, 0.f, 0.f, 0.f};
#pragma unroll
    for (int t = 0; t < 6; ++t) {
      u32x4 pu;
      pu.x = pk2(sacc[2 * t][0], sacc[2 * t][1]); pu.y = pk2(sacc[2 * t][2], sacc[2 * t][3]);
      pu.z = pk2(sacc[2 * t + 1][0], sacc[2 * t + 1][1]); pu.w = pk2(sacc[2 * t + 1][2], sacc[2 * t + 1][3]);
      const bf16x8 pf = __builtin_bit_cast(bf16x8, pu);
#pragma unroll
      for (int et = 0; et < 4; ++et) {
        const char* vrow = ul + 24576 + (et * 16 + lr) * 400;
        const int sw = ((et * 2 + (lr >> 3)) & 7) << 2;
        const u32x2 v0 = *(const u32x2*)(vrow + (((2 * t) * 16 + lq * 4) ^ sw) * 2), v1 = *(const u32x2*)(vrow + (((2 * t + 1) * 16 + lq * 4) ^ sw) * 2);
        u32x4 vu;
        vu.x = v0.x; vu.y = v0.y; vu.z = v1.x; vu.w = v1.y;
        oacc[et] = __builtin_amdgcn_mfma_f32_16x16x32_bf16(__builtin_bit_cast(bf16x8, vu), pf, oacc[et], 0, 0, 0);
      }
    }
    bf16_t* np = num + ((size_t)br * MT + qtok) * 512 + h * 64 + lq * 4;
#pragma unroll
    for (int et = 0; et < 4; ++et) { u32x2 w; w.x = pk2(oacc[et][0], oacc[et][1]); w.y = pk2(oacc[et][2], oacc[et][3]); *(u32x2*)(np + et * 16) = w; }
    if (lq == 0) {
      f32x2 o;
      o.x = mx; o.y = den;
      *(f32x2*)(md + (((size_t)br * MT + qtok) * 8 + h) * 2) = o;
    }
    __syncthreads();
  }
}

DEV void combineA(const P& p) {
  const bf16_t* num = (const bf16_t*)(p.ws + O_NUM);
  const float* md = (const float*)(p.ws + O_MD);
  bf16_t* ycat = (bf16_t*)(p.ws + O_YCAT);
  const int gt = blockIdx.x * NTHR + tidx(), ngt = gridDim.x * NTHR;
  for (int idx = gt; idx < MT * 128; idx += ngt) {
    const int e4 = idx & 15, h = (idx >> 4) & 7, tok = idx >> 7;
    f32x2 m0 = *(const f32x2*)(md + (((size_t)0 * MT + tok) * 8 + h) * 2);
    f32x2 m1 = *(const f32x2*)(md + (((size_t)1 * MT + tok) * 8 + h) * 2);
    f32x2 m2 = *(const f32x2*)(md + (((size_t)2 * MT + tok) * 8 + h) * 2);
    const float ma = fmaxf(m0.x, fmaxf(m1.x, m2.x));
    const float e0 = __expf(m0.x - ma), e1 = __expf(m1.x - ma), e2 = __expf(m2.x - ma);
    const float dn = e0 * m0.y + e1 * m1.y + e2 * m2.y;
    const u32x2 u0 = *(const u32x2*)(num + ((size_t)0 * MT + tok) * 512 + h * 64 + e4 * 4);
    const u32x2 u1 = *(const u32x2*)(num + ((size_t)1 * MT + tok) * 512 + h * 64 + e4 * 4);
    const u32x2 u2 = *(const u32x2*)(num + ((size_t)2 * MT + tok) * 512 + h * 64 + e4 * 4);
    const f32x4 n0 = (f32x4){lo16(u0.x), hi16(u0.x), lo16(u0.y), hi16(u0.y)}, n1 = (f32x4){lo16(u1.x), hi16(u1.x), lo16(u1.y), hi16(u1.y)},
                n2 = (f32x4){lo16(u2.x), hi16(u2.x), lo16(u2.y), hi16(u2.y)};
    const f32x4 o = (n0 * e0 + n1 * e1 + n2 * e2) * (1.f / dn);
    u32x2 pk;
    pk.x = pk2(o[0], o[1]); pk.y = pk2(o[2], o[3]);
    *(u32x2*)(ycat + (size_t)tok * 1024 + 512 + h * 64 + e4 * 4) = pk;
  }
}

DEV float dpp_allreduce16(float x) {
  x += __int_as_float(__builtin_amdgcn_update_dpp(0, __float_as_int(x), 0xB1, 0xF, 0xF, true));
  x += __int_as_float(__builtin_amdgcn_update_dpp(0, __float_as_int(x), 0x4E, 0xF, 0xF, true));
  x += __int_as_float(__builtin_amdgcn_update_dpp(0, __float_as_int(x), 0x141, 0xF, 0xF, true));
  x += __int_as_float(__builtin_amdgcn_update_dpp(0, __float_as_int(x), 0x140, 0xF, 0xF, true));
  return x;
}

DEV void scan_phase(char* lds, const P& p) {
  const bf16_t* omw = (const bf16_t*)(p.ws + O_OMW);
  const bf16_t* kd = (const bf16_t*)(p.ws + O_KD);
  const bf16_t* kka = (const bf16_t*)(p.ws + O_KKA);
  const bf16_t* kk = (const bf16_t*)(p.ws + O_KK);
  const bf16_t* za = (const bf16_t*)p.out;
  bf16_t* Y = (bf16_t*)(p.ws + O_Y);
  float* inb = (float*)lds;
  float* ypart = (float*)(lds + 98304);
  const int tid = tidx(), w = tid >> 6, lane = tid & 63, rg = lane >> 4, jl = lane & 15, j0 = jl * 4;
  for (int it = blockIdx.x; it < 256; it += gridDim.x) {
    const int sc = it >> 1, half = it & 1, d = sc >> 6, b = (sc >> 3) & 7, h = sc & 7;
    if (w >= 4) {
      const int lt = tid - 256;
      const int li = lt >> 3, pc = lt & 7;
      const int t0 = d ? (4095 - li) : li;
      const size_t tok0 = (size_t)(b * 4096 + t0);
      const bf16_t* s_omw = omw + (size_t)d * MT * 512 + tok0 * 512 + h * 64 + pc * 8;
      const bf16_t* s_a = kd + (size_t)d * MT * 512 + tok0 * 512 + h * 64 + pc * 8;
      const bf16_t* s_kk = kk + tok0 * 512 + h * 64 + pc * 8;
      const bf16_t* s_z = za + tok0 * 2048 + h * 64 + pc * 8;
      const ptrdiff_t st5 = (ptrdiff_t)512 * 32 * (d ? -1 : 1), st2 = (ptrdiff_t)2048 * 32 * (d ? -1 : 1);
      const int dst0 = li * 384 + pc * 8;
      float kav[8];
      *(f32x4*)kav = *(const f32x4*)(p.k_a + h * 64 + pc * 8); *(f32x4*)(kav + 4) = *(const f32x4*)(p.k_a + h * 64 + pc * 8 + 4);
      u32x4 rr[7];
      const ptrdiff_t prevoff = (li == 0) ? 0 : (d ? 512 : -512);
#define SCAN_LOAD(cc) do { rr[0] = *(const u32x4*)(s_omw + st5 * (cc)); rr[1] = *(const u32x4*)(s_a + st5 * (cc)); rr[2] = *(const u32x4*)(s_kk + st5 * (cc)); \
        rr[3] = *(const u32x4*)(s_z + 512 + st2 * (cc)); rr[4] = *(const u32x4*)(s_z + st2 * (cc)); rr[5] = *(const u32x4*)(s_z + 1024 + st2 * (cc)); \
        rr[6] = *(const u32x4*)(s_omw + st5 * (cc) + prevoff); } while (0)
#define SCAN_FILL(dstbuf) do { float fo[8], fa[8], fk[8], fx[8], fr[8], fv[8], fw[8], fd[8], fq[8], fp[8]; \
        unpackh8(rr[0], fo); unpack8(rr[1], fa); unpack8(rr[2], fk); unpack8(rr[3], fx); unpack8(rr[4], fr); unpack8(rr[5], fv); unpackh8(rr[6], fp); \
        _Pragma("unroll") for (int i_ = 0; i_ < 8; ++i_) { \
          const float einc_ = __expf(fo[i_]), pinc_ = __expf(-fo[i_]), pexc_ = (li == 0) ? 1.f : __expf(-fp[i_]);     \
          fw[i_] = pinc_;                                                      \
          fd[i_] = fx[i_] * (1.f + (fa[i_] - 1.f) * kav[i_]) * einc_;          \
          fq[i_] = fk[i_] * fa[i_] * einc_;                                    \
          fk[i_] = fk[i_] * pexc_;                                             \
          fr[i_] = fr[i_] * pinc_; }                                           \
        float* o_ = (dstbuf) + dst0; \
        *(f32x4*)(o_) = (f32x4){fw[0], fw[1], fw[2], fw[3]}; *(f32x4*)(o_ + 4) = (f32x4){fw[4], fw[5], fw[6], fw[7]}; \
        *(f32x4*)(o_ + 64) = (f32x4){fd[0], fd[1], fd[2], fd[3]}; *(f32x4*)(o_ + 68) = (f32x4){fd[4], fd[5], fd[6], fd[7]}; \
        *(f32x4*)(o_ + 128) = (f32x4){fq[0], fq[1], fq[2], fq[3]}; *(f32x4*)(o_ + 132) = (f32x4){fq[4], fq[5], fq[6], fq[7]}; \
        *(f32x4*)(o_ + 192) = (f32x4){fk[0], fk[1], fk[2], fk[3]}; *(f32x4*)(o_ + 196) = (f32x4){fk[4], fk[5], fk[6], fk[7]}; \
        *(f32x4*)(o_ + 256) = (f32x4){fr[0], fr[1], fr[2], fr[3]}; *(f32x4*)(o_ + 260) = (f32x4){fr[4], fr[5], fr[6], fr[7]}; \
        *(f32x4*)(o_ + 320) = (f32x4){fv[0], fv[1], fv[2], fv[3]}; *(f32x4*)(o_ + 324) = (f32x4){fv[4], fv[5], fv[6], fv[7]}; } while (0)
      SCAN_LOAD(0);
      SCAN_FILL(inb);
      SCAN_LOAD(1);
      __syncthreads();
      for (int c = 0; c < 128; ++c) {
        if (c + 1 < 128) SCAN_FILL(inb + ((c + 1) & 1) * 12288);
        if (c + 2 < 128) SCAN_LOAD(c + 2);
        if (c > 0) {
          const int cc = c - 1, idx = lt * 4, i = idx >> 5, rl = idx & 31;
          const int t = d ? (4095 - (cc * 32 + i)) : (cc * 32 + i);
          const float* q = ypart + (cc & 1) * 4096 + i * 128 + rl;
          const f32x4 o = (*(const f32x4*)q + *(const f32x4*)(q + 32)) + (*(const f32x4*)(q + 64) + *(const f32x4*)(q + 96));
          u32x2 ow; ow.x = pk2(o[0], o[1]); ow.y = pk2(o[2], o[3]);
          *(u32x2*)(Y + ((size_t)d * MT + b * 4096 + t) * 512 + h * 64 + half * 32 + rl) = ow;
        }
        __syncthreads();
      }
      {
        const int cc = 127, idx = lt * 4, i = idx >> 5, rl = idx & 31;
        const int t = d ? (4095 - (cc * 32 + i)) : (cc * 32 + i);
        const float* q = ypart + (cc & 1) * 4096 + i * 128 + rl;
        const f32x4 o = (*(const f32x4*)q + *(const f32x4*)(q + 32)) + (*(const f32x4*)(q + 64) + *(const f32x4*)(q + 96));
        u32x2 ow; ow.x = pk2(o[0], o[1]); ow.y = pk2(o[2], o[3]);
        *(u32x2*)(Y + ((size_t)d * MT + b * 4096 + t) * 512 + h * 64 + half * 32 + rl) = ow;
      }
    } else {
      const int rowl = w * 8 + (lane >> 3), row = half * 32 + rowl, j8 = (lane & 7) * 8;
      f32x2 s0 = (f32x2){0.f, 0.f}, s1 = s0, s2 = s0, s3 = s0;
      __syncthreads();
      for (int c = 0; c < 128; ++c) {
        const float* cur = inb + (c & 1) * 12288;
        float* yp = ypart + (c & 1) * 4096 + ((lane & 7) >> 1) * 32 + rowl;
        f32x4 kdA = *(const f32x4*)(cur + 64 + j8), kdB = *(const f32x4*)(cur + 64 + j8 + 4),
              kaA = *(const f32x4*)(cur + 128 + j8), kaB = *(const f32x4*)(cur + 128 + j8 + 4), kkA = *(const f32x4*)(cur + 192 + j8), kkB = *(const f32x4*)(cur + 192 + j8 + 4),
              rA = *(const f32x4*)(cur + 256 + j8), rB = *(const f32x4*)(cur + 256 + j8 + 4);
        float v = cur[320 + row];
#pragma unroll 8
        for (int i = 0; i < 32; ++i) {
          const float* sn = cur + ((i + 1) & 31) * 384;
          const f32x4 nkdA = *(const f32x4*)(sn + 64 + j8), nkdB = *(const f32x4*)(sn + 64 + j8 + 4),
                      nkaA = *(const f32x4*)(sn + 128 + j8), nkaB = *(const f32x4*)(sn + 128 + j8 + 4), nkkA = *(const f32x4*)(sn + 192 + j8), nkkB = *(const f32x4*)(sn + 192 + j8 + 4),
                      nrA = *(const f32x4*)(sn + 256 + j8), nrB = *(const f32x4*)(sn + 256 + j8 + 4);
          const float nv = sn[320 + row];
          const f32x2 t = (s0 * kkA.xy + s1 * kkA.zw) + (s2 * kkB.xy + s3 * kkB.zw);
          float sk = t.x + t.y;
          sk += __int_as_float(__builtin_amdgcn_update_dpp(0, __float_as_int(sk), 0xB1, 0xF, 0xF, true));
          sk += __int_as_float(__builtin_amdgcn_update_dpp(0, __float_as_int(sk), 0x4E, 0xF, 0xF, true));
          sk += __int_as_float(__builtin_amdgcn_update_dpp(0, __float_as_int(sk), 0x141, 0xF, 0xF, true));
          s0 = (s0 + kdA.xy * v) - kaA.xy * sk;
          s1 = (s1 + kdA.zw * v) - kaA.zw * sk;
          s2 = (s2 + kdB.xy * v) - kaB.xy * sk;
          s3 = (s3 + kdB.zw * v) - kaB.zw * sk;
          const f32x2 u = (s0 * rA.xy + s1 * rA.zw) + (s2 * rB.xy + s3 * rB.zw);
          float y = u.x + u.y;
          y += __int_as_float(__builtin_amdgcn_update_dpp(0, __float_as_int(y), 0xB1, 0xF, 0xF, true));
          yp[i * 128] = y;
          kdA = nkdA; kdB = nkdB; kaA = nkaA; kaB = nkaB; kkA = nkkA; kkB = nkkB; rA = nrA; rB = nrB; v = nv;
        }
        {
          const f32x4 peA = *(const f32x4*)(cur + 31 * 384 + j8), peB = *(const f32x4*)(cur + 31 * 384 + j8 + 4);
          s0 = s0 * peA.xy; s1 = s1 * peA.zw; s2 = s2 * peB.xy; s3 = s3 * peB.zw;
        }
        __syncthreads();
      }
    }
    __syncthreads();
  }
}

DEV void postB(const P& p) {
  const bf16_t* Y = (const bf16_t*)(p.ws + O_Y);
  const bf16_t* kd = (const bf16_t*)(p.ws + O_KD);
  const bf16_t* gg = (const bf16_t*)(p.ws + O_G);
  const bf16_t* za = (const bf16_t*)p.out;
  bf16_t* ycat = (bf16_t*)(p.ws + O_YCAT);
  const int lane = tidx() & 63, sub = lane >> 4, jl = lane & 15, gw = blockIdx.x * 8 + (tidx() >> 6), nw = gridDim.x * 8;
  for (int it = gw; it < MT * 2; it += nw) {
    const int item = it * 4 + sub, tok = item >> 3, h = item & 7, c = h * 64 + jl * 4;
    const u32x2 yu0 = *(const u32x2*)(Y + (size_t)tok * 512 + c), yu1 = *(const u32x2*)(Y + ((size_t)MT + tok) * 512 + c);
    const f32x4 y0 = (f32x4){lo16(yu0.x), hi16(yu0.x), lo16(yu0.y), hi16(yu0.y)}, y1 = (f32x4){lo16(yu1.x), hi16(yu1.x), lo16(yu1.y), hi16(yu1.y)};
    const u32x2 k0 = *(const u32x2*)(kd + (size_t)tok * 512 + c), k1 = *(const u32x2*)(kd + ((size_t)MT + tok) * 512 + c);
    const u32x2 ku = *(const u32x2*)(za + (size_t)tok * 2048 + 512 + c);
    const f32x4 kav = *(const f32x4*)(p.k_a + c);
    const u32x2 ru = *(const u32x2*)(za + (size_t)tok * 2048 + c), vu = *(const u32x2*)(za + (size_t)tok * 2048 + 1024 + c), gu = *(const u32x2*)(gg + (size_t)tok * 512 + c);
    const f32x4 lw = *(const f32x4*)(p.lnx_w + c), lb = *(const f32x4*)(p.lnx_b + c), rk = *(const f32x4*)(p.r_k + c);
    const f32x4 y = y0 + y1;
    const float mu = dpp_allreduce16((y[0] + y[1]) + (y[2] + y[3])) * (1.f / 64.f);
    const f32x4 dv = y - mu;
    const float var = dpp_allreduce16((dv[0] * dv[0] + dv[1] * dv[1]) + (dv[2] * dv[2] + dv[3] * dv[3])) * (1.f / 64.f);
    const float rs = rsqrtf(var + 64e-5f);
    const f32x4 r = (f32x4){lo16(ru.x), hi16(ru.x), lo16(ru.y), hi16(ru.y)}, v = (f32x4){lo16(vu.x), hi16(vu.x), lo16(vu.y), hi16(vu.y)};
    const f32x4 g = (f32x4){lo16(gu.x), hi16(gu.x), lo16(gu.y), hi16(gu.y)};
    const f32x4 asum = (f32x4){lo16(k0.x) + lo16(k1.x), hi16(k0.x) + hi16(k1.x), lo16(k0.y) + lo16(k1.y), hi16(k0.y) + hi16(k1.y)};
    const f32x4 kx = (f32x4){lo16(ku.x), hi16(ku.x), lo16(ku.y), hi16(ku.y)};
    const f32x4 kds = kx * ((asum - 2.f) * kav + 2.f);
    const f32x4 t = r * kds * rk;
    const float bs = dpp_allreduce16((t[0] + t[1]) + (t[2] + t[3]));
    const f32x4 o = (dv * rs * lw + lb + v * bs) * g;
    u32x2 pk;
    pk.x = pk2(o[0], o[1]); pk.y = pk2(o[2], o[3]);
    *(u32x2*)(ycat + (size_t)tok * 1024 + c) = pk;
  }
}

DEV void glu_fixup(const P& p, int l, int strip0, int nstrips) {
  const bf16_t* sb = (const bf16_t*)(p.ws + O_SB);
  bf16_t* act = (bf16_t*)(p.ws + O_ACT);
  const float* cw = p.ffn_conv + (size_t)l * 3 * 5632;
  for (int item = tidx(); item < nstrips * 2 * 352; item += NTHR) {
    const int sl = item / 704, strip = strip0 + sl, rem = item - sl * 704, e = rem / 352, c8 = (rem - e * 352) * 8;
    const int R = strip * 64 + (e ? 63 : 0), s = R & 4095;
    const int colg = (c8 >> 7) * 256 + (c8 & 127);
    const bf16_t* pc = sb + ((size_t)strip * 4 + (e ? 3 : 0)) * 5632 + colg;
    const bf16_t* pp = e ? (pc - 5632) : (pc - 5632);
    const bf16_t* pn = e ? (pc + 5632) : (pc + 5632);
    const u32x4 z0 = (u32x4){0u, 0u, 0u, 0u};
    const bool hasp = e ? true : (s > 0), hasn = e ? (s < 4095) : true;
    float gm[8], gc[8], gn[8], vm[8], vc[8], vn[8], o[8];
    unpack8(hasp ? *(const u32x4*)pp : z0, gm); unpack8(hasp ? *(const u32x4*)(pp + 128) : z0, vm);
    unpack8(*(const u32x4*)pc, gc); unpack8(*(const u32x4*)(pc + 128), vc);
    unpack8(hasn ? *(const u32x4*)pn : z0, gn); unpack8(hasn ? *(const u32x4*)(pn + 128) : z0, vn);
#pragma unroll
    for (int i = 0; i < 8; ++i) {
      const float g = gm[i] * cw[c8 + i] + gc[i] * cw[5632 + c8 + i] + gn[i] * cw[11264 + c8 + i];
      const float vv = vm[i] * cw[2816 + c8 + i] + vc[i] * cw[5632 + 2816 + c8 + i] + vn[i] * cw[11264 + 2816 + c8 + i];
      const float u2 = -1.5957691216057308f * (g + 0.044715f * g * g * g);
      o[i] = g * __builtin_amdgcn_rcpf(1.f + __expf(u2)) * vv;
    }
    *(u32x4*)(act + (size_t)R * 2816 + c8) = pack8(o);
  }
}

template <class Epi>
DEV void gemm_grid(char* lds, const bf16_t* A, int lda, const bf16_t* Bt, int ldb, int K, int tilesM, int tilesN, const Epi& epi) {
  const int nt = tilesM * tilesN;
  u32x4 ra[4], rb[2];
  int t = blockIdx.x;
  if (t < nt) gemm_first_load(A + (size_t)(t / tilesN) * 256 * lda, lda, Bt + (size_t)(t % tilesN) * 128 * ldb, ldb, ra, rb);
  for (; t < nt; t += gridDim.x) {
    const int tm = t / tilesN, tn = t % tilesN, t2 = t + gridDim.x;
    const bf16_t* An = (t2 < nt) ? A + (size_t)(t2 / tilesN) * 256 * lda : nullptr;
    const bf16_t* Bn = (t2 < nt) ? Bt + (size_t)(t2 % tilesN) * 128 * ldb : nullptr;
    gemm_tile(lds, A + (size_t)tm * 256 * lda, lda, Bt + (size_t)tn * 128 * ldb, ldb, K, tm * 256, tn * 128, epi, ra, rb, An, Bn);
  }
}


DEV void dft_fold(const P& p) {
  const bf16_t* CST = (const bf16_t*)(p.ws + O_CST);
  bf16_t* CF = (bf16_t*)(p.ws + O_CSTF);
  for (int idx = blockIdx.x * NTHR + tidx(); idx < 16384 * 256; idx += gridDim.x * NTHR) {
    const int r = idx >> 8, s8 = (idx & 255) * 8, eo = (r >> 10) & 1;
    const bf16_t* src = CST + (size_t)r * 4096;
    float a[8], bq[8], o[8];
    unpack8(*(const u32x4*)(src + s8), a);
    if (s8 == 0) {
      unpack8(*(const u32x4*)(src + 4088), bq);
      o[0] = eo ? 0.f : a[0];
#pragma unroll
      for (int i = 1; i < 8; ++i) o[i] = eo ? (a[i] - bq[8 - i]) : (a[i] + bq[8 - i]);
      if (!eo) ((float*)(p.ws + O_C2048))[(r >> 11) * 1024 + (r & 1023)] = bf2f(src[2048]) * (1.f / 64.f);
    } else {
      unpack8(*(const u32x4*)(src + 4096 - s8 - 8), bq);
      const float b0 = bf2f(src[4096 - s8]);
      o[0] = eo ? (a[0] - b0) : (a[0] + b0);
#pragma unroll
      for (int i = 1; i < 8; ++i) o[i] = eo ? (a[i] - bq[8 - i]) : (a[i] + bq[8 - i]);
    }
    *(u32x4*)(CF + (size_t)r * 2048 + s8) = pack8(o);
  }
}

DEV void dft_combine(const P& p) {
  const bf16_t* EO = (const bf16_t*)(p.ws + O_EO);
  const bf16_t* CST = (const bf16_t*)(p.ws + O_CST);
  bf16_t* f = (bf16_t*)(p.ws + O_F);
  for (int idx = blockIdx.x * NTHR + tidx(); idx < 8 * 2048 * 256; idx += gridDim.x * NTHR) {
    const int c4 = (idx & 255) * 4, k1 = (idx >> 8) & 2047, b = idx >> 19;
    const u32x2 eu = *(const u32x2*)(EO + ((size_t)(b * 2) * 2048 + k1) * 1024 + c4), ou = *(const u32x2*)(EO + ((size_t)(b * 2 + 1) * 2048 + k1) * 1024 + c4);
    f32x4 e = (f32x4){lo16(eu.x), hi16(eu.x), lo16(eu.y), hi16(eu.y)};
    const f32x4 o = (f32x4){lo16(ou.x), hi16(ou.x), lo16(ou.y), hi16(ou.y)};
    {
      const f32x4 cm = *(const f32x4*)((const float*)(p.ws + O_C2048) + b * 1024 + c4);
      e = (k1 & 1) ? (e - cm) : (e + cm);
    }
    const f32x4 d = e - o, s = e + o;
    u32x2 pk;
    pk.x = pk2(d[0], d[1]); pk.y = pk2(d[2], d[3]);
    *(u32x2*)(f + ((size_t)b * 4096 + k1) * 1024 + c4) = pk;
    if (k1 > 0) {
      pk.x = pk2(s[0], s[1]); pk.y = pk2(s[2], s[3]);
      *(u32x2*)(f + ((size_t)b * 4096 + 4096 - k1) * 1024 + c4) = pk;
    }
  }
  for (int r = blockIdx.x * NTHR + tidx(); r < 8 * 1024; r += gridDim.x * NTHR) {
    const float* cc = (const float*)(p.ws + O_C2048);
    f[((size_t)(r >> 10) * 4096 + 2048) * 1024 + (r & 1023)] = f2bf(cc[16384 + r] + cc[r]);
  }
}
DEV void dft_altsum(const P& p) {
  const int lane = tidx() & 63, gw = blockIdx.x * 8 + (tidx() >> 6), nw = gridDim.x * 8;
  const bf16_t* CF = (const bf16_t*)(p.ws + O_CSTF);
  for (int r = gw; r < 8 * 1024; r += nw) {
    const int b = r >> 10, n = r & 1023;
    const bf16_t* cp = CF + ((size_t)(b * 2) * 1024 + n) * 2048;
    float acc = 0.f;
#pragma unroll
    for (int j = 0; j < 4; ++j) {
      const u32x4 u = *(const u32x4*)(cp + j * 512 + lane * 8);
      acc += (lo16(u.x) - hi16(u.x)) + (lo16(u.y) - hi16(u.y)) + (lo16(u.z) - hi16(u.z)) + (lo16(u.w) - hi16(u.w));
    }
    acc = wave_sum(acc);
    if (lane == 0) ((bf16_t*)(p.ws + O_F))[((size_t)b * 4096 + 2048) * 1024 + n] = f2bf(acc * (1.f / 64.f) + ((const float*)(p.ws + O_C2048))[r]);
  }
}

#define LDSP ((PG8_LAS unsigned char*)lds)
template <class Epi>
DEV void pgemm(char* lds, const bf16_t* A, const bf16_t* Bt, int M_, int N_, int K_, const Epi& E) {
  pg8::Gemm g{A, Bt, M_, N_, K_};
  pg8::StaticOrder S;
  S.init(M_, N_, (int)gridDim.x, (int)blockIdx.x);
  pg8::gemm_phase<Epi, pg8::StaticOrder, true, true>(LDSP, g, S, E);
}

DEV void ffn(char* lds, const XcdBarrier& xbar, const P& p, int l) {
  const bf16_t* h = (const bf16_t*)(p.ws + O_H);
  bf16_t* act = (bf16_t*)(p.ws + O_ACT);
  bf16_t* yf = (bf16_t*)(p.ws + O_YF);
  const bf16_t* upt = (const bf16_t*)(p.ws + W_UP) + (size_t)l * 5632 * 1024;
  const bf16_t* dnt = (const bf16_t*)(p.ws + W_DOWN) + (size_t)l * 1024 * 2816;
  pgemm(lds, h, upt, MT, 5632, 1024, pg8::PEpiGlu{act, (bf16_t*)(p.ws + O_SB), p.ffn_conv + (size_t)l * 3 * 5632});
  xcd_barrier(xbar);
  {
    pg8::StaticOrder S;
    S.init(MT, 1024, (int)gridDim.x, (int)blockIdx.x);
    pg8::Unit u;
    for (int i = 0; S.next(i, u); ++i) glu_fixup(p, l, u.pm * 4, 4);
    asm volatile("s_waitcnt vmcnt(0)" ::: "memory");
    __syncthreads();
  }
  pgemm(lds, act, dnt, MT, 1024, 2816, pg8::PEpiBf16<false>{yf, 1024});
  xcd_barrier(xbar);
}

DEV const P& kargs() {
  auto q = __builtin_amdgcn_kernarg_segment_ptr();
  asm volatile("" : "+s"(q));
  return *(const P*)q;
}
#define p (kargs())
__global__ void __launch_bounds__(NTHR) mega(P parg_unused) {
  extern __shared__ __attribute__((aligned(16))) char lds[];
  cg::grid_group grid = cg::this_grid();
  char* ws = p.ws;
  if (tidx() < 4) ((unsigned*)(lds + 131072))[tidx()] = 0u;
  __syncthreads();
  const XcdBarrier xbar = xcd_barrier_post((unsigned*)(ws + W_BAR), (volatile XLAS unsigned*)(lds + 131072));
  float* mod = (float*)(ws + W_MOD);
  const int gt = blockIdx.x * NTHR + tidx(), ngt = gridDim.x * NTHR;

  for (int rep_ = 0; rep_ < REP_PRO; ++rep_) {
  if (rep_ > 0) xcd_barrier(xbar);
  compute_mod(lds, p);
  transpose_convert(lds, p.mix_in, 1024, 3584, (bf16_t*)(ws + W_MIXIN), 1024, 0, 2);
  for (int l = 0; l < 2; ++l) {
    transpose_convert(lds, p.ffn_up + (size_t)l * 1024 * 5632, 1024, 5632, (bf16_t*)(ws + W_UP) + (size_t)l * 5632 * 1024, 1024, 64 * l, 1);
    transpose_convert(lds, p.ffn_down + (size_t)l * 2816 * 1024, 2816, 1024, (bf16_t*)(ws + W_DOWN) + (size_t)l * 1024 * 2816, 2816, 128 + 64 * l);
  }
  transpose_convert(lds, p.mix_out, 1024, 1024, (bf16_t*)(ws + W_MIXOUT), 1024, 32);
  transpose_convert(lds, p.fnet_w, 1024, 1024, (bf16_t*)(ws + W_FNET), 1024, 96);
  for (int d = 0; d < 2; ++d) {
    transpose_convert(lds, p.w1 + (size_t)d * 512 * 64, 512, 64, (bf16_t*)(ws + W_L1) + (size_t)(d * 64) * 512, 512, 8 * d);
    transpose_convert(lds, p.a1 + (size_t)d * 512 * 64, 512, 64, (bf16_t*)(ws + W_L1) + (size_t)(128 + d * 64) * 512, 512, 16 + 8 * d);
    transpose_convert(lds, p.w2 + (size_t)d * 64 * 512, 64, 512, (bf16_t*)(ws + W_W2) + (size_t)d * 512 * 64, 64, 48 + 8 * d);
    transpose_convert(lds, p.a2 + (size_t)d * 64 * 512, 64, 512, (bf16_t*)(ws + W_A2) + (size_t)d * 512 * 64, 64, 64 + 8 * d);
  }
  transpose_convert(lds, p.g1, 512, 128, (bf16_t*)(ws + W_L1) + (size_t)256 * 512, 512, 32);
  transpose_convert(lds, p.g2, 128, 512, (bf16_t*)(ws + W_G2), 128, 80);
  {
    float* rope = (float*)(ws + W_ROPE);
    for (int idx = gt; idx < 4096 * 32; idx += ngt) {
      const int s = idx >> 5, e = idx & 31;
      const float inv = powf(10000.f, -(float)e / 32.f);
      const float ang = (float)s * inv;
      float sv, cv;
      sincosf(ang, &sv, &cv);
      rope[2 * idx] = cv;
      rope[2 * idx + 1] = sv;
    }
    bf16_t* dftc = (bf16_t*)(ws + W_DFTC);
    for (int idx = gt; idx < 256 * 256; idx += ngt) {
      const int n = idx >> 8, cc = idx & 255, c = cc & 127, k2 = n & 127;
      const float ph = (float)((k2 * c) & 127) * (1.f / 64.f);
      float v = 0.f;
      if (n < 128 && cc < 128) v = cospif(ph);
      if (n >= 128 && cc >= 128) v = sinpif(ph);
      dftc[idx] = f2bf(v * 0.08838834764831845f);
    }
  }
  }
  grid.sync();
  for (int rep_ = 0; rep_ < REP_ROW; ++rep_) { rowpass<false, true>(p.x, nullptr, nullptr, nullptr, nullptr, p.norm_g, mod + 1024, mod, (bf16_t*)(ws + O_H0)); xcd_barrier(xbar); }
  pgemm(lds, (const bf16_t*)(ws + O_H0), (const bf16_t*)(ws + W_MIXIN), MT, INC, 1024,
        pg8::PEpiMixIn{(bf16_t*)p.out, (bf16_t*)(ws + O_SBZ), (bf16_t*)(ws + O_QR), (bf16_t*)(ws + O_KR), (bf16_t*)(ws + O_VT), p.mix_conv, (const float*)(ws + W_ROPE)});
  xcd_barrier(xbar);
  za_fixup(p);
  attention(lds, p);
  for (int t = blockIdx.x; t < 128 * 3; t += gridDim.x) za_fixup_u(p, t / 3);
  asm volatile("s_waitcnt vmcnt(0)" ::: "memory");
  __syncthreads();
  gemm_grid(lds, (const bf16_t*)p.out + 1536, 2048, (const bf16_t*)(ws + W_L1), 512, 512, 128, 3, EpiLora1{(bf16_t*)(ws + O_L1)});
  xcd_barrier(xbar);
  for (int d = 0; d < 2; ++d) {
    gemm_grid(lds, (const bf16_t*)(ws + O_L1) + d * 64, 384, (const bf16_t*)(ws + W_W2) + (size_t)d * 512 * 64, 64, 64, 128, 4,
              EpiDecay{(unsigned short*)(ws + O_OMW) + (size_t)d * MT * 512, p.w0 + d * 512, d});
    gemm_grid(lds, (const bf16_t*)(ws + O_L1) + 128 + d * 64, 384, (const bf16_t*)(ws + W_A2) + (size_t)d * 512 * 64, 64, 64, 128, 4,
              EpiA{(bf16_t*)(ws + O_KD) + (size_t)d * MT * 512, (bf16_t*)(ws + O_KK), p.a0 + d * 512, p.k_k, (const bf16_t*)p.out, d == 0});
  }
  gemm_grid(lds, (const bf16_t*)(ws + O_L1) + 256, 384, (const bf16_t*)(ws + W_G2), 128, 128, 128, 4, EpiBf16{(bf16_t*)(ws + O_G), 512});
  combineA(p);
  xcd_barrier(xbar);
  for (int rep_ = 0; rep_ < REP_SCAN; ++rep_) { scan_phase(lds, p); xcd_barrier(xbar); }
  for (int rep_ = 0; rep_ < REP_SYNC; ++rep_) xcd_barrier(xbar);
  postB(p);
  xcd_barrier(xbar);
  pgemm(lds, (const bf16_t*)(ws + O_YCAT), (const bf16_t*)(ws + W_MIXOUT), MT, 1024, 1024, pg8::PEpiBf16<false>{(bf16_t*)(ws + O_YF), 1024});
  xcd_barrier(xbar);
  rowpass<true, true, false, true>(p.x, (const bf16_t*)(ws + O_YF), p.norm_g + 1024, mod + 2048, ws + O_XB, p.norm_g + 2048, mod + 4096, mod + 3072, (bf16_t*)(ws + O_H));
  xcd_barrier(xbar);
  ffn(lds, xbar, p, 0);
  {
    const float* mod1 = mod + 8 * 6144;
    rowpass_fold((bf16_t*)(ws + O_XB), (const bf16_t*)(ws + O_YF), p.norm_g + 3072, mod + 5120, p.norm_g + 4096, mod1 + 1024, mod1, (bf16_t*)(ws + O_H),
                 (float*)(ws + O_C2048) + 8192);
    bf16_t* cs = (bf16_t*)(ws + O_COSSIN);
    for (int idx = blockIdx.x * NTHR + tidx(); idx < 4096 * 256; idx += gridDim.x * NTHR) {
      const int rr = idx >> 8, s8 = (idx & 255) * 8, k1 = rr & 2047;
      float o[8];
#pragma unroll
      for (int i = 0; i < 8; ++i) {
        const float ph = (float)((k1 * (s8 + i)) & 4095) * (1.f / 2048.f);
        o[i] = ((rr < 2048) ? cospif(ph) : sinpif(ph)) * (1.f / 64.f);
      }
      *(u32x4*)(cs + (size_t)rr * 2048 + s8) = pack8(o);
    }
    xcd_barrier(xbar);
    {
      const bf16_t* dA = (const bf16_t*)(ws + W_DFTC);
      const bf16_t* hB = (const bf16_t*)(ws + O_H);
      u32x4 ra[4], rb[2];
      int t = blockIdx.x;
      if (t < 8 * 128) gemm_first_load(dA, 256, hB + (size_t)(t & 127) * 128 * 2048 + (t >> 7) * 256, 2048, ra, rb);
      for (; t < 8 * 128; t += gridDim.x) {
        const int g = t >> 7, tn = t & 127, t2 = t + gridDim.x;
        const bf16_t* Bn = (t2 < 8 * 128) ? hB + (size_t)(t2 & 127) * 128 * 2048 + (t2 >> 7) * 256 : nullptr;
        gemm_tile(lds, dA, 256, hB + (size_t)tn * 128 * 2048 + g * 256, 2048, 256, 0, tn * 128, EpiDftc{(bf16_t*)(ws + O_CSTF), g}, ra, rb,
                  Bn ? dA : nullptr, Bn);
      }
      const float* h2048 = (const float*)(ws + O_C2048) + 8192;
      for (int idx = blockIdx.x * NTHR + tidx(); idx < 8192; idx += gridDim.x * NTHR) {
        const int bb = idx >> 10, n = idx & 1023, g = n >> 7, k2 = n & 127;
        float acc = 0.f;
        for (int c = 0; c < 128; ++c) acc += h2048[bb * 1024 + g * 128 + c] * bf2f(dA[k2 * 256 + c]);
        ((float*)(ws + O_C2048))[idx] = acc * (1.f / 64.f);
      }
    }
    xcd_barrier(xbar);
    dft_altsum(p);
    {
      pg8::Gemm g{(const bf16_t*)(ws + O_COSSIN), (const bf16_t*)(ws + O_CSTF), 4096, 16384, 2048};
      pg8::BatchOrder S{(int)gridDim.x, (int)blockIdx.x};
      pg8::gemm_phase<pg8::PEpiDft, pg8::BatchOrder, true, true>(LDSP, g, S, pg8::PEpiDft{(bf16_t*)(ws + O_EO), (bf16_t*)(ws + O_F), (const float*)(ws + O_C2048)});
    }
    xcd_barrier(xbar);
    pgemm(lds, (const bf16_t*)(ws + O_F), (const bf16_t*)(ws + W_FNET), MT, 1024, 1024, pg8::PEpiBf16<false>{(bf16_t*)(ws + O_YF), 1024});
    xcd_barrier(xbar);
    rowpass<true, true, true, true>(ws + O_XB, (const bf16_t*)(ws + O_YF), p.norm_g + 4096 + 1024, mod1 + 2048, ws + O_XB, p.norm_g + 4096 + 2048, mod1 + 4096, mod1 + 3072,
                        (bf16_t*)(ws + O_H));
    xcd_barrier(xbar);
    ffn(lds, xbar, p, 1);
    rowpass<true, false, true, false>(ws + O_XB, (const bf16_t*)(ws + O_YF), p.norm_g + 4096 + 3072, mod1 + 5120, p.out, nullptr, nullptr, nullptr, nullptr);
  }
}

#undef p
extern "C" void kernel_launch(void* const* d_in, const int* in_sizes, int n_in, void* d_out, int out_size, void* d_ws, size_t ws_size,
                              hipStream_t stream) {
  static int grid_blocks = 0;
  if (!grid_blocks) {
    int dev = 0, cus = 0, per_cu = 0;
    hipGetDevice(&dev);
    hipDeviceGetAttribute(&cus, hipDeviceAttributeMultiprocessorCount, dev);
    hipFuncSetAttribute((const void*)mega, hipFuncAttributeMaxDynamicSharedMemorySize, LDS_BYTES);
    hipOccupancyMaxActiveBlocksPerMultiprocessor(&per_cu, (const void*)mega, NTHR, LDS_BYTES);
    if (per_cu < 1) { fprintf(stderr, "occupancy query returned %d\n", per_cu); per_cu = 1; }
    if (per_cu > 1) per_cu = 1;
    grid_blocks = cus * per_cu;
  }
  P p{};
  const float** pp = (const float**)&p;
  for (int i = 0; i < 25; ++i) pp[i] = (const float*)d_in[i];
  p.out = (float*)d_out;
  p.ws = (char*)d_ws;
  (void)hipMemsetAsync((char*)d_ws + W_BAR, 0, XCD_BAR_WORDS * sizeof(unsigned), stream);
  void* args[] = {&p};
  hipError_t e = hipLaunchCooperativeKernel((const void*)mega, dim3(grid_blocks), dim3(NTHR), args, LDS_BYTES, stream);
  if (e != hipSuccess) fprintf(stderr, "cooperative launch failed: %s (grid %d)\n", hipGetErrorString(e), grid_blocks);
}
```

```cpp
#include <hip/hip_runtime.h>
#include <hip/hip_cooperative_groups.h>
#include <stdint.h>
#include <cstdio>
namespace cg = cooperative_groups;

typedef unsigned short bf16_t;
typedef short bf16x8 __attribute__((ext_vector_type(8)));
typedef short s16x4 __attribute__((ext_vector_type(4)));
typedef float f32x4 __attribute__((ext_vector_type(4)));
typedef float f32x2 __attribute__((ext_vector_type(2)));
typedef unsigned u32x4 __attribute__((ext_vector_type(4)));
typedef unsigned u32x2 __attribute__((ext_vector_type(2)));

#define DEV __device__ __forceinline__
__device__ __forceinline__ int tidx() { int t = threadIdx.x; asm volatile("" : "+v"(t)); return t; }

constexpr int NB = 8, SEQ = 4096, DM = 1024, MT = NB * SEQ, DFF = 2816, INC = 3584;
constexpr size_t MiB = 1024 * 1024;
constexpr int NTHR = 512;
constexpr int LDS_BYTES = 131072 + 16;
constexpr size_t W_BAR = 47 * 1024 * 1024;
#ifndef REP_SCAN
#define REP_SCAN 1
#endif
#ifndef REP_ATT
#define REP_ATT 1
#endif
#ifndef REP_SYNC
#define REP_SYNC 0
#endif
#ifndef REP_PREP
#define REP_PREP 1
#endif
#ifndef REP_LORA
#define REP_LORA 1
#endif
#ifndef REP_GLU
#define REP_GLU 1
#endif
#ifndef REP_PRO
#define REP_PRO 1
#endif
#ifndef REP_ROW
#define REP_ROW 1
#endif

constexpr size_t W_MIXIN = 0;
constexpr size_t W_UP = 7 * MiB;
constexpr size_t W_DOWN = 29 * MiB;
constexpr size_t W_MIXOUT = 40 * MiB;
constexpr size_t W_FNET = 42 * MiB;
constexpr size_t W_L1 = 44 * MiB;
constexpr size_t W_W2 = W_L1 + 512 * 1024;
constexpr size_t W_A2 = W_W2 + 128 * 1024;
constexpr size_t W_G2 = W_A2 + 128 * 1024;
constexpr size_t W_DFTC = W_G2 + 128 * 1024;
constexpr size_t W_MOD = 45 * MiB;
constexpr size_t W_ROPE = 46 * MiB;
constexpr size_t R0 = 48 * MiB;
constexpr size_t O_H0 = R0;
constexpr size_t O_Z = 112 * MiB;
constexpr size_t O_SBZ = 304 * MiB;
constexpr size_t O_QR = 336 * MiB, O_KR = 368 * MiB, O_VT = 400 * MiB;
constexpr size_t O_NUM = R0;
constexpr size_t O_MD = 240 * MiB;
constexpr size_t O_YCAT = 448 * MiB;
constexpr size_t O_OMW = 144 * MiB, O_KK = 208 * MiB, O_KKA = 248 * MiB, O_L1 = 312 * MiB, O_KD = 336 * MiB, O_G = 400 * MiB, O_Y = 48 * MiB;
constexpr size_t O_YF = 48 * MiB;
constexpr size_t O_H = 176 * MiB;
constexpr size_t O_ZF = 240 * MiB;
constexpr size_t O_ACT = 240 * MiB;
constexpr size_t O_SB = 416 * MiB;
constexpr size_t O_COSSIN = 240 * MiB;
constexpr size_t O_CST = 304 * MiB;
constexpr size_t O_F = 176 * MiB;
constexpr size_t O_CSTF = 432 * MiB;
constexpr size_t O_C2048 = 272 * MiB;
constexpr size_t O_EO = 48 * MiB;
constexpr size_t O_XB = 112 * MiB;

struct P {
  const float *x, *c, *ada_w, *ada_b, *norm_g, *mix_in, *mix_conv, *w0, *w1, *w2, *a0, *a1, *a2, *g1, *g2, *k_k, *k_a, *r_k, *lnx_w,
      *lnx_b, *mix_out, *fnet_w, *ffn_up, *ffn_conv, *ffn_down;
  float* out;
  char* ws;
};

DEV float bf2f(bf16_t h) { return __uint_as_float(((unsigned)h) << 16); }
DEV bf16_t f2bf(float f) {
  unsigned u = __float_as_uint(f);
  u += 0x7fffu + ((u >> 16) & 1u);
  return (bf16_t)(u >> 16);
}
typedef __bf16 bf16x2_t __attribute__((ext_vector_type(2)));
DEV unsigned pk2(float a, float b) {
  const f32x2 v = {a, b};
  return __builtin_bit_cast(unsigned, __builtin_convertvector(v, bf16x2_t));
}
DEV float lo16(unsigned u) { return __uint_as_float(u << 16); }
DEV float hi16(unsigned u) { return __uint_as_float(u & 0xffff0000u); }
DEV float wave_sum(float v) {
#pragma unroll
  for (int o = 32; o; o >>= 1) v += __shfl_xor(v, o);
  return v;
}
DEV float sigmoidf_(float x) { return __builtin_amdgcn_rcpf(1.f + __expf(-x)); }

#include <cstdint>
#include <cstdlib>
#include <vector>

#define XB_TMO      128
#define XB_XCNT(j)  (256  + 64 * (j))
#define XB_XSUB(j)  (1280 + 64 * (j))
#define XB_XGEN(j)  (2304 + 64 * (j))
#define XB_TOP      3328
#define XB_TOPGEN   3392
#define XCD_BAR_WORDS 3456
#define XB_SPIN_CAP (1u << 18)
#define XLAS __attribute__((address_space(3)))

__device__ __forceinline__ unsigned xb_ld(unsigned* p)              { return __hip_atomic_load(p, __ATOMIC_RELAXED, __HIP_MEMORY_SCOPE_AGENT); }
__device__ __forceinline__ unsigned xb_add(unsigned* p, unsigned v) { return __hip_atomic_fetch_add(p, v, __ATOMIC_RELAXED, __HIP_MEMORY_SCOPE_AGENT); }
__device__ __forceinline__ unsigned xb_xcc_id() { return (unsigned)__builtin_amdgcn_s_getreg((3 << 11) | 20) & 0xFu; }
#define XB_SPIN(cond, bar) do { unsigned _sp = 0; while (cond) { __builtin_amdgcn_s_sleep(1); \
    if ((++_sp & 255u) == 0u) { if (xb_ld(&(bar)[XB_TMO])) break; if (_sp > XB_SPIN_CAP) { atomicAdd(&(bar)[XB_TMO], 1u); break; } } } } while (0)

struct XcdBarrier {
    unsigned* bar; unsigned x;
    volatile XLAS unsigned* st;
};

__device__ __forceinline__ XcdBarrier xcd_barrier_post(unsigned* bar, volatile XLAS unsigned* st) {
    XcdBarrier b; b.bar = bar; b.x = xb_xcc_id(); b.st = st;
    if (threadIdx.x == 0) (void)xb_add(&bar[XB_XCNT(b.x)], 1u);
    return b;
}
__device__ __forceinline__ void xcd_barrier_complete(unsigned* bar, unsigned x, unsigned& nloc, unsigned& nx) {
    const unsigned G = gridDim.x * gridDim.y * gridDim.z;
    unsigned sum, cnt, mine, sp = 0u;
    for (;;) {
        sum = 0u; cnt = 0u; mine = 0u;
#pragma unroll
        for (unsigned j = 0; j < 16; ++j) { const unsigned c = xb_ld(&bar[XB_XCNT(j)]); sum += c; cnt += (c > 0u) ? 1u : 0u; mine = (j == x) ? c : mine; }
        if (sum == G) break;
        __builtin_amdgcn_s_sleep(1);
        if ((++sp & 255u) == 0u) { if (xb_ld(&bar[XB_TMO])) break; if (sp > XB_SPIN_CAP) { atomicAdd(&bar[XB_TMO], 1u); break; } }
    }
    nloc = mine > 0u ? mine : 1u; nx = cnt > 0u ? cnt : 1u;
}

__device__ __forceinline__ void xcd_barrier(const XcdBarrier& b) {
    asm volatile("s_waitcnt vmcnt(0)" ::: "memory");
    __syncthreads();
    if (threadIdx.x == 0) {
        unsigned* bar = b.bar;
        __builtin_amdgcn_s_waitcnt(0);
        unsigned nloc = b.st[0], nx = b.st[1];
        if (nloc == 0u) { xcd_barrier_complete(bar, b.x, nloc, nx); b.st[0] = nloc; b.st[1] = nx; }
        const unsigned old = xb_add(&bar[XB_XSUB(b.x)], 1u);
        const unsigned gen = old / nloc;
        if (old + 1u == (gen + 1u) * nloc) {
            __builtin_amdgcn_fence(__ATOMIC_RELEASE, "agent");
            asm volatile("s_waitcnt vmcnt(0)" ::: "memory");
            const unsigned og = xb_add(&bar[XB_TOP], 1u);
            const unsigned tg = og / nx;
            if (og + 1u == (tg + 1u) * nx) xb_add(&bar[XB_TOPGEN], 1u);
            else XB_SPIN(xb_ld(&bar[XB_TOPGEN]) == tg, bar);
            __builtin_amdgcn_fence(__ATOMIC_ACQUIRE, "agent");
            xb_add(&bar[XB_XGEN(b.x)], 1u);
            asm volatile("s_waitcnt vmcnt(0)" ::: "memory");
        } else {
            XB_SPIN(xb_ld(&bar[XB_XGEN(b.x)]) == gen, bar);
            __builtin_amdgcn_fence(__ATOMIC_ACQUIRE, "agent");
            asm volatile("s_waitcnt vmcnt(0)" ::: "memory");
        }
    }
    __syncthreads();
}

namespace pg8 {
#define PG8_LAS __attribute__((address_space(3)))
typedef unsigned short bf16_t;
typedef short bf16x8 __attribute__((ext_vector_type(8)));
typedef float f32x4 __attribute__((ext_vector_type(4)));
typedef unsigned u32x4 __attribute__((ext_vector_type(4)));
constexpr int BM = 256, BK = 64, HALF = 128, HTB = HALF * BK * 2  , STAGE_BYTES = 8 * HTB, NXCD = 8, WGM = 8;

__host__ __device__ __forceinline__ int lds_byte(int r, int c) { const int st = (r >> 4) * 2 + (c >> 5), rr = r & 15, cc = c & 31, ob = rr * 64 + cc * 2; return st * 1024 + (ob ^ (((ob >> 9) & 1) << 5)); }
__host__ __device__ __forceinline__ void stage_rc(int b, int& R, int& C) { const int st = b / 1024, sb = b % 1024, swz = sb ^ (((sb >> 9) & 1) << 5); R = (st >> 1) * 16 + swz / 64; C = (st & 1) * 32 + (swz % 64) / 2; }
__host__ __device__ __forceinline__ int perm32(int rho) { const int n = rho >> 4, i = rho & 15; return 8 * (i >> 2) + 4 * n + (i & 3); }

struct Unit { int pm, pn; };
struct Gemm { const bf16_t* A; const bf16_t* Bt; int M, N, K; };

struct StaticOrder {
    int nM, nN, nwg, G, c;
    __host__ __device__ void init(int M, int N, int G_, int c_) { nM = M / BM; nN = N / BM; nwg = nM * nN; G = G_; c = c_; }
    __host__ __device__ bool next(int i, Unit& u) const {
        const long L = (long)i * G + c; if (L >= nwg) return false;
        int wgid = (int)L; { const int q = nwg / NXCD, r = nwg % NXCD, xcd = wgid % NXCD, off = wgid / NXCD; wgid = (xcd < r ? xcd * (q + 1) : r * (q + 1) + (xcd - r) * q) + off; }
        const int nig = WGM * nN, gid = wgid / nig, fm = gid * WGM, gsz = (nM - fm) < WGM ? (nM - fm) : WGM;
        u.pm = fm + ((wgid % nig) % gsz); u.pn = (wgid % nig) / gsz; return true;
    }
    __device__ __forceinline__ void a_ready(const Unit&) const {}
    __device__ __forceinline__ void done(const Unit&) const {}
};

__device__ __forceinline__ unsigned cvt_pk_bf16(float lo, float hi) { unsigned r; asm volatile("v_cvt_pk_bf16_f32 %0, %1, %2" : "=v"(r) : "v"(lo), "v"(hi)); return r; }

template <bool BATCHED> struct PEpiBf16 {
    static constexpr bool PERM = true, AFTER_DRAIN = false;
    bf16_t* O; int ldc;
    __device__ __forceinline__ void operator()(const f32x4 (&acc)[2][2][4][2], const Unit& u, int wr, int wc, int fr, int fq) const {
        const int rb = BATCHED ? ((u.pn >> 2) * 4096 + u.pm * 256) : u.pm * 256, cb = BATCHED ? (u.pn & 3) * 256 : u.pn * 256;
        const int row0 = rb + wr * 64 + fr, col0 = cb + wc * 32 + 8 * fq;
#pragma unroll
        for (int ai = 0; ai < 2; ++ai)
#pragma unroll
            for (int m = 0; m < 4; ++m) { bf16_t* rowp = O + (size_t)(row0 + ai * HALF + m * 16) * ldc + col0;
#pragma unroll
                for (int bj = 0; bj < 2; ++bj) { const f32x4 v0 = acc[ai][bj][m][0], v1 = acc[ai][bj][m][1];
                    u32x4 w; w.x = cvt_pk_bf16(v0[0], v0[1]); w.y = cvt_pk_bf16(v0[2], v0[3]); w.z = cvt_pk_bf16(v1[0], v1[1]); w.w = cvt_pk_bf16(v1[2], v1[3]);
                    *(u32x4*)(rowp + bj * HALF) = w; } }
    }
};
struct PEpiF32 {
    static constexpr bool PERM = true, AFTER_DRAIN = false;
    float* O; int ldc;
    __device__ __forceinline__ void operator()(const f32x4 (&acc)[2][2][4][2], const Unit& u, int wr, int wc, int fr, int fq) const {
        const int row0 = u.pm * 256 + wr * 64 + fr, col0 = u.pn * 256 + wc * 32 + 8 * fq;
#pragma unroll
        for (int ai = 0; ai < 2; ++ai)
#pragma unroll
            for (int m = 0; m < 4; ++m) { float* rowp = O + (size_t)(row0 + ai * HALF + m * 16) * ldc + col0;
#pragma unroll
                for (int bj = 0; bj < 2; ++bj) { *(f32x4*)(rowp + bj * HALF) = acc[ai][bj][m][0]; *(f32x4*)(rowp + bj * HALF + 4) = acc[ai][bj][m][1]; } }
    }
};
template <int CTRL> __device__ __forceinline__ float dppz(float x) { return __int_as_float(__builtin_amdgcn_update_dpp(0, __float_as_int(x), CTRL, 0xF, 0xF, true)); }
template <int CTRL> __device__ __forceinline__ float dppo(float old, float x) { return __int_as_float(__builtin_amdgcn_update_dpp(__float_as_int(old), __float_as_int(x), CTRL, 0xF, 0xF, false)); }
struct PEpiGlu {
    static constexpr bool PERM = true, AFTER_DRAIN = false;
    bf16_t* act; bf16_t* sb; const float* cw;
    __device__ __forceinline__ void operator()(const f32x4 (&acc)[2][2][4][2], const Unit& u, int wr, int wc, int fr, int fq) const {
        const int chb = u.pn * 128 + wc * 32 + 8 * fq, colp = u.pn * 256 + wc * 32 + 8 * fq;
#pragma unroll
        for (int n = 0; n < 2; ++n) {
            const int ch = chb + 4 * n;
            const f32x4 g0 = *(const f32x4*)(cw + ch), g1 = *(const f32x4*)(cw + 5632 + ch), g2 = *(const f32x4*)(cw + 11264 + ch);
            const f32x4 v0 = *(const f32x4*)(cw + 2816 + ch), v1 = *(const f32x4*)(cw + 5632 + 2816 + ch), v2 = *(const f32x4*)(cw + 11264 + 2816 + ch);
#pragma unroll
            for (int ai = 0; ai < 2; ++ai) {
                const int strip = u.pm * 4 + ai * 2 + wr, rowbase = u.pm * 256 + ai * HALF + wr * 64;
#pragma unroll
                for (int m = 0; m < 4; ++m) {
                    float o[4];
#pragma unroll
                    for (int r = 0; r < 4; ++r) {
                        const float gc = acc[ai][0][m][n][r], vc = acc[ai][1][m][n][r];
                        float gx = 0.f, vx = 0.f, gy = 0.f, vy = 0.f;
                        if (m > 0) { gx = dppz<0x121>(acc[ai][0][m - 1][n][r]); vx = dppz<0x121>(acc[ai][1][m - 1][n][r]); }
                        const float gp = dppo<0x111>(gx, gc), vp = dppo<0x111>(vx, vc);
                        if (m < 3) { gy = dppz<0x12F>(acc[ai][0][m + 1][n][r]); vy = dppz<0x12F>(acc[ai][1][m + 1][n][r]); }
                        const float gn = dppo<0x101>(gy, gc), vn = dppo<0x101>(vy, vc);
                        const float g = gp * g0[r] + gc * g1[r] + gn * g2[r];
                        const float v = vp * v0[r] + vc * v1[r] + vn * v2[r];
                        const float u2 = -1.5957691216057308f * (g + 0.044715f * g * g * g);
                        o[r] = g * __builtin_amdgcn_rcpf(1.f + __expf(u2)) * v;
                    }
                    u32x2 w; w.x = cvt_pk_bf16(o[0], o[1]); w.y = cvt_pk_bf16(o[2], o[3]);
                    *(u32x2*)(act + (size_t)(rowbase + m * 16 + fr) * 2816 + ch) = w;
                }
                if (fr < 2) {
                    bf16_t* sp = sb + ((size_t)strip * 4 + fr) * 5632 + colp + 4 * n;
                    u32x2 w; w.x = cvt_pk_bf16(acc[ai][0][0][n][0], acc[ai][0][0][n][1]); w.y = cvt_pk_bf16(acc[ai][0][0][n][2], acc[ai][0][0][n][3]);
                    *(u32x2*)sp = w;
                    w.x = cvt_pk_bf16(acc[ai][1][0][n][0], acc[ai][1][0][n][1]); w.y = cvt_pk_bf16(acc[ai][1][0][n][2], acc[ai][1][0][n][3]);
                    *(u32x2*)(sp + 128) = w;
                }
                if (fr >= 14) {
                    bf16_t* sp = sb + ((size_t)strip * 4 + (fr - 12)) * 5632 + colp + 4 * n;
                    u32x2 w; w.x = cvt_pk_bf16(acc[ai][0][3][n][0], acc[ai][0][3][n][1]); w.y = cvt_pk_bf16(acc[ai][0][3][n][2], acc[ai][0][3][n][3]);
                    *(u32x2*)sp = w;
                    w.x = cvt_pk_bf16(acc[ai][1][3][n][0], acc[ai][1][3][n][1]); w.y = cvt_pk_bf16(acc[ai][1][3][n][2], acc[ai][1][3][n][3]);
                    *(u32x2*)(sp + 128) = w;
                }
            }
        }
    }
};
struct PEpiMixIn {
    static constexpr bool PERM = true, AFTER_DRAIN = false;
    bf16_t *za, *sbz, *qr, *kr, *vr; const float *cw, *rope;
    __device__ __forceinline__ void operator()(const f32x4 (&acc)[2][2][4][2], const Unit& u, int wr, int wc, int fr, int fq) const {
        if (u.pn < 8) {
#pragma unroll
            for (int bj = 0; bj < 2; ++bj)
#pragma unroll
                for (int n = 0; n < 2; ++n) {
                    const int col = u.pn * 256 + bj * HALF + wc * 32 + 8 * fq + 4 * n;
                    const f32x4 w0 = *(const f32x4*)(cw + col), w1 = *(const f32x4*)(cw + 2048 + col), w2 = *(const f32x4*)(cw + 4096 + col);
#pragma unroll
                    for (int ai = 0; ai < 2; ++ai) {
                        const int strip = u.pm * 4 + ai * 2 + wr, rowbase = u.pm * 256 + ai * HALF + wr * 64;
#pragma unroll
                        for (int m = 0; m < 4; ++m) {
                            float o[4];
#pragma unroll
                            for (int r = 0; r < 4; ++r) {
                                const float c = acc[ai][bj][m][n][r];
                                float x = 0.f, y = 0.f;
                                if (m > 0) x = dppz<0x121>(acc[ai][bj][m - 1][n][r]);
                                const float pv = dppo<0x111>(x, c);
                                if (m < 3) y = dppz<0x12F>(acc[ai][bj][m + 1][n][r]);
                                const float nx = dppo<0x101>(y, c);
                                o[r] = pv * w0[r] + c * w1[r] + nx * w2[r];
                            }
                            u32x2 w; w.x = cvt_pk_bf16(o[0], o[1]); w.y = cvt_pk_bf16(o[2], o[3]);
                            *(u32x2*)(za + (size_t)(rowbase + m * 16 + fr) * 2048 + col) = w;
                        }
                        if (fr < 2) { u32x2 w; w.x = cvt_pk_bf16(acc[ai][bj][0][n][0], acc[ai][bj][0][n][1]); w.y = cvt_pk_bf16(acc[ai][bj][0][n][2], acc[ai][bj][0][n][3]);
                            *(u32x2*)(sbz + ((size_t)strip * 4 + fr) * 2048 + col) = w; }
                        if (fr >= 14) { u32x2 w; w.x = cvt_pk_bf16(acc[ai][bj][3][n][0], acc[ai][bj][3][n][1]); w.y = cvt_pk_bf16(acc[ai][bj][3][n][2], acc[ai][bj][3][n][3]);
                            *(u32x2*)(sbz + ((size_t)strip * 4 + (fr - 12)) * 2048 + col) = w; }
                    }
                }
        } else if (u.pn < 12) {
            const int which = (u.pn - 8) >> 1;
            bf16_t* dst = which ? kr : qr;
            const float scl = which ? 1.f : 0.18033688011112042f;
#pragma unroll
            for (int bj = 0; bj < 2; ++bj) {
                const int cq = ((u.pn - 8) & 1) * 256 + bj * HALF + wc * 32 + 8 * fq, h = cq >> 6, j0 = (cq & 63) >> 1;
#pragma unroll
                for (int ai = 0; ai < 2; ++ai)
#pragma unroll
                    for (int m = 0; m < 4; ++m) {
                        const int row = u.pm * 256 + ai * HALF + wr * 64 + m * 16 + fr, s = row & 4095;
                        const float* rp = rope + ((size_t)s * 32 + j0) * 2;
                        const f32x4 t0 = *(const f32x4*)rp, t1 = *(const f32x4*)(rp + 4);
                        const f32x4 a = acc[ai][bj][m][0], b = acc[ai][bj][m][1];
                        float o1[4], o2[4];
                        o1[0] = (a[0] * t0[0] - a[1] * t0[1]) * scl; o2[0] = (a[1] * t0[0] + a[0] * t0[1]) * scl;
                        o1[1] = (a[2] * t0[2] - a[3] * t0[3]) * scl; o2[1] = (a[3] * t0[2] + a[2] * t0[3]) * scl;
                        o1[2] = (b[0] * t1[0] - b[1] * t1[1]) * scl; o2[2] = (b[1] * t1[0] + b[0] * t1[1]) * scl;
                        o1[3] = (b[2] * t1[2] - b[3] * t1[3]) * scl; o2[3] = (b[3] * t1[2] + b[2] * t1[3]) * scl;
                        bf16_t* dp = dst + (size_t)row * 512 + h * 64 + j0;
                        u32x2 w; w.x = cvt_pk_bf16(o1[0], o1[1]); w.y = cvt_pk_bf16(o1[2], o1[3]); *(u32x2*)dp = w;
                        w.x = cvt_pk_bf16(o2[0], o2[1]); w.y = cvt_pk_bf16(o2[2], o2[3]); *(u32x2*)(dp + 32) = w;
                    }
            }
        } else {
#pragma unroll
            for (int bj = 0; bj < 2; ++bj) {
                const int cv = (u.pn - 12) * 256 + bj * HALF + wc * 32 + 8 * fq;
#pragma unroll
                for (int ai = 0; ai < 2; ++ai)
#pragma unroll
                    for (int m = 0; m < 4; ++m) {
                        const int row = u.pm * 256 + ai * HALF + wr * 64 + m * 16 + fr;
                        const f32x4 v0 = acc[ai][bj][m][0], v1 = acc[ai][bj][m][1];
                        u32x4 w; w.x = cvt_pk_bf16(v0[0], v0[1]); w.y = cvt_pk_bf16(v0[2], v0[3]); w.z = cvt_pk_bf16(v1[0], v1[1]); w.w = cvt_pk_bf16(v1[2], v1[3]);
                        *(u32x4*)(vr + (size_t)row * 512 + cv) = w;
                    }
            }
        }
    }
};
struct PEpiDft {
    static constexpr bool PERM = true, AFTER_DRAIN = false;
    bf16_t* E; bf16_t* f; const float* c2048;
    __device__ __forceinline__ void operator()(const f32x4 (&acc)[2][2][4][2], const Unit& u, int wr, int wc, int fr, int fq) const {
        const int be = u.pn >> 2, eo = be & 1, b = be >> 1;
        const int k0 = (u.pm & 7) * 256 + wr * 64 + fr, col0 = (u.pn & 3) * 256 + wc * 32 + 8 * fq;
#pragma unroll
        for (int ai = 0; ai < 2; ++ai)
#pragma unroll
            for (int m = 0; m < 4; ++m) {
                const int k1 = k0 + ai * HALF + m * 16;
#pragma unroll
                for (int bj = 0; bj < 2; ++bj) {
                    const int col = col0 + bj * HALF;
                    const f32x4 v0 = acc[ai][bj][m][0], v1 = acc[ai][bj][m][1];
                    bf16_t* ep = E + ((size_t)(b * 2048 + k1) * 1024 + col);
                    if (eo == 0) {
                        u32x4 w; w.x = cvt_pk_bf16(v0[0], v0[1]); w.y = cvt_pk_bf16(v0[2], v0[3]); w.z = cvt_pk_bf16(v1[0], v1[1]); w.w = cvt_pk_bf16(v1[2], v1[3]);
                        *(u32x4*)ep = w;
                    } else {
                        const u32x4 eu = *(const u32x4*)ep;
                        const f32x4 c0 = *(const f32x4*)(c2048 + b * 1024 + col), c1 = *(const f32x4*)(c2048 + b * 1024 + col + 4);
                        f32x4 e0 = (f32x4){__uint_as_float(eu.x << 16), __uint_as_float(eu.x & 0xffff0000u), __uint_as_float(eu.y << 16), __uint_as_float(eu.y & 0xffff0000u)};
                        f32x4 e1 = (f32x4){__uint_as_float(eu.z << 16), __uint_as_float(eu.z & 0xffff0000u), __uint_as_float(eu.w << 16), __uint_as_float(eu.w & 0xffff0000u)};
                        if (k1 & 1) { e0 = e0 - c0; e1 = e1 - c1; } else { e0 = e0 + c0; e1 = e1 + c1; }
                        const f32x4 d0 = e0 - v0, d1 = e1 - v1, s0 = e0 + v0, s1 = e1 + v1;
                        u32x4 w; w.x = cvt_pk_bf16(d0[0], d0[1]); w.y = cvt_pk_bf16(d0[2], d0[3]); w.z = cvt_pk_bf16(d1[0], d1[1]); w.w = cvt_pk_bf16(d1[2], d1[3]);
                        *(u32x4*)(f + ((size_t)(b * 4096 + k1) * 1024 + col)) = w;
                        if (k1 > 0) {
                            w.x = cvt_pk_bf16(s0[0], s0[1]); w.y = cvt_pk_bf16(s0[2], s0[3]); w.z = cvt_pk_bf16(s1[0], s1[1]); w.w = cvt_pk_bf16(s1[2], s1[3]);
                            *(u32x4*)(f + ((size_t)(b * 4096 + 4096 - k1) * 1024 + col)) = w;
                        }
                    }
                }
            }
    }
};
struct BatchOrder {
    int G, c;
    __device__ __forceinline__ bool next(int i, Unit& u) const { const int T = (i >> 1) * G + c, eo = i & 1; if (T >= 256) return false;
        const int b = T >> 5, r = T & 31, be = b * 2 + eo; u.pm = eo * 8 + (r >> 2); u.pn = be * 4 + (r & 3); return true; }
    __device__ __forceinline__ void a_ready(const Unit&) const {}
    __device__ __forceinline__ void done(const Unit&) const {}
};

template <class Epi, class Sched, bool ALIGN_EPI = false, bool SP2 = false>
__device__ __forceinline__ void gemm_phase(PG8_LAS unsigned char* lds, const Gemm g, const Sched& S, const Epi& E) {
    int tid_ = threadIdx.x; asm volatile("" : "+v"(tid_));
    const int tid = tid_, wid = __builtin_amdgcn_readfirstlane(tid >> 6), lane = tid & 63, wr = wid >> 2, wc = wid & 3, fr = lane & 15, fq = lane >> 4;
    const int K = g.K, nt = K / BK;
    unsigned voffA[2], voffB[2];
#pragma unroll
    for (int i = 0; i < 2; ++i) { int R, C; stage_rc(tid * 16 + i * 8192, R, C); const int Rb = Epi::PERM ? ((R & ~31) + perm32(R & 31)) : R;
        voffA[i] = (unsigned)(R * K + C) * 2u; voffB[i] = (unsigned)(Rb * K + C) * 2u; }
    const size_t kstep = (size_t)(BK * 2);
    const size_t hstep = (size_t)HALF * K * 2;
    const size_t tstep = 2 * hstep;
    const unsigned ldsw = (unsigned)wid * 1024u;
    const int aoff = lds_byte(wr * 64 + fr, fq * 8), boff = lds_byte(wc * 32 + fr, fq * 8);
#define PG8_SA(b, h) (((b) * 2 + (h)) * HTB)
#define PG8_SB(b, h) ((4 + (b) * 2 + (h)) * HTB)
#define PG8_STAGE(bufoff, gbase, voff) do { _Pragma("unroll") for (int _i = 0; _i < 2; ++_i) \
        __builtin_amdgcn_global_load_lds((const unsigned*)((const char*)(gbase) + (voff)[_i]), (PG8_LAS unsigned*)(lds + (bufoff) + ldsw + _i * 8192), 16, 0, 0); } while (0)
#define PG8_LDA(dst, b, h) do { _Pragma("unroll") for (int m = 0; m < 4; ++m) _Pragma("unroll") for (int k = 0; k < 2; ++k) dst[m][k] = *(const PG8_LAS bf16x8*)(lds + PG8_SA(b, h) + aoff + m * 2048 + k * 1024); } while (0)
#define PG8_LDB(dst, b, h) do { _Pragma("unroll") for (int n = 0; n < 2; ++n) _Pragma("unroll") for (int k = 0; k < 2; ++k) dst[n][k] = *(const PG8_LAS bf16x8*)(lds + PG8_SB(b, h) + boff + n * 2048 + k * 1024); } while (0)
#define PG8_MMA(ai, bj, At, Bt) do { __builtin_amdgcn_s_setprio(1); _Pragma("unroll") for (int m = 0; m < 4; ++m) _Pragma("unroll") for (int n = 0; n < 2; ++n) _Pragma("unroll") for (int k = 0; k < 2; ++k) \
        acc[ai][bj][m][n] = __builtin_amdgcn_mfma_f32_16x16x32_bf16(Bt[n][k], At[m][k], acc[ai][bj][m][n], 0, 0, 0); __builtin_amdgcn_s_setprio(0); } while (0)
#define PG8_WAIT_V(n) asm volatile("s_waitcnt vmcnt(" #n ")" ::: "memory")
#define PG8_WAIT_L(n) asm volatile("s_waitcnt lgkmcnt(" #n ")" ::: "memory")
#define PG8_BAR __builtin_amdgcn_s_barrier()
#define PG8_SCHED __builtin_amdgcn_sched_barrier(0)
    Unit cur, nxt; int ui = 0;
    if (!S.next(0, cur)) return;
    f32x4 acc[2][2][4][2];
#pragma unroll
    for (int a = 0; a < 2; ++a)
#pragma unroll
        for (int b = 0; b < 2; ++b)
#pragma unroll
            for (int m = 0; m < 4; ++m)
#pragma unroll
                for (int n = 0; n < 2; ++n) acc[a][b][m][n] = (f32x4){0.f, 0.f, 0.f, 0.f};
    bf16x8 At[4][2], B0[2][2], B1[2][2];
    const char* cA = (const char*)g.A + (size_t)cur.pm * tstep; const char* cB = (const char*)g.Bt + (size_t)cur.pn * tstep;
    S.a_ready(cur);
    if constexpr (SP2) {
        PG8_STAGE(PG8_SB(0, 0), cB, voffB); PG8_STAGE(PG8_SB(0, 1), cB + hstep, voffB); PG8_STAGE(PG8_SA(0, 0), cA, voffA); PG8_STAGE(PG8_SA(0, 1), cA + hstep, voffA);
        if (wr == 1) PG8_BAR;
        PG8_WAIT_V(2); PG8_BAR;
        PG8_STAGE(PG8_SB(1, 0), cB + kstep, voffB); PG8_STAGE(PG8_SA(1, 0), cA + kstep, voffA); PG8_STAGE(PG8_SB(1, 1), cB + hstep + kstep, voffB);
        PG8_WAIT_V(6); PG8_BAR;
    } else {
        PG8_STAGE(PG8_SB(0, 0), cB, voffB); PG8_STAGE(PG8_SA(0, 0), cA, voffA); PG8_STAGE(PG8_SB(0, 1), cB + hstep, voffB); PG8_STAGE(PG8_SA(0, 1), cA + hstep, voffA);
        if (wr == 1) PG8_BAR;
        PG8_WAIT_V(4); PG8_BAR;
        PG8_STAGE(PG8_SB(1, 0), cB + kstep, voffB); PG8_STAGE(PG8_SA(1, 0), cA + kstep, voffA); PG8_STAGE(PG8_SB(1, 1), cB + hstep + kstep, voffB);
        PG8_WAIT_V(6); PG8_BAR;
    }
    for (;;) {
        const bool has_next = S.next(ui + 1, nxt);
        const char* nA = has_next ? (const char*)g.A + (size_t)nxt.pm * tstep : cA; const char* nB = has_next ? (const char*)g.Bt + (size_t)nxt.pn * tstep : cB;
        for (int t = 0; t < nt; t += 2) {
            const bool last = (t == nt - 2);
            const char* a1 = cA + (size_t)(t + 1) * kstep;
            const char* a2 = last ? nA : cA + (size_t)(t + 2) * kstep; const char* b2 = last ? nB : cB + (size_t)(t + 2) * kstep;
            const char* a3 = a2 + kstep; const char* b3 = b2 + kstep;
            if (last && has_next) S.a_ready(nxt);
            if constexpr (SP2) {
            PG8_LDB(B0, 0, 0); PG8_LDB(B1, 0, 1); PG8_SCHED; PG8_LDA(At, 0, 0); PG8_STAGE(PG8_SA(1, 1), a1 + hstep, voffA);
            PG8_WAIT_V(8); PG8_WAIT_L(0); PG8_BAR; PG8_MMA(0, 0, At, B0); PG8_MMA(0, 1, At, B1); PG8_BAR; PG8_SCHED;
            PG8_LDA(At, 0, 1); PG8_STAGE(PG8_SB(0, 0), b2, voffB); PG8_STAGE(PG8_SB(0, 1), b2 + hstep, voffB); PG8_STAGE(PG8_SA(0, 0), a2, voffA);
            PG8_WAIT_V(8); PG8_WAIT_L(0); PG8_BAR; PG8_MMA(1, 0, At, B0); PG8_MMA(1, 1, At, B1); PG8_BAR; PG8_SCHED;
            PG8_LDB(B0, 1, 0); PG8_LDB(B1, 1, 1); PG8_SCHED; PG8_LDA(At, 1, 0); PG8_STAGE(PG8_SA(0, 1), a2 + hstep, voffA);
            PG8_WAIT_V(8); PG8_WAIT_L(0); PG8_BAR; PG8_MMA(0, 0, At, B0); PG8_MMA(0, 1, At, B1); PG8_BAR; PG8_SCHED;
            PG8_LDA(At, 1, 1); PG8_STAGE(PG8_SB(1, 0), b3, voffB); PG8_STAGE(PG8_SB(1, 1), b3 + hstep, voffB); PG8_STAGE(PG8_SA(1, 0), a3, voffA);
            PG8_WAIT_V(8); PG8_WAIT_L(0); PG8_BAR; PG8_MMA(1, 0, At, B0); PG8_MMA(1, 1, At, B1); PG8_BAR; PG8_SCHED;
            } else {
            PG8_LDB(B0, 0, 0); PG8_SCHED; PG8_LDA(At, 0, 0); PG8_STAGE(PG8_SA(1, 1), a1 + hstep, voffA);
            PG8_WAIT_L(8); PG8_BAR; PG8_WAIT_L(0); PG8_MMA(0, 0, At, B0); PG8_BAR; PG8_SCHED;
            PG8_LDB(B1, 0, 1); PG8_STAGE(PG8_SB(0, 0), b2, voffB);
            PG8_BAR; PG8_WAIT_L(0); PG8_MMA(0, 1, At, B1); PG8_BAR;
            PG8_LDA(At, 0, 1); PG8_STAGE(PG8_SA(0, 0), a2, voffA);
            PG8_BAR; PG8_WAIT_L(0); PG8_MMA(1, 0, At, B0); PG8_BAR; PG8_SCHED;
            PG8_STAGE(PG8_SB(0, 1), b2 + hstep, voffB);
            PG8_WAIT_V(6); PG8_BAR; PG8_MMA(1, 1, At, B1); PG8_BAR;
            PG8_LDB(B0, 1, 0); PG8_SCHED; PG8_LDA(At, 1, 0); PG8_STAGE(PG8_SA(0, 1), a2 + hstep, voffA);
            PG8_WAIT_L(8); PG8_BAR; PG8_WAIT_L(0); PG8_MMA(0, 0, At, B0); PG8_BAR; PG8_SCHED;
            PG8_LDB(B1, 1, 1); PG8_STAGE(PG8_SB(1, 0), b3, voffB);
            PG8_BAR; PG8_WAIT_L(0); PG8_MMA(0, 1, At, B1); PG8_BAR;
            PG8_LDA(At, 1, 1); PG8_STAGE(PG8_SA(1, 0), a3, voffA);
            PG8_BAR; PG8_WAIT_L(0); PG8_MMA(1, 0, At, B0); PG8_BAR; PG8_SCHED;
            PG8_STAGE(PG8_SB(1, 1), b3 + hstep, voffB);
            PG8_WAIT_V(6); PG8_BAR; PG8_MMA(1, 1, At, B1); PG8_BAR;
            }
        }
        if constexpr (ALIGN_EPI) { if (wr == 0) PG8_BAR; }
        if constexpr (!Epi::AFTER_DRAIN) { E(acc, cur, wr, wc, fr, fq); S.done(cur); }
        if (!has_next) break;
#pragma unroll
        for (int a = 0; a < 2; ++a)
#pragma unroll
            for (int b = 0; b < 2; ++b)
#pragma unroll
                for (int m = 0; m < 4; ++m)
#pragma unroll
                    for (int n = 0; n < 2; ++n) acc[a][b][m][n] = (f32x4){0.f, 0.f, 0.f, 0.f};
        cur = nxt; cA = nA; cB = nB; ++ui;
        if constexpr (ALIGN_EPI) { if (wr == 1) PG8_BAR; }
    }
    PG8_WAIT_V(0);
    if constexpr (!ALIGN_EPI) { if (wr == 0) PG8_BAR; }
    PG8_BAR;
    if constexpr (Epi::AFTER_DRAIN) { E.fused(acc, cur, wr, wc, fr, fq, lds, wid, lane); S.done(cur); }
#undef PG8_SA
#undef PG8_SB
#undef PG8_STAGE
#undef PG8_LDA
#undef PG8_LDB
#undef PG8_MMA
#undef PG8_WAIT_V
#undef PG8_WAIT_L
#undef PG8_BAR
#undef PG8_SCHED
}
}

template <class E> constexpr bool epi_whole = false;
DEV void gemm_first_load(const bf16_t* __restrict__ A, int lda, const bf16_t* __restrict__ Bt, int ldb, u32x4 (&ra)[4], u32x4 (&rb)[2]) {
  const int tid = tidx(), w = tid >> 6, l = tid & 63, lr = l & 15, lq = l >> 4;
#pragma unroll
  for (int j = 0; j < 4; ++j) {
    const int c = w * 4 + j, mt = c >> 1, sl = c & 1;
    ra[j] = *(const u32x4*)(A + (size_t)(mt * 16 + lr) * lda + sl * 32 + lq * 8);
  }
#pragma unroll
  for (int j = 0; j < 2; ++j) {
    const int nt = w, sl = j;
    const int rowb = (nt >> 2) * 64 + (lr >> 2) * 16 + (nt & 3) * 4 + (lr & 3);
    rb[j] = *(const u32x4*)(Bt + (size_t)rowb * ldb + sl * 32 + lq * 8);
  }
}
template <class Epi>
DEV void gemm_tile(char* lds, const bf16_t* __restrict__ A, int lda, const bf16_t* __restrict__ Bt, int ldb, int K, int trow, int tcol,
                   const Epi& epi, u32x4 (&ra)[4], u32x4 (&rb)[2], const bf16_t* __restrict__ An, const bf16_t* __restrict__ Bn) {
  const int tid = tidx(), w = tid >> 6, l = tid & 63, wm = w >> 1, wn = w & 1, lr = l & 15, lq = l >> 4;
  const bf16_t* ga[4];
  const bf16_t* gb[2];
#pragma unroll
  for (int j = 0; j < 4; ++j) {
    const int c = w * 4 + j, mt = c >> 1, sl = c & 1;
    ga[j] = A + (size_t)(mt * 16 + lr) * lda + sl * 32 + lq * 8;
  }
#pragma unroll
  for (int j = 0; j < 2; ++j) {
    const int nt = w, sl = j;
    const int rowb = (nt >> 2) * 64 + (lr >> 2) * 16 + (nt & 3) * 4 + (lr & 3);
    gb[j] = Bt + (size_t)rowb * ldb + sl * 32 + lq * 8;
  }
  f32x4 acc[4][4];
#pragma unroll
  for (int i = 0; i < 4; ++i)
#pragma unroll
    for (int j = 0; j < 4; ++j) acc[i][j] = (f32x4){0.f, 0.f, 0.f, 0.f};
  const int nk = K >> 6;
#pragma unroll
  for (int j = 0; j < 4; ++j) *(u32x4*)(lds + (w * 4 + j) * 1024 + l * 16) = ra[j];
#pragma unroll
  for (int j = 0; j < 2; ++j) *(u32x4*)(lds + 32768 + (w * 2 + j) * 1024 + l * 16) = rb[j];
  __syncthreads();
  for (int kt = 0; kt < nk; ++kt) {
    char* cur = lds + (kt & 1) * 49152;
    const bool more = (kt + 1 < nk);
    if (more) {
#pragma unroll
      for (int j = 0; j < 4; ++j) ra[j] = *(const u32x4*)(ga[j] + (kt + 1) * 64);
#pragma unroll
      for (int j = 0; j < 2; ++j) rb[j] = *(const u32x4*)(gb[j] + (kt + 1) * 64);
    }
#pragma unroll
    for (int s = 0; s < 2; ++s) {
      bf16x8 af[4], bfr[4];
#pragma unroll
      for (int i = 0; i < 4; ++i) af[i] = *(const bf16x8*)(cur + ((wm * 4 + i) * 2 + s) * 1024 + l * 16);
#pragma unroll
      for (int j = 0; j < 4; ++j) bfr[j] = *(const bf16x8*)(cur + 32768 + ((wn * 4 + j) * 2 + s) * 1024 + l * 16);
#pragma unroll
      for (int i = 0; i < 4; ++i)
#pragma unroll
        for (int j = 0; j < 4; ++j) acc[i][j] = __builtin_amdgcn_mfma_f32_16x16x32_bf16(bfr[j], af[i], acc[i][j], 0, 0, 0);
    }
    if (more) {
      char* nxt = lds + ((kt + 1) & 1) * 49152;
#pragma unroll
      for (int j = 0; j < 4; ++j) *(u32x4*)(nxt + (w * 4 + j) * 1024 + l * 16) = ra[j];
#pragma unroll
      for (int j = 0; j < 2; ++j) *(u32x4*)(nxt + 32768 + (w * 2 + j) * 1024 + l * 16) = rb[j];
    }
    __syncthreads();
  }
  if (An) gemm_first_load(An, lda, Bn, ldb, ra, rb);
  if constexpr (epi_whole<Epi>) epi.whole(trow + wm * 64 + lr, tcol + wn * 64 + lq * 16, acc);
  else {
#pragma unroll
    for (int i = 0; i < 4; ++i) epi(trow + wm * 64 + i * 16 + lr, tcol + wn * 64 + lq * 16, acc[i]);
  }
}

DEV void store16_bf16(bf16_t* dst, const f32x4 (&v)[4], float sc) {
  u32x4 a, b;
  a.x = pk2(v[0][0] * sc, v[0][1] * sc); a.y = pk2(v[0][2] * sc, v[0][3] * sc);
  a.z = pk2(v[1][0] * sc, v[1][1] * sc); a.w = pk2(v[1][2] * sc, v[1][3] * sc);
  b.x = pk2(v[2][0] * sc, v[2][1] * sc); b.y = pk2(v[2][2] * sc, v[2][3] * sc);
  b.z = pk2(v[3][0] * sc, v[3][1] * sc); b.w = pk2(v[3][2] * sc, v[3][3] * sc);
  *(u32x4*)dst = a;
  *(u32x4*)(dst + 8) = b;
}

struct EpiBf16 {
  bf16_t* O; int ldo;
  DEV void operator()(int row, int col, const f32x4 (&v)[4]) const { store16_bf16(O + (size_t)row * ldo + col, v, 1.f); }
};
struct EpiF32 {
  float* O; int ldo;
  DEV void operator()(int row, int col, const f32x4 (&v)[4]) const {
    float* d = O + (size_t)row * ldo + col;
#pragma unroll
    for (int j = 0; j < 4; ++j) *(f32x4*)(d + 4 * j) = v[j];
  }
};
struct EpiLora1 {
  bf16_t* O;
  DEV void operator()(int row, int col, const f32x4 (&v)[4]) const {
    f32x4 o[4];
#pragma unroll
    for (int j = 0; j < 4; ++j)
#pragma unroll
      for (int r = 0; r < 4; ++r) {
        const float t = v[j][r];
        o[j][r] = (col < 128) ? (1.f - 2.f * __builtin_amdgcn_rcpf(1.f + __expf(2.f * t))) : ((col < 256) ? t : sigmoidf_(t));
      }
    store16_bf16(O + (size_t)row * 384 + col, o, 1.f);
  }
};
DEV unsigned pkh(float a, float b) { return (unsigned)(a * 3000.f + 0.5f) | ((unsigned)(b * 3000.f + 0.5f) << 16); }
DEV void unpackh8(const u32x4 u, float (&f)[8]) {
  const float q = 1.f / 3000.f;
  f[0] = (float)(u.x & 0xffffu) * q; f[1] = (float)(u.x >> 16) * q; f[2] = (float)(u.y & 0xffffu) * q; f[3] = (float)(u.y >> 16) * q;
  f[4] = (float)(u.z & 0xffffu) * q; f[5] = (float)(u.z >> 16) * q; f[6] = (float)(u.w & 0xffffu) * q; f[7] = (float)(u.w >> 16) * q;
}
template <int CTRL> DEV float dppz_(float x) { return __int_as_float(__builtin_amdgcn_update_dpp(0, __float_as_int(x), CTRL, 0xF, 0xF, true)); }
struct EpiDecay {
  unsigned short* O; const float* w0; int dir;
  DEV void whole(int row0, int col, const f32x4 (&acc)[4][4]) const {
    float w0v[16];
#pragma unroll
    for (int i = 0; i < 16; i += 4) *(f32x4*)(w0v + i) = *(const f32x4*)(w0 + col + i);
    const int lane = tidx() & 63;
#pragma unroll
    for (int pr = 0; pr < 2; ++pr) {
      float E0[16], E1[16];
#pragma unroll
      for (int j = 0; j < 4; ++j)
#pragma unroll
        for (int r = 0; r < 4; ++r) {
          float e0 = 0.6065306597126334f * sigmoidf_(w0v[4 * j + r] + acc[2 * pr][j][r]);
          float e1 = 0.6065306597126334f * sigmoidf_(w0v[4 * j + r] + acc[2 * pr + 1][j][r]);
          if (dir == 0) {
            e0 += dppz_<0x111>(e0); e0 += dppz_<0x112>(e0); e0 += dppz_<0x114>(e0); e0 += dppz_<0x118>(e0);
            e1 += dppz_<0x111>(e1); e1 += dppz_<0x112>(e1); e1 += dppz_<0x114>(e1); e1 += dppz_<0x118>(e1);
            e1 += __shfl(e0, (lane & 48) | 15);
          } else {
            e0 += dppz_<0x101>(e0); e0 += dppz_<0x102>(e0); e0 += dppz_<0x104>(e0); e0 += dppz_<0x108>(e0);
            e1 += dppz_<0x101>(e1); e1 += dppz_<0x102>(e1); e1 += dppz_<0x104>(e1); e1 += dppz_<0x108>(e1);
            e0 += __shfl(e1, (lane & 48));
          }
          E0[4 * j + r] = e0; E1[4 * j + r] = e1;
        }
      u32x4 p0, p1, q0, q1;
      p0.x = pkh(E0[0], E0[1]); p0.y = pkh(E0[2], E0[3]); p0.z = pkh(E0[4], E0[5]); p0.w = pkh(E0[6], E0[7]);
      p1.x = pkh(E0[8], E0[9]); p1.y = pkh(E0[10], E0[11]); p1.z = pkh(E0[12], E0[13]); p1.w = pkh(E0[14], E0[15]);
      q0.x = pkh(E1[0], E1[1]); q0.y = pkh(E1[2], E1[3]); q0.z = pkh(E1[4], E1[5]); q0.w = pkh(E1[6], E1[7]);
      q1.x = pkh(E1[8], E1[9]); q1.y = pkh(E1[10], E1[11]); q1.z = pkh(E1[12], E1[13]); q1.w = pkh(E1[14], E1[15]);
      unsigned short* d0 = O + (size_t)(row0 + 32 * pr) * 512 + col;
      *(u32x4*)d0 = p0; *(u32x4*)(d0 + 8) = p1;
      *(u32x4*)(d0 + 16 * 512) = q0; *(u32x4*)(d0 + 16 * 512 + 8) = q1;
    }
  }
};
template <> constexpr bool epi_whole<EpiDecay> = true;
struct EpiA {
  bf16_t *AA, *KK; const float *a0, *k_k; const bf16_t* za; int writekk;
  DEV void operator()(int row, int col, const f32x4 (&v)[4]) const {
    float a0v[16];
#pragma unroll
    for (int i = 0; i < 16; i += 4) *(f32x4*)(a0v + i) = *(const f32x4*)(a0 + col + i);
    f32x4 oa[4];
#pragma unroll
    for (int j = 0; j < 4; ++j)
#pragma unroll
      for (int r = 0; r < 4; ++r) oa[j][r] = sigmoidf_(a0v[4 * j + r] + v[j][r]);
    store16_bf16(AA + (size_t)row * 512 + col, oa, 1.f);
    if (writekk) {
      const bf16_t* kp = za + (size_t)row * 2048 + 512 + col;
      const u32x4 k0 = *(const u32x4*)kp, k1 = *(const u32x4*)(kp + 8);
      float kf[16], kkv[16];
      kf[0] = lo16(k0.x); kf[1] = hi16(k0.x); kf[2] = lo16(k0.y); kf[3] = hi16(k0.y); kf[4] = lo16(k0.z); kf[5] = hi16(k0.z); kf[6] = lo16(k0.w); kf[7] = hi16(k0.w);
      kf[8] = lo16(k1.x); kf[9] = hi16(k1.x); kf[10] = lo16(k1.y); kf[11] = hi16(k1.y); kf[12] = lo16(k1.z); kf[13] = hi16(k1.z); kf[14] = lo16(k1.w); kf[15] = hi16(k1.w);
#pragma unroll
      for (int i = 0; i < 16; i += 4) *(f32x4*)(kkv + i) = *(const f32x4*)(k_k + col + i);
      float ss = 0.f;
#pragma unroll
      for (int i = 0; i < 16; ++i) { kf[i] *= kkv[i]; ss += kf[i] * kf[i]; }
      ss += __shfl_xor(ss, 16);
      ss += __shfl_xor(ss, 32);
      const float rn = rsqrtf(ss + 1e-12f);
      f32x4 okk[4];
#pragma unroll
      for (int j = 0; j < 4; ++j)
#pragma unroll
        for (int r = 0; r < 4; ++r) okk[j][r] = kf[4 * j + r] * rn;
      store16_bf16(KK + (size_t)row * 512 + col, okk, 1.f);
    }
  }
};
struct EpiDftc {
  bf16_t* CST; int g;
  DEV void operator()(int row, int col, const f32x4 (&v)[4]) const {
    const int b = col >> 11, s = col & 2047;
    store16_bf16(CST + ((size_t)((b * 2 + (row >> 7)) * 1024 + g * 128 + (row & 127)) * 2048 + s), v, 1.f);
  }
};

DEV void transpose_convert(char* lds, const float* __restrict__ W, int K, int N, bf16_t* __restrict__ Wt, int ldt, int rot, int mode = 0) {
  float* tile = (float*)lds;
  const int tn_n = N >> 6, nt = (K >> 6) * tn_n, tid = tidx();
  const int r0 = tid >> 4, c4 = (tid & 15) * 4;
  int t = (blockIdx.x + rot) % gridDim.x;
  f32x4 ra, rb;
  if (t < nt) {
    const int tk = t / tn_n, tn = t % tn_n;
    const float* src = W + (size_t)(tk * 64 + r0) * N + tn * 64 + c4;
    ra = *(const f32x4*)src; rb = *(const f32x4*)(src + (size_t)32 * N);
  }
  for (; t < nt; t += gridDim.x) {
    const int tk = t / tn_n, tn = t % tn_n;
#pragma unroll
    for (int i = 0; i < 4; ++i) { tile[r0 * 65 + c4 + i] = ra[i]; tile[(r0 + 32) * 65 + c4 + i] = rb[i]; }
    __syncthreads();
    const int t2 = t + gridDim.x;
    if (t2 < nt) {
      const int tk2 = t2 / tn_n, tn2 = t2 % tn_n;
      const float* src = W + (size_t)(tk2 * 64 + r0) * N + tn2 * 64 + c4;
      ra = *(const f32x4*)src; rb = *(const f32x4*)(src + (size_t)32 * N);
    }
    int nbase = tn * 64;
    if (mode == 1) { const int c = tn * 64; nbase = (c < 2816) ? ((c >> 7) * 256 + (c & 127)) : (((c - 2816) >> 7) * 256 + 128 + ((c - 2816) & 127)); }
    const bool qk = (mode == 2) && (tn * 64 >= 2048) && (tn * 64 < 3072);
#pragma unroll
    for (int j = 0; j < 2; ++j) {
      const int ns = r0 + 32 * j;
      const int n = qk ? (2 * (ns & 31) + (ns >> 5)) : ns;
      u32x2 pk;
      pk.x = pk2(tile[(c4 + 0) * 65 + ns], tile[(c4 + 1) * 65 + ns]);
      pk.y = pk2(tile[(c4 + 2) * 65 + ns], tile[(c4 + 3) * 65 + ns]);
      *(u32x2*)(Wt + (size_t)(nbase + n) * ldt + tk * 64 + c4) = pk;
    }
    __syncthreads();
  }
}

DEV void compute_mod(char* lds, const P& p) {
  float* cs = (float*)lds;
  float* red = (float*)(lds + 32768);
  const int tid = tidx();
  float* mod = (float*)(p.ws + W_MOD);
  bool have = false;
  for (int item = blockIdx.x; item < 192; item += gridDim.x) {
    if (!have) {
      for (int i = tid; i < 8192; i += NTHR) { const float cv = p.c[i]; cs[i] = cv / (1.f + expf(-cv)); }
      __syncthreads();
      have = true;
    }
    const int l = item / 96, cb = item % 96, col = cb * 64 + (tid & 63), kg = tid >> 6;
    float a0 = 0, a1 = 0, a2 = 0, a3 = 0, a4 = 0, a5 = 0, a6 = 0, a7 = 0;
    const float* wp = p.ada_w + ((size_t)l * 1024 + kg * 128) * 6144 + col;
    for (int k0 = 0; k0 < 128; k0 += 16) {
      float wv[16];
#pragma unroll
      for (int u = 0; u < 16; ++u) wv[u] = wp[(size_t)(k0 + u) * 6144];
#pragma unroll
      for (int u = 0; u < 16; ++u) {
        const int kk = kg * 128 + k0 + u;
        a0 += cs[kk] * wv[u]; a1 += cs[1024 + kk] * wv[u]; a2 += cs[2048 + kk] * wv[u]; a3 += cs[3072 + kk] * wv[u];
        a4 += cs[4096 + kk] * wv[u]; a5 += cs[5120 + kk] * wv[u]; a6 += cs[6144 + kk] * wv[u]; a7 += cs[7168 + kk] * wv[u];
      }
    }
    float* rp = red + kg * 512 + (tid & 63);
    rp[0] = a0; rp[64] = a1; rp[128] = a2; rp[192] = a3; rp[256] = a4; rp[320] = a5; rp[384] = a6; rp[448] = a7;
    __syncthreads();
    {
      const int b = tid >> 6, cc = tid & 63;
      float s = 0.f;
#pragma unroll
      for (int g = 0; g < 8; ++g) s += red[g * 512 + b * 64 + cc];
      mod[(size_t)(l * 8 + b) * 6144 + cb * 64 + cc] = s + p.ada_b[l * 6144 + cb * 64 + cc];
    }
    __syncthreads();
  }
}

template <bool HAS_Y, bool HAS_H, bool XIN_BF = false, bool XOUT_BF = false>
DEV void rowpass(const void* __restrict__ xin_, const bf16_t* __restrict__ yf, const float* __restrict__ gy, const float* __restrict__ gate,
                 void* __restrict__ xout_, const float* __restrict__ gh, const float* __restrict__ sc, const float* __restrict__ sh,
                 bf16_t* __restrict__ h) {
  const float* xin = (const float*)xin_; const bf16_t* xinb = (const bf16_t*)xin_;
  float* xout = (float*)xout_; bf16_t* xoutb = (bf16_t*)xout_;
  const int lane = tidx() & 63, gw = blockIdx.x * 8 + (tidx() >> 6), nw = gridDim.x * 8;
  for (int row = gw; row < MT; row += nw) {
    const int b = row >> 12;
    f32x4 xv[4];
#pragma unroll
    for (int i = 0; i < 4; ++i) {
      if (XIN_BF) { const u32x2 xu = *(const u32x2*)(xinb + (size_t)row * 1024 + i * 256 + lane * 4); xv[i] = (f32x4){lo16(xu.x), hi16(xu.x), lo16(xu.y), hi16(xu.y)}; }
      else xv[i] = *(const f32x4*)(xin + (size_t)row * 1024 + i * 256 + lane * 4);
    }
    if (HAS_Y) {
      f32x4 yv[4];
      float ss = 0.f;
#pragma unroll
      for (int i = 0; i < 4; ++i) {
        const u32x2 yu = *(const u32x2*)(yf + (size_t)row * 1024 + i * 256 + lane * 4);
        yv[i] = (f32x4){lo16(yu.x), hi16(yu.x), lo16(yu.y), hi16(yu.y)};
        ss += yv[i][0] * yv[i][0] + yv[i][1] * yv[i][1] + yv[i][2] * yv[i][2] + yv[i][3] * yv[i][3];
      }
      ss = wave_sum(ss);
      const float rs = rsqrtf(ss * (1.f / 1024.f) + 1e-6f);
#pragma unroll
      for (int i = 0; i < 4; ++i) {
        const int col = i * 256 + lane * 4;
        const f32x4 g4 = *(const f32x4*)(gy + col), gt = *(const f32x4*)(gate + (size_t)b * 6144 + col);
        xv[i] = xv[i] + gt * (yv[i] * rs * g4);
        if (XOUT_BF) { u32x2 pk; pk.x = pk2(xv[i][0], xv[i][1]); pk.y = pk2(xv[i][2], xv[i][3]); *(u32x2*)(xoutb + (size_t)row * 1024 + col) = pk;
                       xv[i] = (f32x4){lo16(pk.x), hi16(pk.x), lo16(pk.y), hi16(pk.y)}; }
        else *(f32x4*)(xout + (size_t)row * 1024 + col) = xv[i];
      }
    }
    if (HAS_H) {
      float ss = 0.f;
#pragma unroll
      for (int i = 0; i < 4; ++i) ss += xv[i][0] * xv[i][0] + xv[i][1] * xv[i][1] + xv[i][2] * xv[i][2] + xv[i][3] * xv[i][3];
      ss = wave_sum(ss);
      const float rs = rsqrtf(ss * (1.f / 1024.f) + 1e-6f);
#pragma unroll
      for (int i = 0; i < 4; ++i) {
        const int col = i * 256 + lane * 4;
        const f32x4 g4 = *(const f32x4*)(gh + col), s4 = *(const f32x4*)(sc + (size_t)b * 6144 + col), h4 = *(const f32x4*)(sh + (size_t)b * 6144 + col);
        const f32x4 o = (xv[i] * rs * g4) * (s4 + 1.f) + h4;
        u32x2 pk;
        pk.x = pk2(o[0], o[1]); pk.y = pk2(o[2], o[3]);
        *(u32x2*)(h + (size_t)row * 1024 + col) = pk;
      }
    }
  }
}

DEV void row_xh(int row, bf16_t* __restrict__ xb, const bf16_t* __restrict__ yf, const float* __restrict__ gy, const float* __restrict__ gate,
                const float* __restrict__ gh, const float* __restrict__ sc, const float* __restrict__ sh, int lane, f32x4 (&hv)[4]) {
  const int b = row >> 12;
  f32x4 xv[4], yv[4];
  float ss = 0.f;
#pragma unroll
  for (int i = 0; i < 4; ++i) {
    const u32x2 xu = *(const u32x2*)(xb + (size_t)row * 1024 + i * 256 + lane * 4), yu = *(const u32x2*)(yf + (size_t)row * 1024 + i * 256 + lane * 4);
    xv[i] = (f32x4){lo16(xu.x), hi16(xu.x), lo16(xu.y), hi16(xu.y)};
    yv[i] = (f32x4){lo16(yu.x), hi16(yu.x), lo16(yu.y), hi16(yu.y)};
    ss += yv[i][0] * yv[i][0] + yv[i][1] * yv[i][1] + yv[i][2] * yv[i][2] + yv[i][3] * yv[i][3];
  }
  ss = wave_sum(ss);
  const float rs = rsqrtf(ss * (1.f / 1024.f) + 1e-6f);
  float s2 = 0.f;
#pragma unroll
  for (int i = 0; i < 4; ++i) {
    const int col = i * 256 + lane * 4;
    const f32x4 g4 = *(const f32x4*)(gy + col), gt = *(const f32x4*)(gate + (size_t)b * 6144 + col);
    const f32x4 xn = xv[i] + gt * (yv[i] * rs * g4);
    u32x2 pk; pk.x = pk2(xn[0], xn[1]); pk.y = pk2(xn[2], xn[3]);
    *(u32x2*)(xb + (size_t)row * 1024 + col) = pk;
    xv[i] = (f32x4){lo16(pk.x), hi16(pk.x), lo16(pk.y), hi16(pk.y)};
    s2 += xv[i][0] * xv[i][0] + xv[i][1] * xv[i][1] + xv[i][2] * xv[i][2] + xv[i][3] * xv[i][3];
  }
  s2 = wave_sum(s2);
  const float r2 = rsqrtf(s2 * (1.f / 1024.f) + 1e-6f);
#pragma unroll
  for (int i = 0; i < 4; ++i) {
    const int col = i * 256 + lane * 4;
    const f32x4 g4 = *(const f32x4*)(gh + col), s4 = *(const f32x4*)(sc + (size_t)b * 6144 + col), h4 = *(const f32x4*)(sh + (size_t)b * 6144 + col);
    hv[i] = (xv[i] * r2 * g4) * (s4 + 1.f) + h4;
  }
}
DEV void rowpass_fold(bf16_t* __restrict__ xb, const bf16_t* __restrict__ yf, const float* __restrict__ gy, const float* __restrict__ gate,
                      const float* __restrict__ gh, const float* __restrict__ sc, const float* __restrict__ sh, bf16_t* __restrict__ hfd, float* __restrict__ h2048) {
  const int lane = tidx() & 63, gw = blockIdx.x * 8 + (tidx() >> 6), nw = gridDim.x * 8;
  for (int item = gw; item < 8 * 2048; item += nw) {
    const int b = item >> 11, s = item & 2047;
    const int rowA = b * 4096 + s, rowB = b * 4096 + (s ? 4096 - s : 2048);
    f32x4 ha[4], hb[4];
    row_xh(rowA, xb, yf, gy, gate, gh, sc, sh, lane, ha);
    row_xh(rowB, xb, yf, gy, gate, gh, sc, sh, lane, hb);
#pragma unroll
    for (int i = 0; i < 4; ++i) {
      const int col = i * 256 + lane * 4, g = col >> 7, c = col & 127;
      f32x4 f = ha[i] + hb[i], dd = ha[i] - hb[i];
      if (s == 0) { f = ha[i]; dd = (f32x4){0.f, 0.f, 0.f, 0.f}; *(f32x4*)(h2048 + b * 1024 + col) = hb[i]; }
      bf16_t* dp = hfd + (size_t)(b * 2048 + s) * 2048 + g * 256 + c;
      u32x2 pk;
      pk.x = pk2(f[0], f[1]); pk.y = pk2(f[2], f[3]); *(u32x2*)dp = pk;
      pk.x = pk2(dd[0], dd[1]); pk.y = pk2(dd[2], dd[3]); *(u32x2*)(dp + 128) = pk;
    }
  }
}

DEV void unpack8(const u32x4 u, float (&f)[8]) {
  f[0] = lo16(u.x); f[1] = hi16(u.x); f[2] = lo16(u.y); f[3] = hi16(u.y); f[4] = lo16(u.z); f[5] = hi16(u.z); f[6] = lo16(u.w); f[7] = hi16(u.w);
}
DEV u32x4 pack8(const float (&f)[8]) {
  u32x4 u;
  u.x = pk2(f[0], f[1]); u.y = pk2(f[2], f[3]); u.z = pk2(f[4], f[5]); u.w = pk2(f[6], f[7]);
  return u;
}

DEV void prep1(const P& p) {
  const bf16_t* z = (const bf16_t*)(p.ws + O_Z);
  bf16_t* za = (bf16_t*)p.out;
  bf16_t* qr = (bf16_t*)(p.ws + O_QR);
  bf16_t* kr = (bf16_t*)(p.ws + O_KR);
  bf16_t* vt = (bf16_t*)(p.ws + O_VT);
  const float* rope = (const float*)(p.ws + W_ROPE);
  const int gt = blockIdx.x * NTHR + tidx(), ngt = gridDim.x * NTHR;
  for (int idx = gt; idx < MT * 256; idx += ngt) {
    const int tok = idx >> 8, c8 = (idx & 255) * 8, s = tok & 4095;
    const bf16_t* zp = z + (size_t)tok * INC + c8;
    float zc[8], zm[8], zn[8], o[8];
    unpack8(*(const u32x4*)zp, zc);
    if (s > 0) unpack8(*(const u32x4*)(zp - INC), zm); else { for (int i = 0; i < 8; ++i) zm[i] = 0.f; }
    if (s < 4095) unpack8(*(const u32x4*)(zp + INC), zn); else { for (int i = 0; i < 8; ++i) zn[i] = 0.f; }
    float w0[8], w1[8], w2[8];
    *(f32x4*)w0 = *(const f32x4*)(p.mix_conv + c8); *(f32x4*)(w0 + 4) = *(const f32x4*)(p.mix_conv + c8 + 4);
    *(f32x4*)w1 = *(const f32x4*)(p.mix_conv + 2048 + c8); *(f32x4*)(w1 + 4) = *(const f32x4*)(p.mix_conv + 2048 + c8 + 4);
    *(f32x4*)w2 = *(const f32x4*)(p.mix_conv + 4096 + c8); *(f32x4*)(w2 + 4) = *(const f32x4*)(p.mix_conv + 4096 + c8 + 4);
#pragma unroll
    for (int i = 0; i < 8; ++i) o[i] = zm[i] * w0[i] + zc[i] * w1[i] + zn[i] * w2[i];
    *(u32x4*)(za + (size_t)tok * 2048 + c8) = pack8(o);
  }
  for (int idx = gt; idx < MT * 64; idx += ngt) {
    const int e8 = idx & 3, which = (idx >> 2) & 1, h = (idx >> 3) & 7, tok = idx >> 6, s = tok & 4095;
    const bf16_t* src = z + (size_t)tok * INC + 2048 + which * 512 + h * 64 + e8 * 8;
    float x1[8], x2[8], o1[8], o2[8];
    unpack8(*(const u32x4*)src, x1);
    unpack8(*(const u32x4*)(src + 32), x2);
    const float* rp = rope + ((size_t)s * 32 + e8 * 8) * 2;
    const float scl = which ? 1.f : 0.125f;
#pragma unroll
    for (int i = 0; i < 8; ++i) {
      const float cv = rp[2 * i], sv = rp[2 * i + 1];
      o1[i] = (x1[i] * cv - x2[i] * sv) * scl;
      o2[i] = (x2[i] * cv + x1[i] * sv) * scl;
    }
    bf16_t* dst = (which ? kr : qr) + (size_t)tok * 512 + h * 64 + e8 * 8;
    *(u32x4*)dst = pack8(o1);
    *(u32x4*)(dst + 32) = pack8(o2);
  }
  {
    bf16_t* vr = (bf16_t*)(p.ws + O_VT);
    for (int idx = gt; idx < MT * 64; idx += ngt) {
      const int tok = idx >> 6, c8 = (idx & 63) * 8;
      *(u32x4*)(vr + (size_t)tok * 512 + c8) = *(const u32x4*)(z + (size_t)tok * INC + 3072 + c8);
    }
  }
}

DEV void za_fixup(const P& p) {
  const bf16_t* sb = (const bf16_t*)(p.ws + O_SBZ);
  bf16_t* za = (bf16_t*)p.out;
  const int gt = blockIdx.x * NTHR + tidx(), ngt = gridDim.x * NTHR;
  for (int item = gt; item < 512 * 2 * 256; item += ngt) {
    const int strip = item >> 9, e = (item >> 8) & 1, c8 = (item & 255) * 8;
    const int R = strip * 64 + (e ? 63 : 0), s = R & 4095;
    const bf16_t* pc = sb + ((size_t)strip * 4 + (e ? 3 : 0)) * 2048 + c8;
    const u32x4 z0 = (u32x4){0u, 0u, 0u, 0u};
    const bool hasp = e ? true : (s > 0), hasn = e ? (s < 4095) : true;
    float zm[8], zc[8], zn[8], o[8], w0[8], w1[8], w2[8];
    unpack8(hasp ? *(const u32x4*)(pc - 2048) : z0, zm);
    unpack8(*(const u32x4*)pc, zc);
    unpack8(hasn ? *(const u32x4*)(pc + 2048) : z0, zn);
    *(f32x4*)w0 = *(const f32x4*)(p.mix_conv + c8); *(f32x4*)(w0 + 4) = *(const f32x4*)(p.mix_conv + c8 + 4);
    *(f32x4*)w1 = *(const f32x4*)(p.mix_conv + 2048 + c8); *(f32x4*)(w1 + 4) = *(const f32x4*)(p.mix_conv + 2048 + c8 + 4);
    *(f32x4*)w2 = *(const f32x4*)(p.mix_conv + 4096 + c8); *(f32x4*)(w2 + 4) = *(const f32x4*)(p.mix_conv + 4096 + c8 + 4);
#pragma unroll
    for (int i = 0; i < 8; ++i) o[i] = zm[i] * w0[i] + zc[i] * w1[i] + zn[i] * w2[i];
    *(u32x4*)(za + (size_t)R * 2048 + c8) = pack8(o);
  }
}

DEV void za_fixup_u(const P& p, int tm) {
  const bf16_t* sb = (const bf16_t*)(p.ws + O_SBZ);
  bf16_t* za = (bf16_t*)p.out;
  const int item = tidx();
  const int strip = tm * 4 + (item >> 7), e = (item >> 6) & 1, c8 = 1536 + (item & 63) * 8;
  const int R = strip * 64 + (e ? 63 : 0), s = R & 4095;
  const bf16_t* pc = sb + ((size_t)strip * 4 + (e ? 3 : 0)) * 2048 + c8;
  const u32x4 z0 = (u32x4){0u, 0u, 0u, 0u};
  const bool hasp = e ? true : (s > 0), hasn = e ? (s < 4095) : true;
  float zm[8], zc[8], zn[8], o[8], w0[8], w1[8], w2[8];
  unpack8(hasp ? *(const u32x4*)(pc - 2048) : z0, zm);
  unpack8(*(const u32x4*)pc, zc);
  unpack8(hasn ? *(const u32x4*)(pc + 2048) : z0, zn);
  *(f32x4*)w0 = *(const f32x4*)(p.mix_conv + c8); *(f32x4*)(w0 + 4) = *(const f32x4*)(p.mix_conv + c8 + 4);
  *(f32x4*)w1 = *(const f32x4*)(p.mix_conv + 2048 + c8); *(f32x4*)(w1 + 4) = *(const f32x4*)(p.mix_conv + 2048 + c8 + 4);
  *(f32x4*)w2 = *(const f32x4*)(p.mix_conv + 4096 + c8); *(f32x4*)(w2 + 4) = *(const f32x4*)(p.mix_conv + 4096 + c8 + 4);
#pragma unroll
  for (int i = 0; i < 8; ++i) o[i] = zm[i] * w0[i] + zc[i] * w1[i] + zn[i] * w2[i];
  *(u32x4*)(za + (size_t)R * 2048 + c8) = pack8(o);
}

DEV void attention(char* lds, const P& p) {
  const bf16_t* qr = (const bf16_t*)(p.ws + O_QR);
  const bf16_t* kr = (const bf16_t*)(p.ws + O_KR);
  const bf16_t* vt = (const bf16_t*)(p.ws + O_VT);
  bf16_t* num = (bf16_t*)(p.ws + O_NUM);
  float* md = (float*)(p.ws + O_MD);
  constexpr int UNIT_LDS = 24576 + 64 * 400;
  const int tid = tidx(), w = tid >> 6, lane = tid & 63, lr = lane & 15, lq = lane >> 4;
  const int uh = tid >> 8, lt = tid & 255, mt = w & 3;
  char* ul = lds + uh * UNIT_LDS;
  u32x4 pre[12];
  bf16x8 qn[2];
  auto load_pair = [&](int pi) {
    const int unit = pi * 2 + uh;
    const int nb = unit & 63, h = (unit >> 6) & 7, b = (unit >> 9) & 7, br = unit >> 12;
    const int dsh = 2 * br, Mr = 4096 >> dsh;
    const int seg = (nb * 64) / Mr, segstart = seg * Mr, segend = segstart + Mr;
    const bool pv_ok = (nb * 64 - 64 >= segstart), nx_ok = (nb * 64 + 128 <= segend);
#pragma unroll
    for (int j = 0; j < 6; ++j) {
      const int pc = lt + 256 * j, key = pc >> 3, ch = pc & 7, kb = key >> 6;
      int blk = nb + kb - 1;
      if ((kb == 0 && !pv_ok) || (kb == 2 && !nx_ok)) blk = nb;
      const int kp = blk * 64 + (key & 63);
      const int ktok = b * 4096 + (((kp - segstart) << dsh) + seg);
      pre[j] = *(const u32x4*)(kr + (size_t)ktok * 512 + h * 64 + ch * 8);
      pre[6 + j] = *(const u32x4*)(vt + (size_t)ktok * 512 + h * 64 + ch * 8);
    }
    {
      const int qp = nb * 64 + mt * 16 + lr;
      const int qtok = b * 4096 + (((qp - segstart) << dsh) + seg);
      qn[0] = *(const bf16x8*)(qr + (size_t)qtok * 512 + h * 64 + lq * 8);
      qn[1] = *(const bf16x8*)(qr + (size_t)qtok * 512 + h * 64 + 32 + lq * 8);
    }
  };
  const int npairs = 3 * 4096 / 2;
  int pi = blockIdx.x;
  if (pi < npairs) load_pair(pi);
  for (; pi < npairs; pi += gridDim.x) {
#pragma unroll
    for (int j = 0; j < 6; ++j) {
      const int pc = lt + 256 * j, key = pc >> 3, ch = pc & 7;
      *(u32x4*)(ul + key * 128 + ((ch ^ (key & 7)) * 16)) = pre[j];
    }
#pragma unroll
    for (int j = 0; j < 6; ++j) {
      const int pc = lt + 256 * j, key = pc >> 3, ch = pc & 7;
      bf16_t* vd = (bf16_t*)(ul + 24576 + (ch * 8) * 400) + (key ^ (ch << 2));
      const u32x4 u = pre[6 + j];
      vd[0 * 200] = (bf16_t)(u.x & 0xffff); vd[1 * 200] = (bf16_t)(u.x >> 16); vd[2 * 200] = (bf16_t)(u.y & 0xffff); vd[3 * 200] = (bf16_t)(u.y >> 16);
      vd[4 * 200] = (bf16_t)(u.z & 0xffff); vd[5 * 200] = (bf16_t)(u.z >> 16); vd[6 * 200] = (bf16_t)(u.w & 0xffff); vd[7 * 200] = (bf16_t)(u.w >> 16);
    }
    __syncthreads();
    const int unit = pi * 2 + uh;
    const int nb = unit & 63, h = (unit >> 6) & 7, b = (unit >> 9) & 7, br = unit >> 12;
    const int dsh = 2 * br, Mr = 4096 >> dsh;
    const int seg = (nb * 64) / Mr, segstart = seg * Mr, segend = segstart + Mr;
    const bool pv_ok = (nb * 64 - 64 >= segstart), nx_ok = (nb * 64 + 128 <= segend);
    const int qp = nb * 64 + mt * 16 + lr;
    const int qtok = b * 4096 + (((qp - segstart) << dsh) + seg);
    bf16x8 qf[2];
    qf[0] = qn[0]; qf[1] = qn[1];
    if (pi + (int)gridDim.x < npairs) load_pair(pi + gridDim.x);
    f32x4 sacc[12];
#pragma unroll
    for (int kt = 0; kt < 12; ++kt) {
      const int key = kt * 16 + lr;
      const bf16x8 k0 = *(const bf16x8*)(ul + key * 128 + ((lq ^ (key & 7)) * 16));
      const bf16x8 k1 = *(const bf16x8*)(ul + key * 128 + (((4 + lq) ^ (key & 7)) * 16));
      f32x4 a = (f32x4){0.f, 0.f, 0.f, 0.f};
      a = __builtin_amdgcn_mfma_f32_16x16x32_bf16(k0, qf[0], a, 0, 0, 0);
      a = __builtin_amdgcn_mfma_f32_16x16x32_bf16(k1, qf[1], a, 0, 0, 0);
      sacc[kt] = a;
    }
    const int qi = mt * 16 + lr;
    float mx = -1e30f;
#pragma unroll
    for (int kt = 0; kt < 12; ++kt) {
      const int kb = kt >> 2;
#pragma unroll
      for (int r = 0; r < 4; ++r) {
        const int kj = (kt & 3) * 16 + lq * 4 + r;
        bool ok = true;
        if (kb == 0) ok = pv_ok && (kj >= qi);
        if (kb == 2) ok = nx_ok && (kj <= qi);
        const float sv = ok ? sacc[kt][r] : -1e30f;
        sacc[kt][r] = sv;
        mx = fmaxf(mx, sv);
      }
    }
    mx = fmaxf(mx, __shfl_xor(mx, 16));
    mx = fmaxf(mx, __shfl_xor(mx, 32));
    float den = 0.f;
#pragma unroll
    for (int kt = 0; kt < 12; ++kt)
#pragma unroll
      for (int r = 0; r < 4; ++r) {
        const float pe = __builtin_amdgcn_exp2f(sacc[kt][r] - mx);
        sacc[kt][r] = pe;
        den += pe;
      }
    den += __shfl_xor(den, 16);
    den += __shfl_xor(den, 32);
    f32x4 oacc[4];
#pragma unroll
    for (int et = 0; et < 4; ++et) oacc[et] = (f32x4){0.f, 0.f, 0.f, 0.f};
#pragma unroll
    for (int t = 0; t < 6; ++t) {
      u32x4 pu;
      pu.x = pk2(sacc[2 * t][0], sacc[2 * t][1]); pu.y = pk2(sacc[2 * t][2], sacc[2 * t][3]);
      pu.z = pk2(sacc[2 * t + 1][0], sacc[2 * t + 1][1]); pu.w = pk2(sacc[2 * t + 1][2], sacc[2 * t + 1][3]);
      const bf16x8 pf = __builtin_bit_cast(bf16x8, pu);
#pragma unroll
      for (int et = 0; et < 4; ++et) {
        const char* vrow = ul + 24576 + (et * 16 + lr) * 400;
        const int sw = ((et * 2 + (lr >> 3)) & 7) << 2;
        const u32x2 v0 = *(const u32x2*)(vrow + (((2 * t) * 16 + lq * 4) ^ sw) * 2), v1 = *(const u32x2*)(vrow + (((2 * t + 1) * 16 + lq * 4) ^ sw) * 2);
        u32x4 vu;
        vu.x = v0.x; vu.y = v0.y; vu.z = v1.x; vu.w = v1.y;
        oacc[et] = __builtin_amdgcn_mfma_f32_16x16x32_bf16(__builtin_bit_cast(bf16x8, vu), pf, oacc[et], 0, 0, 0);
      }
    }
    bf16_t* np = num + ((size_t)br * MT + qtok) * 512 + h * 64 + lq * 4;
#pragma unroll
    for (int et = 0; et < 4; ++et) { u32x2 w; w.x = pk2(oacc[et][0], oacc[et][1]); w.y = pk2(oacc[et][2], oacc[et][3]); *(u32x2*)(np + et * 16) = w; }
    if (lq == 0) {
      f32x2 o;
      o.x = mx; o.y = den;
      *(f32x2*)(md + (((size_t)br * MT + qtok) * 8 + h) * 2) = o;
    }
    __syncthreads();
  }
}

DEV void combineA(const P& p) {
  const bf16_t* num = (const bf16_t*)(p.ws + O_NUM);
  const float* md = (const float*)(p.ws + O_MD);
  bf16_t* ycat = (bf16_t*)(p.ws + O_YCAT);
  const int gt = blockIdx.x * NTHR + tidx(), ngt = gridDim.x * NTHR;
  for (int idx = gt; idx < MT * 128; idx += ngt) {
    const int e4 = idx & 15, h = (idx >> 4) & 7, tok = idx >> 7;
    f32x2 m0 = *(const f32x2*)(md + (((size_t)0 * MT + tok) * 8 + h) * 2);
    f32x2 m1 = *(const f32x2*)(md + (((size_t)1 * MT + tok) * 8 + h) * 2);
    f32x2 m2 = *(const f32x2*)(md + (((size_t)2 * MT + tok) * 8 + h) * 2);
    const float ma = fmaxf(m0.x, fmaxf(m1.x, m2.x));
    const float e0 = __builtin_amdgcn_exp2f(m0.x - ma), e1 = __builtin_amdgcn_exp2f(m1.x - ma), e2 = __builtin_amdgcn_exp2f(m2.x - ma);
    const float dn = e0 * m0.y + e1 * m1.y + e2 * m2.y;
    const u32x2 u0 = *(const u32x2*)(num + ((size_t)0 * MT + tok) * 512 + h * 64 + e4 * 4);
    const u32x2 u1 = *(const u32x2*)(num + ((size_t)1 * MT + tok) * 512 + h * 64 + e4 * 4);
    const u32x2 u2 = *(const u32x2*)(num + ((size_t)2 * MT + tok) * 512 + h * 64 + e4 * 4);
    const f32x4 n0 = (f32x4){lo16(u0.x), hi16(u0.x), lo16(u0.y), hi16(u0.y)}, n1 = (f32x4){lo16(u1.x), hi16(u1.x), lo16(u1.y), hi16(u1.y)},
                n2 = (f32x4){lo16(u2.x), hi16(u2.x), lo16(u2.y), hi16(u2.y)};
    const f32x4 o = (n0 * e0 + n1 * e1 + n2 * e2) * (1.f / dn);
    u32x2 pk;
    pk.x = pk2(o[0], o[1]); pk.y = pk2(o[2], o[3]);
    *(u32x2*)(ycat + (size_t)tok * 1024 + 512 + h * 64 + e4 * 4) = pk;
  }
}

DEV float dpp_allreduce16(float x) {
  x += __int_as_float(__builtin_amdgcn_update_dpp(0, __float_as_int(x), 0xB1, 0xF, 0xF, true));
  x += __int_as_float(__builtin_amdgcn_update_dpp(0, __float_as_int(x), 0x4E, 0xF, 0xF, true));
  x += __int_as_float(__builtin_amdgcn_update_dpp(0, __float_as_int(x), 0x141, 0xF, 0xF, true));
  x += __int_as_float(__builtin_amdgcn_update_dpp(0, __float_as_int(x), 0x140, 0xF, 0xF, true));
  return x;
}

DEV void scan_phase(char* lds, const P& p) {
  const bf16_t* omw = (const bf16_t*)(p.ws + O_OMW);
  const bf16_t* kd = (const bf16_t*)(p.ws + O_KD);
  const bf16_t* kka = (const bf16_t*)(p.ws + O_KKA);
  const bf16_t* kk = (const bf16_t*)(p.ws + O_KK);
  const bf16_t* za = (const bf16_t*)p.out;
  bf16_t* Y = (bf16_t*)(p.ws + O_Y);
  float* inb = (float*)lds;
  float* ypart = (float*)(lds + 98304);
  const int tid = tidx(), w = tid >> 6, lane = tid & 63, rg = lane >> 4, jl = lane & 15, j0 = jl * 4;
  for (int it = blockIdx.x; it < 256; it += gridDim.x) {
    const int sc = it >> 1, half = it & 1, d = sc >> 6, b = (sc >> 3) & 7, h = sc & 7;
    if (w >= 4) {
      const int lt = tid - 256;
      const int li = lt >> 3, pc = lt & 7;
      const int t0 = d ? (4095 - li) : li;
      const size_t tok0 = (size_t)(b * 4096 + t0);
      const bf16_t* s_omw = omw + (size_t)d * MT * 512 + tok0 * 512 + h * 64 + pc * 8;
      const bf16_t* s_a = kd + (size_t)d * MT * 512 + tok0 * 512 + h * 64 + pc * 8;
      const bf16_t* s_kk = kk + tok0 * 512 + h * 64 + pc * 8;
      const bf16_t* s_z = za + tok0 * 2048 + h * 64 + pc * 8;
      const ptrdiff_t st5 = (ptrdiff_t)512 * 32 * (d ? -1 : 1), st2 = (ptrdiff_t)2048 * 32 * (d ? -1 : 1);
      const int dst0 = li * 384 + pc * 8;
      float kav[8];
      *(f32x4*)kav = *(const f32x4*)(p.k_a + h * 64 + pc * 8); *(f32x4*)(kav + 4) = *(const f32x4*)(p.k_a + h * 64 + pc * 8 + 4);
      u32x4 rr[7];
      const ptrdiff_t prevoff = (li == 0) ? 0 : (d ? 512 : -512);
#define SCAN_LOAD(cc) do { rr[0] = *(const u32x4*)(s_omw + st5 * (cc)); rr[1] = *(const u32x4*)(s_a + st5 * (cc)); rr[2] = *(const u32x4*)(s_kk + st5 * (cc)); \
        rr[3] = *(const u32x4*)(s_z + 512 + st2 * (cc)); rr[4] = *(const u32x4*)(s_z + st2 * (cc)); rr[5] = *(const u32x4*)(s_z + 1024 + st2 * (cc)); \
        rr[6] = *(const u32x4*)(s_omw + st5 * (cc) + prevoff); } while (0)
#define SCAN_FILL(dstbuf) do { float fo[8], fa[8], fk[8], fx[8], fr[8], fv[8], fw[8], fd[8], fq[8], fp[8]; \
        unpackh8(rr[0], fo); unpack8(rr[1], fa); unpack8(rr[2], fk); unpack8(rr[3], fx); unpack8(rr[4], fr); unpack8(rr[5], fv); unpackh8(rr[6], fp); \
        _Pragma("unroll") for (int i_ = 0; i_ < 8; ++i_) { \
          const float einc_ = __expf(fo[i_]), pinc_ = __expf(-fo[i_]), pexc_ = (li == 0) ? 1.f : __expf(-fp[i_]);     \
          fw[i_] = pinc_;                                                      \
          fd[i_] = fx[i_] * (1.f + (fa[i_] - 1.f) * kav[i_]) * einc_;          \
          fq[i_] = fk[i_] * fa[i_] * einc_;                                    \
          fk[i_] = fk[i_] * pexc_;                                             \
          fr[i_] = fr[i_] * pinc_; }                                           \
        float* o_ = (dstbuf) + dst0; \
        *(f32x4*)(o_) = (f32x4){fw[0], fw[1], fw[2], fw[3]}; *(f32x4*)(o_ + 4) = (f32x4){fw[4], fw[5], fw[6], fw[7]}; \
        *(f32x4*)(o_ + 64) = (f32x4){fd[0], fd[1], fd[2], fd[3]}; *(f32x4*)(o_ + 68) = (f32x4){fd[4], fd[5], fd[6], fd[7]}; \
        *(f32x4*)(o_ + 128) = (f32x4){fq[0], fq[1], fq[2], fq[3]}; *(f32x4*)(o_ + 132) = (f32x4){fq[4], fq[5], fq[6], fq[7]}; \
        *(f32x4*)(o_ + 192) = (f32x4){fk[0], fk[1], fk[2], fk[3]}; *(f32x4*)(o_ + 196) = (f32x4){fk[4], fk[5], fk[6], fk[7]}; \
        *(f32x4*)(o_ + 256) = (f32x4){fr[0], fr[1], fr[2], fr[3]}; *(f32x4*)(o_ + 260) = (f32x4){fr[4], fr[5], fr[6], fr[7]}; \
        *(f32x4*)(o_ + 320) = (f32x4){fv[0], fv[1], fv[2], fv[3]}; *(f32x4*)(o_ + 324) = (f32x4){fv[4], fv[5], fv[6], fv[7]}; } while (0)
      SCAN_LOAD(0);
      SCAN_FILL(inb);
      SCAN_LOAD(1);
      __syncthreads();
      for (int c = 0; c < 128; ++c) {
        if (c + 1 < 128) SCAN_FILL(inb + ((c + 1) & 1) * 12288);
        if (c + 2 < 128) SCAN_LOAD(c + 2);
        if (c > 0) {
          const int cc = c - 1, idx = lt * 4, i = idx >> 5, rl = idx & 31;
          const int t = d ? (4095 - (cc * 32 + i)) : (cc * 32 + i);
          const float* q = ypart + (cc & 1) * 4096 + i * 128 + rl;
          const f32x4 o = (*(const f32x4*)q + *(const f32x4*)(q + 32)) + (*(const f32x4*)(q + 64) + *(const f32x4*)(q + 96));
          u32x2 ow; ow.x = pk2(o[0], o[1]); ow.y = pk2(o[2], o[3]);
          *(u32x2*)(Y + ((size_t)d * MT + b * 4096 + t) * 512 + h * 64 + half * 32 + rl) = ow;
        }
        __syncthreads();
      }
      {
        const int cc = 127, idx = lt * 4, i = idx >> 5, rl = idx & 31;
        const int t = d ? (4095 - (cc * 32 + i)) : (cc * 32 + i);
        const float* q = ypart + (cc & 1) * 4096 + i * 128 + rl;
        const f32x4 o = (*(const f32x4*)q + *(const f32x4*)(q + 32)) + (*(const f32x4*)(q + 64) + *(const f32x4*)(q + 96));
        u32x2 ow; ow.x = pk2(o[0], o[1]); ow.y = pk2(o[2], o[3]);
        *(u32x2*)(Y + ((size_t)d * MT + b * 4096 + t) * 512 + h * 64 + half * 32 + rl) = ow;
      }
    } else {
      const int rowl = w * 8 + (lane >> 3), row = half * 32 + rowl, j8 = (lane & 7) * 8;
      f32x2 s0 = (f32x2){0.f, 0.f}, s1 = s0, s2 = s0, s3 = s0;
      __syncthreads();
      for (int c = 0; c < 128; ++c) {
        const float* cur = inb + (c & 1) * 12288;
        float* yp = ypart + (c & 1) * 4096 + ((lane & 7) >> 1) * 32 + rowl;
        f32x4 kdA = *(const f32x4*)(cur + 64 + j8), kdB = *(const f32x4*)(cur + 64 + j8 + 4),
              kaA = *(const f32x4*)(cur + 128 + j8), kaB = *(const f32x4*)(cur + 128 + j8 + 4), kkA = *(const f32x4*)(cur + 192 + j8), kkB = *(const f32x4*)(cur + 192 + j8 + 4),
              rA = *(const f32x4*)(cur + 256 + j8), rB = *(const f32x4*)(cur + 256 + j8 + 4);
        float v = cur[320 + row];
#pragma unroll 8
        for (int i = 0; i < 32; ++i) {
          const float* sn = cur + ((i + 1) & 31) * 384;
          const f32x4 nkdA = *(const f32x4*)(sn + 64 + j8), nkdB = *(const f32x4*)(sn + 64 + j8 + 4),
                      nkaA = *(const f32x4*)(sn + 128 + j8), nkaB = *(const f32x4*)(sn + 128 + j8 + 4), nkkA = *(const f32x4*)(sn + 192 + j8), nkkB = *(const f32x4*)(sn + 192 + j8 + 4),
                      nrA = *(const f32x4*)(sn + 256 + j8), nrB = *(const f32x4*)(sn + 256 + j8 + 4);
          const float nv = sn[320 + row];
          const f32x2 t = (s0 * kkA.xy + s1 * kkA.zw) + (s2 * kkB.xy + s3 * kkB.zw);
          float sk = t.x + t.y;
          sk += __int_as_float(__builtin_amdgcn_update_dpp(0, __float_as_int(sk), 0xB1, 0xF, 0xF, true));
          sk += __int_as_float(__builtin_amdgcn_update_dpp(0, __float_as_int(sk), 0x4E, 0xF, 0xF, true));
          sk += __int_as_float(__builtin_amdgcn_update_dpp(0, __float_as_int(sk), 0x141, 0xF, 0xF, true));
          s0 = (s0 + kdA.xy * v) - kaA.xy * sk;
          s1 = (s1 + kdA.zw * v) - kaA.zw * sk;
          s2 = (s2 + kdB.xy * v) - kaB.xy * sk;
          s3 = (s3 + kdB.zw * v) - kaB.zw * sk;
          const f32x2 u = (s0 * rA.xy + s1 * rA.zw) + (s2 * rB.xy + s3 * rB.zw);
          float y = u.x + u.y;
          y += __int_as_float(__builtin_amdgcn_update_dpp(0, __float_as_int(y), 0xB1, 0xF, 0xF, true));
          yp[i * 128] = y;
          kdA = nkdA; kdB = nkdB; kaA = nkaA; kaB = nkaB; kkA = nkkA; kkB = nkkB; rA = nrA; rB = nrB; v = nv;
        }
        {
          const f32x4 peA = *(const f32x4*)(cur + 31 * 384 + j8), peB = *(const f32x4*)(cur + 31 * 384 + j8 + 4);
          s0 = s0 * peA.xy; s1 = s1 * peA.zw; s2 = s2 * peB.xy; s3 = s3 * peB.zw;
        }
        __syncthreads();
      }
    }
    __syncthreads();
  }
}

DEV void postB(const P& p) {
  const bf16_t* Y = (const bf16_t*)(p.ws + O_Y);
  const bf16_t* kd = (const bf16_t*)(p.ws + O_KD);
  const bf16_t* gg = (const bf16_t*)(p.ws + O_G);
  const bf16_t* za = (const bf16_t*)p.out;
  bf16_t* ycat = (bf16_t*)(p.ws + O_YCAT);
  const int lane = tidx() & 63, sub = lane >> 4, jl = lane & 15, gw = blockIdx.x * 8 + (tidx() >> 6), nw = gridDim.x * 8;
  for (int it = gw; it < MT * 2; it += nw) {
    const int item = it * 4 + sub, tok = item >> 3, h = item & 7, c = h * 64 + jl * 4;
    const u32x2 yu0 = *(const u32x2*)(Y + (size_t)tok * 512 + c), yu1 = *(const u32x2*)(Y + ((size_t)MT + tok) * 512 + c);
    const f32x4 y0 = (f32x4){lo16(yu0.x), hi16(yu0.x), lo16(yu0.y), hi16(yu0.y)}, y1 = (f32x4){lo16(yu1.x), hi16(yu1.x), lo16(yu1.y), hi16(yu1.y)};
    const u32x2 k0 = *(const u32x2*)(kd + (size_t)tok * 512 + c), k1 = *(const u32x2*)(kd + ((size_t)MT + tok) * 512 + c);
    const u32x2 ku = *(const u32x2*)(za + (size_t)tok * 2048 + 512 + c);
    const f32x4 kav = *(const f32x4*)(p.k_a + c);
    const u32x2 ru = *(const u32x2*)(za + (size_t)tok * 2048 + c), vu = *(const u32x2*)(za + (size_t)tok * 2048 + 1024 + c), gu = *(const u32x2*)(gg + (size_t)tok * 512 + c);
    const f32x4 lw = *(const f32x4*)(p.lnx_w + c), lb = *(const f32x4*)(p.lnx_b + c), rk = *(const f32x4*)(p.r_k + c);
    const f32x4 y = y0 + y1;
    const float mu = dpp_allreduce16((y[0] + y[1]) + (y[2] + y[3])) * (1.f / 64.f);
    const f32x4 dv = y - mu;
    const float var = dpp_allreduce16((dv[0] * dv[0] + dv[1] * dv[1]) + (dv[2] * dv[2] + dv[3] * dv[3])) * (1.f / 64.f);
    const float rs = rsqrtf(var + 64e-5f);
    const f32x4 r = (f32x4){lo16(ru.x), hi16(ru.x), lo16(ru.y), hi16(ru.y)}, v = (f32x4){lo16(vu.x), hi16(vu.x), lo16(vu.y), hi16(vu.y)};
    const f32x4 g = (f32x4){lo16(gu.x), hi16(gu.x), lo16(gu.y), hi16(gu.y)};
    const f32x4 asum = (f32x4){lo16(k0.x) + lo16(k1.x), hi16(k0.x) + hi16(k1.x), lo16(k0.y) + lo16(k1.y), hi16(k0.y) + hi16(k1.y)};
    const f32x4 kx = (f32x4){lo16(ku.x), hi16(ku.x), lo16(ku.y), hi16(ku.y)};
    const f32x4 kds = kx * ((asum - 2.f) * kav + 2.f);
    const f32x4 t = r * kds * rk;
    const float bs = dpp_allreduce16((t[0] + t[1]) + (t[2] + t[3]));
    const f32x4 o = (dv * rs * lw + lb + v * bs) * g;
    u32x2 pk;
    pk.x = pk2(o[0], o[1]); pk.y = pk2(o[2], o[3]);
    *(u32x2*)(ycat + (size_t)tok * 1024 + c) = pk;
  }
}

DEV void glu_fixup(const P& p, int l, int strip0, int nstrips) {
  const bf16_t* sb = (const bf16_t*)(p.ws + O_SB);
  bf16_t* act = (bf16_t*)(p.ws + O_ACT);
  const float* cw = p.ffn_conv + (size_t)l * 3 * 5632;
  for (int item = tidx(); item < nstrips * 2 * 352; item += NTHR) {
    const int sl = item / 704, strip = strip0 + sl, rem = item - sl * 704, e = rem / 352, c8 = (rem - e * 352) * 8;
    const int R = strip * 64 + (e ? 63 : 0), s = R & 4095;
    const int colg = (c8 >> 7) * 256 + (c8 & 127);
    const bf16_t* pc = sb + ((size_t)strip * 4 + (e ? 3 : 0)) * 5632 + colg;
    const bf16_t* pp = e ? (pc - 5632) : (pc - 5632);
    const bf16_t* pn = e ? (pc + 5632) : (pc + 5632);
    const u32x4 z0 = (u32x4){0u, 0u, 0u, 0u};
    const bool hasp = e ? true : (s > 0), hasn = e ? (s < 4095) : true;
    float gm[8], gc[8], gn[8], vm[8], vc[8], vn[8], o[8];
    unpack8(hasp ? *(const u32x4*)pp : z0, gm); unpack8(hasp ? *(const u32x4*)(pp + 128) : z0, vm);
    unpack8(*(const u32x4*)pc, gc); unpack8(*(const u32x4*)(pc + 128), vc);
    unpack8(hasn ? *(const u32x4*)pn : z0, gn); unpack8(hasn ? *(const u32x4*)(pn + 128) : z0, vn);
#pragma unroll
    for (int i = 0; i < 8; ++i) {
      const float g = gm[i] * cw[c8 + i] + gc[i] * cw[5632 + c8 + i] + gn[i] * cw[11264 + c8 + i];
      const float vv = vm[i] * cw[2816 + c8 + i] + vc[i] * cw[5632 + 2816 + c8 + i] + vn[i] * cw[11264 + 2816 + c8 + i];
      const float u2 = -1.5957691216057308f * (g + 0.044715f * g * g * g);
      o[i] = g * __builtin_amdgcn_rcpf(1.f + __expf(u2)) * vv;
    }
    *(u32x4*)(act + (size_t)R * 2816 + c8) = pack8(o);
  }
}

template <class Epi>
DEV void gemm_grid(char* lds, const bf16_t* A, int lda, const bf16_t* Bt, int ldb, int K, int tilesM, int tilesN, const Epi& epi) {
  const int nt = tilesM * tilesN;
  u32x4 ra[4], rb[2];
  int t = blockIdx.x;
  if (t < nt) gemm_first_load(A + (size_t)(t / tilesN) * 256 * lda, lda, Bt + (size_t)(t % tilesN) * 128 * ldb, ldb, ra, rb);
  for (; t < nt; t += gridDim.x) {
    const int tm = t / tilesN, tn = t % tilesN, t2 = t + gridDim.x;
    const bf16_t* An = (t2 < nt) ? A + (size_t)(t2 / tilesN) * 256 * lda : nullptr;
    const bf16_t* Bn = (t2 < nt) ? Bt + (size_t)(t2 % tilesN) * 128 * ldb : nullptr;
    gemm_tile(lds, A + (size_t)tm * 256 * lda, lda, Bt + (size_t)tn * 128 * ldb, ldb, K, tm * 256, tn * 128, epi, ra, rb, An, Bn);
  }
}


DEV void dft_fold(const P& p) {
  const bf16_t* CST = (const bf16_t*)(p.ws + O_CST);
  bf16_t* CF = (bf16_t*)(p.ws + O_CSTF);
  for (int idx = blockIdx.x * NTHR + tidx(); idx < 16384 * 256; idx += gridDim.x * NTHR) {
    const int r = idx >> 8, s8 = (idx & 255) * 8, eo = (r >> 10) & 1;
    const bf16_t* src = CST + (size_t)r * 4096;
    float a[8], bq[8], o[8];
    unpack8(*(const u32x4*)(src + s8), a);
    if (s8 == 0) {
      unpack8(*(const u32x4*)(src + 4088), bq);
      o[0] = eo ? 0.f : a[0];
#pragma unroll
      for (int i = 1; i < 8; ++i) o[i] = eo ? (a[i] - bq[8 - i]) : (a[i] + bq[8 - i]);
      if (!eo) ((float*)(p.ws + O_C2048))[(r >> 11) * 1024 + (r & 1023)] = bf2f(src[2048]) * (1.f / 64.f);
    } else {
      unpack8(*(const u32x4*)(src + 4096 - s8 - 8), bq);
      const float b0 = bf2f(src[4096 - s8]);
      o[0] = eo ? (a[0] - b0) : (a[0] + b0);
#pragma unroll
      for (int i = 1; i < 8; ++i) o[i] = eo ? (a[i] - bq[8 - i]) : (a[i] + bq[8 - i]);
    }
    *(u32x4*)(CF + (size_t)r * 2048 + s8) = pack8(o);
  }
}

DEV void dft_combine(const P& p) {
  const bf16_t* EO = (const bf16_t*)(p.ws + O_EO);
  const bf16_t* CST = (const bf16_t*)(p.ws + O_CST);
  bf16_t* f = (bf16_t*)(p.ws + O_F);
  for (int idx = blockIdx.x * NTHR + tidx(); idx < 8 * 2048 * 256; idx += gridDim.x * NTHR) {
    const int c4 = (idx & 255) * 4, k1 = (idx >> 8) & 2047, b = idx >> 19;
    const u32x2 eu = *(const u32x2*)(EO + ((size_t)(b * 2) * 2048 + k1) * 1024 + c4), ou = *(const u32x2*)(EO + ((size_t)(b * 2 + 1) * 2048 + k1) * 1024 + c4);
    f32x4 e = (f32x4){lo16(eu.x), hi16(eu.x), lo16(eu.y), hi16(eu.y)};
    const f32x4 o = (f32x4){lo16(ou.x), hi16(ou.x), lo16(ou.y), hi16(ou.y)};
    {
      const f32x4 cm = *(const f32x4*)((const float*)(p.ws + O_C2048) + b * 1024 + c4);
      e = (k1 & 1) ? (e - cm) : (e + cm);
    }
    const f32x4 d = e - o, s = e + o;
    u32x2 pk;
    pk.x = pk2(d[0], d[1]); pk.y = pk2(d[2], d[3]);
    *(u32x2*)(f + ((size_t)b * 4096 + k1) * 1024 + c4) = pk;
    if (k1 > 0) {
      pk.x = pk2(s[0], s[1]); pk.y = pk2(s[2], s[3]);
      *(u32x2*)(f + ((size_t)b * 4096 + 4096 - k1) * 1024 + c4) = pk;
    }
  }
  for (int r = blockIdx.x * NTHR + tidx(); r < 8 * 1024; r += gridDim.x * NTHR) {
    const float* cc = (const float*)(p.ws + O_C2048);
    f[((size_t)(r >> 10) * 4096 + 2048) * 1024 + (r & 1023)] = f2bf(cc[16384 + r] + cc[r]);
  }
}
DEV void dft_altsum(const P& p) {
  const int lane = tidx() & 63, gw = blockIdx.x * 8 + (tidx() >> 6), nw = gridDim.x * 8;
  const bf16_t* CF = (const bf16_t*)(p.ws + O_CSTF);
  for (int r = gw; r < 8 * 1024; r += nw) {
    const int b = r >> 10, n = r & 1023;
    const bf16_t* cp = CF + ((size_t)(b * 2) * 1024 + n) * 2048;
    float acc = 0.f;
#pragma unroll
    for (int j = 0; j < 4; ++j) {
      const u32x4 u = *(const u32x4*)(cp + j * 512 + lane * 8);
      acc += (lo16(u.x) - hi16(u.x)) + (lo16(u.y) - hi16(u.y)) + (lo16(u.z) - hi16(u.z)) + (lo16(u.w) - hi16(u.w));
    }
    acc = wave_sum(acc);
    if (lane == 0) ((bf16_t*)(p.ws + O_F))[((size_t)b * 4096 + 2048) * 1024 + n] = f2bf(acc * (1.f / 64.f) + ((const float*)(p.ws + O_C2048))[r]);
  }
}

#define LDSP ((PG8_LAS unsigned char*)lds)
template <class Epi>
DEV void pgemm(char* lds, const bf16_t* A, const bf16_t* Bt, int M_, int N_, int K_, const Epi& E) {
  pg8::Gemm g{A, Bt, M_, N_, K_};
  pg8::StaticOrder S;
  S.init(M_, N_, (int)gridDim.x, (int)blockIdx.x);
  pg8::gemm_phase<Epi, pg8::StaticOrder, true, true>(LDSP, g, S, E);
}

DEV void ffn(char* lds, const XcdBarrier& xbar, const P& p, int l) {
  const bf16_t* h = (const bf16_t*)(p.ws + O_H);
  bf16_t* act = (bf16_t*)(p.ws + O_ACT);
  bf16_t* yf = (bf16_t*)(p.ws + O_YF);
  const bf16_t* upt = (const bf16_t*)(p.ws + W_UP) + (size_t)l * 5632 * 1024;
  const bf16_t* dnt = (const bf16_t*)(p.ws + W_DOWN) + (size_t)l * 1024 * 2816;
  pgemm(lds, h, upt, MT, 5632, 1024, pg8::PEpiGlu{act, (bf16_t*)(p.ws + O_SB), p.ffn_conv + (size_t)l * 3 * 5632});
  xcd_barrier(xbar);
  {
    pg8::StaticOrder S;
    S.init(MT, 1024, (int)gridDim.x, (int)blockIdx.x);
    pg8::Unit u;
    for (int i = 0; S.next(i, u); ++i) glu_fixup(p, l, u.pm * 4, 4);
    asm volatile("s_waitcnt vmcnt(0)" ::: "memory");
    __syncthreads();
  }
  pgemm(lds, act, dnt, MT, 1024, 2816, pg8::PEpiBf16<false>{yf, 1024});
  xcd_barrier(xbar);
}

DEV const P& kargs() {
  auto q = __builtin_amdgcn_kernarg_segment_ptr();
  asm volatile("" : "+s"(q));
  return *(const P*)q;
}
#define p (kargs())
__global__ void __launch_bounds__(NTHR) mega(P parg_unused) {
  extern __shared__ __attribute__((aligned(16))) char lds[];
  cg::grid_group grid = cg::this_grid();
  char* ws = p.ws;
  if (tidx() < 4) ((unsigned*)(lds + 131072))[tidx()] = 0u;
  __syncthreads();
  const XcdBarrier xbar = xcd_barrier_post((unsigned*)(ws + W_BAR), (volatile XLAS unsigned*)(lds + 131072));
  float* mod = (float*)(ws + W_MOD);
  const int gt = blockIdx.x * NTHR + tidx(), ngt = gridDim.x * NTHR;

  for (int rep_ = 0; rep_ < REP_PRO; ++rep_) {
  if (rep_ > 0) xcd_barrier(xbar);
  compute_mod(lds, p);
  transpose_convert(lds, p.mix_in, 1024, 3584, (bf16_t*)(ws + W_MIXIN), 1024, 0, 2);
  for (int l = 0; l < 2; ++l) {
    transpose_convert(lds, p.ffn_up + (size_t)l * 1024 * 5632, 1024, 5632, (bf16_t*)(ws + W_UP) + (size_t)l * 5632 * 1024, 1024, 64 * l, 1);
    transpose_convert(lds, p.ffn_down + (size_t)l * 2816 * 1024, 2816, 1024, (bf16_t*)(ws + W_DOWN) + (size_t)l * 1024 * 2816, 2816, 128 + 64 * l);
  }
  transpose_convert(lds, p.mix_out, 1024, 1024, (bf16_t*)(ws + W_MIXOUT), 1024, 32);
  transpose_convert(lds, p.fnet_w, 1024, 1024, (bf16_t*)(ws + W_FNET), 1024, 96);
  for (int d = 0; d < 2; ++d) {
    transpose_convert(lds, p.w1 + (size_t)d * 512 * 64, 512, 64, (bf16_t*)(ws + W_L1) + (size_t)(d * 64) * 512, 512, 8 * d);
    transpose_convert(lds, p.a1 + (size_t)d * 512 * 64, 512, 64, (bf16_t*)(ws + W_L1) + (size_t)(128 + d * 64) * 512, 512, 16 + 8 * d);
    transpose_convert(lds, p.w2 + (size_t)d * 64 * 512, 64, 512, (bf16_t*)(ws + W_W2) + (size_t)d * 512 * 64, 64, 48 + 8 * d);
    transpose_convert(lds, p.a2 + (size_t)d * 64 * 512, 64, 512, (bf16_t*)(ws + W_A2) + (size_t)d * 512 * 64, 64, 64 + 8 * d);
  }
  transpose_convert(lds, p.g1, 512, 128, (bf16_t*)(ws + W_L1) + (size_t)256 * 512, 512, 32);
  transpose_convert(lds, p.g2, 128, 512, (bf16_t*)(ws + W_G2), 128, 80);
  {
    float* rope = (float*)(ws + W_ROPE);
    for (int idx = gt; idx < 4096 * 32; idx += ngt) {
      const int s = idx >> 5, e = idx & 31;
      const float inv = powf(10000.f, -(float)e / 32.f);
      const float ang = (float)s * inv;
      float sv, cv;
      sincosf(ang, &sv, &cv);
      rope[2 * idx] = cv;
      rope[2 * idx + 1] = sv;
    }
    bf16_t* dftc = (bf16_t*)(ws + W_DFTC);
    for (int idx = gt; idx < 256 * 256; idx += ngt) {
      const int n = idx >> 8, cc = idx & 255, c = cc & 127, k2 = n & 127;
      const float ph = (float)((k2 * c) & 127) * (1.f / 64.f);
      float v = 0.f;
      if (n < 128 && cc < 128) v = cospif(ph);
      if (n >= 128 && cc >= 128) v = sinpif(ph);
      dftc[idx] = f2bf(v * 0.08838834764831845f);
    }
  }
  }
  grid.sync();
  for (int rep_ = 0; rep_ < REP_ROW; ++rep_) { rowpass<false, true>(p.x, nullptr, nullptr, nullptr, nullptr, p.norm_g, mod + 1024, mod, (bf16_t*)(ws + O_H0)); xcd_barrier(xbar); }
  pgemm(lds, (const bf16_t*)(ws + O_H0), (const bf16_t*)(ws + W_MIXIN), MT, INC, 1024,
        pg8::PEpiMixIn{(bf16_t*)p.out, (bf16_t*)(ws + O_SBZ), (bf16_t*)(ws + O_QR), (bf16_t*)(ws + O_KR), (bf16_t*)(ws + O_VT), p.mix_conv, (const float*)(ws + W_ROPE)});
  xcd_barrier(xbar);
  za_fixup(p);
  attention(lds, p);
  for (int t = blockIdx.x; t < 128 * 3; t += gridDim.x) za_fixup_u(p, t / 3);
  asm volatile("s_waitcnt vmcnt(0)" ::: "memory");
  __syncthreads();
  gemm_grid(lds, (const bf16_t*)p.out + 1536, 2048, (const bf16_t*)(ws + W_L1), 512, 512, 128, 3, EpiLora1{(bf16_t*)(ws + O_L1)});
  xcd_barrier(xbar);
  for (int d = 0; d < 2; ++d) {
    gemm_grid(lds, (const bf16_t*)(ws + O_L1) + d * 64, 384, (const bf16_t*)(ws + W_W2) + (size_t)d * 512 * 64, 64, 64, 128, 4,
              EpiDecay{(unsigned short*)(ws + O_OMW) + (size_t)d * MT * 512, p.w0 + d * 512, d});
    gemm_grid(lds, (const bf16_t*)(ws + O_L1) + 128 + d * 64, 384, (const bf16_t*)(ws + W_A2) + (size_t)d * 512 * 64, 64, 64, 128, 4,
              EpiA{(bf16_t*)(ws + O_KD) + (size_t)d * MT * 512, (bf16_t*)(ws + O_KK), p.a0 + d * 512, p.k_k, (const bf16_t*)p.out, d == 0});
  }
  gemm_grid(lds, (const bf16_t*)(ws + O_L1) + 256, 384, (const bf16_t*)(ws + W_G2), 128, 128, 128, 4, EpiBf16{(bf16_t*)(ws + O_G), 512});
  combineA(p);
  xcd_barrier(xbar);
  for (int rep_ = 0; rep_ < REP_SCAN; ++rep_) { scan_phase(lds, p); xcd_barrier(xbar); }
  for (int rep_ = 0; rep_ < REP_SYNC; ++rep_) xcd_barrier(xbar);
  postB(p);
  xcd_barrier(xbar);
  pgemm(lds, (const bf16_t*)(ws + O_YCAT), (const bf16_t*)(ws + W_MIXOUT), MT, 1024, 1024, pg8::PEpiBf16<false>{(bf16_t*)(ws + O_YF), 1024});
  xcd_barrier(xbar);
  rowpass<true, true, false, true>(p.x, (const bf16_t*)(ws + O_YF), p.norm_g + 1024, mod + 2048, ws + O_XB, p.norm_g + 2048, mod + 4096, mod + 3072, (bf16_t*)(ws + O_H));
  xcd_barrier(xbar);
  ffn(lds, xbar, p, 0);
  {
    const float* mod1 = mod + 8 * 6144;
    rowpass_fold((bf16_t*)(ws + O_XB), (const bf16_t*)(ws + O_YF), p.norm_g + 3072, mod + 5120, p.norm_g + 4096, mod1 + 1024, mod1, (bf16_t*)(ws + O_H),
                 (float*)(ws + O_C2048) + 8192);
    bf16_t* cs = (bf16_t*)(ws + O_COSSIN);
    for (int idx = blockIdx.x * NTHR + tidx(); idx < 4096 * 256; idx += gridDim.x * NTHR) {
      const int rr = idx >> 8, s8 = (idx & 255) * 8, k1 = rr & 2047;
      float o[8];
#pragma unroll
      for (int i = 0; i < 8; ++i) {
        const float ph = (float)((k1 * (s8 + i)) & 4095) * (1.f / 2048.f);
        o[i] = ((rr < 2048) ? cospif(ph) : sinpif(ph)) * (1.f / 64.f);
      }
      *(u32x4*)(cs + (size_t)rr * 2048 + s8) = pack8(o);
    }
    xcd_barrier(xbar);
    {
      const bf16_t* dA = (const bf16_t*)(ws + W_DFTC);
      const bf16_t* hB = (const bf16_t*)(ws + O_H);
      u32x4 ra[4], rb[2];
      int t = blockIdx.x;
      if (t < 8 * 128) gemm_first_load(dA, 256, hB + (size_t)(t & 127) * 128 * 2048 + (t >> 7) * 256, 2048, ra, rb);
      for (; t < 8 * 128; t += gridDim.x) {
        const int g = t >> 7, tn = t & 127, t2 = t + gridDim.x;
        const bf16_t* Bn = (t2 < 8 * 128) ? hB + (size_t)(t2 & 127) * 128 * 2048 + (t2 >> 7) * 256 : nullptr;
        gemm_tile(lds, dA, 256, hB + (size_t)tn * 128 * 2048 + g * 256, 2048, 256, 0, tn * 128, EpiDftc{(bf16_t*)(ws + O_CSTF), g}, ra, rb,
                  Bn ? dA : nullptr, Bn);
      }
      const float* h2048 = (const float*)(ws + O_C2048) + 8192;
      for (int idx = blockIdx.x * NTHR + tidx(); idx < 8192; idx += gridDim.x * NTHR) {
        const int bb = idx >> 10, n = idx & 1023, g = n >> 7, k2 = n & 127;
        float acc = 0.f;
        for (int c = 0; c < 128; ++c) acc += h2048[bb * 1024 + g * 128 + c] * bf2f(dA[k2 * 256 + c]);
        ((float*)(ws + O_C2048))[idx] = acc * (1.f / 64.f);
      }
    }
    xcd_barrier(xbar);
    dft_altsum(p);
    {
      pg8::Gemm g{(const bf16_t*)(ws + O_COSSIN), (const bf16_t*)(ws + O_CSTF), 4096, 16384, 2048};
      pg8::BatchOrder S{(int)gridDim.x, (int)blockIdx.x};
      pg8::gemm_phase<pg8::PEpiDft, pg8::BatchOrder, true, true>(LDSP, g, S, pg8::PEpiDft{(bf16_t*)(ws + O_EO), (bf16_t*)(ws + O_F), (const float*)(ws + O_C2048)});
    }
    xcd_barrier(xbar);
    pgemm(lds, (const bf16_t*)(ws + O_F), (const bf16_t*)(ws + W_FNET), MT, 1024, 1024, pg8::PEpiBf16<false>{(bf16_t*)(ws + O_YF), 1024});
    xcd_barrier(xbar);
    rowpass<true, true, true, true>(ws + O_XB, (const bf16_t*)(ws + O_YF), p.norm_g + 4096 + 1024, mod1 + 2048, ws + O_XB, p.norm_g + 4096 + 2048, mod1 + 4096, mod1 + 3072,
                        (bf16_t*)(ws + O_H));
    xcd_barrier(xbar);
    ffn(lds, xbar, p, 1);
    rowpass<true, false, true, false>(ws + O_XB, (const bf16_t*)(ws + O_YF), p.norm_g + 4096 + 3072, mod1 + 5120, p.out, nullptr, nullptr, nullptr, nullptr);
  }
}

#undef p
extern "C" void kernel_launch(void* const* d_in, const int* in_sizes, int n_in, void* d_out, int out_size, void* d_ws, size_t ws_size,
                              hipStream_t stream) {
  static int grid_blocks = 0;
  if (!grid_blocks) {
    int dev = 0, cus = 0, per_cu = 0;
    hipGetDevice(&dev);
    hipDeviceGetAttribute(&cus, hipDeviceAttributeMultiprocessorCount, dev);
    hipFuncSetAttribute((const void*)mega, hipFuncAttributeMaxDynamicSharedMemorySize, LDS_BYTES);
    hipOccupancyMaxActiveBlocksPerMultiprocessor(&per_cu, (const void*)mega, NTHR, LDS_BYTES);
    if (per_cu < 1) { fprintf(stderr, "occupancy query returned %d\n", per_cu); per_cu = 1; }
    if (per_cu > 1) per_cu = 1;
    grid_blocks = cus * per_cu;
  }
  P p{};
  const float** pp = (const float**)&p;
  for (int i = 0; i < 25; ++i) pp[i] = (const float*)d_in[i];
  p.out = (float*)d_out;
  p.ws = (char*)d_ws;
  (void)hipMemsetAsync((char*)d_ws + W_BAR, 0, XCD_BAR_WORDS * sizeof(unsigned), stream);
  void* args[] = {&p};
  hipError_t e = hipLaunchCooperativeKernel((const void*)mega, dim3(grid_blocks), dim3(NTHR), args, LDS_BYTES, stream);
  if (e != hipSuccess) fprintf(stderr, "cooperative launch failed: %s (grid %d)\n", hipGetErrorString(e), grid_blocks);
}
```
